# Optimizing an MI355X kernel written in HIP

```python
import jax, jax.numpy as jnp
from jax import lax
import numpy as np

D_MODEL = 1024
BATCH = 4
SEQ = 8192
DEPTH = 1
DEC_BATCH = 32
DEC_SEQ = 32
PAST_LEN = 2048


CHUNK = 64
PAST_CHUNKS = 8
ATT_WINDOW = PAST_CHUNKS * CHUNK
BAND = ATT_WINDOW + CHUNK
MIX_W = D_MODEL
ATT_W = MIX_W // 2
CONV_W = MIX_W - ATT_W
HEAD_DIM = 64
N_HEADS = ATT_W // HEAD_DIM
REL_CLIP = 128
N_REL = 2 * REL_CLIP + 1
CONV_WIDTH = 31
CONV_HIST = CONV_WIDTH - 1
D_FF = -(-8 * D_MODEL // (3 * 256)) * 256
PLE_DIM = 256
IN_COLS = 3 * ATT_W + 2 * CONV_W
EPS = 1e-6
NEG = -1e30

kernel_name = 'hybrid_chunk_attn_conformer_conv_step'


def rms_norm(x, g):
    xf = x.astype(jnp.float32)
    y = xf * lax.rsqrt(jnp.mean(xf * xf, axis=-1, keepdims=True) + EPS)
    return (y * g.astype(jnp.float32)).astype(x.dtype)


def layer_norm(x, g, b):
    xf = x.astype(jnp.float32)
    mu = jnp.mean(xf, axis=-1, keepdims=True)
    xc = xf - mu
    y = xc * lax.rsqrt(jnp.mean(xc * xc, axis=-1, keepdims=True) + EPS)
    return (y * g.astype(jnp.float32) + b.astype(jnp.float32)).astype(x.dtype)


def project_mix_inputs(h, g_mix, w_in, q_gain, k_gain):
    u = rms_norm(h, g_mix)
    z = u @ w_in
    q, k, v, a, b = jnp.split(z, [ATT_W, 2 * ATT_W, 3 * ATT_W, 3 * ATT_W + CONV_W], axis=-1)
    shp = h.shape[:-1] + (N_HEADS, HEAD_DIM)
    q = rms_norm(q.reshape(shp), q_gain)
    k = rms_norm(k.reshape(shp), k_gain)
    v = v.reshape(shp)
    glu = a * jax.nn.sigmoid(b)
    return q, k, v, glu


def band_attend(q, k, v, q_pos, k_pos, rel_bias):
    s = jnp.einsum('nqhd,nkhd->nhqk', q.astype(jnp.float32), k.astype(jnp.float32)) * (HEAD_DIM ** -0.5)
    dist = q_pos[:, None] - k_pos[None, :]
    bias = rel_bias.astype(jnp.float32)[:, jnp.clip(dist, -REL_CLIP, REL_CLIP) + REL_CLIP]
    qc = (q_pos // CHUNK)[:, None]
    kc = (k_pos // CHUNK)[None, :]
    mask = (k_pos[None, :] >= 0) & (kc <= qc) & (kc >= qc - PAST_CHUNKS)
    s = jnp.where(mask, s + bias, NEG)
    p = jax.nn.softmax(s, axis=-1).astype(v.dtype)
    return jnp.einsum('nhqk,nkhd->nqhd', p, v)


def prompt_attention(q, k, v, rel_bias):
    n, s = q.shape[0], q.shape[1]
    n_chunks = s // CHUNK
    pad = jnp.zeros((n, ATT_WINDOW, N_HEADS, HEAD_DIM), k.dtype)
    kp = jnp.concatenate([pad, k], axis=1)
    vp = jnp.concatenate([pad, v], axis=1)

    def one_chunk(c):
        start = c * CHUNK
        qc = lax.dynamic_slice_in_dim(q, start, CHUNK, axis=1)
        kc = lax.dynamic_slice_in_dim(kp, start, BAND, axis=1)
        vc = lax.dynamic_slice_in_dim(vp, start, BAND, axis=1)
        q_pos = start + jnp.arange(CHUNK)
        k_pos = start - ATT_WINDOW + jnp.arange(BAND)
        return band_attend(qc, kc, vc, q_pos, k_pos, rel_bias)

    out = lax.map(one_chunk, jnp.arange(n_chunks))
    return jnp.moveaxis(out, 0, 1).reshape(n, s, ATT_W)


def conv_module_tail(glu, hist, conv_w, conv_b, ln_g, ln_b):
    xp = jnp.concatenate([hist, glu], axis=1)
    y = lax.conv_general_dilated(xp, conv_w[:, None, :], (1,), 'VALID',
                                 dimension_numbers=('NWC', 'WIO', 'NWC'),
                                 feature_group_count=CONV_W)
    y = y + conv_b
    return jax.nn.silu(layer_norm(y, ln_g, ln_b))


def finish_layer(h, att, cv, p, w_out, g_ffn, w_gate_up, w_down, g_ple, w_ple_gate, w_ple_proj):
    h = h + jnp.concatenate([att, cv], axis=-1) @ w_out
    u = rms_norm(h, g_ffn)
    gate, up = jnp.split(u @ w_gate_up, 2, axis=-1)
    h = h + (jax.nn.silu(gate) * up) @ w_down
    g = jax.nn.sigmoid(rms_norm(h, g_ple) @ w_ple_gate)
    return h + g * (p @ w_ple_proj)


def setup_inputs(seed: int = 0) -> dict:
    key = jax.random.key(seed)
    ks = jax.random.split(key, 23)
    rows = min(ATT_WINDOW, PAST_LEN)

    def nrm(k, shape, scale):
        return jax.random.normal(k, shape, jnp.float32) * scale

    return {
        'x_prompt': nrm(ks[0], (BATCH, SEQ, D_MODEL), 1.0),
        'x_sample': nrm(ks[1], (DEC_BATCH, DEC_SEQ, D_MODEL), 1.0),
        'p_prompt': nrm(ks[2], (DEPTH, BATCH, SEQ, PLE_DIM), 1.0),
        'p_sample': nrm(ks[3], (DEPTH, DEC_BATCH, DEC_SEQ, PLE_DIM), 1.0),
        'cache_k': nrm(ks[4], (DEPTH, DEC_BATCH, rows, N_HEADS, HEAD_DIM), 1.0),
        'cache_v': nrm(ks[5], (DEPTH, DEC_BATCH, rows, N_HEADS, HEAD_DIM), 0.5),
        'state_conv': nrm(ks[6], (DEPTH, DEC_BATCH, CONV_HIST, CONV_W), 0.5),
        'g_mix': 1.0 + nrm(ks[7], (DEPTH, D_MODEL), 0.02),
        'w_in': nrm(ks[8], (DEPTH, D_MODEL, IN_COLS), D_MODEL ** -0.5),
        'q_gain': 1.0 + nrm(ks[9], (DEPTH, HEAD_DIM), 0.02),
        'k_gain': 1.0 + nrm(ks[10], (DEPTH, HEAD_DIM), 0.02),
        'rel_bias': nrm(ks[11], (DEPTH, N_HEADS, N_REL), 0.1),
        'conv_w': nrm(ks[12], (DEPTH, CONV_WIDTH, CONV_W), CONV_WIDTH ** -0.5),
        'conv_b': nrm(ks[13], (DEPTH, CONV_W), 0.01),
        'conv_ln_g': 1.0 + nrm(ks[14], (DEPTH, CONV_W), 0.02),
        'conv_ln_b': nrm(ks[15], (DEPTH, CONV_W), 0.01),
        'w_out': nrm(ks[16], (DEPTH, MIX_W, D_MODEL), MIX_W ** -0.5),
        'g_ffn': 1.0 + nrm(ks[17], (DEPTH, D_MODEL), 0.02),
        'w_gate_up': nrm(ks[18], (DEPTH, D_MODEL, 2 * D_FF), D_MODEL ** -0.5),
        'w_down': nrm(ks[19], (DEPTH, D_FF, D_MODEL), D_FF ** -0.5),
        'g_ple': 1.0 + nrm(ks[20], (DEPTH, D_MODEL), 0.02),
        'w_ple_gate': nrm(ks[21], (DEPTH, D_MODEL, D_MODEL), D_MODEL ** -0.5),
        'w_ple_proj': nrm(ks[22], (DEPTH, PLE_DIM, D_MODEL), PLE_DIM ** -0.5),
    }


def reference(x_prompt, x_sample, p_prompt, p_sample, cache_k, cache_v, state_conv,
              g_mix, w_in, q_gain, k_gain, rel_bias, conv_w, conv_b, conv_ln_g, conv_ln_b,
              w_out, g_ffn, w_gate_up, w_down, g_ple, w_ple_gate, w_ple_proj):
    hp, hs = x_prompt, x_sample
    n_p, s_p = x_prompt.shape[0], x_prompt.shape[1]
    n_s, l_s = x_sample.shape[0], x_sample.shape[1]
    keep_p = min(ATT_WINDOW, s_p)
    rows_s = cache_k.shape[2]
    kp_l, vp_l, cp_l, ks_l, vs_l, cs_l = [], [], [], [], [], []
    for i in range(DEPTH):
        q, k, v, glu = project_mix_inputs(hp, g_mix[i], w_in[i], q_gain[i], k_gain[i])
        att = prompt_attention(q, k, v, rel_bias[i])
        hist0 = jnp.zeros((n_p, CONV_HIST, CONV_W), glu.dtype)
        cv = conv_module_tail(glu, hist0, conv_w[i], conv_b[i], conv_ln_g[i], conv_ln_b[i])
        hp_next = finish_layer(hp, att, cv, p_prompt[i], w_out[i], g_ffn[i], w_gate_up[i],
                               w_down[i], g_ple[i], w_ple_gate[i], w_ple_proj[i])
        kp_l.append(k[:, s_p - keep_p:])
        vp_l.append(v[:, s_p - keep_p:])
        cp_l.append(glu[:, s_p - CONV_HIST:])
        hp = hp_next

        q, k, v, glu = project_mix_inputs(hs, g_mix[i], w_in[i], q_gain[i], k_gain[i])
        k_all = jnp.concatenate([cache_k[i], k], axis=1)
        v_all = jnp.concatenate([cache_v[i], v], axis=1)
        q_pos = PAST_LEN + jnp.arange(l_s)
        k_pos = PAST_LEN - rows_s + jnp.arange(rows_s + l_s)
        att = band_attend(q, k_all, v_all, q_pos, k_pos, rel_bias[i]).reshape(n_s, l_s, ATT_W)
        cv = conv_module_tail(glu, state_conv[i], conv_w[i], conv_b[i], conv_ln_g[i], conv_ln_b[i])
        hs_next = finish_layer(hs, att, cv, p_sample[i], w_out[i], g_ffn[i], w_gate_up[i],
                               w_down[i], g_ple[i], w_ple_gate[i], w_ple_proj[i])
        ks_l.append(k_all[:, l_s:])
        vs_l.append(v_all[:, l_s:])
        conv_all = jnp.concatenate([state_conv[i], glu], axis=1)
        cs_l.append(conv_all[:, l_s:])
        hs = hs_next

    new_k_prompt = jnp.stack(kp_l)
    new_v_prompt = jnp.stack(vp_l)
    new_conv_prompt = jnp.stack(cp_l)
    new_k_sample = jnp.stack(ks_l)
    new_v_sample = jnp.stack(vs_l)
    new_conv_sample = jnp.stack(cs_l)
    return (hp, hs, new_k_prompt, new_v_prompt, new_conv_prompt, new_k_sample, new_v_sample, new_conv_sample)
```

```cpp
#include <hip/hip_runtime.h>
#include <cstdint>
#include <cstdio>

constexpr int D = 1024, SEQ = 8192, NB = 4, DB = 32, DS = 32;
constexpr int RP = NB * SEQ, RS = DB * DS, R = RP + RS;
constexpr int INC = 2560, DFF = 2816, PLE = 256, NH = 8, HD = 64, CW = 512;
constexpr int NREL = 257, CONVW = 31, CH = 30, PAST = 2048, CROWS = 512;
constexpr float EPS = 1e-6f;
constexpr size_t OY = 0, OKP = (size_t)R * D, OVP = OKP + (size_t)NB * 512 * 512, OCP = OVP + (size_t)NB * 512 * 512,
                 OKS = OCP + (size_t)NB * CH * CW, OVS = OKS + (size_t)DB * 512 * 512, OCS = OVS + (size_t)DB * 512 * 512;

struct RowSrc { const float* p; const float* s; int ld; int pad;
    __device__ __forceinline__ const float* row(int r) const { return r < RP ? p + (size_t)r * ld : s + (size_t)(r - RP) * ld; } };

__device__ __forceinline__ float wave_sum(float v) {
#pragma unroll
    for (int o = 1; o < 64; o <<= 1) v += __shfl_xor(v, o);
    return v;
}

__global__ void __launch_bounds__(256) rowscale_k(RowSrc src, float* rs) {
    const int r = blockIdx.x * 4 + (threadIdx.x >> 6), lane = threadIdx.x & 63;
    const float* x = src.row(r); float s = 0.f;
    for (int i = lane; i < D; i += 64) { const float v = x[i]; s += v * v; }
    s = wave_sum(s);
    if (lane == 0) rs[r] = rsqrtf(s / D + EPS);
}

struct AScaled { RowSrc src; const float* rs; const float* g;
    __device__ __forceinline__ float operator()(int r, int k) const { return src.row(r)[k] * rs[r] * g[k]; } };
struct APlain { const float* A; int lda; int pad;
    __device__ __forceinline__ float operator()(int r, int k) const { return A[(size_t)r * lda + k]; } };
struct ARows { RowSrc src;
    __device__ __forceinline__ float operator()(int r, int k) const { return src.row(r)[k]; } };
struct BPlain { const float* B; int ldb; int pad;
    __device__ __forceinline__ float operator()(int k, int n) const { return B[(size_t)k * ldb + n]; } };
struct BPair { const float* B; int ldb; int half;
    __device__ __forceinline__ float operator()(int k, int n) const { return B[(size_t)k * ldb + (n & 1) * half + (n >> 1)]; } };
struct EStore { float* C; int ldc; int pad;
    __device__ __forceinline__ void operator()(int r, int c, const float* v) const { for (int j = 0; j < 4; ++j) C[(size_t)r * ldc + c + j] = v[j]; } };
struct EResX { RowSrc x; float* out;
    __device__ __forceinline__ void operator()(int r, int c, const float* v) const { const float* xr = x.row(r); for (int j = 0; j < 4; ++j) out[(size_t)r * D + c + j] = xr[c + j] + v[j]; } };
struct EResIn { float* out;
    __device__ __forceinline__ void operator()(int r, int c, const float* v) const { for (int j = 0; j < 4; ++j) out[(size_t)r * D + c + j] += v[j]; } };
struct EAct { float* act;
    __device__ __forceinline__ void operator()(int r, int c, const float* v) const {
        for (int j = 0; j < 2; ++j) { const float g = v[2 * j], u = v[2 * j + 1]; act[(size_t)r * DFF + (c >> 1) + j] = g / (1.f + __expf(-g)) * u; } } };
struct EFinal { float* out; const float* pp;
    __device__ __forceinline__ void operator()(int r, int c, const float* v) const {
        for (int j = 0; j < 4; ++j) { const size_t o = (size_t)r * D + c + j; out[o] = out[o] + pp[o] / (1.f + __expf(-v[j])); } } };

template <class AF, class BF, class EF>
__global__ void __launch_bounds__(256) gemm_k(long long K_, AF af, BF bf, EF ef) {
    __shared__ float sA[16][68], sB[16][68]; const int K = (int)K_;
    const int tid = threadIdx.x, tx = tid & 15, ty = tid >> 4, row0 = blockIdx.y * 64, col0 = blockIdx.x * 64;
    float acc[4][4];
#pragma unroll
    for (int i = 0; i < 4; ++i)
#pragma unroll
        for (int j = 0; j < 4; ++j) acc[i][j] = 0.f;
    for (int k0 = 0; k0 < K; k0 += 16) {
#pragma unroll
        for (int i = 0; i < 4; ++i) { const int e = tid + i * 256; sA[e & 15][e >> 4] = af(row0 + (e >> 4), k0 + (e & 15)); }
#pragma unroll
        for (int i = 0; i < 4; ++i) { const int e = tid + i * 256; sB[e >> 6][e & 63] = bf(k0 + (e >> 6), col0 + (e & 63)); }
        __syncthreads();
#pragma unroll
        for (int k = 0; k < 16; ++k) {
            float a[4], b[4];
#pragma unroll
            for (int i = 0; i < 4; ++i) { a[i] = sA[k][ty * 4 + i]; b[i] = sB[k][tx * 4 + i]; }
#pragma unroll
            for (int i = 0; i < 4; ++i)
#pragma unroll
                for (int j = 0; j < 4; ++j) acc[i][j] += a[i] * b[j];
        }
        __syncthreads();
    }
#pragma unroll
    for (int i = 0; i < 4; ++i) ef(row0 + ty * 4 + i, col0 + tx * 4, acc[i]);
}

__global__ void __launch_bounds__(512) post_k(float* Z, const float* qg, const float* kg, float* out) {
    const int r = blockIdx.x, t = threadIdx.x, d = t & 63;
    float* z = Z + (size_t)r * INC;
    const float zq = z[t], zk = z[512 + t], zv = z[1024 + t], za = z[1536 + t], zb = z[2048 + t];
    const float q = zq * rsqrtf(wave_sum(zq * zq) / HD + EPS) * qg[d];
    const float k = zk * rsqrtf(wave_sum(zk * zk) / HD + EPS) * kg[d];
    const float glu = za / (1.f + __expf(-zb));
    z[t] = q; z[512 + t] = k; z[1536 + t] = glu;
    if (r < RP) {
        const int b = r / SEQ, tt = r % SEQ;
        if (tt >= SEQ - 512) { const size_t o = ((size_t)b * 512 + (tt - (SEQ - 512))) * 512 + t; out[OKP + o] = k; out[OVP + o] = zv; }
        if (tt >= SEQ - CH) out[OCP + ((size_t)b * CH + (tt - (SEQ - CH))) * CW + t] = glu;
    } else {
        const int b = (r - RP) / DS, i = (r - RP) % DS;
        const size_t o = ((size_t)b * 512 + (512 - DS) + i) * 512 + t; out[OKS + o] = k; out[OVS + o] = zv;
        if (i >= DS - CH) out[OCS + ((size_t)b * CH + (i - (DS - CH))) * CW + t] = glu;
    }
}
__global__ void cache_copy_k(const float* ck, const float* cv, float* out) {
    const size_t i = (size_t)blockIdx.x * 256 + threadIdx.x;
    const size_t b = i / (480 * 512), rem = i % (480 * 512);
    out[OKS + b * 512 * 512 + rem] = ck[b * 512 * 512 + DS * 512 + rem];
    out[OVS + b * 512 * 512 + rem] = cv[b * 512 * 512 + DS * 512 + rem];
}

__global__ void __launch_bounds__(64) attn_k(const float* Z, const float* ck, const float* cv, const float* relb, float* mix) {
    __shared__ float sK[32][64], sV[32][64];
    const int u = blockIdx.x, h = blockIdx.y, i = threadIdx.x;
    int nq, qrow0, qpos0, kpos0, nk; const bool samp = u >= NB * 128; int b, c = 0;
    if (!samp) { b = u / 128; c = u % 128; nq = 64; qrow0 = b * SEQ + 64 * c; qpos0 = 64 * c; kpos0 = 64 * c - 512; nk = 576; }
    else { b = u - NB * 128; nq = 32; qrow0 = RP + b * DS; qpos0 = PAST; kpos0 = PAST - CROWS; nk = CROWS + DS; }
    float q[64], o[64];
    const bool act = i < nq;
    { const float* qp = Z + (size_t)(qrow0 + (act ? i : 0)) * INC + h * 64;
#pragma unroll
      for (int d = 0; d < 64; ++d) { q[d] = qp[d]; o[d] = 0.f; } }
    float m = -1e30f, l = 0.f;
    const float* rb = relb + h * NREL;
    for (int j0 = 0; j0 < nk; j0 += 32) {
        if (kpos0 + j0 + 31 < 0) continue;
        __syncthreads();
        for (int e = i; e < 32 * 64; e += 64) {
            const int jj = e >> 6, d = e & 63, j = j0 + jj; const float *kp, *vp;
            if (!samp) { const size_t rr = (size_t)(b * SEQ + kpos0 + j) * INC + h * 64 + d; kp = Z + rr + 512; vp = Z + rr + 1024; }
            else if (j < CROWS) { const size_t rr = ((size_t)b * CROWS + j) * 512 + h * 64 + d; kp = ck + rr; vp = cv + rr; }
            else { const size_t rr = (size_t)(RP + b * DS + (j - CROWS)) * INC + h * 64 + d; kp = Z + rr + 512; vp = Z + rr + 1024; }
            sK[jj][d] = *kp; sV[jj][d] = *vp;
        }
        __syncthreads();
        if (act) for (int jj = 0; jj < 32; ++jj) {
            float s = 0.f;
#pragma unroll
            for (int d = 0; d < 64; ++d) s += q[d] * sK[jj][d];
            int dist = (qpos0 + i) - (kpos0 + j0 + jj); dist = dist < -128 ? -128 : (dist > 128 ? 128 : dist);
            s = s * 0.125f + rb[dist + 128];
            const float mn = fmaxf(m, s), sc = __expf(m - mn), p = __expf(s - mn);
            l = l * sc + p; m = mn;
#pragma unroll
            for (int d = 0; d < 64; ++d) o[d] = o[d] * sc + p * sV[jj][d];
        }
    }
    if (act) { float* op = mix + (size_t)(qrow0 + i) * D + h * 64; const float il = 1.f / l;
#pragma unroll
        for (int d = 0; d < 64; ++d) op[d] = o[d] * il; }
}

__global__ void __launch_bounds__(512) conv_k(const float* Z, const float* st, const float* cw, const float* cb, const float* lg, const float* lb, float* mix) {
    __shared__ float red[16];
    const int r = blockIdx.x, ch = threadIdx.x;
    int b, t, base; const bool samp = r >= RP;
    if (!samp) { b = r / SEQ; t = r % SEQ; base = b * SEQ; } else { b = (r - RP) / DS; t = (r - RP) % DS; base = RP + b * DS; }
    float y = cb[ch];
    for (int j = 0; j < CONVW; ++j) { const int tp = t - CH + j; float v;
        if (tp >= 0) v = Z[(size_t)(base + tp) * INC + 1536 + ch]; else v = samp ? st[((size_t)b * CH + (CH + tp)) * CW + ch] : 0.f;
        y += cw[j * CW + ch] * v; }
    float s = wave_sum(y); if ((ch & 63) == 0) red[ch >> 6] = s; __syncthreads();
    float mean = 0.f; for (int w = 0; w < 8; ++w) mean += red[w]; mean /= CW;
    const float dlt = y - mean; float s2 = wave_sum(dlt * dlt); if ((ch & 63) == 0) red[8 + (ch >> 6)] = s2; __syncthreads();
    float var = 0.f; for (int w = 0; w < 8; ++w) var += red[8 + w]; var /= CW;
    const float ln = dlt * rsqrtf(var + EPS) * lg[ch] + lb[ch];
    mix[(size_t)r * D + 512 + ch] = ln / (1.f + __expf(-ln));
}

extern "C" void kernel_launch(void* const* d_in, const int* in_sizes, int n_in, void* d_out, int out_size, void* d_ws, size_t ws_size, hipStream_t stream) {
    const float* const* in = (const float* const*)d_in;
    float* out = (float*)d_out; float* ws = (float*)d_ws;
    const RowSrc X{in[0], in[1], D}, P{in[2], in[3], PLE};
    float* Z = ws; float* MIX = Z + (size_t)R * INC; float* RSC = MIX + (size_t)R * D;
    float* ACT = ws; float* PP = ACT + (size_t)R * DFF; float* RSC2 = PP + (size_t)R * D;
    if (ws_size < ((size_t)R * INC + (size_t)R * D + R) * 4 || ws_size < ((size_t)R * DFF + (size_t)R * D + R) * 4) { fprintf(stderr, "ws too small\n"); return; }
    float* Y = out + OY;
    rowscale_k<<<R / 4, 256, 0, stream>>>(X, RSC);
    gemm_k<<<dim3(INC / 64, R / 64), 256, 0, stream>>>(D, AScaled{X, RSC, in[7]}, BPlain{in[8], INC}, EStore{Z, INC});
    post_k<<<R, 512, 0, stream>>>(Z, in[9], in[10], out);
    cache_copy_k<<<DB * 480 * 512 / 256, 256, 0, stream>>>(in[4], in[5], out);
    attn_k<<<dim3(NB * 128 + DB, NH), 64, 0, stream>>>(Z, in[4], in[5], in[11], MIX);
    conv_k<<<R, 512, 0, stream>>>(Z, in[6], in[12], in[13], in[14], in[15], MIX);
    gemm_k<<<dim3(D / 64, R / 64), 256, 0, stream>>>(D, APlain{MIX, D}, BPlain{in[16], D}, EResX{X, Y});
    rowscale_k<<<R / 4, 256, 0, stream>>>(RowSrc{Y, Y + (size_t)RP * D, D}, RSC);
    gemm_k<<<dim3(2 * DFF / 64, R / 64), 256, 0, stream>>>(D, AScaled{RowSrc{Y, Y + (size_t)RP * D, D}, RSC, in[17]}, BPair{in[18], 2 * DFF, DFF}, EAct{ACT});
    gemm_k<<<dim3(D / 64, R / 64), 256, 0, stream>>>(DFF, APlain{ACT, DFF}, BPlain{in[19], D}, EResIn{Y});
    rowscale_k<<<R / 4, 256, 0, stream>>>(RowSrc{Y, Y + (size_t)RP * D, D}, RSC2);
    gemm_k<<<dim3(D / 64, R / 64), 256, 0, stream>>>(PLE, ARows{P}, BPlain{in[22], D}, EStore{PP, D});
    float* H2C = ws;
    (void)hipMemcpyAsync(H2C, Y, (size_t)R * D * 4, hipMemcpyDeviceToDevice, stream);
    gemm_k<<<dim3(D / 64, R / 64), 256, 0, stream>>>(D, AScaled{RowSrc{H2C, H2C + (size_t)RP * D, D}, RSC2, in[20]}, BPlain{in[21], D}, EFinal{Y, PP});
}
```

```cpp
#include <hip/hip_runtime.h>
#include <cstdio>
#include <cstdint>
constexpr int D = 1024, SEQ = 8192, NB = 4, DB = 32, DS = 32;
constexpr int RP = NB * SEQ, RS = DB * DS, R = RP + RS;
constexpr int INC = 2560, DFF = 2816, PLE = 256, NH = 8, HD = 64, CW = 512;
constexpr int NREL = 257, CONVW = 31, CH = 30, KSROWS = 576;
constexpr float EPS = 1e-6f, LOG2E = 1.4426950408889634f, QSCALE = 0.125f * LOG2E;
constexpr size_t OY = 0, OKP = (size_t)R * D, OVP = OKP + (size_t)NB * 512 * 512, OCP = OVP + (size_t)NB * 512 * 512,
                 OKS = OCP + (size_t)NB * CH * CW, OVS = OKS + (size_t)DB * 512 * 512, OCS = OVS + (size_t)DB * 512 * 512;
namespace pg8 {
#define PG8_LAS __attribute__((address_space(3)))
typedef unsigned short bf16_t;
typedef short bf16x8 __attribute__((ext_vector_type(8)));
typedef float f32x4 __attribute__((ext_vector_type(4)));
typedef unsigned u32x4 __attribute__((ext_vector_type(4)));
constexpr int BM = 256, BK = 64, HALF = 128, HTB = HALF * BK * 2  , STAGE_BYTES = 8 * HTB, NXCD = 8, WGM = 8;

__host__ __device__ __forceinline__ int lds_byte(int r, int c) { const int st = (r >> 4) * 2 + (c >> 5), rr = r & 15, cc = c & 31, ob = rr * 64 + cc * 2; return st * 1024 + (ob ^ (((ob >> 9) & 1) << 5)); }
__host__ __device__ __forceinline__ void stage_rc(int b, int& R, int& C) { const int st = b / 1024, sb = b % 1024, swz = sb ^ (((sb >> 9) & 1) << 5); R = (st >> 1) * 16 + swz / 64; C = (st & 1) * 32 + (swz % 64) / 2; }
__host__ __device__ __forceinline__ int perm32(int rho) { const int n = rho >> 4, i = rho & 15; return 8 * (i >> 2) + 4 * n + (i & 3); }

struct Unit { int pm, pn; };
struct Gemm { const bf16_t* A; const bf16_t* Bt; int M, N, K; };

struct StaticOrder {
    int nM, nN, nwg, G, c;
    __host__ __device__ void init(int M, int N, int G_, int c_) { nM = M / BM; nN = N / BM; nwg = nM * nN; G = G_; c = c_; }
    __host__ __device__ bool next(int i, Unit& u) const {
        const long L = (long)i * G + c; if (L >= nwg) return false;
        int wgid = (int)L; { const int q = nwg / NXCD, r = nwg % NXCD, xcd = wgid % NXCD, off = wgid / NXCD; wgid = (xcd < r ? xcd * (q + 1) : r * (q + 1) + (xcd - r) * q) + off; }
        const int nig = WGM * nN, gid = wgid / nig, fm = gid * WGM, gsz = (nM - fm) < WGM ? (nM - fm) : WGM;
        u.pm = fm + ((wgid % nig) % gsz); u.pn = (wgid % nig) / gsz; return true;
    }
    __device__ __forceinline__ void a_ready(const Unit&) const {}
    __device__ __forceinline__ void done(const Unit&) const {}
};

__device__ __forceinline__ unsigned cvt_pk_bf16(float lo, float hi) { unsigned r; asm volatile("v_cvt_pk_bf16_f32 %0, %1, %2" : "=v"(r) : "v"(lo), "v"(hi)); return r; }
typedef float f32x2 __attribute__((ext_vector_type(2)));typedef unsigned u32x2 __attribute__((ext_vector_type(2)));
__device__ __forceinline__ u32x4 pack8(const f32x4 a, const f32x4 b) { u32x4 w; w.x = cvt_pk_bf16(a[0], a[1]); w.y = cvt_pk_bf16(a[2], a[3]); w.z = cvt_pk_bf16(b[0], b[1]); w.w = cvt_pk_bf16(b[2], b[3]); return w; }
__device__ __forceinline__ float sigm(float x) { return __builtin_amdgcn_rcpf(1.0f + __builtin_amdgcn_exp2f(-x * LOG2E)); }
__device__ __forceinline__ float quad_sum(float s) { s += __shfl_xor(s, 16); s += __shfl_xor(s, 32); return s; }
struct Epi1 {
    static constexpr bool PERM = true, AFTER_DRAIN = false;
    const float* rx; const float* qg; const float* kg; bf16_t *Q, *Kp, *Ks, *GLU; float* out; size_t vp_off, vs_off;
    __device__ __forceinline__ void operator()(const f32x4 (&acc)[2][2][4][2], const Unit& u, int wr, int wc, int fr, int fq) const {
        const int pn = u.pn, rowt = u.pm * BM + wr * 64 + fr;
        if (pn < 6) {
            const int sec = pn >> 1, col = (4 * (pn & 1) + wc) * 64 + 8 * fq;
            f32x4 g[2][2];
#pragma unroll
            for (int bj = 0; bj < 2; ++bj)
#pragma unroll
                for (int n = 0; n < 2; ++n) { g[bj][n] = (f32x4){1.f, 1.f, 1.f, 1.f};
                    if (sec == 0) g[bj][n] = *(const f32x4*)(qg + 32 * bj + 8 * fq + 4 * n) * QSCALE;
                    if (sec == 1) g[bj][n] = *(const f32x4*)(kg + 32 * bj + 8 * fq + 4 * n); }
#pragma unroll
            for (int ai = 0; ai < 2; ++ai)
#pragma unroll
                for (int m = 0; m < 4; ++m) {
                    const int row = rowt + ai * HALF + m * 16; const float r = rx[row];
                    f32x4 z[2][2];
#pragma unroll
                    for (int bj = 0; bj < 2; ++bj)
#pragma unroll
                        for (int n = 0; n < 2; ++n) z[bj][n] = acc[ai][bj][m][n] * r;
                    if (sec < 2) {
                        float ss = 0.f;
#pragma unroll
                        for (int bj = 0; bj < 2; ++bj)
#pragma unroll
                            for (int n = 0; n < 2; ++n) { const f32x4 q = z[bj][n] * z[bj][n]; ss += (q[0] + q[1]) + (q[2] + q[3]); }
                        ss = quad_sum(ss);
                        const float rn = rsqrtf(ss * (1.0f / 64.0f) + EPS);
#pragma unroll
                        for (int bj = 0; bj < 2; ++bj)
#pragma unroll
                            for (int n = 0; n < 2; ++n) z[bj][n] = z[bj][n] * rn * g[bj][n];
                    }
                    const int sb = (row - RP) >> 5, si = (row - RP) & 31;
                    bf16_t* dst; float* fo = nullptr;
                    if (sec == 0) dst = Q + (size_t)row * 512 + col;
                    else if (row < RP) { dst = Kp + (size_t)(sec - 1) * vp_off + (size_t)row * 512 + col;
                        const int t = row & (SEQ - 1); if (t >= SEQ - 512) fo = out + OKP + (size_t)(sec - 1) * (OVP - OKP) + ((size_t)((row >> 13) * 512 + (t - (SEQ - 512)))) * 512 + col; }
                    else { dst = Ks + (size_t)(sec - 1) * vs_off + ((size_t)(sb * KSROWS + 512 + si)) * 512 + col; fo = out + OKS + (size_t)(sec - 1) * (OVS - OKS) + ((size_t)(sb * 512 + 480 + si)) * 512 + col; }
#pragma unroll
                    for (int bj = 0; bj < 2; ++bj) *(u32x4*)(dst + 32 * bj) = pack8(z[bj][0], z[bj][1]);
                    if (fo) {
#pragma unroll
                        for (int bj = 0; bj < 2; ++bj)
#pragma unroll
                            for (int n = 0; n < 2; ++n) *(f32x4*)(fo + 32 * bj + 4 * n) = z[bj][n]; }
                    asm volatile("" ::: "memory");
                }
        } else {
            const int col = 128 * (pn - 6) + 32 * wc + 8 * fq;
#pragma unroll
            for (int ai = 0; ai < 2; ++ai)
#pragma unroll
                for (int m = 0; m < 4; ++m) {
                    const int row = rowt + ai * HALF + m * 16; const float r = rx[row];
                    f32x4 gl[2];
#pragma unroll
                    for (int n = 0; n < 2; ++n) { const f32x4 a = acc[ai][0][m][n] * r, b = acc[ai][1][m][n] * r;
#pragma unroll
                        for (int e = 0; e < 4; ++e) gl[n][e] = a[e] * sigm(b[e]); }
                    *(u32x4*)(GLU + (size_t)row * 512 + col) = pack8(gl[0], gl[1]);
                    float* fo = nullptr;
                    if (row < RP) { const int t = row & (SEQ - 1); if (t >= SEQ - CH) fo = out + OCP + ((size_t)((row >> 13) * CH + (t - (SEQ - CH)))) * CW + col; }
                    else { const int sb = (row - RP) >> 5, si = (row - RP) & 31; if (si >= DS - CH) fo = out + OCS + ((size_t)(sb * CH + (si - (DS - CH)))) * CW + col; }
                    if (fo) { *(f32x4*)(fo) = gl[0]; *(f32x4*)(fo + 4) = gl[1]; }
                    asm volatile("" ::: "memory");
                }
        }
    }
};
struct EpiPP {
    static constexpr bool PERM = true, AFTER_DRAIN = false;
    bf16_t* O;
    __device__ __forceinline__ void operator()(const f32x4 (&acc)[2][2][4][2], const Unit& u, int wr, int wc, int fr, int fq) const {
        const int rowt = u.pm * BM + wr * 64 + fr, col = u.pn * BM + 32 * wc + 8 * fq;
#pragma unroll
        for (int ai = 0; ai < 2; ++ai)
#pragma unroll
            for (int m = 0; m < 4; ++m) { bf16_t* rowp = O + (size_t)(rowt + ai * HALF + m * 16) * D + col;
#pragma unroll
                for (int bj = 0; bj < 2; ++bj) *(u32x4*)(rowp + bj * HALF) = pack8(acc[ai][bj][m][0], acc[ai][bj][m][1]); }
    }
};
struct EpiRes {
    static constexpr bool PERM = true, AFTER_DRAIN = false;
    const float* bp; const float* bs; float* Y; bf16_t* HB; float* SS;
    __device__ __forceinline__ void operator()(const f32x4 (&acc)[2][2][4][2], const Unit& u, int wr, int wc, int fr, int fq) const {
        const int rowt = u.pm * BM + wr * 64 + fr, col = u.pn * BM + 32 * wc + 8 * fq;
#pragma unroll
        for (int ai = 0; ai < 2; ++ai)
#pragma unroll
            for (int m = 0; m < 4; ++m) {
                const int row = rowt + ai * HALF + m * 16;
                const float* brow = (row < RP ? bp + (size_t)row * D : bs + (size_t)(row - RP) * D) + col;
                float ss = 0.f;
#pragma unroll
                for (int bj = 0; bj < 2; ++bj) {
                    const f32x4 v0 = *(const f32x4*)(brow + bj * HALF) + acc[ai][bj][m][0], v1 = *(const f32x4*)(brow + bj * HALF + 4) + acc[ai][bj][m][1];
                    float* yp = Y + (size_t)row * D + col + bj * HALF; *(f32x4*)yp = v0; *(f32x4*)(yp + 4) = v1;
                    *(u32x4*)(HB + (size_t)row * D + col + bj * HALF) = pack8(v0, v1);
                    const f32x4 q0 = v0 * v0, q1 = v1 * v1; ss += ((q0[0] + q0[1]) + (q0[2] + q0[3])) + ((q1[0] + q1[1]) + (q1[2] + q1[3]));
                }
                ss = quad_sum(ss);
                if (fq == 0) SS[(size_t)row * 16 + 4 * u.pn + wc] = ss;
            }
    }
};
__device__ __forceinline__ float row_rs(const float* SS, int row, int fq) {
    const f32x4 s4 = *(const f32x4*)(SS + (size_t)row * 16 + 4 * fq);
    return rsqrtf(quad_sum((s4[0] + s4[1]) + (s4[2] + s4[3])) * (1.0f / D) + EPS);
}
struct EpiAct {
    static constexpr bool PERM = true, AFTER_DRAIN = false;
    const float* SS; bf16_t* ACT;
    __device__ __forceinline__ void operator()(const f32x4 (&acc)[2][2][4][2], const Unit& u, int wr, int wc, int fr, int fq) const {
        const int rowt = u.pm * BM + wr * 64 + fr, col = 128 * u.pn + 32 * wc + 8 * fq;
#pragma unroll
        for (int ai = 0; ai < 2; ++ai)
#pragma unroll
            for (int m = 0; m < 4; ++m) {
                const int row = rowt + ai * HALF + m * 16; const float r = row_rs(SS, row, fq);
                f32x4 v[2];
#pragma unroll
                for (int n = 0; n < 2; ++n) { const f32x4 g = acc[ai][0][m][n] * r, up = acc[ai][1][m][n] * r;
#pragma unroll
                    for (int e = 0; e < 4; ++e) v[n][e] = g[e] * sigm(g[e]) * up[e]; }
                *(u32x4*)(ACT + (size_t)row * DFF + col) = pack8(v[0], v[1]);
            }
    }
};
struct EpiFinal {
    static constexpr bool PERM = true, AFTER_DRAIN = false;
    const float* SS; const bf16_t* PP; float* Y;
    __device__ __forceinline__ void operator()(const f32x4 (&acc)[2][2][4][2], const Unit& u, int wr, int wc, int fr, int fq) const {
        const int rowt = u.pm * BM + wr * 64 + fr, col = u.pn * BM + 32 * wc + 8 * fq;
#pragma unroll
        for (int ai = 0; ai < 2; ++ai)
#pragma unroll
            for (int m = 0; m < 4; ++m) {
                const int row = rowt + ai * HALF + m * 16; const float r = row_rs(SS, row, fq);
#pragma unroll
                for (int bj = 0; bj < 2; ++bj) {
                    float* yp = Y + (size_t)row * D + col + bj * HALF;
                    const u32x4 pw = *(const u32x4*)(PP + (size_t)row * D + col + bj * HALF);
                    f32x4 h0 = *(const f32x4*)yp, h1 = *(const f32x4*)(yp + 4);
                    const f32x4 a0 = acc[ai][bj][m][0] * r, a1 = acc[ai][bj][m][1] * r;
                    h0[0] += sigm(a0[0]) * __uint_as_float(pw.x << 16); h0[1] += sigm(a0[1]) * __uint_as_float(pw.x & 0xffff0000u);
                    h0[2] += sigm(a0[2]) * __uint_as_float(pw.y << 16); h0[3] += sigm(a0[3]) * __uint_as_float(pw.y & 0xffff0000u);
                    h1[0] += sigm(a1[0]) * __uint_as_float(pw.z << 16); h1[1] += sigm(a1[1]) * __uint_as_float(pw.z & 0xffff0000u);
                    h1[2] += sigm(a1[2]) * __uint_as_float(pw.w << 16); h1[3] += sigm(a1[3]) * __uint_as_float(pw.w & 0xffff0000u);
                    *(f32x4*)yp = h0; *(f32x4*)(yp + 4) = h1;
                }
            }
    }
};

template <class Epi, class Sched, bool ALIGN_EPI = false, bool SP2 = false>
__device__ __forceinline__ void gemm_phase(PG8_LAS unsigned char* lds, const Gemm g, const Sched& S, const Epi& E) {
    int tid_ = threadIdx.x; asm volatile("" : "+v"(tid_));
    const int tid = tid_, wid = __builtin_amdgcn_readfirstlane(tid >> 6), lane = tid & 63, wr = wid >> 2, wc = wid & 3, fr = lane & 15, fq = lane >> 4;
    int K_ = g.K; asm volatile("" : "+s"(K_));
    const int K = K_, nt = K / BK;
    unsigned voffA[2], voffB[2];
#pragma unroll
    for (int i = 0; i < 2; ++i) { int R, C; stage_rc(tid * 16 + i * 8192, R, C); const int Rb = Epi::PERM ? ((R & ~31) + perm32(R & 31)) : R;
        voffA[i] = (unsigned)(R * K + C) * 2u; voffB[i] = (unsigned)(Rb * K + C) * 2u; }
    const size_t kstep = (size_t)(BK * 2);
    const size_t hstep = (size_t)HALF * K * 2;
    const size_t tstep = 2 * hstep;
    const unsigned ldsw = (unsigned)wid * 1024u;
    const int aoff = lds_byte(wr * 64 + fr, fq * 8), boff = lds_byte(wc * 32 + fr, fq * 8);
#define PG8_SA(b, h) (((b) * 2 + (h)) * HTB)
#define PG8_SB(b, h) ((4 + (b) * 2 + (h)) * HTB)
#define PG8_STAGE(bufoff, gbase, voff) do { _Pragma("unroll") for (int _i = 0; _i < 2; ++_i) \
        __builtin_amdgcn_global_load_lds((const unsigned*)((const char*)(gbase) + (voff)[_i]), (PG8_LAS unsigned*)(lds + (bufoff) + ldsw + _i * 8192), 16, 0, 0); } while (0)
#define PG8_LDA(dst, b, h) do { _Pragma("unroll") for (int m = 0; m < 4; ++m) _Pragma("unroll") for (int k = 0; k < 2; ++k) dst[m][k] = *(const PG8_LAS bf16x8*)(lds + PG8_SA(b, h) + aoff + m * 2048 + k * 1024); } while (0)
#define PG8_LDB(dst, b, h) do { _Pragma("unroll") for (int n = 0; n < 2; ++n) _Pragma("unroll") for (int k = 0; k < 2; ++k) dst[n][k] = *(const PG8_LAS bf16x8*)(lds + PG8_SB(b, h) + boff + n * 2048 + k * 1024); } while (0)
#define PG8_MMA(ai, bj, At, Bt) do { __builtin_amdgcn_s_setprio(1); _Pragma("unroll") for (int m = 0; m < 4; ++m) _Pragma("unroll") for (int n = 0; n < 2; ++n) _Pragma("unroll") for (int k = 0; k < 2; ++k) \
        acc[ai][bj][m][n] = __builtin_amdgcn_mfma_f32_16x16x32_bf16(Bt[n][k], At[m][k], acc[ai][bj][m][n], 0, 0, 0); __builtin_amdgcn_s_setprio(0); } while (0)
#define PG8_WAIT_V(n) asm volatile("s_waitcnt vmcnt(" #n ")" ::: "memory")
#define PG8_WAIT_L(n) asm volatile("s_waitcnt lgkmcnt(" #n ")" ::: "memory")
#define PG8_BAR __builtin_amdgcn_s_barrier()
#define PG8_SCHED __builtin_amdgcn_sched_barrier(0)
    Unit cur, nxt; int ui = 0;
    if (!S.next(0, cur)) return;
    f32x4 acc[2][2][4][2];
#pragma unroll
    for (int a = 0; a < 2; ++a)
#pragma unroll
        for (int b = 0; b < 2; ++b)
#pragma unroll
            for (int m = 0; m < 4; ++m)
#pragma unroll
                for (int n = 0; n < 2; ++n) acc[a][b][m][n] = (f32x4){0.f, 0.f, 0.f, 0.f};
    bf16x8 At[4][2], B0[2][2], B1[2][2];
    const char* cA = (const char*)g.A + (size_t)cur.pm * tstep; const char* cB = (const char*)g.Bt + (size_t)cur.pn * tstep;
    S.a_ready(cur);
    if constexpr (SP2) {
        PG8_STAGE(PG8_SB(0, 0), cB, voffB); PG8_STAGE(PG8_SB(0, 1), cB + hstep, voffB); PG8_STAGE(PG8_SA(0, 0), cA, voffA); PG8_STAGE(PG8_SA(0, 1), cA + hstep, voffA);
        if (wr == 1) PG8_BAR;
        PG8_WAIT_V(2); PG8_BAR;
        PG8_STAGE(PG8_SB(1, 0), cB + kstep, voffB); PG8_STAGE(PG8_SA(1, 0), cA + kstep, voffA); PG8_STAGE(PG8_SB(1, 1), cB + hstep + kstep, voffB);
        PG8_WAIT_V(6); PG8_BAR;
    } else {
        PG8_STAGE(PG8_SB(0, 0), cB, voffB); PG8_STAGE(PG8_SA(0, 0), cA, voffA); PG8_STAGE(PG8_SB(0, 1), cB + hstep, voffB); PG8_STAGE(PG8_SA(0, 1), cA + hstep, voffA);
        if (wr == 1) PG8_BAR;
        PG8_WAIT_V(4); PG8_BAR;
        PG8_STAGE(PG8_SB(1, 0), cB + kstep, voffB); PG8_STAGE(PG8_SA(1, 0), cA + kstep, voffA); PG8_STAGE(PG8_SB(1, 1), cB + hstep + kstep, voffB);
        PG8_WAIT_V(6); PG8_BAR;
    }
    for (;;) {
        const bool has_next = S.next(ui + 1, nxt);
        const char* nA = has_next ? (const char*)g.A + (size_t)nxt.pm * tstep : cA; const char* nB = has_next ? (const char*)g.Bt + (size_t)nxt.pn * tstep : cB;
        for (int t = 0; t < nt; t += 2) {
            const bool last = (t == nt - 2);
            const char* a1 = cA + (size_t)(t + 1) * kstep;
            const char* a2 = last ? nA : cA + (size_t)(t + 2) * kstep; const char* b2 = last ? nB : cB + (size_t)(t + 2) * kstep;
            const char* a3 = a2 + kstep; const char* b3 = b2 + kstep;
            if (last && has_next) S.a_ready(nxt);
            if constexpr (SP2) {
            PG8_LDB(B0, 0, 0); PG8_LDB(B1, 0, 1); PG8_SCHED; PG8_LDA(At, 0, 0); PG8_STAGE(PG8_SA(1, 1), a1 + hstep, voffA);
            PG8_WAIT_V(8); PG8_WAIT_L(0); PG8_BAR; PG8_MMA(0, 0, At, B0); PG8_MMA(0, 1, At, B1); PG8_BAR; PG8_SCHED;
            PG8_LDA(At, 0, 1); PG8_STAGE(PG8_SB(0, 0), b2, voffB); PG8_STAGE(PG8_SB(0, 1), b2 + hstep, voffB); PG8_STAGE(PG8_SA(0, 0), a2, voffA);
            PG8_WAIT_V(8); PG8_WAIT_L(0); PG8_BAR; PG8_MMA(1, 0, At, B0); PG8_MMA(1, 1, At, B1); PG8_BAR; PG8_SCHED;
            PG8_LDB(B0, 1, 0); PG8_LDB(B1, 1, 1); PG8_SCHED; PG8_LDA(At, 1, 0); PG8_STAGE(PG8_SA(0, 1), a2 + hstep, voffA);
            PG8_WAIT_V(8); PG8_WAIT_L(0); PG8_BAR; PG8_MMA(0, 0, At, B0); PG8_MMA(0, 1, At, B1); PG8_BAR; PG8_SCHED;
            PG8_LDA(At, 1, 1); PG8_STAGE(PG8_SB(1, 0), b3, voffB); PG8_STAGE(PG8_SB(1, 1), b3 + hstep, voffB); PG8_STAGE(PG8_SA(1, 0), a3, voffA);
            PG8_WAIT_V(8); PG8_WAIT_L(0); PG8_BAR; PG8_MMA(1, 0, At, B0); PG8_MMA(1, 1, At, B1); PG8_BAR; PG8_SCHED;
            } else {
            PG8_LDB(B0, 0, 0); PG8_SCHED; PG8_LDA(At, 0, 0); PG8_STAGE(PG8_SA(1, 1), a1 + hstep, voffA);
            PG8_WAIT_L(8); PG8_BAR; PG8_WAIT_L(0); PG8_MMA(0, 0, At, B0); PG8_BAR; PG8_SCHED;
            PG8_LDB(B1, 0, 1); PG8_STAGE(PG8_SB(0, 0), b2, voffB);
            PG8_BAR; PG8_WAIT_L(0); PG8_MMA(0, 1, At, B1); PG8_BAR;
            PG8_LDA(At, 0, 1); PG8_STAGE(PG8_SA(0, 0), a2, voffA);
            PG8_BAR; PG8_WAIT_L(0); PG8_MMA(1, 0, At, B0); PG8_BAR; PG8_SCHED;
            PG8_STAGE(PG8_SB(0, 1), b2 + hstep, voffB);
            PG8_WAIT_V(6); PG8_BAR; PG8_MMA(1, 1, At, B1); PG8_BAR;
            PG8_LDB(B0, 1, 0); PG8_SCHED; PG8_LDA(At, 1, 0); PG8_STAGE(PG8_SA(0, 1), a2 + hstep, voffA);
            PG8_WAIT_L(8); PG8_BAR; PG8_WAIT_L(0); PG8_MMA(0, 0, At, B0); PG8_BAR; PG8_SCHED;
            PG8_LDB(B1, 1, 1); PG8_STAGE(PG8_SB(1, 0), b3, voffB);
            PG8_BAR; PG8_WAIT_L(0); PG8_MMA(0, 1, At, B1); PG8_BAR;
            PG8_LDA(At, 1, 1); PG8_STAGE(PG8_SA(1, 0), a3, voffA);
            PG8_BAR; PG8_WAIT_L(0); PG8_MMA(1, 0, At, B0); PG8_BAR; PG8_SCHED;
            PG8_STAGE(PG8_SB(1, 1), b3 + hstep, voffB);
            PG8_WAIT_V(6); PG8_BAR; PG8_MMA(1, 1, At, B1); PG8_BAR;
            }
        }
        if constexpr (ALIGN_EPI) { if (wr == 0) PG8_BAR; }
        if constexpr (!Epi::AFTER_DRAIN) { E(acc, cur, wr, wc, fr, fq); S.done(cur); }
        if (!has_next) break;
#pragma unroll
        for (int a = 0; a < 2; ++a)
#pragma unroll
            for (int b = 0; b < 2; ++b)
#pragma unroll
                for (int m = 0; m < 4; ++m)
#pragma unroll
                    for (int n = 0; n < 2; ++n) acc[a][b][m][n] = (f32x4){0.f, 0.f, 0.f, 0.f};
        cur = nxt; cA = nA; cB = nB; ++ui;
        if constexpr (ALIGN_EPI) { if (wr == 1) PG8_BAR; }
    }
    PG8_WAIT_V(0);
    if constexpr (!ALIGN_EPI) { if (wr == 0) PG8_BAR; }
    PG8_BAR;
    if constexpr (Epi::AFTER_DRAIN) { E.fused(acc, cur, wr, wc, fr, fq, lds, wid, lane); S.done(cur); }
#undef PG8_SA
#undef PG8_SB
#undef PG8_STAGE
#undef PG8_LDA
#undef PG8_LDB
#undef PG8_MMA
#undef PG8_WAIT_V
#undef PG8_WAIT_L
#undef PG8_BAR
#undef PG8_SCHED
}
}
#define GAS __attribute__((address_space(1)))
#define LAS __attribute__((address_space(3)))
typedef unsigned short bf16;
typedef unsigned v4u __attribute__((ext_vector_type(4)));
typedef float f32x4 __attribute__((ext_vector_type(4)));
typedef short bf16x8 __attribute__((ext_vector_type(8)));
typedef GAS unsigned gu32;
typedef GAS unsigned long long gu64;
#define RLX_AGENT __ATOMIC_RELAXED, __HIP_MEMORY_SCOPE_AGENT
#define LDS_WAIT() asm volatile("s_waitcnt lgkmcnt(0)" ::: "memory")
#define VM_WAIT() asm volatile("s_waitcnt vmcnt(0)" ::: "memory")
__device__ __forceinline__ unsigned long long rt() { return __builtin_amdgcn_s_memrealtime(); }
__device__ __forceinline__ unsigned f2bf(float f) { unsigned u = __builtin_bit_cast(unsigned, f); return (u + 0x7fffu + ((u >> 16) & 1u)) >> 16; }
__device__ __forceinline__ unsigned pk2(float lo, float hi) { return f2bf(lo) | (f2bf(hi) << 16); }
#define XB_TMO      128
#define XB_XCNT(j)  (256  + 64 * (j))
#define XB_XSUB(j)  (1280 + 64 * (j))
#define XB_XGEN(j)  (2304 + 64 * (j))
#define XB_TOP      3328
#define XB_TOPGEN   3392
#define XCD_BAR_WORDS 3456
#define XB_SPIN_CAP (1u << 18)

__device__ __forceinline__ unsigned xb_ld(unsigned* p)              { return __hip_atomic_load(p, __ATOMIC_RELAXED, __HIP_MEMORY_SCOPE_AGENT); }
__device__ __forceinline__ unsigned xb_add(unsigned* p, unsigned v) { return __hip_atomic_fetch_add(p, v, __ATOMIC_RELAXED, __HIP_MEMORY_SCOPE_AGENT); }
__device__ __forceinline__ unsigned xb_xcc_id() { return (unsigned)__builtin_amdgcn_s_getreg((3 << 11) | 20) & 0xFu; }
#define XB_SPIN(cond, bar) do { unsigned _sp = 0; while (cond) { __builtin_amdgcn_s_sleep(1); \
    if ((++_sp & 255u) == 0u) { if (xb_ld(&(bar)[XB_TMO])) break; if (_sp > XB_SPIN_CAP) { atomicAdd(&(bar)[XB_TMO], 1u); break; } } } } while (0)

struct XcdBarrier {
    unsigned* bar; unsigned x;
    volatile LAS unsigned* st;
};

__device__ __forceinline__ XcdBarrier xcd_barrier_post(unsigned* bar, volatile LAS unsigned* st) {
    XcdBarrier b; b.bar = bar; b.x = xb_xcc_id(); b.st = st;
    if (threadIdx.x == 0) (void)xb_add(&bar[XB_XCNT(b.x)], 1u);
    return b;
}
__device__ __forceinline__ void xcd_barrier_complete(unsigned* bar, unsigned x, unsigned& nloc, unsigned& nx) {
    const unsigned G = gridDim.x * gridDim.y * gridDim.z;
    unsigned sum, cnt, mine, sp = 0u;
    for (;;) {
        sum = 0u; cnt = 0u; mine = 0u;
#pragma unroll
        for (unsigned j = 0; j < 16; ++j) { const unsigned c = xb_ld(&bar[XB_XCNT(j)]); sum += c; cnt += (c > 0u) ? 1u : 0u; mine = (j == x) ? c : mine; }
        if (sum == G) break;
        __builtin_amdgcn_s_sleep(1);
        if ((++sp & 255u) == 0u) { if (xb_ld(&bar[XB_TMO])) break; if (sp > XB_SPIN_CAP) { atomicAdd(&bar[XB_TMO], 1u); break; } }
    }
    nloc = mine > 0u ? mine : 1u; nx = cnt > 0u ? cnt : 1u;
}

__device__ __forceinline__ void xcd_barrier(const XcdBarrier& b) {
    asm volatile("s_waitcnt vmcnt(0)" ::: "memory");
    __syncthreads();
    if (threadIdx.x == 0) {
        unsigned* bar = b.bar;
        __builtin_amdgcn_s_waitcnt(0);
        unsigned nloc = b.st[0], nx = b.st[1];
        if (nloc == 0u) { xcd_barrier_complete(bar, b.x, nloc, nx); b.st[0] = nloc; b.st[1] = nx; }
        const unsigned old = xb_add(&bar[XB_XSUB(b.x)], 1u);
        const unsigned gen = old / nloc;
        if (old + 1u == (gen + 1u) * nloc) {
            __builtin_amdgcn_fence(__ATOMIC_RELEASE, "agent");
            asm volatile("s_waitcnt vmcnt(0)" ::: "memory");
            const unsigned og = xb_add(&bar[XB_TOP], 1u);
            const unsigned tg = og / nx;
            if (og + 1u == (tg + 1u) * nx) xb_add(&bar[XB_TOPGEN], 1u);
            else XB_SPIN(xb_ld(&bar[XB_TOPGEN]) == tg, bar);
            __builtin_amdgcn_fence(__ATOMIC_ACQUIRE, "agent");
            xb_add(&bar[XB_XGEN(b.x)], 1u);
            asm volatile("s_waitcnt vmcnt(0)" ::: "memory");
        } else {
            XB_SPIN(xb_ld(&bar[XB_XGEN(b.x)]) == gen, bar);
            __builtin_amdgcn_fence(__ATOMIC_ACQUIRE, "agent");
            asm volatile("s_waitcnt vmcnt(0)" ::: "memory");
        }
    }
    __syncthreads();
}
constexpr int NWAVES = 8;
constexpr size_t MiB = 1u << 20;
constexpr size_t WS_CTL = 0, CTL_ZERO_BYTES = 1 * MiB;
constexpr size_t WS_W1 = 1 * MiB, WS_WO = 6 * MiB, WS_WGU = 8 * MiB, WS_WD = 19 * MiB, WS_WPG = 25 * MiB, WS_WPP = 27 * MiB;
constexpr size_t WS_RX = 28 * MiB, WS_SS1 = 29 * MiB, WS_SS2 = 32 * MiB;
constexpr size_t WS_XB = 36 * MiB;
constexpr size_t WS_PB = 102 * MiB, WS_PP = 119 * MiB;
constexpr size_t WS_Q = 185 * MiB, WS_KP = 218 * MiB, WS_VP = 250 * MiB, WS_KS = 282 * MiB, WS_VS = 300 * MiB, WS_GLU = 318 * MiB, WS_MIX = 351 * MiB;
constexpr size_t WS_ACT = 185 * MiB;
constexpr size_t WS_END = 417 * MiB;
static_assert(WS_XB + (size_t)R * D * 2 <= WS_PB && WS_PB + (size_t)R * PLE * 2 <= WS_PP && WS_PP + (size_t)R * D * 2 <= WS_Q && WS_Q + (size_t)R * 512 * 2 <= WS_KP && WS_KP + (size_t)RP * 512 * 2 <= WS_VP &&
              WS_VP + (size_t)RP * 512 * 2 <= WS_KS && WS_KS + (size_t)DB * KSROWS * 512 * 2 <= WS_VS && WS_VS + (size_t)DB * KSROWS * 512 * 2 <= WS_GLU && WS_GLU + (size_t)R * 512 * 2 <= WS_MIX &&
              WS_MIX + (size_t)R * D * 2 <= WS_END && WS_ACT + (size_t)R * DFF * 2 <= WS_END && WS_SS1 + (size_t)R * 64 <= WS_SS2 && WS_SS2 + (size_t)R * 64 <= WS_XB && WS_RX + (size_t)R * 4 <= WS_SS1, "d_ws map");
constexpr int CW_BAR = 4096, CW_Q = 8192;
constexpr int RING_OFF = 0, RING_BYTES = 131072;
constexpr int LDSCTL_OFF = RING_BYTES, MISC_OFF = LDSCTL_OFF + 320;
constexpr int ATT_TAB = 132096, ATT_LSC = ATT_TAB + 8192;
constexpr int LDS_BYTES = 147456;
static_assert(ATT_LSC + 2048 <= LDS_BYTES && MISC_OFF + 128 <= ATT_TAB, "LDS map");

__device__ __forceinline__ float wave_sum(float v) {
#pragma unroll
    for (int o = 1; o < 64; o <<= 1) v += __shfl_xor(v, o);
    return v;
}
__device__ __forceinline__ float wave_max(float v) {
#pragma unroll
    for (int o = 1; o < 64; o <<= 1) v = fmaxf(v, __shfl_xor(v, o));
    return v;
}
__device__ __forceinline__ int map_win(int n) {
    if (n < 1536) { const int sec = n >> 9, nn = n & 511, h = nn >> 6, d = nn & 63; return sec * 512 + 256 * (h >> 2) + 128 * (d >> 5) + 32 * (h & 3) + (d & 31); }
    if (n < 2048) { const int i = n - 1536; return 1536 + 256 * (i >> 7) + (i & 127); }
    const int i = n - 2048; return 1536 + 256 * (i >> 7) + 128 + (i & 127);
}
__device__ __forceinline__ int map_gu(int n) {
    if (n < DFF) return 256 * (n >> 7) + (n & 127);
    const int i = n - DFF; return 256 * (i >> 7) + 128 + (i & 127);
}
template <int MAP> __device__ __forceinline__ void p0_transpose_item(const float* W, const float* gain, int K, int N, bf16* WT, LAS float* scr, int item, int lane) {
    const int nblk = N / 32, kb = item / nblk, nb = item % nblk, k0 = 64 * kb, n0 = 32 * nb;
#pragma unroll 8
    for (int i = 0; i < 32; ++i) { const int kk = 2 * i + (lane >> 5); float v = W[(size_t)(k0 + kk) * N + n0 + (lane & 31)]; if (gain) v *= gain[k0 + kk]; scr[kk * 33 + (lane & 31)] = v; }
    LDS_WAIT(); asm volatile("" ::: "memory");
    const int c = lane & 7;
#pragma unroll
    for (int j = 0; j < 4; ++j) { const int n = (lane >> 3) + 8 * j; const LAS float* s = scr + (8 * c) * 33 + n;
        v4u o; o.x = pk2(s[0 * 33], s[1 * 33]); o.y = pk2(s[2 * 33], s[3 * 33]); o.z = pk2(s[4 * 33], s[5 * 33]); o.w = pk2(s[6 * 33], s[7 * 33]);
        const int ns = n0 + n, dr = MAP == 0 ? ns : (MAP == 1 ? map_win(ns) : map_gu(ns));
        *(GAS v4u*)(WT + (size_t)dr * K + k0 + 8 * c) = o; }
    LDS_WAIT(); asm volatile("" ::: "memory");
}

namespace att {
typedef short bf16x8 __attribute__((ext_vector_type(8)));
typedef short s16x4 __attribute__((ext_vector_type(4)));
typedef float f32x16 __attribute__((ext_vector_type(16)));
typedef unsigned u32x4 __attribute__((ext_vector_type(4)));
typedef float f32x2_t __attribute__((ext_vector_type(2))); typedef __bf16 bf16x2_t __attribute__((ext_vector_type(2)));
typedef short v4i16_t __attribute__((ext_vector_type(4)));
typedef LAS const char* lds_cptr;
constexpr int BUFB = 65536, HSLOT = 16384;
__device__ __forceinline__ int crow(int r, int hi) { return (r & 3) + 8 * (r >> 2) + 4 * hi; }
__device__ __forceinline__ void glds16(const void* gsrc, unsigned lds_dst) { unsigned keep;
    asm volatile("s_mov_b32 %0, m0\n\ts_mov_b32 m0, %2\n\ts_nop 0\n\tglobal_load_lds_dwordx4 %1, off\n\ts_mov_b32 m0, %0" : "=&s"(keep) : "v"(gsrc), "s"(lds_dst) : "memory"); }
__device__ __forceinline__ unsigned cvtpk_s(float lo, float hi) { f32x2_t v = {lo, hi}; bf16x2_t b = __builtin_convertvector(v, bf16x2_t); return __builtin_bit_cast(unsigned, b); }
__device__ __forceinline__ s16x4 vtr(lds_cptr p) { return __builtin_bit_cast(s16x4, __builtin_amdgcn_ds_read_tr16_b64_v4i16((LAS v4i16_t*)p)); }
#define ATT_WAIT_BAR() asm volatile("s_waitcnt vmcnt(0) lgkmcnt(0)\n\ts_barrier" ::: "memory")

struct AUnit { const bf16* Qrow; const bf16* Kb; const bf16* Vb; bf16* Orow; int nt, hg, sample; };

__device__ __forceinline__ void attn_unit(const AUnit& U, LAS unsigned char* lds, int wid, int lane) {
    const int r32 = lane & 31, hi = lane >> 5, hl = wid & 3, qh = wid >> 2, head = 4 * U.hg + hl, nt = U.nt;
    const bool active = !U.sample || qh == 0;
    const unsigned lds0 = (unsigned)(size_t)lds;
    const LAS float* tabh = (const LAS float*)(lds + ATT_TAB) + head * 256;
    LAS float* lsc = (LAS float*)(lds + ATT_LSC) + wid * 64;
    bf16x8 qr[4];
    { const bf16* Qw = U.Qrow + (size_t)((active ? 32 * qh : 0) + r32) * 512 + head * 64 + hi * 8;
#pragma unroll
      for (int d0 = 0; d0 < 4; ++d0) qr[d0] = *(const bf16x8*)(Qw + d0 * 16); }
    const float cfar = tabh[255];
    f32x16 o[2]; o[0] = f32x16{}; o[1] = f32x16{}; float lsum = 0.f;
    const bf16* ksrc = U.Kb + (size_t)lane * 512 + wid * 8 + 4 * U.hg * 64;
    const bf16* vsrc = U.Vb + (size_t)(16 * (wid & 3) + (lane >> 2)) * 512 + (wid >> 2) * 32 + (lane & 3) * 8 + 4 * U.hg * 64;
    const unsigned kdst = lds0 + wid * 1024, vdst = lds0 + 8192 + wid * 1024;
#define ATT_DMA(ti, b) do { _Pragma("unroll") for (int j_ = 0; j_ < 4; ++j_) { \
        glds16(ksrc + (size_t)(ti) * 64 * 512 + j_ * 64, (unsigned)__builtin_amdgcn_readfirstlane(kdst + (b) * BUFB + j_ * HSLOT)); \
        glds16(vsrc + (size_t)(ti) * 64 * 512 + j_ * 64, (unsigned)__builtin_amdgcn_readfirstlane(vdst + (b) * BUFB + j_ * HSLOT)); } } while (0)
    ATT_DMA(0, 0);
    for (int ti = 0; ti < nt; ++ti) {
        ATT_WAIT_BAR();
        const int b = ti & 1;
        if (ti + 1 < nt) ATT_DMA(ti + 1, b ^ 1);
        if (active) {
            const int jt = nt - 1 - ti;
            const bool half = U.sample && jt == 0;
            const lds_cptr kp = (lds_cptr)(lds + b * BUFB + hl * HSLOT + hi * 1024 + r32 * 16);
            const float c0 = jt >= 3 ? cfar : 0.f;
            f32x16 p0, p1;
#pragma unroll
            for (int r = 0; r < 16; ++r) { p0[r] = c0; p1[r] = c0; }
#pragma unroll
            for (int d0 = 0; d0 < 4; ++d0) {
                const bf16x8 k0 = *(const LAS bf16x8*)(kp + d0 * 2048);
                p0 = __builtin_amdgcn_mfma_f32_32x32x16_bf16(k0, qr[d0], p0, 0, 0, 0);
                if (!half) { const bf16x8 k1 = *(const LAS bf16x8*)(kp + d0 * 2048 + 512); p1 = __builtin_amdgcn_mfma_f32_32x32x16_bf16(k1, qr[d0], p1, 0, 0, 0); }
            }
            if (jt < 3) { const LAS float* tp = tabh + (191 - (32 * qh + r32) - 64 * jt + 4 * hi);
#pragma unroll
                for (int r = 0; r < 16; ++r) { p0[r] += tp[(r & 3) + 8 * (r >> 2)]; p1[r] += tp[32 + (r & 3) + 8 * (r >> 2)]; } }
            float sacc = 0.f;
#pragma unroll
            for (int r = 0; r < 16; ++r) { p0[r] = __builtin_amdgcn_exp2f(p0[r]); p1[r] = half ? 0.f : __builtin_amdgcn_exp2f(p1[r]); sacc += p0[r] + p1[r]; }
            lsum += sacc;
            u32x4 pw[4];
#pragma unroll
            for (int k = 0; k < 2; ++k) { pw[k] = (u32x4){cvtpk_s(p0[8 * k], p0[8 * k + 1]), cvtpk_s(p0[8 * k + 2], p0[8 * k + 3]), cvtpk_s(p0[8 * k + 4], p0[8 * k + 5]), cvtpk_s(p0[8 * k + 6], p0[8 * k + 7])};
                pw[2 + k] = (u32x4){cvtpk_s(p1[8 * k], p1[8 * k + 1]), cvtpk_s(p1[8 * k + 2], p1[8 * k + 3]), cvtpk_s(p1[8 * k + 4], p1[8 * k + 5]), cvtpk_s(p1[8 * k + 6], p1[8 * k + 7])}; }
            const lds_cptr vp = (lds_cptr)(lds + b * BUFB + hl * HSLOT + 8192 + ((lane >> 4) & 1) * 32 + (lane & 3) * 8 + (4 * hi + ((lane & 15) >> 2)) * 64);
#pragma unroll
            for (int d0 = 0; d0 < 2; ++d0)
#pragma unroll
                for (int ks = 0; ks < 4; ++ks) { if (half && ks >= 2) continue;
                    const s16x4 lo = vtr(vp + d0 * 4096 + ks * 1024), hh = vtr(vp + d0 * 4096 + ks * 1024 + 512);
                    const bf16x8 vf = (bf16x8){lo[0], lo[1], lo[2], lo[3], hh[0], hh[1], hh[2], hh[3]};
                    o[d0] = __builtin_amdgcn_mfma_f32_32x32x16_bf16(__builtin_bit_cast(bf16x8, pw[ks]), vf, o[d0], 0, 0, 0); }
        }
    }
    ATT_WAIT_BAR();
    if (active) {
        { auto rr = __builtin_amdgcn_permlane32_swap(__float_as_uint(lsum), __float_as_uint(lsum), false, false); lsum = __uint_as_float(rr[0]) + __uint_as_float(rr[1]); }
        if (hi == 0) lsc[r32] = lsum;
        asm volatile("s_waitcnt lgkmcnt(0)" ::: "memory");
        LAS bf16* stg = (LAS bf16*)(lds + wid * 4096);
#pragma unroll
        for (int r = 0; r < 16; ++r) { const int orow = crow(r, hi); const float rl = __builtin_amdgcn_rcpf(lsc[orow]);
#pragma unroll
            for (int d0 = 0; d0 < 2; ++d0) stg[orow * 64 + d0 * 32 + r32] = (bf16)f2bf(o[d0][r] * rl); }
        asm volatile("s_waitcnt lgkmcnt(0)" ::: "memory");
        bf16* Ow = U.Orow + (size_t)(32 * qh) * D + head * 64;
#pragma unroll
        for (int i = 0; i < 4; ++i) { const int row = i * 8 + (lane >> 3), ch = lane & 7; const u32x4 v = *(const LAS u32x4*)(stg + row * 64 + ch * 8); *(u32x4*)(Ow + (size_t)row * D + ch * 8) = v; }
    }
    ATT_WAIT_BAR();
#undef ATT_DMA
}
}

__device__ __forceinline__ void conv_item(int item, const bf16* GLU, const float* st, const float* cw, const float* cb, const float* lg, const float* lb, bf16* MIX, LAS unsigned char* lds, int tid) {
    const bool samp = item >= RP / 32; const int b = samp ? item - RP / 32 : item >> 8, t0 = samp ? 0 : (item & 255) * 32, rowbase = samp ? RP + DS * b : b * SEQ;
    const int ch = tid, wid = tid >> 6, lane = tid & 63;
    LAS float* ybuf = (LAS float*)lds;
    float w[CONVW];
#pragma unroll
    for (int j = 0; j < CONVW; ++j) w[j] = cw[j * CW + ch];
    const float bias = cb[ch];
#pragma unroll 1
    for (int hb = 0; hb < 2; ++hb) {
        float x[46];
#pragma unroll
        for (int k = 0; k < 46; ++k) { const int tp = t0 + 16 * hb - CH + k;
            if (tp < 0) x[k] = samp ? st[((size_t)b * CH + (CH + tp)) * CW + ch] : 0.f;
            else x[k] = __uint_as_float((unsigned)GLU[(size_t)(rowbase + tp) * 512 + ch] << 16); }
#pragma unroll
        for (int i = 0; i < 16; ++i) { float y = bias;
#pragma unroll
            for (int j = 0; j < CONVW; ++j) y += w[j] * x[i + j];
            ybuf[(16 * hb + i) * 512 + ch] = y; }
    }
    __syncthreads();
    f32x4 g0 = *(const f32x4*)(lg + 8 * lane), g1 = *(const f32x4*)(lg + 8 * lane + 4), b0 = *(const f32x4*)(lb + 8 * lane), b1 = *(const f32x4*)(lb + 8 * lane + 4);
#pragma unroll
    for (int q = 0; q < 4; ++q) { const int i = 4 * wid + q;
        f32x4 v0 = *(const LAS f32x4*)(ybuf + i * 512 + 8 * lane), v1 = *(const LAS f32x4*)(ybuf + i * 512 + 8 * lane + 4);
        const float mean = wave_sum((v0[0] + v0[1]) + (v0[2] + v0[3]) + (v1[0] + v1[1]) + (v1[2] + v1[3])) * (1.0f / CW);
        v0 = v0 - mean; v1 = v1 - mean;
        const f32x4 q0 = v0 * v0, q1 = v1 * v1;
        const float rstd = rsqrtf(wave_sum((q0[0] + q0[1]) + (q0[2] + q0[3]) + (q1[0] + q1[1]) + (q1[2] + q1[3])) * (1.0f / CW) + EPS);
        v0 = v0 * rstd * g0 + b0; v1 = v1 * rstd * g1 + b1;
#pragma unroll
        for (int e = 0; e < 4; ++e) { v0[e] *= pg8::sigm(v0[e]); v1[e] *= pg8::sigm(v1[e]); }
        *(pg8::u32x4*)(MIX + (size_t)(rowbase + t0 + i) * D + 512 + 8 * lane) = pg8::pack8(v0, v1); }
    __syncthreads();
}

struct Args { const float* in[23]; float* out; unsigned char* ws; };
constexpr int N_ATT_S = 2 * DB, N_ATT_P = NB * 128 * 2, N_CONV = R / 32, N_P2 = N_ATT_S + N_ATT_P + N_CONV;
#define W1t ((bf16*)(ws + WS_W1))
#define WOt ((bf16*)(ws + WS_WO))
#define WGUt ((bf16*)(ws + WS_WGU))
#define WDt ((bf16*)(ws + WS_WD))
#define WPGt ((bf16*)(ws + WS_WPG))
#define WPPt ((bf16*)(ws + WS_WPP))
#define RX ((float*)(ws + WS_RX))
#define SS1 ((float*)(ws + WS_SS1))
#define SS2 ((float*)(ws + WS_SS2))
#define XB ((bf16*)(ws + WS_XB))
#define PB ((bf16*)(ws + WS_PB))
#define PPb ((bf16*)(ws + WS_PP))
#define Qb ((bf16*)(ws + WS_Q))
#define KPb ((bf16*)(ws + WS_KP))
#define VPb ((bf16*)(ws + WS_VP))
#define KSb ((bf16*)(ws + WS_KS))
#define VSb ((bf16*)(ws + WS_VS))
#define GLUb ((bf16*)(ws + WS_GLU))
#define MIXb ((bf16*)(ws + WS_MIX))
#define ACTb ((bf16*)(ws + WS_ACT))
#define Y (out + OY)
__global__ void __launch_bounds__(NWAVES * 64, 2) mk_fwd(Args args) {
    extern __shared__ __attribute__((aligned(16))) unsigned char lds_[];
    LAS unsigned char* lds = (LAS unsigned char*)lds_;
    volatile LAS unsigned* MISC = (volatile LAS unsigned*)(lds + MISC_OFF);
    const int G = gridDim.x, vcu = (G % 8 == 0) ? ((int)blockIdx.x % 8) * (G / 8) + (int)blockIdx.x / 8 : (int)blockIdx.x;
    unsigned char* ws = args.ws; float* out = args.out;
    gu32* ctl = (gu32*)(ws + WS_CTL);
    for (int u = threadIdx.x; u < (ATT_TAB - LDSCTL_OFF) / 4; u += NWAVES * 64) ((LAS unsigned*)(lds + LDSCTL_OFF))[u] = 0u;
    __syncthreads();
    XcdBarrier bar = xcd_barrier_post((unsigned*)(ctl + CW_BAR), MISC + 8);

#ifndef SKIP_P0
    {
        int tid0 = threadIdx.x; asm volatile("" : "+v"(tid0));
        const int lane = tid0 & 63, wave = __builtin_amdgcn_readfirstlane(tid0 >> 6);
        LAS float* scr = (LAS float*)(lds + RING_OFF + wave * 16384);
        const int gw = vcu * NWAVES + wave, NGW = G * NWAVES;
        constexpr int I_1 = (D / 64) * (INC / 32), I_O = (D / 64) * (D / 32), I_GU = (D / 64) * (2 * DFF / 32), I_D = (DFF / 64) * (D / 32), I_PG = I_O, I_PP = (PLE / 64) * (D / 32);
        constexpr int NITEMS = I_1 + I_O + I_GU + I_D + I_PG + I_PP;
        for (int it = gw; it < NITEMS; it += NGW) {
            int r = it;
            if (r < I_1) { p0_transpose_item<1>(args.in[8], args.in[7], D, INC, W1t, scr, r, lane); continue; } r -= I_1;
            if (r < I_O) { p0_transpose_item<0>(args.in[16], nullptr, D, D, WOt, scr, r, lane); continue; } r -= I_O;
            if (r < I_GU) { p0_transpose_item<2>(args.in[18], args.in[17], D, 2 * DFF, WGUt, scr, r, lane); continue; } r -= I_GU;
            if (r < I_D) { p0_transpose_item<0>(args.in[19], nullptr, DFF, D, WDt, scr, r, lane); continue; } r -= I_D;
            if (r < I_PG) { p0_transpose_item<0>(args.in[21], args.in[20], D, D, WPGt, scr, r, lane); continue; } r -= I_PG;
            p0_transpose_item<0>(args.in[22], nullptr, PLE, D, WPPt, scr, r, lane);
        }
        for (int m = gw; m < R; m += NGW) {
            const float* xrow = m < RP ? args.in[0] + (size_t)m * D : args.in[1] + (size_t)(m - RP) * D;
            const GAS f32x4* xr = (const GAS f32x4*)xrow + lane; f32x4 v[4]; float s = 0.f;
#pragma unroll
            for (int j = 0; j < 4; ++j) { v[j] = xr[64 * j]; s += (v[j].x * v[j].x + v[j].y * v[j].y) + (v[j].z * v[j].z + v[j].w * v[j].w); }
            s = wave_sum(s); if (lane == 0) RX[m] = rsqrtf(s * (1.0f / D) + EPS);
            GAS unsigned long long* o8 = (GAS unsigned long long*)(XB + (size_t)m * D) + lane;
#pragma unroll
            for (int j = 0; j < 4; ++j) o8[64 * j] = (unsigned long long)pk2(v[j].x, v[j].y) | ((unsigned long long)pk2(v[j].z, v[j].w) << 32);
            const float* prow = m < RP ? args.in[2] + (size_t)m * PLE : args.in[3] + (size_t)(m - RP) * PLE;
            const f32x4 pv = ((const GAS f32x4*)prow)[lane];
            ((GAS unsigned long long*)(PB + (size_t)m * PLE))[lane] = (unsigned long long)pk2(pv.x, pv.y) | ((unsigned long long)pk2(pv.z, pv.w) << 32);
        }
        for (int m = gw; m < 2 * DB * 512; m += NGW) {
            const int kv = m >= DB * 512, mm = kv ? m - DB * 512 : m, b = mm >> 9, j = mm & 511;
            const GAS f32x4* src = (const GAS f32x4*)(args.in[4 + kv] + (size_t)mm * 512) + lane;
            const f32x4 a0 = src[0], a1 = src[64];
            GAS unsigned long long* d8 = (GAS unsigned long long*)((kv ? VSb : KSb) + ((size_t)b * KSROWS + j) * 512) + lane;
            d8[0] = (unsigned long long)pk2(a0.x, a0.y) | ((unsigned long long)pk2(a0.z, a0.w) << 32);
            d8[64] = (unsigned long long)pk2(a1.x, a1.y) | ((unsigned long long)pk2(a1.z, a1.w) << 32);
            if (j >= DS) { GAS f32x4* fo = (GAS f32x4*)(out + (kv ? OVS : OKS) + ((size_t)b * 512 + (j - DS)) * 512) + lane; fo[0] = a0; fo[64] = a1; }
        }
    }
#endif
    xcd_barrier(bar);

#ifndef SKIP_P1
    {
        pg8::Gemm g{XB, W1t, R, INC, D}; pg8::StaticOrder S; S.init(R, INC, G, (int)blockIdx.x);
        pg8::Epi1 E{RX, args.in[9], args.in[10], Qb, KPb, KSb, GLUb, out, (WS_VP - WS_KP) / 2, (WS_VS - WS_KS) / 2};
        pg8::gemm_phase<pg8::Epi1, pg8::StaticOrder, true, true>(lds + RING_OFF, g, S, E);
        pg8::Gemm g2{PB, WPPt, R, D, PLE}; pg8::StaticOrder S2; S2.init(R, D, G, (int)blockIdx.x);
        pg8::EpiPP E2{PPb};
        pg8::gemm_phase<pg8::EpiPP, pg8::StaticOrder, true, true>(lds + RING_OFF, g2, S2, E2);
    }
#endif
    xcd_barrier(bar);

#ifndef SKIP_P2
    {
        { int tidt = threadIdx.x; asm volatile("" : "+v"(tidt)); const int lane = tidt & 63, wave = __builtin_amdgcn_readfirstlane(tidt >> 6);
          const float* relb = args.in[11] + wave * NREL; LAS float* T = (LAS float*)(lds + ATT_TAB) + wave * 256;
          const float gq = wave_max(fabsf(args.in[9][lane])), gk = wave_max(fabsf(args.in[10][lane]));
          float bm = -1e30f; for (int i = lane; i < NREL; i += 64) bm = fmaxf(bm, relb[i]); bm = wave_max(bm);
          const float shift = 8.0f * gq * gk + bm;
          for (int x = lane; x < 256; x += 64) { int dd = 191 - x; dd = dd < -128 ? -128 : (dd > 128 ? 128 : dd); if (x == 255) dd = 128; T[x] = (relb[dd + 128] - shift) * LOG2E; } }
        __syncthreads();
        for (;;) {
            int tid2 = threadIdx.x; asm volatile("" : "+v"(tid2));
            if (tid2 == 0) MISC[4] = __hip_atomic_fetch_add((unsigned*)(ctl + CW_Q), 1u, __ATOMIC_RELAXED, __HIP_MEMORY_SCOPE_AGENT);
            __syncthreads();
            const int idx = (int)MISC[4];
            __syncthreads();
            if (idx >= N_P2) break;
            const int lane2 = tid2 & 63, wave2 = __builtin_amdgcn_readfirstlane(tid2 >> 6);
            if (idx < N_ATT_S + N_ATT_P) {
                att::AUnit U;
                if (idx < N_ATT_S) { const int b = idx >> 1; U.hg = idx & 1; U.sample = 1; U.nt = 9;
                    U.Qrow = Qb + (size_t)(RP + DS * b) * 512; U.Kb = KSb + (size_t)b * KSROWS * 512; U.Vb = VSb + (size_t)b * KSROWS * 512; U.Orow = MIXb + (size_t)(RP + DS * b) * D; }
                else { int u = idx - N_ATT_S, b, c;
                    if (u < 960) { U.hg = u & 1; const int rest = u >> 1; b = rest / 120; c = 8 + rest % 120; }
                    else { u -= 960; U.hg = u & 1; b = (u >> 1) & 3; c = 7 - (u >> 3); }
                    U.sample = 0; U.nt = (c < 8 ? c : 8) + 1; const size_t row0 = (size_t)b * SEQ + 64 * c, k0 = row0 - 64 * (U.nt - 1);
                    U.Qrow = Qb + row0 * 512; U.Kb = KPb + k0 * 512; U.Vb = VPb + k0 * 512; U.Orow = MIXb + row0 * D; }
                att::attn_unit(U, lds, wave2, lane2);
            } else conv_item(idx - (N_ATT_S + N_ATT_P), GLUb, args.in[6], args.in[12], args.in[13], args.in[14], args.in[15], MIXb, lds, tid2);
        }
    }
#endif
    xcd_barrier(bar);

#ifndef SKIP_P3
    {
        pg8::Gemm g{MIXb, WOt, R, D, D}; pg8::StaticOrder S; S.init(R, D, G, (int)blockIdx.x);
        pg8::EpiRes E{args.in[0], args.in[1], Y, XB, SS1};
        pg8::gemm_phase<pg8::EpiRes, pg8::StaticOrder, true, true>(lds + RING_OFF, g, S, E);
    }
#endif
    xcd_barrier(bar);

#ifndef SKIP_P4
    {
        pg8::Gemm g{XB, WGUt, R, 2 * DFF, D}; pg8::StaticOrder S; S.init(R, 2 * DFF, G, (int)blockIdx.x);
        pg8::EpiAct E{SS1, ACTb};
        pg8::gemm_phase<pg8::EpiAct, pg8::StaticOrder, true, true>(lds + RING_OFF, g, S, E);
    }
#endif
    xcd_barrier(bar);

#ifndef SKIP_P5
    {
        pg8::Gemm g{ACTb, WDt, R, D, DFF}; pg8::StaticOrder S; S.init(R, D, G, (int)blockIdx.x);
        pg8::EpiRes E{Y, Y + (size_t)RP * D, Y, XB, SS2};
        pg8::gemm_phase<pg8::EpiRes, pg8::StaticOrder, true, true>(lds + RING_OFF, g, S, E);
    }
#endif
    xcd_barrier(bar);

#ifndef SKIP_P6
    {
        pg8::Gemm g{XB, WPGt, R, D, D}; pg8::StaticOrder S; S.init(R, D, G, (int)blockIdx.x);
        pg8::EpiFinal E{SS2, PPb, Y};
        pg8::gemm_phase<pg8::EpiFinal, pg8::StaticOrder, true, true>(lds + RING_OFF, g, S, E);
    }
#endif
}

extern "C" void kernel_launch(void* const* d_in, const int* in_sizes, int n_in, void* d_out, int out_size, void* d_ws, size_t ws_size, hipStream_t stream) {
    static int grid = 0;
    if (grid == 0) {
        if (n_in != 23 || ws_size < WS_END) { fprintf(stderr, "kernel_launch: unexpected shapes (n_in %d, ws %zu)\n", n_in, ws_size); grid = -1; return; }
        int dev = 0, cus = 0, per_cu = 0;
        if (hipGetDevice(&dev) != hipSuccess || hipDeviceGetAttribute(&cus, hipDeviceAttributeMultiprocessorCount, dev) != hipSuccess) { grid = -1; return; }
        if (hipFuncSetAttribute((const void*)mk_fwd, hipFuncAttributeMaxDynamicSharedMemorySize, LDS_BYTES) != hipSuccess) { fprintf(stderr, "kernel_launch: hipFuncSetAttribute failed\n"); grid = -1; return; }
        if (hipOccupancyMaxActiveBlocksPerMultiprocessor(&per_cu, (const void*)mk_fwd, NWAVES * 64, LDS_BYTES) != hipSuccess || per_cu < 1) { fprintf(stderr, "kernel_launch: occupancy query says %d blocks per CU\n", per_cu); }
        (void)hipGetLastError();
        grid = cus;
    }
    if (grid < 0) return;
    if (hipMemsetAsync((char*)d_ws + WS_CTL, 0, CTL_ZERO_BYTES, stream) != hipSuccess) return;
    Args a{};
    for (int i = 0; i < 23; ++i) a.in[i] = (const float*)d_in[i];
    a.out = (float*)d_out; a.ws = (unsigned char*)d_ws;
    hipLaunchKernelGGL(mk_fwd, dim3(grid), dim3(NWAVES * 64), LDS_BYTES, stream, a);
}
```

```cpp
#include <hip/hip_runtime.h>
#include <cstdio>
#include <cstdint>
constexpr int D = 1024, SEQ = 8192, NB = 4, DB = 32, DS = 32;
constexpr int RP = NB * SEQ, RS = DB * DS, R = RP + RS;
constexpr int INC = 2560, DFF = 2816, PLE = 256, NH = 8, HD = 64, CW = 512;
constexpr int NREL = 257, CONVW = 31, CH = 30, KSROWS = 576;
constexpr int KVT_BYTES = 131072;
constexpr float EPS = 1e-6f, LOG2E = 1.4426950408889634f, QSCALE = 0.125f * LOG2E;
constexpr size_t OY = 0, OKP = (size_t)R * D, OVP = OKP + (size_t)NB * 512 * 512, OCP = OVP + (size_t)NB * 512 * 512,
                 OKS = OCP + (size_t)NB * CH * CW, OVS = OKS + (size_t)DB * 512 * 512, OCS = OVS + (size_t)DB * 512 * 512;
namespace pg8 {
#define PG8_LAS __attribute__((address_space(3)))
typedef unsigned short bf16_t;
typedef short bf16x8 __attribute__((ext_vector_type(8)));
typedef float f32x4 __attribute__((ext_vector_type(4)));
typedef unsigned u32x4 __attribute__((ext_vector_type(4)));
constexpr int BM = 256, BK = 64, HALF = 128, HTB = HALF * BK * 2  , STAGE_BYTES = 8 * HTB, NXCD = 8, WGM = 8;

__host__ __device__ __forceinline__ int lds_byte(int r, int c) { const int st = (r >> 4) * 2 + (c >> 5), rr = r & 15, cc = c & 31, ob = rr * 64 + cc * 2; return st * 1024 + (ob ^ (((ob >> 9) & 1) << 5)); }
__host__ __device__ __forceinline__ void stage_rc(int b, int& R, int& C) { const int st = b / 1024, sb = b % 1024, swz = sb ^ (((sb >> 9) & 1) << 5); R = (st >> 1) * 16 + swz / 64; C = (st & 1) * 32 + (swz % 64) / 2; }
__host__ __device__ __forceinline__ int perm32(int rho) { const int n = rho >> 4, i = rho & 15; return 8 * (i >> 2) + 4 * n + (i & 3); }

struct Unit { int pm, pn; };
struct Gemm { const bf16_t* A; const bf16_t* Bt; int M, N, K; };

struct StaticOrder {
    int nM, nN, nwg, G, c;
    __host__ __device__ void init(int M, int N, int G_, int c_) { nM = M / BM; nN = N / BM; nwg = nM * nN; G = G_; c = c_; }
    __host__ __device__ bool next(int i, Unit& u) const {
        const long L = (long)i * G + c; if (L >= nwg) return false;
        int wgid = (int)L; { const int q = nwg / NXCD, r = nwg % NXCD, xcd = wgid % NXCD, off = wgid / NXCD; wgid = (xcd < r ? xcd * (q + 1) : r * (q + 1) + (xcd - r) * q) + off; }
        const int nig = WGM * nN, gid = wgid / nig, fm = gid * WGM, gsz = (nM - fm) < WGM ? (nM - fm) : WGM;
        u.pm = fm + ((wgid % nig) % gsz); u.pn = (wgid % nig) / gsz; return true;
    }
    __device__ __forceinline__ void a_ready(const Unit&) const {}
    __device__ __forceinline__ void done(const Unit&) const {}
};

__device__ __forceinline__ unsigned cvt_pk_bf16(float lo, float hi) { unsigned r; asm volatile("v_cvt_pk_bf16_f32 %0, %1, %2" : "=v"(r) : "v"(lo), "v"(hi)); return r; }
typedef float f32x2 __attribute__((ext_vector_type(2)));typedef unsigned u32x2 __attribute__((ext_vector_type(2)));
__device__ __forceinline__ u32x4 pack8(const f32x4 a, const f32x4 b) { u32x4 w; w.x = cvt_pk_bf16(a[0], a[1]); w.y = cvt_pk_bf16(a[2], a[3]); w.z = cvt_pk_bf16(b[0], b[1]); w.w = cvt_pk_bf16(b[2], b[3]); return w; }
__device__ __forceinline__ float sigm(float x) { return __builtin_amdgcn_rcpf(1.0f + __builtin_amdgcn_exp2f(-x * LOG2E)); }
__device__ __forceinline__ float quad_sum(float s) { s += __shfl_xor(s, 16); s += __shfl_xor(s, 32); return s; }
struct Epi1 {
    static constexpr bool PERM = true, AFTER_DRAIN = false;
    const float* rx; const float* qg; const float* kg; bf16_t* Q; unsigned char* KVP; unsigned char* KVS; bf16_t* GLU; float* out;
    __device__ __forceinline__ void operator()(const f32x4 (&acc)[2][2][4][2], const Unit& u, int wr, int wc, int fr, int fq) const {
        const int pn = u.pn, rowt = u.pm * BM + wr * 64 + fr;
        if (pn < 6) {
            const int sec = pn >> 1, col = (4 * (pn & 1) + wc) * 64 + 8 * fq;
            f32x4 g[2][2];
#pragma unroll
            for (int bj = 0; bj < 2; ++bj)
#pragma unroll
                for (int n = 0; n < 2; ++n) { g[bj][n] = (f32x4){1.f, 1.f, 1.f, 1.f};
                    if (sec == 0) g[bj][n] = *(const f32x4*)(qg + 32 * bj + 8 * fq + 4 * n) * QSCALE;
                    if (sec == 1) g[bj][n] = *(const f32x4*)(kg + 32 * bj + 8 * fq + 4 * n); }
#pragma unroll
            for (int ai = 0; ai < 2; ++ai)
#pragma unroll
                for (int m = 0; m < 4; ++m) {
                    const int row = rowt + ai * HALF + m * 16; const float r = rx[row];
                    f32x4 z[2][2];
#pragma unroll
                    for (int bj = 0; bj < 2; ++bj)
#pragma unroll
                        for (int n = 0; n < 2; ++n) z[bj][n] = acc[ai][bj][m][n] * r;
                    if (sec < 2) {
                        float ss = 0.f;
#pragma unroll
                        for (int bj = 0; bj < 2; ++bj)
#pragma unroll
                            for (int n = 0; n < 2; ++n) { const f32x4 q = z[bj][n] * z[bj][n]; ss += (q[0] + q[1]) + (q[2] + q[3]); }
                        ss = quad_sum(ss);
                        const float rn = rsqrtf(ss * (1.0f / 64.0f) + EPS);
#pragma unroll
                        for (int bj = 0; bj < 2; ++bj)
#pragma unroll
                            for (int n = 0; n < 2; ++n) z[bj][n] = z[bj][n] * rn * g[bj][n];
                    }
                    const int sb = (row - RP) >> 5, si = (row - RP) & 31;
                    float* fo = nullptr;
                    if (sec == 0) {
#pragma unroll
                        for (int bj = 0; bj < 2; ++bj) *(u32x4*)(Q + (size_t)row * 512 + col + 32 * bj) = pack8(z[bj][0], z[bj][1]);
                    } else {
                        unsigned char* tb; int kv;
                        if (row < RP) { tb = KVP + (size_t)(row >> 6) * KVT_BYTES; kv = row & 63;
                            const int t = row & (SEQ - 1); if (t >= SEQ - 512) fo = out + OKP + (size_t)(sec - 1) * (OVP - OKP) + ((size_t)((row >> 13) * 512 + (t - (SEQ - 512)))) * 512 + col; }
                        else { tb = KVS + (size_t)(sb * 9 + 8) * KVT_BYTES; kv = si; fo = out + OKS + (size_t)(sec - 1) * (OVS - OKS) + ((size_t)(sb * 512 + 480 + si)) * 512 + col; }
                        tb += (pn & 1) * 65536 + wc * 16384;
                        const int ok = fq * 1024 + kv * 16, ov = 8192 + (kv >> 4) * 1024 + (kv & 15) * 64 + fq * 16;
#pragma unroll
                        for (int bj = 0; bj < 2; ++bj) *(u32x4*)(tb + (sec == 1 ? ok + bj * 4096 : ov + bj * 4096)) = pack8(z[bj][0], z[bj][1]);
                    }
                    if (fo) {
#pragma unroll
                        for (int bj = 0; bj < 2; ++bj)
#pragma unroll
                            for (int n = 0; n < 2; ++n) *(f32x4*)(fo + 32 * bj + 4 * n) = z[bj][n]; }
                    asm volatile("" ::: "memory");
                }
        } else {
            const int col = 128 * (pn - 6) + 32 * wc + 8 * fq;
#pragma unroll
            for (int ai = 0; ai < 2; ++ai)
#pragma unroll
                for (int m = 0; m < 4; ++m) {
                    const int row = rowt + ai * HALF + m * 16; const float r = rx[row];
                    f32x4 gl[2];
#pragma unroll
                    for (int n = 0; n < 2; ++n) { const f32x4 a = acc[ai][0][m][n] * r, b = acc[ai][1][m][n] * r;
#pragma unroll
                        for (int e = 0; e < 4; ++e) gl[n][e] = a[e] * sigm(b[e]); }
                    *(u32x4*)(GLU + (size_t)row * 512 + col) = pack8(gl[0], gl[1]);
                    float* fo = nullptr;
                    if (row < RP) { const int t = row & (SEQ - 1); if (t >= SEQ - CH) fo = out + OCP + ((size_t)((row >> 13) * CH + (t - (SEQ - CH)))) * CW + col; }
                    else { const int sb = (row - RP) >> 5, si = (row - RP) & 31; if (si >= DS - CH) fo = out + OCS + ((size_t)(sb * CH + (si - (DS - CH)))) * CW + col; }
                    if (fo) { *(f32x4*)(fo) = gl[0]; *(f32x4*)(fo + 4) = gl[1]; }
                    asm volatile("" ::: "memory");
                }
        }
    }
};
struct EpiPP {
    static constexpr bool PERM = true, AFTER_DRAIN = false;
    bf16_t* O;
    __device__ __forceinline__ void operator()(const f32x4 (&acc)[2][2][4][2], const Unit& u, int wr, int wc, int fr, int fq) const {
        const int rowt = u.pm * BM + wr * 64 + fr, col = u.pn * BM + 32 * wc + 8 * fq;
#pragma unroll
        for (int ai = 0; ai < 2; ++ai)
#pragma unroll
            for (int m = 0; m < 4; ++m) { bf16_t* rowp = O + (size_t)(rowt + ai * HALF + m * 16) * D + col;
#pragma unroll
                for (int bj = 0; bj < 2; ++bj) *(u32x4*)(rowp + bj * HALF) = pack8(acc[ai][bj][m][0], acc[ai][bj][m][1]); }
    }
};
__device__ __forceinline__ f32x4 bf_lo4(const u32x4 w) { return (f32x4){__uint_as_float(w.x << 16), __uint_as_float(w.x & 0xffff0000u), __uint_as_float(w.y << 16), __uint_as_float(w.y & 0xffff0000u)}; }
__device__ __forceinline__ f32x4 bf_hi4(const u32x4 w) { return (f32x4){__uint_as_float(w.z << 16), __uint_as_float(w.z & 0xffff0000u), __uint_as_float(w.w << 16), __uint_as_float(w.w & 0xffff0000u)}; }
template <bool BF> struct EpiRes {
    static constexpr bool PERM = true, AFTER_DRAIN = false;
    const float* bp; const float* bs; bf16_t* HB; float* SS;
    __device__ __forceinline__ void operator()(const f32x4 (&acc)[2][2][4][2], const Unit& u, int wr, int wc, int fr, int fq) const {
        const int rowt = u.pm * BM + wr * 64 + fr, col = u.pn * BM + 32 * wc + 8 * fq;
#pragma unroll
        for (int ai = 0; ai < 2; ++ai)
#pragma unroll
            for (int m = 0; m < 4; ++m) {
                const int row = rowt + ai * HALF + m * 16;
                const float* brow = (row < RP ? bp + (size_t)row * D : bs + (size_t)(row - RP) * D) + col;
                bf16_t* hrow = HB + (size_t)row * D + col;
                float ss = 0.f;
#pragma unroll
                for (int bj = 0; bj < 2; ++bj) {
                    f32x4 v0, v1;
                    if (BF) { const u32x4 w = *(const u32x4*)(hrow + bj * HALF); v0 = bf_lo4(w); v1 = bf_hi4(w); }
                    else { v0 = *(const f32x4*)(brow + bj * HALF); v1 = *(const f32x4*)(brow + bj * HALF + 4); }
                    v0 = v0 + acc[ai][bj][m][0]; v1 = v1 + acc[ai][bj][m][1];
                    *(u32x4*)(hrow + bj * HALF) = pack8(v0, v1);
                    const f32x4 q0 = v0 * v0, q1 = v1 * v1; ss += ((q0[0] + q0[1]) + (q0[2] + q0[3])) + ((q1[0] + q1[1]) + (q1[2] + q1[3]));
                }
                ss = quad_sum(ss);
                if (fq == 0) SS[(size_t)row * 16 + 4 * u.pn + wc] = ss;
            }
    }
};
__device__ __forceinline__ float row_rs(const float* SS, int row, int fq) {
    const f32x4 s4 = *(const f32x4*)(SS + (size_t)row * 16 + 4 * fq);
    return rsqrtf(quad_sum((s4[0] + s4[1]) + (s4[2] + s4[3])) * (1.0f / D) + EPS);
}
struct EpiAct {
    static constexpr bool PERM = true, AFTER_DRAIN = false;
    const float* SS; bf16_t* ACT;
    __device__ __forceinline__ void operator()(const f32x4 (&acc)[2][2][4][2], const Unit& u, int wr, int wc, int fr, int fq) const {
        const int rowt = u.pm * BM + wr * 64 + fr, col = 128 * u.pn + 32 * wc + 8 * fq;
#pragma unroll
        for (int ai = 0; ai < 2; ++ai)
#pragma unroll
            for (int m = 0; m < 4; ++m) {
                const int row = rowt + ai * HALF + m * 16; const float r = row_rs(SS, row, fq);
                f32x4 v[2];
#pragma unroll
                for (int n = 0; n < 2; ++n) { const f32x4 g = acc[ai][0][m][n] * r, up = acc[ai][1][m][n] * r;
#pragma unroll
                    for (int e = 0; e < 4; ++e) v[n][e] = g[e] * sigm(g[e]) * up[e]; }
                *(u32x4*)(ACT + (size_t)row * DFF + col) = pack8(v[0], v[1]);
            }
    }
};
struct EpiFinal {
    static constexpr bool PERM = true, AFTER_DRAIN = false;
    const float* SS; const bf16_t* PP; const bf16_t* HB; float* Y;
    __device__ __forceinline__ void operator()(const f32x4 (&acc)[2][2][4][2], const Unit& u, int wr, int wc, int fr, int fq) const {
        const int rowt = u.pm * BM + wr * 64 + fr, col = u.pn * BM + 32 * wc + 8 * fq;
#pragma unroll
        for (int ai = 0; ai < 2; ++ai)
#pragma unroll
            for (int m = 0; m < 4; ++m) {
                const int row = rowt + ai * HALF + m * 16; const float r = row_rs(SS, row, fq);
#pragma unroll
                for (int bj = 0; bj < 2; ++bj) {
                    const size_t o = (size_t)row * D + col + bj * HALF;
                    const u32x4 pw = *(const u32x4*)(PP + o), hw = *(const u32x4*)(HB + o);
                    const f32x4 a0 = acc[ai][bj][m][0] * r, a1 = acc[ai][bj][m][1] * r, p0 = bf_lo4(pw), p1 = bf_hi4(pw);
                    f32x4 h0 = bf_lo4(hw), h1 = bf_hi4(hw);
#pragma unroll
                    for (int e2 = 0; e2 < 4; ++e2) { h0[e2] += sigm(a0[e2]) * p0[e2]; h1[e2] += sigm(a1[e2]) * p1[e2]; }
                    *(f32x4*)(Y + o) = h0; *(f32x4*)(Y + o + 4) = h1;
                }
            }
    }
};

template <class Epi, class Sched, bool ALIGN_EPI = false, bool SP2 = false>
__device__ __forceinline__ void gemm_phase(PG8_LAS unsigned char* lds, const Gemm g, const Sched& S, const Epi& E) {
    int tid_ = threadIdx.x; asm volatile("" : "+v"(tid_));
    const int tid = tid_, wid = __builtin_amdgcn_readfirstlane(tid >> 6), lane = tid & 63, wr = wid >> 2, wc = wid & 3, fr = lane & 15, fq = lane >> 4;
    int K_ = g.K; asm volatile("" : "+s"(K_));
    const int K = K_, nt = K / BK;
    unsigned voffA[2], voffB[2];
#pragma unroll
    for (int i = 0; i < 2; ++i) { int R, C; stage_rc(tid * 16 + i * 8192, R, C); const int Rb = Epi::PERM ? ((R & ~31) + perm32(R & 31)) : R;
        voffA[i] = (unsigned)(R * K + C) * 2u; voffB[i] = (unsigned)(Rb * K + C) * 2u; }
    const size_t kstep = (size_t)(BK * 2);
    const size_t hstep = (size_t)HALF * K * 2;
    const size_t tstep = 2 * hstep;
    const unsigned ldsw = (unsigned)wid * 1024u;
    const int aoff = lds_byte(wr * 64 + fr, fq * 8), boff = lds_byte(wc * 32 + fr, fq * 8);
#define PG8_SA(b, h) (((b) * 2 + (h)) * HTB)
#define PG8_SB(b, h) ((4 + (b) * 2 + (h)) * HTB)
#define PG8_STAGE(bufoff, gbase, voff) do { _Pragma("unroll") for (int _i = 0; _i < 2; ++_i) \
        __builtin_amdgcn_global_load_lds((const unsigned*)((const char*)(gbase) + (voff)[_i]), (PG8_LAS unsigned*)(lds + (bufoff) + ldsw + _i * 8192), 16, 0, 0); } while (0)
#define PG8_LDA(dst, b, h) do { _Pragma("unroll") for (int m = 0; m < 4; ++m) _Pragma("unroll") for (int k = 0; k < 2; ++k) dst[m][k] = *(const PG8_LAS bf16x8*)(lds + PG8_SA(b, h) + aoff + m * 2048 + k * 1024); } while (0)
#define PG8_LDB(dst, b, h) do { _Pragma("unroll") for (int n = 0; n < 2; ++n) _Pragma("unroll") for (int k = 0; k < 2; ++k) dst[n][k] = *(const PG8_LAS bf16x8*)(lds + PG8_SB(b, h) + boff + n * 2048 + k * 1024); } while (0)
#define PG8_MMA(ai, bj, At, Bt) do { __builtin_amdgcn_s_setprio(1); _Pragma("unroll") for (int m = 0; m < 4; ++m) _Pragma("unroll") for (int n = 0; n < 2; ++n) _Pragma("unroll") for (int k = 0; k < 2; ++k) \
        acc[ai][bj][m][n] = __builtin_amdgcn_mfma_f32_16x16x32_bf16(Bt[n][k], At[m][k], acc[ai][bj][m][n], 0, 0, 0); __builtin_amdgcn_s_setprio(0); } while (0)
#define PG8_WAIT_V(n) asm volatile("s_waitcnt vmcnt(" #n ")" ::: "memory")
#define PG8_WAIT_L(n) asm volatile("s_waitcnt lgkmcnt(" #n ")" ::: "memory")
#define PG8_BAR __builtin_amdgcn_s_barrier()
#define PG8_SCHED __builtin_amdgcn_sched_barrier(0)
    Unit cur, nxt; int ui = 0;
    if (!S.next(0, cur)) return;
    f32x4 acc[2][2][4][2];
#pragma unroll
    for (int a = 0; a < 2; ++a)
#pragma unroll
        for (int b = 0; b < 2; ++b)
#pragma unroll
            for (int m = 0; m < 4; ++m)
#pragma unroll
                for (int n = 0; n < 2; ++n) acc[a][b][m][n] = (f32x4){0.f, 0.f, 0.f, 0.f};
    bf16x8 At[4][2], B0[2][2], B1[2][2];
    const char* cA = (const char*)g.A + (size_t)cur.pm * tstep; const char* cB = (const char*)g.Bt + (size_t)cur.pn * tstep;
    S.a_ready(cur);
    if constexpr (SP2) {
        PG8_STAGE(PG8_SB(0, 0), cB, voffB); PG8_STAGE(PG8_SB(0, 1), cB + hstep, voffB); PG8_STAGE(PG8_SA(0, 0), cA, voffA); PG8_STAGE(PG8_SA(0, 1), cA + hstep, voffA);
        if (wr == 1) PG8_BAR;
        PG8_WAIT_V(2); PG8_BAR;
        PG8_STAGE(PG8_SB(1, 0), cB + kstep, voffB); PG8_STAGE(PG8_SA(1, 0), cA + kstep, voffA); PG8_STAGE(PG8_SB(1, 1), cB + hstep + kstep, voffB);
        PG8_WAIT_V(6); PG8_BAR;
    } else {
        PG8_STAGE(PG8_SB(0, 0), cB, voffB); PG8_STAGE(PG8_SA(0, 0), cA, voffA); PG8_STAGE(PG8_SB(0, 1), cB + hstep, voffB); PG8_STAGE(PG8_SA(0, 1), cA + hstep, voffA);
        if (wr == 1) PG8_BAR;
        PG8_WAIT_V(4); PG8_BAR;
        PG8_STAGE(PG8_SB(1, 0), cB + kstep, voffB); PG8_STAGE(PG8_SA(1, 0), cA + kstep, voffA); PG8_STAGE(PG8_SB(1, 1), cB + hstep + kstep, voffB);
        PG8_WAIT_V(6); PG8_BAR;
    }
    for (;;) {
        const bool has_next = S.next(ui + 1, nxt);
        const char* nA = has_next ? (const char*)g.A + (size_t)nxt.pm * tstep : cA; const char* nB = has_next ? (const char*)g.Bt + (size_t)nxt.pn * tstep : cB;
        for (int t = 0; t < nt; t += 2) {
            const bool last = (t == nt - 2);
            const char* a1 = cA + (size_t)(t + 1) * kstep;
            const char* a2 = last ? nA : cA + (size_t)(t + 2) * kstep; const char* b2 = last ? nB : cB + (size_t)(t + 2) * kstep;
            const char* a3 = a2 + kstep; const char* b3 = b2 + kstep;
            if (last && has_next) S.a_ready(nxt);
            if constexpr (SP2) {
            PG8_LDB(B0, 0, 0); PG8_LDB(B1, 0, 1); PG8_SCHED; PG8_LDA(At, 0, 0); PG8_STAGE(PG8_SA(1, 1), a1 + hstep, voffA);
            PG8_WAIT_V(8); PG8_WAIT_L(0); PG8_BAR; PG8_MMA(0, 0, At, B0); PG8_MMA(0, 1, At, B1); PG8_BAR; PG8_SCHED;
            PG8_LDA(At, 0, 1); PG8_STAGE(PG8_SB(0, 0), b2, voffB); PG8_STAGE(PG8_SB(0, 1), b2 + hstep, voffB); PG8_STAGE(PG8_SA(0, 0), a2, voffA);
            PG8_WAIT_V(8); PG8_WAIT_L(0); PG8_BAR; PG8_MMA(1, 0, At, B0); PG8_MMA(1, 1, At, B1); PG8_BAR; PG8_SCHED;
            PG8_LDB(B0, 1, 0); PG8_LDB(B1, 1, 1); PG8_SCHED; PG8_LDA(At, 1, 0); PG8_STAGE(PG8_SA(0, 1), a2 + hstep, voffA);
            PG8_WAIT_V(8); PG8_WAIT_L(0); PG8_BAR; PG8_MMA(0, 0, At, B0); PG8_MMA(0, 1, At, B1); PG8_BAR; PG8_SCHED;
            PG8_LDA(At, 1, 1); PG8_STAGE(PG8_SB(1, 0), b3, voffB); PG8_STAGE(PG8_SB(1, 1), b3 + hstep, voffB); PG8_STAGE(PG8_SA(1, 0), a3, voffA);
            PG8_WAIT_V(8); PG8_WAIT_L(0); PG8_BAR; PG8_MMA(1, 0, At, B0); PG8_MMA(1, 1, At, B1); PG8_BAR; PG8_SCHED;
            } else {
            PG8_LDB(B0, 0, 0); PG8_SCHED; PG8_LDA(At, 0, 0); PG8_STAGE(PG8_SA(1, 1), a1 + hstep, voffA);
            PG8_WAIT_L(8); PG8_BAR; PG8_WAIT_L(0); PG8_MMA(0, 0, At, B0); PG8_BAR; PG8_SCHED;
            PG8_LDB(B1, 0, 1); PG8_STAGE(PG8_SB(0, 0), b2, voffB);
            PG8_BAR; PG8_WAIT_L(0); PG8_MMA(0, 1, At, B1); PG8_BAR;
            PG8_LDA(At, 0, 1); PG8_STAGE(PG8_SA(0, 0), a2, voffA);
            PG8_BAR; PG8_WAIT_L(0); PG8_MMA(1, 0, At, B0); PG8_BAR; PG8_SCHED;
            PG8_STAGE(PG8_SB(0, 1), b2 + hstep, voffB);
            PG8_WAIT_V(6); PG8_BAR; PG8_MMA(1, 1, At, B1); PG8_BAR;
            PG8_LDB(B0, 1, 0); PG8_SCHED; PG8_LDA(At, 1, 0); PG8_STAGE(PG8_SA(0, 1), a2 + hstep, voffA);
            PG8_WAIT_L(8); PG8_BAR; PG8_WAIT_L(0); PG8_MMA(0, 0, At, B0); PG8_BAR; PG8_SCHED;
            PG8_LDB(B1, 1, 1); PG8_STAGE(PG8_SB(1, 0), b3, voffB);
            PG8_BAR; PG8_WAIT_L(0); PG8_MMA(0, 1, At, B1); PG8_BAR;
            PG8_LDA(At, 1, 1); PG8_STAGE(PG8_SA(1, 0), a3, voffA);
            PG8_BAR; PG8_WAIT_L(0); PG8_MMA(1, 0, At, B0); PG8_BAR; PG8_SCHED;
            PG8_STAGE(PG8_SB(1, 1), b3 + hstep, voffB);
            PG8_WAIT_V(6); PG8_BAR; PG8_MMA(1, 1, At, B1); PG8_BAR;
            }
        }
        if constexpr (ALIGN_EPI) { if (wr == 0) PG8_BAR; }
        if constexpr (!Epi::AFTER_DRAIN) { E(acc, cur, wr, wc, fr, fq); S.done(cur); }
        if (!has_next) break;
#pragma unroll
        for (int a = 0; a < 2; ++a)
#pragma unroll
            for (int b = 0; b < 2; ++b)
#pragma unroll
                for (int m = 0; m < 4; ++m)
#pragma unroll
                    for (int n = 0; n < 2; ++n) acc[a][b][m][n] = (f32x4){0.f, 0.f, 0.f, 0.f};
        cur = nxt; cA = nA; cB = nB; ++ui;
        if constexpr (ALIGN_EPI) { if (wr == 1) PG8_BAR; }
    }
    PG8_WAIT_V(0);
    if constexpr (!ALIGN_EPI) { if (wr == 0) PG8_BAR; }
    PG8_BAR;
    if constexpr (Epi::AFTER_DRAIN) { E.fused(acc, cur, wr, wc, fr, fq, lds, wid, lane); S.done(cur); }
#undef PG8_SA
#undef PG8_SB
#undef PG8_STAGE
#undef PG8_LDA
#undef PG8_LDB
#undef PG8_MMA
#undef PG8_WAIT_V
#undef PG8_WAIT_L
#undef PG8_BAR
#undef PG8_SCHED
}
}
#define GAS __attribute__((address_space(1)))
#define LAS __attribute__((address_space(3)))
typedef unsigned short bf16;
typedef unsigned v4u __attribute__((ext_vector_type(4)));
typedef float f32x4 __attribute__((ext_vector_type(4)));
typedef short bf16x8 __attribute__((ext_vector_type(8)));
typedef GAS unsigned gu32;
typedef GAS unsigned long long gu64;
#define RLX_AGENT __ATOMIC_RELAXED, __HIP_MEMORY_SCOPE_AGENT
#define LDS_WAIT() asm volatile("s_waitcnt lgkmcnt(0)" ::: "memory")
#define VM_WAIT() asm volatile("s_waitcnt vmcnt(0)" ::: "memory")
__device__ __forceinline__ unsigned long long rt() { return __builtin_amdgcn_s_memrealtime(); }
__device__ __forceinline__ unsigned f2bf(float f) { unsigned u = __builtin_bit_cast(unsigned, f); return (u + 0x7fffu + ((u >> 16) & 1u)) >> 16; }
__device__ __forceinline__ unsigned pk2(float lo, float hi) { return f2bf(lo) | (f2bf(hi) << 16); }
#define XB_TMO      128
#define XB_XCNT(j)  (256  + 64 * (j))
#define XB_XSUB(j)  (1280 + 64 * (j))
#define XB_XGEN(j)  (2304 + 64 * (j))
#define XB_TOP      3328
#define XB_TOPGEN   3392
#define XCD_BAR_WORDS 3456
#define XB_SPIN_CAP (1u << 18)

__device__ __forceinline__ unsigned xb_ld(unsigned* p)              { return __hip_atomic_load(p, __ATOMIC_RELAXED, __HIP_MEMORY_SCOPE_AGENT); }
__device__ __forceinline__ unsigned xb_add(unsigned* p, unsigned v) { return __hip_atomic_fetch_add(p, v, __ATOMIC_RELAXED, __HIP_MEMORY_SCOPE_AGENT); }
__device__ __forceinline__ unsigned xb_xcc_id() { return (unsigned)__builtin_amdgcn_s_getreg((3 << 11) | 20) & 0xFu; }
#define XB_SPIN(cond, bar) do { unsigned _sp = 0; while (cond) { __builtin_amdgcn_s_sleep(1); \
    if ((++_sp & 255u) == 0u) { if (xb_ld(&(bar)[XB_TMO])) break; if (_sp > XB_SPIN_CAP) { atomicAdd(&(bar)[XB_TMO], 1u); break; } } } } while (0)

struct XcdBarrier {
    unsigned* bar; unsigned x;
    volatile LAS unsigned* st;
};

__device__ __forceinline__ XcdBarrier xcd_barrier_post(unsigned* bar, volatile LAS unsigned* st) {
    XcdBarrier b; b.bar = bar; b.x = xb_xcc_id(); b.st = st;
    if (threadIdx.x == 0) (void)xb_add(&bar[XB_XCNT(b.x)], 1u);
    return b;
}
__device__ __forceinline__ void xcd_barrier_complete(unsigned* bar, unsigned x, unsigned& nloc, unsigned& nx) {
    const unsigned G = gridDim.x * gridDim.y * gridDim.z;
    unsigned sum, cnt, mine, sp = 0u;
    for (;;) {
        sum = 0u; cnt = 0u; mine = 0u;
#pragma unroll
        for (unsigned j = 0; j < 16; ++j) { const unsigned c = xb_ld(&bar[XB_XCNT(j)]); sum += c; cnt += (c > 0u) ? 1u : 0u; mine = (j == x) ? c : mine; }
        if (sum == G) break;
        __builtin_amdgcn_s_sleep(1);
        if ((++sp & 255u) == 0u) { if (xb_ld(&bar[XB_TMO])) break; if (sp > XB_SPIN_CAP) { atomicAdd(&bar[XB_TMO], 1u); break; } }
    }
    nloc = mine > 0u ? mine : 1u; nx = cnt > 0u ? cnt : 1u;
}

__device__ __forceinline__ void xcd_barrier(const XcdBarrier& b) {
    asm volatile("s_waitcnt vmcnt(0)" ::: "memory");
    __syncthreads();
    if (threadIdx.x == 0) {
        unsigned* bar = b.bar;
        __builtin_amdgcn_s_waitcnt(0);
        unsigned nloc = b.st[0], nx = b.st[1];
        if (nloc == 0u) { xcd_barrier_complete(bar, b.x, nloc, nx); b.st[0] = nloc; b.st[1] = nx; }
        const unsigned old = xb_add(&bar[XB_XSUB(b.x)], 1u);
        const unsigned gen = old / nloc;
        if (old + 1u == (gen + 1u) * nloc) {
            __builtin_amdgcn_fence(__ATOMIC_RELEASE, "agent");
            asm volatile("s_waitcnt vmcnt(0)" ::: "memory");
            const unsigned og = xb_add(&bar[XB_TOP], 1u);
            const unsigned tg = og / nx;
            if (og + 1u == (tg + 1u) * nx) xb_add(&bar[XB_TOPGEN], 1u);
            else XB_SPIN(xb_ld(&bar[XB_TOPGEN]) == tg, bar);
            __builtin_amdgcn_fence(__ATOMIC_ACQUIRE, "agent");
            xb_add(&bar[XB_XGEN(b.x)], 1u);
            asm volatile("s_waitcnt vmcnt(0)" ::: "memory");
        } else {
            XB_SPIN(xb_ld(&bar[XB_XGEN(b.x)]) == gen, bar);
            __builtin_amdgcn_fence(__ATOMIC_ACQUIRE, "agent");
            asm volatile("s_waitcnt vmcnt(0)" ::: "memory");
        }
    }
    __syncthreads();
}
constexpr int NWAVES = 8;
constexpr size_t MiB = 1u << 20;
constexpr size_t WS_CTL = 0, CTL_ZERO_BYTES = 1 * MiB;
constexpr size_t WS_W1 = 1 * MiB, WS_WO = 6 * MiB, WS_WGU = 8 * MiB, WS_WD = 19 * MiB, WS_WPG = 25 * MiB, WS_WPP = 27 * MiB;
constexpr size_t WS_RX = 28 * MiB, WS_SS1 = 29 * MiB, WS_SS2 = 32 * MiB;
constexpr size_t WS_XB = 36 * MiB;
constexpr size_t WS_PB = 102 * MiB, WS_PP = 119 * MiB;
constexpr size_t WS_Q = 185 * MiB, WS_KP = 218 * MiB, WS_VP = 250 * MiB, WS_KS = 282 * MiB, WS_VS = 300 * MiB, WS_GLU = 318 * MiB, WS_MIX = 351 * MiB;
constexpr size_t WS_ACT = 185 * MiB;
constexpr size_t WS_END = 417 * MiB;
static_assert(WS_XB + (size_t)R * D * 2 <= WS_PB && WS_PB + (size_t)R * PLE * 2 <= WS_PP && WS_PP + (size_t)R * D * 2 <= WS_Q && WS_Q + (size_t)R * 512 * 2 <= WS_KP &&
              WS_KP + (size_t)(RP / 64) * KVT_BYTES <= WS_KS && WS_KS + (size_t)DB * 9 * KVT_BYTES <= WS_GLU && WS_GLU + (size_t)R * 512 * 2 <= WS_MIX &&
              WS_MIX + (size_t)R * D * 2 <= WS_END && WS_ACT + (size_t)R * DFF * 2 <= WS_END && WS_SS1 + (size_t)R * 64 <= WS_SS2 && WS_SS2 + (size_t)R * 64 <= WS_XB && WS_RX + (size_t)R * 4 <= WS_SS1, "d_ws map");
constexpr int CW_BAR = 4096, CW_Q = 8192;
constexpr int RING_OFF = 0, RING_BYTES = 131072;
constexpr int LDSCTL_OFF = RING_BYTES, MISC_OFF = LDSCTL_OFF + 320;
constexpr int ATT_TAB = 132096, ATT_LSC = ATT_TAB + 8192;
constexpr int LDS_BYTES = 147456;
static_assert(ATT_LSC + 2048 <= LDS_BYTES && MISC_OFF + 128 <= ATT_TAB, "LDS map");

__device__ __forceinline__ float wave_sum(float v) {
#pragma unroll
    for (int o = 1; o < 64; o <<= 1) v += __shfl_xor(v, o);
    return v;
}
__device__ __forceinline__ float wave_max(float v) {
#pragma unroll
    for (int o = 1; o < 64; o <<= 1) v = fmaxf(v, __shfl_xor(v, o));
    return v;
}
__device__ __forceinline__ int map_win(int n) {
    if (n < 1536) { const int sec = n >> 9, nn = n & 511, h = nn >> 6, d = nn & 63; return sec * 512 + 256 * (h >> 2) + 128 * (d >> 5) + 32 * (h & 3) + (d & 31); }
    if (n < 2048) { const int i = n - 1536; return 1536 + 256 * (i >> 7) + (i & 127); }
    const int i = n - 2048; return 1536 + 256 * (i >> 7) + 128 + (i & 127);
}
__device__ __forceinline__ int map_gu(int n) {
    if (n < DFF) return 256 * (n >> 7) + (n & 127);
    const int i = n - DFF; return 256 * (i >> 7) + 128 + (i & 127);
}
template <int MAP> __device__ __forceinline__ void p0_transpose_item(const float* W, const float* gain, int K, int N, bf16* WT, LAS float* scr, int item, int lane) {
    const int nblk = N / 32, kb = item / nblk, nb = item % nblk, k0 = 64 * kb, n0 = 32 * nb;
    { const int nq = lane & 7, kr = lane >> 3; f32x4 v[8];
#pragma unroll
      for (int i = 0; i < 8; ++i) v[i] = *(const GAS f32x4*)(W + (size_t)(k0 + 8 * i + kr) * N + n0 + 4 * nq);
#pragma unroll
      for (int i = 0; i < 8; ++i) { const int kk = 8 * i + kr; const float gk = gain ? gain[k0 + kk] : 1.0f;
#pragma unroll
          for (int e = 0; e < 4; ++e) scr[kk * 33 + 4 * nq + e] = v[i][e] * gk; } }
    LDS_WAIT(); asm volatile("" ::: "memory");
    const int c = lane & 7;
#pragma unroll
    for (int j = 0; j < 4; ++j) { const int n = (lane >> 3) + 8 * j; const LAS float* s = scr + (8 * c) * 33 + n;
        v4u o; o.x = pk2(s[0 * 33], s[1 * 33]); o.y = pk2(s[2 * 33], s[3 * 33]); o.z = pk2(s[4 * 33], s[5 * 33]); o.w = pk2(s[6 * 33], s[7 * 33]);
        const int ns = n0 + n, dr = MAP == 0 ? ns : (MAP == 1 ? map_win(ns) : map_gu(ns));
        *(GAS v4u*)(WT + (size_t)dr * K + k0 + 8 * c) = o; }
    LDS_WAIT(); asm volatile("" ::: "memory");
}

namespace att {
typedef short bf16x8 __attribute__((ext_vector_type(8)));
typedef short s16x4 __attribute__((ext_vector_type(4)));
typedef float f32x16 __attribute__((ext_vector_type(16)));
typedef unsigned u32x4 __attribute__((ext_vector_type(4)));
typedef float f32x2_t __attribute__((ext_vector_type(2))); typedef __bf16 bf16x2_t __attribute__((ext_vector_type(2)));
typedef short v4i16_t __attribute__((ext_vector_type(4)));
typedef LAS const char* lds_cptr;
constexpr int BUFB = 65536, HSLOT = 16384;
__device__ __forceinline__ int crow(int r, int hi) { return (r & 3) + 8 * (r >> 2) + 4 * hi; }
__device__ __forceinline__ void glds16(const void* gsrc, unsigned lds_dst) { unsigned keep;
    asm volatile("s_mov_b32 %0, m0\n\ts_mov_b32 m0, %2\n\ts_nop 0\n\tglobal_load_lds_dwordx4 %1, off\n\ts_mov_b32 m0, %0" : "=&s"(keep) : "v"(gsrc), "s"(lds_dst) : "memory"); }
__device__ __forceinline__ unsigned cvtpk_s(float lo, float hi) { f32x2_t v = {lo, hi}; bf16x2_t b = __builtin_convertvector(v, bf16x2_t); return __builtin_bit_cast(unsigned, b); }
__device__ __forceinline__ s16x4 vtr(lds_cptr p) { return __builtin_bit_cast(s16x4, __builtin_amdgcn_ds_read_tr16_b64_v4i16((LAS v4i16_t*)p)); }
#define ATT_WAIT_BAR() asm volatile("s_waitcnt vmcnt(0) lgkmcnt(0)\n\ts_barrier" ::: "memory")

struct AUnit { const bf16* Qrow; const unsigned char* KV; bf16* Orow; int nt, hg, sample; };

__device__ __forceinline__ void attn_unit(const AUnit& U, LAS unsigned char* lds, int wid, int lane) {
    const int r32 = lane & 31, hi = lane >> 5, hl = wid & 3, qh = wid >> 2, head = 4 * U.hg + hl, nt = U.nt;
    const bool active = !U.sample || qh == 0;
    const unsigned lds0 = (unsigned)(size_t)lds;
    const LAS float* tabh = (const LAS float*)(lds + ATT_TAB) + head * 256;
    LAS float* lsc = (LAS float*)(lds + ATT_LSC) + wid * 64;
    bf16x8 qr[4];
    { const bf16* Qw = U.Qrow + (size_t)((active ? 32 * qh : 0) + r32) * 512 + head * 64 + hi * 8;
#pragma unroll
      for (int d0 = 0; d0 < 4; ++d0) qr[d0] = *(const bf16x8*)(Qw + d0 * 16); }
    const float cfar = tabh[255];
    f32x16 o[2]; o[0] = f32x16{}; o[1] = f32x16{}; float lsum = 0.f;
    const unsigned char* kvsrc = U.KV + U.hg * 65536 + wid * 1024 + lane * 16;
    const unsigned kvdst = lds0 + wid * 1024;
#define ATT_DMA(ti, b) do { _Pragma("unroll") for (int j_ = 0; j_ < 8; ++j_) \
        glds16(kvsrc + (size_t)(ti) * KVT_BYTES + j_ * 8192, (unsigned)__builtin_amdgcn_readfirstlane(kvdst + (b) * BUFB + j_ * 8192)); } while (0)
    ATT_DMA(0, 0);
    for (int ti = 0; ti < nt; ++ti) {
        ATT_WAIT_BAR();
        const int b = ti & 1;
        if (ti + 1 < nt) ATT_DMA(ti + 1, b ^ 1);
        if (active) {
            const int jt = nt - 1 - ti;
            const bool half = U.sample && jt == 0;
            const lds_cptr kp = (lds_cptr)(lds + b * BUFB + hl * HSLOT + hi * 1024 + r32 * 16);
            const float c0 = jt >= 3 ? cfar : 0.f;
            f32x16 p0, p1;
#pragma unroll
            for (int r = 0; r < 16; ++r) { p0[r] = c0; p1[r] = c0; }
#pragma unroll
            for (int d0 = 0; d0 < 4; ++d0) {
                const bf16x8 k0 = *(const LAS bf16x8*)(kp + d0 * 2048);
                p0 = __builtin_amdgcn_mfma_f32_32x32x16_bf16(k0, qr[d0], p0, 0, 0, 0);
                if (!half) { const bf16x8 k1 = *(const LAS bf16x8*)(kp + d0 * 2048 + 512); p1 = __builtin_amdgcn_mfma_f32_32x32x16_bf16(k1, qr[d0], p1, 0, 0, 0); }
            }
            if (jt < 3) { const LAS float* tp = tabh + (191 - (32 * qh + r32) - 64 * jt + 4 * hi);
#pragma unroll
                for (int r = 0; r < 16; ++r) { p0[r] += tp[(r & 3) + 8 * (r >> 2)]; p1[r] += tp[32 + (r & 3) + 8 * (r >> 2)]; } }
            float sacc = 0.f;
#pragma unroll
            for (int r = 0; r < 16; ++r) { p0[r] = __builtin_amdgcn_exp2f(p0[r]); p1[r] = half ? 0.f : __builtin_amdgcn_exp2f(p1[r]); sacc += p0[r] + p1[r]; }
            lsum += sacc;
            u32x4 pw[4];
#pragma unroll
            for (int k = 0; k < 2; ++k) { pw[k] = (u32x4){cvtpk_s(p0[8 * k], p0[8 * k + 1]), cvtpk_s(p0[8 * k + 2], p0[8 * k + 3]), cvtpk_s(p0[8 * k + 4], p0[8 * k + 5]), cvtpk_s(p0[8 * k + 6], p0[8 * k + 7])};
                pw[2 + k] = (u32x4){cvtpk_s(p1[8 * k], p1[8 * k + 1]), cvtpk_s(p1[8 * k + 2], p1[8 * k + 3]), cvtpk_s(p1[8 * k + 4], p1[8 * k + 5]), cvtpk_s(p1[8 * k + 6], p1[8 * k + 7])}; }
            const lds_cptr vp = (lds_cptr)(lds + b * BUFB + hl * HSLOT + 8192 + ((lane >> 4) & 1) * 32 + (lane & 3) * 8 + (4 * hi + ((lane & 15) >> 2)) * 64);
#pragma unroll
            for (int d0 = 0; d0 < 2; ++d0)
#pragma unroll
                for (int ks = 0; ks < 4; ++ks) { if (half && ks >= 2) continue;
                    const s16x4 lo = vtr(vp + d0 * 4096 + ks * 1024), hh = vtr(vp + d0 * 4096 + ks * 1024 + 512);
                    const bf16x8 vf = (bf16x8){lo[0], lo[1], lo[2], lo[3], hh[0], hh[1], hh[2], hh[3]};
                    o[d0] = __builtin_amdgcn_mfma_f32_32x32x16_bf16(__builtin_bit_cast(bf16x8, pw[ks]), vf, o[d0], 0, 0, 0); }
        }
    }
    ATT_WAIT_BAR();
    if (active) {
        { auto rr = __builtin_amdgcn_permlane32_swap(__float_as_uint(lsum), __float_as_uint(lsum), false, false); lsum = __uint_as_float(rr[0]) + __uint_as_float(rr[1]); }
        if (hi == 0) lsc[r32] = lsum;
        asm volatile("s_waitcnt lgkmcnt(0)" ::: "memory");
        LAS bf16* stg = (LAS bf16*)(lds + wid * 4096);
#pragma unroll
        for (int r = 0; r < 16; ++r) { const int orow = crow(r, hi); const float rl = __builtin_amdgcn_rcpf(lsc[orow]);
#pragma unroll
            for (int d0 = 0; d0 < 2; ++d0) stg[orow * 64 + d0 * 32 + r32] = (bf16)f2bf(o[d0][r] * rl); }
        asm volatile("s_waitcnt lgkmcnt(0)" ::: "memory");
        bf16* Ow = U.Orow + (size_t)(32 * qh) * D + head * 64;
#pragma unroll
        for (int i = 0; i < 4; ++i) { const int row = i * 8 + (lane >> 3), ch = lane & 7; const u32x4 v = *(const LAS u32x4*)(stg + row * 64 + ch * 8); *(u32x4*)(Ow + (size_t)row * D + ch * 8) = v; }
    }
    ATT_WAIT_BAR();
#undef ATT_DMA
}
}

__device__ __forceinline__ void conv_item(int item, const bf16* GLU, const float* st, const float* cw, const float* cb, const float* lg, const float* lb, bf16* MIX, LAS unsigned char* lds, int tid) {
    const bool samp = item >= RP / 32; const int b = samp ? item - RP / 32 : item >> 8, t0 = samp ? 0 : (item & 255) * 32, rowbase = samp ? RP + DS * b : b * SEQ;
    const int ch = tid, wid = tid >> 6, lane = tid & 63;
    LAS bf16* xs = (LAS bf16*)lds;
    LAS float* ybuf = (LAS float*)(lds + 65536);
#pragma unroll
    for (int i = 0; i < 8; ++i) { const int k = wid + 8 * i; if (k < 62) { const int tp = t0 - CH + k; pg8::u32x4 v = (pg8::u32x4){0u, 0u, 0u, 0u};
        if (tp >= 0) v = *(const pg8::u32x4*)(GLU + (size_t)(rowbase + tp) * 512 + 8 * lane);
        else if (samp) { const float* sp = st + ((size_t)b * CH + (CH + tp)) * CW + 8 * lane; v = pg8::pack8(*(const f32x4*)sp, *(const f32x4*)(sp + 4)); }
        *(LAS pg8::u32x4*)(xs + k * 512 + 8 * lane) = v; } }
    float w[CONVW];
#pragma unroll
    for (int j = 0; j < CONVW; ++j) w[j] = cw[j * CW + ch];
    const float bias = cb[ch];
    __syncthreads();
#pragma unroll 1
    for (int hb = 0; hb < 2; ++hb) {
        float x[46];
#pragma unroll
        for (int k = 0; k < 46; ++k) x[k] = __uint_as_float((unsigned)xs[(16 * hb + k) * 512 + ch] << 16);
        float y[16];
#pragma unroll
        for (int i = 0; i < 16; ++i) y[i] = bias;
#pragma unroll
        for (int j = 0; j < CONVW; ++j)
#pragma unroll
            for (int i = 0; i < 16; ++i) y[i] += w[j] * x[i + j];
#pragma unroll
        for (int i = 0; i < 16; ++i) ybuf[(16 * hb + i) * 512 + ch] = y[i];
    }
    __syncthreads();
    f32x4 g0 = *(const f32x4*)(lg + 8 * lane), g1 = *(const f32x4*)(lg + 8 * lane + 4), b0 = *(const f32x4*)(lb + 8 * lane), b1 = *(const f32x4*)(lb + 8 * lane + 4);
#pragma unroll
    for (int q = 0; q < 4; ++q) { const int i = 4 * wid + q;
        f32x4 v0 = *(const LAS f32x4*)(ybuf + i * 512 + 8 * lane), v1 = *(const LAS f32x4*)(ybuf + i * 512 + 8 * lane + 4);
        const float mean = wave_sum((v0[0] + v0[1]) + (v0[2] + v0[3]) + (v1[0] + v1[1]) + (v1[2] + v1[3])) * (1.0f / CW);
        v0 = v0 - mean; v1 = v1 - mean;
        const f32x4 q0 = v0 * v0, q1 = v1 * v1;
        const float rstd = rsqrtf(wave_sum((q0[0] + q0[1]) + (q0[2] + q0[3]) + (q1[0] + q1[1]) + (q1[2] + q1[3])) * (1.0f / CW) + EPS);
        v0 = v0 * rstd * g0 + b0; v1 = v1 * rstd * g1 + b1;
#pragma unroll
        for (int e = 0; e < 4; ++e) { v0[e] *= pg8::sigm(v0[e]); v1[e] *= pg8::sigm(v1[e]); }
        *(pg8::u32x4*)(MIX + (size_t)(rowbase + t0 + i) * D + 512 + 8 * lane) = pg8::pack8(v0, v1); }
    __syncthreads();
}


template <class Epi> __device__ __forceinline__ void sgemm64(const bf16* A, const bf16* Bt, int K_, int tile, const Epi& E, LAS unsigned char* lds) {
    int tid_ = threadIdx.x; asm volatile("" : "+v"(tid_)); int K = K_; asm volatile("" : "+s"(K));
    const int lane = tid_ & 63, wave = __builtin_amdgcn_readfirstlane(tid_ >> 6), fr = lane & 15, fq = lane >> 4, wm = wave & 3, wn = wave >> 2, tr = tile >> 4, tc = tile & 15;
    const bf16* ap = A + (size_t)(64 * tr + 16 * wm + fr) * K + 8 * fq;
    const bf16* bp = Bt + (size_t)(64 * tc + 32 * wn + fr) * K + 8 * fq;
    const size_t b1 = (size_t)16 * K;
    f32x4 acc0 = (f32x4){0.f, 0.f, 0.f, 0.f}, acc1 = acc0;
    bf16x8 a[4], p0[4], p1[4], an[4], q0[4], q1[4];
#pragma unroll
    for (int s = 0; s < 4; ++s) { a[s] = *(const bf16x8*)(ap + 32 * s); p0[s] = *(const bf16x8*)(bp + 32 * s); p1[s] = *(const bf16x8*)(bp + b1 + 32 * s); }
    for (int k = 128; k <= K; k += 128) {
        const int kn = k < K ? k : 0;
#pragma unroll
        for (int s = 0; s < 4; ++s) { an[s] = *(const bf16x8*)(ap + kn + 32 * s); q0[s] = *(const bf16x8*)(bp + kn + 32 * s); q1[s] = *(const bf16x8*)(bp + b1 + kn + 32 * s); }
#pragma unroll
        for (int s = 0; s < 4; ++s) { acc0 = __builtin_amdgcn_mfma_f32_16x16x32_bf16(p0[s], a[s], acc0, 0, 0, 0); acc1 = __builtin_amdgcn_mfma_f32_16x16x32_bf16(p1[s], a[s], acc1, 0, 0, 0); }
#pragma unroll
        for (int s = 0; s < 4; ++s) { a[s] = an[s]; p0[s] = q0[s]; p1[s] = q1[s]; }
    }
    E(64 * tr + 16 * wm + fr, 64 * tc + 32 * wn + 4 * fq, tc, wm, wn, fr, fq, acc0, acc1, lds);
}
template <bool BF> struct SEpiRes {
    const float* base; bf16* HB; float* SS;
    __device__ __forceinline__ void operator()(int row, int col, int tc, int wm, int wn, int fr, int fq, const f32x4 acc0, const f32x4 acc1, LAS unsigned char* lds) const {
        const size_t o = (size_t)row * D + col;
        f32x4 v0, v1;
        if (BF) { const unsigned long long w0 = *(const unsigned long long*)(HB + o), w1 = *(const unsigned long long*)(HB + o + 16);
            v0 = (f32x4){__uint_as_float((unsigned)w0 << 16), __uint_as_float((unsigned)w0 & 0xffff0000u), __uint_as_float((unsigned)(w0 >> 32) << 16), __uint_as_float((unsigned)(w0 >> 32) & 0xffff0000u)};
            v1 = (f32x4){__uint_as_float((unsigned)w1 << 16), __uint_as_float((unsigned)w1 & 0xffff0000u), __uint_as_float((unsigned)(w1 >> 32) << 16), __uint_as_float((unsigned)(w1 >> 32) & 0xffff0000u)}; }
        else { v0 = *(const f32x4*)(base + o); v1 = *(const f32x4*)(base + o + 16); }
        v0 = v0 + acc0; v1 = v1 + acc1;
        *(unsigned long long*)(HB + o) = (unsigned long long)pk2(v0[0], v0[1]) | ((unsigned long long)pk2(v0[2], v0[3]) << 32);
        *(unsigned long long*)(HB + o + 16) = (unsigned long long)pk2(v1[0], v1[1]) | ((unsigned long long)pk2(v1[2], v1[3]) << 32);
        const f32x4 q0 = v0 * v0, q1 = v1 * v1;
        const float ss = pg8::quad_sum(((q0[0] + q0[1]) + (q0[2] + q0[3])) + ((q1[0] + q1[1]) + (q1[2] + q1[3])));
        LAS float* red = (LAS float*)lds;
        if (wn == 1 && fq == 0) red[16 * wm + fr] = ss;
        __syncthreads();
        if (wn == 0 && fq == 0) SS[(size_t)row * 16 + tc] = ss + red[16 * wm + fr];
        __syncthreads();
    }
};
struct SEpiFinal {
    const float* SS; const bf16* PP; const bf16* HB; float* Y;
    __device__ __forceinline__ void operator()(int row, int col, int tc, int wm, int wn, int fr, int fq, const f32x4 acc0, const f32x4 acc1, LAS unsigned char* lds) const {
        const float r = pg8::row_rs(SS, row, fq); const size_t o = (size_t)row * D + col;
#pragma unroll
        for (int n = 0; n < 2; ++n) { const f32x4 a = (n ? acc1 : acc0) * r;
            const unsigned long long pw = *(const unsigned long long*)(PP + o + 16 * n), hw = *(const unsigned long long*)(HB + o + 16 * n);
            const unsigned lo = (unsigned)pw, hi = (unsigned)(pw >> 32), hlo = (unsigned)hw, hhi = (unsigned)(hw >> 32);
            f32x4 h;
            h[0] = __uint_as_float(hlo << 16) + pg8::sigm(a[0]) * __uint_as_float(lo << 16); h[1] = __uint_as_float(hlo & 0xffff0000u) + pg8::sigm(a[1]) * __uint_as_float(lo & 0xffff0000u);
            h[2] = __uint_as_float(hhi << 16) + pg8::sigm(a[2]) * __uint_as_float(hi << 16); h[3] = __uint_as_float(hhi & 0xffff0000u) + pg8::sigm(a[3]) * __uint_as_float(hi & 0xffff0000u);
            *(f32x4*)(Y + o + 16 * n) = h; }
    }
};

#ifndef REP_P0
#define REP_P0 1
#endif
#ifndef REP_P1
#define REP_P1 1
#endif
#ifndef REP_P2
#define REP_P2 1
#endif
#ifndef REP_P3
#define REP_P3 1
#endif
#ifndef REP_P4
#define REP_P4 1
#endif
struct Args { const float* in[23]; float* out; unsigned char* ws; };
constexpr int N_ATT_S = 2 * DB, N_ATT_P = NB * 128 * 2, N_CONV = R / 32, N_P2 = N_ATT_S + N_ATT_P + N_CONV;
#define W1t ((bf16*)(ws + WS_W1))
#define WOt ((bf16*)(ws + WS_WO))
#define WGUt ((bf16*)(ws + WS_WGU))
#define WDt ((bf16*)(ws + WS_WD))
#define WPGt ((bf16*)(ws + WS_WPG))
#define WPPt ((bf16*)(ws + WS_WPP))
#define RX ((float*)(ws + WS_RX))
#define SS1 ((float*)(ws + WS_SS1))
#define SS2 ((float*)(ws + WS_SS2))
#define XB ((bf16*)(ws + WS_XB))
#define PB ((bf16*)(ws + WS_PB))
#define PPb ((bf16*)(ws + WS_PP))
#define Qb ((bf16*)(ws + WS_Q))
#define KVP (ws + WS_KP)
#define KVS (ws + WS_KS)
#define GLUb ((bf16*)(ws + WS_GLU))
#define MIXb ((bf16*)(ws + WS_MIX))
#define ACTb ((bf16*)(ws + WS_ACT))
#define Y (out + OY)
__global__ void __launch_bounds__(NWAVES * 64, 2) mk_fwd(Args args) {
    extern __shared__ __attribute__((aligned(16))) unsigned char lds_[];
    LAS unsigned char* lds = (LAS unsigned char*)lds_;
    volatile LAS unsigned* MISC = (volatile LAS unsigned*)(lds + MISC_OFF);
    const int G = gridDim.x, vcu = (G % 8 == 0) ? ((int)blockIdx.x % 8) * (G / 8) + (int)blockIdx.x / 8 : (int)blockIdx.x;
    unsigned char* ws = args.ws; float* out = args.out;
    gu32* ctl = (gu32*)(ws + WS_CTL);
    for (int u = threadIdx.x; u < (ATT_TAB - LDSCTL_OFF) / 4; u += NWAVES * 64) ((LAS unsigned*)(lds + LDSCTL_OFF))[u] = 0u;
    __syncthreads();
    XcdBarrier bar = xcd_barrier_post((unsigned*)(ctl + CW_BAR), MISC + 8);

#ifndef SKIP_P0
    for (int rep = 0; rep < REP_P0; ++rep) {
        if (rep) xcd_barrier(bar);
        int tid0 = threadIdx.x; asm volatile("" : "+v"(tid0));
        const int lane = tid0 & 63, wave = __builtin_amdgcn_readfirstlane(tid0 >> 6);
        LAS float* scr = (LAS float*)(lds + RING_OFF + wave * 16384);
        const int gw = vcu * NWAVES + wave, NGW = G * NWAVES;
        constexpr int I_1 = (D / 64) * (INC / 32), I_O = (D / 64) * (D / 32), I_GU = (D / 64) * (2 * DFF / 32), I_D = (DFF / 64) * (D / 32), I_PG = I_O, I_PP = (PLE / 64) * (D / 32);
        constexpr int NITEMS = I_1 + I_O + I_GU + I_D + I_PG + I_PP;
        for (int it = gw; it < NITEMS; it += NGW) {
            int r = it;
            if (r < I_1) { p0_transpose_item<1>(args.in[8], args.in[7], D, INC, W1t, scr, r, lane); continue; } r -= I_1;
            if (r < I_O) { p0_transpose_item<0>(args.in[16], nullptr, D, D, WOt, scr, r, lane); continue; } r -= I_O;
            if (r < I_GU) { p0_transpose_item<2>(args.in[18], args.in[17], D, 2 * DFF, WGUt, scr, r, lane); continue; } r -= I_GU;
            if (r < I_D) { p0_transpose_item<0>(args.in[19], nullptr, DFF, D, WDt, scr, r, lane); continue; } r -= I_D;
            if (r < I_PG) { p0_transpose_item<0>(args.in[21], args.in[20], D, D, WPGt, scr, r, lane); continue; } r -= I_PG;
            p0_transpose_item<0>(args.in[22], nullptr, PLE, D, WPPt, scr, r, lane);
        }
        for (int m2 = gw; m2 < R / 2; m2 += NGW) {
            f32x4 v[2][4];
#pragma unroll
            for (int rr = 0; rr < 2; ++rr) { const int m = 2 * m2 + rr; const float* xrow = m < RP ? args.in[0] + (size_t)m * D : args.in[1] + (size_t)(m - RP) * D;
                const GAS f32x4* xr = (const GAS f32x4*)xrow + lane;
#pragma unroll
                for (int j = 0; j < 4; ++j) v[rr][j] = xr[64 * j]; }
#pragma unroll
            for (int rr = 0; rr < 2; ++rr) { const int m = 2 * m2 + rr; float s = 0.f;
#pragma unroll
                for (int j = 0; j < 4; ++j) s += (v[rr][j].x * v[rr][j].x + v[rr][j].y * v[rr][j].y) + (v[rr][j].z * v[rr][j].z + v[rr][j].w * v[rr][j].w);
                s = wave_sum(s); if (lane == 0) RX[m] = rsqrtf(s * (1.0f / D) + EPS);
                GAS unsigned long long* o8 = (GAS unsigned long long*)(XB + (size_t)m * D) + lane;
#pragma unroll
                for (int j = 0; j < 4; ++j) o8[64 * j] = (unsigned long long)pk2(v[rr][j].x, v[rr][j].y) | ((unsigned long long)pk2(v[rr][j].z, v[rr][j].w) << 32); }
        }
        for (int m8 = gw; m8 < R / 8; m8 += NGW) {
            const int m = 8 * m8; const float* prow = m < RP ? args.in[2] + (size_t)m * PLE : args.in[3] + (size_t)(m - RP) * PLE;
            const GAS f32x4* pr = (const GAS f32x4*)prow + lane; f32x4 pv[8];
#pragma unroll
            for (int j = 0; j < 8; ++j) pv[j] = pr[64 * j];
            GAS unsigned long long* o8 = (GAS unsigned long long*)(PB + (size_t)m * PLE) + lane;
#pragma unroll
            for (int j = 0; j < 8; ++j) o8[64 * j] = (unsigned long long)pk2(pv[j].x, pv[j].y) | ((unsigned long long)pk2(pv[j].z, pv[j].w) << 32);
        }
    }
#endif
    xcd_barrier(bar);

#ifndef SKIP_P1
    for (int rep = 0; rep < REP_P1; ++rep) {
        if (rep) xcd_barrier(bar);
        pg8::Gemm g{XB, W1t, R, INC, D}; pg8::StaticOrder S; S.init(R, INC, G, (int)blockIdx.x);
        pg8::Epi1 E{RX, args.in[9], args.in[10], Qb, KVP, KVS, GLUb, out};
        pg8::gemm_phase<pg8::Epi1, pg8::StaticOrder, true, true>(lds + RING_OFF, g, S, E);
        pg8::Gemm g2{PB, WPPt, R, D, PLE}; pg8::StaticOrder S2; S2.init(R, D, G, (int)blockIdx.x);
        pg8::EpiPP E2{PPb};
        pg8::gemm_phase<pg8::EpiPP, pg8::StaticOrder, true, true>(lds + RING_OFF, g2, S2, E2);
        { const int c0 = ((R / 256) * (INC / 256)) % G, nwgc = c0 ? G - c0 : G, cc = c0 ? (int)blockIdx.x - c0 : (int)blockIdx.x;
          if (cc >= 0) {
            int tidc = threadIdx.x; asm volatile("" : "+v"(tidc));
            const int lane = tidc & 63, wave = __builtin_amdgcn_readfirstlane(tidc >> 6), head = lane >> 3, dq = lane & 7;
            for (int m2 = cc * NWAVES + wave; m2 < DB * 512; m2 += nwgc * NWAVES) {
                const int b = m2 >> 9, j = m2 & 511, kv = j & 63;
                const GAS f32x4* sk = (const GAS f32x4*)(args.in[4] + (size_t)m2 * 512) + 2 * lane; const GAS f32x4* sv = (const GAS f32x4*)(args.in[5] + (size_t)m2 * 512) + 2 * lane;
                const f32x4 k0 = sk[0], k1 = sk[1], v0 = sv[0], v1 = sv[1];
                unsigned char* tb = KVS + (size_t)(b * 9 + (j >> 6)) * KVT_BYTES + (head >> 2) * 65536 + (head & 3) * 16384;
                *(GAS v4u*)(tb + dq * 1024 + kv * 16) = (v4u){pk2(k0.x, k0.y), pk2(k0.z, k0.w), pk2(k1.x, k1.y), pk2(k1.z, k1.w)};
                *(GAS v4u*)(tb + 8192 + (dq >> 2) * 4096 + (kv >> 4) * 1024 + (kv & 15) * 64 + (dq & 3) * 16) = (v4u){pk2(v0.x, v0.y), pk2(v0.z, v0.w), pk2(v1.x, v1.y), pk2(v1.z, v1.w)};
                if (j >= DS) { GAS f32x4* fk = (GAS f32x4*)(out + OKS + ((size_t)b * 512 + (j - DS)) * 512) + 2 * lane; GAS f32x4* fv = (GAS f32x4*)(out + OVS + ((size_t)b * 512 + (j - DS)) * 512) + 2 * lane;
                    fk[0] = k0; fk[1] = k1; fv[0] = v0; fv[1] = v1; }
            }
          } }
    }
#endif
    xcd_barrier(bar);

#ifndef SKIP_P2
    for (int rep = 0; rep < REP_P2; ++rep) {
        if (rep) xcd_barrier(bar);
        { int tidt = threadIdx.x; asm volatile("" : "+v"(tidt)); const int lane = tidt & 63, wave = __builtin_amdgcn_readfirstlane(tidt >> 6);
          const float* relb = args.in[11] + wave * NREL; LAS float* T = (LAS float*)(lds + ATT_TAB) + wave * 256;
          const float gq = wave_max(fabsf(args.in[9][lane])), gk = wave_max(fabsf(args.in[10][lane]));
          float bm = -1e30f; for (int i = lane; i < NREL; i += 64) bm = fmaxf(bm, relb[i]); bm = wave_max(bm);
          const float shift = 8.0f * gq * gk + bm;
          for (int x = lane; x < 256; x += 64) { int dd = 191 - x; dd = dd < -128 ? -128 : (dd > 128 ? 128 : dd); if (x == 255) dd = 128; T[x] = (relb[dd + 128] - shift) * LOG2E; } }
        __syncthreads();
        for (;;) {
            int tid2 = threadIdx.x; asm volatile("" : "+v"(tid2));
            if (tid2 == 0) MISC[4] = __hip_atomic_fetch_add((unsigned*)(ctl + CW_Q + 64 * rep), 1u, __ATOMIC_RELAXED, __HIP_MEMORY_SCOPE_AGENT);
            __syncthreads();
            const int idx = (int)MISC[4];
            __syncthreads();
            if (idx >= N_P2) break;
            const int lane2 = tid2 & 63, wave2 = __builtin_amdgcn_readfirstlane(tid2 >> 6);
            if (idx < N_ATT_S + N_ATT_P) {
                att::AUnit U;
                if (idx < N_ATT_S) { const int b = idx >> 1; U.hg = idx & 1; U.sample = 1; U.nt = 9;
                    U.Qrow = Qb + (size_t)(RP + DS * b) * 512; U.KV = KVS + (size_t)(b * 9) * KVT_BYTES; U.Orow = MIXb + (size_t)(RP + DS * b) * D; }
                else { int u = idx - N_ATT_S, b, c;
                    if (u < 960) { U.hg = u & 1; const int rest = u >> 1; b = rest / 120; c = 8 + rest % 120; }
                    else { u -= 960; U.hg = u & 1; b = (u >> 1) & 3; c = 7 - (u >> 3); }
                    U.sample = 0; U.nt = (c < 8 ? c : 8) + 1; const size_t row0 = (size_t)b * SEQ + 64 * c;
                    U.Qrow = Qb + row0 * 512; U.KV = KVP + (size_t)(b * 128 + c - (U.nt - 1)) * KVT_BYTES; U.Orow = MIXb + row0 * D; }
                att::attn_unit(U, lds, wave2, lane2);
            } else conv_item(idx - (N_ATT_S + N_ATT_P), GLUb, args.in[6], args.in[12], args.in[13], args.in[14], args.in[15], MIXb, lds, tid2);
        }
    }
#endif
    xcd_barrier(bar);

#ifndef SKIP_P3
    for (int rep = 0; rep < REP_P3; ++rep) {
        if (rep) xcd_barrier(bar);
        pg8::Gemm g{MIXb, WOt, RP, D, D}; pg8::StaticOrder S; S.init(RP, D, G, (int)blockIdx.x);
        pg8::EpiRes<false> E{args.in[0], args.in[1], XB, SS1};
        pg8::gemm_phase<pg8::EpiRes<false>, pg8::StaticOrder, true, true>(lds + RING_OFF, g, S, E);
        { const SEpiRes<false> SE{args.in[1], XB + (size_t)RP * D, SS1 + (size_t)RP * 16};
          for (int t = (int)blockIdx.x; t < 256; t += G) sgemm64(MIXb + (size_t)RP * D, WOt, D, t, SE, lds + RING_OFF); }
    }
#endif
    xcd_barrier(bar);

#ifndef SKIP_P4
    for (int rep = 0; rep < REP_P4; ++rep) {
        if (rep) xcd_barrier(bar);
        pg8::Gemm g{XB, WGUt, R, 2 * DFF, D}; pg8::StaticOrder S; S.init(R, 2 * DFF, G, (int)blockIdx.x);
        pg8::EpiAct E{SS1, ACTb};
        pg8::gemm_phase<pg8::EpiAct, pg8::StaticOrder, true, true>(lds + RING_OFF, g, S, E);
    }
#endif
    xcd_barrier(bar);

#ifndef SKIP_P5
    {
        pg8::Gemm g{ACTb, WDt, RP, D, DFF}; pg8::StaticOrder S; S.init(RP, D, G, (int)blockIdx.x);
        pg8::EpiRes<true> E{nullptr, nullptr, XB, SS2};
        pg8::gemm_phase<pg8::EpiRes<true>, pg8::StaticOrder, true, true>(lds + RING_OFF, g, S, E);
        { const SEpiRes<true> SE{nullptr, XB + (size_t)RP * D, SS2 + (size_t)RP * 16};
          for (int t = (int)blockIdx.x; t < 256; t += G) sgemm64(ACTb + (size_t)RP * DFF, WDt, DFF, t, SE, lds + RING_OFF); }
    }
#endif
    xcd_barrier(bar);

#ifndef SKIP_P6
    {
        pg8::Gemm g{XB, WPGt, RP, D, D}; pg8::StaticOrder S; S.init(RP, D, G, (int)blockIdx.x);
        pg8::EpiFinal E{SS2, PPb, XB, Y};
        pg8::gemm_phase<pg8::EpiFinal, pg8::StaticOrder, true, true>(lds + RING_OFF, g, S, E);
        { const SEpiFinal SE{SS2 + (size_t)RP * 16, PPb + (size_t)RP * D, XB + (size_t)RP * D, Y + (size_t)RP * D};
          for (int t = (int)blockIdx.x; t < 256; t += G) sgemm64(XB + (size_t)RP * D, WPGt, D, t, SE, lds + RING_OFF); }
    }
#endif
}

extern "C" void kernel_launch(void* const* d_in, const int* in_sizes, int n_in, void* d_out, int out_size, void* d_ws, size_t ws_size, hipStream_t stream) {
    static int grid = 0;
    if (grid == 0) {
        if (n_in != 23 || ws_size < WS_END) { fprintf(stderr, "kernel_launch: unexpected shapes (n_in %d, ws %zu)\n", n_in, ws_size); grid = -1; return; }
        int dev = 0, cus = 0, per_cu = 0;
        if (hipGetDevice(&dev) != hipSuccess || hipDeviceGetAttribute(&cus, hipDeviceAttributeMultiprocessorCount, dev) != hipSuccess) { grid = -1; return; }
        if (hipFuncSetAttribute((const void*)mk_fwd, hipFuncAttributeMaxDynamicSharedMemorySize, LDS_BYTES) != hipSuccess) { fprintf(stderr, "kernel_launch: hipFuncSetAttribute failed\n"); grid = -1; return; }
        if (hipOccupancyMaxActiveBlocksPerMultiprocessor(&per_cu, (const void*)mk_fwd, NWAVES * 64, LDS_BYTES) != hipSuccess || per_cu < 1) { fprintf(stderr, "kernel_launch: occupancy query says %d blocks per CU\n", per_cu); }
        (void)hipGetLastError();
        grid = cus;
    }
    if (grid < 0) return;
    if (hipMemsetAsync((char*)d_ws + WS_CTL, 0, CTL_ZERO_BYTES, stream) != hipSuccess) return;
    Args a{};
    for (int i = 0; i < 23; ++i) a.in[i] = (const float*)d_in[i];
    a.out = (float*)d_out; a.ws = (unsigned char*)d_ws;
    hipLaunchKernelGGL(mk_fwd, dim3(grid), dim3(NWAVES * 64), LDS_BYTES, stream, a);
}
```

```cpp
#include <hip/hip_runtime.h>
#include <cstdio>
#include <cstdint>
constexpr int D = 1024, SEQ = 8192, NB = 4, DB = 32, DS = 32;
constexpr int RP = NB * SEQ, RS = DB * DS, R = RP + RS;
constexpr int INC = 2560, DFF = 2816, PLE = 256, NH = 8, HD = 64, CW = 512;
constexpr int NREL = 257, CONVW = 31, CH = 30, KSROWS = 576;
constexpr int KVT_BYTES = 131072;
constexpr float EPS = 1e-6f, LOG2E = 1.4426950408889634f, QSCALE = 0.125f * LOG2E;
constexpr size_t OY = 0, OKP = (size_t)R * D, OVP = OKP + (size_t)NB * 512 * 512, OCP = OVP + (size_t)NB * 512 * 512,
                 OKS = OCP + (size_t)NB * CH * CW, OVS = OKS + (size_t)DB * 512 * 512, OCS = OVS + (size_t)DB * 512 * 512;
namespace pg8 {
#define PG8_LAS __attribute__((address_space(3)))
typedef unsigned short bf16_t;
typedef short bf16x8 __attribute__((ext_vector_type(8)));
typedef float f32x4 __attribute__((ext_vector_type(4)));
typedef unsigned u32x4 __attribute__((ext_vector_type(4)));
constexpr int BM = 256, BK = 64, HALF = 128, HTB = HALF * BK * 2  , STAGE_BYTES = 8 * HTB, NXCD = 8, WGM = 8;

__host__ __device__ __forceinline__ int lds_byte(int r, int c) { const int st = (r >> 4) * 2 + (c >> 5), rr = r & 15, cc = c & 31, ob = rr * 64 + cc * 2; return st * 1024 + (ob ^ (((ob >> 9) & 1) << 5)); }
__host__ __device__ __forceinline__ void stage_rc(int b, int& R, int& C) { const int st = b / 1024, sb = b % 1024, swz = sb ^ (((sb >> 9) & 1) << 5); R = (st >> 1) * 16 + swz / 64; C = (st & 1) * 32 + (swz % 64) / 2; }
__host__ __device__ __forceinline__ int perm32(int rho) { const int n = rho >> 4, i = rho & 15; return 8 * (i >> 2) + 4 * n + (i & 3); }

struct Unit { int pm, pn; };
struct Gemm { const bf16_t* A; const bf16_t* Bt; int M, N, K; };

struct StaticOrder {
    int nM, nN, nwg, G, c;
    __host__ __device__ void init(int M, int N, int G_, int c_) { nM = M / BM; nN = N / BM; nwg = nM * nN; G = G_; c = c_; }
    __host__ __device__ bool next(int i, Unit& u) const {
        const long L = (long)i * G + c; if (L >= nwg) return false;
        int wgid = (int)L; { const int q = nwg / NXCD, r = nwg % NXCD, xcd = wgid % NXCD, off = wgid / NXCD; wgid = (xcd < r ? xcd * (q + 1) : r * (q + 1) + (xcd - r) * q) + off; }
        const int nig = WGM * nN, gid = wgid / nig, fm = gid * WGM, gsz = (nM - fm) < WGM ? (nM - fm) : WGM;
        u.pm = fm + ((wgid % nig) % gsz); u.pn = (wgid % nig) / gsz; return true;
    }
    __device__ __forceinline__ void a_ready(const Unit&) const {}
    __device__ __forceinline__ void done(const Unit&) const {}
};

__device__ __forceinline__ unsigned cvt_pk_bf16(float lo, float hi) { unsigned r; asm volatile("v_cvt_pk_bf16_f32 %0, %1, %2" : "=v"(r) : "v"(lo), "v"(hi)); return r; }
typedef float f32x2 __attribute__((ext_vector_type(2)));typedef unsigned u32x2 __attribute__((ext_vector_type(2)));
__device__ __forceinline__ u32x4 pack8(const f32x4 a, const f32x4 b) { u32x4 w; w.x = cvt_pk_bf16(a[0], a[1]); w.y = cvt_pk_bf16(a[2], a[3]); w.z = cvt_pk_bf16(b[0], b[1]); w.w = cvt_pk_bf16(b[2], b[3]); return w; }
__device__ __forceinline__ float sigm(float x) { return __builtin_amdgcn_rcpf(1.0f + __builtin_amdgcn_exp2f(-x * LOG2E)); }
__device__ __forceinline__ float quad_sum(float s) { s += __shfl_xor(s, 16); s += __shfl_xor(s, 32); return s; }
struct Epi1 {
    static constexpr bool PERM = true, AFTER_DRAIN = false;
    const float* rx; const float* qg; const float* kg; bf16_t* Q; unsigned char* KVP; unsigned char* KVS; bf16_t* GLU; float* out;
    __device__ __forceinline__ void operator()(const f32x4 (&acc)[2][2][4][2], const Unit& u, int wr, int wc, int fr, int fq) const {
        const int pn = u.pn, rowt = u.pm * BM + wr * 64 + fr;
        if (pn < 6) {
            const int sec = pn >> 1, col = (4 * (pn & 1) + wc) * 64 + 8 * fq;
            f32x4 g[2][2];
#pragma unroll
            for (int bj = 0; bj < 2; ++bj)
#pragma unroll
                for (int n = 0; n < 2; ++n) { g[bj][n] = (f32x4){1.f, 1.f, 1.f, 1.f};
                    if (sec == 0) g[bj][n] = *(const f32x4*)(qg + 32 * bj + 8 * fq + 4 * n) * QSCALE;
                    if (sec == 1) g[bj][n] = *(const f32x4*)(kg + 32 * bj + 8 * fq + 4 * n); }
#pragma unroll
            for (int ai = 0; ai < 2; ++ai)
#pragma unroll
                for (int m = 0; m < 4; ++m) {
                    const int row = rowt + ai * HALF + m * 16; const float r = rx[row];
                    f32x4 z[2][2];
#pragma unroll
                    for (int bj = 0; bj < 2; ++bj)
#pragma unroll
                        for (int n = 0; n < 2; ++n) z[bj][n] = acc[ai][bj][m][n] * r;
                    if (sec < 2) {
                        float ss = 0.f;
#pragma unroll
                        for (int bj = 0; bj < 2; ++bj)
#pragma unroll
                            for (int n = 0; n < 2; ++n) { const f32x4 q = z[bj][n] * z[bj][n]; ss += (q[0] + q[1]) + (q[2] + q[3]); }
                        ss = quad_sum(ss);
                        const float rn = rsqrtf(ss * (1.0f / 64.0f) + EPS);
#pragma unroll
                        for (int bj = 0; bj < 2; ++bj)
#pragma unroll
                            for (int n = 0; n < 2; ++n) z[bj][n] = z[bj][n] * rn * g[bj][n];
                    }
                    const int sb = (row - RP) >> 5, si = (row - RP) & 31;
                    float* fo = nullptr;
                    if (sec == 0) {
#pragma unroll
                        for (int bj = 0; bj < 2; ++bj) *(u32x4*)(Q + (size_t)row * 512 + col + 32 * bj) = pack8(z[bj][0], z[bj][1]);
                    } else {
                        unsigned char* tb; int kv;
                        if (row < RP) { tb = KVP + (size_t)(row >> 6) * KVT_BYTES; kv = row & 63;
                            const int t = row & (SEQ - 1); if (t >= SEQ - 512) fo = out + OKP + (size_t)(sec - 1) * (OVP - OKP) + ((size_t)((row >> 13) * 512 + (t - (SEQ - 512)))) * 512 + col; }
                        else { tb = KVS + (size_t)(sb * 9 + 8) * KVT_BYTES; kv = si; fo = out + OKS + (size_t)(sec - 1) * (OVS - OKS) + ((size_t)(sb * 512 + 480 + si)) * 512 + col; }
                        tb += (pn & 1) * 65536 + wc * 16384;
                        const int ok = fq * 1024 + kv * 16, ov = 8192 + (kv >> 4) * 1024 + (kv & 15) * 64 + fq * 16;
#pragma unroll
                        for (int bj = 0; bj < 2; ++bj) *(u32x4*)(tb + (sec == 1 ? ok + bj * 4096 : ov + bj * 4096)) = pack8(z[bj][0], z[bj][1]);
                    }
                    if (fo) {
#pragma unroll
                        for (int bj = 0; bj < 2; ++bj)
#pragma unroll
                            for (int n = 0; n < 2; ++n) *(f32x4*)(fo + 32 * bj + 4 * n) = z[bj][n]; }
                    asm volatile("" ::: "memory");
                }
        } else {
            const int col = 128 * (pn - 6) + 32 * wc + 8 * fq;
#pragma unroll
            for (int ai = 0; ai < 2; ++ai)
#pragma unroll
                for (int m = 0; m < 4; ++m) {
                    const int row = rowt + ai * HALF + m * 16; const float r = rx[row];
                    f32x4 gl[2];
#pragma unroll
                    for (int n = 0; n < 2; ++n) { const f32x4 a = acc[ai][0][m][n] * r, b = acc[ai][1][m][n] * r;
#pragma unroll
                        for (int e = 0; e < 4; ++e) gl[n][e] = a[e] * sigm(b[e]); }
                    *(u32x4*)(GLU + (size_t)row * 512 + col) = pack8(gl[0], gl[1]);
                    float* fo = nullptr;
                    if (row < RP) { const int t = row & (SEQ - 1); if (t >= SEQ - CH) fo = out + OCP + ((size_t)((row >> 13) * CH + (t - (SEQ - CH)))) * CW + col; }
                    else { const int sb = (row - RP) >> 5, si = (row - RP) & 31; if (si >= DS - CH) fo = out + OCS + ((size_t)(sb * CH + (si - (DS - CH)))) * CW + col; }
                    if (fo) { *(f32x4*)(fo) = gl[0]; *(f32x4*)(fo + 4) = gl[1]; }
                    asm volatile("" ::: "memory");
                }
        }
    }
};
struct EpiPP {
    static constexpr bool PERM = true, AFTER_DRAIN = false;
    bf16_t* O;
    __device__ __forceinline__ void operator()(const f32x4 (&acc)[2][2][4][2], const Unit& u, int wr, int wc, int fr, int fq) const {
        const int rowt = u.pm * BM + wr * 64 + fr, col = u.pn * BM + 32 * wc + 8 * fq;
#pragma unroll
        for (int ai = 0; ai < 2; ++ai)
#pragma unroll
            for (int m = 0; m < 4; ++m) { bf16_t* rowp = O + (size_t)(rowt + ai * HALF + m * 16) * D + col;
#pragma unroll
                for (int bj = 0; bj < 2; ++bj) *(u32x4*)(rowp + bj * HALF) = pack8(acc[ai][bj][m][0], acc[ai][bj][m][1]); }
    }
};
__device__ __forceinline__ f32x4 bf_lo4(const u32x4 w) { return (f32x4){__uint_as_float(w.x << 16), __uint_as_float(w.x & 0xffff0000u), __uint_as_float(w.y << 16), __uint_as_float(w.y & 0xffff0000u)}; }
__device__ __forceinline__ f32x4 bf_hi4(const u32x4 w) { return (f32x4){__uint_as_float(w.z << 16), __uint_as_float(w.z & 0xffff0000u), __uint_as_float(w.w << 16), __uint_as_float(w.w & 0xffff0000u)}; }
template <bool BF> struct EpiRes {
    static constexpr bool PERM = true, AFTER_DRAIN = false;
    const float* bp; const float* bs; bf16_t* HB; float* SS;
    __device__ __forceinline__ void operator()(const f32x4 (&acc)[2][2][4][2], const Unit& u, int wr, int wc, int fr, int fq) const {
        const int rowt = u.pm * BM + wr * 64 + fr, col = u.pn * BM + 32 * wc + 8 * fq;
#pragma unroll
        for (int ai = 0; ai < 2; ++ai)
#pragma unroll
            for (int m = 0; m < 4; ++m) {
                const int row = rowt + ai * HALF + m * 16;
                const float* brow = (row < RP ? bp + (size_t)row * D : bs + (size_t)(row - RP) * D) + col;
                bf16_t* hrow = HB + (size_t)row * D + col;
                float ss = 0.f;
#pragma unroll
                for (int bj = 0; bj < 2; ++bj) {
                    f32x4 v0, v1;
                    if (BF) { const u32x4 w = *(const u32x4*)(hrow + bj * HALF); v0 = bf_lo4(w); v1 = bf_hi4(w); }
                    else { v0 = *(const f32x4*)(brow + bj * HALF); v1 = *(const f32x4*)(brow + bj * HALF + 4); }
                    v0 = v0 + acc[ai][bj][m][0]; v1 = v1 + acc[ai][bj][m][1];
                    *(u32x4*)(hrow + bj * HALF) = pack8(v0, v1);
                    const f32x4 q0 = v0 * v0, q1 = v1 * v1; ss += ((q0[0] + q0[1]) + (q0[2] + q0[3])) + ((q1[0] + q1[1]) + (q1[2] + q1[3]));
                }
                ss = quad_sum(ss);
                if (fq == 0) SS[(size_t)row * 16 + 4 * u.pn + wc] = ss;
            }
    }
};
__device__ __forceinline__ float row_rs(const float* SS, int row, int fq) {
    const f32x4 s4 = *(const f32x4*)(SS + (size_t)row * 16 + 4 * fq);
    return rsqrtf(quad_sum((s4[0] + s4[1]) + (s4[2] + s4[3])) * (1.0f / D) + EPS);
}
struct EpiAct {
    static constexpr bool PERM = true, AFTER_DRAIN = false;
    const float* SS; bf16_t* ACT;
    __device__ __forceinline__ void operator()(const f32x4 (&acc)[2][2][4][2], const Unit& u, int wr, int wc, int fr, int fq) const {
        const int rowt = u.pm * BM + wr * 64 + fr, col = 128 * u.pn + 32 * wc + 8 * fq;
#pragma unroll
        for (int ai = 0; ai < 2; ++ai)
#pragma unroll
            for (int m = 0; m < 4; ++m) {
                const int row = rowt + ai * HALF + m * 16; const float r = row_rs(SS, row, fq);
                f32x4 v[2];
#pragma unroll
                for (int n = 0; n < 2; ++n) { const f32x4 g = acc[ai][0][m][n] * r, up = acc[ai][1][m][n] * r;
#pragma unroll
                    for (int e = 0; e < 4; ++e) v[n][e] = g[e] * sigm(g[e]) * up[e]; }
                *(u32x4*)(ACT + (size_t)row * DFF + col) = pack8(v[0], v[1]);
            }
    }
};
struct EpiFinal {
    static constexpr bool PERM = true, AFTER_DRAIN = false;
    const float* SS; const bf16_t* PP; const bf16_t* HB; float* Y;
    __device__ __forceinline__ void operator()(const f32x4 (&acc)[2][2][4][2], const Unit& u, int wr, int wc, int fr, int fq) const {
        const int rowt = u.pm * BM + wr * 64 + fr, col = u.pn * BM + 32 * wc + 8 * fq;
#pragma unroll
        for (int ai = 0; ai < 2; ++ai)
#pragma unroll
            for (int m = 0; m < 4; ++m) {
                const int row = rowt + ai * HALF + m * 16; const float r = row_rs(SS, row, fq);
#pragma unroll
                for (int bj = 0; bj < 2; ++bj) {
                    const size_t o = (size_t)row * D + col + bj * HALF;
                    const u32x4 pw = *(const u32x4*)(PP + o), hw = *(const u32x4*)(HB + o);
                    const f32x4 a0 = acc[ai][bj][m][0] * r, a1 = acc[ai][bj][m][1] * r, p0 = bf_lo4(pw), p1 = bf_hi4(pw);
                    f32x4 h0 = bf_lo4(hw), h1 = bf_hi4(hw);
#pragma unroll
                    for (int e2 = 0; e2 < 4; ++e2) { h0[e2] += sigm(a0[e2]) * p0[e2]; h1[e2] += sigm(a1[e2]) * p1[e2]; }
                    *(f32x4*)(Y + o) = h0; *(f32x4*)(Y + o + 4) = h1;
                }
            }
    }
};

template <class Epi, class Sched, bool ALIGN_EPI = false, bool SP2 = false>
__device__ __forceinline__ void gemm_phase(PG8_LAS unsigned char* lds, const Gemm g, const Sched& S, const Epi& E) {
    int tid_ = threadIdx.x; asm volatile("" : "+v"(tid_));
    const int tid = tid_, wid = __builtin_amdgcn_readfirstlane(tid >> 6), lane = tid & 63, wr = wid >> 2, wc = wid & 3, fr = lane & 15, fq = lane >> 4;
    int K_ = g.K; asm volatile("" : "+s"(K_));
    const int K = K_, nt = K / BK;
    unsigned voffA[2], voffB[2];
#pragma unroll
    for (int i = 0; i < 2; ++i) { int R, C; stage_rc(tid * 16 + i * 8192, R, C); const int Rb = Epi::PERM ? ((R & ~31) + perm32(R & 31)) : R;
        voffA[i] = (unsigned)(R * K + C) * 2u; voffB[i] = (unsigned)(Rb * K + C) * 2u; }
    const size_t kstep = (size_t)(BK * 2);
    const size_t hstep = (size_t)HALF * K * 2;
    const size_t tstep = 2 * hstep;
    const unsigned ldsw = (unsigned)wid * 1024u;
    const int aoff = lds_byte(wr * 64 + fr, fq * 8), boff = lds_byte(wc * 32 + fr, fq * 8);
#define PG8_SA(b, h) (((b) * 2 + (h)) * HTB)
#define PG8_SB(b, h) ((4 + (b) * 2 + (h)) * HTB)
#define PG8_STAGE(bufoff, gbase, voff) do { _Pragma("unroll") for (int _i = 0; _i < 2; ++_i) \
        __builtin_amdgcn_global_load_lds((const unsigned*)((const char*)(gbase) + (voff)[_i]), (PG8_LAS unsigned*)(lds + (bufoff) + ldsw + _i * 8192), 16, 0, 0); } while (0)
#define PG8_LDA(dst, b, h) do { _Pragma("unroll") for (int m = 0; m < 4; ++m) _Pragma("unroll") for (int k = 0; k < 2; ++k) dst[m][k] = *(const PG8_LAS bf16x8*)(lds + PG8_SA(b, h) + aoff + m * 2048 + k * 1024); } while (0)
#define PG8_LDB(dst, b, h) do { _Pragma("unroll") for (int n = 0; n < 2; ++n) _Pragma("unroll") for (int k = 0; k < 2; ++k) dst[n][k] = *(const PG8_LAS bf16x8*)(lds + PG8_SB(b, h) + boff + n * 2048 + k * 1024); } while (0)
#define PG8_MMA(ai, bj, At, Bt) do { __builtin_amdgcn_s_setprio(1); _Pragma("unroll") for (int m = 0; m < 4; ++m) _Pragma("unroll") for (int n = 0; n < 2; ++n) _Pragma("unroll") for (int k = 0; k < 2; ++k) \
        acc[ai][bj][m][n] = __builtin_amdgcn_mfma_f32_16x16x32_bf16(Bt[n][k], At[m][k], acc[ai][bj][m][n], 0, 0, 0); __builtin_amdgcn_s_setprio(0); } while (0)
#define PG8_WAIT_V(n) asm volatile("s_waitcnt vmcnt(" #n ")" ::: "memory")
#define PG8_WAIT_L(n) asm volatile("s_waitcnt lgkmcnt(" #n ")" ::: "memory")
#define PG8_BAR __builtin_amdgcn_s_barrier()
#define PG8_SCHED __builtin_amdgcn_sched_barrier(0)
    Unit cur, nxt; int ui = 0;
    if (!S.next(0, cur)) return;
    f32x4 acc[2][2][4][2];
#pragma unroll
    for (int a = 0; a < 2; ++a)
#pragma unroll
        for (int b = 0; b < 2; ++b)
#pragma unroll
            for (int m = 0; m < 4; ++m)
#pragma unroll
                for (int n = 0; n < 2; ++n) acc[a][b][m][n] = (f32x4){0.f, 0.f, 0.f, 0.f};
    bf16x8 At[4][2], B0[2][2], B1[2][2];
    const char* cA = (const char*)g.A + (size_t)cur.pm * tstep; const char* cB = (const char*)g.Bt + (size_t)cur.pn * tstep;
    S.a_ready(cur);
    if constexpr (SP2) {
        PG8_STAGE(PG8_SB(0, 0), cB, voffB); PG8_STAGE(PG8_SB(0, 1), cB + hstep, voffB); PG8_STAGE(PG8_SA(0, 0), cA, voffA); PG8_STAGE(PG8_SA(0, 1), cA + hstep, voffA);
        if (wr == 1) PG8_BAR;
        PG8_WAIT_V(2); PG8_BAR;
        PG8_STAGE(PG8_SB(1, 0), cB + kstep, voffB); PG8_STAGE(PG8_SA(1, 0), cA + kstep, voffA); PG8_STAGE(PG8_SB(1, 1), cB + hstep + kstep, voffB);
        PG8_WAIT_V(6); PG8_BAR;
    } else {
        PG8_STAGE(PG8_SB(0, 0), cB, voffB); PG8_STAGE(PG8_SA(0, 0), cA, voffA); PG8_STAGE(PG8_SB(0, 1), cB + hstep, voffB); PG8_STAGE(PG8_SA(0, 1), cA + hstep, voffA);
        if (wr == 1) PG8_BAR;
        PG8_WAIT_V(4); PG8_BAR;
        PG8_STAGE(PG8_SB(1, 0), cB + kstep, voffB); PG8_STAGE(PG8_SA(1, 0), cA + kstep, voffA); PG8_STAGE(PG8_SB(1, 1), cB + hstep + kstep, voffB);
        PG8_WAIT_V(6); PG8_BAR;
    }
    for (;;) {
        const bool has_next = S.next(ui + 1, nxt);
        const char* nA = has_next ? (const char*)g.A + (size_t)nxt.pm * tstep : cA; const char* nB = has_next ? (const char*)g.Bt + (size_t)nxt.pn * tstep : cB;
        for (int t = 0; t < nt; t += 2) {
            const bool last = (t == nt - 2);
            const char* a1 = cA + (size_t)(t + 1) * kstep;
            const char* a2 = last ? nA : cA + (size_t)(t + 2) * kstep; const char* b2 = last ? nB : cB + (size_t)(t + 2) * kstep;
            const char* a3 = a2 + kstep; const char* b3 = b2 + kstep;
            if (last && has_next) S.a_ready(nxt);
            if constexpr (SP2) {
            PG8_LDB(B0, 0, 0); PG8_LDB(B1, 0, 1); PG8_SCHED; PG8_LDA(At, 0, 0); PG8_STAGE(PG8_SA(1, 1), a1 + hstep, voffA);
            PG8_WAIT_V(8); PG8_WAIT_L(0); PG8_BAR; PG8_MMA(0, 0, At, B0); PG8_MMA(0, 1, At, B1); PG8_BAR; PG8_SCHED;
            PG8_LDA(At, 0, 1); PG8_STAGE(PG8_SB(0, 0), b2, voffB); PG8_STAGE(PG8_SB(0, 1), b2 + hstep, voffB); PG8_STAGE(PG8_SA(0, 0), a2, voffA);
            PG8_WAIT_V(8); PG8_WAIT_L(0); PG8_BAR; PG8_MMA(1, 0, At, B0); PG8_MMA(1, 1, At, B1); PG8_BAR; PG8_SCHED;
            PG8_LDB(B0, 1, 0); PG8_LDB(B1, 1, 1); PG8_SCHED; PG8_LDA(At, 1, 0); PG8_STAGE(PG8_SA(0, 1), a2 + hstep, voffA);
            PG8_WAIT_V(8); PG8_WAIT_L(0); PG8_BAR; PG8_MMA(0, 0, At, B0); PG8_MMA(0, 1, At, B1); PG8_BAR; PG8_SCHED;
            PG8_LDA(At, 1, 1); PG8_STAGE(PG8_SB(1, 0), b3, voffB); PG8_STAGE(PG8_SB(1, 1), b3 + hstep, voffB); PG8_STAGE(PG8_SA(1, 0), a3, voffA);
            PG8_WAIT_V(8); PG8_WAIT_L(0); PG8_BAR; PG8_MMA(1, 0, At, B0); PG8_MMA(1, 1, At, B1); PG8_BAR; PG8_SCHED;
            } else {
            PG8_LDB(B0, 0, 0); PG8_SCHED; PG8_LDA(At, 0, 0); PG8_STAGE(PG8_SA(1, 1), a1 + hstep, voffA);
            PG8_WAIT_L(8); PG8_BAR; PG8_WAIT_L(0); PG8_MMA(0, 0, At, B0); PG8_BAR; PG8_SCHED;
            PG8_LDB(B1, 0, 1); PG8_STAGE(PG8_SB(0, 0), b2, voffB);
            PG8_BAR; PG8_WAIT_L(0); PG8_MMA(0, 1, At, B1); PG8_BAR;
            PG8_LDA(At, 0, 1); PG8_STAGE(PG8_SA(0, 0), a2, voffA);
            PG8_BAR; PG8_WAIT_L(0); PG8_MMA(1, 0, At, B0); PG8_BAR; PG8_SCHED;
            PG8_STAGE(PG8_SB(0, 1), b2 + hstep, voffB);
            PG8_WAIT_V(6); PG8_BAR; PG8_MMA(1, 1, At, B1); PG8_BAR;
            PG8_LDB(B0, 1, 0); PG8_SCHED; PG8_LDA(At, 1, 0); PG8_STAGE(PG8_SA(0, 1), a2 + hstep, voffA);
            PG8_WAIT_L(8); PG8_BAR; PG8_WAIT_L(0); PG8_MMA(0, 0, At, B0); PG8_BAR; PG8_SCHED;
            PG8_LDB(B1, 1, 1); PG8_STAGE(PG8_SB(1, 0), b3, voffB);
            PG8_BAR; PG8_WAIT_L(0); PG8_MMA(0, 1, At, B1); PG8_BAR;
            PG8_LDA(At, 1, 1); PG8_STAGE(PG8_SA(1, 0), a3, voffA);
            PG8_BAR; PG8_WAIT_L(0); PG8_MMA(1, 0, At, B0); PG8_BAR; PG8_SCHED;
            PG8_STAGE(PG8_SB(1, 1), b3 + hstep, voffB);
            PG8_WAIT_V(6); PG8_BAR; PG8_MMA(1, 1, At, B1); PG8_BAR;
            }
        }
        if constexpr (ALIGN_EPI) { if (wr == 0) PG8_BAR; }
        if constexpr (!Epi::AFTER_DRAIN) { E(acc, cur, wr, wc, fr, fq); S.done(cur); }
        if (!has_next) break;
#pragma unroll
        for (int a = 0; a < 2; ++a)
#pragma unroll
            for (int b = 0; b < 2; ++b)
#pragma unroll
                for (int m = 0; m < 4; ++m)
#pragma unroll
                    for (int n = 0; n < 2; ++n) acc[a][b][m][n] = (f32x4){0.f, 0.f, 0.f, 0.f};
        cur = nxt; cA = nA; cB = nB; ++ui;
        if constexpr (ALIGN_EPI) { if (wr == 1) PG8_BAR; }
    }
    PG8_WAIT_V(0);
    if constexpr (!ALIGN_EPI) { if (wr == 0) PG8_BAR; }
    PG8_BAR;
    if constexpr (Epi::AFTER_DRAIN) { E.fused(acc, cur, wr, wc, fr, fq, lds, wid, lane); S.done(cur); }
#undef PG8_SA
#undef PG8_SB
#undef PG8_STAGE
#undef PG8_LDA
#undef PG8_LDB
#undef PG8_MMA
#undef PG8_WAIT_V
#undef PG8_WAIT_L
#undef PG8_BAR
#undef PG8_SCHED
}
}
#define GAS __attribute__((address_space(1)))
#define LAS __attribute__((address_space(3)))
typedef unsigned short bf16;
typedef unsigned v4u __attribute__((ext_vector_type(4)));
typedef float f32x4 __attribute__((ext_vector_type(4)));
typedef short bf16x8 __attribute__((ext_vector_type(8)));
typedef GAS unsigned gu32;
typedef GAS unsigned long long gu64;
#define RLX_AGENT __ATOMIC_RELAXED, __HIP_MEMORY_SCOPE_AGENT
#define LDS_WAIT() asm volatile("s_waitcnt lgkmcnt(0)" ::: "memory")
#define VM_WAIT() asm volatile("s_waitcnt vmcnt(0)" ::: "memory")
__device__ __forceinline__ unsigned long long rt() { return __builtin_amdgcn_s_memrealtime(); }
__device__ __forceinline__ unsigned f2bf(float f) { unsigned u = __builtin_bit_cast(unsigned, f); return (u + 0x7fffu + ((u >> 16) & 1u)) >> 16; }
__device__ __forceinline__ unsigned pk2(float lo, float hi) { return f2bf(lo) | (f2bf(hi) << 16); }
#define XB_TMO      128
#define XB_XCNT(j)  (256  + 64 * (j))
#define XB_XSUB(j)  (1280 + 64 * (j))
#define XB_XGEN(j)  (2304 + 64 * (j))
#define XB_TOP      3328
#define XB_TOPGEN   3392
#define XCD_BAR_WORDS 3456
#define XB_SPIN_CAP (1u << 18)

__device__ __forceinline__ unsigned xb_ld(unsigned* p)              { return __hip_atomic_load(p, __ATOMIC_RELAXED, __HIP_MEMORY_SCOPE_AGENT); }
__device__ __forceinline__ unsigned xb_add(unsigned* p, unsigned v) { return __hip_atomic_fetch_add(p, v, __ATOMIC_RELAXED, __HIP_MEMORY_SCOPE_AGENT); }
__device__ __forceinline__ unsigned xb_xcc_id() { return (unsigned)__builtin_amdgcn_s_getreg((3 << 11) | 20) & 0xFu; }
#define XB_SPIN(cond, bar) do { unsigned _sp = 0; while (cond) { __builtin_amdgcn_s_sleep(1); \
    if ((++_sp & 255u) == 0u) { if (xb_ld(&(bar)[XB_TMO])) break; if (_sp > XB_SPIN_CAP) { atomicAdd(&(bar)[XB_TMO], 1u); break; } } } } while (0)

struct XcdBarrier {
    unsigned* bar; unsigned x;
    volatile LAS unsigned* st;
};

__device__ __forceinline__ XcdBarrier xcd_barrier_post(unsigned* bar, volatile LAS unsigned* st) {
    XcdBarrier b; b.bar = bar; b.x = xb_xcc_id(); b.st = st;
    if (threadIdx.x == 0) (void)xb_add(&bar[XB_XCNT(b.x)], 1u);
    return b;
}
__device__ __forceinline__ void xcd_barrier_complete(unsigned* bar, unsigned x, unsigned& nloc, unsigned& nx) {
    const unsigned G = gridDim.x * gridDim.y * gridDim.z;
    unsigned sum, cnt, mine, sp = 0u;
    for (;;) {
        sum = 0u; cnt = 0u; mine = 0u;
#pragma unroll
        for (unsigned j = 0; j < 16; ++j) { const unsigned c = xb_ld(&bar[XB_XCNT(j)]); sum += c; cnt += (c > 0u) ? 1u : 0u; mine = (j == x) ? c : mine; }
        if (sum == G) break;
        __builtin_amdgcn_s_sleep(1);
        if ((++sp & 255u) == 0u) { if (xb_ld(&bar[XB_TMO])) break; if (sp > XB_SPIN_CAP) { atomicAdd(&bar[XB_TMO], 1u); break; } }
    }
    nloc = mine > 0u ? mine : 1u; nx = cnt > 0u ? cnt : 1u;
}

__device__ __forceinline__ void xcd_barrier(const XcdBarrier& b) {
    asm volatile("s_waitcnt vmcnt(0)" ::: "memory");
    __syncthreads();
    if (threadIdx.x == 0) {
        unsigned* bar = b.bar;
        __builtin_amdgcn_s_waitcnt(0);
        unsigned nloc = b.st[0], nx = b.st[1];
        if (nloc == 0u) { xcd_barrier_complete(bar, b.x, nloc, nx); b.st[0] = nloc; b.st[1] = nx; }
        const unsigned old = xb_add(&bar[XB_XSUB(b.x)], 1u);
        const unsigned gen = old / nloc;
        if (old + 1u == (gen + 1u) * nloc) {
            __builtin_amdgcn_fence(__ATOMIC_RELEASE, "agent");
            asm volatile("s_waitcnt vmcnt(0)" ::: "memory");
            const unsigned og = xb_add(&bar[XB_TOP], 1u);
            const unsigned tg = og / nx;
            if (og + 1u == (tg + 1u) * nx) xb_add(&bar[XB_TOPGEN], 1u);
            else XB_SPIN(xb_ld(&bar[XB_TOPGEN]) == tg, bar);
            __builtin_amdgcn_fence(__ATOMIC_ACQUIRE, "agent");
            xb_add(&bar[XB_XGEN(b.x)], 1u);
            asm volatile("s_waitcnt vmcnt(0)" ::: "memory");
        } else {
            XB_SPIN(xb_ld(&bar[XB_XGEN(b.x)]) == gen, bar);
            __builtin_amdgcn_fence(__ATOMIC_ACQUIRE, "agent");
            asm volatile("s_waitcnt vmcnt(0)" ::: "memory");
        }
    }
    __syncthreads();
}
constexpr int NWAVES = 8;
constexpr size_t MiB = 1u << 20;
constexpr size_t WS_CTL = 0, CTL_ZERO_BYTES = 1 * MiB;
constexpr size_t WS_W1 = 1 * MiB, WS_WO = 6 * MiB, WS_WGU = 8 * MiB, WS_WD = 19 * MiB, WS_WPG = 25 * MiB, WS_WPP = 27 * MiB;
constexpr size_t WS_RX = 28 * MiB, WS_SS1 = 29 * MiB, WS_SS2 = 32 * MiB;
constexpr size_t WS_XB = 36 * MiB;
constexpr size_t WS_PB = 102 * MiB, WS_PP = 119 * MiB;
constexpr size_t WS_Q = 185 * MiB, WS_KP = 218 * MiB, WS_VP = 250 * MiB, WS_KS = 282 * MiB, WS_VS = 300 * MiB, WS_GLU = 318 * MiB, WS_MIX = 351 * MiB;
constexpr size_t WS_ACT = 185 * MiB;
constexpr size_t WS_END = 417 * MiB;
static_assert(WS_XB + (size_t)R * D * 2 <= WS_PB && WS_PB + (size_t)R * PLE * 2 <= WS_PP && WS_PP + (size_t)R * D * 2 <= WS_Q && WS_Q + (size_t)R * 512 * 2 <= WS_KP &&
              WS_KP + (size_t)(RP / 64) * KVT_BYTES <= WS_KS && WS_KS + (size_t)DB * 9 * KVT_BYTES <= WS_GLU && WS_GLU + (size_t)R * 512 * 2 <= WS_MIX &&
              WS_MIX + (size_t)R * D * 2 <= WS_END && WS_ACT + (size_t)R * DFF * 2 <= WS_END && WS_SS1 + (size_t)R * 64 <= WS_SS2 && WS_SS2 + (size_t)R * 64 <= WS_XB && WS_RX + (size_t)R * 4 <= WS_SS1, "d_ws map");
constexpr int CW_BAR = 4096, CW_Q = 8192;
constexpr int RING_OFF = 0, RING_BYTES = 131072;
constexpr int LDSCTL_OFF = RING_BYTES, MISC_OFF = LDSCTL_OFF + 320;
constexpr int ATT_TAB = 132096, ATT_LSC = ATT_TAB + 8192;
constexpr int LDS_BYTES = 147456;
static_assert(ATT_LSC + 2048 <= LDS_BYTES && MISC_OFF + 128 <= ATT_TAB, "LDS map");

__device__ __forceinline__ float wave_sum(float v) {
#pragma unroll
    for (int o = 1; o < 64; o <<= 1) v += __shfl_xor(v, o);
    return v;
}
__device__ __forceinline__ float wave_max(float v) {
#pragma unroll
    for (int o = 1; o < 64; o <<= 1) v = fmaxf(v, __shfl_xor(v, o));
    return v;
}
__device__ __forceinline__ int map_win(int n) {
    if (n < 1536) { const int sec = n >> 9, nn = n & 511, h = nn >> 6, d = nn & 63; return sec * 512 + 256 * (h >> 2) + 128 * (d >> 5) + 32 * (h & 3) + (d & 31); }
    if (n < 2048) { const int i = n - 1536; return 1536 + 256 * (i >> 7) + (i & 127); }
    const int i = n - 2048; return 1536 + 256 * (i >> 7) + 128 + (i & 127);
}
__device__ __forceinline__ int map_gu(int n) {
    if (n < DFF) return 256 * (n >> 7) + (n & 127);
    const int i = n - DFF; return 256 * (i >> 7) + 128 + (i & 127);
}
template <int MAP> __device__ __forceinline__ void p0_transpose_item(const float* W, const float* gain, int K, int N, bf16* WT, LAS float* scr, int item, int lane) {
    const int nblk = N / 32, kb = item / nblk, nb = item % nblk, k0 = 64 * kb, n0 = 32 * nb;
    { const int nq = lane & 7, kr = lane >> 3; f32x4 v[8];
#pragma unroll
      for (int i = 0; i < 8; ++i) v[i] = *(const GAS f32x4*)(W + (size_t)(k0 + 8 * i + kr) * N + n0 + 4 * nq);
#pragma unroll
      for (int i = 0; i < 8; ++i) { const int kk = 8 * i + kr; const float gk = gain ? gain[k0 + kk] : 1.0f;
#pragma unroll
          for (int e = 0; e < 4; ++e) scr[kk * 33 + 4 * nq + e] = v[i][e] * gk; } }
    LDS_WAIT(); asm volatile("" ::: "memory");
    const int c = lane & 7;
#pragma unroll
    for (int j = 0; j < 4; ++j) { const int n = (lane >> 3) + 8 * j; const LAS float* s = scr + (8 * c) * 33 + n;
        v4u o; o.x = pk2(s[0 * 33], s[1 * 33]); o.y = pk2(s[2 * 33], s[3 * 33]); o.z = pk2(s[4 * 33], s[5 * 33]); o.w = pk2(s[6 * 33], s[7 * 33]);
        const int ns = n0 + n, dr = MAP == 0 ? ns : (MAP == 1 ? map_win(ns) : map_gu(ns));
        *(GAS v4u*)(WT + (size_t)dr * K + k0 + 8 * c) = o; }
    LDS_WAIT(); asm volatile("" ::: "memory");
}

namespace att {
typedef short bf16x8 __attribute__((ext_vector_type(8)));
typedef short s16x4 __attribute__((ext_vector_type(4)));
typedef float f32x16 __attribute__((ext_vector_type(16)));
typedef unsigned u32x4 __attribute__((ext_vector_type(4)));
typedef float f32x2_t __attribute__((ext_vector_type(2))); typedef __bf16 bf16x2_t __attribute__((ext_vector_type(2)));
typedef short v4i16_t __attribute__((ext_vector_type(4)));
typedef LAS const char* lds_cptr;
constexpr int BUFB = 65536, HSLOT = 16384;
__device__ __forceinline__ int crow(int r, int hi) { return (r & 3) + 8 * (r >> 2) + 4 * hi; }
__device__ __forceinline__ void glds16(const void* gsrc, unsigned lds_dst) { unsigned keep;
    asm volatile("s_mov_b32 %0, m0\n\ts_mov_b32 m0, %2\n\ts_nop 0\n\tglobal_load_lds_dwordx4 %1, off\n\ts_mov_b32 m0, %0" : "=&s"(keep) : "v"(gsrc), "s"(lds_dst) : "memory"); }
__device__ __forceinline__ unsigned cvtpk_s(float lo, float hi) { f32x2_t v = {lo, hi}; bf16x2_t b = __builtin_convertvector(v, bf16x2_t); return __builtin_bit_cast(unsigned, b); }
__device__ __forceinline__ s16x4 vtr(lds_cptr p) { return __builtin_bit_cast(s16x4, __builtin_amdgcn_ds_read_tr16_b64_v4i16((LAS v4i16_t*)p)); }
#define ATT_WAIT_BAR() asm volatile("s_waitcnt vmcnt(0) lgkmcnt(0)\n\ts_barrier" ::: "memory")

struct AUnit { const bf16* Qrow; const unsigned char* KV; bf16* Orow; int nt, hg, sample, c0rel; };

__device__ __forceinline__ void attn_unit(const AUnit& U, LAS unsigned char* lds, int wid, int lane) {
    const int r32 = lane & 31, hi = lane >> 5, hl = wid & 3, ci = wid >> 2, head = 4 * U.hg + hl, nt = U.nt, own = U.c0rel + ci;
    const bool wact = !U.sample || ci == 0, two = !U.sample;
    const unsigned lds0 = (unsigned)(size_t)lds;
    const LAS float* tabh = (const LAS float*)(lds + ATT_TAB) + head * 256;
    LAS float* lsc = (LAS float*)(lds + ATT_LSC) + wid * 64;
    bf16x8 qr[2][4];
    { const bf16* Qw = U.Qrow + (size_t)((wact ? 64 * ci : 0) + r32) * 512 + head * 64 + hi * 8; const bf16* Qw1 = Qw + (two ? 32 * 512 : 0);
#pragma unroll
      for (int d0 = 0; d0 < 4; ++d0) { qr[0][d0] = *(const bf16x8*)(Qw + d0 * 16); qr[1][d0] = *(const bf16x8*)(Qw1 + d0 * 16); } }
    const float cfar = tabh[255];
    f32x16 o[2][2]; o[0][0] = f32x16{}; o[0][1] = f32x16{}; o[1][0] = f32x16{}; o[1][1] = f32x16{}; float lsum[2] = {0.f, 0.f};
    const unsigned char* kvsrc = U.KV + U.hg * 65536 + wid * 1024 + lane * 16;
    const unsigned kvdst = lds0 + wid * 1024;
#define ATT_DMA(ti, b) do { _Pragma("unroll") for (int j_ = 0; j_ < 8; ++j_) \
        glds16(kvsrc + (size_t)(ti) * KVT_BYTES + j_ * 8192, (unsigned)__builtin_amdgcn_readfirstlane(kvdst + (b) * BUFB + j_ * 8192)); } while (0)
    ATT_DMA(0, 0);
    for (int ti = 0; ti < nt; ++ti) {
        ATT_WAIT_BAR();
        const int b = ti & 1;
        if (ti + 1 < nt) ATT_DMA(ti + 1, b ^ 1);
        const int jt = own - ti;
        if (wact && jt >= 0 && jt <= 8) {
            const bool half = U.sample && jt == 0;
            const lds_cptr kp = (lds_cptr)(lds + b * BUFB + hl * HSLOT + hi * 1024 + r32 * 16);
            const float c0 = jt >= 3 ? cfar : 0.f;
            u32x4 pw[2][4];
#pragma unroll
            for (int h2 = 0; h2 < 2; ++h2) {
                if (h2 == 1 && !two) { pw[1][0] = pw[0][0]; pw[1][1] = pw[0][1]; pw[1][2] = pw[0][2]; pw[1][3] = pw[0][3]; continue; }
                f32x16 p0, p1;
#pragma unroll
                for (int r = 0; r < 16; ++r) { p0[r] = c0; p1[r] = c0; }
#pragma unroll
                for (int d0 = 0; d0 < 4; ++d0) {
                    const bf16x8 k0 = *(const LAS bf16x8*)(kp + d0 * 2048);
                    p0 = __builtin_amdgcn_mfma_f32_32x32x16_bf16(k0, qr[h2][d0], p0, 0, 0, 0);
                    if (!half) { const bf16x8 k1 = *(const LAS bf16x8*)(kp + d0 * 2048 + 512); p1 = __builtin_amdgcn_mfma_f32_32x32x16_bf16(k1, qr[h2][d0], p1, 0, 0, 0); }
                }
                if (jt < 3) { const LAS float* tp = tabh + (191 - (32 * h2 + r32) - 64 * jt + 4 * hi);
#pragma unroll
                    for (int r = 0; r < 16; ++r) { p0[r] += tp[(r & 3) + 8 * (r >> 2)]; p1[r] += tp[32 + (r & 3) + 8 * (r >> 2)]; } }
                float sacc = 0.f;
#pragma unroll
                for (int r = 0; r < 16; ++r) { p0[r] = __builtin_amdgcn_exp2f(p0[r]); p1[r] = half ? 0.f : __builtin_amdgcn_exp2f(p1[r]); sacc += p0[r] + p1[r]; }
                lsum[h2] += sacc;
#pragma unroll
                for (int k = 0; k < 2; ++k) { pw[h2][k] = (u32x4){cvtpk_s(p0[8 * k], p0[8 * k + 1]), cvtpk_s(p0[8 * k + 2], p0[8 * k + 3]), cvtpk_s(p0[8 * k + 4], p0[8 * k + 5]), cvtpk_s(p0[8 * k + 6], p0[8 * k + 7])};
                    pw[h2][2 + k] = (u32x4){cvtpk_s(p1[8 * k], p1[8 * k + 1]), cvtpk_s(p1[8 * k + 2], p1[8 * k + 3]), cvtpk_s(p1[8 * k + 4], p1[8 * k + 5]), cvtpk_s(p1[8 * k + 6], p1[8 * k + 7])}; }
            }
            const lds_cptr vp = (lds_cptr)(lds + b * BUFB + hl * HSLOT + 8192 + ((lane >> 4) & 1) * 32 + (lane & 3) * 8 + (4 * hi + ((lane & 15) >> 2)) * 64);
#pragma unroll
            for (int d0 = 0; d0 < 2; ++d0)
#pragma unroll
                for (int ks = 0; ks < 4; ++ks) { if (half && ks >= 2) continue;
                    const s16x4 lo = vtr(vp + d0 * 4096 + ks * 1024), hh = vtr(vp + d0 * 4096 + ks * 1024 + 512);
                    const bf16x8 vf = (bf16x8){lo[0], lo[1], lo[2], lo[3], hh[0], hh[1], hh[2], hh[3]};
                    o[0][d0] = __builtin_amdgcn_mfma_f32_32x32x16_bf16(__builtin_bit_cast(bf16x8, pw[0][ks]), vf, o[0][d0], 0, 0, 0);
                    if (two) o[1][d0] = __builtin_amdgcn_mfma_f32_32x32x16_bf16(__builtin_bit_cast(bf16x8, pw[1][ks]), vf, o[1][d0], 0, 0, 0); }
        }
    }
    ATT_WAIT_BAR();
    if (wact) {
#pragma unroll
        for (int h2 = 0; h2 < 2; ++h2) { if (h2 == 1 && !two) continue;
            float ls = lsum[h2];
            { auto rr = __builtin_amdgcn_permlane32_swap(__float_as_uint(ls), __float_as_uint(ls), false, false); ls = __uint_as_float(rr[0]) + __uint_as_float(rr[1]); }
            if (hi == 0) lsc[32 * h2 + r32] = ls;
            asm volatile("s_waitcnt lgkmcnt(0)" ::: "memory");
            LAS bf16* stg = (LAS bf16*)(lds + wid * 8192 + h2 * 4096);
#pragma unroll
            for (int r = 0; r < 16; ++r) { const int orow = crow(r, hi); const float rl = __builtin_amdgcn_rcpf(lsc[32 * h2 + orow]);
#pragma unroll
                for (int d0 = 0; d0 < 2; ++d0) stg[orow * 64 + d0 * 32 + r32] = (bf16)f2bf(o[h2][d0][r] * rl); }
            asm volatile("s_waitcnt lgkmcnt(0)" ::: "memory");
            bf16* Ow = U.Orow + (size_t)(64 * ci + 32 * h2) * D + head * 64;
#pragma unroll
            for (int i = 0; i < 4; ++i) { const int row = i * 8 + (lane >> 3), ch = lane & 7; const u32x4 v = *(const LAS u32x4*)(stg + row * 64 + ch * 8); *(u32x4*)(Ow + (size_t)row * D + ch * 8) = v; }
        }
    }
    ATT_WAIT_BAR();
#undef ATT_DMA
}
}

__device__ __forceinline__ void conv_item(int item, const bf16* GLU, const float* st, const float* cw, const float* cb, const float* lg, const float* lb, bf16* MIX, LAS unsigned char* lds, int tid) {
    const bool samp = item >= RP / 32; const int b = samp ? item - RP / 32 : item >> 8, t0 = samp ? 0 : (item & 255) * 32, rowbase = samp ? RP + DS * b : b * SEQ;
    const int ch = tid, wid = tid >> 6, lane = tid & 63;
    LAS bf16* xs = (LAS bf16*)lds;
    LAS float* ybuf = (LAS float*)(lds + 65536);
#pragma unroll
    for (int i = 0; i < 8; ++i) { const int k = wid + 8 * i; if (k < 62) { const int tp = t0 - CH + k; pg8::u32x4 v = (pg8::u32x4){0u, 0u, 0u, 0u};
        if (tp >= 0) v = *(const pg8::u32x4*)(GLU + (size_t)(rowbase + tp) * 512 + 8 * lane);
        else if (samp) { const float* sp = st + ((size_t)b * CH + (CH + tp)) * CW + 8 * lane; v = pg8::pack8(*(const f32x4*)sp, *(const f32x4*)(sp + 4)); }
        *(LAS pg8::u32x4*)(xs + k * 512 + 8 * lane) = v; } }
    float w[CONVW];
#pragma unroll
    for (int j = 0; j < CONVW; ++j) w[j] = cw[j * CW + ch];
    const float bias = cb[ch];
    __syncthreads();
#pragma unroll 1
    for (int hb = 0; hb < 2; ++hb) {
        float x[46];
#pragma unroll
        for (int k = 0; k < 46; ++k) x[k] = __uint_as_float((unsigned)xs[(16 * hb + k) * 512 + ch] << 16);
        float y[16];
#pragma unroll
        for (int i = 0; i < 16; ++i) y[i] = bias;
#pragma unroll
        for (int j = 0; j < CONVW; ++j)
#pragma unroll
            for (int i = 0; i < 16; ++i) y[i] += w[j] * x[i + j];
#pragma unroll
        for (int i = 0; i < 16; ++i) ybuf[(16 * hb + i) * 512 + ch] = y[i];
    }
    __syncthreads();
    f32x4 g0 = *(const f32x4*)(lg + 8 * lane), g1 = *(const f32x4*)(lg + 8 * lane + 4), b0 = *(const f32x4*)(lb + 8 * lane), b1 = *(const f32x4*)(lb + 8 * lane + 4);
#pragma unroll
    for (int q = 0; q < 4; ++q) { const int i = 4 * wid + q;
        f32x4 v0 = *(const LAS f32x4*)(ybuf + i * 512 + 8 * lane), v1 = *(const LAS f32x4*)(ybuf + i * 512 + 8 * lane + 4);
        const float mean = wave_sum((v0[0] + v0[1]) + (v0[2] + v0[3]) + (v1[0] + v1[1]) + (v1[2] + v1[3])) * (1.0f / CW);
        v0 = v0 - mean; v1 = v1 - mean;
        const f32x4 q0 = v0 * v0, q1 = v1 * v1;
        const float rstd = rsqrtf(wave_sum((q0[0] + q0[1]) + (q0[2] + q0[3]) + (q1[0] + q1[1]) + (q1[2] + q1[3])) * (1.0f / CW) + EPS);
        v0 = v0 * rstd * g0 + b0; v1 = v1 * rstd * g1 + b1;
#pragma unroll
        for (int e = 0; e < 4; ++e) { v0[e] *= pg8::sigm(v0[e]); v1[e] *= pg8::sigm(v1[e]); }
        *(pg8::u32x4*)(MIX + (size_t)(rowbase + t0 + i) * D + 512 + 8 * lane) = pg8::pack8(v0, v1); }
    __syncthreads();
}


constexpr int SG_LD = 68;
template <class Epi> __device__ __forceinline__ void sgemm64(const bf16* A, const bf16* Bt, int K_, int tile, const Epi& E, LAS unsigned char* lds) {
    int tid_ = threadIdx.x; asm volatile("" : "+v"(tid_)); int K = K_; asm volatile("" : "+s"(K));
    const int lane = tid_ & 63, wave = __builtin_amdgcn_readfirstlane(tid_ >> 6), fr = lane & 15, fq = lane >> 4, kg = wave & 3, nh = wave >> 2, tr = tile >> 4, tc = tile & 15;
    const int Kq = K >> 2;
    const bf16* ap = A + (size_t)(64 * tr + fr) * K + kg * Kq + 8 * fq;
    const bf16* bp = Bt + (size_t)(64 * tc + 32 * nh + fr) * K + kg * Kq + 8 * fq;
    const size_t r16 = (size_t)16 * K;
    f32x4 acc[4][2];
#pragma unroll
    for (int mi = 0; mi < 4; ++mi) { acc[mi][0] = (f32x4){0.f, 0.f, 0.f, 0.f}; acc[mi][1] = acc[mi][0]; }
    bf16x8 a[2][4], p[2][2], an[2][4], pn[2][2];
#pragma unroll
    for (int s = 0; s < 2; ++s) {
#pragma unroll
        for (int mi = 0; mi < 4; ++mi) a[s][mi] = *(const bf16x8*)(ap + mi * r16 + 32 * s);
        p[s][0] = *(const bf16x8*)(bp + 32 * s); p[s][1] = *(const bf16x8*)(bp + r16 + 32 * s); }
    for (int k = 64; k <= Kq; k += 64) {
        const int kn = k < Kq ? k : 0;
#pragma unroll
        for (int s = 0; s < 2; ++s) {
#pragma unroll
            for (int mi = 0; mi < 4; ++mi) an[s][mi] = *(const bf16x8*)(ap + mi * r16 + kn + 32 * s);
            pn[s][0] = *(const bf16x8*)(bp + kn + 32 * s); pn[s][1] = *(const bf16x8*)(bp + r16 + kn + 32 * s); }
#pragma unroll
        for (int s = 0; s < 2; ++s)
#pragma unroll
            for (int mi = 0; mi < 4; ++mi) { acc[mi][0] = __builtin_amdgcn_mfma_f32_16x16x32_bf16(p[s][0], a[s][mi], acc[mi][0], 0, 0, 0); acc[mi][1] = __builtin_amdgcn_mfma_f32_16x16x32_bf16(p[s][1], a[s][mi], acc[mi][1], 0, 0, 0); }
#pragma unroll
        for (int s = 0; s < 2; ++s) {
#pragma unroll
            for (int mi = 0; mi < 4; ++mi) a[s][mi] = an[s][mi];
            p[s][0] = pn[s][0]; p[s][1] = pn[s][1]; }
    }
    LAS float* part = (LAS float*)lds;
#pragma unroll
    for (int mi = 0; mi < 4; ++mi)
#pragma unroll
        for (int ni = 0; ni < 2; ++ni) *(LAS f32x4*)(part + (kg * 64 + 16 * mi + fr) * SG_LD + 32 * nh + 16 * ni + 4 * fq) = acc[mi][ni];
    __syncthreads();
    const int row = tid_ >> 3, c8 = (tid_ & 7) * 8;
    f32x4 v0 = *(const LAS f32x4*)(part + row * SG_LD + c8), v1 = *(const LAS f32x4*)(part + row * SG_LD + c8 + 4);
#pragma unroll
    for (int g = 1; g < 4; ++g) { v0 = v0 + *(const LAS f32x4*)(part + (g * 64 + row) * SG_LD + c8); v1 = v1 + *(const LAS f32x4*)(part + (g * 64 + row) * SG_LD + c8 + 4); }
    E(64 * tr + row, 64 * tc + c8, tc, tid_ & 7, v0, v1);
    __syncthreads();
}
__device__ __forceinline__ float oct_sum(float s) { s += __shfl_xor(s, 1); s += __shfl_xor(s, 2); s += __shfl_xor(s, 4); return s; }
template <bool BF> struct SEpiRes {
    const float* base; bf16* HB; float* SS;
    __device__ __forceinline__ void operator()(int row, int col, int tc, int l8, f32x4 v0, f32x4 v1) const {
        const size_t o = (size_t)row * D + col;
        if (BF) { const pg8::u32x4 w = *(const pg8::u32x4*)(HB + o); v0 = v0 + pg8::bf_lo4(w); v1 = v1 + pg8::bf_hi4(w); }
        else { v0 = v0 + *(const f32x4*)(base + o); v1 = v1 + *(const f32x4*)(base + o + 4); }
        *(pg8::u32x4*)(HB + o) = pg8::pack8(v0, v1);
        const f32x4 q0 = v0 * v0, q1 = v1 * v1;
        const float ss = oct_sum(((q0[0] + q0[1]) + (q0[2] + q0[3])) + ((q1[0] + q1[1]) + (q1[2] + q1[3])));
        if (l8 == 0) SS[(size_t)row * 16 + tc] = ss;
    }
};
struct SEpiFinal {
    const float* SS; const bf16* PP; const bf16* HB; float* Y;
    __device__ __forceinline__ void operator()(int row, int col, int tc, int l8, f32x4 v0, f32x4 v1) const {
        const float r = rsqrtf(oct_sum(SS[(size_t)row * 16 + 2 * l8] + SS[(size_t)row * 16 + 2 * l8 + 1]) * (1.0f / D) + EPS);
        const size_t o = (size_t)row * D + col;
        const pg8::u32x4 pw = *(const pg8::u32x4*)(PP + o), hw = *(const pg8::u32x4*)(HB + o);
        const f32x4 p0 = pg8::bf_lo4(pw), p1 = pg8::bf_hi4(pw); f32x4 h0 = pg8::bf_lo4(hw), h1 = pg8::bf_hi4(hw);
#pragma unroll
        for (int e = 0; e < 4; ++e) { h0[e] += pg8::sigm(v0[e] * r) * p0[e]; h1[e] += pg8::sigm(v1[e] * r) * p1[e]; }
        *(f32x4*)(Y + o) = h0; *(f32x4*)(Y + o + 4) = h1;
    }
};

#ifndef REP_P0
#define REP_P0 1
#endif
#ifndef REP_P1
#define REP_P1 1
#endif
#ifndef REP_P2
#define REP_P2 1
#endif
#ifndef REP_P3
#define REP_P3 1
#endif
#ifndef REP_P4
#define REP_P4 1
#endif
struct Args { const float* in[23]; float* out; unsigned char* ws; };
constexpr int N_ATT_S = 2 * DB, N_ATT_P = NB * 64 * 2, N_CONV = R / 32, N_P2 = N_ATT_S + N_ATT_P + N_CONV;
#define W1t ((bf16*)(ws + WS_W1))
#define WOt ((bf16*)(ws + WS_WO))
#define WGUt ((bf16*)(ws + WS_WGU))
#define WDt ((bf16*)(ws + WS_WD))
#define WPGt ((bf16*)(ws + WS_WPG))
#define WPPt ((bf16*)(ws + WS_WPP))
#define RX ((float*)(ws + WS_RX))
#define SS1 ((float*)(ws + WS_SS1))
#define SS2 ((float*)(ws + WS_SS2))
#define XB ((bf16*)(ws + WS_XB))
#define PB ((bf16*)(ws + WS_PB))
#define PPb ((bf16*)(ws + WS_PP))
#define Qb ((bf16*)(ws + WS_Q))
#define KVP (ws + WS_KP)
#define KVS (ws + WS_KS)
#define GLUb ((bf16*)(ws + WS_GLU))
#define MIXb ((bf16*)(ws + WS_MIX))
#define ACTb ((bf16*)(ws + WS_ACT))
#define Y (out + OY)
__global__ void __launch_bounds__(NWAVES * 64, 2) mk_fwd(Args args) {
    extern __shared__ __attribute__((aligned(16))) unsigned char lds_[];
    LAS unsigned char* lds = (LAS unsigned char*)lds_;
    volatile LAS unsigned* MISC = (volatile LAS unsigned*)(lds + MISC_OFF);
    const int G = gridDim.x, vcu = (G % 8 == 0) ? ((int)blockIdx.x % 8) * (G / 8) + (int)blockIdx.x / 8 : (int)blockIdx.x;
    unsigned char* ws = args.ws; float* out = args.out;
    gu32* ctl = (gu32*)(ws + WS_CTL);
    for (int u = threadIdx.x; u < (ATT_TAB - LDSCTL_OFF) / 4; u += NWAVES * 64) ((LAS unsigned*)(lds + LDSCTL_OFF))[u] = 0u;
    __syncthreads();
    XcdBarrier bar = xcd_barrier_post((unsigned*)(ctl + CW_BAR), MISC + 8);

#ifndef SKIP_P0
    for (int rep = 0; rep < REP_P0; ++rep) {
        if (rep) xcd_barrier(bar);
        int tid0 = threadIdx.x; asm volatile("" : "+v"(tid0));
        const int lane = tid0 & 63, wave = __builtin_amdgcn_readfirstlane(tid0 >> 6);
        LAS float* scr = (LAS float*)(lds + RING_OFF + wave * 16384);
        const int gw = vcu * NWAVES + wave, NGW = G * NWAVES;
        constexpr int I_1 = (D / 64) * (INC / 32), I_O = (D / 64) * (D / 32), I_GU = (D / 64) * (2 * DFF / 32), I_D = (DFF / 64) * (D / 32), I_PG = I_O, I_PP = (PLE / 64) * (D / 32);
        constexpr int NITEMS = I_1 + I_O + I_GU + I_D + I_PG + I_PP;
        for (int it = gw; it < NITEMS; it += NGW) {
            int r = it;
            if (r < I_1) { p0_transpose_item<1>(args.in[8], args.in[7], D, INC, W1t, scr, r, lane); continue; } r -= I_1;
            if (r < I_O) { p0_transpose_item<0>(args.in[16], nullptr, D, D, WOt, scr, r, lane); continue; } r -= I_O;
            if (r < I_GU) { p0_transpose_item<2>(args.in[18], args.in[17], D, 2 * DFF, WGUt, scr, r, lane); continue; } r -= I_GU;
            if (r < I_D) { p0_transpose_item<0>(args.in[19], nullptr, DFF, D, WDt, scr, r, lane); continue; } r -= I_D;
            if (r < I_PG) { p0_transpose_item<0>(args.in[21], args.in[20], D, D, WPGt, scr, r, lane); continue; } r -= I_PG;
            p0_transpose_item<0>(args.in[22], nullptr, PLE, D, WPPt, scr, r, lane);
        }
        for (int m2 = gw; m2 < R / 2; m2 += NGW) {
            f32x4 v[2][4];
#pragma unroll
            for (int rr = 0; rr < 2; ++rr) { const int m = 2 * m2 + rr; const float* xrow = m < RP ? args.in[0] + (size_t)m * D : args.in[1] + (size_t)(m - RP) * D;
                const GAS f32x4* xr = (const GAS f32x4*)xrow + lane;
#pragma unroll
                for (int j = 0; j < 4; ++j) v[rr][j] = xr[64 * j]; }
#pragma unroll
            for (int rr = 0; rr < 2; ++rr) { const int m = 2 * m2 + rr; float s = 0.f;
#pragma unroll
                for (int j = 0; j < 4; ++j) s += (v[rr][j].x * v[rr][j].x + v[rr][j].y * v[rr][j].y) + (v[rr][j].z * v[rr][j].z + v[rr][j].w * v[rr][j].w);
                s = wave_sum(s); if (lane == 0) RX[m] = rsqrtf(s * (1.0f / D) + EPS);
                GAS unsigned long long* o8 = (GAS unsigned long long*)(XB + (size_t)m * D) + lane;
#pragma unroll
                for (int j = 0; j < 4; ++j) o8[64 * j] = (unsigned long long)pk2(v[rr][j].x, v[rr][j].y) | ((unsigned long long)pk2(v[rr][j].z, v[rr][j].w) << 32); }
        }
        for (int m8 = gw; m8 < R / 8; m8 += NGW) {
            const int m = 8 * m8; const float* prow = m < RP ? args.in[2] + (size_t)m * PLE : args.in[3] + (size_t)(m - RP) * PLE;
            const GAS f32x4* pr = (const GAS f32x4*)prow + lane; f32x4 pv[8];
#pragma unroll
            for (int j = 0; j < 8; ++j) pv[j] = pr[64 * j];
            GAS unsigned long long* o8 = (GAS unsigned long long*)(PB + (size_t)m * PLE) + lane;
#pragma unroll
            for (int j = 0; j < 8; ++j) o8[64 * j] = (unsigned long long)pk2(pv[j].x, pv[j].y) | ((unsigned long long)pk2(pv[j].z, pv[j].w) << 32);
        }
    }
#endif
    xcd_barrier(bar);

#ifndef SKIP_P1
    for (int rep = 0; rep < REP_P1; ++rep) {
        if (rep) xcd_barrier(bar);
        pg8::Gemm g{XB, W1t, R, INC, D}; pg8::StaticOrder S; S.init(R, INC, G, (int)blockIdx.x);
        pg8::Epi1 E{RX, args.in[9], args.in[10], Qb, KVP, KVS, GLUb, out};
        pg8::gemm_phase<pg8::Epi1, pg8::StaticOrder, true, true>(lds + RING_OFF, g, S, E);
        pg8::Gemm g2{PB, WPPt, R, D, PLE}; pg8::StaticOrder S2; S2.init(R, D, G, (int)blockIdx.x);
        pg8::EpiPP E2{PPb};
        pg8::gemm_phase<pg8::EpiPP, pg8::StaticOrder, true, true>(lds + RING_OFF, g2, S2, E2);
        { const int c0 = ((R / 256) * (INC / 256)) % G, nwgc = c0 ? G - c0 : G, cc = c0 ? (int)blockIdx.x - c0 : (int)blockIdx.x;
          if (cc >= 0) {
            int tidc = threadIdx.x; asm volatile("" : "+v"(tidc));
            const int lane = tidc & 63, wave = __builtin_amdgcn_readfirstlane(tidc >> 6), head = lane >> 3, dq = lane & 7;
            for (int m2 = cc * NWAVES + wave; m2 < DB * 512; m2 += nwgc * NWAVES) {
                const int b = m2 >> 9, j = m2 & 511, kv = j & 63;
                const GAS f32x4* sk = (const GAS f32x4*)(args.in[4] + (size_t)m2 * 512) + 2 * lane; const GAS f32x4* sv = (const GAS f32x4*)(args.in[5] + (size_t)m2 * 512) + 2 * lane;
                const f32x4 k0 = sk[0], k1 = sk[1], v0 = sv[0], v1 = sv[1];
                unsigned char* tb = KVS + (size_t)(b * 9 + (j >> 6)) * KVT_BYTES + (head >> 2) * 65536 + (head & 3) * 16384;
                *(GAS v4u*)(tb + dq * 1024 + kv * 16) = (v4u){pk2(k0.x, k0.y), pk2(k0.z, k0.w), pk2(k1.x, k1.y), pk2(k1.z, k1.w)};
                *(GAS v4u*)(tb + 8192 + (dq >> 2) * 4096 + (kv >> 4) * 1024 + (kv & 15) * 64 + (dq & 3) * 16) = (v4u){pk2(v0.x, v0.y), pk2(v0.z, v0.w), pk2(v1.x, v1.y), pk2(v1.z, v1.w)};
            }
          } }
    }
#endif
    xcd_barrier(bar);

#ifndef SKIP_P2
    for (int rep = 0; rep < REP_P2; ++rep) {
        if (rep) xcd_barrier(bar);
        { int tidt = threadIdx.x; asm volatile("" : "+v"(tidt)); const int lane = tidt & 63, wave = __builtin_amdgcn_readfirstlane(tidt >> 6);
          const float* relb = args.in[11] + wave * NREL; LAS float* T = (LAS float*)(lds + ATT_TAB) + wave * 256;
          const float gq = wave_max(fabsf(args.in[9][lane])), gk = wave_max(fabsf(args.in[10][lane]));
          float bm = -1e30f; for (int i = lane; i < NREL; i += 64) bm = fmaxf(bm, relb[i]); bm = wave_max(bm);
          const float shift = 8.0f * gq * gk + bm;
          for (int x = lane; x < 256; x += 64) { int dd = 191 - x; dd = dd < -128 ? -128 : (dd > 128 ? 128 : dd); if (x == 255) dd = 128; T[x] = (relb[dd + 128] - shift) * LOG2E; } }
        __syncthreads();
        for (;;) {
            int tid2 = threadIdx.x; asm volatile("" : "+v"(tid2));
            if (tid2 == 0) MISC[4] = __hip_atomic_fetch_add((unsigned*)(ctl + CW_Q + 64 * rep), 1u, __ATOMIC_RELAXED, __HIP_MEMORY_SCOPE_AGENT);
            __syncthreads();
            const int idx = (int)MISC[4];
            __syncthreads();
            if (idx >= N_P2) break;
            const int lane2 = tid2 & 63, wave2 = __builtin_amdgcn_readfirstlane(tid2 >> 6);
            if (idx < N_ATT_S + N_ATT_P) {
                att::AUnit U;
                if (idx < N_ATT_S) { const int b = idx >> 1; U.hg = idx & 1; U.sample = 1; U.nt = 9; U.c0rel = 8;
                    U.Qrow = Qb + (size_t)(RP + DS * b) * 512; U.KV = KVS + (size_t)(b * 9) * KVT_BYTES; U.Orow = MIXb + (size_t)(RP + DS * b) * D; }
                else { int u = idx - N_ATT_S, b, pi;
                    if (u < 480) { U.hg = u & 1; const int rest = u >> 1; b = rest / 60; pi = 4 + rest % 60; }
                    else { u -= 480; U.hg = u & 1; b = (u >> 1) & 3; pi = 3 - (u >> 3); }
                    const int c0 = 2 * pi; U.sample = 0; U.c0rel = c0 < 8 ? c0 : 8; U.nt = U.c0rel + 2; const size_t row0 = (size_t)b * SEQ + 64 * c0;
                    U.Qrow = Qb + row0 * 512; U.KV = KVP + (size_t)(b * 128 + c0 - U.c0rel) * KVT_BYTES; U.Orow = MIXb + row0 * D; }
                att::attn_unit(U, lds, wave2, lane2);
            } else conv_item(idx - (N_ATT_S + N_ATT_P), GLUb, args.in[6], args.in[12], args.in[13], args.in[14], args.in[15], MIXb, lds, tid2);
        }
    }
#endif
    xcd_barrier(bar);

#ifndef SKIP_P3
    for (int rep = 0; rep < REP_P3; ++rep) {
        if (rep) xcd_barrier(bar);
        pg8::Gemm g{MIXb, WOt, RP, D, D}; pg8::StaticOrder S; S.init(RP, D, G, (int)blockIdx.x);
        pg8::EpiRes<false> E{args.in[0], args.in[1], XB, SS1};
        const SEpiRes<false> SE{args.in[1], XB + (size_t)RP * D, SS1 + (size_t)RP * 16};
        if (blockIdx.x & 1) for (int t = (int)blockIdx.x; t < 256; t += G) sgemm64(MIXb + (size_t)RP * D, WOt, D, t, SE, lds + RING_OFF);
        pg8::gemm_phase<pg8::EpiRes<false>, pg8::StaticOrder, true, true>(lds + RING_OFF, g, S, E);
        if (!(blockIdx.x & 1)) for (int t = (int)blockIdx.x; t < 256; t += G) sgemm64(MIXb + (size_t)RP * D, WOt, D, t, SE, lds + RING_OFF);
    }
#endif
    xcd_barrier(bar);

#ifndef SKIP_P4
    for (int rep = 0; rep < REP_P4; ++rep) {
        if (rep) xcd_barrier(bar);
        { const int c0 = ((R / 256) * (2 * DFF / 256)) % G, nwgc = c0 ? G - c0 : G, cc = c0 ? (int)blockIdx.x - c0 : (int)blockIdx.x;
          if (cc >= 0) {
            int tidc = threadIdx.x; asm volatile("" : "+v"(tidc));
            const int lane = tidc & 63, wave = __builtin_amdgcn_readfirstlane(tidc >> 6);
            for (int m4 = cc * NWAVES + wave; m4 < 2 * DB * 120; m4 += nwgc * NWAVES) {
                const int kv = m4 >= DB * 120, mm = kv ? m4 - DB * 120 : m4, b = mm / 120, j = DS + 4 * (mm % 120);
                const GAS f32x4* src = (const GAS f32x4*)(args.in[4 + kv] + ((size_t)b * 512 + j) * 512) + lane;
                GAS f32x4* dst = (GAS f32x4*)(out + (kv ? OVS : OKS) + ((size_t)b * 512 + (j - DS)) * 512) + lane;
                f32x4 v[8];
#pragma unroll
                for (int i = 0; i < 8; ++i) v[i] = src[64 * i];
#pragma unroll
                for (int i = 0; i < 8; ++i) dst[64 * i] = v[i];
            }
          } }
        pg8::Gemm g{XB, WGUt, R, 2 * DFF, D}; pg8::StaticOrder S; S.init(R, 2 * DFF, G, (int)blockIdx.x);
        pg8::EpiAct E{SS1, ACTb};
        pg8::gemm_phase<pg8::EpiAct, pg8::StaticOrder, true, true>(lds + RING_OFF, g, S, E);
    }
#endif
    xcd_barrier(bar);

#ifndef SKIP_P5
    {
        pg8::Gemm g{ACTb, WDt, RP, D, DFF}; pg8::StaticOrder S; S.init(RP, D, G, (int)blockIdx.x);
        pg8::EpiRes<true> E{nullptr, nullptr, XB, SS2};
        const SEpiRes<true> SE{nullptr, XB + (size_t)RP * D, SS2 + (size_t)RP * 16};
        if (blockIdx.x & 1) for (int t = (int)blockIdx.x; t < 256; t += G) sgemm64(ACTb + (size_t)RP * DFF, WDt, DFF, t, SE, lds + RING_OFF);
        pg8::gemm_phase<pg8::EpiRes<true>, pg8::StaticOrder, true, true>(lds + RING_OFF, g, S, E);
        if (!(blockIdx.x & 1)) for (int t = (int)blockIdx.x; t < 256; t += G) sgemm64(ACTb + (size_t)RP * DFF, WDt, DFF, t, SE, lds + RING_OFF);
    }
#endif
    xcd_barrier(bar);

#ifndef SKIP_P6
    {
        pg8::Gemm g{XB, WPGt, RP, D, D}; pg8::StaticOrder S; S.init(RP, D, G, (int)blockIdx.x);
        pg8::EpiFinal E{SS2, PPb, XB, Y};
        const SEpiFinal SE{SS2 + (size_t)RP * 16, PPb + (size_t)RP * D, XB + (size_t)RP * D, Y + (size_t)RP * D};
        if (blockIdx.x & 1) for (int t = (int)blockIdx.x; t < 256; t += G) sgemm64(XB + (size_t)RP * D, WPGt, D, t, SE, lds + RING_OFF);
        pg8::gemm_phase<pg8::EpiFinal, pg8::StaticOrder, true, true>(lds + RING_OFF, g, S, E);
        if (!(blockIdx.x & 1)) for (int t = (int)blockIdx.x; t < 256; t += G) sgemm64(XB + (size_t)RP * D, WPGt, D, t, SE, lds + RING_OFF);
    }
#endif
}

extern "C" void kernel_launch(void* const* d_in, const int* in_sizes, int n_in, void* d_out, int out_size, void* d_ws, size_t ws_size, hipStream_t stream) {
    static int grid = 0;
    if (grid == 0) {
        if (n_in != 23 || ws_size < WS_END) { fprintf(stderr, "kernel_launch: unexpected shapes (n_in %d, ws %zu)\n", n_in, ws_size); grid = -1; return; }
        int dev = 0, cus = 0, per_cu = 0;
        if (hipGetDevice(&dev) != hipSuccess || hipDeviceGetAttribute(&cus, hipDeviceAttributeMultiprocessorCount, dev) != hipSuccess) { grid = -1; return; }
        if (hipFuncSetAttribute((const void*)mk_fwd, hipFuncAttributeMaxDynamicSharedMemorySize, LDS_BYTES) != hipSuccess) { fprintf(stderr, "kernel_launch: hipFuncSetAttribute failed\n"); grid = -1; return; }
        if (hipOccupancyMaxActiveBlocksPerMultiprocessor(&per_cu, (const void*)mk_fwd, NWAVES * 64, LDS_BYTES) != hipSuccess || per_cu < 1) { fprintf(stderr, "kernel_launch: occupancy query says %d blocks per CU\n", per_cu); }
        (void)hipGetLastError();
        grid = cus;
    }
    if (grid < 0) return;
    if (hipMemsetAsync((char*)d_ws + WS_CTL, 0, CTL_ZERO_BYTES, stream) != hipSuccess) return;
    Args a{};
    for (int i = 0; i < 23; ++i) a.in[i] = (const float*)d_in[i];
    a.out = (float*)d_out; a.ws = (unsigned char*)d_ws;
    hipLaunchKernelGGL(mk_fwd, dim3(grid), dim3(NWAVES * 64), LDS_BYTES, stream, a);
}
```

```cpp
#include <hip/hip_runtime.h>
#include <cstdio>
#include <cstdint>
constexpr int D = 1024, SEQ = 8192, NB = 4, DB = 32, DS = 32;
constexpr int RP = NB * SEQ, RS = DB * DS, R = RP + RS;
constexpr int INC = 2560, DFF = 2816, PLE = 256, NH = 8, HD = 64, CW = 512;
constexpr int NREL = 257, CONVW = 31, CH = 30, KSROWS = 576;
constexpr int KVT_BYTES = 131072;
constexpr float EPS = 1e-6f, LOG2E = 1.4426950408889634f, QSCALE = 0.125f * LOG2E;
constexpr size_t OY = 0, OKP = (size_t)R * D, OVP = OKP + (size_t)NB * 512 * 512, OCP = OVP + (size_t)NB * 512 * 512,
                 OKS = OCP + (size_t)NB * CH * CW, OVS = OKS + (size_t)DB * 512 * 512, OCS = OVS + (size_t)DB * 512 * 512;
namespace pg8 {
#define PG8_LAS __attribute__((address_space(3)))
typedef unsigned short bf16_t;
typedef short bf16x8 __attribute__((ext_vector_type(8)));
typedef float f32x4 __attribute__((ext_vector_type(4)));
typedef unsigned u32x4 __attribute__((ext_vector_type(4)));
constexpr int BM = 256, BK = 64, HALF = 128, HTB = HALF * BK * 2  , STAGE_BYTES = 8 * HTB, NXCD = 8, WGM = 8;

__host__ __device__ __forceinline__ int lds_byte(int r, int c) { const int st = (r >> 4) * 2 + (c >> 5), rr = r & 15, cc = c & 31, ob = rr * 64 + cc * 2; return st * 1024 + (ob ^ (((ob >> 9) & 1) << 5)); }
__host__ __device__ __forceinline__ void stage_rc(int b, int& R, int& C) { const int st = b / 1024, sb = b % 1024, swz = sb ^ (((sb >> 9) & 1) << 5); R = (st >> 1) * 16 + swz / 64; C = (st & 1) * 32 + (swz % 64) / 2; }
__host__ __device__ __forceinline__ int perm32(int rho) { const int n = rho >> 4, i = rho & 15; return 8 * (i >> 2) + 4 * n + (i & 3); }

struct Unit { int pm, pn; };
struct Gemm { const bf16_t* A; const bf16_t* Bt; int M, N, K; };

struct StaticOrder {
    int nM, nN, nwg, G, c;
    __host__ __device__ void init(int M, int N, int G_, int c_) { nM = M / BM; nN = N / BM; nwg = nM * nN; G = G_; c = c_; }
    __host__ __device__ bool next(int i, Unit& u) const {
        const long L = (long)i * G + c; if (L >= nwg) return false;
        int wgid = (int)L; { const int q = nwg / NXCD, r = nwg % NXCD, xcd = wgid % NXCD, off = wgid / NXCD; wgid = (xcd < r ? xcd * (q + 1) : r * (q + 1) + (xcd - r) * q) + off; }
        const int nig = WGM * nN, gid = wgid / nig, fm = gid * WGM, gsz = (nM - fm) < WGM ? (nM - fm) : WGM;
        u.pm = fm + ((wgid % nig) % gsz); u.pn = (wgid % nig) / gsz; return true;
    }
    __device__ __forceinline__ void a_ready(const Unit&) const {}
    __device__ __forceinline__ void done(const Unit&) const {}
};

__device__ __forceinline__ unsigned cvt_pk_bf16(float lo, float hi) { unsigned r; asm volatile("v_cvt_pk_bf16_f32 %0, %1, %2" : "=v"(r) : "v"(lo), "v"(hi)); return r; }
typedef float f32x2 __attribute__((ext_vector_type(2)));typedef unsigned u32x2 __attribute__((ext_vector_type(2)));
__device__ __forceinline__ u32x4 pack8(const f32x4 a, const f32x4 b) { u32x4 w; w.x = cvt_pk_bf16(a[0], a[1]); w.y = cvt_pk_bf16(a[2], a[3]); w.z = cvt_pk_bf16(b[0], b[1]); w.w = cvt_pk_bf16(b[2], b[3]); return w; }
__device__ __forceinline__ float sigm(float x) { return __builtin_amdgcn_rcpf(1.0f + __builtin_amdgcn_exp2f(-x * LOG2E)); }
__device__ __forceinline__ float quad_sum(float s) { s += __shfl_xor(s, 16); s += __shfl_xor(s, 32); return s; }
struct Epi1 {
    static constexpr bool PERM = true, AFTER_DRAIN = false;
    const float* rx; const float* qg; const float* kg; bf16_t* Q; unsigned char* KVP; unsigned char* KVS; bf16_t* GLU; float* out;
    __device__ __forceinline__ void operator()(const f32x4 (&acc)[2][2][4][2], const Unit& u, int wr, int wc, int fr, int fq) const {
        const int pn = u.pn, rowt = u.pm * BM + wr * 64 + fr;
        float rxv[2][4];
#pragma unroll
        for (int ai = 0; ai < 2; ++ai)
#pragma unroll
            for (int m = 0; m < 4; ++m) rxv[ai][m] = rx[rowt + ai * HALF + m * 16];
        if (pn < 6) {
            const int sec = pn >> 1, col = (4 * (pn & 1) + wc) * 64 + 8 * fq;
            f32x4 g[2][2];
#pragma unroll
            for (int bj = 0; bj < 2; ++bj)
#pragma unroll
                for (int n = 0; n < 2; ++n) { g[bj][n] = (f32x4){1.f, 1.f, 1.f, 1.f};
                    if (sec == 0) g[bj][n] = *(const f32x4*)(qg + 32 * bj + 8 * fq + 4 * n) * QSCALE;
                    if (sec == 1) g[bj][n] = *(const f32x4*)(kg + 32 * bj + 8 * fq + 4 * n); }
#pragma unroll
            for (int ai = 0; ai < 2; ++ai)
#pragma unroll
                for (int m = 0; m < 4; ++m) {
                    const int row = rowt + ai * HALF + m * 16; const float r = rxv[ai][m];
                    f32x4 z[2][2];
#pragma unroll
                    for (int bj = 0; bj < 2; ++bj)
#pragma unroll
                        for (int n = 0; n < 2; ++n) z[bj][n] = acc[ai][bj][m][n] * r;
                    if (sec < 2) {
                        float ss = 0.f;
#pragma unroll
                        for (int bj = 0; bj < 2; ++bj)
#pragma unroll
                            for (int n = 0; n < 2; ++n) { const f32x4 q = z[bj][n] * z[bj][n]; ss += (q[0] + q[1]) + (q[2] + q[3]); }
                        ss = quad_sum(ss);
                        const float rn = rsqrtf(ss * (1.0f / 64.0f) + EPS);
#pragma unroll
                        for (int bj = 0; bj < 2; ++bj)
#pragma unroll
                            for (int n = 0; n < 2; ++n) z[bj][n] = z[bj][n] * rn * g[bj][n];
                    }
                    const int sb = (row - RP) >> 5, si = (row - RP) & 31;
                    float* fo = nullptr;
                    if (sec == 0) {
#pragma unroll
                        for (int bj = 0; bj < 2; ++bj) *(u32x4*)(Q + (size_t)row * 512 + col + 32 * bj) = pack8(z[bj][0], z[bj][1]);
                    } else {
                        unsigned char* tb; int kv;
                        if (row < RP) { tb = KVP + (size_t)(row >> 6) * KVT_BYTES; kv = row & 63;
                            const int t = row & (SEQ - 1); if (t >= SEQ - 512) fo = out + OKP + (size_t)(sec - 1) * (OVP - OKP) + ((size_t)((row >> 13) * 512 + (t - (SEQ - 512)))) * 512 + col; }
                        else { tb = KVS + (size_t)(sb * 9 + 8) * KVT_BYTES; kv = si; fo = out + OKS + (size_t)(sec - 1) * (OVS - OKS) + ((size_t)(sb * 512 + 480 + si)) * 512 + col; }
                        tb += (pn & 1) * 65536 + wc * 16384;
                        const int ok = fq * 1024 + kv * 16, ov = 8192 + (kv >> 4) * 1024 + (kv & 15) * 64 + fq * 16;
#pragma unroll
                        for (int bj = 0; bj < 2; ++bj) *(u32x4*)(tb + (sec == 1 ? ok + bj * 4096 : ov + bj * 4096)) = pack8(z[bj][0], z[bj][1]);
                    }
                    if (fo) {
#pragma unroll
                        for (int bj = 0; bj < 2; ++bj)
#pragma unroll
                            for (int n = 0; n < 2; ++n) *(f32x4*)(fo + 32 * bj + 4 * n) = z[bj][n]; }
                }
        } else {
            const int col = 128 * (pn - 6) + 32 * wc + 8 * fq;
#pragma unroll
            for (int ai = 0; ai < 2; ++ai)
#pragma unroll
                for (int m = 0; m < 4; ++m) {
                    const int row = rowt + ai * HALF + m * 16; const float r = rxv[ai][m];
                    f32x4 gl[2];
#pragma unroll
                    for (int n = 0; n < 2; ++n) { const f32x4 a = acc[ai][0][m][n] * r, b = acc[ai][1][m][n] * r;
#pragma unroll
                        for (int e = 0; e < 4; ++e) gl[n][e] = a[e] * sigm(b[e]); }
                    *(u32x4*)(GLU + (size_t)row * 512 + col) = pack8(gl[0], gl[1]);
                    float* fo = nullptr;
                    if (row < RP) { const int t = row & (SEQ - 1); if (t >= SEQ - CH) fo = out + OCP + ((size_t)((row >> 13) * CH + (t - (SEQ - CH)))) * CW + col; }
                    else { const int sb = (row - RP) >> 5, si = (row - RP) & 31; if (si >= DS - CH) fo = out + OCS + ((size_t)(sb * CH + (si - (DS - CH)))) * CW + col; }
                    if (fo) { *(f32x4*)(fo) = gl[0]; *(f32x4*)(fo + 4) = gl[1]; }
                }
        }
    }
};
struct EpiPP {
    static constexpr bool PERM = true, AFTER_DRAIN = false;
    bf16_t* O;
    __device__ __forceinline__ void operator()(const f32x4 (&acc)[2][2][4][2], const Unit& u, int wr, int wc, int fr, int fq) const {
        const int rowt = u.pm * BM + wr * 64 + fr, col = u.pn * BM + 32 * wc + 8 * fq;
#pragma unroll
        for (int ai = 0; ai < 2; ++ai)
#pragma unroll
            for (int m = 0; m < 4; ++m) { bf16_t* rowp = O + (size_t)(rowt + ai * HALF + m * 16) * D + col;
#pragma unroll
                for (int bj = 0; bj < 2; ++bj) *(u32x4*)(rowp + bj * HALF) = pack8(acc[ai][bj][m][0], acc[ai][bj][m][1]); }
    }
};
__device__ __forceinline__ f32x4 bf_lo4(const u32x4 w) { return (f32x4){__uint_as_float(w.x << 16), __uint_as_float(w.x & 0xffff0000u), __uint_as_float(w.y << 16), __uint_as_float(w.y & 0xffff0000u)}; }
__device__ __forceinline__ f32x4 bf_hi4(const u32x4 w) { return (f32x4){__uint_as_float(w.z << 16), __uint_as_float(w.z & 0xffff0000u), __uint_as_float(w.w << 16), __uint_as_float(w.w & 0xffff0000u)}; }
template <bool BF> struct EpiRes {
    static constexpr bool PERM = true, AFTER_DRAIN = false;
    const float* bp; const float* bs; bf16_t* HB; float* SS;
    __device__ __forceinline__ void operator()(const f32x4 (&acc)[2][2][4][2], const Unit& u, int wr, int wc, int fr, int fq) const {
        const int rowt = u.pm * BM + wr * 64 + fr, col = u.pn * BM + 32 * wc + 8 * fq;
        f32x4 bv[2][2][2];
        auto ldbase = [&](int i, f32x4 (&d)[2][2]) {
            const int row = rowt + (i >> 2) * HALF + (i & 3) * 16;
            if (BF) { const bf16_t* hrow = HB + (size_t)row * D + col;
#pragma unroll
                for (int bj = 0; bj < 2; ++bj) { const u32x4 w = *(const u32x4*)(hrow + bj * HALF); d[bj][0] = bf_lo4(w); d[bj][1] = bf_hi4(w); } }
            else { const float* brow = (row < RP ? bp + (size_t)row * D : bs + (size_t)(row - RP) * D) + col;
#pragma unroll
                for (int bj = 0; bj < 2; ++bj) { d[bj][0] = *(const f32x4*)(brow + bj * HALF); d[bj][1] = *(const f32x4*)(brow + bj * HALF + 4); } } };
        ldbase(0, bv[0]);
#pragma unroll
        for (int i = 0; i < 8; ++i) {
            const int ai = i >> 2, m = i & 3, row = rowt + ai * HALF + m * 16;
            if (i + 1 < 8) ldbase(i + 1, bv[(i + 1) & 1]);
            bf16_t* hrow = HB + (size_t)row * D + col;
            float ss = 0.f;
#pragma unroll
            for (int bj = 0; bj < 2; ++bj) {
                const f32x4 v0 = bv[i & 1][bj][0] + acc[ai][bj][m][0], v1 = bv[i & 1][bj][1] + acc[ai][bj][m][1];
                *(u32x4*)(hrow + bj * HALF) = pack8(v0, v1);
                const f32x4 q0 = v0 * v0, q1 = v1 * v1; ss += ((q0[0] + q0[1]) + (q0[2] + q0[3])) + ((q1[0] + q1[1]) + (q1[2] + q1[3]));
            }
            ss = quad_sum(ss);
            if (fq == 0) SS[(size_t)row * 16 + 4 * u.pn + wc] = ss;
        }
    }
};
__device__ __forceinline__ float row_rs(const float* SS, int row, int fq) {
    const f32x4 s4 = *(const f32x4*)(SS + (size_t)row * 16 + 4 * fq);
    return rsqrtf(quad_sum((s4[0] + s4[1]) + (s4[2] + s4[3])) * (1.0f / D) + EPS);
}
struct EpiAct {
    static constexpr bool PERM = true, AFTER_DRAIN = false;
    const float* SS; bf16_t* ACT;
    __device__ __forceinline__ void operator()(const f32x4 (&acc)[2][2][4][2], const Unit& u, int wr, int wc, int fr, int fq) const {
        const int rowt = u.pm * BM + wr * 64 + fr, col = 128 * u.pn + 32 * wc + 8 * fq;
        float rv[2][4];
#pragma unroll
        for (int ai = 0; ai < 2; ++ai)
#pragma unroll
            for (int m = 0; m < 4; ++m) rv[ai][m] = row_rs(SS, rowt + ai * HALF + m * 16, fq);
#pragma unroll
        for (int ai = 0; ai < 2; ++ai)
#pragma unroll
            for (int m = 0; m < 4; ++m) {
                const int row = rowt + ai * HALF + m * 16; const float r = rv[ai][m];
                f32x4 v[2];
#pragma unroll
                for (int n = 0; n < 2; ++n) { const f32x4 g = acc[ai][0][m][n] * r, up = acc[ai][1][m][n] * r;
#pragma unroll
                    for (int e = 0; e < 4; ++e) v[n][e] = g[e] * sigm(g[e]) * up[e]; }
                *(u32x4*)(ACT + (size_t)row * DFF + col) = pack8(v[0], v[1]);
            }
    }
};
struct EpiFinal {
    static constexpr bool PERM = true, AFTER_DRAIN = false;
    const float* SS; const bf16_t* PP; const bf16_t* HB; float* Y;
    __device__ __forceinline__ void operator()(const f32x4 (&acc)[2][2][4][2], const Unit& u, int wr, int wc, int fr, int fq) const {
        const int rowt = u.pm * BM + wr * 64 + fr, col = u.pn * BM + 32 * wc + 8 * fq;
        float rv[2][4];
#pragma unroll
        for (int ai = 0; ai < 2; ++ai)
#pragma unroll
            for (int m = 0; m < 4; ++m) rv[ai][m] = row_rs(SS, rowt + ai * HALF + m * 16, fq);
        u32x4 pwv[2][2], hwv[2][2];
        auto ld = [&](int i, u32x4 (&p)[2], u32x4 (&h)[2]) { const size_t o = (size_t)(rowt + (i >> 2) * HALF + (i & 3) * 16) * D + col;
#pragma unroll
            for (int bj = 0; bj < 2; ++bj) { p[bj] = *(const u32x4*)(PP + o + bj * HALF); h[bj] = *(const u32x4*)(HB + o + bj * HALF); } };
        ld(0, pwv[0], hwv[0]);
#pragma unroll
        for (int i = 0; i < 8; ++i) {
            const int ai = i >> 2, m = i & 3, row = rowt + ai * HALF + m * 16; const float r = rv[ai][m];
            if (i + 1 < 8) ld(i + 1, pwv[(i + 1) & 1], hwv[(i + 1) & 1]);
#pragma unroll
            for (int bj = 0; bj < 2; ++bj) {
                const size_t o = (size_t)row * D + col + bj * HALF;
                const u32x4 pw = pwv[i & 1][bj], hw = hwv[i & 1][bj];
                const f32x4 a0 = acc[ai][bj][m][0] * r, a1 = acc[ai][bj][m][1] * r, p0 = bf_lo4(pw), p1 = bf_hi4(pw);
                f32x4 h0 = bf_lo4(hw), h1 = bf_hi4(hw);
#pragma unroll
                for (int e2 = 0; e2 < 4; ++e2) { h0[e2] += sigm(a0[e2]) * p0[e2]; h1[e2] += sigm(a1[e2]) * p1[e2]; }
                *(f32x4*)(Y + o) = h0; *(f32x4*)(Y + o + 4) = h1;
            }
        }
    }
};

template <class Epi, class Sched, bool ALIGN_EPI = false, bool SP2 = false>
__device__ __forceinline__ void gemm_phase(PG8_LAS unsigned char* lds, const Gemm g, const Sched& S, const Epi& E) {
    int tid_ = threadIdx.x; asm volatile("" : "+v"(tid_));
    const int tid = tid_, wid = __builtin_amdgcn_readfirstlane(tid >> 6), lane = tid & 63, wr = wid >> 2, wc = wid & 3, fr = lane & 15, fq = lane >> 4;
    int K_ = g.K; asm volatile("" : "+s"(K_));
    const int K = K_, nt = K / BK;
    unsigned voffA[2], voffB[2];
#pragma unroll
    for (int i = 0; i < 2; ++i) { int R, C; stage_rc(tid * 16 + i * 8192, R, C); const int Rb = Epi::PERM ? ((R & ~31) + perm32(R & 31)) : R;
        voffA[i] = (unsigned)(R * K + C) * 2u; voffB[i] = (unsigned)(Rb * K + C) * 2u; }
    const size_t kstep = (size_t)(BK * 2);
    const size_t hstep = (size_t)HALF * K * 2;
    const size_t tstep = 2 * hstep;
    const unsigned ldsw = (unsigned)wid * 1024u;
    const int aoff = lds_byte(wr * 64 + fr, fq * 8), boff = lds_byte(wc * 32 + fr, fq * 8);
#define PG8_SA(b, h) (((b) * 2 + (h)) * HTB)
#define PG8_SB(b, h) ((4 + (b) * 2 + (h)) * HTB)
#define PG8_STAGE(bufoff, gbase, voff) do { _Pragma("unroll") for (int _i = 0; _i < 2; ++_i) \
        __builtin_amdgcn_global_load_lds((const unsigned*)((const char*)(gbase) + (voff)[_i]), (PG8_LAS unsigned*)(lds + (bufoff) + ldsw + _i * 8192), 16, 0, 0); } while (0)
#define PG8_LDA(dst, b, h) do { _Pragma("unroll") for (int m = 0; m < 4; ++m) _Pragma("unroll") for (int k = 0; k < 2; ++k) dst[m][k] = *(const PG8_LAS bf16x8*)(lds + PG8_SA(b, h) + aoff + m * 2048 + k * 1024); } while (0)
#define PG8_LDB(dst, b, h) do { _Pragma("unroll") for (int n = 0; n < 2; ++n) _Pragma("unroll") for (int k = 0; k < 2; ++k) dst[n][k] = *(const PG8_LAS bf16x8*)(lds + PG8_SB(b, h) + boff + n * 2048 + k * 1024); } while (0)
#define PG8_MMA(ai, bj, At, Bt) do { __builtin_amdgcn_s_setprio(1); _Pragma("unroll") for (int m = 0; m < 4; ++m) _Pragma("unroll") for (int n = 0; n < 2; ++n) _Pragma("unroll") for (int k = 0; k < 2; ++k) \
        acc[ai][bj][m][n] = __builtin_amdgcn_mfma_f32_16x16x32_bf16(Bt[n][k], At[m][k], acc[ai][bj][m][n], 0, 0, 0); __builtin_amdgcn_s_setprio(0); } while (0)
#define PG8_WAIT_V(n) asm volatile("s_waitcnt vmcnt(" #n ")" ::: "memory")
#define PG8_WAIT_L(n) asm volatile("s_waitcnt lgkmcnt(" #n ")" ::: "memory")
#define PG8_BAR __builtin_amdgcn_s_barrier()
#define PG8_SCHED __builtin_amdgcn_sched_barrier(0)
    Unit cur, nxt; int ui = 0;
    if (!S.next(0, cur)) return;
    f32x4 acc[2][2][4][2];
#pragma unroll
    for (int a = 0; a < 2; ++a)
#pragma unroll
        for (int b = 0; b < 2; ++b)
#pragma unroll
            for (int m = 0; m < 4; ++m)
#pragma unroll
                for (int n = 0; n < 2; ++n) acc[a][b][m][n] = (f32x4){0.f, 0.f, 0.f, 0.f};
    bf16x8 At[4][2], B0[2][2], B1[2][2];
    const char* cA = (const char*)g.A + (size_t)cur.pm * tstep; const char* cB = (const char*)g.Bt + (size_t)cur.pn * tstep;
    S.a_ready(cur);
    if constexpr (SP2) {
        PG8_STAGE(PG8_SB(0, 0), cB, voffB); PG8_STAGE(PG8_SB(0, 1), cB + hstep, voffB); PG8_STAGE(PG8_SA(0, 0), cA, voffA); PG8_STAGE(PG8_SA(0, 1), cA + hstep, voffA);
        if (wr == 1) PG8_BAR;
        PG8_WAIT_V(2); PG8_BAR;
        PG8_STAGE(PG8_SB(1, 0), cB + kstep, voffB); PG8_STAGE(PG8_SA(1, 0), cA + kstep, voffA); PG8_STAGE(PG8_SB(1, 1), cB + hstep + kstep, voffB);
        PG8_WAIT_V(6); PG8_BAR;
    } else {
        PG8_STAGE(PG8_SB(0, 0), cB, voffB); PG8_STAGE(PG8_SA(0, 0), cA, voffA); PG8_STAGE(PG8_SB(0, 1), cB + hstep, voffB); PG8_STAGE(PG8_SA(0, 1), cA + hstep, voffA);
        if (wr == 1) PG8_BAR;
        PG8_WAIT_V(4); PG8_BAR;
        PG8_STAGE(PG8_SB(1, 0), cB + kstep, voffB); PG8_STAGE(PG8_SA(1, 0), cA + kstep, voffA); PG8_STAGE(PG8_SB(1, 1), cB + hstep + kstep, voffB);
        PG8_WAIT_V(6); PG8_BAR;
    }
    for (;;) {
        const bool has_next = S.next(ui + 1, nxt);
        const char* nA = has_next ? (const char*)g.A + (size_t)nxt.pm * tstep : cA; const char* nB = has_next ? (const char*)g.Bt + (size_t)nxt.pn * tstep : cB;
        for (int t = 0; t < nt; t += 2) {
            const bool last = (t == nt - 2);
            const char* a1 = cA + (size_t)(t + 1) * kstep;
            const char* a2 = last ? nA : cA + (size_t)(t + 2) * kstep; const char* b2 = last ? nB : cB + (size_t)(t + 2) * kstep;
            const char* a3 = a2 + kstep; const char* b3 = b2 + kstep;
            if (last && has_next) S.a_ready(nxt);
            if constexpr (SP2) {
            PG8_LDB(B0, 0, 0); PG8_LDB(B1, 0, 1); PG8_SCHED; PG8_LDA(At, 0, 0); PG8_STAGE(PG8_SA(1, 1), a1 + hstep, voffA);
            PG8_WAIT_V(8); PG8_WAIT_L(0); PG8_BAR; PG8_MMA(0, 0, At, B0); PG8_MMA(0, 1, At, B1); PG8_BAR; PG8_SCHED;
            PG8_LDA(At, 0, 1); PG8_STAGE(PG8_SB(0, 0), b2, voffB); PG8_STAGE(PG8_SB(0, 1), b2 + hstep, voffB); PG8_STAGE(PG8_SA(0, 0), a2, voffA);
            PG8_WAIT_V(8); PG8_WAIT_L(0); PG8_BAR; PG8_MMA(1, 0, At, B0); PG8_MMA(1, 1, At, B1); PG8_BAR; PG8_SCHED;
            PG8_LDB(B0, 1, 0); PG8_LDB(B1, 1, 1); PG8_SCHED; PG8_LDA(At, 1, 0); PG8_STAGE(PG8_SA(0, 1), a2 + hstep, voffA);
            PG8_WAIT_V(8); PG8_WAIT_L(0); PG8_BAR; PG8_MMA(0, 0, At, B0); PG8_MMA(0, 1, At, B1); PG8_BAR; PG8_SCHED;
            PG8_LDA(At, 1, 1); PG8_STAGE(PG8_SB(1, 0), b3, voffB); PG8_STAGE(PG8_SB(1, 1), b3 + hstep, voffB); PG8_STAGE(PG8_SA(1, 0), a3, voffA);
            PG8_WAIT_V(8); PG8_WAIT_L(0); PG8_BAR; PG8_MMA(1, 0, At, B0); PG8_MMA(1, 1, At, B1); PG8_BAR; PG8_SCHED;
            } else {
            PG8_LDB(B0, 0, 0); PG8_SCHED; PG8_LDA(At, 0, 0); PG8_STAGE(PG8_SA(1, 1), a1 + hstep, voffA);
            PG8_WAIT_L(8); PG8_BAR; PG8_WAIT_L(0); PG8_MMA(0, 0, At, B0); PG8_BAR; PG8_SCHED;
            PG8_LDB(B1, 0, 1); PG8_STAGE(PG8_SB(0, 0), b2, voffB);
            PG8_BAR; PG8_WAIT_L(0); PG8_MMA(0, 1, At, B1); PG8_BAR;
            PG8_LDA(At, 0, 1); PG8_STAGE(PG8_SA(0, 0), a2, voffA);
            PG8_BAR; PG8_WAIT_L(0); PG8_MMA(1, 0, At, B0); PG8_BAR; PG8_SCHED;
            PG8_STAGE(PG8_SB(0, 1), b2 + hstep, voffB);
            PG8_WAIT_V(6); PG8_BAR; PG8_MMA(1, 1, At, B1); PG8_BAR;
            PG8_LDB(B0, 1, 0); PG8_SCHED; PG8_LDA(At, 1, 0); PG8_STAGE(PG8_SA(0, 1), a2 + hstep, voffA);
            PG8_WAIT_L(8); PG8_BAR; PG8_WAIT_L(0); PG8_MMA(0, 0, At, B0); PG8_BAR; PG8_SCHED;
            PG8_LDB(B1, 1, 1); PG8_STAGE(PG8_SB(1, 0), b3, voffB);
            PG8_BAR; PG8_WAIT_L(0); PG8_MMA(0, 1, At, B1); PG8_BAR;
            PG8_LDA(At, 1, 1); PG8_STAGE(PG8_SA(1, 0), a3, voffA);
            PG8_BAR; PG8_WAIT_L(0); PG8_MMA(1, 0, At, B0); PG8_BAR; PG8_SCHED;
            PG8_STAGE(PG8_SB(1, 1), b3 + hstep, voffB);
            PG8_WAIT_V(6); PG8_BAR; PG8_MMA(1, 1, At, B1); PG8_BAR;
            }
        }
        if constexpr (ALIGN_EPI) { if (wr == 0) PG8_BAR; }
        if constexpr (!Epi::AFTER_DRAIN) { E(acc, cur, wr, wc, fr, fq); S.done(cur); }
        if (!has_next) break;
#pragma unroll
        for (int a = 0; a < 2; ++a)
#pragma unroll
            for (int b = 0; b < 2; ++b)
#pragma unroll
                for (int m = 0; m < 4; ++m)
#pragma unroll
                    for (int n = 0; n < 2; ++n) acc[a][b][m][n] = (f32x4){0.f, 0.f, 0.f, 0.f};
        cur = nxt; cA = nA; cB = nB; ++ui;
        if constexpr (ALIGN_EPI) { if (wr == 1) PG8_BAR; }
    }
    PG8_WAIT_V(0);
    if constexpr (!ALIGN_EPI) { if (wr == 0) PG8_BAR; }
    PG8_BAR;
    if constexpr (Epi::AFTER_DRAIN) { E.fused(acc, cur, wr, wc, fr, fq, lds, wid, lane); S.done(cur); }
#undef PG8_SA
#undef PG8_SB
#undef PG8_STAGE
#undef PG8_LDA
#undef PG8_LDB
#undef PG8_MMA
#undef PG8_WAIT_V
#undef PG8_WAIT_L
#undef PG8_BAR
#undef PG8_SCHED
}
}
#define GAS __attribute__((address_space(1)))
#define LAS __attribute__((address_space(3)))
typedef unsigned short bf16;
typedef unsigned v4u __attribute__((ext_vector_type(4)));
typedef float f32x4 __attribute__((ext_vector_type(4)));
typedef short bf16x8 __attribute__((ext_vector_type(8)));
typedef GAS unsigned gu32;
typedef GAS unsigned long long gu64;
#define RLX_AGENT __ATOMIC_RELAXED, __HIP_MEMORY_SCOPE_AGENT
#define LDS_WAIT() asm volatile("s_waitcnt lgkmcnt(0)" ::: "memory")
#define VM_WAIT() asm volatile("s_waitcnt vmcnt(0)" ::: "memory")
__device__ __forceinline__ unsigned long long rt() { return __builtin_amdgcn_s_memrealtime(); }
__device__ __forceinline__ unsigned f2bf(float f) { unsigned u = __builtin_bit_cast(unsigned, f); return (u + 0x7fffu + ((u >> 16) & 1u)) >> 16; }
__device__ __forceinline__ unsigned pk2(float lo, float hi) { return f2bf(lo) | (f2bf(hi) << 16); }
#define XB_TMO      128
#define XB_XCNT(j)  (256  + 64 * (j))
#define XB_XSUB(j)  (1280 + 64 * (j))
#define XB_XGEN(j)  (2304 + 64 * (j))
#define XB_TOP      3328
#define XB_TOPGEN   3392
#define XCD_BAR_WORDS 3456
#define XB_SPIN_CAP (1u << 18)

__device__ __forceinline__ unsigned xb_ld(unsigned* p)              { return __hip_atomic_load(p, __ATOMIC_RELAXED, __HIP_MEMORY_SCOPE_AGENT); }
__device__ __forceinline__ unsigned xb_add(unsigned* p, unsigned v) { return __hip_atomic_fetch_add(p, v, __ATOMIC_RELAXED, __HIP_MEMORY_SCOPE_AGENT); }
__device__ __forceinline__ unsigned xb_xcc_id() { return (unsigned)__builtin_amdgcn_s_getreg((3 << 11) | 20) & 0xFu; }
#define XB_SPIN(cond, bar) do { unsigned _sp = 0; while (cond) { __builtin_amdgcn_s_sleep(1); \
    if ((++_sp & 255u) == 0u) { if (xb_ld(&(bar)[XB_TMO])) break; if (_sp > XB_SPIN_CAP) { atomicAdd(&(bar)[XB_TMO], 1u); break; } } } } while (0)

struct XcdBarrier {
    unsigned* bar; unsigned x;
    volatile LAS unsigned* st;
};

__device__ __forceinline__ XcdBarrier xcd_barrier_post(unsigned* bar, volatile LAS unsigned* st) {
    XcdBarrier b; b.bar = bar; b.x = xb_xcc_id(); b.st = st;
    if (threadIdx.x == 0) (void)xb_add(&bar[XB_XCNT(b.x)], 1u);
    return b;
}
__device__ __forceinline__ void xcd_barrier_complete(unsigned* bar, unsigned x, unsigned& nloc, unsigned& nx) {
    const unsigned G = gridDim.x * gridDim.y * gridDim.z;
    unsigned sum, cnt, mine, sp = 0u;
    for (;;) {
        sum = 0u; cnt = 0u; mine = 0u;
#pragma unroll
        for (unsigned j = 0; j < 16; ++j) { const unsigned c = xb_ld(&bar[XB_XCNT(j)]); sum += c; cnt += (c > 0u) ? 1u : 0u; mine = (j == x) ? c : mine; }
        if (sum == G) break;
        __builtin_amdgcn_s_sleep(1);
        if ((++sp & 255u) == 0u) { if (xb_ld(&bar[XB_TMO])) break; if (sp > XB_SPIN_CAP) { atomicAdd(&bar[XB_TMO], 1u); break; } }
    }
    nloc = mine > 0u ? mine : 1u; nx = cnt > 0u ? cnt : 1u;
}

__device__ __forceinline__ void xcd_barrier(const XcdBarrier& b) {
    asm volatile("s_waitcnt vmcnt(0)" ::: "memory");
    __syncthreads();
    if (threadIdx.x == 0) {
        unsigned* bar = b.bar;
        __builtin_amdgcn_s_waitcnt(0);
        unsigned nloc = b.st[0], nx = b.st[1];
        if (nloc == 0u) { xcd_barrier_complete(bar, b.x, nloc, nx); b.st[0] = nloc; b.st[1] = nx; }
        const unsigned old = xb_add(&bar[XB_XSUB(b.x)], 1u);
        const unsigned gen = old / nloc;
        if (old + 1u == (gen + 1u) * nloc) {
            __builtin_amdgcn_fence(__ATOMIC_RELEASE, "agent");
            asm volatile("s_waitcnt vmcnt(0)" ::: "memory");
            const unsigned og = xb_add(&bar[XB_TOP], 1u);
            const unsigned tg = og / nx;
            if (og + 1u == (tg + 1u) * nx) xb_add(&bar[XB_TOPGEN], 1u);
            else XB_SPIN(xb_ld(&bar[XB_TOPGEN]) == tg, bar);
            __builtin_amdgcn_fence(__ATOMIC_ACQUIRE, "agent");
            xb_add(&bar[XB_XGEN(b.x)], 1u);
            asm volatile("s_waitcnt vmcnt(0)" ::: "memory");
        } else {
            XB_SPIN(xb_ld(&bar[XB_XGEN(b.x)]) == gen, bar);
            __builtin_amdgcn_fence(__ATOMIC_ACQUIRE, "agent");
            asm volatile("s_waitcnt vmcnt(0)" ::: "memory");
        }
    }
    __syncthreads();
}
constexpr int NWAVES = 8;
constexpr size_t MiB = 1u << 20;
constexpr size_t WS_CTL = 0, CTL_ZERO_BYTES = 65536;
constexpr size_t WS_W1 = 1 * MiB, WS_WO = 6 * MiB, WS_WGU = 8 * MiB, WS_WD = 19 * MiB, WS_WPG = 25 * MiB, WS_WPP = 27 * MiB;
constexpr size_t WS_RX = 28 * MiB, WS_SS1 = 29 * MiB, WS_SS2 = 32 * MiB;
constexpr size_t WS_XB = 36 * MiB;
constexpr size_t WS_PB = 102 * MiB, WS_PP = 119 * MiB;
constexpr size_t WS_Q = 185 * MiB, WS_KP = 218 * MiB, WS_VP = 250 * MiB, WS_KS = 282 * MiB, WS_VS = 300 * MiB, WS_GLU = 318 * MiB, WS_MIX = 351 * MiB;
constexpr size_t WS_ACT = 185 * MiB;
constexpr size_t WS_END = 417 * MiB;
static_assert(WS_XB + (size_t)R * D * 2 <= WS_PB && WS_PB + (size_t)R * PLE * 2 <= WS_PP && WS_PP + (size_t)R * D * 2 <= WS_Q && WS_Q + (size_t)R * 512 * 2 <= WS_KP &&
              WS_KP + (size_t)(RP / 64) * KVT_BYTES <= WS_KS && WS_KS + (size_t)DB * 9 * KVT_BYTES <= WS_GLU && WS_GLU + (size_t)R * 512 * 2 <= WS_MIX &&
              WS_MIX + (size_t)R * D * 2 <= WS_END && WS_ACT + (size_t)R * DFF * 2 <= WS_END && WS_SS1 + (size_t)R * 64 <= WS_SS2 && WS_SS2 + (size_t)R * 64 <= WS_XB && WS_RX + (size_t)R * 4 <= WS_SS1, "d_ws map");
constexpr int CW_BAR = 4096, CW_Q = 8192;
constexpr int RING_OFF = 0, RING_BYTES = 131072;
constexpr int LDSCTL_OFF = RING_BYTES, MISC_OFF = LDSCTL_OFF + 320;
constexpr int ATT_TAB = 132096, ATT_LSC = ATT_TAB + 8192;
constexpr int LDS_BYTES = 147456;
static_assert(ATT_LSC + 2048 <= LDS_BYTES && MISC_OFF + 128 <= ATT_TAB, "LDS map");

__device__ __forceinline__ float wave_sum(float v) {
#pragma unroll
    for (int o = 1; o < 64; o <<= 1) v += __shfl_xor(v, o);
    return v;
}
__device__ __forceinline__ float wave_max(float v) {
#pragma unroll
    for (int o = 1; o < 64; o <<= 1) v = fmaxf(v, __shfl_xor(v, o));
    return v;
}
__device__ __forceinline__ int map_win(int n) {
    if (n < 1536) { const int sec = n >> 9, nn = n & 511, h = nn >> 6, d = nn & 63; return sec * 512 + 256 * (h >> 2) + 128 * (d >> 5) + 32 * (h & 3) + (d & 31); }
    if (n < 2048) { const int i = n - 1536; return 1536 + 256 * (i >> 7) + (i & 127); }
    const int i = n - 2048; return 1536 + 256 * (i >> 7) + 128 + (i & 127);
}
__device__ __forceinline__ int map_gu(int n) {
    if (n < DFF) return 256 * (n >> 7) + (n & 127);
    const int i = n - DFF; return 256 * (i >> 7) + 128 + (i & 127);
}
template <int MAP> __device__ __forceinline__ void p0_transpose_item(const float* W, const float* gain, int K, int N, bf16* WT, LAS float* scr, int item, int lane) {
    const int nblk = N / 32, kb = item / nblk, nb = item % nblk, k0 = 64 * kb, n0 = 32 * nb;
    { const int nq = lane & 7, kr = lane >> 3; f32x4 v[8];
#pragma unroll
      for (int i = 0; i < 8; ++i) v[i] = *(const GAS f32x4*)(W + (size_t)(k0 + 8 * i + kr) * N + n0 + 4 * nq);
#pragma unroll
      for (int i = 0; i < 8; ++i) { const int kk = 8 * i + kr; const float gk = gain ? gain[k0 + kk] : 1.0f;
#pragma unroll
          for (int e = 0; e < 4; ++e) scr[kk * 33 + 4 * nq + e] = v[i][e] * gk; } }
    LDS_WAIT(); asm volatile("" ::: "memory");
    const int c = lane & 7;
#pragma unroll
    for (int j = 0; j < 4; ++j) { const int n = (lane >> 3) + 8 * j; const LAS float* s = scr + (8 * c) * 33 + n;
        v4u o; o.x = pk2(s[0 * 33], s[1 * 33]); o.y = pk2(s[2 * 33], s[3 * 33]); o.z = pk2(s[4 * 33], s[5 * 33]); o.w = pk2(s[6 * 33], s[7 * 33]);
        const int ns = n0 + n, dr = MAP == 0 ? ns : (MAP == 1 ? map_win(ns) : map_gu(ns));
        *(GAS v4u*)(WT + (size_t)dr * K + k0 + 8 * c) = o; }
    LDS_WAIT(); asm volatile("" ::: "memory");
}

namespace att {
typedef short bf16x8 __attribute__((ext_vector_type(8)));
typedef short s16x4 __attribute__((ext_vector_type(4)));
typedef float f32x16 __attribute__((ext_vector_type(16)));
typedef unsigned u32x4 __attribute__((ext_vector_type(4)));
typedef float f32x2_t __attribute__((ext_vector_type(2))); typedef __bf16 bf16x2_t __attribute__((ext_vector_type(2)));
typedef short v4i16_t __attribute__((ext_vector_type(4)));
typedef LAS const char* lds_cptr;
constexpr int BUFB = 65536, HSLOT = 16384;
__device__ __forceinline__ int crow(int r, int hi) { return (r & 3) + 8 * (r >> 2) + 4 * hi; }
__device__ __forceinline__ void glds16(const void* gsrc, unsigned lds_dst) { unsigned keep;
    asm volatile("s_mov_b32 %0, m0\n\ts_mov_b32 m0, %2\n\ts_nop 0\n\tglobal_load_lds_dwordx4 %1, off\n\ts_mov_b32 m0, %0" : "=&s"(keep) : "v"(gsrc), "s"(lds_dst) : "memory"); }
__device__ __forceinline__ unsigned cvtpk_s(float lo, float hi) { f32x2_t v = {lo, hi}; bf16x2_t b = __builtin_convertvector(v, bf16x2_t); return __builtin_bit_cast(unsigned, b); }
__device__ __forceinline__ s16x4 vtr(lds_cptr p) { return __builtin_bit_cast(s16x4, __builtin_amdgcn_ds_read_tr16_b64_v4i16((LAS v4i16_t*)p)); }
#define ATT_WAIT_BAR() asm volatile("s_waitcnt vmcnt(0) lgkmcnt(0)\n\ts_barrier" ::: "memory")

struct AUnit { const bf16* Qrow; const unsigned char* KV; bf16* Orow; int nt, hg, sample, c0rel; };

__device__ __forceinline__ void attn_unit(const AUnit& U, LAS unsigned char* lds, int wid, int lane) {
    const int r32 = lane & 31, hi = lane >> 5, hl = wid & 3, ci = wid >> 2, head = 4 * U.hg + hl, nt = U.nt, own = U.c0rel + ci;
    const bool wact = !U.sample || ci == 0, two = !U.sample;
    const unsigned lds0 = (unsigned)(size_t)lds;
    const LAS float* tabh = (const LAS float*)(lds + ATT_TAB) + head * 256;
    LAS float* lsc = (LAS float*)(lds + ATT_LSC) + wid * 64;
    bf16x8 qr[2][4];
    { const bf16* Qw = U.Qrow + (size_t)((wact ? 64 * ci : 0) + r32) * 512 + head * 64 + hi * 8; const bf16* Qw1 = Qw + (two ? 32 * 512 : 0);
#pragma unroll
      for (int d0 = 0; d0 < 4; ++d0) { qr[0][d0] = *(const bf16x8*)(Qw + d0 * 16); qr[1][d0] = *(const bf16x8*)(Qw1 + d0 * 16); } }
    const float cfar = tabh[255];
    f32x16 o[2][2]; o[0][0] = f32x16{}; o[0][1] = f32x16{}; o[1][0] = f32x16{}; o[1][1] = f32x16{}; float lsum[2] = {0.f, 0.f};
    const unsigned char* kvsrc = U.KV + U.hg * 65536 + wid * 1024 + lane * 16;
    const unsigned kvdst = lds0 + wid * 1024;
#define ATT_DMA(ti, b) do { _Pragma("unroll") for (int j_ = 0; j_ < 8; ++j_) \
        glds16(kvsrc + (size_t)(ti) * KVT_BYTES + j_ * 8192, (unsigned)__builtin_amdgcn_readfirstlane(kvdst + (b) * BUFB + j_ * 8192)); } while (0)
    ATT_DMA(0, 0);
    for (int ti = 0; ti < nt; ++ti) {
        ATT_WAIT_BAR();
        const int b = ti & 1;
        if (ti + 1 < nt) ATT_DMA(ti + 1, b ^ 1);
        const int jt = own - ti;
        if (wact && jt >= 0 && jt <= 8) {
            const bool half = U.sample && jt == 0;
            const lds_cptr kp = (lds_cptr)(lds + b * BUFB + hl * HSLOT + hi * 1024 + r32 * 16);
            const float c0 = jt >= 3 ? cfar : 0.f;
            u32x4 pw[2][4];
#pragma unroll
            for (int h2 = 0; h2 < 2; ++h2) {
                if (h2 == 1 && !two) { pw[1][0] = pw[0][0]; pw[1][1] = pw[0][1]; pw[1][2] = pw[0][2]; pw[1][3] = pw[0][3]; continue; }
                f32x16 p0, p1;
#pragma unroll
                for (int r = 0; r < 16; ++r) { p0[r] = c0; p1[r] = c0; }
#pragma unroll
                for (int d0 = 0; d0 < 4; ++d0) {
                    const bf16x8 k0 = *(const LAS bf16x8*)(kp + d0 * 2048);
                    p0 = __builtin_amdgcn_mfma_f32_32x32x16_bf16(k0, qr[h2][d0], p0, 0, 0, 0);
                    if (!half) { const bf16x8 k1 = *(const LAS bf16x8*)(kp + d0 * 2048 + 512); p1 = __builtin_amdgcn_mfma_f32_32x32x16_bf16(k1, qr[h2][d0], p1, 0, 0, 0); }
                }
                if (jt < 3) { const LAS float* tp = tabh + (191 - (32 * h2 + r32) - 64 * jt + 4 * hi);
#pragma unroll
                    for (int r = 0; r < 16; ++r) { p0[r] += tp[(r & 3) + 8 * (r >> 2)]; p1[r] += tp[32 + (r & 3) + 8 * (r >> 2)]; } }
                float sacc = 0.f;
#pragma unroll
                for (int r = 0; r < 16; ++r) { p0[r] = __builtin_amdgcn_exp2f(p0[r]); p1[r] = half ? 0.f : __builtin_amdgcn_exp2f(p1[r]); sacc += p0[r] + p1[r]; }
                lsum[h2] += sacc;
#pragma unroll
                for (int k = 0; k < 2; ++k) { pw[h2][k] = (u32x4){cvtpk_s(p0[8 * k], p0[8 * k + 1]), cvtpk_s(p0[8 * k + 2], p0[8 * k + 3]), cvtpk_s(p0[8 * k + 4], p0[8 * k + 5]), cvtpk_s(p0[8 * k + 6], p0[8 * k + 7])};
                    pw[h2][2 + k] = (u32x4){cvtpk_s(p1[8 * k], p1[8 * k + 1]), cvtpk_s(p1[8 * k + 2], p1[8 * k + 3]), cvtpk_s(p1[8 * k + 4], p1[8 * k + 5]), cvtpk_s(p1[8 * k + 6], p1[8 * k + 7])}; }
            }
            const lds_cptr vp = (lds_cptr)(lds + b * BUFB + hl * HSLOT + 8192 + ((lane >> 4) & 1) * 32 + (lane & 3) * 8 + (4 * hi + ((lane & 15) >> 2)) * 64);
#pragma unroll
            for (int d0 = 0; d0 < 2; ++d0)
#pragma unroll
                for (int ks = 0; ks < 4; ++ks) { if (half && ks >= 2) continue;
                    const s16x4 lo = vtr(vp + d0 * 4096 + ks * 1024), hh = vtr(vp + d0 * 4096 + ks * 1024 + 512);
                    const bf16x8 vf = (bf16x8){lo[0], lo[1], lo[2], lo[3], hh[0], hh[1], hh[2], hh[3]};
                    o[0][d0] = __builtin_amdgcn_mfma_f32_32x32x16_bf16(__builtin_bit_cast(bf16x8, pw[0][ks]), vf, o[0][d0], 0, 0, 0);
                    if (two) o[1][d0] = __builtin_amdgcn_mfma_f32_32x32x16_bf16(__builtin_bit_cast(bf16x8, pw[1][ks]), vf, o[1][d0], 0, 0, 0); }
        }
    }
    ATT_WAIT_BAR();
    if (wact) {
#pragma unroll
        for (int h2 = 0; h2 < 2; ++h2) { if (h2 == 1 && !two) continue;
            float ls = lsum[h2];
            { auto rr = __builtin_amdgcn_permlane32_swap(__float_as_uint(ls), __float_as_uint(ls), false, false); ls = __uint_as_float(rr[0]) + __uint_as_float(rr[1]); }
            if (hi == 0) lsc[32 * h2 + r32] = ls;
            asm volatile("s_waitcnt lgkmcnt(0)" ::: "memory");
            LAS bf16* stg = (LAS bf16*)(lds + wid * 8192 + h2 * 4096);
#pragma unroll
            for (int r = 0; r < 16; ++r) { const int orow = crow(r, hi); const float rl = __builtin_amdgcn_rcpf(lsc[32 * h2 + orow]);
#pragma unroll
                for (int d0 = 0; d0 < 2; ++d0) stg[orow * 64 + d0 * 32 + r32] = (bf16)f2bf(o[h2][d0][r] * rl); }
            asm volatile("s_waitcnt lgkmcnt(0)" ::: "memory");
            bf16* Ow = U.Orow + (size_t)(64 * ci + 32 * h2) * D + head * 64;
#pragma unroll
            for (int i = 0; i < 4; ++i) { const int row = i * 8 + (lane >> 3), ch = lane & 7; const u32x4 v = *(const LAS u32x4*)(stg + row * 64 + ch * 8); *(u32x4*)(Ow + (size_t)row * D + ch * 8) = v; }
        }
    }
    ATT_WAIT_BAR();
#undef ATT_DMA
}
}

__device__ __forceinline__ void conv_item(int item, const bf16* GLU, const float* st, const float* cw, const float* cb, const float* lg, const float* lb, bf16* MIX, LAS unsigned char* lds, int tid) {
    const bool samp = item >= RP / 32; const int b = samp ? item - RP / 32 : item >> 8, t0 = samp ? 0 : (item & 255) * 32, rowbase = samp ? RP + DS * b : b * SEQ;
    const int ch = tid, wid = tid >> 6, lane = tid & 63;
    LAS bf16* xs = (LAS bf16*)lds;
    LAS float* ybuf = (LAS float*)(lds + 65536);
#pragma unroll
    for (int i = 0; i < 8; ++i) { const int k = wid + 8 * i; if (k < 62) { const int tp = t0 - CH + k; pg8::u32x4 v = (pg8::u32x4){0u, 0u, 0u, 0u};
        if (tp >= 0) v = *(const pg8::u32x4*)(GLU + (size_t)(rowbase + tp) * 512 + 8 * lane);
        else if (samp) { const float* sp = st + ((size_t)b * CH + (CH + tp)) * CW + 8 * lane; v = pg8::pack8(*(const f32x4*)sp, *(const f32x4*)(sp + 4)); }
        *(LAS pg8::u32x4*)(xs + k * 512 + 8 * lane) = v; } }
    float w[CONVW];
#pragma unroll
    for (int j = 0; j < CONVW; ++j) w[j] = cw[j * CW + ch];
    const float bias = cb[ch];
    __syncthreads();
#pragma unroll 1
    for (int hb = 0; hb < 2; ++hb) {
        float x[46];
#pragma unroll
        for (int k = 0; k < 46; ++k) x[k] = __uint_as_float((unsigned)xs[(16 * hb + k) * 512 + ch] << 16);
        float y[16];
#pragma unroll
        for (int i = 0; i < 16; ++i) y[i] = bias;
#pragma unroll
        for (int j = 0; j < CONVW; ++j)
#pragma unroll
            for (int i = 0; i < 16; ++i) y[i] += w[j] * x[i + j];
#pragma unroll
        for (int i = 0; i < 16; ++i) ybuf[(16 * hb + i) * 512 + ch] = y[i];
    }
    __syncthreads();
    f32x4 g0 = *(const f32x4*)(lg + 8 * lane), g1 = *(const f32x4*)(lg + 8 * lane + 4), b0 = *(const f32x4*)(lb + 8 * lane), b1 = *(const f32x4*)(lb + 8 * lane + 4);
#pragma unroll
    for (int q = 0; q < 4; ++q) { const int i = 4 * wid + q;
        f32x4 v0 = *(const LAS f32x4*)(ybuf + i * 512 + 8 * lane), v1 = *(const LAS f32x4*)(ybuf + i * 512 + 8 * lane + 4);
        const float mean = wave_sum((v0[0] + v0[1]) + (v0[2] + v0[3]) + (v1[0] + v1[1]) + (v1[2] + v1[3])) * (1.0f / CW);
        v0 = v0 - mean; v1 = v1 - mean;
        const f32x4 q0 = v0 * v0, q1 = v1 * v1;
        const float rstd = rsqrtf(wave_sum((q0[0] + q0[1]) + (q0[2] + q0[3]) + (q1[0] + q1[1]) + (q1[2] + q1[3])) * (1.0f / CW) + EPS);
        v0 = v0 * rstd * g0 + b0; v1 = v1 * rstd * g1 + b1;
#pragma unroll
        for (int e = 0; e < 4; ++e) { v0[e] *= pg8::sigm(v0[e]); v1[e] *= pg8::sigm(v1[e]); }
        *(pg8::u32x4*)(MIX + (size_t)(rowbase + t0 + i) * D + 512 + 8 * lane) = pg8::pack8(v0, v1); }
    __syncthreads();
}


constexpr int SG_LD = 68;
template <class Epi> __device__ __forceinline__ void sgemm64(const bf16* A, const bf16* Bt, int K_, int tile, const Epi& E, LAS unsigned char* lds) {
    int tid_ = threadIdx.x; asm volatile("" : "+v"(tid_)); int K = K_; asm volatile("" : "+s"(K));
    const int lane = tid_ & 63, wave = __builtin_amdgcn_readfirstlane(tid_ >> 6), fr = lane & 15, fq = lane >> 4, kg = wave & 3, nh = wave >> 2, tr = tile >> 4, tc = tile & 15;
    const int Kq = K >> 2;
    const bf16* ap = A + (size_t)(64 * tr + fr) * K + kg * Kq + 8 * fq;
    const bf16* bp = Bt + (size_t)(64 * tc + 32 * nh + fr) * K + kg * Kq + 8 * fq;
    const size_t r16 = (size_t)16 * K;
    f32x4 acc[4][2];
#pragma unroll
    for (int mi = 0; mi < 4; ++mi) { acc[mi][0] = (f32x4){0.f, 0.f, 0.f, 0.f}; acc[mi][1] = acc[mi][0]; }
    bf16x8 a[2][4], p[2][2], an[2][4], pn[2][2];
#pragma unroll
    for (int s = 0; s < 2; ++s) {
#pragma unroll
        for (int mi = 0; mi < 4; ++mi) a[s][mi] = *(const bf16x8*)(ap + mi * r16 + 32 * s);
        p[s][0] = *(const bf16x8*)(bp + 32 * s); p[s][1] = *(const bf16x8*)(bp + r16 + 32 * s); }
    for (int k = 64; k <= Kq; k += 64) {
        const int kn = k < Kq ? k : 0;
#pragma unroll
        for (int s = 0; s < 2; ++s) {
#pragma unroll
            for (int mi = 0; mi < 4; ++mi) an[s][mi] = *(const bf16x8*)(ap + mi * r16 + kn + 32 * s);
            pn[s][0] = *(const bf16x8*)(bp + kn + 32 * s); pn[s][1] = *(const bf16x8*)(bp + r16 + kn + 32 * s); }
#pragma unroll
        for (int s = 0; s < 2; ++s)
#pragma unroll
            for (int mi = 0; mi < 4; ++mi) { acc[mi][0] = __builtin_amdgcn_mfma_f32_16x16x32_bf16(p[s][0], a[s][mi], acc[mi][0], 0, 0, 0); acc[mi][1] = __builtin_amdgcn_mfma_f32_16x16x32_bf16(p[s][1], a[s][mi], acc[mi][1], 0, 0, 0); }
#pragma unroll
        for (int s = 0; s < 2; ++s) {
#pragma unroll
            for (int mi = 0; mi < 4; ++mi) a[s][mi] = an[s][mi];
            p[s][0] = pn[s][0]; p[s][1] = pn[s][1]; }
    }
    LAS float* part = (LAS float*)lds;
#pragma unroll
    for (int mi = 0; mi < 4; ++mi)
#pragma unroll
        for (int ni = 0; ni < 2; ++ni) *(LAS f32x4*)(part + (kg * 64 + 16 * mi + fr) * SG_LD + 32 * nh + 16 * ni + 4 * fq) = acc[mi][ni];
    __syncthreads();
    const int row = tid_ >> 3, c8 = (tid_ & 7) * 8;
    f32x4 v0 = *(const LAS f32x4*)(part + row * SG_LD + c8), v1 = *(const LAS f32x4*)(part + row * SG_LD + c8 + 4);
#pragma unroll
    for (int g = 1; g < 4; ++g) { v0 = v0 + *(const LAS f32x4*)(part + (g * 64 + row) * SG_LD + c8); v1 = v1 + *(const LAS f32x4*)(part + (g * 64 + row) * SG_LD + c8 + 4); }
    E(64 * tr + row, 64 * tc + c8, tc, tid_ & 7, v0, v1);
    __syncthreads();
}
__device__ __forceinline__ float oct_sum(float s) { s += __shfl_xor(s, 1); s += __shfl_xor(s, 2); s += __shfl_xor(s, 4); return s; }
template <bool BF> struct SEpiRes {
    const float* base; bf16* HB; float* SS;
    __device__ __forceinline__ void operator()(int row, int col, int tc, int l8, f32x4 v0, f32x4 v1) const {
        const size_t o = (size_t)row * D + col;
        if (BF) { const pg8::u32x4 w = *(const pg8::u32x4*)(HB + o); v0 = v0 + pg8::bf_lo4(w); v1 = v1 + pg8::bf_hi4(w); }
        else { v0 = v0 + *(const f32x4*)(base + o); v1 = v1 + *(const f32x4*)(base + o + 4); }
        *(pg8::u32x4*)(HB + o) = pg8::pack8(v0, v1);
        const f32x4 q0 = v0 * v0, q1 = v1 * v1;
        const float ss = oct_sum(((q0[0] + q0[1]) + (q0[2] + q0[3])) + ((q1[0] + q1[1]) + (q1[2] + q1[3])));
        if (l8 == 0) SS[(size_t)row * 16 + tc] = ss;
    }
};
struct SEpiFinal {
    const float* SS; const bf16* PP; const bf16* HB; float* Y;
    __device__ __forceinline__ void operator()(int row, int col, int tc, int l8, f32x4 v0, f32x4 v1) const {
        const float r = rsqrtf(oct_sum(SS[(size_t)row * 16 + 2 * l8] + SS[(size_t)row * 16 + 2 * l8 + 1]) * (1.0f / D) + EPS);
        const size_t o = (size_t)row * D + col;
        const pg8::u32x4 pw = *(const pg8::u32x4*)(PP + o), hw = *(const pg8::u32x4*)(HB + o);
        const f32x4 p0 = pg8::bf_lo4(pw), p1 = pg8::bf_hi4(pw); f32x4 h0 = pg8::bf_lo4(hw), h1 = pg8::bf_hi4(hw);
#pragma unroll
        for (int e = 0; e < 4; ++e) { h0[e] += pg8::sigm(v0[e] * r) * p0[e]; h1[e] += pg8::sigm(v1[e] * r) * p1[e]; }
        *(f32x4*)(Y + o) = h0; *(f32x4*)(Y + o + 4) = h1;
    }
};

#ifndef REP_P0
#define REP_P0 1
#endif
#ifndef REP_P1
#define REP_P1 1
#endif
#ifndef REP_P2
#define REP_P2 1
#endif
#ifndef REP_P3
#define REP_P3 1
#endif
#ifndef REP_P4
#define REP_P4 1
#endif
struct Args { const float* in[23]; float* out; unsigned char* ws; };
constexpr int N_ATT_S = 2 * DB, N_ATT_P = NB * 64 * 2, N_CONV = R / 32;
constexpr int I_WO = (D / 64) * (D / 32), I_WGU = (D / 64) * (2 * DFF / 32), N_WCV = (I_WO + I_WGU) / 8;
constexpr int N_P2 = N_ATT_S + N_ATT_P + N_CONV + N_WCV;
static_assert((I_WO + I_WGU) % 8 == 0, "weight conversion entries");
#define W1t ((bf16*)(ws + WS_W1))
#define WOt ((bf16*)(ws + WS_WO))
#define WGUt ((bf16*)(ws + WS_WGU))
#define WDt ((bf16*)(ws + WS_WD))
#define WPGt ((bf16*)(ws + WS_WPG))
#define WPPt ((bf16*)(ws + WS_WPP))
#define RX ((float*)(ws + WS_RX))
#define SS1 ((float*)(ws + WS_SS1))
#define SS2 ((float*)(ws + WS_SS2))
#define XB ((bf16*)(ws + WS_XB))
#define PB ((bf16*)(ws + WS_PB))
#define PPb ((bf16*)(ws + WS_PP))
#define Qb ((bf16*)(ws + WS_Q))
#define KVP (ws + WS_KP)
#define KVS (ws + WS_KS)
#define GLUb ((bf16*)(ws + WS_GLU))
#define MIXb ((bf16*)(ws + WS_MIX))
#define ACTb ((bf16*)(ws + WS_ACT))
#define Y (out + OY)
__global__ void __launch_bounds__(NWAVES * 64, 2) mk_fwd(Args args) {
    extern __shared__ __attribute__((aligned(16))) unsigned char lds_[];
    LAS unsigned char* lds = (LAS unsigned char*)lds_;
    volatile LAS unsigned* MISC = (volatile LAS unsigned*)(lds + MISC_OFF);
    const int G = gridDim.x, vcu = (G % 8 == 0) ? ((int)blockIdx.x % 8) * (G / 8) + (int)blockIdx.x / 8 : (int)blockIdx.x;
    unsigned char* ws = args.ws; float* out = args.out;
    gu32* ctl = (gu32*)(ws + WS_CTL);
    for (int u = threadIdx.x; u < (ATT_TAB - LDSCTL_OFF) / 4; u += NWAVES * 64) ((LAS unsigned*)(lds + LDSCTL_OFF))[u] = 0u;
    __syncthreads();
    XcdBarrier bar = xcd_barrier_post((unsigned*)(ctl + CW_BAR), MISC + 8);

#ifndef SKIP_P0
    for (int rep = 0; rep < REP_P0; ++rep) {
        if (rep) xcd_barrier(bar);
        int tid0 = threadIdx.x; asm volatile("" : "+v"(tid0));
        const int lane = tid0 & 63, wave = __builtin_amdgcn_readfirstlane(tid0 >> 6);
        LAS float* scr = (LAS float*)(lds + RING_OFF + wave * 16384);
        const int gw = vcu * NWAVES + wave, NGW = G * NWAVES;
        constexpr int I_1 = (D / 64) * (INC / 32), I_PP = (PLE / 64) * (D / 32);
        constexpr int NITEMS = I_1 + I_PP;
        for (int it = gw; it < NITEMS; it += NGW) {
            if (it < I_1) p0_transpose_item<1>(args.in[8], args.in[7], D, INC, W1t, scr, it, lane);
            else p0_transpose_item<0>(args.in[22], nullptr, PLE, D, WPPt, scr, it - I_1, lane);
        }
        for (int m2 = gw; m2 < R / 2; m2 += NGW) {
            f32x4 v[2][4];
#pragma unroll
            for (int rr = 0; rr < 2; ++rr) { const int m = 2 * m2 + rr; const float* xrow = m < RP ? args.in[0] + (size_t)m * D : args.in[1] + (size_t)(m - RP) * D;
                const GAS f32x4* xr = (const GAS f32x4*)xrow + lane;
#pragma unroll
                for (int j = 0; j < 4; ++j) v[rr][j] = xr[64 * j]; }
#pragma unroll
            for (int rr = 0; rr < 2; ++rr) { const int m = 2 * m2 + rr; float s = 0.f;
#pragma unroll
                for (int j = 0; j < 4; ++j) s += (v[rr][j].x * v[rr][j].x + v[rr][j].y * v[rr][j].y) + (v[rr][j].z * v[rr][j].z + v[rr][j].w * v[rr][j].w);
                s = wave_sum(s); if (lane == 0) RX[m] = rsqrtf(s * (1.0f / D) + EPS);
                GAS unsigned long long* o8 = (GAS unsigned long long*)(XB + (size_t)m * D) + lane;
#pragma unroll
                for (int j = 0; j < 4; ++j) o8[64 * j] = (unsigned long long)pk2(v[rr][j].x, v[rr][j].y) | ((unsigned long long)pk2(v[rr][j].z, v[rr][j].w) << 32); }
        }
        for (int m8 = gw; m8 < R / 8; m8 += NGW) {
            const int m = 8 * m8; const float* prow = m < RP ? args.in[2] + (size_t)m * PLE : args.in[3] + (size_t)(m - RP) * PLE;
            const GAS f32x4* pr = (const GAS f32x4*)prow + lane; f32x4 pv[8];
#pragma unroll
            for (int j = 0; j < 8; ++j) pv[j] = pr[64 * j];
            GAS unsigned long long* o8 = (GAS unsigned long long*)(PB + (size_t)m * PLE) + lane;
#pragma unroll
            for (int j = 0; j < 8; ++j) o8[64 * j] = (unsigned long long)pk2(pv[j].x, pv[j].y) | ((unsigned long long)pk2(pv[j].z, pv[j].w) << 32);
        }
    }
#endif
    xcd_barrier(bar);

#ifndef SKIP_P1
    for (int rep = 0; rep < REP_P1; ++rep) {
        if (rep) xcd_barrier(bar);
        pg8::Gemm g{XB, W1t, R, INC, D}; pg8::StaticOrder S; S.init(R, INC, G, (int)blockIdx.x);
        pg8::Epi1 E{RX, args.in[9], args.in[10], Qb, KVP, KVS, GLUb, out};
        pg8::Gemm g2{PB, WPPt, R, D, PLE}; pg8::StaticOrder S2; S2.init(R, D, G, (int)blockIdx.x);
        pg8::EpiPP E2{PPb};
        const bool ppfirst = ((int)blockIdx.x >> 3) & 1;
        if (ppfirst) pg8::gemm_phase<pg8::EpiPP, pg8::StaticOrder, true, true>(lds + RING_OFF, g2, S2, E2);
        pg8::gemm_phase<pg8::Epi1, pg8::StaticOrder, true, true>(lds + RING_OFF, g, S, E);
        if (!ppfirst) pg8::gemm_phase<pg8::EpiPP, pg8::StaticOrder, true, true>(lds + RING_OFF, g2, S2, E2);
        { const int c0 = ((R / 256) * (INC / 256)) % G, nwgc = c0 ? G - c0 : G, cc = c0 ? (int)blockIdx.x - c0 : (int)blockIdx.x;
          if (cc >= 0) {
            int tidc = threadIdx.x; asm volatile("" : "+v"(tidc));
            const int lane = tidc & 63, wave = __builtin_amdgcn_readfirstlane(tidc >> 6), head = lane >> 3, dq = lane & 7;
            for (int m2 = cc * NWAVES + wave; m2 < DB * 512; m2 += nwgc * NWAVES) {
                const int b = m2 >> 9, j = m2 & 511, kv = j & 63;
                const GAS f32x4* sk = (const GAS f32x4*)(args.in[4] + (size_t)m2 * 512) + 2 * lane; const GAS f32x4* sv = (const GAS f32x4*)(args.in[5] + (size_t)m2 * 512) + 2 * lane;
                const f32x4 k0 = sk[0], k1 = sk[1], v0 = sv[0], v1 = sv[1];
                unsigned char* tb = KVS + (size_t)(b * 9 + (j >> 6)) * KVT_BYTES + (head >> 2) * 65536 + (head & 3) * 16384;
                *(GAS v4u*)(tb + dq * 1024 + kv * 16) = (v4u){pk2(k0.x, k0.y), pk2(k0.z, k0.w), pk2(k1.x, k1.y), pk2(k1.z, k1.w)};
                *(GAS v4u*)(tb + 8192 + (dq >> 2) * 4096 + (kv >> 4) * 1024 + (kv & 15) * 64 + (dq & 3) * 16) = (v4u){pk2(v0.x, v0.y), pk2(v0.z, v0.w), pk2(v1.x, v1.y), pk2(v1.z, v1.w)};
            }
          } }
    }
#endif
    xcd_barrier(bar);

#ifndef SKIP_P2
    for (int rep = 0; rep < REP_P2; ++rep) {
        if (rep) xcd_barrier(bar);
        { int tidt = threadIdx.x; asm volatile("" : "+v"(tidt)); const int lane = tidt & 63, wave = __builtin_amdgcn_readfirstlane(tidt >> 6);
          const float* relb = args.in[11] + wave * NREL; LAS float* T = (LAS float*)(lds + ATT_TAB) + wave * 256;
          const float gq = wave_max(fabsf(args.in[9][lane])), gk = wave_max(fabsf(args.in[10][lane]));
          float bm = -1e30f; for (int i = lane; i < NREL; i += 64) bm = fmaxf(bm, relb[i]); bm = wave_max(bm);
          const float shift = 8.0f * gq * gk + bm;
          for (int x = lane; x < 256; x += 64) { int dd = 191 - x; dd = dd < -128 ? -128 : (dd > 128 ? 128 : dd); if (x == 255) dd = 128; T[x] = (relb[dd + 128] - shift) * LOG2E; } }
        __syncthreads();
        for (;;) {
            int tid2 = threadIdx.x; asm volatile("" : "+v"(tid2));
            if (tid2 == 0) MISC[4] = __hip_atomic_fetch_add((unsigned*)(ctl + CW_Q + 64 * rep), 1u, __ATOMIC_RELAXED, __HIP_MEMORY_SCOPE_AGENT);
            __syncthreads();
            const int idx = (int)MISC[4];
            __syncthreads();
            if (idx >= N_P2) break;
            const int lane2 = tid2 & 63, wave2 = __builtin_amdgcn_readfirstlane(tid2 >> 6);
            if (idx < N_ATT_S + N_ATT_P) {
                att::AUnit U;
                if (idx < N_ATT_S) { const int b = idx >> 1; U.hg = idx & 1; U.sample = 1; U.nt = 9; U.c0rel = 8;
                    U.Qrow = Qb + (size_t)(RP + DS * b) * 512; U.KV = KVS + (size_t)(b * 9) * KVT_BYTES; U.Orow = MIXb + (size_t)(RP + DS * b) * D; }
                else { int u = idx - N_ATT_S, b, pi;
                    if (u < 480) { U.hg = u & 1; const int rest = u >> 1; b = rest / 60; pi = 4 + rest % 60; }
                    else { u -= 480; U.hg = u & 1; b = (u >> 1) & 3; pi = 3 - (u >> 3); }
                    const int c0 = 2 * pi; U.sample = 0; U.c0rel = c0 < 8 ? c0 : 8; U.nt = U.c0rel + 2; const size_t row0 = (size_t)b * SEQ + 64 * c0;
                    U.Qrow = Qb + row0 * 512; U.KV = KVP + (size_t)(b * 128 + c0 - U.c0rel) * KVT_BYTES; U.Orow = MIXb + row0 * D; }
                att::attn_unit(U, lds, wave2, lane2);
            } else if (idx < N_ATT_S + N_ATT_P + N_CONV) conv_item(idx - (N_ATT_S + N_ATT_P), GLUb, args.in[6], args.in[12], args.in[13], args.in[14], args.in[15], MIXb, lds, tid2);
            else { const int it = 8 * (idx - (N_ATT_S + N_ATT_P + N_CONV)) + wave2; LAS float* scr = (LAS float*)(lds + RING_OFF + wave2 * 16384);
                if (it < I_WO) p0_transpose_item<0>(args.in[16], nullptr, D, D, WOt, scr, it, lane2);
                else p0_transpose_item<2>(args.in[18], args.in[17], D, 2 * DFF, WGUt, scr, it - I_WO, lane2);
                __syncthreads(); }
        }
    }
#endif
    xcd_barrier(bar);

#ifndef SKIP_P3
    for (int rep = 0; rep < REP_P3; ++rep) {
        if (rep) xcd_barrier(bar);
        pg8::Gemm g{MIXb, WOt, RP, D, D}; pg8::StaticOrder S; S.init(RP, D, G, (int)blockIdx.x);
        pg8::EpiRes<false> E{args.in[0], args.in[1], XB, SS1};
        const SEpiRes<false> SE{args.in[1], XB + (size_t)RP * D, SS1 + (size_t)RP * 16};
        if (blockIdx.x & 1) for (int t = (int)blockIdx.x; t < 256; t += G) sgemm64(MIXb + (size_t)RP * D, WOt, D, t, SE, lds + RING_OFF);
        pg8::gemm_phase<pg8::EpiRes<false>, pg8::StaticOrder, true, true>(lds + RING_OFF, g, S, E);
        if (!(blockIdx.x & 1)) for (int t = (int)blockIdx.x; t < 256; t += G) sgemm64(MIXb + (size_t)RP * D, WOt, D, t, SE, lds + RING_OFF);
    }
#endif
    xcd_barrier(bar);

#ifndef SKIP_P4
    for (int rep = 0; rep < REP_P4; ++rep) {
        if (rep) xcd_barrier(bar);
        { const int c0 = ((R / 256) * (2 * DFF / 256)) % G, nwgc = c0 ? G - c0 : G, cc = c0 ? (int)blockIdx.x - c0 : (int)blockIdx.x;
          if (cc >= 0) {
            const bool wt = (nwgc % 4) == 0; const int k = wt ? cc & 3 : 1, j = wt ? cc >> 2 : cc, per = wt ? nwgc / 4 : nwgc, nslot = wt ? 6 * per : per;
            const int s0 = !wt ? j : (k == 1 ? j : (k == 2 ? per + 2 * j : 3 * per + 3 * j));
            int tidc = threadIdx.x; asm volatile("" : "+v"(tidc));
            const int lane = tidc & 63, wave = __builtin_amdgcn_readfirstlane(tidc >> 6);
            for (int q = 0; q < k; ++q)
            for (int m4 = s0 + q + nslot * wave; m4 < 2 * DB * 120; m4 += nslot * NWAVES) {
                const int kv = m4 >= DB * 120, mm = kv ? m4 - DB * 120 : m4, b = mm / 120, j2 = DS + 4 * (mm % 120);
                const GAS f32x4* src = (const GAS f32x4*)(args.in[4 + kv] + ((size_t)b * 512 + j2) * 512) + lane;
                GAS f32x4* dst = (GAS f32x4*)(out + (kv ? OVS : OKS) + ((size_t)b * 512 + (j2 - DS)) * 512) + lane;
                f32x4 v[8];
#pragma unroll
                for (int i = 0; i < 8; ++i) v[i] = src[64 * i];
#pragma unroll
                for (int i = 0; i < 8; ++i) dst[64 * i] = v[i];
            }
            { LAS float* scr = (LAS float*)(lds + RING_OFF + wave * 16384); constexpr int I_D = (DFF / 64) * (D / 32), I_PG = (D / 64) * (D / 32);
              for (int it = cc * NWAVES + wave; it < I_D + I_PG; it += nwgc * NWAVES) {
                  if (it < I_D) p0_transpose_item<0>(args.in[19], nullptr, DFF, D, WDt, scr, it, lane);
                  else p0_transpose_item<0>(args.in[21], args.in[20], D, D, WPGt, scr, it - I_D, lane); }
              __syncthreads(); }
          } }
        pg8::Gemm g{XB, WGUt, R, 2 * DFF, D}; pg8::StaticOrder S; S.init(R, 2 * DFF, G, (int)blockIdx.x);
        pg8::EpiAct E{SS1, ACTb};
        pg8::gemm_phase<pg8::EpiAct, pg8::StaticOrder, true, true>(lds + RING_OFF, g, S, E);
    }
#endif
    xcd_barrier(bar);

#ifndef SKIP_P5
    {
        pg8::Gemm g{ACTb, WDt, RP, D, DFF}; pg8::StaticOrder S; S.init(RP, D, G, (int)blockIdx.x);
        pg8::EpiRes<true> E{nullptr, nullptr, XB, SS2};
        const SEpiRes<true> SE{nullptr, XB + (size_t)RP * D, SS2 + (size_t)RP * 16};
        if (blockIdx.x & 1) for (int t = (int)blockIdx.x; t < 256; t += G) sgemm64(ACTb + (size_t)RP * DFF, WDt, DFF, t, SE, lds + RING_OFF);
        pg8::gemm_phase<pg8::EpiRes<true>, pg8::StaticOrder, true, true>(lds + RING_OFF, g, S, E);
        if (!(blockIdx.x & 1)) for (int t = (int)blockIdx.x; t < 256; t += G) sgemm64(ACTb + (size_t)RP * DFF, WDt, DFF, t, SE, lds + RING_OFF);
    }
#endif
    xcd_barrier(bar);

#ifndef SKIP_P6
    {
        pg8::Gemm g{XB, WPGt, RP, D, D}; pg8::StaticOrder S; S.init(RP, D, G, (int)blockIdx.x);
        pg8::EpiFinal E{SS2, PPb, XB, Y};
        const SEpiFinal SE{SS2 + (size_t)RP * 16, PPb + (size_t)RP * D, XB + (size_t)RP * D, Y + (size_t)RP * D};
        if (blockIdx.x & 1) for (int t = (int)blockIdx.x; t < 256; t += G) sgemm64(XB + (size_t)RP * D, WPGt, D, t, SE, lds + RING_OFF);
        pg8::gemm_phase<pg8::EpiFinal, pg8::StaticOrder, true, true>(lds + RING_OFF, g, S, E);
        if (!(blockIdx.x & 1)) for (int t = (int)blockIdx.x; t < 256; t += G) sgemm64(XB + (size_t)RP * D, WPGt, D, t, SE, lds + RING_OFF);
    }
#endif
}

extern "C" void kernel_launch(void* const* d_in, const int* in_sizes, int n_in, void* d_out, int out_size, void* d_ws, size_t ws_size, hipStream_t stream) {
    static int grid = 0;
    if (grid == 0) {
        if (n_in != 23 || ws_size < WS_END) { fprintf(stderr, "kernel_launch: unexpected shapes (n_in %d, ws %zu)\n", n_in, ws_size); grid = -1; return; }
        int dev = 0, cus = 0, per_cu = 0;
        if (hipGetDevice(&dev) != hipSuccess || hipDeviceGetAttribute(&cus, hipDeviceAttributeMultiprocessorCount, dev) != hipSuccess) { grid = -1; return; }
        if (hipFuncSetAttribute((const void*)mk_fwd, hipFuncAttributeMaxDynamicSharedMemorySize, LDS_BYTES) != hipSuccess) { fprintf(stderr, "kernel_launch: hipFuncSetAttribute failed\n"); grid = -1; return; }
        if (hipOccupancyMaxActiveBlocksPerMultiprocessor(&per_cu, (const void*)mk_fwd, NWAVES * 64, LDS_BYTES) != hipSuccess || per_cu < 1) { fprintf(stderr, "kernel_launch: occupancy query says %d blocks per CU\n", per_cu); }
        (void)hipGetLastError();
        grid = cus;
    }
    if (grid < 0) return;
    if (hipMemsetAsync((char*)d_ws + WS_CTL, 0, CTL_ZERO_BYTES, stream) != hipSuccess) return;
    Args a{};
    for (int i = 0; i < 23; ++i) a.in[i] = (const float*)d_in[i];
    a.out = (float*)d_out; a.ws = (unsigned char*)d_ws;
    hipLaunchKernelGGL(mk_fwd, dim3(grid), dim3(NWAVES * 64), LDS_BYTES, stream, a);
}
```

```cpp
#include <hip/hip_runtime.h>
#include <cstdio>
#include <cstdint>
constexpr int D = 1024, SEQ = 8192, NB = 4, DB = 32, DS = 32;
constexpr int RP = NB * SEQ, RS = DB * DS, R = RP + RS;
constexpr int INC = 2560, DFF = 2816, PLE = 256, NH = 8, HD = 64, CW = 512;
constexpr int NREL = 257, CONVW = 31, CH = 30, KSROWS = 576;
constexpr int KVT_BYTES = 131072;
constexpr float EPS = 1e-6f, LOG2E = 1.4426950408889634f, QSCALE = 0.125f * LOG2E;
constexpr size_t OY = 0, OKP = (size_t)R * D, OVP = OKP + (size_t)NB * 512 * 512, OCP = OVP + (size_t)NB * 512 * 512,
                 OKS = OCP + (size_t)NB * CH * CW, OVS = OKS + (size_t)DB * 512 * 512, OCS = OVS + (size_t)DB * 512 * 512;
namespace pg8 {
#define PG8_LAS __attribute__((address_space(3)))
typedef unsigned short bf16_t;
typedef short bf16x8 __attribute__((ext_vector_type(8)));
typedef float f32x4 __attribute__((ext_vector_type(4)));
typedef unsigned u32x4 __attribute__((ext_vector_type(4)));
constexpr int BM = 256, BK = 64, HALF = 128, HTB = HALF * BK * 2  , STAGE_BYTES = 8 * HTB, NXCD = 8, WGM = 8;

__host__ __device__ __forceinline__ int lds_byte(int r, int c) { const int st = (r >> 4) * 2 + (c >> 5), rr = r & 15, cc = c & 31, ob = rr * 64 + cc * 2; return st * 1024 + (ob ^ (((ob >> 9) & 1) << 5)); }
__host__ __device__ __forceinline__ void stage_rc(int b, int& R, int& C) { const int st = b / 1024, sb = b % 1024, swz = sb ^ (((sb >> 9) & 1) << 5); R = (st >> 1) * 16 + swz / 64; C = (st & 1) * 32 + (swz % 64) / 2; }
__host__ __device__ __forceinline__ int perm32(int rho) { const int n = rho >> 4, i = rho & 15; return 8 * (i >> 2) + 4 * n + (i & 3); }

struct Unit { int pm, pn; };
struct Gemm { const bf16_t* A; const bf16_t* Bt; int M, N, K; };

struct StaticOrder {
    int nM, nN, nwg, G, c;
    __host__ __device__ void init(int M, int N, int G_, int c_) { nM = M / BM; nN = N / BM; nwg = nM * nN; G = G_; c = c_; }
    __host__ __device__ bool next(int i, Unit& u) const {
        const long L = (long)i * G + c; if (L >= nwg) return false;
        int wgid = (int)L; { const int q = nwg / NXCD, r = nwg % NXCD, xcd = wgid % NXCD, off = wgid / NXCD; wgid = (xcd < r ? xcd * (q + 1) : r * (q + 1) + (xcd - r) * q) + off; }
        const int nig = WGM * nN, gid = wgid / nig, fm = gid * WGM, gsz = (nM - fm) < WGM ? (nM - fm) : WGM;
        u.pm = fm + ((wgid % nig) % gsz); u.pn = (wgid % nig) / gsz; return true;
    }
    __device__ __forceinline__ void a_ready(const Unit&) const {}
    __device__ __forceinline__ void done(const Unit&) const {}
};

__device__ __forceinline__ unsigned cvt_pk_bf16(float lo, float hi) { unsigned r; asm volatile("v_cvt_pk_bf16_f32 %0, %1, %2" : "=v"(r) : "v"(lo), "v"(hi)); return r; }
typedef float f32x2 __attribute__((ext_vector_type(2)));typedef unsigned u32x2 __attribute__((ext_vector_type(2)));
__device__ __forceinline__ u32x4 pack8(const f32x4 a, const f32x4 b) { u32x4 w; w.x = cvt_pk_bf16(a[0], a[1]); w.y = cvt_pk_bf16(a[2], a[3]); w.z = cvt_pk_bf16(b[0], b[1]); w.w = cvt_pk_bf16(b[2], b[3]); return w; }
__device__ __forceinline__ float sigm(float x) { return __builtin_amdgcn_rcpf(1.0f + __builtin_amdgcn_exp2f(-x * LOG2E)); }
__device__ __forceinline__ float quad_sum(float s) { s += __shfl_xor(s, 16); s += __shfl_xor(s, 32); return s; }
struct Epi1 {
    static constexpr bool PERM = true, AFTER_DRAIN = false;
    const float* rx; const float* qg; const float* kg; bf16_t* Q; unsigned char* KVP; unsigned char* KVS; bf16_t* GLU; float* out;
    __device__ __forceinline__ void operator()(const f32x4 (&acc)[2][2][4][2], const Unit& u, int wr, int wc, int fr, int fq) const {
        const int pn = u.pn, rowt = u.pm * BM + wr * 64 + fr;
        float rxv[2][4];
#pragma unroll
        for (int ai = 0; ai < 2; ++ai)
#pragma unroll
            for (int m = 0; m < 4; ++m) rxv[ai][m] = rx[rowt + ai * HALF + m * 16];
        if (pn < 6) {
            const int sec = pn >> 1, col = (4 * (pn & 1) + wc) * 64 + 8 * fq;
            f32x4 g[2][2];
#pragma unroll
            for (int bj = 0; bj < 2; ++bj)
#pragma unroll
                for (int n = 0; n < 2; ++n) { g[bj][n] = (f32x4){1.f, 1.f, 1.f, 1.f};
                    if (sec == 0) g[bj][n] = *(const f32x4*)(qg + 32 * bj + 8 * fq + 4 * n) * QSCALE;
                    if (sec == 1) g[bj][n] = *(const f32x4*)(kg + 32 * bj + 8 * fq + 4 * n); }
#pragma unroll
            for (int ai = 0; ai < 2; ++ai)
#pragma unroll
                for (int m = 0; m < 4; ++m) {
                    const int row = rowt + ai * HALF + m * 16; const float r = rxv[ai][m];
                    f32x4 z[2][2];
#pragma unroll
                    for (int bj = 0; bj < 2; ++bj)
#pragma unroll
                        for (int n = 0; n < 2; ++n) z[bj][n] = acc[ai][bj][m][n] * r;
                    if (sec < 2) {
                        float ss = 0.f;
#pragma unroll
                        for (int bj = 0; bj < 2; ++bj)
#pragma unroll
                            for (int n = 0; n < 2; ++n) { const f32x4 q = z[bj][n] * z[bj][n]; ss += (q[0] + q[1]) + (q[2] + q[3]); }
                        ss = quad_sum(ss);
                        const float rn = rsqrtf(ss * (1.0f / 64.0f) + EPS);
#pragma unroll
                        for (int bj = 0; bj < 2; ++bj)
#pragma unroll
                            for (int n = 0; n < 2; ++n) z[bj][n] = z[bj][n] * rn * g[bj][n];
                    }
                    const int sb = (row - RP) >> 5, si = (row - RP) & 31;
                    float* fo = nullptr;
                    if (sec == 0) {
#pragma unroll
                        for (int bj = 0; bj < 2; ++bj) *(u32x4*)(Q + (size_t)row * 512 + col + 32 * bj) = pack8(z[bj][0], z[bj][1]);
                    } else {
                        unsigned char* tb; int kv;
                        if (row < RP) { tb = KVP + (size_t)(row >> 6) * KVT_BYTES; kv = row & 63;
                            const int t = row & (SEQ - 1); if (t >= SEQ - 512) fo = out + OKP + (size_t)(sec - 1) * (OVP - OKP) + ((size_t)((row >> 13) * 512 + (t - (SEQ - 512)))) * 512 + col; }
                        else { tb = KVS + (size_t)(sb * 9 + 8) * KVT_BYTES; kv = si; fo = out + OKS + (size_t)(sec - 1) * (OVS - OKS) + ((size_t)(sb * 512 + 480 + si)) * 512 + col; }
                        tb += (pn & 1) * 65536 + wc * 16384;
                        const int ok = fq * 1024 + kv * 16, ov = 8192 + (kv >> 4) * 1024 + (kv & 15) * 64 + fq * 16;
#pragma unroll
                        for (int bj = 0; bj < 2; ++bj) *(u32x4*)(tb + (sec == 1 ? ok + bj * 4096 : ov + bj * 4096)) = pack8(z[bj][0], z[bj][1]);
                    }
                    if (fo) {
#pragma unroll
                        for (int bj = 0; bj < 2; ++bj)
#pragma unroll
                            for (int n = 0; n < 2; ++n) *(f32x4*)(fo + 32 * bj + 4 * n) = z[bj][n]; }
                }
        } else {
            const int col = 128 * (pn - 6) + 32 * wc + 8 * fq;
#pragma unroll
            for (int ai = 0; ai < 2; ++ai)
#pragma unroll
                for (int m = 0; m < 4; ++m) {
                    const int row = rowt + ai * HALF + m * 16; const float r = rxv[ai][m];
                    f32x4 gl[2];
#pragma unroll
                    for (int n = 0; n < 2; ++n) { const f32x4 a = acc[ai][0][m][n] * r, b = acc[ai][1][m][n] * r;
#pragma unroll
                        for (int e = 0; e < 4; ++e) gl[n][e] = a[e] * sigm(b[e]); }
                    *(u32x4*)(GLU + (size_t)row * 512 + col) = pack8(gl[0], gl[1]);
                    float* fo = nullptr;
                    if (row < RP) { const int t = row & (SEQ - 1); if (t >= SEQ - CH) fo = out + OCP + ((size_t)((row >> 13) * CH + (t - (SEQ - CH)))) * CW + col; }
                    else { const int sb = (row - RP) >> 5, si = (row - RP) & 31; if (si >= DS - CH) fo = out + OCS + ((size_t)(sb * CH + (si - (DS - CH)))) * CW + col; }
                    if (fo) { *(f32x4*)(fo) = gl[0]; *(f32x4*)(fo + 4) = gl[1]; }
                }
        }
    }
};
struct EpiPP {
    static constexpr bool PERM = true, AFTER_DRAIN = false;
    bf16_t* O;
    __device__ __forceinline__ void operator()(const f32x4 (&acc)[2][2][4][2], const Unit& u, int wr, int wc, int fr, int fq) const {
        const int rowt = u.pm * BM + wr * 64 + fr, col = u.pn * BM + 32 * wc + 8 * fq;
#pragma unroll
        for (int ai = 0; ai < 2; ++ai)
#pragma unroll
            for (int m = 0; m < 4; ++m) { bf16_t* rowp = O + (size_t)(rowt + ai * HALF + m * 16) * D + col;
#pragma unroll
                for (int bj = 0; bj < 2; ++bj) *(u32x4*)(rowp + bj * HALF) = pack8(acc[ai][bj][m][0], acc[ai][bj][m][1]); }
    }
};
__device__ __forceinline__ f32x4 bf_lo4(const u32x4 w) { return (f32x4){__uint_as_float(w.x << 16), __uint_as_float(w.x & 0xffff0000u), __uint_as_float(w.y << 16), __uint_as_float(w.y & 0xffff0000u)}; }
__device__ __forceinline__ f32x4 bf_hi4(const u32x4 w) { return (f32x4){__uint_as_float(w.z << 16), __uint_as_float(w.z & 0xffff0000u), __uint_as_float(w.w << 16), __uint_as_float(w.w & 0xffff0000u)}; }
template <bool BF> struct EpiRes {
    static constexpr bool PERM = true, AFTER_DRAIN = false;
    const float* bp; const float* bs; bf16_t* HB; float* SS;
    __device__ __forceinline__ void operator()(const f32x4 (&acc)[2][2][4][2], const Unit& u, int wr, int wc, int fr, int fq) const {
        const int rowt = u.pm * BM + wr * 64 + fr, col = u.pn * BM + 32 * wc + 8 * fq;
        f32x4 bv[2][2][2];
        auto ldbase = [&](int i, f32x4 (&d)[2][2]) {
            const int row = rowt + (i >> 2) * HALF + (i & 3) * 16;
            if (BF) { const bf16_t* hrow = HB + (size_t)row * D + col;
#pragma unroll
                for (int bj = 0; bj < 2; ++bj) { const u32x4 w = *(const u32x4*)(hrow + bj * HALF); d[bj][0] = bf_lo4(w); d[bj][1] = bf_hi4(w); } }
            else { const float* brow = (row < RP ? bp + (size_t)row * D : bs + (size_t)(row - RP) * D) + col;
#pragma unroll
                for (int bj = 0; bj < 2; ++bj) { d[bj][0] = *(const f32x4*)(brow + bj * HALF); d[bj][1] = *(const f32x4*)(brow + bj * HALF + 4); } } };
        ldbase(0, bv[0]);
#pragma unroll
        for (int i = 0; i < 8; ++i) {
            const int ai = i >> 2, m = i & 3, row = rowt + ai * HALF + m * 16;
            if (i + 1 < 8) ldbase(i + 1, bv[(i + 1) & 1]);
            bf16_t* hrow = HB + (size_t)row * D + col;
            float ss = 0.f;
#pragma unroll
            for (int bj = 0; bj < 2; ++bj) {
                const f32x4 v0 = bv[i & 1][bj][0] + acc[ai][bj][m][0], v1 = bv[i & 1][bj][1] + acc[ai][bj][m][1];
                *(u32x4*)(hrow + bj * HALF) = pack8(v0, v1);
                const f32x4 q0 = v0 * v0, q1 = v1 * v1; ss += ((q0[0] + q0[1]) + (q0[2] + q0[3])) + ((q1[0] + q1[1]) + (q1[2] + q1[3]));
            }
            ss = quad_sum(ss);
            if (fq == 0) SS[(size_t)row * 16 + 4 * u.pn + wc] = ss;
        }
    }
};
__device__ __forceinline__ float row_rs(const float* SS, int row, int fq) {
    const f32x4 s4 = *(const f32x4*)(SS + (size_t)row * 16 + 4 * fq);
    return rsqrtf(quad_sum((s4[0] + s4[1]) + (s4[2] + s4[3])) * (1.0f / D) + EPS);
}
struct EpiAct {
    static constexpr bool PERM = true, AFTER_DRAIN = false;
    const float* SS; bf16_t* ACT;
    __device__ __forceinline__ void operator()(const f32x4 (&acc)[2][2][4][2], const Unit& u, int wr, int wc, int fr, int fq) const {
        const int rowt = u.pm * BM + wr * 64 + fr, col = 128 * u.pn + 32 * wc + 8 * fq;
        float rv[2][4];
#pragma unroll
        for (int ai = 0; ai < 2; ++ai)
#pragma unroll
            for (int m = 0; m < 4; ++m) rv[ai][m] = row_rs(SS, rowt + ai * HALF + m * 16, fq);
#pragma unroll
        for (int ai = 0; ai < 2; ++ai)
#pragma unroll
            for (int m = 0; m < 4; ++m) {
                const int row = rowt + ai * HALF + m * 16; const float r = rv[ai][m];
                f32x4 v[2];
#pragma unroll
                for (int n = 0; n < 2; ++n) { const f32x4 g = acc[ai][0][m][n] * r, up = acc[ai][1][m][n] * r;
#pragma unroll
                    for (int e = 0; e < 4; ++e) v[n][e] = g[e] * sigm(g[e]) * up[e]; }
                *(u32x4*)(ACT + (size_t)row * DFF + col) = pack8(v[0], v[1]);
            }
    }
};
struct EpiFinal {
    static constexpr bool PERM = true, AFTER_DRAIN = false;
    const float* SS; const bf16_t* PP; const bf16_t* HB; float* Y;
    __device__ __forceinline__ void operator()(const f32x4 (&acc)[2][2][4][2], const Unit& u, int wr, int wc, int fr, int fq) const {
        const int rowt = u.pm * BM + wr * 64 + fr, col = u.pn * BM + 32 * wc + 8 * fq;
        float rv[2][4];
#pragma unroll
        for (int ai = 0; ai < 2; ++ai)
#pragma unroll
            for (int m = 0; m < 4; ++m) rv[ai][m] = row_rs(SS, rowt + ai * HALF + m * 16, fq);
        u32x4 pwv[2][2], hwv[2][2];
        auto ld = [&](int i, u32x4 (&p)[2], u32x4 (&h)[2]) { const size_t o = (size_t)(rowt + (i >> 2) * HALF + (i & 3) * 16) * D + col;
#pragma unroll
            for (int bj = 0; bj < 2; ++bj) { p[bj] = *(const u32x4*)(PP + o + bj * HALF); h[bj] = *(const u32x4*)(HB + o + bj * HALF); } };
        ld(0, pwv[0], hwv[0]);
#pragma unroll
        for (int i = 0; i < 8; ++i) {
            const int ai = i >> 2, m = i & 3, row = rowt + ai * HALF + m * 16; const float r = rv[ai][m];
            if (i + 1 < 8) ld(i + 1, pwv[(i + 1) & 1], hwv[(i + 1) & 1]);
#pragma unroll
            for (int bj = 0; bj < 2; ++bj) {
                const size_t o = (size_t)row * D + col + bj * HALF;
                const u32x4 pw = pwv[i & 1][bj], hw = hwv[i & 1][bj];
                const f32x4 a0 = acc[ai][bj][m][0] * r, a1 = acc[ai][bj][m][1] * r, p0 = bf_lo4(pw), p1 = bf_hi4(pw);
                f32x4 h0 = bf_lo4(hw), h1 = bf_hi4(hw);
#pragma unroll
                for (int e2 = 0; e2 < 4; ++e2) { h0[e2] += sigm(a0[e2]) * p0[e2]; h1[e2] += sigm(a1[e2]) * p1[e2]; }
                *(f32x4*)(Y + o) = h0; *(f32x4*)(Y + o + 4) = h1;
            }
        }
    }
};

template <class Epi, class Sched, bool ALIGN_EPI = false, bool SP2 = false>
__device__ __forceinline__ void gemm_phase(PG8_LAS unsigned char* lds, const Gemm g, const Sched& S, const Epi& E) {
    int tid_ = threadIdx.x; asm volatile("" : "+v"(tid_));
    const int tid = tid_, wid = __builtin_amdgcn_readfirstlane(tid >> 6), lane = tid & 63, wr = wid >> 2, wc = wid & 3, fr = lane & 15, fq = lane >> 4;
    int K_ = g.K; asm volatile("" : "+s"(K_));
    const int K = K_, nt = K / BK;
    unsigned voffA[2], voffB[2];
#pragma unroll
    for (int i = 0; i < 2; ++i) { int R, C; stage_rc(tid * 16 + i * 8192, R, C); const int Rb = Epi::PERM ? ((R & ~31) + perm32(R & 31)) : R;
        voffA[i] = (unsigned)(R * K + C) * 2u; voffB[i] = (unsigned)(Rb * K + C) * 2u; }
    const size_t kstep = (size_t)(BK * 2);
    const size_t hstep = (size_t)HALF * K * 2;
    const size_t tstep = 2 * hstep;
    const unsigned ldsw = (unsigned)wid * 1024u;
    const int aoff = lds_byte(wr * 64 + fr, fq * 8), boff = lds_byte(wc * 32 + fr, fq * 8);
#define PG8_SA(b, h) (((b) * 2 + (h)) * HTB)
#define PG8_SB(b, h) ((4 + (b) * 2 + (h)) * HTB)
#define PG8_STAGE(bufoff, gbase, voff) do { _Pragma("unroll") for (int _i = 0; _i < 2; ++_i) \
        __builtin_amdgcn_global_load_lds((const unsigned*)((const char*)(gbase) + (voff)[_i]), (PG8_LAS unsigned*)(lds + (bufoff) + ldsw + _i * 8192), 16, 0, 0); } while (0)
#define PG8_LDA(dst, b, h) do { _Pragma("unroll") for (int m = 0; m < 4; ++m) _Pragma("unroll") for (int k = 0; k < 2; ++k) dst[m][k] = *(const PG8_LAS bf16x8*)(lds + PG8_SA(b, h) + aoff + m * 2048 + k * 1024); } while (0)
#define PG8_LDB(dst, b, h) do { _Pragma("unroll") for (int n = 0; n < 2; ++n) _Pragma("unroll") for (int k = 0; k < 2; ++k) dst[n][k] = *(const PG8_LAS bf16x8*)(lds + PG8_SB(b, h) + boff + n * 2048 + k * 1024); } while (0)
#define PG8_MMA(ai, bj, At, Bt) do { __builtin_amdgcn_s_setprio(1); _Pragma("unroll") for (int m = 0; m < 4; ++m) _Pragma("unroll") for (int n = 0; n < 2; ++n) _Pragma("unroll") for (int k = 0; k < 2; ++k) \
        acc[ai][bj][m][n] = __builtin_amdgcn_mfma_f32_16x16x32_bf16(Bt[n][k], At[m][k], acc[ai][bj][m][n], 0, 0, 0); __builtin_amdgcn_s_setprio(0); } while (0)
#define PG8_WAIT_V(n) asm volatile("s_waitcnt vmcnt(" #n ")" ::: "memory")
#define PG8_WAIT_L(n) asm volatile("s_waitcnt lgkmcnt(" #n ")" ::: "memory")
#define PG8_BAR __builtin_amdgcn_s_barrier()
#define PG8_SCHED __builtin_amdgcn_sched_barrier(0)
    Unit cur, nxt; int ui = 0;
    if (!S.next(0, cur)) return;
    f32x4 acc[2][2][4][2];
#pragma unroll
    for (int a = 0; a < 2; ++a)
#pragma unroll
        for (int b = 0; b < 2; ++b)
#pragma unroll
            for (int m = 0; m < 4; ++m)
#pragma unroll
                for (int n = 0; n < 2; ++n) acc[a][b][m][n] = (f32x4){0.f, 0.f, 0.f, 0.f};
    bf16x8 At[4][2], B0[2][2], B1[2][2];
    const char* cA = (const char*)g.A + (size_t)cur.pm * tstep; const char* cB = (const char*)g.Bt + (size_t)cur.pn * tstep;
    S.a_ready(cur);
    if constexpr (SP2) {
        PG8_STAGE(PG8_SB(0, 0), cB, voffB); PG8_STAGE(PG8_SB(0, 1), cB + hstep, voffB); PG8_STAGE(PG8_SA(0, 0), cA, voffA); PG8_STAGE(PG8_SA(0, 1), cA + hstep, voffA);
        if (wr == 1) PG8_BAR;
        PG8_WAIT_V(2); PG8_BAR;
        PG8_STAGE(PG8_SB(1, 0), cB + kstep, voffB); PG8_STAGE(PG8_SA(1, 0), cA + kstep, voffA); PG8_STAGE(PG8_SB(1, 1), cB + hstep + kstep, voffB);
        PG8_WAIT_V(6); PG8_BAR;
    } else {
        PG8_STAGE(PG8_SB(0, 0), cB, voffB); PG8_STAGE(PG8_SA(0, 0), cA, voffA); PG8_STAGE(PG8_SB(0, 1), cB + hstep, voffB); PG8_STAGE(PG8_SA(0, 1), cA + hstep, voffA);
        if (wr == 1) PG8_BAR;
        PG8_WAIT_V(4); PG8_BAR;
        PG8_STAGE(PG8_SB(1, 0), cB + kstep, voffB); PG8_STAGE(PG8_SA(1, 0), cA + kstep, voffA); PG8_STAGE(PG8_SB(1, 1), cB + hstep + kstep, voffB);
        PG8_WAIT_V(6); PG8_BAR;
    }
    for (;;) {
        const bool has_next = S.next(ui + 1, nxt);
        const char* nA = has_next ? (const char*)g.A + (size_t)nxt.pm * tstep : cA; const char* nB = has_next ? (const char*)g.Bt + (size_t)nxt.pn * tstep : cB;
        for (int t = 0; t < nt; t += 2) {
            const bool last = (t == nt - 2);
            const char* a1 = cA + (size_t)(t + 1) * kstep;
            const char* a2 = last ? nA : cA + (size_t)(t + 2) * kstep; const char* b2 = last ? nB : cB + (size_t)(t + 2) * kstep;
            const char* a3 = a2 + kstep; const char* b3 = b2 + kstep;
            if (last && has_next) S.a_ready(nxt);
            if constexpr (SP2) {
            PG8_LDB(B0, 0, 0); PG8_LDB(B1, 0, 1); PG8_SCHED; PG8_LDA(At, 0, 0); PG8_STAGE(PG8_SA(1, 1), a1 + hstep, voffA);
            PG8_WAIT_V(8); PG8_WAIT_L(0); PG8_BAR; PG8_MMA(0, 0, At, B0); PG8_MMA(0, 1, At, B1); PG8_BAR; PG8_SCHED;
            PG8_LDA(At, 0, 1); PG8_STAGE(PG8_SB(0, 0), b2, voffB); PG8_STAGE(PG8_SB(0, 1), b2 + hstep, voffB); PG8_STAGE(PG8_SA(0, 0), a2, voffA);
            PG8_WAIT_V(8); PG8_WAIT_L(0); PG8_BAR; PG8_MMA(1, 0, At, B0); PG8_MMA(1, 1, At, B1); PG8_BAR; PG8_SCHED;
            PG8_LDB(B0, 1, 0); PG8_LDB(B1, 1, 1); PG8_SCHED; PG8_LDA(At, 1, 0); PG8_STAGE(PG8_SA(0, 1), a2 + hstep, voffA);
            PG8_WAIT_V(8); PG8_WAIT_L(0); PG8_BAR; PG8_MMA(0, 0, At, B0); PG8_MMA(0, 1, At, B1); PG8_BAR; PG8_SCHED;
            PG8_LDA(At, 1, 1); PG8_STAGE(PG8_SB(1, 0), b3, voffB); PG8_STAGE(PG8_SB(1, 1), b3 + hstep, voffB); PG8_STAGE(PG8_SA(1, 0), a3, voffA);
            PG8_WAIT_V(8); PG8_WAIT_L(0); PG8_BAR; PG8_MMA(1, 0, At, B0); PG8_MMA(1, 1, At, B1); PG8_BAR; PG8_SCHED;
            } else {
            PG8_LDB(B0, 0, 0); PG8_SCHED; PG8_LDA(At, 0, 0); PG8_STAGE(PG8_SA(1, 1), a1 + hstep, voffA);
            PG8_WAIT_L(8); PG8_BAR; PG8_WAIT_L(0); PG8_MMA(0, 0, At, B0); PG8_BAR; PG8_SCHED;
            PG8_LDB(B1, 0, 1); PG8_STAGE(PG8_SB(0, 0), b2, voffB);
            PG8_BAR; PG8_WAIT_L(0); PG8_MMA(0, 1, At, B1); PG8_BAR;
            PG8_LDA(At, 0, 1); PG8_STAGE(PG8_SA(0, 0), a2, voffA);
            PG8_BAR; PG8_WAIT_L(0); PG8_MMA(1, 0, At, B0); PG8_BAR; PG8_SCHED;
            PG8_STAGE(PG8_SB(0, 1), b2 + hstep, voffB);
            PG8_WAIT_V(6); PG8_BAR; PG8_MMA(1, 1, At, B1); PG8_BAR;
            PG8_LDB(B0, 1, 0); PG8_SCHED; PG8_LDA(At, 1, 0); PG8_STAGE(PG8_SA(0, 1), a2 + hstep, voffA);
            PG8_WAIT_L(8); PG8_BAR; PG8_WAIT_L(0); PG8_MMA(0, 0, At, B0); PG8_BAR; PG8_SCHED;
            PG8_LDB(B1, 1, 1); PG8_STAGE(PG8_SB(1, 0), b3, voffB);
            PG8_BAR; PG8_WAIT_L(0); PG8_MMA(0, 1, At, B1); PG8_BAR;
            PG8_LDA(At, 1, 1); PG8_STAGE(PG8_SA(1, 0), a3, voffA);
            PG8_BAR; PG8_WAIT_L(0); PG8_MMA(1, 0, At, B0); PG8_BAR; PG8_SCHED;
            PG8_STAGE(PG8_SB(1, 1), b3 + hstep, voffB);
            PG8_WAIT_V(6); PG8_BAR; PG8_MMA(1, 1, At, B1); PG8_BAR;
            }
        }
        if constexpr (ALIGN_EPI) { if (wr == 0) PG8_BAR; }
        if constexpr (!Epi::AFTER_DRAIN) { E(acc, cur, wr, wc, fr, fq); S.done(cur); }
        if (!has_next) break;
#pragma unroll
        for (int a = 0; a < 2; ++a)
#pragma unroll
            for (int b = 0; b < 2; ++b)
#pragma unroll
                for (int m = 0; m < 4; ++m)
#pragma unroll
                    for (int n = 0; n < 2; ++n) acc[a][b][m][n] = (f32x4){0.f, 0.f, 0.f, 0.f};
        cur = nxt; cA = nA; cB = nB; ++ui;
        if constexpr (ALIGN_EPI) { if (wr == 1) PG8_BAR; }
    }
    PG8_WAIT_V(0);
    if constexpr (!ALIGN_EPI) { if (wr == 0) PG8_BAR; }
    PG8_BAR;
    if constexpr (Epi::AFTER_DRAIN) { E.fused(acc, cur, wr, wc, fr, fq, lds, wid, lane); S.done(cur); }
#undef PG8_SA
#undef PG8_SB
#undef PG8_STAGE
#undef PG8_LDA
#undef PG8_LDB
#undef PG8_MMA
#undef PG8_WAIT_V
#undef PG8_WAIT_L
#undef PG8_BAR
#undef PG8_SCHED
}
}
#define GAS __attribute__((address_space(1)))
#define LAS __attribute__((address_space(3)))
typedef unsigned short bf16;
typedef unsigned v4u __attribute__((ext_vector_type(4)));
typedef float f32x4 __attribute__((ext_vector_type(4)));
typedef short bf16x8 __attribute__((ext_vector_type(8)));
typedef GAS unsigned gu32;
typedef GAS unsigned long long gu64;
#define RLX_AGENT __ATOMIC_RELAXED, __HIP_MEMORY_SCOPE_AGENT
#define LDS_WAIT() asm volatile("s_waitcnt lgkmcnt(0)" ::: "memory")
#define VM_WAIT() asm volatile("s_waitcnt vmcnt(0)" ::: "memory")
__device__ __forceinline__ unsigned long long rt() { return __builtin_amdgcn_s_memrealtime(); }
__device__ __forceinline__ unsigned f2bf(float f) { unsigned u = __builtin_bit_cast(unsigned, f); return (u + 0x7fffu + ((u >> 16) & 1u)) >> 16; }
__device__ __forceinline__ unsigned pk2(float lo, float hi) { return f2bf(lo) | (f2bf(hi) << 16); }
#define XB_TMO      128
#define XB_XCNT(j)  (256  + 64 * (j))
#define XB_XSUB(j)  (1280 + 64 * (j))
#define XB_XGEN(j)  (2304 + 64 * (j))
#define XB_TOP      3328
#define XB_TOPGEN   3392
#define XCD_BAR_WORDS 3456
#define XB_SPIN_CAP (1u << 18)

__device__ __forceinline__ unsigned xb_ld(unsigned* p)              { return __hip_atomic_load(p, __ATOMIC_RELAXED, __HIP_MEMORY_SCOPE_AGENT); }
__device__ __forceinline__ unsigned xb_add(unsigned* p, unsigned v) { return __hip_atomic_fetch_add(p, v, __ATOMIC_RELAXED, __HIP_MEMORY_SCOPE_AGENT); }
__device__ __forceinline__ unsigned xb_xcc_id() { return (unsigned)__builtin_amdgcn_s_getreg((3 << 11) | 20) & 0xFu; }
#define XB_SPIN(cond, bar) do { unsigned _sp = 0; while (cond) { __builtin_amdgcn_s_sleep(1); \
    if ((++_sp & 255u) == 0u) { if (xb_ld(&(bar)[XB_TMO])) break; if (_sp > XB_SPIN_CAP) { atomicAdd(&(bar)[XB_TMO], 1u); break; } } } } while (0)

struct XcdBarrier {
    unsigned* bar; unsigned x;
    volatile LAS unsigned* st;
};

__device__ __forceinline__ XcdBarrier xcd_barrier_post(unsigned* bar, volatile LAS unsigned* st) {
    XcdBarrier b; b.bar = bar; b.x = xb_xcc_id(); b.st = st;
    if (threadIdx.x == 0) (void)xb_add(&bar[XB_XCNT(b.x)], 1u);
    return b;
}
__device__ __forceinline__ void xcd_barrier_complete(unsigned* bar, unsigned x, unsigned& nloc, unsigned& nx) {
    const unsigned G = gridDim.x * gridDim.y * gridDim.z;
    unsigned sum, cnt, mine, sp = 0u;
    for (;;) {
        sum = 0u; cnt = 0u; mine = 0u;
#pragma unroll
        for (unsigned j = 0; j < 16; ++j) { const unsigned c = xb_ld(&bar[XB_XCNT(j)]); sum += c; cnt += (c > 0u) ? 1u : 0u; mine = (j == x) ? c : mine; }
        if (sum == G) break;
        __builtin_amdgcn_s_sleep(1);
        if ((++sp & 255u) == 0u) { if (xb_ld(&bar[XB_TMO])) break; if (sp > XB_SPIN_CAP) { atomicAdd(&bar[XB_TMO], 1u); break; } }
    }
    nloc = mine > 0u ? mine : 1u; nx = cnt > 0u ? cnt : 1u;
}

__device__ __forceinline__ void xcd_barrier(const XcdBarrier& b) {
    asm volatile("s_waitcnt vmcnt(0)" ::: "memory");
    __syncthreads();
    if (threadIdx.x == 0) {
        unsigned* bar = b.bar;
        __builtin_amdgcn_s_waitcnt(0);
        unsigned nloc = b.st[0], nx = b.st[1];
        if (nloc == 0u) { xcd_barrier_complete(bar, b.x, nloc, nx); b.st[0] = nloc; b.st[1] = nx; }
        const unsigned old = xb_add(&bar[XB_XSUB(b.x)], 1u);
        const unsigned gen = old / nloc;
        if (old + 1u == (gen + 1u) * nloc) {
            __builtin_amdgcn_fence(__ATOMIC_RELEASE, "agent");
            asm volatile("s_waitcnt vmcnt(0)" ::: "memory");
            const unsigned og = xb_add(&bar[XB_TOP], 1u);
            const unsigned tg = og / nx;
            if (og + 1u == (tg + 1u) * nx) xb_add(&bar[XB_TOPGEN], 1u);
            else XB_SPIN(xb_ld(&bar[XB_TOPGEN]) == tg, bar);
            __builtin_amdgcn_fence(__ATOMIC_ACQUIRE, "agent");
            xb_add(&bar[XB_XGEN(b.x)], 1u);
            asm volatile("s_waitcnt vmcnt(0)" ::: "memory");
        } else {
            XB_SPIN(xb_ld(&bar[XB_XGEN(b.x)]) == gen, bar);
            __builtin_amdgcn_fence(__ATOMIC_ACQUIRE, "agent");
            asm volatile("s_waitcnt vmcnt(0)" ::: "memory");
        }
    }
    __syncthreads();
}
constexpr int NWAVES = 8;
constexpr size_t MiB = 1u << 20;
constexpr size_t WS_CTL = 0, CTL_ZERO_BYTES = 65536;
constexpr size_t WS_W1 = 1 * MiB, WS_WO = 6 * MiB, WS_WGU = 8 * MiB, WS_WD = 19 * MiB, WS_WPG = 25 * MiB, WS_WPP = 27 * MiB;
constexpr size_t WS_RX = 28 * MiB, WS_SS1 = 29 * MiB, WS_SS2 = 32 * MiB;
constexpr size_t WS_XB = 36 * MiB;
constexpr size_t WS_PB = 102 * MiB, WS_PP = 119 * MiB;
constexpr size_t WS_Q = 185 * MiB, WS_KP = 218 * MiB, WS_VP = 250 * MiB, WS_KS = 282 * MiB, WS_VS = 300 * MiB, WS_GLU = 318 * MiB, WS_MIX = 351 * MiB;
constexpr size_t WS_ACT = 185 * MiB;
constexpr size_t WS_END = 417 * MiB;
static_assert(WS_XB + (size_t)R * D * 2 <= WS_PB && WS_PB + (size_t)R * PLE * 2 <= WS_PP && WS_PP + (size_t)R * D * 2 <= WS_Q && WS_Q + (size_t)R * 512 * 2 <= WS_KP &&
              WS_KP + (size_t)(RP / 64) * KVT_BYTES <= WS_KS && WS_KS + (size_t)DB * 9 * KVT_BYTES <= WS_GLU && WS_GLU + (size_t)R * 512 * 2 <= WS_MIX &&
              WS_MIX + (size_t)R * D * 2 <= WS_END && WS_ACT + (size_t)R * DFF * 2 <= WS_END && WS_SS1 + (size_t)R * 64 <= WS_SS2 && WS_SS2 + (size_t)R * 64 <= WS_XB && WS_RX + (size_t)R * 4 <= WS_SS1, "d_ws map");
constexpr int CW_BAR = 4096, CW_Q = 8192, CW_QG = CW_Q + 64 * 32;
constexpr int RING_OFF = 0, RING_BYTES = 131072;
constexpr int LDSCTL_OFF = RING_BYTES, MISC_OFF = LDSCTL_OFF + 320;
constexpr int ATT_TAB = 132096, ATT_LSC = ATT_TAB + 8192;
constexpr int LDS_BYTES = 147456;
static_assert(ATT_LSC + 2048 <= LDS_BYTES && MISC_OFF + 128 <= ATT_TAB, "LDS map");

__device__ __forceinline__ float wave_sum(float v) {
#pragma unroll
    for (int o = 1; o < 64; o <<= 1) v += __shfl_xor(v, o);
    return v;
}
__device__ __forceinline__ float wave_max(float v) {
#pragma unroll
    for (int o = 1; o < 64; o <<= 1) v = fmaxf(v, __shfl_xor(v, o));
    return v;
}
__device__ __forceinline__ int map_win(int n) {
    if (n < 1536) { const int sec = n >> 9, nn = n & 511, h = nn >> 6, d = nn & 63; return sec * 512 + 256 * (h >> 2) + 128 * (d >> 5) + 32 * (h & 3) + (d & 31); }
    if (n < 2048) { const int i = n - 1536; return 1536 + 256 * (i >> 7) + (i & 127); }
    const int i = n - 2048; return 1536 + 256 * (i >> 7) + 128 + (i & 127);
}
__device__ __forceinline__ int map_gu(int n) {
    if (n < DFF) return 256 * (n >> 7) + (n & 127);
    const int i = n - DFF; return 256 * (i >> 7) + 128 + (i & 127);
}
template <int MAP> __device__ __forceinline__ void p0_transpose_item(const float* W, const float* gain, int K, int N, bf16* WT, LAS float* scr, int item, int lane) {
    const int nblk = N / 32, kb = item / nblk, nb = item % nblk, k0 = 64 * kb, n0 = 32 * nb;
    { const int nq = lane & 7, kr = lane >> 3; f32x4 v[8];
#pragma unroll
      for (int i = 0; i < 8; ++i) v[i] = *(const GAS f32x4*)(W + (size_t)(k0 + 8 * i + kr) * N + n0 + 4 * nq);
#pragma unroll
      for (int i = 0; i < 8; ++i) { const int kk = 8 * i + kr; const float gk = gain ? gain[k0 + kk] : 1.0f;
#pragma unroll
          for (int e = 0; e < 4; ++e) scr[kk * 33 + 4 * nq + e] = v[i][e] * gk; } }
    LDS_WAIT(); asm volatile("" ::: "memory");
    const int c = lane & 7;
#pragma unroll
    for (int j = 0; j < 4; ++j) { const int n = (lane >> 3) + 8 * j; const LAS float* s = scr + (8 * c) * 33 + n;
        v4u o; o.x = pk2(s[0 * 33], s[1 * 33]); o.y = pk2(s[2 * 33], s[3 * 33]); o.z = pk2(s[4 * 33], s[5 * 33]); o.w = pk2(s[6 * 33], s[7 * 33]);
        const int ns = n0 + n, dr = MAP == 0 ? ns : (MAP == 1 ? map_win(ns) : map_gu(ns));
        *(GAS v4u*)(WT + (size_t)dr * K + k0 + 8 * c) = o; }
    LDS_WAIT(); asm volatile("" ::: "memory");
}

namespace att {
typedef short bf16x8 __attribute__((ext_vector_type(8)));
typedef short s16x4 __attribute__((ext_vector_type(4)));
typedef float f32x16 __attribute__((ext_vector_type(16)));
typedef unsigned u32x4 __attribute__((ext_vector_type(4)));
typedef float f32x2_t __attribute__((ext_vector_type(2))); typedef __bf16 bf16x2_t __attribute__((ext_vector_type(2)));
typedef short v4i16_t __attribute__((ext_vector_type(4)));
typedef LAS const char* lds_cptr;
constexpr int BUFB = 65536, HSLOT = 16384;
__device__ __forceinline__ int crow(int r, int hi) { return (r & 3) + 8 * (r >> 2) + 4 * hi; }
__device__ __forceinline__ void glds16(const void* gsrc, unsigned lds_dst) { unsigned keep;
    asm volatile("s_mov_b32 %0, m0\n\ts_mov_b32 m0, %2\n\ts_nop 0\n\tglobal_load_lds_dwordx4 %1, off\n\ts_mov_b32 m0, %0" : "=&s"(keep) : "v"(gsrc), "s"(lds_dst) : "memory"); }
__device__ __forceinline__ unsigned cvtpk_s(float lo, float hi) { f32x2_t v = {lo, hi}; bf16x2_t b = __builtin_convertvector(v, bf16x2_t); return __builtin_bit_cast(unsigned, b); }
__device__ __forceinline__ s16x4 vtr(lds_cptr p) { return __builtin_bit_cast(s16x4, __builtin_amdgcn_ds_read_tr16_b64_v4i16((LAS v4i16_t*)p)); }
#define ATT_WAIT_BAR() asm volatile("s_waitcnt vmcnt(0) lgkmcnt(0)\n\ts_barrier" ::: "memory")

struct AUnit { const bf16* Qrow; const unsigned char* KV; bf16* Orow; int nt, hg, sample, c0rel; };

__device__ __forceinline__ void attn_unit(const AUnit& U, LAS unsigned char* lds, int wid, int lane) {
    const int r32 = lane & 31, hi = lane >> 5, hl = wid & 3, ci = wid >> 2, head = 4 * U.hg + hl, nt = U.nt, own = U.c0rel + ci;
    const bool wact = !U.sample || ci == 0, two = !U.sample;
    const unsigned lds0 = (unsigned)(size_t)lds;
    const LAS float* tabh = (const LAS float*)(lds + ATT_TAB) + head * 256;
    LAS float* lsc = (LAS float*)(lds + ATT_LSC) + wid * 64;
    bf16x8 qr[2][4];
    { const bf16* Qw = U.Qrow + (size_t)((wact ? 64 * ci : 0) + r32) * 512 + head * 64 + hi * 8; const bf16* Qw1 = Qw + (two ? 32 * 512 : 0);
#pragma unroll
      for (int d0 = 0; d0 < 4; ++d0) { qr[0][d0] = *(const bf16x8*)(Qw + d0 * 16); qr[1][d0] = *(const bf16x8*)(Qw1 + d0 * 16); } }
    const float cfar = tabh[255];
    f32x16 o[2][2]; o[0][0] = f32x16{}; o[0][1] = f32x16{}; o[1][0] = f32x16{}; o[1][1] = f32x16{}; float lsum[2] = {0.f, 0.f};
    const unsigned char* kvsrc = U.KV + U.hg * 65536 + wid * 1024 + lane * 16;
    const unsigned kvdst = lds0 + wid * 1024;
#define ATT_DMA(ti, b) do { _Pragma("unroll") for (int j_ = 0; j_ < 8; ++j_) \
        glds16(kvsrc + (size_t)(ti) * KVT_BYTES + j_ * 8192, (unsigned)__builtin_amdgcn_readfirstlane(kvdst + (b) * BUFB + j_ * 8192)); } while (0)
    ATT_DMA(0, 0);
#pragma unroll
    for (int d0 = 0; d0 < 4; ++d0) asm volatile("" : "+v"(qr[0][d0]), "+v"(qr[1][d0]));
    for (int ti = 0; ti < nt; ++ti) {
        ATT_WAIT_BAR();
        const int b = ti & 1;
        if (ti + 1 < nt) ATT_DMA(ti + 1, b ^ 1);
        const int jt = own - ti;
        if (wact && jt >= 0 && jt <= 8) {
            const bool half = U.sample && jt == 0;
            const lds_cptr kp = (lds_cptr)(lds + b * BUFB + hl * HSLOT + hi * 1024 + r32 * 16);
            const float c0 = jt >= 3 ? cfar : 0.f;
            u32x4 pw[2][4];
#pragma unroll
            for (int h2 = 0; h2 < 2; ++h2) {
                if (h2 == 1 && !two) { pw[1][0] = pw[0][0]; pw[1][1] = pw[0][1]; pw[1][2] = pw[0][2]; pw[1][3] = pw[0][3]; continue; }
                f32x16 p0, p1;
#pragma unroll
                for (int r = 0; r < 16; ++r) { p0[r] = c0; p1[r] = c0; }
#pragma unroll
                for (int d0 = 0; d0 < 4; ++d0) {
                    const bf16x8 k0 = *(const LAS bf16x8*)(kp + d0 * 2048);
                    p0 = __builtin_amdgcn_mfma_f32_32x32x16_bf16(k0, qr[h2][d0], p0, 0, 0, 0);
                    if (!half) { const bf16x8 k1 = *(const LAS bf16x8*)(kp + d0 * 2048 + 512); p1 = __builtin_amdgcn_mfma_f32_32x32x16_bf16(k1, qr[h2][d0], p1, 0, 0, 0); }
                }
                if (jt < 3) { const LAS float* tp = tabh + (191 - (32 * h2 + r32) - 64 * jt + 4 * hi);
#pragma unroll
                    for (int r = 0; r < 16; ++r) { p0[r] += tp[(r & 3) + 8 * (r >> 2)]; p1[r] += tp[32 + (r & 3) + 8 * (r >> 2)]; } }
                float sacc = 0.f;
#pragma unroll
                for (int r = 0; r < 16; ++r) { p0[r] = __builtin_amdgcn_exp2f(p0[r]); p1[r] = half ? 0.f : __builtin_amdgcn_exp2f(p1[r]); sacc += p0[r] + p1[r]; }
                lsum[h2] += sacc;
#pragma unroll
                for (int k = 0; k < 2; ++k) { pw[h2][k] = (u32x4){cvtpk_s(p0[8 * k], p0[8 * k + 1]), cvtpk_s(p0[8 * k + 2], p0[8 * k + 3]), cvtpk_s(p0[8 * k + 4], p0[8 * k + 5]), cvtpk_s(p0[8 * k + 6], p0[8 * k + 7])};
                    pw[h2][2 + k] = (u32x4){cvtpk_s(p1[8 * k], p1[8 * k + 1]), cvtpk_s(p1[8 * k + 2], p1[8 * k + 3]), cvtpk_s(p1[8 * k + 4], p1[8 * k + 5]), cvtpk_s(p1[8 * k + 6], p1[8 * k + 7])}; }
            }
            const lds_cptr vp = (lds_cptr)(lds + b * BUFB + hl * HSLOT + 8192 + ((lane >> 4) & 1) * 32 + (lane & 3) * 8 + (4 * hi + ((lane & 15) >> 2)) * 64);
#pragma unroll
            for (int d0 = 0; d0 < 2; ++d0)
#pragma unroll
                for (int ks = 0; ks < 4; ++ks) { if (half && ks >= 2) continue;
                    const s16x4 lo = vtr(vp + d0 * 4096 + ks * 1024), hh = vtr(vp + d0 * 4096 + ks * 1024 + 512);
                    const bf16x8 vf = (bf16x8){lo[0], lo[1], lo[2], lo[3], hh[0], hh[1], hh[2], hh[3]};
                    o[0][d0] = __builtin_amdgcn_mfma_f32_32x32x16_bf16(__builtin_bit_cast(bf16x8, pw[0][ks]), vf, o[0][d0], 0, 0, 0);
                    if (two) o[1][d0] = __builtin_amdgcn_mfma_f32_32x32x16_bf16(__builtin_bit_cast(bf16x8, pw[1][ks]), vf, o[1][d0], 0, 0, 0); }
        }
    }
    ATT_WAIT_BAR();
    if (wact) {
#pragma unroll
        for (int h2 = 0; h2 < 2; ++h2) { if (h2 == 1 && !two) continue;
            float ls = lsum[h2];
            { auto rr = __builtin_amdgcn_permlane32_swap(__float_as_uint(ls), __float_as_uint(ls), false, false); ls = __uint_as_float(rr[0]) + __uint_as_float(rr[1]); }
            if (hi == 0) lsc[32 * h2 + r32] = ls;
            asm volatile("s_waitcnt lgkmcnt(0)" ::: "memory");
            LAS bf16* stg = (LAS bf16*)(lds + wid * 8192 + h2 * 4096);
#pragma unroll
            for (int r = 0; r < 16; ++r) { const int orow = crow(r, hi); const float rl = __builtin_amdgcn_rcpf(lsc[32 * h2 + orow]);
#pragma unroll
                for (int d0 = 0; d0 < 2; ++d0) stg[orow * 64 + d0 * 32 + r32] = (bf16)f2bf(o[h2][d0][r] * rl); }
            asm volatile("s_waitcnt lgkmcnt(0)" ::: "memory");
            bf16* Ow = U.Orow + (size_t)(64 * ci + 32 * h2) * D + head * 64;
#pragma unroll
            for (int i = 0; i < 4; ++i) { const int row = i * 8 + (lane >> 3), ch = lane & 7; const u32x4 v = *(const LAS u32x4*)(stg + row * 64 + ch * 8); *(u32x4*)(Ow + (size_t)row * D + ch * 8) = v; }
        }
    }
    ATT_WAIT_BAR();
#undef ATT_DMA
}
}

__device__ __forceinline__ void conv_item(int item, const bf16* GLU, const float* st, const float* cw, const float* cb, const float* lg, const float* lb, bf16* MIX, LAS unsigned char* lds, int tid) {
    const bool samp = item >= RP / 32; const int b = samp ? item - RP / 32 : item >> 8, t0 = samp ? 0 : (item & 255) * 32, rowbase = samp ? RP + DS * b : b * SEQ;
    const int ch = tid, wid = tid >> 6, lane = tid & 63;
    LAS bf16* xs = (LAS bf16*)lds;
    LAS float* ybuf = (LAS float*)(lds + 65536);
#pragma unroll
    for (int i = 0; i < 8; ++i) { const int k = wid + 8 * i; if (k < 62) { const int tp = t0 - CH + k; pg8::u32x4 v = (pg8::u32x4){0u, 0u, 0u, 0u};
        if (tp >= 0) v = *(const pg8::u32x4*)(GLU + (size_t)(rowbase + tp) * 512 + 8 * lane);
        else if (samp) { const float* sp = st + ((size_t)b * CH + (CH + tp)) * CW + 8 * lane; v = pg8::pack8(*(const f32x4*)sp, *(const f32x4*)(sp + 4)); }
        *(LAS pg8::u32x4*)(xs + k * 512 + 8 * lane) = v; } }
    float w[CONVW];
#pragma unroll
    for (int j = 0; j < CONVW; ++j) w[j] = cw[j * CW + ch];
    const float bias = cb[ch];
    __syncthreads();
#pragma unroll 1
    for (int hb = 0; hb < 2; ++hb) {
        float x[46];
#pragma unroll
        for (int k = 0; k < 46; ++k) x[k] = __uint_as_float((unsigned)xs[(16 * hb + k) * 512 + ch] << 16);
        float y[16];
#pragma unroll
        for (int i = 0; i < 16; ++i) y[i] = bias;
#pragma unroll
        for (int j = 0; j < CONVW; ++j)
#pragma unroll
            for (int i = 0; i < 16; ++i) y[i] += w[j] * x[i + j];
#pragma unroll
        for (int i = 0; i < 16; ++i) ybuf[(16 * hb + i) * 512 + ch] = y[i];
    }
    __syncthreads();
    f32x4 g0 = *(const f32x4*)(lg + 8 * lane), g1 = *(const f32x4*)(lg + 8 * lane + 4), b0 = *(const f32x4*)(lb + 8 * lane), b1 = *(const f32x4*)(lb + 8 * lane + 4);
#pragma unroll
    for (int q = 0; q < 4; ++q) { const int i = 4 * wid + q;
        f32x4 v0 = *(const LAS f32x4*)(ybuf + i * 512 + 8 * lane), v1 = *(const LAS f32x4*)(ybuf + i * 512 + 8 * lane + 4);
        const float mean = wave_sum((v0[0] + v0[1]) + (v0[2] + v0[3]) + (v1[0] + v1[1]) + (v1[2] + v1[3])) * (1.0f / CW);
        v0 = v0 - mean; v1 = v1 - mean;
        const f32x4 q0 = v0 * v0, q1 = v1 * v1;
        const float rstd = rsqrtf(wave_sum((q0[0] + q0[1]) + (q0[2] + q0[3]) + (q1[0] + q1[1]) + (q1[2] + q1[3])) * (1.0f / CW) + EPS);
        v0 = v0 * rstd * g0 + b0; v1 = v1 * rstd * g1 + b1;
#pragma unroll
        for (int e = 0; e < 4; ++e) { v0[e] *= pg8::sigm(v0[e]); v1[e] *= pg8::sigm(v1[e]); }
        *(pg8::u32x4*)(MIX + (size_t)(rowbase + t0 + i) * D + 512 + 8 * lane) = pg8::pack8(v0, v1); }
    __syncthreads();
}


constexpr int SG_LD = 68;
template <class Epi> __device__ __forceinline__ void sgemm64(const bf16* A, const bf16* Bt, int K_, int tile, const Epi& E, LAS unsigned char* lds) {
    int tid_ = threadIdx.x; asm volatile("" : "+v"(tid_)); int K = K_; asm volatile("" : "+s"(K));
    const int lane = tid_ & 63, wave = __builtin_amdgcn_readfirstlane(tid_ >> 6), fr = lane & 15, fq = lane >> 4, kg = wave & 3, nh = wave >> 2, tr = tile >> 4, tc = tile & 15;
    const int Kq = K >> 2;
    const bf16* ap = A + (size_t)(64 * tr + fr) * K + kg * Kq + 8 * fq;
    const bf16* bp = Bt + (size_t)(64 * tc + 32 * nh + fr) * K + kg * Kq + 8 * fq;
    const size_t r16 = (size_t)16 * K;
    f32x4 acc[4][2];
#pragma unroll
    for (int mi = 0; mi < 4; ++mi) { acc[mi][0] = (f32x4){0.f, 0.f, 0.f, 0.f}; acc[mi][1] = acc[mi][0]; }
    bf16x8 a[2][4], p[2][2], an[2][4], pn[2][2];
#pragma unroll
    for (int s = 0; s < 2; ++s) {
#pragma unroll
        for (int mi = 0; mi < 4; ++mi) a[s][mi] = *(const bf16x8*)(ap + mi * r16 + 32 * s);
        p[s][0] = *(const bf16x8*)(bp + 32 * s); p[s][1] = *(const bf16x8*)(bp + r16 + 32 * s); }
    for (int k = 64; k <= Kq; k += 64) {
        const int kn = k < Kq ? k : 0;
#pragma unroll
        for (int s = 0; s < 2; ++s) {
#pragma unroll
            for (int mi = 0; mi < 4; ++mi) an[s][mi] = *(const bf16x8*)(ap + mi * r16 + kn + 32 * s);
            pn[s][0] = *(const bf16x8*)(bp + kn + 32 * s); pn[s][1] = *(const bf16x8*)(bp + r16 + kn + 32 * s); }
#pragma unroll
        for (int s = 0; s < 2; ++s)
#pragma unroll
            for (int mi = 0; mi < 4; ++mi) { acc[mi][0] = __builtin_amdgcn_mfma_f32_16x16x32_bf16(p[s][0], a[s][mi], acc[mi][0], 0, 0, 0); acc[mi][1] = __builtin_amdgcn_mfma_f32_16x16x32_bf16(p[s][1], a[s][mi], acc[mi][1], 0, 0, 0); }
#pragma unroll
        for (int s = 0; s < 2; ++s) {
#pragma unroll
            for (int mi = 0; mi < 4; ++mi) a[s][mi] = an[s][mi];
            p[s][0] = pn[s][0]; p[s][1] = pn[s][1]; }
    }
    LAS float* part = (LAS float*)lds;
#pragma unroll
    for (int mi = 0; mi < 4; ++mi)
#pragma unroll
        for (int ni = 0; ni < 2; ++ni) *(LAS f32x4*)(part + (kg * 64 + 16 * mi + fr) * SG_LD + 32 * nh + 16 * ni + 4 * fq) = acc[mi][ni];
    __syncthreads();
    const int row = tid_ >> 3, c8 = (tid_ & 7) * 8;
    f32x4 v0 = *(const LAS f32x4*)(part + row * SG_LD + c8), v1 = *(const LAS f32x4*)(part + row * SG_LD + c8 + 4);
#pragma unroll
    for (int g = 1; g < 4; ++g) { v0 = v0 + *(const LAS f32x4*)(part + (g * 64 + row) * SG_LD + c8); v1 = v1 + *(const LAS f32x4*)(part + (g * 64 + row) * SG_LD + c8 + 4); }
    E(64 * tr + row, 64 * tc + c8, tc, tid_ & 7, v0, v1);
    __syncthreads();
}
__device__ __forceinline__ float oct_sum(float s) { s += __shfl_xor(s, 1); s += __shfl_xor(s, 2); s += __shfl_xor(s, 4); return s; }
template <bool BF> struct SEpiRes {
    const float* base; bf16* HB; float* SS;
    __device__ __forceinline__ void operator()(int row, int col, int tc, int l8, f32x4 v0, f32x4 v1) const {
        const size_t o = (size_t)row * D + col;
        if (BF) { const pg8::u32x4 w = *(const pg8::u32x4*)(HB + o); v0 = v0 + pg8::bf_lo4(w); v1 = v1 + pg8::bf_hi4(w); }
        else { v0 = v0 + *(const f32x4*)(base + o); v1 = v1 + *(const f32x4*)(base + o + 4); }
        *(pg8::u32x4*)(HB + o) = pg8::pack8(v0, v1);
        const f32x4 q0 = v0 * v0, q1 = v1 * v1;
        const float ss = oct_sum(((q0[0] + q0[1]) + (q0[2] + q0[3])) + ((q1[0] + q1[1]) + (q1[2] + q1[3])));
        if (l8 == 0) SS[(size_t)row * 16 + tc] = ss;
    }
};
struct SEpiFinal {
    const float* SS; const bf16* PP; const bf16* HB; float* Y;
    __device__ __forceinline__ void operator()(int row, int col, int tc, int l8, f32x4 v0, f32x4 v1) const {
        const float r = rsqrtf(oct_sum(SS[(size_t)row * 16 + 2 * l8] + SS[(size_t)row * 16 + 2 * l8 + 1]) * (1.0f / D) + EPS);
        const size_t o = (size_t)row * D + col;
        const pg8::u32x4 pw = *(const pg8::u32x4*)(PP + o), hw = *(const pg8::u32x4*)(HB + o);
        const f32x4 p0 = pg8::bf_lo4(pw), p1 = pg8::bf_hi4(pw); f32x4 h0 = pg8::bf_lo4(hw), h1 = pg8::bf_hi4(hw);
#pragma unroll
        for (int e = 0; e < 4; ++e) { h0[e] += pg8::sigm(v0[e] * r) * p0[e]; h1[e] += pg8::sigm(v1[e] * r) * p1[e]; }
        *(f32x4*)(Y + o) = h0; *(f32x4*)(Y + o + 4) = h1;
    }
};

#ifndef REP_P0
#define REP_P0 1
#endif
#ifndef REP_P1
#define REP_P1 1
#endif
#ifndef REP_P2
#define REP_P2 1
#endif
#ifndef REP_P3
#define REP_P3 1
#endif
#ifndef REP_P4
#define REP_P4 1
#endif
struct Args { const float* in[23]; float* out; unsigned char* ws; };
constexpr int N_ATT_S = 2 * DB, N_ATT_P = NB * 64 * 2, N_CONV = R / 32;
constexpr int I_WO = (D / 64) * (D / 32), I_WGU = (D / 64) * (2 * DFF / 32), N_WCV = (I_WO + I_WGU) / 8;
constexpr int N_ATT_Q = 8 + 64;
static_assert((I_WO + I_WGU) % 8 == 0, "weight conversion entries");
#define W1t ((bf16*)(ws + WS_W1))
#define WOt ((bf16*)(ws + WS_WO))
#define WGUt ((bf16*)(ws + WS_WGU))
#define WDt ((bf16*)(ws + WS_WD))
#define WPGt ((bf16*)(ws + WS_WPG))
#define WPPt ((bf16*)(ws + WS_WPP))
#define RX ((float*)(ws + WS_RX))
#define SS1 ((float*)(ws + WS_SS1))
#define SS2 ((float*)(ws + WS_SS2))
#define XB ((bf16*)(ws + WS_XB))
#define PB ((bf16*)(ws + WS_PB))
#define PPb ((bf16*)(ws + WS_PP))
#define Qb ((bf16*)(ws + WS_Q))
#define KVP (ws + WS_KP)
#define KVS (ws + WS_KS)
#define GLUb ((bf16*)(ws + WS_GLU))
#define MIXb ((bf16*)(ws + WS_MIX))
#define ACTb ((bf16*)(ws + WS_ACT))
#define Y (out + OY)
__global__ void __launch_bounds__(NWAVES * 64, 2) mk_fwd(Args args) {
    extern __shared__ __attribute__((aligned(16))) unsigned char lds_[];
    LAS unsigned char* lds = (LAS unsigned char*)lds_;
    volatile LAS unsigned* MISC = (volatile LAS unsigned*)(lds + MISC_OFF);
    const int G = gridDim.x, vcu = (G % 8 == 0) ? ((int)blockIdx.x % 8) * (G / 8) + (int)blockIdx.x / 8 : (int)blockIdx.x;
    unsigned char* ws = args.ws; float* out = args.out;
    gu32* ctl = (gu32*)(ws + WS_CTL);
    for (int u = threadIdx.x; u < (ATT_TAB - LDSCTL_OFF) / 4; u += NWAVES * 64) ((LAS unsigned*)(lds + LDSCTL_OFF))[u] = 0u;
    __syncthreads();
    XcdBarrier bar = xcd_barrier_post((unsigned*)(ctl + CW_BAR), MISC + 8);

#ifndef SKIP_P0
    for (int rep = 0; rep < REP_P0; ++rep) {
        if (rep) xcd_barrier(bar);
        int tid0 = threadIdx.x; asm volatile("" : "+v"(tid0));
        const int lane = tid0 & 63, wave = __builtin_amdgcn_readfirstlane(tid0 >> 6);
        LAS float* scr = (LAS float*)(lds + RING_OFF + wave * 16384);
        const int gw = vcu * NWAVES + wave, NGW = G * NWAVES;
        constexpr int I_1 = (D / 64) * (INC / 32), I_PP = (PLE / 64) * (D / 32);
        constexpr int NITEMS = I_1 + I_PP;
        for (int it = gw; it < NITEMS; it += NGW) {
            if (it < I_1) p0_transpose_item<1>(args.in[8], args.in[7], D, INC, W1t, scr, it, lane);
            else p0_transpose_item<0>(args.in[22], nullptr, PLE, D, WPPt, scr, it - I_1, lane);
        }
        for (int m2 = gw; m2 < R / 2; m2 += NGW) {
            f32x4 v[2][4];
#pragma unroll
            for (int rr = 0; rr < 2; ++rr) { const int m = 2 * m2 + rr; const float* xrow = m < RP ? args.in[0] + (size_t)m * D : args.in[1] + (size_t)(m - RP) * D;
                const GAS f32x4* xr = (const GAS f32x4*)xrow + lane;
#pragma unroll
                for (int j = 0; j < 4; ++j) v[rr][j] = xr[64 * j]; }
#pragma unroll
            for (int rr = 0; rr < 2; ++rr) { const int m = 2 * m2 + rr; float s = 0.f;
#pragma unroll
                for (int j = 0; j < 4; ++j) s += (v[rr][j].x * v[rr][j].x + v[rr][j].y * v[rr][j].y) + (v[rr][j].z * v[rr][j].z + v[rr][j].w * v[rr][j].w);
                s = wave_sum(s); if (lane == 0) RX[m] = rsqrtf(s * (1.0f / D) + EPS);
                GAS unsigned long long* o8 = (GAS unsigned long long*)(XB + (size_t)m * D) + lane;
#pragma unroll
                for (int j = 0; j < 4; ++j) o8[64 * j] = (unsigned long long)pk2(v[rr][j].x, v[rr][j].y) | ((unsigned long long)pk2(v[rr][j].z, v[rr][j].w) << 32); }
        }
        for (int m8 = gw; m8 < R / 8; m8 += NGW) {
            const int m = 8 * m8; const float* prow = m < RP ? args.in[2] + (size_t)m * PLE : args.in[3] + (size_t)(m - RP) * PLE;
            const GAS f32x4* pr = (const GAS f32x4*)prow + lane; f32x4 pv[8];
#pragma unroll
            for (int j = 0; j < 8; ++j) pv[j] = pr[64 * j];
            GAS unsigned long long* o8 = (GAS unsigned long long*)(PB + (size_t)m * PLE) + lane;
#pragma unroll
            for (int j = 0; j < 8; ++j) o8[64 * j] = (unsigned long long)pk2(pv[j].x, pv[j].y) | ((unsigned long long)pk2(pv[j].z, pv[j].w) << 32);
        }
    }
#endif
    xcd_barrier(bar);

#ifndef SKIP_P1
    for (int rep = 0; rep < REP_P1; ++rep) {
        if (rep) xcd_barrier(bar);
        pg8::Gemm g{XB, W1t, R, INC, D}; pg8::StaticOrder S; S.init(R, INC, G, (int)blockIdx.x);
        pg8::Epi1 E{RX, args.in[9], args.in[10], Qb, KVP, KVS, GLUb, out};
        pg8::Gemm g2{PB, WPPt, R, D, PLE}; pg8::StaticOrder S2; S2.init(R, D, G, (int)blockIdx.x);
        pg8::EpiPP E2{PPb};
        const bool ppfirst = ((int)blockIdx.x >> 3) & 1;
        if (ppfirst) pg8::gemm_phase<pg8::EpiPP, pg8::StaticOrder, true, true>(lds + RING_OFF, g2, S2, E2);
        pg8::gemm_phase<pg8::Epi1, pg8::StaticOrder, true, true>(lds + RING_OFF, g, S, E);
        if (!ppfirst) pg8::gemm_phase<pg8::EpiPP, pg8::StaticOrder, true, true>(lds + RING_OFF, g2, S2, E2);
        { const int c0 = ((R / 256) * (INC / 256)) % G, nwgc = c0 ? G - c0 : G, cc = c0 ? (int)blockIdx.x - c0 : (int)blockIdx.x;
          if (cc >= 0) {
            int tidc = threadIdx.x; asm volatile("" : "+v"(tidc));
            const int lane = tidc & 63, wave = __builtin_amdgcn_readfirstlane(tidc >> 6), head = lane >> 3, dq = lane & 7;
            for (int m2 = cc * NWAVES + wave; m2 < DB * 512; m2 += nwgc * NWAVES) {
                const int b = m2 >> 9, j = m2 & 511, kv = j & 63;
                const GAS f32x4* sk = (const GAS f32x4*)(args.in[4] + (size_t)m2 * 512) + 2 * lane; const GAS f32x4* sv = (const GAS f32x4*)(args.in[5] + (size_t)m2 * 512) + 2 * lane;
                const f32x4 k0 = sk[0], k1 = sk[1], v0 = sv[0], v1 = sv[1];
                unsigned char* tb = KVS + (size_t)(b * 9 + (j >> 6)) * KVT_BYTES + (head >> 2) * 65536 + (head & 3) * 16384;
                *(GAS v4u*)(tb + dq * 1024 + kv * 16) = (v4u){pk2(k0.x, k0.y), pk2(k0.z, k0.w), pk2(k1.x, k1.y), pk2(k1.z, k1.w)};
                *(GAS v4u*)(tb + 8192 + (dq >> 2) * 4096 + (kv >> 4) * 1024 + (kv & 15) * 64 + (dq & 3) * 16) = (v4u){pk2(v0.x, v0.y), pk2(v0.z, v0.w), pk2(v1.x, v1.y), pk2(v1.z, v1.w)};
            }
          } }
    }
#endif
    xcd_barrier(bar);

#ifndef SKIP_P2
    for (int rep = 0; rep < REP_P2; ++rep) {
        if (rep) xcd_barrier(bar);
        { int tidt = threadIdx.x; asm volatile("" : "+v"(tidt)); const int lane = tidt & 63, wave = __builtin_amdgcn_readfirstlane(tidt >> 6);
          const float* relb = args.in[11] + wave * NREL; LAS float* T = (LAS float*)(lds + ATT_TAB) + wave * 256;
          const float gq = wave_max(fabsf(args.in[9][lane])), gk = wave_max(fabsf(args.in[10][lane]));
          float bm = -1e30f; for (int i = lane; i < NREL; i += 64) bm = fmaxf(bm, relb[i]); bm = wave_max(bm);
          const float shift = 8.0f * gq * gk + bm;
          for (int x = lane; x < 256; x += 64) { int dd = 191 - x; dd = dd < -128 ? -128 : (dd > 128 ? 128 : dd); if (x == 255) dd = 128; T[x] = (relb[dd + 128] - shift) * LOG2E; } }
        __syncthreads();
        for (int qk = 0; qk < 8; ++qk) {
            const int q = ((int)blockIdx.x + qk) & 7;
            for (;;) {
                int tid2 = threadIdx.x; asm volatile("" : "+v"(tid2));
                if (tid2 == 0) MISC[4] = __hip_atomic_fetch_add((unsigned*)(ctl + CW_Q + 64 * (q + 8 * rep)), 1u, __ATOMIC_RELAXED, __HIP_MEMORY_SCOPE_AGENT);
                __syncthreads();
                const int i = (int)MISC[4];
                __syncthreads();
                if (i >= N_ATT_Q) break;
                const int lane2 = tid2 & 63, wave2 = __builtin_amdgcn_readfirstlane(tid2 >> 6);
                att::AUnit U;
                if (i < 8) { const int sb = 4 * q + (i >> 1); U.hg = i & 1; U.sample = 1; U.nt = 9; U.c0rel = 8;
                    U.Qrow = Qb + (size_t)(RP + DS * sb) * 512; U.KV = KVS + (size_t)(sb * 9) * KVT_BYTES; U.Orow = MIXb + (size_t)(RP + DS * sb) * D; }
                else { const int j = i - 8, pi = j < 60 ? 4 + j : 63 - j, bb = q >> 1, c0 = 2 * pi;
                    U.hg = q & 1; U.sample = 0; U.c0rel = c0 < 8 ? c0 : 8; U.nt = U.c0rel + 2; const size_t row0 = (size_t)bb * SEQ + 64 * c0;
                    U.Qrow = Qb + row0 * 512; U.KV = KVP + (size_t)(bb * 128 + c0 - U.c0rel) * KVT_BYTES; U.Orow = MIXb + row0 * D; }
                att::attn_unit(U, lds, wave2, lane2);
            }
        }
        for (;;) {
            int tid2 = threadIdx.x; asm volatile("" : "+v"(tid2));
            if (tid2 == 0) MISC[4] = __hip_atomic_fetch_add((unsigned*)(ctl + CW_QG + 64 * rep), 1u, __ATOMIC_RELAXED, __HIP_MEMORY_SCOPE_AGENT);
            __syncthreads();
            const int idx = (int)MISC[4];
            __syncthreads();
            if (idx >= N_CONV + N_WCV) break;
            const int lane2 = tid2 & 63, wave2 = __builtin_amdgcn_readfirstlane(tid2 >> 6);
            if (idx < N_CONV) conv_item(idx, GLUb, args.in[6], args.in[12], args.in[13], args.in[14], args.in[15], MIXb, lds, tid2);
            else { const int it = 8 * (idx - N_CONV) + wave2; LAS float* scr = (LAS float*)(lds + RING_OFF + wave2 * 16384);
                if (it < I_WO) p0_transpose_item<0>(args.in[16], nullptr, D, D, WOt, scr, it, lane2);
                else p0_transpose_item<2>(args.in[18], args.in[17], D, 2 * DFF, WGUt, scr, it - I_WO, lane2);
                __syncthreads(); }
        }
    }
#endif
    xcd_barrier(bar);

#ifndef SKIP_P3
    for (int rep = 0; rep < REP_P3; ++rep) {
        if (rep) xcd_barrier(bar);
        pg8::Gemm g{MIXb, WOt, RP, D, D}; pg8::StaticOrder S; S.init(RP, D, G, (int)blockIdx.x);
        pg8::EpiRes<false> E{args.in[0], args.in[1], XB, SS1};
        const SEpiRes<false> SE{args.in[1], XB + (size_t)RP * D, SS1 + (size_t)RP * 16};
        if (blockIdx.x & 1) for (int t = (int)blockIdx.x; t < 256; t += G) sgemm64(MIXb + (size_t)RP * D, WOt, D, t, SE, lds + RING_OFF);
        pg8::gemm_phase<pg8::EpiRes<false>, pg8::StaticOrder, true, true>(lds + RING_OFF, g, S, E);
        if (!(blockIdx.x & 1)) for (int t = (int)blockIdx.x; t < 256; t += G) sgemm64(MIXb + (size_t)RP * D, WOt, D, t, SE, lds + RING_OFF);
    }
#endif
    xcd_barrier(bar);

#ifndef SKIP_P4
    for (int rep = 0; rep < REP_P4; ++rep) {
        if (rep) xcd_barrier(bar);
        { const int c0 = ((R / 256) * (2 * DFF / 256)) % G, nwgc = c0 ? G - c0 : G, cc = c0 ? (int)blockIdx.x - c0 : (int)blockIdx.x;
          if (cc >= 0) {
            const bool wt = (nwgc % 4) == 0; const int k = wt ? cc & 3 : 1, j = wt ? cc >> 2 : cc, per = wt ? nwgc / 4 : nwgc, nslot = wt ? 6 * per : per;
            const int s0 = !wt ? j : (k == 1 ? j : (k == 2 ? per + 2 * j : 3 * per + 3 * j));
            int tidc = threadIdx.x; asm volatile("" : "+v"(tidc));
            const int lane = tidc & 63, wave = __builtin_amdgcn_readfirstlane(tidc >> 6);
            for (int q = 0; q < k; ++q)
            for (int m4 = s0 + q + nslot * wave; m4 < 2 * DB * 120; m4 += nslot * NWAVES) {
                const int kv = m4 >= DB * 120, mm = kv ? m4 - DB * 120 : m4, b = mm / 120, j2 = DS + 4 * (mm % 120);
                const GAS f32x4* src = (const GAS f32x4*)(args.in[4 + kv] + ((size_t)b * 512 + j2) * 512) + lane;
                GAS f32x4* dst = (GAS f32x4*)(out + (kv ? OVS : OKS) + ((size_t)b * 512 + (j2 - DS)) * 512) + lane;
                f32x4 v[8];
#pragma unroll
                for (int i = 0; i < 8; ++i) v[i] = src[64 * i];
#pragma unroll
                for (int i = 0; i < 8; ++i) dst[64 * i] = v[i];
            }
            { LAS float* scr = (LAS float*)(lds + RING_OFF + wave * 16384); constexpr int I_D = (DFF / 64) * (D / 32), I_PG = (D / 64) * (D / 32);
              for (int it = cc * NWAVES + wave; it < I_D + I_PG; it += nwgc * NWAVES) {
                  if (it < I_D) p0_transpose_item<0>(args.in[19], nullptr, DFF, D, WDt, scr, it, lane);
                  else p0_transpose_item<0>(args.in[21], args.in[20], D, D, WPGt, scr, it - I_D, lane); }
              __syncthreads(); }
          } }
        pg8::Gemm g{XB, WGUt, R, 2 * DFF, D}; pg8::StaticOrder S; S.init(R, 2 * DFF, G, (int)blockIdx.x);
        pg8::EpiAct E{SS1, ACTb};
        pg8::gemm_phase<pg8::EpiAct, pg8::StaticOrder, true, true>(lds + RING_OFF, g, S, E);
    }
#endif
    xcd_barrier(bar);

#ifndef SKIP_P5
    {
        pg8::Gemm g{ACTb, WDt, RP, D, DFF}; pg8::StaticOrder S; S.init(RP, D, G, (int)blockIdx.x);
        pg8::EpiRes<true> E{nullptr, nullptr, XB, SS2};
        const SEpiRes<true> SE{nullptr, XB + (size_t)RP * D, SS2 + (size_t)RP * 16};
        if (blockIdx.x & 1) for (int t = (int)blockIdx.x; t < 256; t += G) sgemm64(ACTb + (size_t)RP * DFF, WDt, DFF, t, SE, lds + RING_OFF);
        pg8::gemm_phase<pg8::EpiRes<true>, pg8::StaticOrder, true, true>(lds + RING_OFF, g, S, E);
        if (!(blockIdx.x & 1)) for (int t = (int)blockIdx.x; t < 256; t += G) sgemm64(ACTb + (size_t)RP * DFF, WDt, DFF, t, SE, lds + RING_OFF);
    }
#endif
    xcd_barrier(bar);

#ifndef SKIP_P6
    {
        pg8::Gemm g{XB, WPGt, RP, D, D}; pg8::StaticOrder S; S.init(RP, D, G, (int)blockIdx.x);
        pg8::EpiFinal E{SS2, PPb, XB, Y};
        const SEpiFinal SE{SS2 + (size_t)RP * 16, PPb + (size_t)RP * D, XB + (size_t)RP * D, Y + (size_t)RP * D};
        if (blockIdx.x & 1) for (int t = (int)blockIdx.x; t < 256; t += G) sgemm64(XB + (size_t)RP * D, WPGt, D, t, SE, lds + RING_OFF);
        pg8::gemm_phase<pg8::EpiFinal, pg8::StaticOrder, true, true>(lds + RING_OFF, g, S, E);
        if (!(blockIdx.x & 1)) for (int t = (int)blockIdx.x; t < 256; t += G) sgemm64(XB + (size_t)RP * D, WPGt, D, t, SE, lds + RING_OFF);
    }
#endif
}

extern "C" void kernel_launch(void* const* d_in, const int* in_sizes, int n_in, void* d_out, int out_size, void* d_ws, size_t ws_size, hipStream_t stream) {
    static int grid = 0;
    if (grid == 0) {
        if (n_in != 23 || ws_size < WS_END) { fprintf(stderr, "kernel_launch: unexpected shapes (n_in %d, ws %zu)\n", n_in, ws_size); grid = -1; return; }
        int dev = 0, cus = 0, per_cu = 0;
        if (hipGetDevice(&dev) != hipSuccess || hipDeviceGetAttribute(&cus, hipDeviceAttributeMultiprocessorCount, dev) != hipSuccess) { grid = -1; return; }
        if (hipFuncSetAttribute((const void*)mk_fwd, hipFuncAttributeMaxDynamicSharedMemorySize, LDS_BYTES) != hipSuccess) { fprintf(stderr, "kernel_launch: hipFuncSetAttribute failed\n"); grid = -1; return; }
        if (hipOccupancyMaxActiveBlocksPerMultiprocessor(&per_cu, (const void*)mk_fwd, NWAVES * 64, LDS_BYTES) != hipSuccess || per_cu < 1) { fprintf(stderr, "kernel_launch: occupancy query says %d blocks per CU\n", per_cu); }
        (void)hipGetLastError();
        grid = cus;
    }
    if (grid < 0) return;
    if (hipMemsetAsync((char*)d_ws + WS_CTL, 0, CTL_ZERO_BYTES, stream) != hipSuccess) return;
    Args a{};
    for (int i = 0; i < 23; ++i) a.in[i] = (const float*)d_in[i];
    a.out = (float*)d_out; a.ws = (unsigned char*)d_ws;
    hipLaunchKernelGGL(mk_fwd, dim3(grid), dim3(NWAVES * 64), LDS_BYTES, stream, a);
}
```

```cpp
#include <hip/hip_runtime.h>
#include <cstdio>
#include <cstdint>
constexpr int D = 1024, SEQ = 8192, NB = 4, DB = 32, DS = 32;
constexpr int RP = NB * SEQ, RS = DB * DS, R = RP + RS;
constexpr int INC = 2560, DFF = 2816, PLE = 256, NH = 8, HD = 64, CW = 512;
constexpr int NREL = 257, CONVW = 31, CH = 30, KSROWS = 576;
constexpr int KVT_BYTES = 131072;
constexpr float EPS = 1e-6f, LOG2E = 1.4426950408889634f, QSCALE = 0.125f * LOG2E;
constexpr size_t OY = 0, OKP = (size_t)R * D, OVP = OKP + (size_t)NB * 512 * 512, OCP = OVP + (size_t)NB * 512 * 512,
                 OKS = OCP + (size_t)NB * CH * CW, OVS = OKS + (size_t)DB * 512 * 512, OCS = OVS + (size_t)DB * 512 * 512;
namespace pg8 {
#define PG8_LAS __attribute__((address_space(3)))
typedef unsigned short bf16_t;
typedef short bf16x8 __attribute__((ext_vector_type(8)));
typedef float f32x4 __attribute__((ext_vector_type(4)));
typedef unsigned u32x4 __attribute__((ext_vector_type(4)));
constexpr int BM = 256, BK = 64, HALF = 128, HTB = HALF * BK * 2  , STAGE_BYTES = 8 * HTB, NXCD = 8, WGM = 8;

__host__ __device__ __forceinline__ int lds_byte(int r, int c) { const int st = (r >> 4) * 2 + (c >> 5), rr = r & 15, cc = c & 31, ob = rr * 64 + cc * 2; return st * 1024 + (ob ^ (((ob >> 9) & 1) << 5)); }
__host__ __device__ __forceinline__ void stage_rc(int b, int& R, int& C) { const int st = b / 1024, sb = b % 1024, swz = sb ^ (((sb >> 9) & 1) << 5); R = (st >> 1) * 16 + swz / 64; C = (st & 1) * 32 + (swz % 64) / 2; }
__host__ __device__ __forceinline__ int perm32(int rho) { const int n = rho >> 4, i = rho & 15; return 8 * (i >> 2) + 4 * n + (i & 3); }

struct Unit { int pm, pn; };
struct Gemm { const bf16_t* A; const bf16_t* Bt; int M, N, K; };

struct StaticOrder {
    int nM, nN, nwg, G, c;
    __host__ __device__ void init(int M, int N, int G_, int c_) { nM = M / BM; nN = N / BM; nwg = nM * nN; G = G_; c = c_; }
    __host__ __device__ bool next(int i, Unit& u) const {
        const long L = (long)i * G + c; if (L >= nwg) return false;
        int wgid = (int)L; { const int q = nwg / NXCD, r = nwg % NXCD, xcd = wgid % NXCD, off = wgid / NXCD; wgid = (xcd < r ? xcd * (q + 1) : r * (q + 1) + (xcd - r) * q) + off; }
        const int nig = WGM * nN, gid = wgid / nig, fm = gid * WGM, gsz = (nM - fm) < WGM ? (nM - fm) : WGM;
        u.pm = fm + ((wgid % nig) % gsz); u.pn = (wgid % nig) / gsz; return true;
    }
    __device__ __forceinline__ void a_ready(const Unit&) const {}
    __device__ __forceinline__ void done(const Unit&) const {}
};

__device__ __forceinline__ unsigned cvt_pk_bf16(float lo, float hi) { unsigned r; asm volatile("v_cvt_pk_bf16_f32 %0, %1, %2" : "=v"(r) : "v"(lo), "v"(hi)); return r; }
typedef float f32x2 __attribute__((ext_vector_type(2)));typedef unsigned u32x2 __attribute__((ext_vector_type(2)));
__device__ __forceinline__ u32x4 pack8(const f32x4 a, const f32x4 b) { u32x4 w; w.x = cvt_pk_bf16(a[0], a[1]); w.y = cvt_pk_bf16(a[2], a[3]); w.z = cvt_pk_bf16(b[0], b[1]); w.w = cvt_pk_bf16(b[2], b[3]); return w; }
__device__ __forceinline__ float sigm(float x) { return __builtin_amdgcn_rcpf(1.0f + __builtin_amdgcn_exp2f(-x * LOG2E)); }
__device__ __forceinline__ float quad_sum(float s) { s += __shfl_xor(s, 16); s += __shfl_xor(s, 32); return s; }
struct Epi1 {
    static constexpr bool PERM = true, AFTER_DRAIN = false;
    const float* rx; const float* qg; const float* kg; bf16_t* Q; unsigned char* KVP; unsigned char* KVS; bf16_t* GLU; float* out;
    __device__ __forceinline__ void operator()(const f32x4 (&acc)[2][2][4][2], const Unit& u, int wr, int wc, int fr, int fq) const {
        const int pn = u.pn, rowt = u.pm * BM + wr * 64 + fr;
        float rxv[2][4];
#pragma unroll
        for (int ai = 0; ai < 2; ++ai)
#pragma unroll
            for (int m = 0; m < 4; ++m) rxv[ai][m] = rx[rowt + ai * HALF + m * 16];
        if (pn < 6) {
            const int sec = pn >> 1, col = (4 * (pn & 1) + wc) * 64 + 8 * fq;
            f32x4 g[2][2];
#pragma unroll
            for (int bj = 0; bj < 2; ++bj)
#pragma unroll
                for (int n = 0; n < 2; ++n) { g[bj][n] = (f32x4){1.f, 1.f, 1.f, 1.f};
                    if (sec == 0) g[bj][n] = *(const f32x4*)(qg + 32 * bj + 8 * fq + 4 * n) * QSCALE;
                    if (sec == 1) g[bj][n] = *(const f32x4*)(kg + 32 * bj + 8 * fq + 4 * n); }
#pragma unroll
            for (int ai = 0; ai < 2; ++ai)
#pragma unroll
                for (int m = 0; m < 4; ++m) {
                    const int row = rowt + ai * HALF + m * 16; const float r = rxv[ai][m];
                    f32x4 z[2][2];
#pragma unroll
                    for (int bj = 0; bj < 2; ++bj)
#pragma unroll
                        for (int n = 0; n < 2; ++n) z[bj][n] = acc[ai][bj][m][n] * r;
                    if (sec < 2) {
                        float ss = 0.f;
#pragma unroll
                        for (int bj = 0; bj < 2; ++bj)
#pragma unroll
                            for (int n = 0; n < 2; ++n) { const f32x4 q = z[bj][n] * z[bj][n]; ss += (q[0] + q[1]) + (q[2] + q[3]); }
                        ss = quad_sum(ss);
                        const float rn = rsqrtf(ss * (1.0f / 64.0f) + EPS);
#pragma unroll
                        for (int bj = 0; bj < 2; ++bj)
#pragma unroll
                            for (int n = 0; n < 2; ++n) z[bj][n] = z[bj][n] * rn * g[bj][n];
                    }
                    const int sb = (row - RP) >> 5, si = (row - RP) & 31;
                    float* fo = nullptr;
                    if (sec == 0) {
#pragma unroll
                        for (int bj = 0; bj < 2; ++bj) *(u32x4*)(Q + (size_t)row * 512 + col + 32 * bj) = pack8(z[bj][0], z[bj][1]);
                    } else {
                        unsigned char* tb; int kv;
                        if (row < RP) { tb = KVP + (size_t)(row >> 6) * KVT_BYTES; kv = row & 63;
                            const int t = row & (SEQ - 1); if (t >= SEQ - 512) fo = out + OKP + (size_t)(sec - 1) * (OVP - OKP) + ((size_t)((row >> 13) * 512 + (t - (SEQ - 512)))) * 512 + col; }
                        else { tb = KVS + (size_t)(sb * 9 + 8) * KVT_BYTES; kv = si; fo = out + OKS + (size_t)(sec - 1) * (OVS - OKS) + ((size_t)(sb * 512 + 480 + si)) * 512 + col; }
                        tb += (pn & 1) * 65536 + wc * 16384;
                        const int ok = fq * 1024 + kv * 16, ov = 8192 + (kv >> 4) * 1024 + (kv & 15) * 64 + fq * 16;
#pragma unroll
                        for (int bj = 0; bj < 2; ++bj) *(u32x4*)(tb + (sec == 1 ? ok + bj * 4096 : ov + bj * 4096)) = pack8(z[bj][0], z[bj][1]);
                    }
                    if (fo) {
#pragma unroll
                        for (int bj = 0; bj < 2; ++bj)
#pragma unroll
                            for (int n = 0; n < 2; ++n) *(f32x4*)(fo + 32 * bj + 4 * n) = z[bj][n]; }
                }
        } else {
            const int col = 128 * (pn - 6) + 32 * wc + 8 * fq;
#pragma unroll
            for (int ai = 0; ai < 2; ++ai)
#pragma unroll
                for (int m = 0; m < 4; ++m) {
                    const int row = rowt + ai * HALF + m * 16; const float r = rxv[ai][m];
                    f32x4 gl[2];
#pragma unroll
                    for (int n = 0; n < 2; ++n) { const f32x4 a = acc[ai][0][m][n] * r, b = acc[ai][1][m][n] * r;
#pragma unroll
                        for (int e = 0; e < 4; ++e) gl[n][e] = a[e] * sigm(b[e]); }
                    *(u32x4*)(GLU + (size_t)row * 512 + col) = pack8(gl[0], gl[1]);
                    float* fo = nullptr;
                    if (row < RP) { const int t = row & (SEQ - 1); if (t >= SEQ - CH) fo = out + OCP + ((size_t)((row >> 13) * CH + (t - (SEQ - CH)))) * CW + col; }
                    else { const int sb = (row - RP) >> 5, si = (row - RP) & 31; if (si >= DS - CH) fo = out + OCS + ((size_t)(sb * CH + (si - (DS - CH)))) * CW + col; }
                    if (fo) { *(f32x4*)(fo) = gl[0]; *(f32x4*)(fo + 4) = gl[1]; }
                }
        }
    }
};
struct EpiPP {
    static constexpr bool PERM = true, AFTER_DRAIN = false;
    bf16_t* O;
    __device__ __forceinline__ void operator()(const f32x4 (&acc)[2][2][4][2], const Unit& u, int wr, int wc, int fr, int fq) const {
        const int rowt = u.pm * BM + wr * 64 + fr, col = u.pn * BM + 32 * wc + 8 * fq;
#pragma unroll
        for (int ai = 0; ai < 2; ++ai)
#pragma unroll
            for (int m = 0; m < 4; ++m) { bf16_t* rowp = O + (size_t)(rowt + ai * HALF + m * 16) * D + col;
#pragma unroll
                for (int bj = 0; bj < 2; ++bj) *(u32x4*)(rowp + bj * HALF) = pack8(acc[ai][bj][m][0], acc[ai][bj][m][1]); }
    }
};
__device__ __forceinline__ f32x4 bf_lo4(const u32x4 w) { return (f32x4){__uint_as_float(w.x << 16), __uint_as_float(w.x & 0xffff0000u), __uint_as_float(w.y << 16), __uint_as_float(w.y & 0xffff0000u)}; }
__device__ __forceinline__ f32x4 bf_hi4(const u32x4 w) { return (f32x4){__uint_as_float(w.z << 16), __uint_as_float(w.z & 0xffff0000u), __uint_as_float(w.w << 16), __uint_as_float(w.w & 0xffff0000u)}; }
template <bool BF> struct EpiRes {
    static constexpr bool PERM = true, AFTER_DRAIN = false;
    const float* bp; const float* bs; bf16_t* HB; float* SS;
    __device__ __forceinline__ void operator()(const f32x4 (&acc)[2][2][4][2], const Unit& u, int wr, int wc, int fr, int fq) const {
        const int rowt = u.pm * BM + wr * 64 + fr, col = u.pn * BM + 32 * wc + 8 * fq;
        f32x4 bv[2][2][2];
        auto ldbase = [&](int i, f32x4 (&d)[2][2]) {
            const int row = rowt + (i >> 2) * HALF + (i & 3) * 16;
            if (BF) { const bf16_t* hrow = HB + (size_t)row * D + col;
#pragma unroll
                for (int bj = 0; bj < 2; ++bj) { const u32x4 w = *(const u32x4*)(hrow + bj * HALF); d[bj][0] = bf_lo4(w); d[bj][1] = bf_hi4(w); } }
            else { const float* brow = (row < RP ? bp + (size_t)row * D : bs + (size_t)(row - RP) * D) + col;
#pragma unroll
                for (int bj = 0; bj < 2; ++bj) { d[bj][0] = *(const f32x4*)(brow + bj * HALF); d[bj][1] = *(const f32x4*)(brow + bj * HALF + 4); } } };
        ldbase(0, bv[0]);
#pragma unroll
        for (int i = 0; i < 8; ++i) {
            const int ai = i >> 2, m = i & 3, row = rowt + ai * HALF + m * 16;
            if (i + 1 < 8) ldbase(i + 1, bv[(i + 1) & 1]);
            bf16_t* hrow = HB + (size_t)row * D + col;
            float ss = 0.f;
#pragma unroll
            for (int bj = 0; bj < 2; ++bj) {
                const f32x4 v0 = bv[i & 1][bj][0] + acc[ai][bj][m][0], v1 = bv[i & 1][bj][1] + acc[ai][bj][m][1];
                *(u32x4*)(hrow + bj * HALF) = pack8(v0, v1);
                const f32x4 q0 = v0 * v0, q1 = v1 * v1; ss += ((q0[0] + q0[1]) + (q0[2] + q0[3])) + ((q1[0] + q1[1]) + (q1[2] + q1[3]));
            }
            ss = quad_sum(ss);
            if (fq == 0) SS[(size_t)row * 16 + 4 * u.pn + wc] = ss;
        }
    }
};
__device__ __forceinline__ float row_rs(const float* SS, int row, int fq) {
    const f32x4 s4 = *(const f32x4*)(SS + (size_t)row * 16 + 4 * fq);
    return rsqrtf(quad_sum((s4[0] + s4[1]) + (s4[2] + s4[3])) * (1.0f / D) + EPS);
}
struct EpiAct {
    static constexpr bool PERM = true, AFTER_DRAIN = false;
    const float* SS; bf16_t* ACT;
    __device__ __forceinline__ void operator()(const f32x4 (&acc)[2][2][4][2], const Unit& u, int wr, int wc, int fr, int fq) const {
        const int rowt = u.pm * BM + wr * 64 + fr, col = 128 * u.pn + 32 * wc + 8 * fq;
        float rv[2][4];
#pragma unroll
        for (int ai = 0; ai < 2; ++ai)
#pragma unroll
            for (int m = 0; m < 4; ++m) rv[ai][m] = row_rs(SS, rowt + ai * HALF + m * 16, fq);
#pragma unroll
        for (int ai = 0; ai < 2; ++ai)
#pragma unroll
            for (int m = 0; m < 4; ++m) {
                const int row = rowt + ai * HALF + m * 16; const float r = rv[ai][m];
                f32x4 v[2];
#pragma unroll
                for (int n = 0; n < 2; ++n) { const f32x4 g = acc[ai][0][m][n] * r, up = acc[ai][1][m][n] * r;
#pragma unroll
                    for (int e = 0; e < 4; ++e) v[n][e] = g[e] * sigm(g[e]) * up[e]; }
                *(u32x4*)(ACT + (size_t)row * DFF + col) = pack8(v[0], v[1]);
            }
    }
};
struct EpiFinal {
    static constexpr bool PERM = true, AFTER_DRAIN = false;
    const float* SS; const bf16_t* PP; const bf16_t* HB; float* Y;
    __device__ __forceinline__ void operator()(const f32x4 (&acc)[2][2][4][2], const Unit& u, int wr, int wc, int fr, int fq) const {
        const int rowt = u.pm * BM + wr * 64 + fr, col = u.pn * BM + 32 * wc + 8 * fq;
        float rv[2][4];
#pragma unroll
        for (int ai = 0; ai < 2; ++ai)
#pragma unroll
            for (int m = 0; m < 4; ++m) rv[ai][m] = row_rs(SS, rowt + ai * HALF + m * 16, fq);
        u32x4 pwv[2][2], hwv[2][2];
        auto ld = [&](int i, u32x4 (&p)[2], u32x4 (&h)[2]) { const size_t o = (size_t)(rowt + (i >> 2) * HALF + (i & 3) * 16) * D + col;
#pragma unroll
            for (int bj = 0; bj < 2; ++bj) { p[bj] = *(const u32x4*)(PP + o + bj * HALF); h[bj] = *(const u32x4*)(HB + o + bj * HALF); } };
        ld(0, pwv[0], hwv[0]);
#pragma unroll
        for (int i = 0; i < 8; ++i) {
            const int ai = i >> 2, m = i & 3, row = rowt + ai * HALF + m * 16; const float r = rv[ai][m];
            if (i + 1 < 8) ld(i + 1, pwv[(i + 1) & 1], hwv[(i + 1) & 1]);
#pragma unroll
            for (int bj = 0; bj < 2; ++bj) {
                const size_t o = (size_t)row * D + col + bj * HALF;
                const u32x4 pw = pwv[i & 1][bj], hw = hwv[i & 1][bj];
                const f32x4 a0 = acc[ai][bj][m][0] * r, a1 = acc[ai][bj][m][1] * r, p0 = bf_lo4(pw), p1 = bf_hi4(pw);
                f32x4 h0 = bf_lo4(hw), h1 = bf_hi4(hw);
#pragma unroll
                for (int e2 = 0; e2 < 4; ++e2) { h0[e2] += sigm(a0[e2]) * p0[e2]; h1[e2] += sigm(a1[e2]) * p1[e2]; }
                *(f32x4*)(Y + o) = h0; *(f32x4*)(Y + o + 4) = h1;
            }
        }
    }
};

template <class Epi, class Sched, bool ALIGN_EPI = false, bool SP2 = false>
__device__ __forceinline__ void gemm_phase(PG8_LAS unsigned char* lds, const Gemm g, const Sched& S, const Epi& E) {
    int tid_ = threadIdx.x; asm volatile("" : "+v"(tid_));
    const int tid = tid_, wid = __builtin_amdgcn_readfirstlane(tid >> 6), lane = tid & 63, wr = wid >> 2, wc = wid & 3, fr = lane & 15, fq = lane >> 4;
    int K_ = g.K; asm volatile("" : "+s"(K_));
    const int K = K_, nt = K / BK;
    unsigned voffA[2], voffB[2];
#pragma unroll
    for (int i = 0; i < 2; ++i) { int R, C; stage_rc(tid * 16 + i * 8192, R, C); const int Rb = Epi::PERM ? ((R & ~31) + perm32(R & 31)) : R;
        voffA[i] = (unsigned)(R * K + C) * 2u; voffB[i] = (unsigned)(Rb * K + C) * 2u; }
    const size_t kstep = (size_t)(BK * 2);
    const size_t hstep = (size_t)HALF * K * 2;
    const size_t tstep = 2 * hstep;
    const unsigned ldsw = (unsigned)wid * 1024u;
    const int aoff = lds_byte(wr * 64 + fr, fq * 8), boff = lds_byte(wc * 32 + fr, fq * 8);
#define PG8_SA(b, h) (((b) * 2 + (h)) * HTB)
#define PG8_SB(b, h) ((4 + (b) * 2 + (h)) * HTB)
#define PG8_STAGE(bufoff, gbase, voff) do { _Pragma("unroll") for (int _i = 0; _i < 2; ++_i) \
        __builtin_amdgcn_global_load_lds((const unsigned*)((const char*)(gbase) + (voff)[_i]), (PG8_LAS unsigned*)(lds + (bufoff) + ldsw + _i * 8192), 16, 0, 0); } while (0)
#define PG8_LDA(dst, b, h) do { _Pragma("unroll") for (int m = 0; m < 4; ++m) _Pragma("unroll") for (int k = 0; k < 2; ++k) dst[m][k] = *(const PG8_LAS bf16x8*)(lds + PG8_SA(b, h) + aoff + m * 2048 + k * 1024); } while (0)
#define PG8_LDB(dst, b, h) do { _Pragma("unroll") for (int n = 0; n < 2; ++n) _Pragma("unroll") for (int k = 0; k < 2; ++k) dst[n][k] = *(const PG8_LAS bf16x8*)(lds + PG8_SB(b, h) + boff + n * 2048 + k * 1024); } while (0)
#define PG8_MMA(ai, bj, At, Bt) do { __builtin_amdgcn_s_setprio(1); _Pragma("unroll") for (int m = 0; m < 4; ++m) _Pragma("unroll") for (int n = 0; n < 2; ++n) _Pragma("unroll") for (int k = 0; k < 2; ++k) \
        acc[ai][bj][m][n] = __builtin_amdgcn_mfma_f32_16x16x32_bf16(Bt[n][k], At[m][k], acc[ai][bj][m][n], 0, 0, 0); __builtin_amdgcn_s_setprio(0); } while (0)
#define PG8_WAIT_V(n) asm volatile("s_waitcnt vmcnt(" #n ")" ::: "memory")
#define PG8_WAIT_L(n) asm volatile("s_waitcnt lgkmcnt(" #n ")" ::: "memory")
#define PG8_BAR __builtin_amdgcn_s_barrier()
#define PG8_SCHED __builtin_amdgcn_sched_barrier(0)
    Unit cur, nxt; int ui = 0;
    if (!S.next(0, cur)) return;
    f32x4 acc[2][2][4][2];
#pragma unroll
    for (int a = 0; a < 2; ++a)
#pragma unroll
        for (int b = 0; b < 2; ++b)
#pragma unroll
            for (int m = 0; m < 4; ++m)
#pragma unroll
                for (int n = 0; n < 2; ++n) acc[a][b][m][n] = (f32x4){0.f, 0.f, 0.f, 0.f};
    bf16x8 At[4][2], B0[2][2], B1[2][2];
    const char* cA = (const char*)g.A + (size_t)cur.pm * tstep; const char* cB = (const char*)g.Bt + (size_t)cur.pn * tstep;
    S.a_ready(cur);
    if constexpr (SP2) {
        PG8_STAGE(PG8_SB(0, 0), cB, voffB); PG8_STAGE(PG8_SB(0, 1), cB + hstep, voffB); PG8_STAGE(PG8_SA(0, 0), cA, voffA); PG8_STAGE(PG8_SA(0, 1), cA + hstep, voffA);
        if (wr == 1) PG8_BAR;
        PG8_WAIT_V(2); PG8_BAR;
        PG8_STAGE(PG8_SB(1, 0), cB + kstep, voffB); PG8_STAGE(PG8_SA(1, 0), cA + kstep, voffA); PG8_STAGE(PG8_SB(1, 1), cB + hstep + kstep, voffB);
        PG8_WAIT_V(6); PG8_BAR;
    } else {
        PG8_STAGE(PG8_SB(0, 0), cB, voffB); PG8_STAGE(PG8_SA(0, 0), cA, voffA); PG8_STAGE(PG8_SB(0, 1), cB + hstep, voffB); PG8_STAGE(PG8_SA(0, 1), cA + hstep, voffA);
        if (wr == 1) PG8_BAR;
        PG8_WAIT_V(4); PG8_BAR;
        PG8_STAGE(PG8_SB(1, 0), cB + kstep, voffB); PG8_STAGE(PG8_SA(1, 0), cA + kstep, voffA); PG8_STAGE(PG8_SB(1, 1), cB + hstep + kstep, voffB);
        PG8_WAIT_V(6); PG8_BAR;
    }
    for (;;) {
        const bool has_next = S.next(ui + 1, nxt);
        const char* nA = has_next ? (const char*)g.A + (size_t)nxt.pm * tstep : cA; const char* nB = has_next ? (const char*)g.Bt + (size_t)nxt.pn * tstep : cB;
        for (int t = 0; t < nt; t += 2) {
            const bool last = (t == nt - 2);
            const char* a1 = cA + (size_t)(t + 1) * kstep;
            const char* a2 = last ? nA : cA + (size_t)(t + 2) * kstep; const char* b2 = last ? nB : cB + (size_t)(t + 2) * kstep;
            const char* a3 = a2 + kstep; const char* b3 = b2 + kstep;
            if (last && has_next) S.a_ready(nxt);
            if constexpr (SP2) {
            PG8_LDB(B0, 0, 0); PG8_LDB(B1, 0, 1); PG8_SCHED; PG8_LDA(At, 0, 0); PG8_STAGE(PG8_SA(1, 1), a1 + hstep, voffA);
            PG8_WAIT_V(8); PG8_WAIT_L(0); PG8_BAR; PG8_MMA(0, 0, At, B0); PG8_MMA(0, 1, At, B1); PG8_BAR; PG8_SCHED;
            PG8_LDA(At, 0, 1); PG8_STAGE(PG8_SB(0, 0), b2, voffB); PG8_STAGE(PG8_SB(0, 1), b2 + hstep, voffB); PG8_STAGE(PG8_SA(0, 0), a2, voffA);
            PG8_WAIT_V(8); PG8_WAIT_L(0); PG8_BAR; PG8_MMA(1, 0, At, B0); PG8_MMA(1, 1, At, B1); PG8_BAR; PG8_SCHED;
            PG8_LDB(B0, 1, 0); PG8_LDB(B1, 1, 1); PG8_SCHED; PG8_LDA(At, 1, 0); PG8_STAGE(PG8_SA(0, 1), a2 + hstep, voffA);
            PG8_WAIT_V(8); PG8_WAIT_L(0); PG8_BAR; PG8_MMA(0, 0, At, B0); PG8_MMA(0, 1, At, B1); PG8_BAR; PG8_SCHED;
            PG8_LDA(At, 1, 1); PG8_STAGE(PG8_SB(1, 0), b3, voffB); PG8_STAGE(PG8_SB(1, 1), b3 + hstep, voffB); PG8_STAGE(PG8_SA(1, 0), a3, voffA);
            PG8_WAIT_V(8); PG8_WAIT_L(0); PG8_BAR; PG8_MMA(1, 0, At, B0); PG8_MMA(1, 1, At, B1); PG8_BAR; PG8_SCHED;
            } else {
            PG8_LDB(B0, 0, 0); PG8_SCHED; PG8_LDA(At, 0, 0); PG8_STAGE(PG8_SA(1, 1), a1 + hstep, voffA);
            PG8_WAIT_L(8); PG8_BAR; PG8_WAIT_L(0); PG8_MMA(0, 0, At, B0); PG8_BAR; PG8_SCHED;
            PG8_LDB(B1, 0, 1); PG8_STAGE(PG8_SB(0, 0), b2, voffB);
            PG8_BAR; PG8_WAIT_L(0); PG8_MMA(0, 1, At, B1); PG8_BAR;
            PG8_LDA(At, 0, 1); PG8_STAGE(PG8_SA(0, 0), a2, voffA);
            PG8_BAR; PG8_WAIT_L(0); PG8_MMA(1, 0, At, B0); PG8_BAR; PG8_SCHED;
            PG8_STAGE(PG8_SB(0, 1), b2 + hstep, voffB);
            PG8_WAIT_V(6); PG8_BAR; PG8_MMA(1, 1, At, B1); PG8_BAR;
            PG8_LDB(B0, 1, 0); PG8_SCHED; PG8_LDA(At, 1, 0); PG8_STAGE(PG8_SA(0, 1), a2 + hstep, voffA);
            PG8_WAIT_L(8); PG8_BAR; PG8_WAIT_L(0); PG8_MMA(0, 0, At, B0); PG8_BAR; PG8_SCHED;
            PG8_LDB(B1, 1, 1); PG8_STAGE(PG8_SB(1, 0), b3, voffB);
            PG8_BAR; PG8_WAIT_L(0); PG8_MMA(0, 1, At, B1); PG8_BAR;
            PG8_LDA(At, 1, 1); PG8_STAGE(PG8_SA(1, 0), a3, voffA);
            PG8_BAR; PG8_WAIT_L(0); PG8_MMA(1, 0, At, B0); PG8_BAR; PG8_SCHED;
            PG8_STAGE(PG8_SB(1, 1), b3 + hstep, voffB);
            PG8_WAIT_V(6); PG8_BAR; PG8_MMA(1, 1, At, B1); PG8_BAR;
            }
        }
        if constexpr (ALIGN_EPI) { if (wr == 0) PG8_BAR; }
        if constexpr (!Epi::AFTER_DRAIN) { E(acc, cur, wr, wc, fr, fq); S.done(cur); }
        if (!has_next) break;
#pragma unroll
        for (int a = 0; a < 2; ++a)
#pragma unroll
            for (int b = 0; b < 2; ++b)
#pragma unroll
                for (int m = 0; m < 4; ++m)
#pragma unroll
                    for (int n = 0; n < 2; ++n) acc[a][b][m][n] = (f32x4){0.f, 0.f, 0.f, 0.f};
        cur = nxt; cA = nA; cB = nB; ++ui;
        if constexpr (ALIGN_EPI) { if (wr == 1) PG8_BAR; }
    }
    PG8_WAIT_V(0);
    if constexpr (!ALIGN_EPI) { if (wr == 0) PG8_BAR; }
    PG8_BAR;
    if constexpr (Epi::AFTER_DRAIN) { E.fused(acc, cur, wr, wc, fr, fq, lds, wid, lane); S.done(cur); }
#undef PG8_SA
#undef PG8_SB
#undef PG8_STAGE
#undef PG8_LDA
#undef PG8_LDB
#undef PG8_MMA
#undef PG8_WAIT_V
#undef PG8_WAIT_L
#undef PG8_BAR
#undef PG8_SCHED
}
}
#define GAS __attribute__((address_space(1)))
#define LAS __attribute__((address_space(3)))
typedef unsigned short bf16;
typedef unsigned v4u __attribute__((ext_vector_type(4)));
typedef float f32x4 __attribute__((ext_vector_type(4)));
typedef short bf16x8 __attribute__((ext_vector_type(8)));
typedef GAS unsigned gu32;
typedef GAS unsigned long long gu64;
#define RLX_AGENT __ATOMIC_RELAXED, __HIP_MEMORY_SCOPE_AGENT
#define LDS_WAIT() asm volatile("s_waitcnt lgkmcnt(0)" ::: "memory")
#define VM_WAIT() asm volatile("s_waitcnt vmcnt(0)" ::: "memory")
__device__ __forceinline__ unsigned long long rt() { return __builtin_amdgcn_s_memrealtime(); }
__device__ __forceinline__ unsigned f2bf(float f) { unsigned u = __builtin_bit_cast(unsigned, f); return (u + 0x7fffu + ((u >> 16) & 1u)) >> 16; }
__device__ __forceinline__ unsigned pk2(float lo, float hi) { return f2bf(lo) | (f2bf(hi) << 16); }
#define XB_TMO      128
#define XB_XCNT(j)  (256  + 64 * (j))
#define XB_XSUB(j)  (1280 + 64 * (j))
#define XB_XGEN(j)  (2304 + 64 * (j))
#define XB_TOP      3328
#define XB_TOPGEN   3392
#define XCD_BAR_WORDS 3456
#define XB_SPIN_CAP (1u << 18)

__device__ __forceinline__ unsigned xb_ld(unsigned* p)              { return __hip_atomic_load(p, __ATOMIC_RELAXED, __HIP_MEMORY_SCOPE_AGENT); }
__device__ __forceinline__ unsigned xb_add(unsigned* p, unsigned v) { return __hip_atomic_fetch_add(p, v, __ATOMIC_RELAXED, __HIP_MEMORY_SCOPE_AGENT); }
__device__ __forceinline__ unsigned xb_xcc_id() { return (unsigned)__builtin_amdgcn_s_getreg((3 << 11) | 20) & 0xFu; }
#define XB_SPIN(cond, bar) do { unsigned _sp = 0; while (cond) { __builtin_amdgcn_s_sleep(1); \
    if ((++_sp & 255u) == 0u) { if (xb_ld(&(bar)[XB_TMO])) break; if (_sp > XB_SPIN_CAP) { atomicAdd(&(bar)[XB_TMO], 1u); break; } } } } while (0)

struct XcdBarrier {
    unsigned* bar; unsigned x;
    volatile LAS unsigned* st;
};

__device__ __forceinline__ XcdBarrier xcd_barrier_post(unsigned* bar, volatile LAS unsigned* st) {
    XcdBarrier b; b.bar = bar; b.x = xb_xcc_id(); b.st = st;
    if (threadIdx.x == 0) (void)xb_add(&bar[XB_XCNT(b.x)], 1u);
    return b;
}
__device__ __forceinline__ void xcd_barrier_complete(unsigned* bar, unsigned x, unsigned& nloc, unsigned& nx) {
    const unsigned G = gridDim.x * gridDim.y * gridDim.z;
    unsigned sum, cnt, mine, sp = 0u;
    for (;;) {
        sum = 0u; cnt = 0u; mine = 0u;
#pragma unroll
        for (unsigned j = 0; j < 16; ++j) { const unsigned c = xb_ld(&bar[XB_XCNT(j)]); sum += c; cnt += (c > 0u) ? 1u : 0u; mine = (j == x) ? c : mine; }
        if (sum == G) break;
        __builtin_amdgcn_s_sleep(1);
        if ((++sp & 255u) == 0u) { if (xb_ld(&bar[XB_TMO])) break; if (sp > XB_SPIN_CAP) { atomicAdd(&bar[XB_TMO], 1u); break; } }
    }
    nloc = mine > 0u ? mine : 1u; nx = cnt > 0u ? cnt : 1u;
}

__device__ __forceinline__ void xcd_barrier(const XcdBarrier& b) {
    asm volatile("s_waitcnt vmcnt(0)" ::: "memory");
    __syncthreads();
    if (threadIdx.x == 0) {
        unsigned* bar = b.bar;
        __builtin_amdgcn_s_waitcnt(0);
        unsigned nloc = b.st[0], nx = b.st[1];
        if (nloc == 0u) { xcd_barrier_complete(bar, b.x, nloc, nx); b.st[0] = nloc; b.st[1] = nx; }
        const unsigned old = xb_add(&bar[XB_XSUB(b.x)], 1u);
        const unsigned gen = old / nloc;
        if (old + 1u == (gen + 1u) * nloc) {
            __builtin_amdgcn_fence(__ATOMIC_RELEASE, "agent");
            asm volatile("s_waitcnt vmcnt(0)" ::: "memory");
            const unsigned og = xb_add(&bar[XB_TOP], 1u);
            const unsigned tg = og / nx;
            if (og + 1u == (tg + 1u) * nx) xb_add(&bar[XB_TOPGEN], 1u);
            else XB_SPIN(xb_ld(&bar[XB_TOPGEN]) == tg, bar);
            __builtin_amdgcn_fence(__ATOMIC_ACQUIRE, "agent");
            xb_add(&bar[XB_XGEN(b.x)], 1u);
            asm volatile("s_waitcnt vmcnt(0)" ::: "memory");
        } else {
            XB_SPIN(xb_ld(&bar[XB_XGEN(b.x)]) == gen, bar);
            __builtin_amdgcn_fence(__ATOMIC_ACQUIRE, "agent");
            asm volatile("s_waitcnt vmcnt(0)" ::: "memory");
        }
    }
    __syncthreads();
}
constexpr int NWAVES = 8;
constexpr size_t MiB = 1u << 20;
constexpr size_t WS_CTL = 0, CTL_ZERO_BYTES = 65536;
constexpr size_t WS_W1 = 1 * MiB, WS_WO = 6 * MiB, WS_WGU = 8 * MiB, WS_WD = 19 * MiB, WS_WPG = 25 * MiB, WS_WPP = 27 * MiB;
constexpr size_t WS_RX = 28 * MiB, WS_SS1 = 29 * MiB, WS_SS2 = 32 * MiB;
constexpr size_t WS_XB = 36 * MiB;
constexpr size_t WS_PB = 102 * MiB, WS_PP = 119 * MiB;
constexpr size_t WS_Q = 185 * MiB, WS_KP = 218 * MiB, WS_VP = 250 * MiB, WS_KS = 282 * MiB, WS_VS = 300 * MiB, WS_GLU = 318 * MiB, WS_MIX = 351 * MiB;
constexpr size_t WS_ACT = 185 * MiB;
constexpr size_t WS_END = 417 * MiB;
static_assert(WS_XB + (size_t)R * D * 2 <= WS_PB && WS_PB + (size_t)R * PLE * 2 <= WS_PP && WS_PP + (size_t)R * D * 2 <= WS_Q && WS_Q + (size_t)R * 512 * 2 <= WS_KP &&
              WS_KP + (size_t)(RP / 64) * KVT_BYTES <= WS_KS && WS_KS + (size_t)DB * 9 * KVT_BYTES <= WS_GLU && WS_GLU + (size_t)R * 512 * 2 <= WS_MIX &&
              WS_MIX + (size_t)R * D * 2 <= WS_END && WS_ACT + (size_t)R * DFF * 2 <= WS_END && WS_SS1 + (size_t)R * 64 <= WS_SS2 && WS_SS2 + (size_t)R * 64 <= WS_XB && WS_RX + (size_t)R * 4 <= WS_SS1, "d_ws map");
constexpr int CW_BAR = 4096, CW_Q = 8192, CW_QG = CW_Q + 64 * 32;
constexpr int RING_OFF = 0, RING_BYTES = 131072;
constexpr int LDSCTL_OFF = RING_BYTES, MISC_OFF = LDSCTL_OFF + 320;
constexpr int ATT_TAB = 132096, ATT_LSC = ATT_TAB + 8192;
constexpr int LDS_BYTES = 147456;
static_assert(ATT_LSC + 2048 <= LDS_BYTES && MISC_OFF + 128 <= ATT_TAB, "LDS map");

__device__ __forceinline__ float wave_sum(float v) {
#pragma unroll
    for (int o = 1; o < 64; o <<= 1) v += __shfl_xor(v, o);
    return v;
}
__device__ __forceinline__ float wave_max(float v) {
#pragma unroll
    for (int o = 1; o < 64; o <<= 1) v = fmaxf(v, __shfl_xor(v, o));
    return v;
}
__device__ __forceinline__ int map_win(int n) {
    if (n < 1536) { const int sec = n >> 9, nn = n & 511, h = nn >> 6, d = nn & 63; return sec * 512 + 256 * (h >> 2) + 128 * (d >> 5) + 32 * (h & 3) + (d & 31); }
    if (n < 2048) { const int i = n - 1536; return 1536 + 256 * (i >> 7) + (i & 127); }
    const int i = n - 2048; return 1536 + 256 * (i >> 7) + 128 + (i & 127);
}
__device__ __forceinline__ int map_gu(int n) {
    if (n < DFF) return 256 * (n >> 7) + (n & 127);
    const int i = n - DFF; return 256 * (i >> 7) + 128 + (i & 127);
}
template <int MAP> __device__ __forceinline__ void p0_transpose_item(const float* W, const float* gain, int K, int N, bf16* WT, LAS float* scr, int item, int lane) {
    const int nblk = N / 32, kb = item / nblk, nb = item % nblk, k0 = 64 * kb, n0 = 32 * nb;
    { const int nq = lane & 7, kr = lane >> 3; f32x4 v[8];
#pragma unroll
      for (int i = 0; i < 8; ++i) v[i] = *(const GAS f32x4*)(W + (size_t)(k0 + 8 * i + kr) * N + n0 + 4 * nq);
#pragma unroll
      for (int i = 0; i < 8; ++i) { const int kk = 8 * i + kr; const float gk = gain ? gain[k0 + kk] : 1.0f;
#pragma unroll
          for (int e = 0; e < 4; ++e) scr[kk * 33 + 4 * nq + e] = v[i][e] * gk; } }
    LDS_WAIT(); asm volatile("" ::: "memory");
    const int c = lane & 7;
#pragma unroll
    for (int j = 0; j < 4; ++j) { const int n = (lane >> 3) + 8 * j; const LAS float* s = scr + (8 * c) * 33 + n;
        v4u o; o.x = pk2(s[0 * 33], s[1 * 33]); o.y = pk2(s[2 * 33], s[3 * 33]); o.z = pk2(s[4 * 33], s[5 * 33]); o.w = pk2(s[6 * 33], s[7 * 33]);
        const int ns = n0 + n, dr = MAP == 0 ? ns : (MAP == 1 ? map_win(ns) : map_gu(ns));
        *(GAS v4u*)(WT + (size_t)dr * K + k0 + 8 * c) = o; }
    LDS_WAIT(); asm volatile("" ::: "memory");
}

namespace att {
typedef short bf16x8 __attribute__((ext_vector_type(8)));
typedef short s16x4 __attribute__((ext_vector_type(4)));
typedef float f32x16 __attribute__((ext_vector_type(16)));
typedef unsigned u32x4 __attribute__((ext_vector_type(4)));
typedef float f32x2_t __attribute__((ext_vector_type(2))); typedef __bf16 bf16x2_t __attribute__((ext_vector_type(2)));
typedef short v4i16_t __attribute__((ext_vector_type(4)));
typedef LAS const char* lds_cptr;
constexpr int BUFB = 65536, HSLOT = 16384;
__device__ __forceinline__ int crow(int r, int hi) { return (r & 3) + 8 * (r >> 2) + 4 * hi; }
__device__ __forceinline__ void glds16(const void* gsrc, unsigned lds_dst) { unsigned keep;
    asm volatile("s_mov_b32 %0, m0\n\ts_mov_b32 m0, %2\n\ts_nop 0\n\tglobal_load_lds_dwordx4 %1, off\n\ts_mov_b32 m0, %0" : "=&s"(keep) : "v"(gsrc), "s"(lds_dst) : "memory"); }
__device__ __forceinline__ unsigned cvtpk_s(float lo, float hi) { f32x2_t v = {lo, hi}; bf16x2_t b = __builtin_convertvector(v, bf16x2_t); return __builtin_bit_cast(unsigned, b); }
__device__ __forceinline__ s16x4 vtr(lds_cptr p) { return __builtin_bit_cast(s16x4, __builtin_amdgcn_ds_read_tr16_b64_v4i16((LAS v4i16_t*)p)); }
#define ATT_WAIT_BAR() asm volatile("s_waitcnt vmcnt(0) lgkmcnt(0)\n\ts_barrier" ::: "memory")

struct AUnit { const bf16* Qrow; const unsigned char* KV; bf16* Orow; int nt, hg, sample, c0rel; };

__device__ __forceinline__ void attn_prefetch(const AUnit& U, LAS unsigned char* lds, int wid, int lane, bf16x8 (&qr)[2][4]) {
    const int r32 = lane & 31, hi = lane >> 5, hl = wid & 3, ci = wid >> 2, head = 4 * U.hg + hl;
    const bool wact = !U.sample || ci == 0;
    const unsigned char* kvsrc = U.KV + U.hg * 65536 + wid * 1024 + lane * 16;
    const unsigned kvdst = (unsigned)(size_t)lds + wid * 1024;
#pragma unroll
    for (int j_ = 0; j_ < 8; ++j_) glds16(kvsrc + j_ * 8192, (unsigned)__builtin_amdgcn_readfirstlane(kvdst + j_ * 8192));
    const bf16* Qw = U.Qrow + (size_t)((wact ? 64 * ci : 0) + r32) * 512 + head * 64 + hi * 8; const bf16* Qw1 = Qw + (U.sample ? 0 : 32 * 512);
#pragma unroll
    for (int d0 = 0; d0 < 4; ++d0) { qr[0][d0] = *(const bf16x8*)(Qw + d0 * 16); qr[1][d0] = *(const bf16x8*)(Qw1 + d0 * 16); }
}
template <bool TWO> __device__ __forceinline__ void attn_steps(const AUnit& U, LAS unsigned char* lds, int wid, int lane, const bf16x8 (&qr)[2][4], f32x16 (&o)[2][2], float (&lsum)[2]) {
    const int r32 = lane & 31, hi = lane >> 5, hl = wid & 3, ci = wid >> 2, head = 4 * U.hg + hl, nt = U.nt, own = U.c0rel + ci;
    const bool wact = TWO || ci == 0;
    const unsigned lds0 = (unsigned)(size_t)lds;
    const LAS float* tabh = (const LAS float*)(lds + ATT_TAB) + head * 256;
    const unsigned char* kvsrc = U.KV + U.hg * 65536 + wid * 1024 + lane * 16;
    const unsigned kvdst = lds0 + wid * 1024;
#define ATT_DMA(ti, b) do { _Pragma("unroll") for (int j_ = 0; j_ < 8; ++j_) \
        glds16(kvsrc + (size_t)(ti) * KVT_BYTES + j_ * 8192, (unsigned)__builtin_amdgcn_readfirstlane(kvdst + (b) * BUFB + j_ * 8192)); } while (0)
    for (int ti = 0; ti < nt; ++ti) {
        ATT_WAIT_BAR();
        const int b = ti & 1;
        if (ti + 1 < nt) ATT_DMA(ti + 1, b ^ 1);
        const int jt = own - ti;
        if (wact && jt >= 0 && jt <= 8) {
            const float m1 = (!TWO && jt == 0) ? 0.f : 1.f;
            const lds_cptr kp = (lds_cptr)(lds + b * BUFB + hl * HSLOT + hi * 1024 + r32 * 16);
            bf16x8 kf[8];
            { const unsigned ka = (unsigned)(size_t)kp;
              asm volatile("ds_read_b128 %0, %8\n\tds_read_b128 %1, %8 offset:512\n\tds_read_b128 %2, %8 offset:2048\n\tds_read_b128 %3, %8 offset:2560\n\t"
                           "ds_read_b128 %4, %8 offset:4096\n\tds_read_b128 %5, %8 offset:4608\n\tds_read_b128 %6, %8 offset:6144\n\tds_read_b128 %7, %8 offset:6656\n\ts_waitcnt lgkmcnt(0)"
                           : "=&v"(kf[0]), "=&v"(kf[1]), "=&v"(kf[2]), "=&v"(kf[3]), "=&v"(kf[4]), "=&v"(kf[5]), "=&v"(kf[6]), "=&v"(kf[7]) : "v"(ka) : "memory");
              __builtin_amdgcn_sched_barrier(0); }
            f32x16 s[2][2]; s[0][0] = f32x16{}; s[0][1] = f32x16{}; s[1][0] = f32x16{}; s[1][1] = f32x16{};
#pragma unroll
            for (int h2 = 0; h2 < (TWO ? 2 : 1); ++h2)
#pragma unroll
                for (int d0 = 0; d0 < 4; ++d0) { s[h2][0] = __builtin_amdgcn_mfma_f32_32x32x16_bf16(kf[2 * d0], qr[h2][d0], s[h2][0], 0, 0, 0);
                                                 s[h2][1] = __builtin_amdgcn_mfma_f32_32x32x16_bf16(kf[2 * d0 + 1], qr[h2][d0], s[h2][1], 0, 0, 0); }
            u32x4 pw[2][4];
#pragma unroll
            for (int h2 = 0; h2 < (TWO ? 2 : 1); ++h2) {
                f32x16& p0 = s[h2][0]; f32x16& p1 = s[h2][1];
                if (jt < 3) { const LAS float* tp = tabh + (191 - (32 * h2 + r32) - 64 * jt + 4 * hi);
#pragma unroll
                    for (int r = 0; r < 16; ++r) { p0[r] += tp[(r & 3) + 8 * (r >> 2)]; p1[r] += tp[32 + (r & 3) + 8 * (r >> 2)]; } }
                float sacc = 0.f;
#pragma unroll
                for (int r = 0; r < 16; ++r) { p0[r] = __builtin_amdgcn_exp2f(p0[r]); p1[r] = __builtin_amdgcn_exp2f(p1[r]); if (!TWO) p1[r] *= m1; sacc += p0[r] + p1[r]; }
                lsum[h2] += sacc;
#pragma unroll
                for (int k = 0; k < 2; ++k) { pw[h2][k] = (u32x4){cvtpk_s(p0[8 * k], p0[8 * k + 1]), cvtpk_s(p0[8 * k + 2], p0[8 * k + 3]), cvtpk_s(p0[8 * k + 4], p0[8 * k + 5]), cvtpk_s(p0[8 * k + 6], p0[8 * k + 7])};
                    pw[h2][2 + k] = (u32x4){cvtpk_s(p1[8 * k], p1[8 * k + 1]), cvtpk_s(p1[8 * k + 2], p1[8 * k + 3]), cvtpk_s(p1[8 * k + 4], p1[8 * k + 5]), cvtpk_s(p1[8 * k + 6], p1[8 * k + 7])}; }
            }
            const lds_cptr vp = (lds_cptr)(lds + b * BUFB + hl * HSLOT + 8192 + ((lane >> 4) & 1) * 32 + (lane & 3) * 8 + (4 * hi + ((lane & 15) >> 2)) * 64);
            const unsigned va = (unsigned)(size_t)vp;
#pragma unroll
            for (int d0 = 0; d0 < 2; ++d0) {
                s16x4 lo[4], hh[4];
                asm volatile("ds_read_b64_tr_b16 %0, %8 offset:%c9\n\tds_read_b64_tr_b16 %1, %8 offset:%c10\n\tds_read_b64_tr_b16 %2, %8 offset:%c11\n\tds_read_b64_tr_b16 %3, %8 offset:%c12\n\t"
                             "ds_read_b64_tr_b16 %4, %8 offset:%c13\n\tds_read_b64_tr_b16 %5, %8 offset:%c14\n\tds_read_b64_tr_b16 %6, %8 offset:%c15\n\tds_read_b64_tr_b16 %7, %8 offset:%c16\n\ts_waitcnt lgkmcnt(0)"
                             : "=&v"(lo[0]), "=&v"(hh[0]), "=&v"(lo[1]), "=&v"(hh[1]), "=&v"(lo[2]), "=&v"(hh[2]), "=&v"(lo[3]), "=&v"(hh[3])
                             : "v"(va), "i"(d0 * 4096), "i"(d0 * 4096 + 512), "i"(d0 * 4096 + 1024), "i"(d0 * 4096 + 1536), "i"(d0 * 4096 + 2048), "i"(d0 * 4096 + 2560), "i"(d0 * 4096 + 3072), "i"(d0 * 4096 + 3584) : "memory");
                __builtin_amdgcn_sched_barrier(0);
#pragma unroll
                for (int ks = 0; ks < 4; ++ks) {
                    const bf16x8 vf = (bf16x8){lo[ks][0], lo[ks][1], lo[ks][2], lo[ks][3], hh[ks][0], hh[ks][1], hh[ks][2], hh[ks][3]};
                    o[0][d0] = __builtin_amdgcn_mfma_f32_32x32x16_bf16(__builtin_bit_cast(bf16x8, pw[0][ks]), vf, o[0][d0], 0, 0, 0);
                    if (TWO) o[1][d0] = __builtin_amdgcn_mfma_f32_32x32x16_bf16(__builtin_bit_cast(bf16x8, pw[1][ks]), vf, o[1][d0], 0, 0, 0); }
            }
        }
    }
#undef ATT_DMA
}
template <bool TWO> __device__ __forceinline__ void attn_store(const AUnit& U, LAS unsigned char* lds, int wid, int lane, const f32x16 (&o)[2][2], const float (&lsum)[2]) {
    const int r32 = lane & 31, hi = lane >> 5, hl = wid & 3, ci = wid >> 2, head = 4 * U.hg + hl;
    const bool wact = TWO || ci == 0;
    LAS float* lsc = (LAS float*)(lds + ATT_LSC) + wid * 64;
    if (wact) {
#pragma unroll
        for (int h2 = 0; h2 < (TWO ? 2 : 1); ++h2) {
            float ls = lsum[h2];
            { auto rr = __builtin_amdgcn_permlane32_swap(__float_as_uint(ls), __float_as_uint(ls), false, false); ls = __uint_as_float(rr[0]) + __uint_as_float(rr[1]); }
            if (hi == 0) lsc[32 * h2 + r32] = ls;
            asm volatile("s_waitcnt lgkmcnt(0)" ::: "memory");
            LAS bf16* stg = (LAS bf16*)(lds + BUFB + wid * 8192 + h2 * 4096);
#pragma unroll
            for (int r = 0; r < 16; ++r) { const int orow = crow(r, hi); const float rl = __builtin_amdgcn_rcpf(lsc[32 * h2 + orow]);
#pragma unroll
                for (int d0 = 0; d0 < 2; ++d0) stg[orow * 64 + d0 * 32 + r32] = (bf16)f2bf(o[h2][d0][r] * rl); }
            asm volatile("s_waitcnt lgkmcnt(0)" ::: "memory");
            bf16* Ow = U.Orow + (size_t)(64 * ci + 32 * h2) * D + head * 64;
#pragma unroll
            for (int i = 0; i < 4; ++i) { const int row = i * 8 + (lane >> 3), ch = lane & 7; const u32x4 v = *(const LAS u32x4*)(stg + row * 64 + ch * 8); *(u32x4*)(Ow + (size_t)row * D + ch * 8) = v; }
        }
    }
}
}

__device__ __forceinline__ void conv_item(int item, const bf16* GLU, const float* st, const float* cw, const float* cb, const float* lg, const float* lb, bf16* MIX, LAS unsigned char* lds, int tid) {
    const bool samp = item >= RP / 32; const int b = samp ? item - RP / 32 : item >> 8, t0 = samp ? 0 : (item & 255) * 32, rowbase = samp ? RP + DS * b : b * SEQ;
    const int ch = tid, wid = tid >> 6, lane = tid & 63;
    LAS bf16* xs = (LAS bf16*)lds;
    LAS float* ybuf = (LAS float*)(lds + 65536);
#pragma unroll
    for (int i = 0; i < 8; ++i) { const int k = wid + 8 * i; if (k < 62) { const int tp = t0 - CH + k; pg8::u32x4 v = (pg8::u32x4){0u, 0u, 0u, 0u};
        if (tp >= 0) v = *(const pg8::u32x4*)(GLU + (size_t)(rowbase + tp) * 512 + 8 * lane);
        else if (samp) { const float* sp = st + ((size_t)b * CH + (CH + tp)) * CW + 8 * lane; v = pg8::pack8(*(const f32x4*)sp, *(const f32x4*)(sp + 4)); }
        *(LAS pg8::u32x4*)(xs + k * 512 + 8 * lane) = v; } }
    float w[CONVW];
#pragma unroll
    for (int j = 0; j < CONVW; ++j) w[j] = cw[j * CW + ch];
    const float bias = cb[ch];
    __syncthreads();
#pragma unroll 1
    for (int hb = 0; hb < 2; ++hb) {
        float x[46];
#pragma unroll
        for (int k = 0; k < 46; ++k) x[k] = __uint_as_float((unsigned)xs[(16 * hb + k) * 512 + ch] << 16);
        float y[16];
#pragma unroll
        for (int i = 0; i < 16; ++i) y[i] = bias;
#pragma unroll
        for (int j = 0; j < CONVW; ++j)
#pragma unroll
            for (int i = 0; i < 16; ++i) y[i] += w[j] * x[i + j];
#pragma unroll
        for (int i = 0; i < 16; ++i) ybuf[(16 * hb + i) * 512 + ch] = y[i];
    }
    __syncthreads();
    f32x4 g0 = *(const f32x4*)(lg + 8 * lane), g1 = *(const f32x4*)(lg + 8 * lane + 4), b0 = *(const f32x4*)(lb + 8 * lane), b1 = *(const f32x4*)(lb + 8 * lane + 4);
#pragma unroll
    for (int q = 0; q < 4; ++q) { const int i = 4 * wid + q;
        f32x4 v0 = *(const LAS f32x4*)(ybuf + i * 512 + 8 * lane), v1 = *(const LAS f32x4*)(ybuf + i * 512 + 8 * lane + 4);
        const float mean = wave_sum((v0[0] + v0[1]) + (v0[2] + v0[3]) + (v1[0] + v1[1]) + (v1[2] + v1[3])) * (1.0f / CW);
        v0 = v0 - mean; v1 = v1 - mean;
        const f32x4 q0 = v0 * v0, q1 = v1 * v1;
        const float rstd = rsqrtf(wave_sum((q0[0] + q0[1]) + (q0[2] + q0[3]) + (q1[0] + q1[1]) + (q1[2] + q1[3])) * (1.0f / CW) + EPS);
        v0 = v0 * rstd * g0 + b0; v1 = v1 * rstd * g1 + b1;
#pragma unroll
        for (int e = 0; e < 4; ++e) { v0[e] *= pg8::sigm(v0[e]); v1[e] *= pg8::sigm(v1[e]); }
        *(pg8::u32x4*)(MIX + (size_t)(rowbase + t0 + i) * D + 512 + 8 * lane) = pg8::pack8(v0, v1); }
    __syncthreads();
}


constexpr int SG_LD = 68;
template <class Epi> __device__ __forceinline__ void sgemm64(const bf16* A, const bf16* Bt, int K_, int tile, const Epi& E, LAS unsigned char* lds) {
    int tid_ = threadIdx.x; asm volatile("" : "+v"(tid_)); int K = K_; asm volatile("" : "+s"(K));
    const int lane = tid_ & 63, wave = __builtin_amdgcn_readfirstlane(tid_ >> 6), fr = lane & 15, fq = lane >> 4, kg = wave & 3, nh = wave >> 2, tr = tile >> 4, tc = tile & 15;
    const int Kq = K >> 2;
    const bf16* ap = A + (size_t)(64 * tr + fr) * K + kg * Kq + 8 * fq;
    const bf16* bp = Bt + (size_t)(64 * tc + 32 * nh + fr) * K + kg * Kq + 8 * fq;
    const size_t r16 = (size_t)16 * K;
    f32x4 acc[4][2];
#pragma unroll
    for (int mi = 0; mi < 4; ++mi) { acc[mi][0] = (f32x4){0.f, 0.f, 0.f, 0.f}; acc[mi][1] = acc[mi][0]; }
    bf16x8 a[2][4], p[2][2], an[2][4], pn[2][2];
#pragma unroll
    for (int s = 0; s < 2; ++s) {
#pragma unroll
        for (int mi = 0; mi < 4; ++mi) a[s][mi] = *(const bf16x8*)(ap + mi * r16 + 32 * s);
        p[s][0] = *(const bf16x8*)(bp + 32 * s); p[s][1] = *(const bf16x8*)(bp + r16 + 32 * s); }
    for (int k = 64; k <= Kq; k += 64) {
        const int kn = k < Kq ? k : 0;
#pragma unroll
        for (int s = 0; s < 2; ++s) {
#pragma unroll
            for (int mi = 0; mi < 4; ++mi) an[s][mi] = *(const bf16x8*)(ap + mi * r16 + kn + 32 * s);
            pn[s][0] = *(const bf16x8*)(bp + kn + 32 * s); pn[s][1] = *(const bf16x8*)(bp + r16 + kn + 32 * s); }
#pragma unroll
        for (int s = 0; s < 2; ++s)
#pragma unroll
            for (int mi = 0; mi < 4; ++mi) { acc[mi][0] = __builtin_amdgcn_mfma_f32_16x16x32_bf16(p[s][0], a[s][mi], acc[mi][0], 0, 0, 0); acc[mi][1] = __builtin_amdgcn_mfma_f32_16x16x32_bf16(p[s][1], a[s][mi], acc[mi][1], 0, 0, 0); }
#pragma unroll
        for (int s = 0; s < 2; ++s) {
#pragma unroll
            for (int mi = 0; mi < 4; ++mi) a[s][mi] = an[s][mi];
            p[s][0] = pn[s][0]; p[s][1] = pn[s][1]; }
    }
    LAS float* part = (LAS float*)lds;
#pragma unroll
    for (int mi = 0; mi < 4; ++mi)
#pragma unroll
        for (int ni = 0; ni < 2; ++ni) *(LAS f32x4*)(part + (kg * 64 + 16 * mi + fr) * SG_LD + 32 * nh + 16 * ni + 4 * fq) = acc[mi][ni];
    __syncthreads();
    const int row = tid_ >> 3, c8 = (tid_ & 7) * 8;
    f32x4 v0 = *(const LAS f32x4*)(part + row * SG_LD + c8), v1 = *(const LAS f32x4*)(part + row * SG_LD + c8 + 4);
#pragma unroll
    for (int g = 1; g < 4; ++g) { v0 = v0 + *(const LAS f32x4*)(part + (g * 64 + row) * SG_LD + c8); v1 = v1 + *(const LAS f32x4*)(part + (g * 64 + row) * SG_LD + c8 + 4); }
    E(64 * tr + row, 64 * tc + c8, tc, tid_ & 7, v0, v1);
    __syncthreads();
}
__device__ __forceinline__ float oct_sum(float s) { s += __shfl_xor(s, 1); s += __shfl_xor(s, 2); s += __shfl_xor(s, 4); return s; }
template <bool BF> struct SEpiRes {
    const float* base; bf16* HB; float* SS;
    __device__ __forceinline__ void operator()(int row, int col, int tc, int l8, f32x4 v0, f32x4 v1) const {
        const size_t o = (size_t)row * D + col;
        if (BF) { const pg8::u32x4 w = *(const pg8::u32x4*)(HB + o); v0 = v0 + pg8::bf_lo4(w); v1 = v1 + pg8::bf_hi4(w); }
        else { v0 = v0 + *(const f32x4*)(base + o); v1 = v1 + *(const f32x4*)(base + o + 4); }
        *(pg8::u32x4*)(HB + o) = pg8::pack8(v0, v1);
        const f32x4 q0 = v0 * v0, q1 = v1 * v1;
        const float ss = oct_sum(((q0[0] + q0[1]) + (q0[2] + q0[3])) + ((q1[0] + q1[1]) + (q1[2] + q1[3])));
        if (l8 == 0) SS[(size_t)row * 16 + tc] = ss;
    }
};
struct SEpiFinal {
    const float* SS; const bf16* PP; const bf16* HB; float* Y;
    __device__ __forceinline__ void operator()(int row, int col, int tc, int l8, f32x4 v0, f32x4 v1) const {
        const float r = rsqrtf(oct_sum(SS[(size_t)row * 16 + 2 * l8] + SS[(size_t)row * 16 + 2 * l8 + 1]) * (1.0f / D) + EPS);
        const size_t o = (size_t)row * D + col;
        const pg8::u32x4 pw = *(const pg8::u32x4*)(PP + o), hw = *(const pg8::u32x4*)(HB + o);
        const f32x4 p0 = pg8::bf_lo4(pw), p1 = pg8::bf_hi4(pw); f32x4 h0 = pg8::bf_lo4(hw), h1 = pg8::bf_hi4(hw);
#pragma unroll
        for (int e = 0; e < 4; ++e) { h0[e] += pg8::sigm(v0[e] * r) * p0[e]; h1[e] += pg8::sigm(v1[e] * r) * p1[e]; }
        *(f32x4*)(Y + o) = h0; *(f32x4*)(Y + o + 4) = h1;
    }
};

#ifndef REP_P0
#define REP_P0 1
#endif
#ifndef REP_P1
#define REP_P1 1
#endif
#ifndef REP_P2
#define REP_P2 1
#endif
#ifndef REP_P3
#define REP_P3 1
#endif
#ifndef REP_P4
#define REP_P4 1
#endif
struct Args { const float* in[23]; float* out; unsigned char* ws; };
constexpr int N_ATT_S = 2 * DB, N_ATT_P = NB * 64 * 2, N_CONV = R / 32;
constexpr int I_WO = (D / 64) * (D / 32), I_WGU = (D / 64) * (2 * DFF / 32), N_WCV = (I_WO + I_WGU) / 8;
constexpr int N_ATT_Q = 8 + 64;
static_assert((I_WO + I_WGU) % 8 == 0, "weight conversion entries");
#define W1t ((bf16*)(ws + WS_W1))
#define WOt ((bf16*)(ws + WS_WO))
#define WGUt ((bf16*)(ws + WS_WGU))
#define WDt ((bf16*)(ws + WS_WD))
#define WPGt ((bf16*)(ws + WS_WPG))
#define WPPt ((bf16*)(ws + WS_WPP))
#define RX ((float*)(ws + WS_RX))
#define SS1 ((float*)(ws + WS_SS1))
#define SS2 ((float*)(ws + WS_SS2))
#define XB ((bf16*)(ws + WS_XB))
#define PB ((bf16*)(ws + WS_PB))
#define PPb ((bf16*)(ws + WS_PP))
#define Qb ((bf16*)(ws + WS_Q))
#define KVP (ws + WS_KP)
#define KVS (ws + WS_KS)
#define GLUb ((bf16*)(ws + WS_GLU))
#define MIXb ((bf16*)(ws + WS_MIX))
#define ACTb ((bf16*)(ws + WS_ACT))
#define Y (out + OY)
__global__ void __launch_bounds__(NWAVES * 64, 2) mk_fwd(Args args) {
    extern __shared__ __attribute__((aligned(16))) unsigned char lds_[];
    LAS unsigned char* lds = (LAS unsigned char*)lds_;
    volatile LAS unsigned* MISC = (volatile LAS unsigned*)(lds + MISC_OFF);
    const int G = gridDim.x, vcu = (G % 8 == 0) ? ((int)blockIdx.x % 8) * (G / 8) + (int)blockIdx.x / 8 : (int)blockIdx.x;
    unsigned char* ws = args.ws; float* out = args.out;
    gu32* ctl = (gu32*)(ws + WS_CTL);
    for (int u = threadIdx.x; u < (ATT_TAB - LDSCTL_OFF) / 4; u += NWAVES * 64) ((LAS unsigned*)(lds + LDSCTL_OFF))[u] = 0u;
    __syncthreads();
    XcdBarrier bar = xcd_barrier_post((unsigned*)(ctl + CW_BAR), MISC + 8);

#ifndef SKIP_P0
    for (int rep = 0; rep < REP_P0; ++rep) {
        if (rep) xcd_barrier(bar);
        int tid0 = threadIdx.x; asm volatile("" : "+v"(tid0));
        const int lane = tid0 & 63, wave = __builtin_amdgcn_readfirstlane(tid0 >> 6);
        LAS float* scr = (LAS float*)(lds + RING_OFF + wave * 16384);
        const int gw = vcu * NWAVES + wave, NGW = G * NWAVES;
        constexpr int I_1 = (D / 64) * (INC / 32), I_PP = (PLE / 64) * (D / 32);
        constexpr int NITEMS = I_1 + I_PP;
        for (int it = gw; it < NITEMS; it += NGW) {
            if (it < I_1) p0_transpose_item<1>(args.in[8], args.in[7], D, INC, W1t, scr, it, lane);
            else p0_transpose_item<0>(args.in[22], nullptr, PLE, D, WPPt, scr, it - I_1, lane);
        }
        for (int m2 = gw; m2 < R / 2; m2 += NGW) {
            f32x4 v[2][4];
#pragma unroll
            for (int rr = 0; rr < 2; ++rr) { const int m = 2 * m2 + rr; const float* xrow = m < RP ? args.in[0] + (size_t)m * D : args.in[1] + (size_t)(m - RP) * D;
                const GAS f32x4* xr = (const GAS f32x4*)xrow + lane;
#pragma unroll
                for (int j = 0; j < 4; ++j) v[rr][j] = xr[64 * j]; }
#pragma unroll
            for (int rr = 0; rr < 2; ++rr) { const int m = 2 * m2 + rr; float s = 0.f;
#pragma unroll
                for (int j = 0; j < 4; ++j) s += (v[rr][j].x * v[rr][j].x + v[rr][j].y * v[rr][j].y) + (v[rr][j].z * v[rr][j].z + v[rr][j].w * v[rr][j].w);
                s = wave_sum(s); if (lane == 0) RX[m] = rsqrtf(s * (1.0f / D) + EPS);
                GAS unsigned long long* o8 = (GAS unsigned long long*)(XB + (size_t)m * D) + lane;
#pragma unroll
                for (int j = 0; j < 4; ++j) o8[64 * j] = (unsigned long long)pk2(v[rr][j].x, v[rr][j].y) | ((unsigned long long)pk2(v[rr][j].z, v[rr][j].w) << 32); }
        }
        for (int m8 = gw; m8 < R / 8; m8 += NGW) {
            const int m = 8 * m8; const float* prow = m < RP ? args.in[2] + (size_t)m * PLE : args.in[3] + (size_t)(m - RP) * PLE;
            const GAS f32x4* pr = (const GAS f32x4*)prow + lane; f32x4 pv[8];
#pragma unroll
            for (int j = 0; j < 8; ++j) pv[j] = pr[64 * j];
            GAS unsigned long long* o8 = (GAS unsigned long long*)(PB + (size_t)m * PLE) + lane;
#pragma unroll
            for (int j = 0; j < 8; ++j) o8[64 * j] = (unsigned long long)pk2(pv[j].x, pv[j].y) | ((unsigned long long)pk2(pv[j].z, pv[j].w) << 32);
        }
    }
#endif
    xcd_barrier(bar);

#ifndef SKIP_P1
    for (int rep = 0; rep < REP_P1; ++rep) {
        if (rep) xcd_barrier(bar);
        pg8::Gemm g{XB, W1t, R, INC, D}; pg8::StaticOrder S; S.init(R, INC, G, (int)blockIdx.x);
        pg8::Epi1 E{RX, args.in[9], args.in[10], Qb, KVP, KVS, GLUb, out};
        pg8::Gemm g2{PB, WPPt, R, D, PLE}; pg8::StaticOrder S2; S2.init(R, D, G, (int)blockIdx.x);
        pg8::EpiPP E2{PPb};
        const bool ppfirst = ((int)blockIdx.x >> 3) & 1;
        if (ppfirst) pg8::gemm_phase<pg8::EpiPP, pg8::StaticOrder, true, true>(lds + RING_OFF, g2, S2, E2);
        pg8::gemm_phase<pg8::Epi1, pg8::StaticOrder, true, true>(lds + RING_OFF, g, S, E);
        if (!ppfirst) pg8::gemm_phase<pg8::EpiPP, pg8::StaticOrder, true, true>(lds + RING_OFF, g2, S2, E2);
        { const int c0 = ((R / 256) * (INC / 256)) % G, nwgc = c0 ? G - c0 : G, cc = c0 ? (int)blockIdx.x - c0 : (int)blockIdx.x;
          if (cc >= 0) {
            int tidc = threadIdx.x; asm volatile("" : "+v"(tidc));
            const int lane = tidc & 63, wave = __builtin_amdgcn_readfirstlane(tidc >> 6), head = lane >> 3, dq = lane & 7;
            for (int m2 = cc * NWAVES + wave; m2 < DB * 512; m2 += nwgc * NWAVES) {
                const int b = m2 >> 9, j = m2 & 511, kv = j & 63;
                const GAS f32x4* sk = (const GAS f32x4*)(args.in[4] + (size_t)m2 * 512) + 2 * lane; const GAS f32x4* sv = (const GAS f32x4*)(args.in[5] + (size_t)m2 * 512) + 2 * lane;
                const f32x4 k0 = sk[0], k1 = sk[1], v0 = sv[0], v1 = sv[1];
                unsigned char* tb = KVS + (size_t)(b * 9 + (j >> 6)) * KVT_BYTES + (head >> 2) * 65536 + (head & 3) * 16384;
                *(GAS v4u*)(tb + dq * 1024 + kv * 16) = (v4u){pk2(k0.x, k0.y), pk2(k0.z, k0.w), pk2(k1.x, k1.y), pk2(k1.z, k1.w)};
                *(GAS v4u*)(tb + 8192 + (dq >> 2) * 4096 + (kv >> 4) * 1024 + (kv & 15) * 64 + (dq & 3) * 16) = (v4u){pk2(v0.x, v0.y), pk2(v0.z, v0.w), pk2(v1.x, v1.y), pk2(v1.z, v1.w)};
            }
            for (int p = cc * NWAVES + wave; p < DB * NH; p += nwgc * NWAVES) {
                unsigned char* tb = KVS + (size_t)((p >> 3) * 9 + 8) * KVT_BYTES + ((p & 7) >> 2) * 65536 + (p & 3) * 16384; const v4u z = (v4u){0u, 0u, 0u, 0u};
#pragma unroll
                for (int c2 = 0; c2 < 4; ++c2) *(GAS v4u*)(tb + (2 * c2 + (lane >> 5)) * 1024 + 512 + (lane & 31) * 16) = z;
#pragma unroll
                for (int q = 0; q < 4; ++q) *(GAS v4u*)(tb + 8192 + (q >> 1) * 4096 + (2 + (q & 1)) * 1024 + lane * 16) = z;
            }
          } }
    }
#endif
    xcd_barrier(bar);

#ifndef SKIP_P2
    for (int rep = 0; rep < REP_P2; ++rep) {
        if (rep) xcd_barrier(bar);
        { int tidt = threadIdx.x; asm volatile("" : "+v"(tidt)); const int lane = tidt & 63, wave = __builtin_amdgcn_readfirstlane(tidt >> 6);
          const float* relb = args.in[11] + wave * NREL; LAS float* T = (LAS float*)(lds + ATT_TAB) + wave * 256;
          const float bfar = relb[256];
          for (int x = lane; x < 256; x += 64) { int dd = 191 - x; dd = dd < -128 ? -128 : (dd > 128 ? 128 : dd); T[x] = (relb[dd + 128] - bfar) * LOG2E; } }
        __syncthreads();
        {
            int tid2 = threadIdx.x; asm volatile("" : "+v"(tid2));
            const int lane2 = tid2 & 63, wave2 = __builtin_amdgcn_readfirstlane(tid2 >> 6);
            int qk = 0, q = (int)blockIdx.x & 7;
#define ATT_POP(qq) ((int)__hip_atomic_fetch_add((unsigned*)(ctl + CW_Q + 64 * ((qq) + 8 * rep)), 1u, __ATOMIC_RELAXED, __HIP_MEMORY_SCOPE_AGENT))
#define ATT_DECODE(code, U) do { const int q_ = (int)((code) >> 8), i_ = (int)((code) & 255u); \
                if (i_ < 8) { const int sb = 4 * q_ + (i_ >> 1); U.hg = i_ & 1; U.sample = 1; U.nt = 9; U.c0rel = 8; \
                    U.Qrow = Qb + (size_t)(RP + DS * sb) * 512; U.KV = KVS + (size_t)(sb * 9) * KVT_BYTES; U.Orow = MIXb + (size_t)(RP + DS * sb) * D; } \
                else { const int j = i_ - 8, pi = j < 60 ? 4 + j : 63 - j, bb = q_ >> 1, c0 = 2 * pi;     \
                    U.hg = q_ & 1; U.sample = 0; U.c0rel = c0 < 8 ? c0 : 8; U.nt = U.c0rel + 2; const size_t row0 = (size_t)bb * SEQ + 64 * c0; \
                    U.Qrow = Qb + row0 * 512; U.KV = KVP + (size_t)(bb * 128 + c0 - U.c0rel) * KVT_BYTES; U.Orow = MIXb + row0 * D; } } while (0)
            if (tid2 == 0) { int i = ATT_POP(q); while (i >= N_ATT_Q) { if (++qk == 8) { i = -1; break; } q = ((int)blockIdx.x + qk) & 7; i = ATT_POP(q); }
                MISC[4] = i < 0 ? 0xffffffffu : (unsigned)((q << 8) | i); }
            __syncthreads();
            unsigned code = MISC[4];
            if (code != 0xffffffffu) {
                att::AUnit U; ATT_DECODE(code, U);
                att::bf16x8 qr[2][4];
                att::attn_prefetch(U, lds, wave2, lane2, qr);
                for (;;) {
                    int nraw = 0; if (tid2 == 0) nraw = ATT_POP(q);
#pragma unroll
                    for (int d0 = 0; d0 < 4; ++d0) asm volatile("" : "+v"(qr[0][d0]), "+v"(qr[1][d0]));
                    att::f32x16 o[2][2]; o[0][0] = att::f32x16{}; o[0][1] = att::f32x16{}; o[1][0] = att::f32x16{}; o[1][1] = att::f32x16{}; float lsum[2] = {0.f, 0.f};
                    if (U.sample) att::attn_steps<false>(U, lds, wave2, lane2, qr, o, lsum); else att::attn_steps<true>(U, lds, wave2, lane2, qr, o, lsum);
                    if (tid2 == 0) { int i = nraw; while (i >= N_ATT_Q) { if (++qk == 8) { i = -1; break; } q = ((int)blockIdx.x + qk) & 7; i = ATT_POP(q); }
                        MISC[4] = i < 0 ? 0xffffffffu : (unsigned)((q << 8) | i); }
                    ATT_WAIT_BAR();
                    const unsigned ncode = MISC[4];
                    att::AUnit Un = U;
                    if (ncode != 0xffffffffu) { ATT_DECODE(ncode, Un); att::attn_prefetch(Un, lds, wave2, lane2, qr); }
                    if (U.sample) att::attn_store<false>(U, lds, wave2, lane2, o, lsum); else att::attn_store<true>(U, lds, wave2, lane2, o, lsum);
                    if (ncode == 0xffffffffu) break;
                    U = Un;
                }
                ATT_WAIT_BAR();
            }
#undef ATT_POP
#undef ATT_DECODE
        }
        for (;;) {
            int tid2 = threadIdx.x; asm volatile("" : "+v"(tid2));
            if (tid2 == 0) MISC[4] = __hip_atomic_fetch_add((unsigned*)(ctl + CW_QG + 64 * rep), 1u, __ATOMIC_RELAXED, __HIP_MEMORY_SCOPE_AGENT);
            __syncthreads();
            const int idx = (int)MISC[4];
            __syncthreads();
            if (idx >= N_CONV + N_WCV) break;
            const int lane2 = tid2 & 63, wave2 = __builtin_amdgcn_readfirstlane(tid2 >> 6);
            if (idx < N_CONV) conv_item(idx, GLUb, args.in[6], args.in[12], args.in[13], args.in[14], args.in[15], MIXb, lds, tid2);
            else { const int it = 8 * (idx - N_CONV) + wave2; LAS float* scr = (LAS float*)(lds + RING_OFF + wave2 * 16384);
                if (it < I_WO) p0_transpose_item<0>(args.in[16], nullptr, D, D, WOt, scr, it, lane2);
                else p0_transpose_item<2>(args.in[18], args.in[17], D, 2 * DFF, WGUt, scr, it - I_WO, lane2);
                __syncthreads(); }
        }
    }
#endif
    xcd_barrier(bar);

#ifndef SKIP_P3
    for (int rep = 0; rep < REP_P3; ++rep) {
        if (rep) xcd_barrier(bar);
        pg8::Gemm g{MIXb, WOt, RP, D, D}; pg8::StaticOrder S; S.init(RP, D, G, (int)blockIdx.x);
        pg8::EpiRes<false> E{args.in[0], args.in[1], XB, SS1};
        const SEpiRes<false> SE{args.in[1], XB + (size_t)RP * D, SS1 + (size_t)RP * 16};
        if (blockIdx.x & 1) for (int t = (int)blockIdx.x; t < 256; t += G) sgemm64(MIXb + (size_t)RP * D, WOt, D, t, SE, lds + RING_OFF);
        pg8::gemm_phase<pg8::EpiRes<false>, pg8::StaticOrder, true, true>(lds + RING_OFF, g, S, E);
        if (!(blockIdx.x & 1)) for (int t = (int)blockIdx.x; t < 256; t += G) sgemm64(MIXb + (size_t)RP * D, WOt, D, t, SE, lds + RING_OFF);
    }
#endif
    xcd_barrier(bar);

#ifndef SKIP_P4
    for (int rep = 0; rep < REP_P4; ++rep) {
        if (rep) xcd_barrier(bar);
        { const int c0 = ((R / 256) * (2 * DFF / 256)) % G, nwgc = c0 ? G - c0 : G, cc = c0 ? (int)blockIdx.x - c0 : (int)blockIdx.x;
          if (cc >= 0) {
            const bool wt = (nwgc % 4) == 0; const int k = wt ? cc & 3 : 1, j = wt ? cc >> 2 : cc, per = wt ? nwgc / 4 : nwgc, nslot = wt ? 6 * per : per;
            const int s0 = !wt ? j : (k == 1 ? j : (k == 2 ? per + 2 * j : 3 * per + 3 * j));
            int tidc = threadIdx.x; asm volatile("" : "+v"(tidc));
            const int lane = tidc & 63, wave = __builtin_amdgcn_readfirstlane(tidc >> 6);
            for (int q = 0; q < k; ++q)
            for (int m4 = s0 + q + nslot * wave; m4 < 2 * DB * 120; m4 += nslot * NWAVES) {
                const int kv = m4 >= DB * 120, mm = kv ? m4 - DB * 120 : m4, b = mm / 120, j2 = DS + 4 * (mm % 120);
                const GAS f32x4* src = (const GAS f32x4*)(args.in[4 + kv] + ((size_t)b * 512 + j2) * 512) + lane;
                GAS f32x4* dst = (GAS f32x4*)(out + (kv ? OVS : OKS) + ((size_t)b * 512 + (j2 - DS)) * 512) + lane;
                f32x4 v[8];
#pragma unroll
                for (int i = 0; i < 8; ++i) v[i] = src[64 * i];
#pragma unroll
                for (int i = 0; i < 8; ++i) dst[64 * i] = v[i];
            }
            { LAS float* scr = (LAS float*)(lds + RING_OFF + wave * 16384); constexpr int I_D = (DFF / 64) * (D / 32), I_PG = (D / 64) * (D / 32);
              for (int it = cc * NWAVES + wave; it < I_D + I_PG; it += nwgc * NWAVES) {
                  if (it < I_D) p0_transpose_item<0>(args.in[19], nullptr, DFF, D, WDt, scr, it, lane);
                  else p0_transpose_item<0>(args.in[21], args.in[20], D, D, WPGt, scr, it - I_D, lane); }
              __syncthreads(); }
          } }
        pg8::Gemm g{XB, WGUt, R, 2 * DFF, D}; pg8::StaticOrder S; S.init(R, 2 * DFF, G, (int)blockIdx.x);
        pg8::EpiAct E{SS1, ACTb};
        pg8::gemm_phase<pg8::EpiAct, pg8::StaticOrder, true, true>(lds + RING_OFF, g, S, E);
    }
#endif
    xcd_barrier(bar);

#ifndef SKIP_P5
    {
        pg8::Gemm g{ACTb, WDt, RP, D, DFF}; pg8::StaticOrder S; S.init(RP, D, G, (int)blockIdx.x);
        pg8::EpiRes<true> E{nullptr, nullptr, XB, SS2};
        const SEpiRes<true> SE{nullptr, XB + (size_t)RP * D, SS2 + (size_t)RP * 16};
        if (blockIdx.x & 1) for (int t = (int)blockIdx.x; t < 256; t += G) sgemm64(ACTb + (size_t)RP * DFF, WDt, DFF, t, SE, lds + RING_OFF);
        pg8::gemm_phase<pg8::EpiRes<true>, pg8::StaticOrder, true, true>(lds + RING_OFF, g, S, E);
        if (!(blockIdx.x & 1)) for (int t = (int)blockIdx.x; t < 256; t += G) sgemm64(ACTb + (size_t)RP * DFF, WDt, DFF, t, SE, lds + RING_OFF);
    }
#endif
    xcd_barrier(bar);

#ifndef SKIP_P6
    {
        pg8::Gemm g{XB, WPGt, RP, D, D}; pg8::StaticOrder S; S.init(RP, D, G, (int)blockIdx.x);
        pg8::EpiFinal E{SS2, PPb, XB, Y};
        const SEpiFinal SE{SS2 + (size_t)RP * 16, PPb + (size_t)RP * D, XB + (size_t)RP * D, Y + (size_t)RP * D};
        if (blockIdx.x & 1) for (int t = (int)blockIdx.x; t < 256; t += G) sgemm64(XB + (size_t)RP * D, WPGt, D, t, SE, lds + RING_OFF);
        pg8::gemm_phase<pg8::EpiFinal, pg8::StaticOrder, true, true>(lds + RING_OFF, g, S, E);
        if (!(blockIdx.x & 1)) for (int t = (int)blockIdx.x; t < 256; t += G) sgemm64(XB + (size_t)RP * D, WPGt, D, t, SE, lds + RING_OFF);
    }
#endif
}

extern "C" void kernel_launch(void* const* d_in, const int* in_sizes, int n_in, void* d_out, int out_size, void* d_ws, size_t ws_size, hipStream_t stream) {
    static int grid = 0;
    if (grid == 0) {
        if (n_in != 23 || ws_size < WS_END) { fprintf(stderr, "kernel_launch: unexpected shapes (n_in %d, ws %zu)\n", n_in, ws_size); grid = -1; return; }
        int dev = 0, cus = 0, per_cu = 0;
        if (hipGetDevice(&dev) != hipSuccess || hipDeviceGetAttribute(&cus, hipDeviceAttributeMultiprocessorCount, dev) != hipSuccess) { grid = -1; return; }
        if (hipFuncSetAttribute((const void*)mk_fwd, hipFuncAttributeMaxDynamicSharedMemorySize, LDS_BYTES) != hipSuccess) { fprintf(stderr, "kernel_launch: hipFuncSetAttribute failed\n"); grid = -1; return; }
        if (hipOccupancyMaxActiveBlocksPerMultiprocessor(&per_cu, (const void*)mk_fwd, NWAVES * 64, LDS_BYTES) != hipSuccess || per_cu < 1) { fprintf(stderr, "kernel_launch: occupancy query says %d blocks per CU\n", per_cu); }
        (void)hipGetLastError();
        grid = cus;
    }
    if (grid < 0) return;
    if (hipMemsetAsync((char*)d_ws + WS_CTL, 0, CTL_ZERO_BYTES, stream) != hipSuccess) return;
    Args a{};
    for (int i = 0; i < 23; ++i) a.in[i] = (const float*)d_in[i];
    a.out = (float*)d_out; a.ws = (unsigned char*)d_ws;
    hipLaunchKernelGGL(mk_fwd, dim3(grid), dim3(NWAVES * 64), LDS_BYTES, stream, a);
}
```

```cpp
#include <hip/hip_runtime.h>
#include <cstdio>
#include <cstdint>
constexpr int D = 1024, SEQ = 8192, NB = 4, DB = 32, DS = 32;
constexpr int RP = NB * SEQ, RS = DB * DS, R = RP + RS;
constexpr int INC = 2560, DFF = 2816, PLE = 256, NH = 8, HD = 64, CW = 512;
constexpr int NREL = 257, CONVW = 31, CH = 30, KSROWS = 576;
constexpr int KVT_BYTES = 131072;
constexpr float EPS = 1e-6f, LOG2E = 1.4426950408889634f, QSCALE = 0.125f * LOG2E;
constexpr size_t OY = 0, OKP = (size_t)R * D, OVP = OKP + (size_t)NB * 512 * 512, OCP = OVP + (size_t)NB * 512 * 512,
                 OKS = OCP + (size_t)NB * CH * CW, OVS = OKS + (size_t)DB * 512 * 512, OCS = OVS + (size_t)DB * 512 * 512;
namespace pg8 {
#define PG8_LAS __attribute__((address_space(3)))
typedef unsigned short bf16_t;
typedef short bf16x8 __attribute__((ext_vector_type(8)));
typedef float f32x4 __attribute__((ext_vector_type(4)));
typedef unsigned u32x4 __attribute__((ext_vector_type(4)));
constexpr int BM = 256, BK = 64, HALF = 128, HTB = HALF * BK * 2  , STAGE_BYTES = 8 * HTB, NXCD = 8, WGM = 8;

__host__ __device__ __forceinline__ int lds_byte(int r, int c) { const int st = (r >> 4) * 2 + (c >> 5), rr = r & 15, cc = c & 31, ob = rr * 64 + cc * 2; return st * 1024 + (ob ^ (((ob >> 9) & 1) << 5)); }
__host__ __device__ __forceinline__ void stage_rc(int b, int& R, int& C) { const int st = b / 1024, sb = b % 1024, swz = sb ^ (((sb >> 9) & 1) << 5); R = (st >> 1) * 16 + swz / 64; C = (st & 1) * 32 + (swz % 64) / 2; }
__host__ __device__ __forceinline__ int perm32(int rho) { const int n = rho >> 4, i = rho & 15; return 8 * (i >> 2) + 4 * n + (i & 3); }

struct Unit { int pm, pn; };
struct Gemm { const bf16_t* A; const bf16_t* Bt; int M, N, K; };

struct StaticOrder {
    int nM, nN, nwg, G, c;
    __host__ __device__ void init(int M, int N, int G_, int c_) { nM = M / BM; nN = N / BM; nwg = nM * nN; G = G_; c = c_; }
    __host__ __device__ bool next(int i, Unit& u) const {
        const long L = (long)i * G + c; if (L >= nwg) return false;
        int wgid = (int)L; { const int q = nwg / NXCD, r = nwg % NXCD, xcd = wgid % NXCD, off = wgid / NXCD; wgid = (xcd < r ? xcd * (q + 1) : r * (q + 1) + (xcd - r) * q) + off; }
        const int nig = WGM * nN, gid = wgid / nig, fm = gid * WGM, gsz = (nM - fm) < WGM ? (nM - fm) : WGM;
        u.pm = fm + ((wgid % nig) % gsz); u.pn = (wgid % nig) / gsz; return true;
    }
    __device__ __forceinline__ void a_ready(const Unit&) const {}
    __device__ __forceinline__ void done(const Unit&) const {}
};

__device__ __forceinline__ unsigned cvt_pk_bf16(float lo, float hi) { unsigned r; asm volatile("v_cvt_pk_bf16_f32 %0, %1, %2" : "=v"(r) : "v"(lo), "v"(hi)); return r; }
typedef float f32x2 __attribute__((ext_vector_type(2)));typedef unsigned u32x2 __attribute__((ext_vector_type(2)));
__device__ __forceinline__ u32x4 pack8(const f32x4 a, const f32x4 b) { u32x4 w; w.x = cvt_pk_bf16(a[0], a[1]); w.y = cvt_pk_bf16(a[2], a[3]); w.z = cvt_pk_bf16(b[0], b[1]); w.w = cvt_pk_bf16(b[2], b[3]); return w; }
__device__ __forceinline__ float sigm(float x) { return __builtin_amdgcn_rcpf(1.0f + __builtin_amdgcn_exp2f(-x * LOG2E)); }
__device__ __forceinline__ float quad_sum(float s) { s += __shfl_xor(s, 16); s += __shfl_xor(s, 32); return s; }
struct Epi1 {
    static constexpr bool PERM = true, AFTER_DRAIN = false;
    const float* rx; const float* qg; const float* kg; bf16_t* Q; unsigned char* KVP; unsigned char* KVS; bf16_t* GLU; float* out;
    __device__ __forceinline__ void operator()(const f32x4 (&acc)[2][2][4][2], const Unit& u, int wr, int wc, int fr, int fq) const {
        const int pn = u.pn, rowt = u.pm * BM + wr * 64 + fr;
        float rxv[2][4];
#pragma unroll
        for (int ai = 0; ai < 2; ++ai)
#pragma unroll
            for (int m = 0; m < 4; ++m) rxv[ai][m] = rx[rowt + ai * HALF + m * 16];
        if (pn < 6) {
            const int sec = pn >> 1, col = (4 * (pn & 1) + wc) * 64 + 8 * fq;
            f32x4 g[2][2];
#pragma unroll
            for (int bj = 0; bj < 2; ++bj)
#pragma unroll
                for (int n = 0; n < 2; ++n) { g[bj][n] = (f32x4){1.f, 1.f, 1.f, 1.f};
                    if (sec == 0) g[bj][n] = *(const f32x4*)(qg + 32 * bj + 8 * fq + 4 * n) * QSCALE;
                    if (sec == 1) g[bj][n] = *(const f32x4*)(kg + 32 * bj + 8 * fq + 4 * n); }
#pragma unroll
            for (int ai = 0; ai < 2; ++ai)
#pragma unroll
                for (int m = 0; m < 4; ++m) {
                    const int row = rowt + ai * HALF + m * 16; const float r = rxv[ai][m];
                    f32x4 z[2][2];
#pragma unroll
                    for (int bj = 0; bj < 2; ++bj)
#pragma unroll
                        for (int n = 0; n < 2; ++n) z[bj][n] = acc[ai][bj][m][n] * r;
                    if (sec < 2) {
                        float ss = 0.f;
#pragma unroll
                        for (int bj = 0; bj < 2; ++bj)
#pragma unroll
                            for (int n = 0; n < 2; ++n) { const f32x4 q = z[bj][n] * z[bj][n]; ss += (q[0] + q[1]) + (q[2] + q[3]); }
                        ss = quad_sum(ss);
                        const float rn = rsqrtf(ss * (1.0f / 64.0f) + EPS);
#pragma unroll
                        for (int bj = 0; bj < 2; ++bj)
#pragma unroll
                            for (int n = 0; n < 2; ++n) z[bj][n] = z[bj][n] * rn * g[bj][n];
                    }
                    const int sb = (row - RP) >> 5, si = (row - RP) & 31;
                    float* fo = nullptr;
                    if (sec == 0) {
#pragma unroll
                        for (int bj = 0; bj < 2; ++bj) *(u32x4*)(Q + (size_t)row * 512 + col + 32 * bj) = pack8(z[bj][0], z[bj][1]);
                    } else {
                        unsigned char* tb; int kv;
                        if (row < RP) { tb = KVP + (size_t)(row >> 6) * KVT_BYTES; kv = row & 63;
                            const int t = row & (SEQ - 1); if (t >= SEQ - 512) fo = out + OKP + (size_t)(sec - 1) * (OVP - OKP) + ((size_t)((row >> 13) * 512 + (t - (SEQ - 512)))) * 512 + col; }
                        else { tb = KVS + (size_t)(sb * 9 + 8) * KVT_BYTES; kv = si; fo = out + OKS + (size_t)(sec - 1) * (OVS - OKS) + ((size_t)(sb * 512 + 480 + si)) * 512 + col; }
                        tb += (pn & 1) * 65536 + wc * 16384;
                        const int ok = fq * 1024 + kv * 16, ov = 8192 + (kv >> 4) * 1024 + (kv & 15) * 64 + fq * 16;
#pragma unroll
                        for (int bj = 0; bj < 2; ++bj) *(u32x4*)(tb + (sec == 1 ? ok + bj * 4096 : ov + bj * 4096)) = pack8(z[bj][0], z[bj][1]);
                    }
                    if (fo) {
#pragma unroll
                        for (int bj = 0; bj < 2; ++bj)
#pragma unroll
                            for (int n = 0; n < 2; ++n) *(f32x4*)(fo + 32 * bj + 4 * n) = z[bj][n]; }
                }
        } else {
            const int col = 128 * (pn - 6) + 32 * wc + 8 * fq;
#pragma unroll
            for (int ai = 0; ai < 2; ++ai)
#pragma unroll
                for (int m = 0; m < 4; ++m) {
                    const int row = rowt + ai * HALF + m * 16; const float r = rxv[ai][m];
                    f32x4 gl[2];
#pragma unroll
                    for (int n = 0; n < 2; ++n) { const f32x4 a = acc[ai][0][m][n] * r, b = acc[ai][1][m][n] * r;
#pragma unroll
                        for (int e = 0; e < 4; ++e) gl[n][e] = a[e] * sigm(b[e]); }
                    *(u32x4*)(GLU + (size_t)row * 512 + col) = pack8(gl[0], gl[1]);
                    float* fo = nullptr;
                    if (row < RP) { const int t = row & (SEQ - 1); if (t >= SEQ - CH) fo = out + OCP + ((size_t)((row >> 13) * CH + (t - (SEQ - CH)))) * CW + col; }
                    else { const int sb = (row - RP) >> 5, si = (row - RP) & 31; if (si >= DS - CH) fo = out + OCS + ((size_t)(sb * CH + (si - (DS - CH)))) * CW + col; }
                    if (fo) { *(f32x4*)(fo) = gl[0]; *(f32x4*)(fo + 4) = gl[1]; }
                }
        }
    }
};
struct EpiPP {
    static constexpr bool PERM = true, AFTER_DRAIN = false;
    bf16_t* O;
    __device__ __forceinline__ void operator()(const f32x4 (&acc)[2][2][4][2], const Unit& u, int wr, int wc, int fr, int fq) const {
        const int rowt = u.pm * BM + wr * 64 + fr, col = u.pn * BM + 32 * wc + 8 * fq;
#pragma unroll
        for (int ai = 0; ai < 2; ++ai)
#pragma unroll
            for (int m = 0; m < 4; ++m) { bf16_t* rowp = O + (size_t)(rowt + ai * HALF + m * 16) * D + col;
#pragma unroll
                for (int bj = 0; bj < 2; ++bj) *(u32x4*)(rowp + bj * HALF) = pack8(acc[ai][bj][m][0], acc[ai][bj][m][1]); }
    }
};
__device__ __forceinline__ f32x4 bf_lo4(const u32x4 w) { return (f32x4){__uint_as_float(w.x << 16), __uint_as_float(w.x & 0xffff0000u), __uint_as_float(w.y << 16), __uint_as_float(w.y & 0xffff0000u)}; }
__device__ __forceinline__ f32x4 bf_hi4(const u32x4 w) { return (f32x4){__uint_as_float(w.z << 16), __uint_as_float(w.z & 0xffff0000u), __uint_as_float(w.w << 16), __uint_as_float(w.w & 0xffff0000u)}; }
template <bool BF> struct EpiRes {
    static constexpr bool PERM = true, AFTER_DRAIN = false;
    const float* bp; const float* bs; bf16_t* HB; float* SS;
    __device__ __forceinline__ void operator()(const f32x4 (&acc)[2][2][4][2], const Unit& u, int wr, int wc, int fr, int fq) const {
        const int rowt = u.pm * BM + wr * 64 + fr, col = u.pn * BM + 32 * wc + 8 * fq;
        f32x4 bv[2][2][2];
        auto ldbase = [&](int i, f32x4 (&d)[2][2]) {
            const int row = rowt + (i >> 2) * HALF + (i & 3) * 16;
            if (BF) { const bf16_t* hrow = HB + (size_t)row * D + col;
#pragma unroll
                for (int bj = 0; bj < 2; ++bj) { const u32x4 w = *(const u32x4*)(hrow + bj * HALF); d[bj][0] = bf_lo4(w); d[bj][1] = bf_hi4(w); } }
            else { const float* brow = (row < RP ? bp + (size_t)row * D : bs + (size_t)(row - RP) * D) + col;
#pragma unroll
                for (int bj = 0; bj < 2; ++bj) { d[bj][0] = *(const f32x4*)(brow + bj * HALF); d[bj][1] = *(const f32x4*)(brow + bj * HALF + 4); } } };
        ldbase(0, bv[0]);
#pragma unroll
        for (int i = 0; i < 8; ++i) {
            const int ai = i >> 2, m = i & 3, row = rowt + ai * HALF + m * 16;
            if (i + 1 < 8) ldbase(i + 1, bv[(i + 1) & 1]);
            bf16_t* hrow = HB + (size_t)row * D + col;
            float ss = 0.f;
#pragma unroll
            for (int bj = 0; bj < 2; ++bj) {
                const f32x4 v0 = bv[i & 1][bj][0] + acc[ai][bj][m][0], v1 = bv[i & 1][bj][1] + acc[ai][bj][m][1];
                *(u32x4*)(hrow + bj * HALF) = pack8(v0, v1);
                const f32x4 q0 = v0 * v0, q1 = v1 * v1; ss += ((q0[0] + q0[1]) + (q0[2] + q0[3])) + ((q1[0] + q1[1]) + (q1[2] + q1[3]));
            }
            ss = quad_sum(ss);
            if (fq == 0) SS[(size_t)row * 16 + 4 * u.pn + wc] = ss;
        }
    }
};
__device__ __forceinline__ float row_rs(const float* SS, int row, int fq) {
    const f32x4 s4 = *(const f32x4*)(SS + (size_t)row * 16 + 4 * fq);
    return rsqrtf(quad_sum((s4[0] + s4[1]) + (s4[2] + s4[3])) * (1.0f / D) + EPS);
}
struct EpiAct {
    static constexpr bool PERM = true, AFTER_DRAIN = false;
    const float* SS; bf16_t* ACT;
    __device__ __forceinline__ void operator()(const f32x4 (&acc)[2][2][4][2], const Unit& u, int wr, int wc, int fr, int fq) const {
        const int rowt = u.pm * BM + wr * 64 + fr, col = 128 * u.pn + 32 * wc + 8 * fq;
        float rv[2][4];
#pragma unroll
        for (int ai = 0; ai < 2; ++ai)
#pragma unroll
            for (int m = 0; m < 4; ++m) rv[ai][m] = row_rs(SS, rowt + ai * HALF + m * 16, fq);
#pragma unroll
        for (int ai = 0; ai < 2; ++ai)
#pragma unroll
            for (int m = 0; m < 4; ++m) {
                const int row = rowt + ai * HALF + m * 16; const float r = rv[ai][m];
                f32x4 v[2];
#pragma unroll
                for (int n = 0; n < 2; ++n) { const f32x4 g = acc[ai][0][m][n] * r, up = acc[ai][1][m][n] * r;
#pragma unroll
                    for (int e = 0; e < 4; ++e) v[n][e] = g[e] * sigm(g[e]) * up[e]; }
                *(u32x4*)(ACT + (size_t)row * DFF + col) = pack8(v[0], v[1]);
            }
    }
};
struct EpiFinal {
    static constexpr bool PERM = true, AFTER_DRAIN = false;
    const float* SS; const bf16_t* PP; const bf16_t* HB; float* Y;
    __device__ __forceinline__ void operator()(const f32x4 (&acc)[2][2][4][2], const Unit& u, int wr, int wc, int fr, int fq) const {
        const int rowt = u.pm * BM + wr * 64 + fr, col = u.pn * BM + 32 * wc + 8 * fq;
        float rv[2][4];
#pragma unroll
        for (int ai = 0; ai < 2; ++ai)
#pragma unroll
            for (int m = 0; m < 4; ++m) rv[ai][m] = row_rs(SS, rowt + ai * HALF + m * 16, fq);
        u32x4 pwv[2][2], hwv[2][2];
        auto ld = [&](int i, u32x4 (&p)[2], u32x4 (&h)[2]) { const size_t o = (size_t)(rowt + (i >> 2) * HALF + (i & 3) * 16) * D + col;
#pragma unroll
            for (int bj = 0; bj < 2; ++bj) { p[bj] = *(const u32x4*)(PP + o + bj * HALF); h[bj] = *(const u32x4*)(HB + o + bj * HALF); } };
        ld(0, pwv[0], hwv[0]);
#pragma unroll
        for (int i = 0; i < 8; ++i) {
            const int ai = i >> 2, m = i & 3, row = rowt + ai * HALF + m * 16; const float r = rv[ai][m];
            if (i + 1 < 8) ld(i + 1, pwv[(i + 1) & 1], hwv[(i + 1) & 1]);
#pragma unroll
            for (int bj = 0; bj < 2; ++bj) {
                const size_t o = (size_t)row * D + col + bj * HALF;
                const u32x4 pw = pwv[i & 1][bj], hw = hwv[i & 1][bj];
                const f32x4 a0 = acc[ai][bj][m][0] * r, a1 = acc[ai][bj][m][1] * r, p0 = bf_lo4(pw), p1 = bf_hi4(pw);
                f32x4 h0 = bf_lo4(hw), h1 = bf_hi4(hw);
#pragma unroll
                for (int e2 = 0; e2 < 4; ++e2) { h0[e2] += sigm(a0[e2]) * p0[e2]; h1[e2] += sigm(a1[e2]) * p1[e2]; }
                *(f32x4*)(Y + o) = h0; *(f32x4*)(Y + o + 4) = h1;
            }
        }
    }
};

template <class Epi, class Sched, bool ALIGN_EPI = false, bool SP2 = false>
__device__ __forceinline__ void gemm_phase(PG8_LAS unsigned char* lds, const Gemm g, const Sched& S, const Epi& E) {
    int tid_ = threadIdx.x; asm volatile("" : "+v"(tid_));
    const int tid = tid_, wid = __builtin_amdgcn_readfirstlane(tid >> 6), lane = tid & 63, wr = wid >> 2, wc = wid & 3, fr = lane & 15, fq = lane >> 4;
    int K_ = g.K; asm volatile("" : "+s"(K_));
    const int K = K_, nt = K / BK;
    unsigned voffA[2], voffB[2];
#pragma unroll
    for (int i = 0; i < 2; ++i) { int R, C; stage_rc(tid * 16 + i * 8192, R, C); const int Rb = Epi::PERM ? ((R & ~31) + perm32(R & 31)) : R;
        voffA[i] = (unsigned)(R * K + C) * 2u; voffB[i] = (unsigned)(Rb * K + C) * 2u; }
    const size_t kstep = (size_t)(BK * 2);
    const size_t hstep = (size_t)HALF * K * 2;
    const size_t tstep = 2 * hstep;
    const unsigned ldsw = (unsigned)wid * 1024u;
    const int aoff = lds_byte(wr * 64 + fr, fq * 8), boff = lds_byte(wc * 32 + fr, fq * 8);
#define PG8_SA(b, h) (((b) * 2 + (h)) * HTB)
#define PG8_SB(b, h) ((4 + (b) * 2 + (h)) * HTB)
#define PG8_STAGE(bufoff, gbase, voff) do { _Pragma("unroll") for (int _i = 0; _i < 2; ++_i) \
        __builtin_amdgcn_global_load_lds((const unsigned*)((const char*)(gbase) + (voff)[_i]), (PG8_LAS unsigned*)(lds + (bufoff) + ldsw + _i * 8192), 16, 0, 0); } while (0)
#define PG8_LDA(dst, b, h) do { _Pragma("unroll") for (int m = 0; m < 4; ++m) _Pragma("unroll") for (int k = 0; k < 2; ++k) dst[m][k] = *(const PG8_LAS bf16x8*)(lds + PG8_SA(b, h) + aoff + m * 2048 + k * 1024); } while (0)
#define PG8_LDB(dst, b, h) do { _Pragma("unroll") for (int n = 0; n < 2; ++n) _Pragma("unroll") for (int k = 0; k < 2; ++k) dst[n][k] = *(const PG8_LAS bf16x8*)(lds + PG8_SB(b, h) + boff + n * 2048 + k * 1024); } while (0)
#define PG8_MMA(ai, bj, At, Bt) do { __builtin_amdgcn_s_setprio(1); _Pragma("unroll") for (int m = 0; m < 4; ++m) _Pragma("unroll") for (int n = 0; n < 2; ++n) _Pragma("unroll") for (int k = 0; k < 2; ++k) \
        acc[ai][bj][m][n] = __builtin_amdgcn_mfma_f32_16x16x32_bf16(Bt[n][k], At[m][k], acc[ai][bj][m][n], 0, 0, 0); __builtin_amdgcn_s_setprio(0); } while (0)
#define PG8_WAIT_V(n) asm volatile("s_waitcnt vmcnt(" #n ")" ::: "memory")
#define PG8_WAIT_L(n) asm volatile("s_waitcnt lgkmcnt(" #n ")" ::: "memory")
#define PG8_BAR __builtin_amdgcn_s_barrier()
#define PG8_SCHED __builtin_amdgcn_sched_barrier(0)
    Unit cur, nxt; int ui = 0;
    if (!S.next(0, cur)) return;
    f32x4 acc[2][2][4][2];
#pragma unroll
    for (int a = 0; a < 2; ++a)
#pragma unroll
        for (int b = 0; b < 2; ++b)
#pragma unroll
            for (int m = 0; m < 4; ++m)
#pragma unroll
                for (int n = 0; n < 2; ++n) acc[a][b][m][n] = (f32x4){0.f, 0.f, 0.f, 0.f};
    bf16x8 At[4][2], B0[2][2], B1[2][2];
    const char* cA = (const char*)g.A + (size_t)cur.pm * tstep; const char* cB = (const char*)g.Bt + (size_t)cur.pn * tstep;
    S.a_ready(cur);
    if constexpr (SP2) {
        PG8_STAGE(PG8_SB(0, 0), cB, voffB); PG8_STAGE(PG8_SB(0, 1), cB + hstep, voffB); PG8_STAGE(PG8_SA(0, 0), cA, voffA); PG8_STAGE(PG8_SA(0, 1), cA + hstep, voffA);
        if (wr == 1) PG8_BAR;
        PG8_WAIT_V(2); PG8_BAR;
        PG8_STAGE(PG8_SB(1, 0), cB + kstep, voffB); PG8_STAGE(PG8_SA(1, 0), cA + kstep, voffA); PG8_STAGE(PG8_SB(1, 1), cB + hstep + kstep, voffB);
        PG8_WAIT_V(6); PG8_BAR;
    } else {
        PG8_STAGE(PG8_SB(0, 0), cB, voffB); PG8_STAGE(PG8_SA(0, 0), cA, voffA); PG8_STAGE(PG8_SB(0, 1), cB + hstep, voffB); PG8_STAGE(PG8_SA(0, 1), cA + hstep, voffA);
        if (wr == 1) PG8_BAR;
        PG8_WAIT_V(4); PG8_BAR;
        PG8_STAGE(PG8_SB(1, 0), cB + kstep, voffB); PG8_STAGE(PG8_SA(1, 0), cA + kstep, voffA); PG8_STAGE(PG8_SB(1, 1), cB + hstep + kstep, voffB);
        PG8_WAIT_V(6); PG8_BAR;
    }
    for (;;) {
        const bool has_next = S.next(ui + 1, nxt);
        const char* nA = has_next ? (const char*)g.A + (size_t)nxt.pm * tstep : cA; const char* nB = has_next ? (const char*)g.Bt + (size_t)nxt.pn * tstep : cB;
        for (int t = 0; t < nt; t += 2) {
            const bool last = (t == nt - 2);
            const char* a1 = cA + (size_t)(t + 1) * kstep;
            const char* a2 = last ? nA : cA + (size_t)(t + 2) * kstep; const char* b2 = last ? nB : cB + (size_t)(t + 2) * kstep;
            const char* a3 = a2 + kstep; const char* b3 = b2 + kstep;
            if (last && has_next) S.a_ready(nxt);
            if constexpr (SP2) {
            PG8_LDB(B0, 0, 0); PG8_LDB(B1, 0, 1); PG8_SCHED; PG8_LDA(At, 0, 0); PG8_STAGE(PG8_SA(1, 1), a1 + hstep, voffA);
            PG8_WAIT_V(8); PG8_WAIT_L(0); PG8_BAR; PG8_MMA(0, 0, At, B0); PG8_MMA(0, 1, At, B1); PG8_BAR; PG8_SCHED;
            PG8_LDA(At, 0, 1); PG8_STAGE(PG8_SB(0, 0), b2, voffB); PG8_STAGE(PG8_SB(0, 1), b2 + hstep, voffB); PG8_STAGE(PG8_SA(0, 0), a2, voffA);
            PG8_WAIT_V(8); PG8_WAIT_L(0); PG8_BAR; PG8_MMA(1, 0, At, B0); PG8_MMA(1, 1, At, B1); PG8_BAR; PG8_SCHED;
            PG8_LDB(B0, 1, 0); PG8_LDB(B1, 1, 1); PG8_SCHED; PG8_LDA(At, 1, 0); PG8_STAGE(PG8_SA(0, 1), a2 + hstep, voffA);
            PG8_WAIT_V(8); PG8_WAIT_L(0); PG8_BAR; PG8_MMA(0, 0, At, B0); PG8_MMA(0, 1, At, B1); PG8_BAR; PG8_SCHED;
            PG8_LDA(At, 1, 1); PG8_STAGE(PG8_SB(1, 0), b3, voffB); PG8_STAGE(PG8_SB(1, 1), b3 + hstep, voffB); PG8_STAGE(PG8_SA(1, 0), a3, voffA);
            PG8_WAIT_V(8); PG8_WAIT_L(0); PG8_BAR; PG8_MMA(1, 0, At, B0); PG8_MMA(1, 1, At, B1); PG8_BAR; PG8_SCHED;
            } else {
            PG8_LDB(B0, 0, 0); PG8_SCHED; PG8_LDA(At, 0, 0); PG8_STAGE(PG8_SA(1, 1), a1 + hstep, voffA);
            PG8_WAIT_L(8); PG8_BAR; PG8_WAIT_L(0); PG8_MMA(0, 0, At, B0); PG8_BAR; PG8_SCHED;
            PG8_LDB(B1, 0, 1); PG8_STAGE(PG8_SB(0, 0), b2, voffB);
            PG8_BAR; PG8_WAIT_L(0); PG8_MMA(0, 1, At, B1); PG8_BAR;
            PG8_LDA(At, 0, 1); PG8_STAGE(PG8_SA(0, 0), a2, voffA);
            PG8_BAR; PG8_WAIT_L(0); PG8_MMA(1, 0, At, B0); PG8_BAR; PG8_SCHED;
            PG8_STAGE(PG8_SB(0, 1), b2 + hstep, voffB);
            PG8_WAIT_V(6); PG8_BAR; PG8_MMA(1, 1, At, B1); PG8_BAR;
            PG8_LDB(B0, 1, 0); PG8_SCHED; PG8_LDA(At, 1, 0); PG8_STAGE(PG8_SA(0, 1), a2 + hstep, voffA);
            PG8_WAIT_L(8); PG8_BAR; PG8_WAIT_L(0); PG8_MMA(0, 0, At, B0); PG8_BAR; PG8_SCHED;
            PG8_LDB(B1, 1, 1); PG8_STAGE(PG8_SB(1, 0), b3, voffB);
            PG8_BAR; PG8_WAIT_L(0); PG8_MMA(0, 1, At, B1); PG8_BAR;
            PG8_LDA(At, 1, 1); PG8_STAGE(PG8_SA(1, 0), a3, voffA);
            PG8_BAR; PG8_WAIT_L(0); PG8_MMA(1, 0, At, B0); PG8_BAR; PG8_SCHED;
            PG8_STAGE(PG8_SB(1, 1), b3 + hstep, voffB);
            PG8_WAIT_V(6); PG8_BAR; PG8_MMA(1, 1, At, B1); PG8_BAR;
            }
        }
        if constexpr (ALIGN_EPI) { if (wr == 0) PG8_BAR; }
        if constexpr (!Epi::AFTER_DRAIN) { E(acc, cur, wr, wc, fr, fq); S.done(cur); }
        if (!has_next) break;
#pragma unroll
        for (int a = 0; a < 2; ++a)
#pragma unroll
            for (int b = 0; b < 2; ++b)
#pragma unroll
                for (int m = 0; m < 4; ++m)
#pragma unroll
                    for (int n = 0; n < 2; ++n) acc[a][b][m][n] = (f32x4){0.f, 0.f, 0.f, 0.f};
        cur = nxt; cA = nA; cB = nB; ++ui;
        if constexpr (ALIGN_EPI) { if (wr == 1) PG8_BAR; }
    }
    PG8_WAIT_V(0);
    if constexpr (!ALIGN_EPI) { if (wr == 0) PG8_BAR; }
    PG8_BAR;
    if constexpr (Epi::AFTER_DRAIN) { E.fused(acc, cur, wr, wc, fr, fq, lds, wid, lane); S.done(cur); }
#undef PG8_SA
#undef PG8_SB
#undef PG8_STAGE
#undef PG8_LDA
#undef PG8_LDB
#undef PG8_MMA
#undef PG8_WAIT_V
#undef PG8_WAIT_L
#undef PG8_BAR
#undef PG8_SCHED
}
}
#define GAS __attribute__((address_space(1)))
#define LAS __attribute__((address_space(3)))
typedef unsigned short bf16;
typedef unsigned v4u __attribute__((ext_vector_type(4)));
typedef float f32x4 __attribute__((ext_vector_type(4)));
typedef short bf16x8 __attribute__((ext_vector_type(8)));
typedef GAS unsigned gu32;
typedef GAS unsigned long long gu64;
#define RLX_AGENT __ATOMIC_RELAXED, __HIP_MEMORY_SCOPE_AGENT
#define LDS_WAIT() asm volatile("s_waitcnt lgkmcnt(0)" ::: "memory")
#define VM_WAIT() asm volatile("s_waitcnt vmcnt(0)" ::: "memory")
__device__ __forceinline__ unsigned long long rt() { return __builtin_amdgcn_s_memrealtime(); }
__device__ __forceinline__ unsigned f2bf(float f) { unsigned u = __builtin_bit_cast(unsigned, f); return (u + 0x7fffu + ((u >> 16) & 1u)) >> 16; }
__device__ __forceinline__ unsigned pk2(float lo, float hi) { return f2bf(lo) | (f2bf(hi) << 16); }
#define XB_TMO      128
#define XB_XCNT(j)  (256  + 64 * (j))
#define XB_XSUB(j)  (1280 + 64 * (j))
#define XB_XGEN(j)  (2304 + 64 * (j))
#define XB_TOP      3328
#define XB_TOPGEN   3392
#define XCD_BAR_WORDS 3456
#define XB_SPIN_CAP (1u << 18)

__device__ __forceinline__ unsigned xb_ld(unsigned* p)              { return __hip_atomic_load(p, __ATOMIC_RELAXED, __HIP_MEMORY_SCOPE_AGENT); }
__device__ __forceinline__ unsigned xb_add(unsigned* p, unsigned v) { return __hip_atomic_fetch_add(p, v, __ATOMIC_RELAXED, __HIP_MEMORY_SCOPE_AGENT); }
__device__ __forceinline__ unsigned xb_xcc_id() { return (unsigned)__builtin_amdgcn_s_getreg((3 << 11) | 20) & 0xFu; }
#define XB_SPIN(cond, bar) do { unsigned _sp = 0; while (cond) { __builtin_amdgcn_s_sleep(1); \
    if ((++_sp & 255u) == 0u) { if (xb_ld(&(bar)[XB_TMO])) break; if (_sp > XB_SPIN_CAP) { atomicAdd(&(bar)[XB_TMO], 1u); break; } } } } while (0)

struct XcdBarrier {
    unsigned* bar; unsigned x;
    volatile LAS unsigned* st;
};

__device__ __forceinline__ XcdBarrier xcd_barrier_post(unsigned* bar, volatile LAS unsigned* st) {
    XcdBarrier b; b.bar = bar; b.x = xb_xcc_id(); b.st = st;
    if (threadIdx.x == 0) (void)xb_add(&bar[XB_XCNT(b.x)], 1u);
    return b;
}
__device__ __forceinline__ void xcd_barrier_complete(unsigned* bar, unsigned x, unsigned& nloc, unsigned& nx) {
    const unsigned G = gridDim.x * gridDim.y * gridDim.z;
    unsigned sum, cnt, mine, sp = 0u;
    for (;;) {
        sum = 0u; cnt = 0u; mine = 0u;
#pragma unroll
        for (unsigned j = 0; j < 16; ++j) { const unsigned c = xb_ld(&bar[XB_XCNT(j)]); sum += c; cnt += (c > 0u) ? 1u : 0u; mine = (j == x) ? c : mine; }
        if (sum == G) break;
        __builtin_amdgcn_s_sleep(1);
        if ((++sp & 255u) == 0u) { if (xb_ld(&bar[XB_TMO])) break; if (sp > XB_SPIN_CAP) { atomicAdd(&bar[XB_TMO], 1u); break; } }
    }
    nloc = mine > 0u ? mine : 1u; nx = cnt > 0u ? cnt : 1u;
}

__device__ __forceinline__ void xcd_barrier(const XcdBarrier& b) {
    asm volatile("s_waitcnt vmcnt(0)" ::: "memory");
    __syncthreads();
    if (threadIdx.x == 0) {
        unsigned* bar = b.bar;
        __builtin_amdgcn_s_waitcnt(0);
        unsigned nloc = b.st[0], nx = b.st[1];
        if (nloc == 0u) { xcd_barrier_complete(bar, b.x, nloc, nx); b.st[0] = nloc; b.st[1] = nx; }
        const unsigned old = xb_add(&bar[XB_XSUB(b.x)], 1u);
        const unsigned gen = old / nloc;
        if (old + 1u == (gen + 1u) * nloc) {
            __builtin_amdgcn_fence(__ATOMIC_RELEASE, "agent");
            asm volatile("s_waitcnt vmcnt(0)" ::: "memory");
            const unsigned og = xb_add(&bar[XB_TOP], 1u);
            const unsigned tg = og / nx;
            if (og + 1u == (tg + 1u) * nx) xb_add(&bar[XB_TOPGEN], 1u);
            else XB_SPIN(xb_ld(&bar[XB_TOPGEN]) == tg, bar);
            __builtin_amdgcn_fence(__ATOMIC_ACQUIRE, "agent");
            xb_add(&bar[XB_XGEN(b.x)], 1u);
            asm volatile("s_waitcnt vmcnt(0)" ::: "memory");
        } else {
            XB_SPIN(xb_ld(&bar[XB_XGEN(b.x)]) == gen, bar);
            __builtin_amdgcn_fence(__ATOMIC_ACQUIRE, "agent");
            asm volatile("s_waitcnt vmcnt(0)" ::: "memory");
        }
    }
    __syncthreads();
}
constexpr int NWAVES = 8;
constexpr size_t MiB = 1u << 20;
constexpr size_t WS_CTL = 0, CTL_ZERO_BYTES = 65536;
constexpr size_t WS_W1 = 1 * MiB, WS_WO = 6 * MiB, WS_WGU = 8 * MiB, WS_WD = 19 * MiB, WS_WPG = 25 * MiB, WS_WPP = 27 * MiB;
constexpr size_t WS_RX = 28 * MiB, WS_SS1 = 29 * MiB, WS_SS2 = 32 * MiB;
constexpr size_t WS_XB = 36 * MiB;
constexpr size_t WS_PB = 102 * MiB, WS_PP = 119 * MiB;
constexpr size_t WS_Q = 185 * MiB, WS_KP = 218 * MiB, WS_VP = 250 * MiB, WS_KS = 282 * MiB, WS_VS = 300 * MiB, WS_GLU = 318 * MiB, WS_MIX = 351 * MiB;
constexpr size_t WS_ACT = 185 * MiB;
constexpr size_t WS_END = 417 * MiB;
static_assert(WS_XB + (size_t)R * D * 2 <= WS_PB && WS_PB + (size_t)R * PLE * 2 <= WS_PP && WS_PP + (size_t)R * D * 2 <= WS_Q && WS_Q + (size_t)R * 512 * 2 <= WS_KP &&
              WS_KP + (size_t)(RP / 64) * KVT_BYTES <= WS_KS && WS_KS + (size_t)DB * 9 * KVT_BYTES <= WS_GLU && WS_GLU + (size_t)R * 512 * 2 <= WS_MIX &&
              WS_MIX + (size_t)R * D * 2 <= WS_END && WS_ACT + (size_t)R * DFF * 2 <= WS_END && WS_SS1 + (size_t)R * 64 <= WS_SS2 && WS_SS2 + (size_t)R * 64 <= WS_XB && WS_RX + (size_t)R * 4 <= WS_SS1, "d_ws map");
constexpr int CW_BAR = 4096, CW_Q = 8192, CW_QG = CW_Q + 64 * 32;
constexpr int RING_OFF = 0, RING_BYTES = 131072;
constexpr int LDSCTL_OFF = RING_BYTES, MISC_OFF = LDSCTL_OFF + 320;
constexpr int ATT_TAB = 132096, ATT_LSC = ATT_TAB + 8192;
constexpr int LDS_BYTES = 147456;
static_assert(ATT_LSC + 2048 <= LDS_BYTES && MISC_OFF + 128 <= ATT_TAB, "LDS map");

__device__ __forceinline__ float wave_sum(float v) {
#pragma unroll
    for (int o = 1; o < 64; o <<= 1) v += __shfl_xor(v, o);
    return v;
}
__device__ __forceinline__ float wave_max(float v) {
#pragma unroll
    for (int o = 1; o < 64; o <<= 1) v = fmaxf(v, __shfl_xor(v, o));
    return v;
}
__device__ __forceinline__ int map_win(int n) {
    if (n < 1536) { const int sec = n >> 9, nn = n & 511, h = nn >> 6, d = nn & 63; return sec * 512 + 256 * (h >> 2) + 128 * (d >> 5) + 32 * (h & 3) + (d & 31); }
    if (n < 2048) { const int i = n - 1536; return 1536 + 256 * (i >> 7) + (i & 127); }
    const int i = n - 2048; return 1536 + 256 * (i >> 7) + 128 + (i & 127);
}
__device__ __forceinline__ int map_gu(int n) {
    if (n < DFF) return 256 * (n >> 7) + (n & 127);
    const int i = n - DFF; return 256 * (i >> 7) + 128 + (i & 127);
}
template <int MAP> __device__ __forceinline__ void p0_transpose_item(const float* W, const float* gain, int K, int N, bf16* WT, LAS float* scr, int item, int lane) {
    const int nblk = N / 32, kb = item / nblk, nb = item % nblk, k0 = 64 * kb, n0 = 32 * nb;
    { const int nq = lane & 7, kr = lane >> 3; f32x4 v[8];
#pragma unroll
      for (int i = 0; i < 8; ++i) v[i] = *(const GAS f32x4*)(W + (size_t)(k0 + 8 * i + kr) * N + n0 + 4 * nq);
#pragma unroll
      for (int i = 0; i < 8; ++i) { const int kk = 8 * i + kr; const float gk = gain ? gain[k0 + kk] : 1.0f;
#pragma unroll
          for (int e = 0; e < 4; ++e) scr[kk * 33 + 4 * nq + e] = v[i][e] * gk; } }
    LDS_WAIT(); asm volatile("" ::: "memory");
    const int c = lane & 7;
#pragma unroll
    for (int j = 0; j < 4; ++j) { const int n = (lane >> 3) + 8 * j; const LAS float* s = scr + (8 * c) * 33 + n;
        v4u o; o.x = pk2(s[0 * 33], s[1 * 33]); o.y = pk2(s[2 * 33], s[3 * 33]); o.z = pk2(s[4 * 33], s[5 * 33]); o.w = pk2(s[6 * 33], s[7 * 33]);
        const int ns = n0 + n, dr = MAP == 0 ? ns : (MAP == 1 ? map_win(ns) : map_gu(ns));
        *(GAS v4u*)(WT + (size_t)dr * K + k0 + 8 * c) = o; }
    LDS_WAIT(); asm volatile("" ::: "memory");
}

namespace att {
typedef short bf16x8 __attribute__((ext_vector_type(8)));
typedef short s16x4 __attribute__((ext_vector_type(4)));
typedef float f32x16 __attribute__((ext_vector_type(16)));
typedef unsigned u32x4 __attribute__((ext_vector_type(4)));
typedef float f32x2_t __attribute__((ext_vector_type(2))); typedef __bf16 bf16x2_t __attribute__((ext_vector_type(2)));
typedef short v4i16_t __attribute__((ext_vector_type(4)));
typedef LAS const char* lds_cptr;
constexpr int BUFB = 65536, HSLOT = 16384;
__device__ __forceinline__ int crow(int r, int hi) { return (r & 3) + 8 * (r >> 2) + 4 * hi; }
__device__ __forceinline__ void glds16(const void* gsrc, unsigned lds_dst) { unsigned keep;
    asm volatile("s_mov_b32 %0, m0\n\ts_mov_b32 m0, %2\n\ts_nop 0\n\tglobal_load_lds_dwordx4 %1, off\n\ts_mov_b32 m0, %0" : "=&s"(keep) : "v"(gsrc), "s"(lds_dst) : "memory"); }
__device__ __forceinline__ unsigned cvtpk_s(float lo, float hi) { f32x2_t v = {lo, hi}; bf16x2_t b = __builtin_convertvector(v, bf16x2_t); return __builtin_bit_cast(unsigned, b); }
__device__ __forceinline__ s16x4 vtr(lds_cptr p) { return __builtin_bit_cast(s16x4, __builtin_amdgcn_ds_read_tr16_b64_v4i16((LAS v4i16_t*)p)); }
#define ATT_WAIT_BAR() asm volatile("s_waitcnt vmcnt(0) lgkmcnt(0)\n\ts_barrier" ::: "memory")

struct AUnit { const bf16* Qrow; const unsigned char* KV; bf16* Orow; int nt, hg, sample, c0rel; };

__device__ __forceinline__ void attn_prefetch(const AUnit& U, LAS unsigned char* lds, int wid, int lane, bf16x8 (&qr)[2][4]) {
    const int r32 = lane & 31, hi = lane >> 5, hl = wid & 3, ci = wid >> 2, head = 4 * U.hg + hl;
    const bool wact = !U.sample || ci == 0;
    const unsigned char* kvsrc = U.KV + U.hg * 65536 + wid * 1024 + lane * 16;
    const unsigned kvdst = (unsigned)(size_t)lds + wid * 1024;
#pragma unroll
    for (int j_ = 0; j_ < 8; ++j_) glds16(kvsrc + j_ * 8192, (unsigned)__builtin_amdgcn_readfirstlane(kvdst + j_ * 8192));
    const bf16* Qw = U.Qrow + (size_t)((wact ? 64 * ci : 0) + r32) * 512 + head * 64 + hi * 8; const bf16* Qw1 = Qw + (U.sample ? 0 : 32 * 512);
#pragma unroll
    for (int d0 = 0; d0 < 4; ++d0) { qr[0][d0] = *(const bf16x8*)(Qw + d0 * 16); qr[1][d0] = *(const bf16x8*)(Qw1 + d0 * 16); }
}
template <bool TWO> __device__ __forceinline__ void attn_steps(const AUnit& U, LAS unsigned char* lds, int wid, int lane, const bf16x8 (&qr)[2][4], f32x16 (&o)[2][2], float (&lsum)[2]) {
    const int r32 = lane & 31, hi = lane >> 5, hl = wid & 3, ci = wid >> 2, head = 4 * U.hg + hl, nt = U.nt, own = U.c0rel + ci;
    const bool wact = TWO || ci == 0;
    const unsigned lds0 = (unsigned)(size_t)lds;
    const LAS float* tabh = (const LAS float*)(lds + ATT_TAB) + head * 256;
    const unsigned char* kvsrc = U.KV + U.hg * 65536 + wid * 1024 + lane * 16;
    const unsigned kvdst = lds0 + wid * 1024;
#define ATT_DMA(ti, b) do { _Pragma("unroll") for (int j_ = 0; j_ < 8; ++j_) \
        glds16(kvsrc + (size_t)(ti) * KVT_BYTES + j_ * 8192, (unsigned)__builtin_amdgcn_readfirstlane(kvdst + (b) * BUFB + j_ * 8192)); } while (0)
    for (int ti = 0; ti < nt; ++ti) {
        ATT_WAIT_BAR();
        const int b = ti & 1;
        if (ti + 1 < nt) ATT_DMA(ti + 1, b ^ 1);
        const int jt = own - ti;
        if (wact && jt >= 0 && jt <= 8) {
            const float m1 = (!TWO && jt == 0) ? 0.f : 1.f;
            const lds_cptr kp = (lds_cptr)(lds + b * BUFB + hl * HSLOT + hi * 1024 + r32 * 16);
            bf16x8 kf[8];
            { const unsigned ka = (unsigned)(size_t)kp;
              asm volatile("ds_read_b128 %0, %8\n\tds_read_b128 %1, %8 offset:512\n\tds_read_b128 %2, %8 offset:2048\n\tds_read_b128 %3, %8 offset:2560\n\t"
                           "ds_read_b128 %4, %8 offset:4096\n\tds_read_b128 %5, %8 offset:4608\n\tds_read_b128 %6, %8 offset:6144\n\tds_read_b128 %7, %8 offset:6656\n\ts_waitcnt lgkmcnt(0)"
                           : "=&v"(kf[0]), "=&v"(kf[1]), "=&v"(kf[2]), "=&v"(kf[3]), "=&v"(kf[4]), "=&v"(kf[5]), "=&v"(kf[6]), "=&v"(kf[7]) : "v"(ka) : "memory");
              __builtin_amdgcn_sched_barrier(0); }
            f32x16 s[2][2]; s[0][0] = f32x16{}; s[0][1] = f32x16{}; s[1][0] = f32x16{}; s[1][1] = f32x16{};
#pragma unroll
            for (int h2 = 0; h2 < (TWO ? 2 : 1); ++h2)
#pragma unroll
                for (int d0 = 0; d0 < 4; ++d0) { s[h2][0] = __builtin_amdgcn_mfma_f32_32x32x16_bf16(kf[2 * d0], qr[h2][d0], s[h2][0], 0, 0, 0);
                                                 s[h2][1] = __builtin_amdgcn_mfma_f32_32x32x16_bf16(kf[2 * d0 + 1], qr[h2][d0], s[h2][1], 0, 0, 0); }
            u32x4 pw[2][4];
#pragma unroll
            for (int h2 = 0; h2 < (TWO ? 2 : 1); ++h2) {
                f32x16& p0 = s[h2][0]; f32x16& p1 = s[h2][1];
                if (jt < 3) { const LAS float* tp = tabh + (191 - (32 * h2 + r32) - 64 * jt + 4 * hi);
#pragma unroll
                    for (int r = 0; r < 16; ++r) { p0[r] += tp[(r & 3) + 8 * (r >> 2)]; p1[r] += tp[32 + (r & 3) + 8 * (r >> 2)]; } }
                float sacc = 0.f;
#pragma unroll
                for (int r = 0; r < 16; ++r) { p0[r] = __builtin_amdgcn_exp2f(p0[r]); p1[r] = __builtin_amdgcn_exp2f(p1[r]); if (!TWO) p1[r] *= m1; sacc += p0[r] + p1[r]; }
                lsum[h2] += sacc;
#pragma unroll
                for (int k = 0; k < 2; ++k) { pw[h2][k] = (u32x4){cvtpk_s(p0[8 * k], p0[8 * k + 1]), cvtpk_s(p0[8 * k + 2], p0[8 * k + 3]), cvtpk_s(p0[8 * k + 4], p0[8 * k + 5]), cvtpk_s(p0[8 * k + 6], p0[8 * k + 7])};
                    pw[h2][2 + k] = (u32x4){cvtpk_s(p1[8 * k], p1[8 * k + 1]), cvtpk_s(p1[8 * k + 2], p1[8 * k + 3]), cvtpk_s(p1[8 * k + 4], p1[8 * k + 5]), cvtpk_s(p1[8 * k + 6], p1[8 * k + 7])}; }
            }
            const lds_cptr vp = (lds_cptr)(lds + b * BUFB + hl * HSLOT + 8192 + ((lane >> 4) & 1) * 32 + (lane & 3) * 8 + (4 * hi + ((lane & 15) >> 2)) * 64);
            const unsigned va = (unsigned)(size_t)vp;
#pragma unroll
            for (int d0 = 0; d0 < 2; ++d0) {
                s16x4 lo[4], hh[4];
                asm volatile("ds_read_b64_tr_b16 %0, %8 offset:%c9\n\tds_read_b64_tr_b16 %1, %8 offset:%c10\n\tds_read_b64_tr_b16 %2, %8 offset:%c11\n\tds_read_b64_tr_b16 %3, %8 offset:%c12\n\t"
                             "ds_read_b64_tr_b16 %4, %8 offset:%c13\n\tds_read_b64_tr_b16 %5, %8 offset:%c14\n\tds_read_b64_tr_b16 %6, %8 offset:%c15\n\tds_read_b64_tr_b16 %7, %8 offset:%c16\n\ts_waitcnt lgkmcnt(0)"
                             : "=&v"(lo[0]), "=&v"(hh[0]), "=&v"(lo[1]), "=&v"(hh[1]), "=&v"(lo[2]), "=&v"(hh[2]), "=&v"(lo[3]), "=&v"(hh[3])
                             : "v"(va), "i"(d0 * 4096), "i"(d0 * 4096 + 512), "i"(d0 * 4096 + 1024), "i"(d0 * 4096 + 1536), "i"(d0 * 4096 + 2048), "i"(d0 * 4096 + 2560), "i"(d0 * 4096 + 3072), "i"(d0 * 4096 + 3584) : "memory");
                __builtin_amdgcn_sched_barrier(0);
#pragma unroll
                for (int ks = 0; ks < 4; ++ks) {
                    const bf16x8 vf = (bf16x8){lo[ks][0], lo[ks][1], lo[ks][2], lo[ks][3], hh[ks][0], hh[ks][1], hh[ks][2], hh[ks][3]};
                    o[0][d0] = __builtin_amdgcn_mfma_f32_32x32x16_bf16(__builtin_bit_cast(bf16x8, pw[0][ks]), vf, o[0][d0], 0, 0, 0);
                    if (TWO) o[1][d0] = __builtin_amdgcn_mfma_f32_32x32x16_bf16(__builtin_bit_cast(bf16x8, pw[1][ks]), vf, o[1][d0], 0, 0, 0); }
            }
        }
    }
#undef ATT_DMA
}
template <bool TWO> __device__ __forceinline__ void attn_store(const AUnit& U, LAS unsigned char* lds, int wid, int lane, const f32x16 (&o)[2][2], const float (&lsum)[2]) {
    const int r32 = lane & 31, hi = lane >> 5, hl = wid & 3, ci = wid >> 2, head = 4 * U.hg + hl;
    const bool wact = TWO || ci == 0;
    LAS float* lsc = (LAS float*)(lds + ATT_LSC) + wid * 64;
    if (wact) {
#pragma unroll
        for (int h2 = 0; h2 < (TWO ? 2 : 1); ++h2) {
            float ls = lsum[h2];
            { auto rr = __builtin_amdgcn_permlane32_swap(__float_as_uint(ls), __float_as_uint(ls), false, false); ls = __uint_as_float(rr[0]) + __uint_as_float(rr[1]); }
            if (hi == 0) lsc[32 * h2 + r32] = ls;
            asm volatile("s_waitcnt lgkmcnt(0)" ::: "memory");
            LAS bf16* stg = (LAS bf16*)(lds + BUFB + wid * 8192 + h2 * 4096);
#pragma unroll
            for (int r = 0; r < 16; ++r) { const int orow = crow(r, hi); const float rl = __builtin_amdgcn_rcpf(lsc[32 * h2 + orow]);
#pragma unroll
                for (int d0 = 0; d0 < 2; ++d0) stg[orow * 64 + d0 * 32 + r32] = (bf16)f2bf(o[h2][d0][r] * rl); }
            asm volatile("s_waitcnt lgkmcnt(0)" ::: "memory");
            bf16* Ow = U.Orow + (size_t)(64 * ci + 32 * h2) * D + head * 64;
#pragma unroll
            for (int i = 0; i < 4; ++i) { const int row = i * 8 + (lane >> 3), ch = lane & 7; const u32x4 v = *(const LAS u32x4*)(stg + row * 64 + ch * 8); *(u32x4*)(Ow + (size_t)row * D + ch * 8) = v; }
        }
    }
}
}

__device__ __forceinline__ void conv_item(int item, const bf16* GLU, const float* st, const float* cw, const float* cb, const float* lg, const float* lb, bf16* MIX, LAS unsigned char* lds, int tid) {
    const bool samp = item >= RP / 32; const int b = samp ? item - RP / 32 : item >> 8, t0 = samp ? 0 : (item & 255) * 32, rowbase = samp ? RP + DS * b : b * SEQ;
    const int ch = tid, wid = tid >> 6, lane = tid & 63;
    LAS bf16* xs = (LAS bf16*)lds;
    LAS float* ybuf = (LAS float*)(lds + 65536);
#pragma unroll
    for (int i = 0; i < 8; ++i) { const int k = wid + 8 * i; if (k < 62) { const int tp = t0 - CH + k; pg8::u32x4 v = (pg8::u32x4){0u, 0u, 0u, 0u};
        if (tp >= 0) v = *(const pg8::u32x4*)(GLU + (size_t)(rowbase + tp) * 512 + 8 * lane);
        else if (samp) { const float* sp = st + ((size_t)b * CH + (CH + tp)) * CW + 8 * lane; v = pg8::pack8(*(const f32x4*)sp, *(const f32x4*)(sp + 4)); }
        *(LAS pg8::u32x4*)(xs + k * 512 + 8 * lane) = v; } }
    float w[CONVW];
#pragma unroll
    for (int j = 0; j < CONVW; ++j) w[j] = cw[j * CW + ch];
    const float bias = cb[ch];
    __syncthreads();
#pragma unroll 1
    for (int hb = 0; hb < 2; ++hb) {
        float x[46];
#pragma unroll
        for (int k = 0; k < 46; ++k) x[k] = __uint_as_float((unsigned)xs[(16 * hb + k) * 512 + ch] << 16);
        float y[16];
#pragma unroll
        for (int i = 0; i < 16; ++i) y[i] = bias;
#pragma unroll
        for (int j = 0; j < CONVW; ++j)
#pragma unroll
            for (int i = 0; i < 16; ++i) y[i] += w[j] * x[i + j];
#pragma unroll
        for (int i = 0; i < 16; ++i) ybuf[(16 * hb + i) * 512 + ch] = y[i];
    }
    __syncthreads();
    f32x4 g0 = *(const f32x4*)(lg + 8 * lane), g1 = *(const f32x4*)(lg + 8 * lane + 4), b0 = *(const f32x4*)(lb + 8 * lane), b1 = *(const f32x4*)(lb + 8 * lane + 4);
#pragma unroll
    for (int q = 0; q < 4; ++q) { const int i = 4 * wid + q;
        f32x4 v0 = *(const LAS f32x4*)(ybuf + i * 512 + 8 * lane), v1 = *(const LAS f32x4*)(ybuf + i * 512 + 8 * lane + 4);
        const float mean = wave_sum((v0[0] + v0[1]) + (v0[2] + v0[3]) + (v1[0] + v1[1]) + (v1[2] + v1[3])) * (1.0f / CW);
        v0 = v0 - mean; v1 = v1 - mean;
        const f32x4 q0 = v0 * v0, q1 = v1 * v1;
        const float rstd = rsqrtf(wave_sum((q0[0] + q0[1]) + (q0[2] + q0[3]) + (q1[0] + q1[1]) + (q1[2] + q1[3])) * (1.0f / CW) + EPS);
        v0 = v0 * rstd * g0 + b0; v1 = v1 * rstd * g1 + b1;
#pragma unroll
        for (int e = 0; e < 4; ++e) { v0[e] *= pg8::sigm(v0[e]); v1[e] *= pg8::sigm(v1[e]); }
        *(pg8::u32x4*)(MIX + (size_t)(rowbase + t0 + i) * D + 512 + 8 * lane) = pg8::pack8(v0, v1); }
    __syncthreads();
}


constexpr int SG_LD = 68;
template <class Epi> __device__ __forceinline__ void sgemm64(const bf16* A, const bf16* Bt, int K_, int tile, const Epi& E, LAS unsigned char* lds) {
    int tid_ = threadIdx.x; asm volatile("" : "+v"(tid_)); int K = K_; asm volatile("" : "+s"(K));
    const int lane = tid_ & 63, wave = __builtin_amdgcn_readfirstlane(tid_ >> 6), fr = lane & 15, fq = lane >> 4, kg = wave & 3, nh = wave >> 2, tr = tile >> 4, tc = tile & 15;
    const int Kq = K >> 2;
    const bf16* ap = A + (size_t)(64 * tr + fr) * K + kg * Kq + 8 * fq;
    const bf16* bp = Bt + (size_t)(64 * tc + 32 * nh + fr) * K + kg * Kq + 8 * fq;
    const size_t r16 = (size_t)16 * K;
    f32x4 acc[4][2];
#pragma unroll
    for (int mi = 0; mi < 4; ++mi) { acc[mi][0] = (f32x4){0.f, 0.f, 0.f, 0.f}; acc[mi][1] = acc[mi][0]; }
    bf16x8 a[2][4], p[2][2], an[2][4], pn[2][2];
#pragma unroll
    for (int s = 0; s < 2; ++s) {
#pragma unroll
        for (int mi = 0; mi < 4; ++mi) a[s][mi] = *(const bf16x8*)(ap + mi * r16 + 32 * s);
        p[s][0] = *(const bf16x8*)(bp + 32 * s); p[s][1] = *(const bf16x8*)(bp + r16 + 32 * s); }
    for (int k = 64; k <= Kq; k += 64) {
        const int kn = k < Kq ? k : 0;
#pragma unroll
        for (int s = 0; s < 2; ++s) {
#pragma unroll
            for (int mi = 0; mi < 4; ++mi) an[s][mi] = *(const bf16x8*)(ap + mi * r16 + kn + 32 * s);
            pn[s][0] = *(const bf16x8*)(bp + kn + 32 * s); pn[s][1] = *(const bf16x8*)(bp + r16 + kn + 32 * s); }
#pragma unroll
        for (int s = 0; s < 2; ++s)
#pragma unroll
            for (int mi = 0; mi < 4; ++mi) { acc[mi][0] = __builtin_amdgcn_mfma_f32_16x16x32_bf16(p[s][0], a[s][mi], acc[mi][0], 0, 0, 0); acc[mi][1] = __builtin_amdgcn_mfma_f32_16x16x32_bf16(p[s][1], a[s][mi], acc[mi][1], 0, 0, 0); }
#pragma unroll
        for (int s = 0; s < 2; ++s) {
#pragma unroll
            for (int mi = 0; mi < 4; ++mi) a[s][mi] = an[s][mi];
            p[s][0] = pn[s][0]; p[s][1] = pn[s][1]; }
    }
    LAS float* part = (LAS float*)lds;
#pragma unroll
    for (int mi = 0; mi < 4; ++mi)
#pragma unroll
        for (int ni = 0; ni < 2; ++ni) *(LAS f32x4*)(part + (kg * 64 + 16 * mi + fr) * SG_LD + 32 * nh + 16 * ni + 4 * fq) = acc[mi][ni];
    __syncthreads();
    const int row = tid_ >> 3, c8 = (tid_ & 7) * 8;
    f32x4 v0 = *(const LAS f32x4*)(part + row * SG_LD + c8), v1 = *(const LAS f32x4*)(part + row * SG_LD + c8 + 4);
#pragma unroll
    for (int g = 1; g < 4; ++g) { v0 = v0 + *(const LAS f32x4*)(part + (g * 64 + row) * SG_LD + c8); v1 = v1 + *(const LAS f32x4*)(part + (g * 64 + row) * SG_LD + c8 + 4); }
    E(64 * tr + row, 64 * tc + c8, tc, tid_ & 7, v0, v1);
    __syncthreads();
}
__device__ __forceinline__ float oct_sum(float s) { s += __shfl_xor(s, 1); s += __shfl_xor(s, 2); s += __shfl_xor(s, 4); return s; }
template <bool BF> struct SEpiRes {
    const float* base; bf16* HB; float* SS;
    __device__ __forceinline__ void operator()(int row, int col, int tc, int l8, f32x4 v0, f32x4 v1) const {
        const size_t o = (size_t)row * D + col;
        if (BF) { const pg8::u32x4 w = *(const pg8::u32x4*)(HB + o); v0 = v0 + pg8::bf_lo4(w); v1 = v1 + pg8::bf_hi4(w); }
        else { v0 = v0 + *(const f32x4*)(base + o); v1 = v1 + *(const f32x4*)(base + o + 4); }
        *(pg8::u32x4*)(HB + o) = pg8::pack8(v0, v1);
        const f32x4 q0 = v0 * v0, q1 = v1 * v1;
        const float ss = oct_sum(((q0[0] + q0[1]) + (q0[2] + q0[3])) + ((q1[0] + q1[1]) + (q1[2] + q1[3])));
        if (l8 == 0) SS[(size_t)row * 16 + tc] = ss;
    }
};
struct SEpiPP {
    bf16* PP;
    __device__ __forceinline__ void operator()(int row, int col, int tc, int l8, f32x4 v0, f32x4 v1) const { *(pg8::u32x4*)(PP + (size_t)row * D + col) = pg8::pack8(v0, v1); }
};
struct SEpiFinal {
    const float* SS; const bf16* PP; const bf16* HB; float* Y;
    __device__ __forceinline__ void operator()(int row, int col, int tc, int l8, f32x4 v0, f32x4 v1) const {
        const float r = rsqrtf(oct_sum(SS[(size_t)row * 16 + 2 * l8] + SS[(size_t)row * 16 + 2 * l8 + 1]) * (1.0f / D) + EPS);
        const size_t o = (size_t)row * D + col;
        const pg8::u32x4 pw = *(const pg8::u32x4*)(PP + o), hw = *(const pg8::u32x4*)(HB + o);
        const f32x4 p0 = pg8::bf_lo4(pw), p1 = pg8::bf_hi4(pw); f32x4 h0 = pg8::bf_lo4(hw), h1 = pg8::bf_hi4(hw);
#pragma unroll
        for (int e = 0; e < 4; ++e) { h0[e] += pg8::sigm(v0[e] * r) * p0[e]; h1[e] += pg8::sigm(v1[e] * r) * p1[e]; }
        *(f32x4*)(Y + o) = h0; *(f32x4*)(Y + o + 4) = h1;
    }
};

#ifndef REP_P0
#define REP_P0 1
#endif
#ifndef REP_P1
#define REP_P1 1
#endif
#ifndef REP_P2
#define REP_P2 1
#endif
#ifndef REP_P3
#define REP_P3 1
#endif
#ifndef REP_P4
#define REP_P4 1
#endif
struct Args { const float* in[23]; float* out; unsigned char* ws; };
constexpr int N_ATT_S = 2 * DB, N_ATT_P = NB * 64 * 2, N_CONV = R / 32;
constexpr int I_WO = (D / 64) * (D / 32), I_WGU = (D / 64) * (2 * DFF / 32), N_WCV = (I_WO + I_WGU) / 8;
constexpr int N_ATT_Q = 8 + 64;
static_assert((I_WO + I_WGU) % 8 == 0, "weight conversion entries");
#define W1t ((bf16*)(ws + WS_W1))
#define WOt ((bf16*)(ws + WS_WO))
#define WGUt ((bf16*)(ws + WS_WGU))
#define WDt ((bf16*)(ws + WS_WD))
#define WPGt ((bf16*)(ws + WS_WPG))
#define WPPt ((bf16*)(ws + WS_WPP))
#define RX ((float*)(ws + WS_RX))
#define SS1 ((float*)(ws + WS_SS1))
#define SS2 ((float*)(ws + WS_SS2))
#define XB ((bf16*)(ws + WS_XB))
#define PB ((bf16*)(ws + WS_PB))
#define PPb ((bf16*)(ws + WS_PP))
#define Qb ((bf16*)(ws + WS_Q))
#define KVP (ws + WS_KP)
#define KVS (ws + WS_KS)
#define GLUb ((bf16*)(ws + WS_GLU))
#define MIXb ((bf16*)(ws + WS_MIX))
#define ACTb ((bf16*)(ws + WS_ACT))
#define Y (out + OY)
__global__ void __launch_bounds__(NWAVES * 64, 2) mk_fwd(Args args) {
    extern __shared__ __attribute__((aligned(16))) unsigned char lds_[];
    LAS unsigned char* lds = (LAS unsigned char*)lds_;
    volatile LAS unsigned* MISC = (volatile LAS unsigned*)(lds + MISC_OFF);
    const int G = gridDim.x, vcu = (G % 8 == 0) ? ((int)blockIdx.x % 8) * (G / 8) + (int)blockIdx.x / 8 : (int)blockIdx.x;
    unsigned char* ws = args.ws; float* out = args.out;
    gu32* ctl = (gu32*)(ws + WS_CTL);
    for (int u = threadIdx.x; u < (ATT_TAB - LDSCTL_OFF) / 4; u += NWAVES * 64) ((LAS unsigned*)(lds + LDSCTL_OFF))[u] = 0u;
    __syncthreads();
    XcdBarrier bar = xcd_barrier_post((unsigned*)(ctl + CW_BAR), MISC + 8);

#ifndef SKIP_P0
    for (int rep = 0; rep < REP_P0; ++rep) {
        if (rep) xcd_barrier(bar);
        int tid0 = threadIdx.x; asm volatile("" : "+v"(tid0));
        const int lane = tid0 & 63, wave = __builtin_amdgcn_readfirstlane(tid0 >> 6);
        LAS float* scr = (LAS float*)(lds + RING_OFF + wave * 16384);
        const int gw = vcu * NWAVES + wave, NGW = G * NWAVES;
        constexpr int I_1 = (D / 64) * (INC / 32), I_PP = (PLE / 64) * (D / 32);
        constexpr int NITEMS = I_1 + I_PP;
        for (int it = gw; it < NITEMS; it += NGW) {
            if (it < I_1) p0_transpose_item<1>(args.in[8], args.in[7], D, INC, W1t, scr, it, lane);
            else p0_transpose_item<0>(args.in[22], nullptr, PLE, D, WPPt, scr, it - I_1, lane);
        }
        for (int m2 = gw; m2 < R / 2; m2 += NGW) {
            f32x4 v[2][4];
#pragma unroll
            for (int rr = 0; rr < 2; ++rr) { const int m = 2 * m2 + rr; const float* xrow = m < RP ? args.in[0] + (size_t)m * D : args.in[1] + (size_t)(m - RP) * D;
                const GAS f32x4* xr = (const GAS f32x4*)xrow + lane;
#pragma unroll
                for (int j = 0; j < 4; ++j) v[rr][j] = xr[64 * j]; }
#pragma unroll
            for (int rr = 0; rr < 2; ++rr) { const int m = 2 * m2 + rr; float s = 0.f;
#pragma unroll
                for (int j = 0; j < 4; ++j) s += (v[rr][j].x * v[rr][j].x + v[rr][j].y * v[rr][j].y) + (v[rr][j].z * v[rr][j].z + v[rr][j].w * v[rr][j].w);
                s = wave_sum(s); if (lane == 0) RX[m] = rsqrtf(s * (1.0f / D) + EPS);
                GAS unsigned long long* o8 = (GAS unsigned long long*)(XB + (size_t)m * D) + lane;
#pragma unroll
                for (int j = 0; j < 4; ++j) o8[64 * j] = (unsigned long long)pk2(v[rr][j].x, v[rr][j].y) | ((unsigned long long)pk2(v[rr][j].z, v[rr][j].w) << 32); }
        }
        for (int m8 = gw; m8 < R / 8; m8 += NGW) {
            const int m = 8 * m8; const float* prow = m < RP ? args.in[2] + (size_t)m * PLE : args.in[3] + (size_t)(m - RP) * PLE;
            const GAS f32x4* pr = (const GAS f32x4*)prow + lane; f32x4 pv[8];
#pragma unroll
            for (int j = 0; j < 8; ++j) pv[j] = pr[64 * j];
            GAS unsigned long long* o8 = (GAS unsigned long long*)(PB + (size_t)m * PLE) + lane;
#pragma unroll
            for (int j = 0; j < 8; ++j) o8[64 * j] = (unsigned long long)pk2(pv[j].x, pv[j].y) | ((unsigned long long)pk2(pv[j].z, pv[j].w) << 32);
        }
    }
#endif
    xcd_barrier(bar);

#ifndef SKIP_P1
    for (int rep = 0; rep < REP_P1; ++rep) {
        if (rep) xcd_barrier(bar);
        pg8::Gemm g{XB, W1t, R, INC, D}; pg8::StaticOrder S; S.init(R, INC, G, (int)blockIdx.x);
        pg8::Epi1 E{RX, args.in[9], args.in[10], Qb, KVP, KVS, GLUb, out};
        pg8::gemm_phase<pg8::Epi1, pg8::StaticOrder, true, true>(lds + RING_OFF, g, S, E);
        { const int c0 = ((R / 256) * (INC / 256)) % G, nwgc = c0 ? G - c0 : G, cc = c0 ? (int)blockIdx.x - c0 : (int)blockIdx.x;
          if (cc >= 0) {
            int tidc = threadIdx.x; asm volatile("" : "+v"(tidc));
            const int lane = tidc & 63, wave = __builtin_amdgcn_readfirstlane(tidc >> 6), head = lane >> 3, dq = lane & 7;
            for (int m2 = cc * NWAVES + wave; m2 < DB * 512; m2 += nwgc * NWAVES) {
                const int b = m2 >> 9, j = m2 & 511, kv = j & 63;
                const GAS f32x4* sk = (const GAS f32x4*)(args.in[4] + (size_t)m2 * 512) + 2 * lane; const GAS f32x4* sv = (const GAS f32x4*)(args.in[5] + (size_t)m2 * 512) + 2 * lane;
                const f32x4 k0 = sk[0], k1 = sk[1], v0 = sv[0], v1 = sv[1];
                unsigned char* tb = KVS + (size_t)(b * 9 + (j >> 6)) * KVT_BYTES + (head >> 2) * 65536 + (head & 3) * 16384;
                *(GAS v4u*)(tb + dq * 1024 + kv * 16) = (v4u){pk2(k0.x, k0.y), pk2(k0.z, k0.w), pk2(k1.x, k1.y), pk2(k1.z, k1.w)};
                *(GAS v4u*)(tb + 8192 + (dq >> 2) * 4096 + (kv >> 4) * 1024 + (kv & 15) * 64 + (dq & 3) * 16) = (v4u){pk2(v0.x, v0.y), pk2(v0.z, v0.w), pk2(v1.x, v1.y), pk2(v1.z, v1.w)};
            }
            for (int p = cc * NWAVES + wave; p < DB * NH; p += nwgc * NWAVES) {
                unsigned char* tb = KVS + (size_t)((p >> 3) * 9 + 8) * KVT_BYTES + ((p & 7) >> 2) * 65536 + (p & 3) * 16384; const v4u z = (v4u){0u, 0u, 0u, 0u};
#pragma unroll
                for (int c2 = 0; c2 < 4; ++c2) *(GAS v4u*)(tb + (2 * c2 + (lane >> 5)) * 1024 + 512 + (lane & 31) * 16) = z;
#pragma unroll
                for (int q = 0; q < 4; ++q) *(GAS v4u*)(tb + 8192 + (q >> 1) * 4096 + (2 + (q & 1)) * 1024 + lane * 16) = z;
            }
          } }
    }
#endif
    xcd_barrier(bar);

#ifndef SKIP_P2
    for (int rep = 0; rep < REP_P2; ++rep) {
        if (rep) xcd_barrier(bar);
        { int tidt = threadIdx.x; asm volatile("" : "+v"(tidt)); const int lane = tidt & 63, wave = __builtin_amdgcn_readfirstlane(tidt >> 6);
          const float* relb = args.in[11] + wave * NREL; LAS float* T = (LAS float*)(lds + ATT_TAB) + wave * 256;
          const float bfar = relb[256];
          for (int x = lane; x < 256; x += 64) { int dd = 191 - x; dd = dd < -128 ? -128 : (dd > 128 ? 128 : dd); T[x] = (relb[dd + 128] - bfar) * LOG2E; } }
        __syncthreads();
        {
            int tid2 = threadIdx.x; asm volatile("" : "+v"(tid2));
            const int lane2 = tid2 & 63, wave2 = __builtin_amdgcn_readfirstlane(tid2 >> 6);
            int qk = 0, q = (int)blockIdx.x & 7;
#define ATT_POP(qq) ((int)__hip_atomic_fetch_add((unsigned*)(ctl + CW_Q + 64 * ((qq) + 8 * rep)), 1u, __ATOMIC_RELAXED, __HIP_MEMORY_SCOPE_AGENT))
#define ATT_DECODE(code, U) do { const int q_ = (int)((code) >> 8), i_ = (int)((code) & 255u); \
                if (i_ < 8) { const int sb = 4 * q_ + (i_ >> 1); U.hg = i_ & 1; U.sample = 1; U.nt = 9; U.c0rel = 8; \
                    U.Qrow = Qb + (size_t)(RP + DS * sb) * 512; U.KV = KVS + (size_t)(sb * 9) * KVT_BYTES; U.Orow = MIXb + (size_t)(RP + DS * sb) * D; } \
                else { const int j = i_ - 8, pi = j < 60 ? 4 + j : 63 - j, bb = q_ >> 1, c0 = 2 * pi;     \
                    U.hg = q_ & 1; U.sample = 0; U.c0rel = c0 < 8 ? c0 : 8; U.nt = U.c0rel + 2; const size_t row0 = (size_t)bb * SEQ + 64 * c0; \
                    U.Qrow = Qb + row0 * 512; U.KV = KVP + (size_t)(bb * 128 + c0 - U.c0rel) * KVT_BYTES; U.Orow = MIXb + row0 * D; } } while (0)
            if (tid2 == 0) { int i = ATT_POP(q); while (i >= N_ATT_Q) { if (++qk == 8) { i = -1; break; } q = ((int)blockIdx.x + qk) & 7; i = ATT_POP(q); }
                MISC[4] = i < 0 ? 0xffffffffu : (unsigned)((q << 8) | i); }
            __syncthreads();
            unsigned code = MISC[4];
            if (code != 0xffffffffu) {
                att::AUnit U; ATT_DECODE(code, U);
                att::bf16x8 qr[2][4];
                att::attn_prefetch(U, lds, wave2, lane2, qr);
                for (;;) {
                    int nraw = 0; if (tid2 == 0) nraw = ATT_POP(q);
#pragma unroll
                    for (int d0 = 0; d0 < 4; ++d0) asm volatile("" : "+v"(qr[0][d0]), "+v"(qr[1][d0]));
                    att::f32x16 o[2][2]; o[0][0] = att::f32x16{}; o[0][1] = att::f32x16{}; o[1][0] = att::f32x16{}; o[1][1] = att::f32x16{}; float lsum[2] = {0.f, 0.f};
                    if (U.sample) att::attn_steps<false>(U, lds, wave2, lane2, qr, o, lsum); else att::attn_steps<true>(U, lds, wave2, lane2, qr, o, lsum);
                    if (tid2 == 0) { int i = nraw; while (i >= N_ATT_Q) { if (++qk == 8) { i = -1; break; } q = ((int)blockIdx.x + qk) & 7; i = ATT_POP(q); }
                        MISC[4] = i < 0 ? 0xffffffffu : (unsigned)((q << 8) | i); }
                    ATT_WAIT_BAR();
                    const unsigned ncode = MISC[4];
                    att::AUnit Un = U;
                    if (ncode != 0xffffffffu) { ATT_DECODE(ncode, Un); att::attn_prefetch(Un, lds, wave2, lane2, qr); }
                    if (U.sample) att::attn_store<false>(U, lds, wave2, lane2, o, lsum); else att::attn_store<true>(U, lds, wave2, lane2, o, lsum);
                    if (ncode == 0xffffffffu) break;
                    U = Un;
                }
                ATT_WAIT_BAR();
            }
#undef ATT_POP
#undef ATT_DECODE
        }
        for (;;) {
            int tid2 = threadIdx.x; asm volatile("" : "+v"(tid2));
            if (tid2 == 0) MISC[4] = __hip_atomic_fetch_add((unsigned*)(ctl + CW_QG + 64 * rep), 1u, __ATOMIC_RELAXED, __HIP_MEMORY_SCOPE_AGENT);
            __syncthreads();
            const int idx = (int)MISC[4];
            __syncthreads();
            if (idx >= N_CONV + N_WCV) break;
            const int lane2 = tid2 & 63, wave2 = __builtin_amdgcn_readfirstlane(tid2 >> 6);
            if (idx < N_CONV) conv_item(idx, GLUb, args.in[6], args.in[12], args.in[13], args.in[14], args.in[15], MIXb, lds, tid2);
            else { const int it = 8 * (idx - N_CONV) + wave2; LAS float* scr = (LAS float*)(lds + RING_OFF + wave2 * 16384);
                if (it < I_WO) p0_transpose_item<0>(args.in[16], nullptr, D, D, WOt, scr, it, lane2);
                else p0_transpose_item<2>(args.in[18], args.in[17], D, 2 * DFF, WGUt, scr, it - I_WO, lane2);
                __syncthreads(); }
        }
    }
#endif
    xcd_barrier(bar);

#ifndef SKIP_P3
    for (int rep = 0; rep < REP_P3; ++rep) {
        if (rep) xcd_barrier(bar);
        pg8::Gemm g{MIXb, WOt, RP, D, D}; pg8::StaticOrder S; S.init(RP, D, G, (int)blockIdx.x);
        pg8::EpiRes<true> E{nullptr, nullptr, XB, SS1};
        const SEpiRes<true> SE{nullptr, XB + (size_t)RP * D, SS1 + (size_t)RP * 16};
        if (blockIdx.x & 1) for (int t = (int)blockIdx.x; t < 256; t += G) sgemm64(MIXb + (size_t)RP * D, WOt, D, t, SE, lds + RING_OFF);
        pg8::gemm_phase<pg8::EpiRes<true>, pg8::StaticOrder, true, true>(lds + RING_OFF, g, S, E);
        if (!(blockIdx.x & 1)) for (int t = (int)blockIdx.x; t < 256; t += G) sgemm64(MIXb + (size_t)RP * D, WOt, D, t, SE, lds + RING_OFF);
    }
#endif
    xcd_barrier(bar);

#ifndef SKIP_P4
    for (int rep = 0; rep < REP_P4; ++rep) {
        if (rep) xcd_barrier(bar);
        { const int c0 = ((R / 256) * (2 * DFF / 256)) % G, nwgc = c0 ? G - c0 : G, cc = c0 ? (int)blockIdx.x - c0 : (int)blockIdx.x;
          if (cc >= 0) {
            const bool wt = (nwgc % 4) == 0; const int k = wt ? cc & 3 : 1, j = wt ? cc >> 2 : cc, per = wt ? nwgc / 4 : nwgc, nslot = wt ? 6 * per : per;
            const int s0 = !wt ? j : (k == 1 ? j : (k == 2 ? per + 2 * j : 3 * per + 3 * j));
            int tidc = threadIdx.x; asm volatile("" : "+v"(tidc));
            const int lane = tidc & 63, wave = __builtin_amdgcn_readfirstlane(tidc >> 6);
            for (int q = 0; q < k; ++q)
            for (int m4 = s0 + q + nslot * wave; m4 < 2 * DB * 120; m4 += nslot * NWAVES) {
                const int kv = m4 >= DB * 120, mm = kv ? m4 - DB * 120 : m4, b = mm / 120, j2 = DS + 4 * (mm % 120);
                const GAS f32x4* src = (const GAS f32x4*)(args.in[4 + kv] + ((size_t)b * 512 + j2) * 512) + lane;
                GAS f32x4* dst = (GAS f32x4*)(out + (kv ? OVS : OKS) + ((size_t)b * 512 + (j2 - DS)) * 512) + lane;
                f32x4 v[8];
#pragma unroll
                for (int i = 0; i < 8; ++i) v[i] = src[64 * i];
#pragma unroll
                for (int i = 0; i < 8; ++i) dst[64 * i] = v[i];
            }
            { LAS float* scr = (LAS float*)(lds + RING_OFF + wave * 16384); constexpr int I_D = (DFF / 64) * (D / 32), I_PG = (D / 64) * (D / 32);
              for (int it = cc * NWAVES + wave; it < I_D + I_PG; it += nwgc * NWAVES) {
                  if (it < I_D) p0_transpose_item<0>(args.in[19], nullptr, DFF, D, WDt, scr, it, lane);
                  else p0_transpose_item<0>(args.in[21], args.in[20], D, D, WPGt, scr, it - I_D, lane); }
              __syncthreads(); }
          } }
        pg8::Gemm g{XB, WGUt, R, 2 * DFF, D}; pg8::StaticOrder S; S.init(R, 2 * DFF, G, (int)blockIdx.x);
        pg8::EpiAct E{SS1, ACTb};
        pg8::gemm_phase<pg8::EpiAct, pg8::StaticOrder, true, true>(lds + RING_OFF, g, S, E);
    }
#endif
    xcd_barrier(bar);

#ifndef SKIP_P5
    {
        pg8::Gemm g{ACTb, WDt, RP, D, DFF}; pg8::StaticOrder S; S.init(RP, D, G, (int)blockIdx.x);
        pg8::EpiRes<true> E{nullptr, nullptr, XB, SS2};
        const SEpiRes<true> SE{nullptr, XB + (size_t)RP * D, SS2 + (size_t)RP * 16};
        if (blockIdx.x & 1) for (int t = (int)blockIdx.x; t < 256; t += G) sgemm64(ACTb + (size_t)RP * DFF, WDt, DFF, t, SE, lds + RING_OFF);
        pg8::gemm_phase<pg8::EpiRes<true>, pg8::StaticOrder, true, true>(lds + RING_OFF, g, S, E);
        if (!(blockIdx.x & 1)) for (int t = (int)blockIdx.x; t < 256; t += G) sgemm64(ACTb + (size_t)RP * DFF, WDt, DFF, t, SE, lds + RING_OFF);
    }
#endif
    xcd_barrier(bar);

#ifndef SKIP_P6
    {
        pg8::Gemm g{XB, WPGt, RP, D, D}; pg8::StaticOrder S; S.init(RP, D, G, (int)blockIdx.x);
        pg8::EpiFinal E{SS2, PPb, XB, Y};
        const SEpiFinal SE{SS2 + (size_t)RP * 16, PPb + (size_t)RP * D, XB + (size_t)RP * D, Y + (size_t)RP * D};
        pg8::Gemm gp{PB, WPPt, RP, D, PLE}; pg8::EpiPP EP{PPb}; const SEpiPP SP{PPb + (size_t)RP * D};
        if (blockIdx.x & 1) for (int t = (int)blockIdx.x; t < 256; t += G) { sgemm64(PB + (size_t)RP * PLE, WPPt, PLE, t, SP, lds + RING_OFF); sgemm64(XB + (size_t)RP * D, WPGt, D, t, SE, lds + RING_OFF); }
        pg8::gemm_phase<pg8::EpiPP, pg8::StaticOrder, true, true>(lds + RING_OFF, gp, S, EP);
        pg8::gemm_phase<pg8::EpiFinal, pg8::StaticOrder, true, true>(lds + RING_OFF, g, S, E);
        if (!(blockIdx.x & 1)) for (int t = (int)blockIdx.x; t < 256; t += G) { sgemm64(PB + (size_t)RP * PLE, WPPt, PLE, t, SP, lds + RING_OFF); sgemm64(XB + (size_t)RP * D, WPGt, D, t, SE, lds + RING_OFF); }
    }
#endif
}

extern "C" void kernel_launch(void* const* d_in, const int* in_sizes, int n_in, void* d_out, int out_size, void* d_ws, size_t ws_size, hipStream_t stream) {
    static int grid = 0;
    if (grid == 0) {
        if (n_in != 23 || ws_size < WS_END) { fprintf(stderr, "kernel_launch: unexpected shapes (n_in %d, ws %zu)\n", n_in, ws_size); grid = -1; return; }
        int dev = 0, cus = 0, per_cu = 0;
        if (hipGetDevice(&dev) != hipSuccess || hipDeviceGetAttribute(&cus, hipDeviceAttributeMultiprocessorCount, dev) != hipSuccess) { grid = -1; return; }
        if (hipFuncSetAttribute((const void*)mk_fwd, hipFuncAttributeMaxDynamicSharedMemorySize, LDS_BYTES) != hipSuccess) { fprintf(stderr, "kernel_launch: hipFuncSetAttribute failed\n"); grid = -1; return; }
        if (hipOccupancyMaxActiveBlocksPerMultiprocessor(&per_cu, (const void*)mk_fwd, NWAVES * 64, LDS_BYTES) != hipSuccess || per_cu < 1) { fprintf(stderr, "kernel_launch: occupancy query says %d blocks per CU\n", per_cu); }
        (void)hipGetLastError();
        grid = cus;
    }
    if (grid < 0) return;
    if (hipMemsetAsync((char*)d_ws + WS_CTL, 0, CTL_ZERO_BYTES, stream) != hipSuccess) return;
    Args a{};
    for (int i = 0; i < 23; ++i) a.in[i] = (const float*)d_in[i];
    a.out = (float*)d_out; a.ws = (unsigned char*)d_ws;
    hipLaunchKernelGGL(mk_fwd, dim3(grid), dim3(NWAVES * 64), LDS_BYTES, stream, a);
}
```

```cpp
#include <hip/hip_runtime.h>
#include <cstdio>
#include <cstdint>
constexpr int D = 1024, SEQ = 8192, NB = 4, DB = 32, DS = 32;
constexpr int RP = NB * SEQ, RS = DB * DS, R = RP + RS;
constexpr int INC = 2560, DFF = 2816, PLE = 256, NH = 8, HD = 64, CW = 512;
constexpr int NREL = 257, CONVW = 31, CH = 30, KSROWS = 576;
constexpr int KVT_BYTES = 131072;
constexpr float EPS = 1e-6f, LOG2E = 1.4426950408889634f, QSCALE = 0.125f * LOG2E;
constexpr size_t OY = 0, OKP = (size_t)R * D, OVP = OKP + (size_t)NB * 512 * 512, OCP = OVP + (size_t)NB * 512 * 512,
                 OKS = OCP + (size_t)NB * CH * CW, OVS = OKS + (size_t)DB * 512 * 512, OCS = OVS + (size_t)DB * 512 * 512;
namespace pg8 {
#define PG8_LAS __attribute__((address_space(3)))
typedef unsigned short bf16_t;
typedef short bf16x8 __attribute__((ext_vector_type(8)));
typedef float f32x4 __attribute__((ext_vector_type(4)));
typedef unsigned u32x4 __attribute__((ext_vector_type(4)));
constexpr int BM = 256, BK = 64, HALF = 128, HTB = HALF * BK * 2  , STAGE_BYTES = 8 * HTB, NXCD = 8, WGM = 8;

__host__ __device__ __forceinline__ int lds_byte(int r, int c) { const int st = (r >> 4) * 2 + (c >> 5), rr = r & 15, cc = c & 31, ob = rr * 64 + cc * 2; return st * 1024 + (ob ^ (((ob >> 9) & 1) << 5)); }
__host__ __device__ __forceinline__ void stage_rc(int b, int& R, int& C) { const int st = b / 1024, sb = b % 1024, swz = sb ^ (((sb >> 9) & 1) << 5); R = (st >> 1) * 16 + swz / 64; C = (st & 1) * 32 + (swz % 64) / 2; }
__host__ __device__ __forceinline__ int perm32(int rho) { const int n = rho >> 4, i = rho & 15; return 8 * (i >> 2) + 4 * n + (i & 3); }

struct Unit { int pm, pn; };
struct Gemm { const bf16_t* A; const bf16_t* Bt; int M, N, K; };

struct StaticOrder {
    int nM, nN, nwg, G, c;
    __host__ __device__ void init(int M, int N, int G_, int c_) { nM = M / BM; nN = N / BM; nwg = nM * nN; G = G_; c = c_; }
    __host__ __device__ bool next(int i, Unit& u) const {
        const long L = (long)i * G + c; if (L >= nwg) return false;
        int wgid = (int)L; { const int q = nwg / NXCD, r = nwg % NXCD, xcd = wgid % NXCD, off = wgid / NXCD; wgid = (xcd < r ? xcd * (q + 1) : r * (q + 1) + (xcd - r) * q) + off; }
        const int nig = WGM * nN, gid = wgid / nig, fm = gid * WGM, gsz = (nM - fm) < WGM ? (nM - fm) : WGM;
        u.pm = fm + ((wgid % nig) % gsz); u.pn = (wgid % nig) / gsz; return true;
    }
    __device__ __forceinline__ void a_ready(const Unit&) const {}
    __device__ __forceinline__ void done(const Unit&) const {}
};

__device__ __forceinline__ unsigned cvt_pk_bf16(float lo, float hi) { unsigned r; asm volatile("v_cvt_pk_bf16_f32 %0, %1, %2" : "=v"(r) : "v"(lo), "v"(hi)); return r; }
typedef float f32x2 __attribute__((ext_vector_type(2)));typedef unsigned u32x2 __attribute__((ext_vector_type(2)));
__device__ __forceinline__ u32x4 pack8(const f32x4 a, const f32x4 b) { u32x4 w; w.x = cvt_pk_bf16(a[0], a[1]); w.y = cvt_pk_bf16(a[2], a[3]); w.z = cvt_pk_bf16(b[0], b[1]); w.w = cvt_pk_bf16(b[2], b[3]); return w; }
__device__ __forceinline__ float sigm(float x) { return __builtin_amdgcn_rcpf(1.0f + __builtin_amdgcn_exp2f(-x * LOG2E)); }
__device__ __forceinline__ float quad_sum(float s) { s += __shfl_xor(s, 16); s += __shfl_xor(s, 32); return s; }
struct Epi1 {
    static constexpr bool PERM = true, AFTER_DRAIN = false;
    const float* rx; const float* qg; const float* kg; bf16_t* Q; unsigned char* KVP; unsigned char* KVS; bf16_t* GLU; float* out;
    __device__ __forceinline__ void operator()(const f32x4 (&acc)[2][2][4][2], const Unit& u, int wr, int wc, int fr, int fq) const {
        const int pn = u.pn, rowt = u.pm * BM + wr * 64 + fr;
        float rxv[2][4];
#pragma unroll
        for (int ai = 0; ai < 2; ++ai)
#pragma unroll
            for (int m = 0; m < 4; ++m) rxv[ai][m] = rx[rowt + ai * HALF + m * 16];
        if (pn < 6) {
            const int sec = pn >> 1, col = (4 * (pn & 1) + wc) * 64 + 8 * fq;
            f32x4 g[2][2];
#pragma unroll
            for (int bj = 0; bj < 2; ++bj)
#pragma unroll
                for (int n = 0; n < 2; ++n) { g[bj][n] = (f32x4){1.f, 1.f, 1.f, 1.f};
                    if (sec == 0) g[bj][n] = *(const f32x4*)(qg + 32 * bj + 8 * fq + 4 * n) * QSCALE;
                    if (sec == 1) g[bj][n] = *(const f32x4*)(kg + 32 * bj + 8 * fq + 4 * n); }
#pragma unroll
            for (int ai = 0; ai < 2; ++ai)
#pragma unroll
                for (int m = 0; m < 4; ++m) {
                    const int row = rowt + ai * HALF + m * 16; const float r = rxv[ai][m];
                    f32x4 z[2][2];
#pragma unroll
                    for (int bj = 0; bj < 2; ++bj)
#pragma unroll
                        for (int n = 0; n < 2; ++n) z[bj][n] = acc[ai][bj][m][n] * r;
                    if (sec < 2) {
                        float ss = 0.f;
#pragma unroll
                        for (int bj = 0; bj < 2; ++bj)
#pragma unroll
                            for (int n = 0; n < 2; ++n) { const f32x4 q = z[bj][n] * z[bj][n]; ss += (q[0] + q[1]) + (q[2] + q[3]); }
                        ss = quad_sum(ss);
                        const float rn = rsqrtf(ss * (1.0f / 64.0f) + EPS);
#pragma unroll
                        for (int bj = 0; bj < 2; ++bj)
#pragma unroll
                            for (int n = 0; n < 2; ++n) z[bj][n] = z[bj][n] * rn * g[bj][n];
                    }
                    const int sb = (row - RP) >> 5, si = (row - RP) & 31;
                    float* fo = nullptr;
                    if (sec == 0) {
#pragma unroll
                        for (int bj = 0; bj < 2; ++bj) *(u32x4*)(Q + (size_t)row * 512 + col + 32 * bj) = pack8(z[bj][0], z[bj][1]);
                    } else {
                        unsigned char* tb; int kv;
                        if (row < RP) { tb = KVP + (size_t)(row >> 6) * KVT_BYTES; kv = row & 63;
                            const int t = row & (SEQ - 1); if (t >= SEQ - 512) fo = out + OKP + (size_t)(sec - 1) * (OVP - OKP) + ((size_t)((row >> 13) * 512 + (t - (SEQ - 512)))) * 512 + col; }
                        else { tb = KVS + (size_t)(sb * 9 + 8) * KVT_BYTES; kv = si; fo = out + OKS + (size_t)(sec - 1) * (OVS - OKS) + ((size_t)(sb * 512 + 480 + si)) * 512 + col; }
                        tb += (pn & 1) * 65536 + wc * 16384;
                        const int ok = fq * 1024 + kv * 16, ov = 8192 + (kv >> 4) * 1024 + (kv & 15) * 64 + fq * 16;
#pragma unroll
                        for (int bj = 0; bj < 2; ++bj) *(u32x4*)(tb + (sec == 1 ? ok + bj * 4096 : ov + bj * 4096)) = pack8(z[bj][0], z[bj][1]);
                    }
                    if (fo) {
#pragma unroll
                        for (int bj = 0; bj < 2; ++bj)
#pragma unroll
                            for (int n = 0; n < 2; ++n) *(f32x4*)(fo + 32 * bj + 4 * n) = z[bj][n]; }
                }
        } else {
            const int col = 128 * (pn - 6) + 32 * wc + 8 * fq;
#pragma unroll
            for (int ai = 0; ai < 2; ++ai)
#pragma unroll
                for (int m = 0; m < 4; ++m) {
                    const int row = rowt + ai * HALF + m * 16; const float r = rxv[ai][m];
                    f32x4 gl[2];
#pragma unroll
                    for (int n = 0; n < 2; ++n) { const f32x4 a = acc[ai][0][m][n] * r, b = acc[ai][1][m][n] * r;
#pragma unroll
                        for (int e = 0; e < 4; ++e) gl[n][e] = a[e] * sigm(b[e]); }
                    *(u32x4*)(GLU + (size_t)row * 512 + col) = pack8(gl[0], gl[1]);
                    float* fo = nullptr;
                    if (row < RP) { const int t = row & (SEQ - 1); if (t >= SEQ - CH) fo = out + OCP + ((size_t)((row >> 13) * CH + (t - (SEQ - CH)))) * CW + col; }
                    else { const int sb = (row - RP) >> 5, si = (row - RP) & 31; if (si >= DS - CH) fo = out + OCS + ((size_t)(sb * CH + (si - (DS - CH)))) * CW + col; }
                    if (fo) { *(f32x4*)(fo) = gl[0]; *(f32x4*)(fo + 4) = gl[1]; }
                }
        }
    }
};
struct EpiPP {
    static constexpr bool PERM = true, AFTER_DRAIN = false;
    bf16_t* O;
    __device__ __forceinline__ void operator()(const f32x4 (&acc)[2][2][4][2], const Unit& u, int wr, int wc, int fr, int fq) const {
        const int rowt = u.pm * BM + wr * 64 + fr, col = u.pn * BM + 32 * wc + 8 * fq;
#pragma unroll
        for (int ai = 0; ai < 2; ++ai)
#pragma unroll
            for (int m = 0; m < 4; ++m) { bf16_t* rowp = O + (size_t)(rowt + ai * HALF + m * 16) * D + col;
#pragma unroll
                for (int bj = 0; bj < 2; ++bj) *(u32x4*)(rowp + bj * HALF) = pack8(acc[ai][bj][m][0], acc[ai][bj][m][1]); }
    }
};
__device__ __forceinline__ f32x4 bf_lo4(const u32x4 w) { return (f32x4){__uint_as_float(w.x << 16), __uint_as_float(w.x & 0xffff0000u), __uint_as_float(w.y << 16), __uint_as_float(w.y & 0xffff0000u)}; }
__device__ __forceinline__ f32x4 bf_hi4(const u32x4 w) { return (f32x4){__uint_as_float(w.z << 16), __uint_as_float(w.z & 0xffff0000u), __uint_as_float(w.w << 16), __uint_as_float(w.w & 0xffff0000u)}; }
template <bool BF> struct EpiRes {
    static constexpr bool PERM = true, AFTER_DRAIN = false;
    const float* bp; const float* bs; bf16_t* HB; float* SS;
    __device__ __forceinline__ void operator()(const f32x4 (&acc)[2][2][4][2], const Unit& u, int wr, int wc, int fr, int fq) const {
        const int rowt = u.pm * BM + wr * 64 + fr, col = u.pn * BM + 32 * wc + 8 * fq;
        f32x4 bv[2][2][2];
        auto ldbase = [&](int i, f32x4 (&d)[2][2]) {
            const int row = rowt + (i >> 2) * HALF + (i & 3) * 16;
            if (BF) { const bf16_t* hrow = HB + (size_t)row * D + col;
#pragma unroll
                for (int bj = 0; bj < 2; ++bj) { const u32x4 w = *(const u32x4*)(hrow + bj * HALF); d[bj][0] = bf_lo4(w); d[bj][1] = bf_hi4(w); } }
            else { const float* brow = (row < RP ? bp + (size_t)row * D : bs + (size_t)(row - RP) * D) + col;
#pragma unroll
                for (int bj = 0; bj < 2; ++bj) { d[bj][0] = *(const f32x4*)(brow + bj * HALF); d[bj][1] = *(const f32x4*)(brow + bj * HALF + 4); } } };
        ldbase(0, bv[0]);
#pragma unroll
        for (int i = 0; i < 8; ++i) {
            const int ai = i >> 2, m = i & 3, row = rowt + ai * HALF + m * 16;
            if (i + 1 < 8) ldbase(i + 1, bv[(i + 1) & 1]);
            bf16_t* hrow = HB + (size_t)row * D + col;
            float ss = 0.f;
#pragma unroll
            for (int bj = 0; bj < 2; ++bj) {
                const f32x4 v0 = bv[i & 1][bj][0] + acc[ai][bj][m][0], v1 = bv[i & 1][bj][1] + acc[ai][bj][m][1];
                *(u32x4*)(hrow + bj * HALF) = pack8(v0, v1);
                const f32x4 q0 = v0 * v0, q1 = v1 * v1; ss += ((q0[0] + q0[1]) + (q0[2] + q0[3])) + ((q1[0] + q1[1]) + (q1[2] + q1[3]));
            }
            ss = quad_sum(ss);
            if (fq == 0) SS[(size_t)row * 16 + 4 * u.pn + wc] = ss;
        }
    }
};
__device__ __forceinline__ float row_rs(const float* SS, int row, int fq) {
    const f32x4 s4 = *(const f32x4*)(SS + (size_t)row * 16 + 4 * fq);
    return rsqrtf(quad_sum((s4[0] + s4[1]) + (s4[2] + s4[3])) * (1.0f / D) + EPS);
}
struct EpiAct {
    static constexpr bool PERM = true, AFTER_DRAIN = false;
    const float* SS; bf16_t* ACT;
    __device__ __forceinline__ void operator()(const f32x4 (&acc)[2][2][4][2], const Unit& u, int wr, int wc, int fr, int fq) const {
        const int rowt = u.pm * BM + wr * 64 + fr, col = 128 * u.pn + 32 * wc + 8 * fq;
        float rv[2][4];
#pragma unroll
        for (int ai = 0; ai < 2; ++ai)
#pragma unroll
            for (int m = 0; m < 4; ++m) rv[ai][m] = row_rs(SS, rowt + ai * HALF + m * 16, fq);
#pragma unroll
        for (int ai = 0; ai < 2; ++ai)
#pragma unroll
            for (int m = 0; m < 4; ++m) {
                const int row = rowt + ai * HALF + m * 16; const float r = rv[ai][m];
                f32x4 v[2];
#pragma unroll
                for (int n = 0; n < 2; ++n) { const f32x4 g = acc[ai][0][m][n] * r, up = acc[ai][1][m][n] * r;
#pragma unroll
                    for (int e = 0; e < 4; ++e) v[n][e] = g[e] * sigm(g[e]) * up[e]; }
                *(u32x4*)(ACT + (size_t)row * DFF + col) = pack8(v[0], v[1]);
            }
    }
};
struct EpiFinal {
    static constexpr bool PERM = true, AFTER_DRAIN = false;
    const float* SS; const bf16_t* PP; const bf16_t* HB; float* Y;
    __device__ __forceinline__ void operator()(const f32x4 (&acc)[2][2][4][2], const Unit& u, int wr, int wc, int fr, int fq) const {
        const int rowt = u.pm * BM + wr * 64 + fr, col = u.pn * BM + 32 * wc + 8 * fq;
        float rv[2][4];
#pragma unroll
        for (int ai = 0; ai < 2; ++ai)
#pragma unroll
            for (int m = 0; m < 4; ++m) rv[ai][m] = row_rs(SS, rowt + ai * HALF + m * 16, fq);
        u32x4 pwv[2][2], hwv[2][2];
        auto ld = [&](int i, u32x4 (&p)[2], u32x4 (&h)[2]) { const size_t o = (size_t)(rowt + (i >> 2) * HALF + (i & 3) * 16) * D + col;
#pragma unroll
            for (int bj = 0; bj < 2; ++bj) { p[bj] = *(const u32x4*)(PP + o + bj * HALF); h[bj] = *(const u32x4*)(HB + o + bj * HALF); } };
        ld(0, pwv[0], hwv[0]);
#pragma unroll
        for (int i = 0; i < 8; ++i) {
            const int ai = i >> 2, m = i & 3, row = rowt + ai * HALF + m * 16; const float r = rv[ai][m];
            if (i + 1 < 8) ld(i + 1, pwv[(i + 1) & 1], hwv[(i + 1) & 1]);
#pragma unroll
            for (int bj = 0; bj < 2; ++bj) {
                const size_t o = (size_t)row * D + col + bj * HALF;
                const u32x4 pw = pwv[i & 1][bj], hw = hwv[i & 1][bj];
                const f32x4 a0 = acc[ai][bj][m][0] * r, a1 = acc[ai][bj][m][1] * r, p0 = bf_lo4(pw), p1 = bf_hi4(pw);
                f32x4 h0 = bf_lo4(hw), h1 = bf_hi4(hw);
#pragma unroll
                for (int e2 = 0; e2 < 4; ++e2) { h0[e2] += sigm(a0[e2]) * p0[e2]; h1[e2] += sigm(a1[e2]) * p1[e2]; }
                *(f32x4*)(Y + o) = h0; *(f32x4*)(Y + o + 4) = h1;
            }
        }
    }
};

template <class Epi, class Sched, bool ALIGN_EPI = false, bool SP2 = false>
__device__ __forceinline__ void gemm_phase(PG8_LAS unsigned char* lds, const Gemm g, const Sched& S, const Epi& E) {
    int tid_ = threadIdx.x; asm volatile("" : "+v"(tid_));
    const int tid = tid_, wid = __builtin_amdgcn_readfirstlane(tid >> 6), lane = tid & 63, wr = wid >> 2, wc = wid & 3, fr = lane & 15, fq = lane >> 4;
    int K_ = g.K; asm volatile("" : "+s"(K_));
    const int K = K_, nt = K / BK;
    unsigned voffA[2], voffB[2];
#pragma unroll
    for (int i = 0; i < 2; ++i) { int R, C; stage_rc(tid * 16 + i * 8192, R, C); const int Rb = Epi::PERM ? ((R & ~31) + perm32(R & 31)) : R;
        voffA[i] = (unsigned)(R * K + C) * 2u; voffB[i] = (unsigned)(Rb * K + C) * 2u; }
    const size_t kstep = (size_t)(BK * 2);
    const size_t hstep = (size_t)HALF * K * 2;
    const size_t tstep = 2 * hstep;
    const unsigned ldsw = (unsigned)wid * 1024u;
    const int aoff = lds_byte(wr * 64 + fr, fq * 8), boff = lds_byte(wc * 32 + fr, fq * 8);
#define PG8_SA(b, h) (((b) * 2 + (h)) * HTB)
#define PG8_SB(b, h) ((4 + (b) * 2 + (h)) * HTB)
#define PG8_STAGE(bufoff, gbase, voff) do { _Pragma("unroll") for (int _i = 0; _i < 2; ++_i) \
        __builtin_amdgcn_global_load_lds((const unsigned*)((const char*)(gbase) + (voff)[_i]), (PG8_LAS unsigned*)(lds + (bufoff) + ldsw + _i * 8192), 16, 0, 0); } while (0)
#define PG8_LDA(dst, b, h) do { _Pragma("unroll") for (int m = 0; m < 4; ++m) _Pragma("unroll") for (int k = 0; k < 2; ++k) dst[m][k] = *(const PG8_LAS bf16x8*)(lds + PG8_SA(b, h) + aoff + m * 2048 + k * 1024); } while (0)
#define PG8_LDB(dst, b, h) do { _Pragma("unroll") for (int n = 0; n < 2; ++n) _Pragma("unroll") for (int k = 0; k < 2; ++k) dst[n][k] = *(const PG8_LAS bf16x8*)(lds + PG8_SB(b, h) + boff + n * 2048 + k * 1024); } while (0)
#define PG8_MMA(ai, bj, At, Bt) do { __builtin_amdgcn_s_setprio(1); _Pragma("unroll") for (int m = 0; m < 4; ++m) _Pragma("unroll") for (int n = 0; n < 2; ++n) _Pragma("unroll") for (int k = 0; k < 2; ++k) \
        acc[ai][bj][m][n] = __builtin_amdgcn_mfma_f32_16x16x32_bf16(Bt[n][k], At[m][k], acc[ai][bj][m][n], 0, 0, 0); __builtin_amdgcn_s_setprio(0); } while (0)
#define PG8_WAIT_V(n) asm volatile("s_waitcnt vmcnt(" #n ")" ::: "memory")
#define PG8_WAIT_L(n) asm volatile("s_waitcnt lgkmcnt(" #n ")" ::: "memory")
#define PG8_BAR __builtin_amdgcn_s_barrier()
#define PG8_SCHED __builtin_amdgcn_sched_barrier(0)
    Unit cur, nxt; int ui = 0;
    if (!S.next(0, cur)) return;
    f32x4 acc[2][2][4][2];
#pragma unroll
    for (int a = 0; a < 2; ++a)
#pragma unroll
        for (int b = 0; b < 2; ++b)
#pragma unroll
            for (int m = 0; m < 4; ++m)
#pragma unroll
                for (int n = 0; n < 2; ++n) acc[a][b][m][n] = (f32x4){0.f, 0.f, 0.f, 0.f};
    bf16x8 At[4][2], B0[2][2], B1[2][2];
    const char* cA = (const char*)g.A + (size_t)cur.pm * tstep; const char* cB = (const char*)g.Bt + (size_t)cur.pn * tstep;
    S.a_ready(cur);
    if constexpr (SP2) {
        PG8_STAGE(PG8_SB(0, 0), cB, voffB); PG8_STAGE(PG8_SB(0, 1), cB + hstep, voffB); PG8_STAGE(PG8_SA(0, 0), cA, voffA); PG8_STAGE(PG8_SA(0, 1), cA + hstep, voffA);
        if (wr == 1) PG8_BAR;
        PG8_WAIT_V(2); PG8_BAR;
        PG8_STAGE(PG8_SB(1, 0), cB + kstep, voffB); PG8_STAGE(PG8_SA(1, 0), cA + kstep, voffA); PG8_STAGE(PG8_SB(1, 1), cB + hstep + kstep, voffB);
        PG8_WAIT_V(6); PG8_BAR;
    } else {
        PG8_STAGE(PG8_SB(0, 0), cB, voffB); PG8_STAGE(PG8_SA(0, 0), cA, voffA); PG8_STAGE(PG8_SB(0, 1), cB + hstep, voffB); PG8_STAGE(PG8_SA(0, 1), cA + hstep, voffA);
        if (wr == 1) PG8_BAR;
        PG8_WAIT_V(4); PG8_BAR;
        PG8_STAGE(PG8_SB(1, 0), cB + kstep, voffB); PG8_STAGE(PG8_SA(1, 0), cA + kstep, voffA); PG8_STAGE(PG8_SB(1, 1), cB + hstep + kstep, voffB);
        PG8_WAIT_V(6); PG8_BAR;
    }
    for (;;) {
        const bool has_next = S.next(ui + 1, nxt);
        const char* nA = has_next ? (const char*)g.A + (size_t)nxt.pm * tstep : cA; const char* nB = has_next ? (const char*)g.Bt + (size_t)nxt.pn * tstep : cB;
        for (int t = 0; t < nt; t += 2) {
            const bool last = (t == nt - 2);
            const char* a1 = cA + (size_t)(t + 1) * kstep;
            const char* a2 = last ? nA : cA + (size_t)(t + 2) * kstep; const char* b2 = last ? nB : cB + (size_t)(t + 2) * kstep;
            const char* a3 = a2 + kstep; const char* b3 = b2 + kstep;
            if (last && has_next) S.a_ready(nxt);
            if constexpr (SP2) {
            PG8_LDB(B0, 0, 0); PG8_LDB(B1, 0, 1); PG8_SCHED; PG8_LDA(At, 0, 0); PG8_STAGE(PG8_SA(1, 1), a1 + hstep, voffA);
            PG8_WAIT_V(8); PG8_WAIT_L(0); PG8_BAR; PG8_MMA(0, 0, At, B0); PG8_MMA(0, 1, At, B1); PG8_BAR; PG8_SCHED;
            PG8_LDA(At, 0, 1); PG8_STAGE(PG8_SB(0, 0), b2, voffB); PG8_STAGE(PG8_SB(0, 1), b2 + hstep, voffB); PG8_STAGE(PG8_SA(0, 0), a2, voffA);
            PG8_WAIT_V(8); PG8_WAIT_L(0); PG8_BAR; PG8_MMA(1, 0, At, B0); PG8_MMA(1, 1, At, B1); PG8_BAR; PG8_SCHED;
            PG8_LDB(B0, 1, 0); PG8_LDB(B1, 1, 1); PG8_SCHED; PG8_LDA(At, 1, 0); PG8_STAGE(PG8_SA(0, 1), a2 + hstep, voffA);
            PG8_WAIT_V(8); PG8_WAIT_L(0); PG8_BAR; PG8_MMA(0, 0, At, B0); PG8_MMA(0, 1, At, B1); PG8_BAR; PG8_SCHED;
            PG8_LDA(At, 1, 1); PG8_STAGE(PG8_SB(1, 0), b3, voffB); PG8_STAGE(PG8_SB(1, 1), b3 + hstep, voffB); PG8_STAGE(PG8_SA(1, 0), a3, voffA);
            PG8_WAIT_V(8); PG8_WAIT_L(0); PG8_BAR; PG8_MMA(1, 0, At, B0); PG8_MMA(1, 1, At, B1); PG8_BAR; PG8_SCHED;
            } else {
            PG8_LDB(B0, 0, 0); PG8_SCHED; PG8_LDA(At, 0, 0); PG8_STAGE(PG8_SA(1, 1), a1 + hstep, voffA);
            PG8_WAIT_L(8); PG8_BAR; PG8_WAIT_L(0); PG8_MMA(0, 0, At, B0); PG8_BAR; PG8_SCHED;
            PG8_LDB(B1, 0, 1); PG8_STAGE(PG8_SB(0, 0), b2, voffB);
            PG8_BAR; PG8_WAIT_L(0); PG8_MMA(0, 1, At, B1); PG8_BAR;
            PG8_LDA(At, 0, 1); PG8_STAGE(PG8_SA(0, 0), a2, voffA);
            PG8_BAR; PG8_WAIT_L(0); PG8_MMA(1, 0, At, B0); PG8_BAR; PG8_SCHED;
            PG8_STAGE(PG8_SB(0, 1), b2 + hstep, voffB);
            PG8_WAIT_V(6); PG8_BAR; PG8_MMA(1, 1, At, B1); PG8_BAR;
            PG8_LDB(B0, 1, 0); PG8_SCHED; PG8_LDA(At, 1, 0); PG8_STAGE(PG8_SA(0, 1), a2 + hstep, voffA);
            PG8_WAIT_L(8); PG8_BAR; PG8_WAIT_L(0); PG8_MMA(0, 0, At, B0); PG8_BAR; PG8_SCHED;
            PG8_LDB(B1, 1, 1); PG8_STAGE(PG8_SB(1, 0), b3, voffB);
            PG8_BAR; PG8_WAIT_L(0); PG8_MMA(0, 1, At, B1); PG8_BAR;
            PG8_LDA(At, 1, 1); PG8_STAGE(PG8_SA(1, 0), a3, voffA);
            PG8_BAR; PG8_WAIT_L(0); PG8_MMA(1, 0, At, B0); PG8_BAR; PG8_SCHED;
            PG8_STAGE(PG8_SB(1, 1), b3 + hstep, voffB);
            PG8_WAIT_V(6); PG8_BAR; PG8_MMA(1, 1, At, B1); PG8_BAR;
            }
        }
        if constexpr (ALIGN_EPI) { if (wr == 0) PG8_BAR; }
        if constexpr (!Epi::AFTER_DRAIN) { E(acc, cur, wr, wc, fr, fq); S.done(cur); }
        if (!has_next) break;
#pragma unroll
        for (int a = 0; a < 2; ++a)
#pragma unroll
            for (int b = 0; b < 2; ++b)
#pragma unroll
                for (int m = 0; m < 4; ++m)
#pragma unroll
                    for (int n = 0; n < 2; ++n) acc[a][b][m][n] = (f32x4){0.f, 0.f, 0.f, 0.f};
        cur = nxt; cA = nA; cB = nB; ++ui;
        if constexpr (ALIGN_EPI) { if (wr == 1) PG8_BAR; }
    }
    PG8_WAIT_V(0);
    if constexpr (!ALIGN_EPI) { if (wr == 0) PG8_BAR; }
    PG8_BAR;
    if constexpr (Epi::AFTER_DRAIN) { E.fused(acc, cur, wr, wc, fr, fq, lds, wid, lane); S.done(cur); }
#undef PG8_SA
#undef PG8_SB
#undef PG8_STAGE
#undef PG8_LDA
#undef PG8_LDB
#undef PG8_MMA
#undef PG8_WAIT_V
#undef PG8_WAIT_L
#undef PG8_BAR
#undef PG8_SCHED
}
}
#define GAS __attribute__((address_space(1)))
#define LAS __attribute__((address_space(3)))
typedef unsigned short bf16;
typedef unsigned v4u __attribute__((ext_vector_type(4)));
typedef float f32x4 __attribute__((ext_vector_type(4)));
typedef short bf16x8 __attribute__((ext_vector_type(8)));
typedef GAS unsigned gu32;
typedef GAS unsigned long long gu64;
#define RLX_AGENT __ATOMIC_RELAXED, __HIP_MEMORY_SCOPE_AGENT
#define LDS_WAIT() asm volatile("s_waitcnt lgkmcnt(0)" ::: "memory")
#define VM_WAIT() asm volatile("s_waitcnt vmcnt(0)" ::: "memory")
__device__ __forceinline__ unsigned long long rt() { return __builtin_amdgcn_s_memrealtime(); }
__device__ __forceinline__ unsigned f2bf(float f) { unsigned u = __builtin_bit_cast(unsigned, f); return (u + 0x7fffu + ((u >> 16) & 1u)) >> 16; }
__device__ __forceinline__ unsigned pk2(float lo, float hi) { return f2bf(lo) | (f2bf(hi) << 16); }
#define XB_TMO      128
#define XB_XCNT(j)  (256  + 64 * (j))
#define XB_XSUB(j)  (1280 + 64 * (j))
#define XB_XGEN(j)  (2304 + 64 * (j))
#define XB_TOP      3328
#define XB_TOPGEN   3392
#define XCD_BAR_WORDS 3456
#define XB_SPIN_CAP (1u << 18)

__device__ __forceinline__ unsigned xb_ld(unsigned* p)              { return __hip_atomic_load(p, __ATOMIC_RELAXED, __HIP_MEMORY_SCOPE_AGENT); }
__device__ __forceinline__ unsigned xb_add(unsigned* p, unsigned v) { return __hip_atomic_fetch_add(p, v, __ATOMIC_RELAXED, __HIP_MEMORY_SCOPE_AGENT); }
__device__ __forceinline__ unsigned xb_xcc_id() { return (unsigned)__builtin_amdgcn_s_getreg((3 << 11) | 20) & 0xFu; }
#define XB_SPIN(cond, bar) do { unsigned _sp = 0; while (cond) { __builtin_amdgcn_s_sleep(1); \
    if ((++_sp & 255u) == 0u) { if (xb_ld(&(bar)[XB_TMO])) break; if (_sp > XB_SPIN_CAP) { atomicAdd(&(bar)[XB_TMO], 1u); break; } } } } while (0)

struct XcdBarrier {
    unsigned* bar; unsigned x;
    volatile LAS unsigned* st;
};

__device__ __forceinline__ XcdBarrier xcd_barrier_post(unsigned* bar, volatile LAS unsigned* st) {
    XcdBarrier b; b.bar = bar; b.x = xb_xcc_id(); b.st = st;
    if (threadIdx.x == 0) (void)xb_add(&bar[XB_XCNT(b.x)], 1u);
    return b;
}
__device__ __forceinline__ void xcd_barrier_complete(unsigned* bar, unsigned x, unsigned& nloc, unsigned& nx) {
    const unsigned G = gridDim.x * gridDim.y * gridDim.z;
    unsigned sum, cnt, mine, sp = 0u;
    for (;;) {
        sum = 0u; cnt = 0u; mine = 0u;
#pragma unroll
        for (unsigned j = 0; j < 16; ++j) { const unsigned c = xb_ld(&bar[XB_XCNT(j)]); sum += c; cnt += (c > 0u) ? 1u : 0u; mine = (j == x) ? c : mine; }
        if (sum == G) break;
        __builtin_amdgcn_s_sleep(1);
        if ((++sp & 255u) == 0u) { if (xb_ld(&bar[XB_TMO])) break; if (sp > XB_SPIN_CAP) { atomicAdd(&bar[XB_TMO], 1u); break; } }
    }
    nloc = mine > 0u ? mine : 1u; nx = cnt > 0u ? cnt : 1u;
}

__device__ __forceinline__ void xcd_barrier(const XcdBarrier& b) {
    asm volatile("s_waitcnt vmcnt(0)" ::: "memory");
    __syncthreads();
    if (threadIdx.x == 0) {
        unsigned* bar = b.bar;
        __builtin_amdgcn_s_waitcnt(0);
        unsigned nloc = b.st[0], nx = b.st[1];
        if (nloc == 0u) { xcd_barrier_complete(bar, b.x, nloc, nx); b.st[0] = nloc; b.st[1] = nx; }
        const unsigned old = xb_add(&bar[XB_XSUB(b.x)], 1u);
        const unsigned gen = old / nloc;
        if (old + 1u == (gen + 1u) * nloc) {
            __builtin_amdgcn_fence(__ATOMIC_RELEASE, "agent");
            asm volatile("s_waitcnt vmcnt(0)" ::: "memory");
            const unsigned og = xb_add(&bar[XB_TOP], 1u);
            const unsigned tg = og / nx;
            if (og + 1u == (tg + 1u) * nx) xb_add(&bar[XB_TOPGEN], 1u);
            else XB_SPIN(xb_ld(&bar[XB_TOPGEN]) == tg, bar);
            __builtin_amdgcn_fence(__ATOMIC_ACQUIRE, "agent");
            xb_add(&bar[XB_XGEN(b.x)], 1u);
            asm volatile("s_waitcnt vmcnt(0)" ::: "memory");
        } else {
            XB_SPIN(xb_ld(&bar[XB_XGEN(b.x)]) == gen, bar);
            __builtin_amdgcn_fence(__ATOMIC_ACQUIRE, "agent");
            asm volatile("s_waitcnt vmcnt(0)" ::: "memory");
        }
    }
    __syncthreads();
}
constexpr int NWAVES = 8;
constexpr size_t MiB = 1u << 20;
constexpr size_t WS_CTL = 0, CTL_ZERO_BYTES = 65536;
constexpr size_t WS_W1 = 1 * MiB, WS_WO = 6 * MiB, WS_WGU = 8 * MiB, WS_WD = 19 * MiB, WS_WPG = 25 * MiB, WS_WPP = 27 * MiB;
constexpr size_t WS_RX = 28 * MiB, WS_SS1 = 29 * MiB, WS_SS2 = 32 * MiB;
constexpr size_t WS_XB = 36 * MiB;
constexpr size_t WS_PB = 102 * MiB, WS_PP = 119 * MiB;
constexpr size_t WS_Q = 185 * MiB, WS_KP = 218 * MiB, WS_VP = 250 * MiB, WS_KS = 282 * MiB, WS_VS = 300 * MiB, WS_GLU = 318 * MiB, WS_MIX = 351 * MiB;
constexpr size_t WS_ACT = 185 * MiB;
constexpr size_t WS_END = 417 * MiB;
static_assert(WS_XB + (size_t)R * D * 2 <= WS_PB && WS_PB + (size_t)R * PLE * 2 <= WS_PP && WS_PP + (size_t)R * D * 2 <= WS_Q && WS_Q + (size_t)R * 512 * 2 <= WS_KP &&
              WS_KP + (size_t)(RP / 64) * KVT_BYTES <= WS_KS && WS_KS + (size_t)DB * 9 * KVT_BYTES <= WS_GLU && WS_GLU + (size_t)R * 512 * 2 <= WS_MIX &&
              WS_MIX + (size_t)R * D * 2 <= WS_END && WS_ACT + (size_t)R * DFF * 2 <= WS_END && WS_SS1 + (size_t)R * 64 <= WS_SS2 && WS_SS2 + (size_t)R * 64 <= WS_XB && WS_RX + (size_t)R * 4 <= WS_SS1, "d_ws map");
constexpr int CW_BAR = 4096, CW_Q = 8192, CW_QG = CW_Q + 64 * 32;
constexpr int RING_OFF = 0, RING_BYTES = 131072;
constexpr int LDSCTL_OFF = RING_BYTES, MISC_OFF = LDSCTL_OFF + 320;
constexpr int ATT_TAB = 132096, ATT_LSC = ATT_TAB + 8192;
constexpr int LDS_BYTES = 147456;
static_assert(ATT_LSC + 2048 <= LDS_BYTES && MISC_OFF + 128 <= ATT_TAB, "LDS map");

__device__ __forceinline__ float wave_sum(float v) {
#pragma unroll
    for (int o = 1; o < 64; o <<= 1) v += __shfl_xor(v, o);
    return v;
}
__device__ __forceinline__ float wave_max(float v) {
#pragma unroll
    for (int o = 1; o < 64; o <<= 1) v = fmaxf(v, __shfl_xor(v, o));
    return v;
}
__device__ __forceinline__ int map_win(int n) {
    if (n < 1536) { const int sec = n >> 9, nn = n & 511, h = nn >> 6, d = nn & 63; return sec * 512 + 256 * (h >> 2) + 128 * (d >> 5) + 32 * (h & 3) + (d & 31); }
    if (n < 2048) { const int i = n - 1536; return 1536 + 256 * (i >> 7) + (i & 127); }
    const int i = n - 2048; return 1536 + 256 * (i >> 7) + 128 + (i & 127);
}
__device__ __forceinline__ int map_gu(int n) {
    if (n < DFF) return 256 * (n >> 7) + (n & 127);
    const int i = n - DFF; return 256 * (i >> 7) + 128 + (i & 127);
}
template <int MAP> __device__ __forceinline__ void p0_transpose_item(const float* W, const float* gain, int K, int N, bf16* WT, LAS float* scr, int item, int lane) {
    const int nblk = N / 32, kb = item / nblk, nb = item % nblk, k0 = 64 * kb, n0 = 32 * nb;
    { const int nq = lane & 7, kr = lane >> 3; f32x4 v[8];
#pragma unroll
      for (int i = 0; i < 8; ++i) v[i] = *(const GAS f32x4*)(W + (size_t)(k0 + 8 * i + kr) * N + n0 + 4 * nq);
#pragma unroll
      for (int i = 0; i < 8; ++i) { const int kk = 8 * i + kr; const float gk = gain ? gain[k0 + kk] : 1.0f;
#pragma unroll
          for (int e = 0; e < 4; ++e) scr[kk * 33 + 4 * nq + e] = v[i][e] * gk; } }
    LDS_WAIT(); asm volatile("" ::: "memory");
    const int c = lane & 7;
#pragma unroll
    for (int j = 0; j < 4; ++j) { const int n = (lane >> 3) + 8 * j; const LAS float* s = scr + (8 * c) * 33 + n;
        v4u o; o.x = pk2(s[0 * 33], s[1 * 33]); o.y = pk2(s[2 * 33], s[3 * 33]); o.z = pk2(s[4 * 33], s[5 * 33]); o.w = pk2(s[6 * 33], s[7 * 33]);
        const int ns = n0 + n, dr = MAP == 0 ? ns : (MAP == 1 ? map_win(ns) : map_gu(ns));
        *(GAS v4u*)(WT + (size_t)dr * K + k0 + 8 * c) = o; }
    LDS_WAIT(); asm volatile("" ::: "memory");
}

namespace att {
typedef short bf16x8 __attribute__((ext_vector_type(8)));
typedef short s16x4 __attribute__((ext_vector_type(4)));
typedef float f32x16 __attribute__((ext_vector_type(16)));
typedef unsigned u32x4 __attribute__((ext_vector_type(4)));
typedef float f32x2_t __attribute__((ext_vector_type(2))); typedef __bf16 bf16x2_t __attribute__((ext_vector_type(2)));
typedef short v4i16_t __attribute__((ext_vector_type(4)));
typedef LAS const char* lds_cptr;
constexpr int BUFB = 65536, HSLOT = 16384;
__device__ __forceinline__ int crow(int r, int hi) { return (r & 3) + 8 * (r >> 2) + 4 * hi; }
__device__ __forceinline__ void glds16(const void* gsrc, unsigned lds_dst) { unsigned keep;
    asm volatile("s_mov_b32 %0, m0\n\ts_mov_b32 m0, %2\n\ts_nop 0\n\tglobal_load_lds_dwordx4 %1, off\n\ts_mov_b32 m0, %0" : "=&s"(keep) : "v"(gsrc), "s"(lds_dst) : "memory"); }
__device__ __forceinline__ unsigned cvtpk_s(float lo, float hi) { f32x2_t v = {lo, hi}; bf16x2_t b = __builtin_convertvector(v, bf16x2_t); return __builtin_bit_cast(unsigned, b); }
__device__ __forceinline__ s16x4 vtr(lds_cptr p) { return __builtin_bit_cast(s16x4, __builtin_amdgcn_ds_read_tr16_b64_v4i16((LAS v4i16_t*)p)); }
#define ATT_WAIT_BAR() asm volatile("s_waitcnt vmcnt(0) lgkmcnt(0)\n\ts_barrier" ::: "memory")

struct AUnit { const bf16* Qrow; const unsigned char* KV; bf16* Orow; int nt, hg, sample, c0rel; };

__device__ __forceinline__ void attn_prefetch(const AUnit& U, LAS unsigned char* lds, int wid, int lane, bf16x8 (&qr)[2][4]) {
    const int r32 = lane & 31, hi = lane >> 5, hl = wid & 3, ci = wid >> 2, head = 4 * U.hg + hl;
    const bool wact = !U.sample || ci == 0;
    const unsigned char* kvsrc = U.KV + U.hg * 65536 + wid * 1024 + lane * 16;
    const unsigned kvdst = (unsigned)(size_t)lds + wid * 1024;
#pragma unroll
    for (int j_ = 0; j_ < 8; ++j_) glds16(kvsrc + j_ * 8192, (unsigned)__builtin_amdgcn_readfirstlane(kvdst + j_ * 8192));
    const bf16* Qw = U.Qrow + (size_t)((wact ? 64 * ci : 0) + r32) * 512 + head * 64 + hi * 8; const bf16* Qw1 = Qw + (U.sample ? 0 : 32 * 512);
#pragma unroll
    for (int d0 = 0; d0 < 4; ++d0) { qr[0][d0] = *(const bf16x8*)(Qw + d0 * 16); qr[1][d0] = *(const bf16x8*)(Qw1 + d0 * 16); }
}
template <bool TWO> __device__ __forceinline__ void attn_steps(const AUnit& U, LAS unsigned char* lds, int wid, int lane, const bf16x8 (&qr)[2][4], f32x16 (&o)[2][2], float (&lsum)[2]) {
    const int r32 = lane & 31, hi = lane >> 5, hl = wid & 3, ci = wid >> 2, head = 4 * U.hg + hl, nt = U.nt, own = U.c0rel + ci;
    const bool wact = TWO || ci == 0;
    const unsigned lds0 = (unsigned)(size_t)lds;
    const LAS float* tabh = (const LAS float*)(lds + ATT_TAB) + head * 256;
    const unsigned char* kvsrc = U.KV + U.hg * 65536 + wid * 1024 + lane * 16;
    const unsigned kvdst = lds0 + wid * 1024;
#define ATT_DMA(ti, b) do { _Pragma("unroll") for (int j_ = 0; j_ < 8; ++j_) \
        glds16(kvsrc + (size_t)(ti) * KVT_BYTES + j_ * 8192, (unsigned)__builtin_amdgcn_readfirstlane(kvdst + (b) * BUFB + j_ * 8192)); } while (0)
    for (int ti = 0; ti < nt; ++ti) {
        ATT_WAIT_BAR();
        const int b = ti & 1;
        if (ti + 1 < nt) ATT_DMA(ti + 1, b ^ 1);
        const int jt = own - ti;
        if (wact && jt >= 0 && jt <= 8) {
            const float m1 = (!TWO && jt == 0) ? 0.f : 1.f;
            const lds_cptr kp = (lds_cptr)(lds + b * BUFB + hl * HSLOT + hi * 1024 + r32 * 16);
            bf16x8 kf[8];
            { const unsigned ka = (unsigned)(size_t)kp;
              asm volatile("ds_read_b128 %0, %8\n\tds_read_b128 %1, %8 offset:512\n\tds_read_b128 %2, %8 offset:2048\n\tds_read_b128 %3, %8 offset:2560\n\t"
                           "ds_read_b128 %4, %8 offset:4096\n\tds_read_b128 %5, %8 offset:4608\n\tds_read_b128 %6, %8 offset:6144\n\tds_read_b128 %7, %8 offset:6656\n\ts_waitcnt lgkmcnt(0)"
                           : "=&v"(kf[0]), "=&v"(kf[1]), "=&v"(kf[2]), "=&v"(kf[3]), "=&v"(kf[4]), "=&v"(kf[5]), "=&v"(kf[6]), "=&v"(kf[7]) : "v"(ka) : "memory");
              __builtin_amdgcn_sched_barrier(0); }
            f32x16 s[2][2]; s[0][0] = f32x16{}; s[0][1] = f32x16{}; s[1][0] = f32x16{}; s[1][1] = f32x16{};
#pragma unroll
            for (int h2 = 0; h2 < (TWO ? 2 : 1); ++h2)
#pragma unroll
                for (int d0 = 0; d0 < 4; ++d0) { s[h2][0] = __builtin_amdgcn_mfma_f32_32x32x16_bf16(kf[2 * d0], qr[h2][d0], s[h2][0], 0, 0, 0);
                                                 s[h2][1] = __builtin_amdgcn_mfma_f32_32x32x16_bf16(kf[2 * d0 + 1], qr[h2][d0], s[h2][1], 0, 0, 0); }
            u32x4 pw[2][4];
#pragma unroll
            for (int h2 = 0; h2 < (TWO ? 2 : 1); ++h2) {
                f32x16& p0 = s[h2][0]; f32x16& p1 = s[h2][1];
                if (jt < 3) { const LAS float* tp = tabh + (191 - (32 * h2 + r32) - 64 * jt + 4 * hi);
#pragma unroll
                    for (int r = 0; r < 16; ++r) { p0[r] += tp[(r & 3) + 8 * (r >> 2)]; p1[r] += tp[32 + (r & 3) + 8 * (r >> 2)]; } }
                float sacc = 0.f;
#pragma unroll
                for (int r = 0; r < 16; ++r) { p0[r] = __builtin_amdgcn_exp2f(p0[r]); p1[r] = __builtin_amdgcn_exp2f(p1[r]); if (!TWO) p1[r] *= m1; sacc += p0[r] + p1[r]; }
                lsum[h2] += sacc;
#pragma unroll
                for (int k = 0; k < 2; ++k) { pw[h2][k] = (u32x4){cvtpk_s(p0[8 * k], p0[8 * k + 1]), cvtpk_s(p0[8 * k + 2], p0[8 * k + 3]), cvtpk_s(p0[8 * k + 4], p0[8 * k + 5]), cvtpk_s(p0[8 * k + 6], p0[8 * k + 7])};
                    pw[h2][2 + k] = (u32x4){cvtpk_s(p1[8 * k], p1[8 * k + 1]), cvtpk_s(p1[8 * k + 2], p1[8 * k + 3]), cvtpk_s(p1[8 * k + 4], p1[8 * k + 5]), cvtpk_s(p1[8 * k + 6], p1[8 * k + 7])}; }
            }
            const lds_cptr vp = (lds_cptr)(lds + b * BUFB + hl * HSLOT + 8192 + ((lane >> 4) & 1) * 32 + (lane & 3) * 8 + (4 * hi + ((lane & 15) >> 2)) * 64);
            const unsigned va = (unsigned)(size_t)vp;
#pragma unroll
            for (int d0 = 0; d0 < 2; ++d0) {
                s16x4 lo[4], hh[4];
                asm volatile("ds_read_b64_tr_b16 %0, %8 offset:%c9\n\tds_read_b64_tr_b16 %1, %8 offset:%c10\n\tds_read_b64_tr_b16 %2, %8 offset:%c11\n\tds_read_b64_tr_b16 %3, %8 offset:%c12\n\t"
                             "ds_read_b64_tr_b16 %4, %8 offset:%c13\n\tds_read_b64_tr_b16 %5, %8 offset:%c14\n\tds_read_b64_tr_b16 %6, %8 offset:%c15\n\tds_read_b64_tr_b16 %7, %8 offset:%c16\n\ts_waitcnt lgkmcnt(0)"
                             : "=&v"(lo[0]), "=&v"(hh[0]), "=&v"(lo[1]), "=&v"(hh[1]), "=&v"(lo[2]), "=&v"(hh[2]), "=&v"(lo[3]), "=&v"(hh[3])
                             : "v"(va), "i"(d0 * 4096), "i"(d0 * 4096 + 512), "i"(d0 * 4096 + 1024), "i"(d0 * 4096 + 1536), "i"(d0 * 4096 + 2048), "i"(d0 * 4096 + 2560), "i"(d0 * 4096 + 3072), "i"(d0 * 4096 + 3584) : "memory");
                __builtin_amdgcn_sched_barrier(0);
#pragma unroll
                for (int ks = 0; ks < 4; ++ks) {
                    const bf16x8 vf = (bf16x8){lo[ks][0], lo[ks][1], lo[ks][2], lo[ks][3], hh[ks][0], hh[ks][1], hh[ks][2], hh[ks][3]};
                    o[0][d0] = __builtin_amdgcn_mfma_f32_32x32x16_bf16(__builtin_bit_cast(bf16x8, pw[0][ks]), vf, o[0][d0], 0, 0, 0);
                    if (TWO) o[1][d0] = __builtin_amdgcn_mfma_f32_32x32x16_bf16(__builtin_bit_cast(bf16x8, pw[1][ks]), vf, o[1][d0], 0, 0, 0); }
            }
        }
    }
#undef ATT_DMA
}
template <bool TWO> __device__ __forceinline__ void attn_store(const AUnit& U, LAS unsigned char* lds, int wid, int lane, const f32x16 (&o)[2][2], const float (&lsum)[2]) {
    const int r32 = lane & 31, hi = lane >> 5, hl = wid & 3, ci = wid >> 2, head = 4 * U.hg + hl;
    const bool wact = TWO || ci == 0;
    LAS float* lsc = (LAS float*)(lds + ATT_LSC) + wid * 64;
    if (wact) {
#pragma unroll
        for (int h2 = 0; h2 < (TWO ? 2 : 1); ++h2) {
            float ls = lsum[h2];
            { auto rr = __builtin_amdgcn_permlane32_swap(__float_as_uint(ls), __float_as_uint(ls), false, false); ls = __uint_as_float(rr[0]) + __uint_as_float(rr[1]); }
            if (hi == 0) lsc[32 * h2 + r32] = ls;
            asm volatile("s_waitcnt lgkmcnt(0)" ::: "memory");
            LAS bf16* stg = (LAS bf16*)(lds + BUFB + wid * 8192 + h2 * 4096);
#pragma unroll
            for (int r = 0; r < 16; ++r) { const int orow = crow(r, hi); const float rl = __builtin_amdgcn_rcpf(lsc[32 * h2 + orow]);
#pragma unroll
                for (int d0 = 0; d0 < 2; ++d0) stg[orow * 64 + d0 * 32 + r32] = (bf16)f2bf(o[h2][d0][r] * rl); }
            asm volatile("s_waitcnt lgkmcnt(0)" ::: "memory");
            bf16* Ow = U.Orow + (size_t)(64 * ci + 32 * h2) * D + head * 64;
#pragma unroll
            for (int i = 0; i < 4; ++i) { const int row = i * 8 + (lane >> 3), ch = lane & 7; const u32x4 v = *(const LAS u32x4*)(stg + row * 64 + ch * 8); *(u32x4*)(Ow + (size_t)row * D + ch * 8) = v; }
        }
    }
}
}

__device__ __forceinline__ void conv_item(int item, const bf16* GLU, const float* st, const float* cw, const float* cb, const float* lg, const float* lb, bf16* MIX, LAS unsigned char* lds, int tid) {
    const bool samp = item >= RP / 32; const int b = samp ? item - RP / 32 : item >> 8, t0 = samp ? 0 : (item & 255) * 32, rowbase = samp ? RP + DS * b : b * SEQ;
    const int ch = tid, wid = tid >> 6, lane = tid & 63;
    LAS bf16* xs = (LAS bf16*)lds;
    LAS float* ybuf = (LAS float*)(lds + 65536);
#pragma unroll
    for (int i = 0; i < 8; ++i) { const int k = wid + 8 * i; if (k < 62) { const int tp = t0 - CH + k; pg8::u32x4 v = (pg8::u32x4){0u, 0u, 0u, 0u};
        if (tp >= 0) v = *(const pg8::u32x4*)(GLU + (size_t)(rowbase + tp) * 512 + 8 * lane);
        else if (samp) { const float* sp = st + ((size_t)b * CH + (CH + tp)) * CW + 8 * lane; v = pg8::pack8(*(const f32x4*)sp, *(const f32x4*)(sp + 4)); }
        *(LAS pg8::u32x4*)(xs + k * 512 + 8 * lane) = v; } }
    float w[CONVW];
#pragma unroll
    for (int j = 0; j < CONVW; ++j) w[j] = cw[j * CW + ch];
    const float bias = cb[ch];
    __syncthreads();
#pragma unroll 1
    for (int hb = 0; hb < 2; ++hb) {
        float x[46];
#pragma unroll
        for (int k = 0; k < 46; ++k) x[k] = __uint_as_float((unsigned)xs[(16 * hb + k) * 512 + ch] << 16);
        float y[16];
#pragma unroll
        for (int i = 0; i < 16; ++i) y[i] = bias;
#pragma unroll
        for (int j = 0; j < CONVW; ++j)
#pragma unroll
            for (int i = 0; i < 16; ++i) y[i] += w[j] * x[i + j];
#pragma unroll
        for (int i = 0; i < 16; ++i) ybuf[(16 * hb + i) * 512 + ch] = y[i];
    }
    __syncthreads();
    f32x4 g0 = *(const f32x4*)(lg + 8 * lane), g1 = *(const f32x4*)(lg + 8 * lane + 4), b0 = *(const f32x4*)(lb + 8 * lane), b1 = *(const f32x4*)(lb + 8 * lane + 4);
#pragma unroll
    for (int q = 0; q < 4; ++q) { const int i = 4 * wid + q;
        f32x4 v0 = *(const LAS f32x4*)(ybuf + i * 512 + 8 * lane), v1 = *(const LAS f32x4*)(ybuf + i * 512 + 8 * lane + 4);
        const float mean = wave_sum((v0[0] + v0[1]) + (v0[2] + v0[3]) + (v1[0] + v1[1]) + (v1[2] + v1[3])) * (1.0f / CW);
        v0 = v0 - mean; v1 = v1 - mean;
        const f32x4 q0 = v0 * v0, q1 = v1 * v1;
        const float rstd = rsqrtf(wave_sum((q0[0] + q0[1]) + (q0[2] + q0[3]) + (q1[0] + q1[1]) + (q1[2] + q1[3])) * (1.0f / CW) + EPS);
        v0 = v0 * rstd * g0 + b0; v1 = v1 * rstd * g1 + b1;
#pragma unroll
        for (int e = 0; e < 4; ++e) { v0[e] *= pg8::sigm(v0[e]); v1[e] *= pg8::sigm(v1[e]); }
        *(pg8::u32x4*)(MIX + (size_t)(rowbase + t0 + i) * D + 512 + 8 * lane) = pg8::pack8(v0, v1); }
    __syncthreads();
}


constexpr int SG_LD = 68;
#define SG_WAIT_BAR(N) asm volatile("s_waitcnt vmcnt(" #N ") lgkmcnt(0)\n\ts_barrier" ::: "memory")
template <class Epi> __device__ __forceinline__ void sgemm64(const bf16* A, const bf16* Bt, int K_, int tile, const Epi& E, LAS unsigned char* lds) {
    int tid_ = threadIdx.x; asm volatile("" : "+v"(tid_)); int K = K_; asm volatile("" : "+s"(K));
    const int lane = tid_ & 63, wave = __builtin_amdgcn_readfirstlane(tid_ >> 6), fr = lane & 15, fq = lane >> 4, wm = wave & 3, wn = wave >> 2, tr = tile >> 4, tc = tile & 15;
    const int KS = K >> 7;
    const unsigned char* src[4]; unsigned dsto[4];
#pragma unroll
    for (int i = 0; i < 4; ++i) { const int p = wave + 8 * i, r = 4 * (p & 15) + (lane >> 4), cs = (lane & 15) ^ (r & 15);
        src[i] = (const unsigned char*)((p < 16 ? A + (size_t)(64 * tr + r) * K : Bt + (size_t)(64 * tc + r) * K)) + cs * 16;
        dsto[i] = (p < 16 ? 0u : 16384u) + (unsigned)(p & 15) * 1024u; }
    const unsigned lds0 = (unsigned)(size_t)lds;
#define SG_STAGE(t) do { _Pragma("unroll") for (int i_ = 0; i_ < 4; ++i_) att::glds16(src[i_] + (size_t)(t) * 256, (unsigned)__builtin_amdgcn_readfirstlane(lds0 + (unsigned)((t) & 3) * 32768u + dsto[i_])); } while (0)
    f32x4 acc0 = (f32x4){0.f, 0.f, 0.f, 0.f}, acc1 = acc0;
    SG_STAGE(0); if (KS > 1) SG_STAGE(1); if (KS > 2) SG_STAGE(2);
    const unsigned ra = (unsigned)(16 * wm + fr) * 256u, rb = 16384u + (unsigned)(32 * wn + fr) * 256u;
    for (int t = 0; t < KS; ++t) {
        if (t + 2 < KS) SG_WAIT_BAR(8); else if (t + 1 < KS) SG_WAIT_BAR(4); else SG_WAIT_BAR(0);
        if (t + 3 < KS) SG_STAGE(t + 3);
        const LAS unsigned char* sb = lds + (t & 3) * 32768;
#pragma unroll
        for (int ks = 0; ks < 4; ++ks) { const unsigned ch = (unsigned)((4 * ks + fq) ^ fr) * 16u;
            const bf16x8 a = *(const LAS bf16x8*)(sb + ra + ch), b0 = *(const LAS bf16x8*)(sb + rb + ch), b1 = *(const LAS bf16x8*)(sb + rb + 4096 + ch);
            acc0 = __builtin_amdgcn_mfma_f32_16x16x32_bf16(b0, a, acc0, 0, 0, 0); acc1 = __builtin_amdgcn_mfma_f32_16x16x32_bf16(b1, a, acc1, 0, 0, 0); }
    }
#undef SG_STAGE
    SG_WAIT_BAR(0);
    LAS float* part = (LAS float*)lds;
    *(LAS f32x4*)(part + (16 * wm + fr) * SG_LD + 32 * wn + 4 * fq) = acc0; *(LAS f32x4*)(part + (16 * wm + fr) * SG_LD + 32 * wn + 16 + 4 * fq) = acc1;
    __syncthreads();
    const int row = tid_ >> 3, c8 = (tid_ & 7) * 8;
    const f32x4 v0 = *(const LAS f32x4*)(part + row * SG_LD + c8), v1 = *(const LAS f32x4*)(part + row * SG_LD + c8 + 4);
    E(64 * tr + row, 64 * tc + c8, tc, tid_ & 7, v0, v1);
    __syncthreads();
}
__device__ __forceinline__ float oct_sum(float s) { s += __shfl_xor(s, 1); s += __shfl_xor(s, 2); s += __shfl_xor(s, 4); return s; }
template <bool BF> struct SEpiRes {
    const float* base; bf16* HB; float* SS;
    __device__ __forceinline__ void operator()(int row, int col, int tc, int l8, f32x4 v0, f32x4 v1) const {
        const size_t o = (size_t)row * D + col;
        if (BF) { const pg8::u32x4 w = *(const pg8::u32x4*)(HB + o); v0 = v0 + pg8::bf_lo4(w); v1 = v1 + pg8::bf_hi4(w); }
        else { v0 = v0 + *(const f32x4*)(base + o); v1 = v1 + *(const f32x4*)(base + o + 4); }
        *(pg8::u32x4*)(HB + o) = pg8::pack8(v0, v1);
        const f32x4 q0 = v0 * v0, q1 = v1 * v1;
        const float ss = oct_sum(((q0[0] + q0[1]) + (q0[2] + q0[3])) + ((q1[0] + q1[1]) + (q1[2] + q1[3])));
        if (l8 == 0) SS[(size_t)row * 16 + tc] = ss;
    }
};
struct SEpiPP {
    bf16* PP;
    __device__ __forceinline__ void operator()(int row, int col, int tc, int l8, f32x4 v0, f32x4 v1) const { *(pg8::u32x4*)(PP + (size_t)row * D + col) = pg8::pack8(v0, v1); }
};
struct SEpiFinal {
    const float* SS; const bf16* PP; const bf16* HB; float* Y;
    __device__ __forceinline__ void operator()(int row, int col, int tc, int l8, f32x4 v0, f32x4 v1) const {
        const float r = rsqrtf(oct_sum(SS[(size_t)row * 16 + 2 * l8] + SS[(size_t)row * 16 + 2 * l8 + 1]) * (1.0f / D) + EPS);
        const size_t o = (size_t)row * D + col;
        const pg8::u32x4 pw = *(const pg8::u32x4*)(PP + o), hw = *(const pg8::u32x4*)(HB + o);
        const f32x4 p0 = pg8::bf_lo4(pw), p1 = pg8::bf_hi4(pw); f32x4 h0 = pg8::bf_lo4(hw), h1 = pg8::bf_hi4(hw);
#pragma unroll
        for (int e = 0; e < 4; ++e) { h0[e] += pg8::sigm(v0[e] * r) * p0[e]; h1[e] += pg8::sigm(v1[e] * r) * p1[e]; }
        *(f32x4*)(Y + o) = h0; *(f32x4*)(Y + o + 4) = h1;
    }
};

#ifndef REP_P0
#define REP_P0 1
#endif
#ifndef REP_P1
#define REP_P1 1
#endif
#ifndef REP_P2
#define REP_P2 1
#endif
#ifndef REP_P3
#define REP_P3 1
#endif
#ifndef REP_P4
#define REP_P4 1
#endif
struct Args { const float* in[23]; float* out; unsigned char* ws; };
constexpr int N_ATT_S = 2 * DB, N_ATT_P = NB * 64 * 2, N_CONV = R / 32;
constexpr int I_WO = (D / 64) * (D / 32), I_WGU = (D / 64) * (2 * DFF / 32), N_WCV = (I_WO + I_WGU) / 8;
constexpr int N_ATT_Q = 8 + 64;
static_assert((I_WO + I_WGU) % 8 == 0, "weight conversion entries");
#define W1t ((bf16*)(ws + WS_W1))
#define WOt ((bf16*)(ws + WS_WO))
#define WGUt ((bf16*)(ws + WS_WGU))
#define WDt ((bf16*)(ws + WS_WD))
#define WPGt ((bf16*)(ws + WS_WPG))
#define WPPt ((bf16*)(ws + WS_WPP))
#define RX ((float*)(ws + WS_RX))
#define SS1 ((float*)(ws + WS_SS1))
#define SS2 ((float*)(ws + WS_SS2))
#define XB ((bf16*)(ws + WS_XB))
#define PB ((bf16*)(ws + WS_PB))
#define PPb ((bf16*)(ws + WS_PP))
#define Qb ((bf16*)(ws + WS_Q))
#define KVP (ws + WS_KP)
#define KVS (ws + WS_KS)
#define GLUb ((bf16*)(ws + WS_GLU))
#define MIXb ((bf16*)(ws + WS_MIX))
#define ACTb ((bf16*)(ws + WS_ACT))
#define Y (out + OY)
__global__ void __launch_bounds__(NWAVES * 64, 2) mk_fwd(Args args) {
    extern __shared__ __attribute__((aligned(16))) unsigned char lds_[];
    LAS unsigned char* lds = (LAS unsigned char*)lds_;
    volatile LAS unsigned* MISC = (volatile LAS unsigned*)(lds + MISC_OFF);
    const int G = gridDim.x, vcu = (G % 8 == 0) ? ((int)blockIdx.x % 8) * (G / 8) + (int)blockIdx.x / 8 : (int)blockIdx.x;
    unsigned char* ws = args.ws; float* out = args.out;
    gu32* ctl = (gu32*)(ws + WS_CTL);
    for (int u = threadIdx.x; u < (ATT_TAB - LDSCTL_OFF) / 4; u += NWAVES * 64) ((LAS unsigned*)(lds + LDSCTL_OFF))[u] = 0u;
    __syncthreads();
    XcdBarrier bar = xcd_barrier_post((unsigned*)(ctl + CW_BAR), MISC + 8);

#ifndef SKIP_P0
    for (int rep = 0; rep < REP_P0; ++rep) {
        if (rep) xcd_barrier(bar);
        int tid0 = threadIdx.x; asm volatile("" : "+v"(tid0));
        const int lane = tid0 & 63, wave = __builtin_amdgcn_readfirstlane(tid0 >> 6);
        LAS float* scr = (LAS float*)(lds + RING_OFF + wave * 16384);
        const int gw = vcu * NWAVES + wave, NGW = G * NWAVES;
        constexpr int I_1 = (D / 64) * (INC / 32), I_PP = (PLE / 64) * (D / 32);
        constexpr int NITEMS = I_1 + I_PP;
        for (int it = gw; it < NITEMS; it += NGW) {
            if (it < I_1) p0_transpose_item<1>(args.in[8], args.in[7], D, INC, W1t, scr, it, lane);
            else p0_transpose_item<0>(args.in[22], nullptr, PLE, D, WPPt, scr, it - I_1, lane);
        }
        for (int m2 = gw; m2 < R / 2; m2 += NGW) {
            f32x4 v[2][4];
#pragma unroll
            for (int rr = 0; rr < 2; ++rr) { const int m = 2 * m2 + rr; const float* xrow = m < RP ? args.in[0] + (size_t)m * D : args.in[1] + (size_t)(m - RP) * D;
                const GAS f32x4* xr = (const GAS f32x4*)xrow + lane;
#pragma unroll
                for (int j = 0; j < 4; ++j) v[rr][j] = xr[64 * j]; }
#pragma unroll
            for (int rr = 0; rr < 2; ++rr) { const int m = 2 * m2 + rr; float s = 0.f;
#pragma unroll
                for (int j = 0; j < 4; ++j) s += (v[rr][j].x * v[rr][j].x + v[rr][j].y * v[rr][j].y) + (v[rr][j].z * v[rr][j].z + v[rr][j].w * v[rr][j].w);
                s = wave_sum(s); if (lane == 0) RX[m] = rsqrtf(s * (1.0f / D) + EPS);
                GAS unsigned long long* o8 = (GAS unsigned long long*)(XB + (size_t)m * D) + lane;
#pragma unroll
                for (int j = 0; j < 4; ++j) o8[64 * j] = (unsigned long long)pk2(v[rr][j].x, v[rr][j].y) | ((unsigned long long)pk2(v[rr][j].z, v[rr][j].w) << 32); }
        }
        for (int m8 = gw; m8 < R / 8; m8 += NGW) {
            const int m = 8 * m8; const float* prow = m < RP ? args.in[2] + (size_t)m * PLE : args.in[3] + (size_t)(m - RP) * PLE;
            const GAS f32x4* pr = (const GAS f32x4*)prow + lane; f32x4 pv[8];
#pragma unroll
            for (int j = 0; j < 8; ++j) pv[j] = pr[64 * j];
            GAS unsigned long long* o8 = (GAS unsigned long long*)(PB + (size_t)m * PLE) + lane;
#pragma unroll
            for (int j = 0; j < 8; ++j) o8[64 * j] = (unsigned long long)pk2(pv[j].x, pv[j].y) | ((unsigned long long)pk2(pv[j].z, pv[j].w) << 32);
        }
    }
#endif
    xcd_barrier(bar);

#ifndef SKIP_P1
    for (int rep = 0; rep < REP_P1; ++rep) {
        if (rep) xcd_barrier(bar);
        pg8::Gemm g{XB, W1t, R, INC, D}; pg8::StaticOrder S; S.init(R, INC, G, (int)blockIdx.x);
        pg8::Epi1 E{RX, args.in[9], args.in[10], Qb, KVP, KVS, GLUb, out};
        pg8::gemm_phase<pg8::Epi1, pg8::StaticOrder, true, true>(lds + RING_OFF, g, S, E);
        { const int c0 = ((R / 256) * (INC / 256)) % G, nwgc = c0 ? G - c0 : G, cc = c0 ? (int)blockIdx.x - c0 : (int)blockIdx.x;
          if (cc >= 0) {
            int tidc = threadIdx.x; asm volatile("" : "+v"(tidc));
            const int lane = tidc & 63, wave = __builtin_amdgcn_readfirstlane(tidc >> 6), head = lane >> 3, dq = lane & 7;
            for (int m2 = cc * NWAVES + wave; m2 < DB * 512; m2 += nwgc * NWAVES) {
                const int b = m2 >> 9, j = m2 & 511, kv = j & 63;
                const GAS f32x4* sk = (const GAS f32x4*)(args.in[4] + (size_t)m2 * 512) + 2 * lane; const GAS f32x4* sv = (const GAS f32x4*)(args.in[5] + (size_t)m2 * 512) + 2 * lane;
                const f32x4 k0 = sk[0], k1 = sk[1], v0 = sv[0], v1 = sv[1];
                unsigned char* tb = KVS + (size_t)(b * 9 + (j >> 6)) * KVT_BYTES + (head >> 2) * 65536 + (head & 3) * 16384;
                *(GAS v4u*)(tb + dq * 1024 + kv * 16) = (v4u){pk2(k0.x, k0.y), pk2(k0.z, k0.w), pk2(k1.x, k1.y), pk2(k1.z, k1.w)};
                *(GAS v4u*)(tb + 8192 + (dq >> 2) * 4096 + (kv >> 4) * 1024 + (kv & 15) * 64 + (dq & 3) * 16) = (v4u){pk2(v0.x, v0.y), pk2(v0.z, v0.w), pk2(v1.x, v1.y), pk2(v1.z, v1.w)};
            }
            for (int p = cc * NWAVES + wave; p < DB * NH; p += nwgc * NWAVES) {
                unsigned char* tb = KVS + (size_t)((p >> 3) * 9 + 8) * KVT_BYTES + ((p & 7) >> 2) * 65536 + (p & 3) * 16384; const v4u z = (v4u){0u, 0u, 0u, 0u};
#pragma unroll
                for (int c2 = 0; c2 < 4; ++c2) *(GAS v4u*)(tb + (2 * c2 + (lane >> 5)) * 1024 + 512 + (lane & 31) * 16) = z;
#pragma unroll
                for (int q = 0; q < 4; ++q) *(GAS v4u*)(tb + 8192 + (q >> 1) * 4096 + (2 + (q & 1)) * 1024 + lane * 16) = z;
            }
          } }
    }
#endif
    xcd_barrier(bar);

#ifndef SKIP_P2
    for (int rep = 0; rep < REP_P2; ++rep) {
        if (rep) xcd_barrier(bar);
        { int tidt = threadIdx.x; asm volatile("" : "+v"(tidt)); const int lane = tidt & 63, wave = __builtin_amdgcn_readfirstlane(tidt >> 6);
          const float* relb = args.in[11] + wave * NREL; LAS float* T = (LAS float*)(lds + ATT_TAB) + wave * 256;
          const float bfar = relb[256];
          for (int x = lane; x < 256; x += 64) { int dd = 191 - x; dd = dd < -128 ? -128 : (dd > 128 ? 128 : dd); T[x] = (relb[dd + 128] - bfar) * LOG2E; } }
        __syncthreads();
        {
            int tid2 = threadIdx.x; asm volatile("" : "+v"(tid2));
            const int lane2 = tid2 & 63, wave2 = __builtin_amdgcn_readfirstlane(tid2 >> 6);
            int qk = 0, q = (int)blockIdx.x & 7;
#define ATT_POP(qq) ((int)__hip_atomic_fetch_add((unsigned*)(ctl + CW_Q + 64 * ((qq) + 8 * rep)), 1u, __ATOMIC_RELAXED, __HIP_MEMORY_SCOPE_AGENT))
#define ATT_DECODE(code, U) do { const int q_ = (int)((code) >> 8), i_ = (int)((code) & 255u); \
                if (i_ < 8) { const int sb = 4 * q_ + (i_ >> 1); U.hg = i_ & 1; U.sample = 1; U.nt = 9; U.c0rel = 8; \
                    U.Qrow = Qb + (size_t)(RP + DS * sb) * 512; U.KV = KVS + (size_t)(sb * 9) * KVT_BYTES; U.Orow = MIXb + (size_t)(RP + DS * sb) * D; } \
                else { const int j = i_ - 8, pi = j < 60 ? 4 + j : 63 - j, bb = q_ >> 1, c0 = 2 * pi;     \
                    U.hg = q_ & 1; U.sample = 0; U.c0rel = c0 < 8 ? c0 : 8; U.nt = U.c0rel + 2; const size_t row0 = (size_t)bb * SEQ + 64 * c0; \
                    U.Qrow = Qb + row0 * 512; U.KV = KVP + (size_t)(bb * 128 + c0 - U.c0rel) * KVT_BYTES; U.Orow = MIXb + row0 * D; } } while (0)
            if (tid2 == 0) { int i = ATT_POP(q); while (i >= N_ATT_Q) { if (++qk == 8) { i = -1; break; } q = ((int)blockIdx.x + qk) & 7; i = ATT_POP(q); }
                MISC[4] = i < 0 ? 0xffffffffu : (unsigned)((q << 8) | i); }
            __syncthreads();
            unsigned code = MISC[4];
            if (code != 0xffffffffu) {
                att::AUnit U; ATT_DECODE(code, U);
                att::bf16x8 qr[2][4];
                att::attn_prefetch(U, lds, wave2, lane2, qr);
                for (;;) {
                    int nraw = 0; if (tid2 == 0) nraw = ATT_POP(q);
#pragma unroll
                    for (int d0 = 0; d0 < 4; ++d0) asm volatile("" : "+v"(qr[0][d0]), "+v"(qr[1][d0]));
                    att::f32x16 o[2][2]; o[0][0] = att::f32x16{}; o[0][1] = att::f32x16{}; o[1][0] = att::f32x16{}; o[1][1] = att::f32x16{}; float lsum[2] = {0.f, 0.f};
                    if (U.sample) att::attn_steps<false>(U, lds, wave2, lane2, qr, o, lsum); else att::attn_steps<true>(U, lds, wave2, lane2, qr, o, lsum);
                    if (tid2 == 0) { int i = nraw; while (i >= N_ATT_Q) { if (++qk == 8) { i = -1; break; } q = ((int)blockIdx.x + qk) & 7; i = ATT_POP(q); }
                        MISC[4] = i < 0 ? 0xffffffffu : (unsigned)((q << 8) | i); }
                    ATT_WAIT_BAR();
                    const unsigned ncode = MISC[4];
                    att::AUnit Un = U;
                    if (ncode != 0xffffffffu) { ATT_DECODE(ncode, Un); att::attn_prefetch(Un, lds, wave2, lane2, qr); }
                    if (U.sample) att::attn_store<false>(U, lds, wave2, lane2, o, lsum); else att::attn_store<true>(U, lds, wave2, lane2, o, lsum);
                    if (ncode == 0xffffffffu) break;
                    U = Un;
                }
                ATT_WAIT_BAR();
            }
#undef ATT_POP
#undef ATT_DECODE
        }
        for (;;) {
            int tid2 = threadIdx.x; asm volatile("" : "+v"(tid2));
            if (tid2 == 0) MISC[4] = __hip_atomic_fetch_add((unsigned*)(ctl + CW_QG + 64 * rep), 1u, __ATOMIC_RELAXED, __HIP_MEMORY_SCOPE_AGENT);
            __syncthreads();
            const int idx = (int)MISC[4];
            __syncthreads();
            if (idx >= N_CONV + N_WCV) break;
            const int lane2 = tid2 & 63, wave2 = __builtin_amdgcn_readfirstlane(tid2 >> 6);
            if (idx < N_CONV) conv_item(idx, GLUb, args.in[6], args.in[12], args.in[13], args.in[14], args.in[15], MIXb, lds, tid2);
            else { const int it = 8 * (idx - N_CONV) + wave2; LAS float* scr = (LAS float*)(lds + RING_OFF + wave2 * 16384);
                if (it < I_WO) p0_transpose_item<0>(args.in[16], nullptr, D, D, WOt, scr, it, lane2);
                else p0_transpose_item<2>(args.in[18], args.in[17], D, 2 * DFF, WGUt, scr, it - I_WO, lane2);
                __syncthreads(); }
        }
    }
#endif
    xcd_barrier(bar);

#ifndef SKIP_P3
    for (int rep = 0; rep < REP_P3; ++rep) {
        if (rep) xcd_barrier(bar);
        pg8::Gemm g{MIXb, WOt, RP, D, D}; pg8::StaticOrder S; S.init(RP, D, G, (int)blockIdx.x);
        pg8::EpiRes<true> E{nullptr, nullptr, XB, SS1};
        const SEpiRes<true> SE{nullptr, XB + (size_t)RP * D, SS1 + (size_t)RP * 16};
        if (blockIdx.x & 1) for (int t = (int)blockIdx.x; t < 256; t += G) sgemm64(MIXb + (size_t)RP * D, WOt, D, t, SE, lds + RING_OFF);
        pg8::gemm_phase<pg8::EpiRes<true>, pg8::StaticOrder, true, true>(lds + RING_OFF, g, S, E);
        if (!(blockIdx.x & 1)) for (int t = (int)blockIdx.x; t < 256; t += G) sgemm64(MIXb + (size_t)RP * D, WOt, D, t, SE, lds + RING_OFF);
    }
#endif
    xcd_barrier(bar);

#ifndef SKIP_P4
    for (int rep = 0; rep < REP_P4; ++rep) {
        if (rep) xcd_barrier(bar);
        { const int c0 = ((R / 256) * (2 * DFF / 256)) % G, nwgc = c0 ? G - c0 : G, cc = c0 ? (int)blockIdx.x - c0 : (int)blockIdx.x;
          if (cc >= 0) {
            const bool wt = (nwgc % 4) == 0; const int k = wt ? cc & 3 : 1, j = wt ? cc >> 2 : cc, per = wt ? nwgc / 4 : nwgc, nslot = wt ? 6 * per : per;
            const int s0 = !wt ? j : (k == 1 ? j : (k == 2 ? per + 2 * j : 3 * per + 3 * j));
            int tidc = threadIdx.x; asm volatile("" : "+v"(tidc));
            const int lane = tidc & 63, wave = __builtin_amdgcn_readfirstlane(tidc >> 6);
            for (int q = 0; q < k; ++q)
            for (int m4 = s0 + q + nslot * wave; m4 < 2 * DB * 120; m4 += nslot * NWAVES) {
                const int kv = m4 >= DB * 120, mm = kv ? m4 - DB * 120 : m4, b = mm / 120, j2 = DS + 4 * (mm % 120);
                const GAS f32x4* src = (const GAS f32x4*)(args.in[4 + kv] + ((size_t)b * 512 + j2) * 512) + lane;
                GAS f32x4* dst = (GAS f32x4*)(out + (kv ? OVS : OKS) + ((size_t)b * 512 + (j2 - DS)) * 512) + lane;
                f32x4 v[8];
#pragma unroll
                for (int i = 0; i < 8; ++i) v[i] = src[64 * i];
#pragma unroll
                for (int i = 0; i < 8; ++i) dst[64 * i] = v[i];
            }
            { LAS float* scr = (LAS float*)(lds + RING_OFF + wave * 16384); constexpr int I_D = (DFF / 64) * (D / 32), I_PG = (D / 64) * (D / 32);
              for (int it = cc * NWAVES + wave; it < I_D + I_PG; it += nwgc * NWAVES) {
                  if (it < I_D) p0_transpose_item<0>(args.in[19], nullptr, DFF, D, WDt, scr, it, lane);
                  else p0_transpose_item<0>(args.in[21], args.in[20], D, D, WPGt, scr, it - I_D, lane); }
              __syncthreads(); }
          } }
        pg8::Gemm g{XB, WGUt, R, 2 * DFF, D}; pg8::StaticOrder S; S.init(R, 2 * DFF, G, (int)blockIdx.x);
        pg8::EpiAct E{SS1, ACTb};
        pg8::gemm_phase<pg8::EpiAct, pg8::StaticOrder, true, true>(lds + RING_OFF, g, S, E);
    }
#endif
    xcd_barrier(bar);

#ifndef SKIP_P5
    {
        pg8::Gemm g{ACTb, WDt, RP, D, DFF}; pg8::StaticOrder S; S.init(RP, D, G, (int)blockIdx.x);
        pg8::EpiRes<true> E{nullptr, nullptr, XB, SS2};
        const SEpiRes<true> SE{nullptr, XB + (size_t)RP * D, SS2 + (size_t)RP * 16};
        if (blockIdx.x & 1) for (int t = (int)blockIdx.x; t < 256; t += G) sgemm64(ACTb + (size_t)RP * DFF, WDt, DFF, t, SE, lds + RING_OFF);
        pg8::gemm_phase<pg8::EpiRes<true>, pg8::StaticOrder, true, true>(lds + RING_OFF, g, S, E);
        if (!(blockIdx.x & 1)) for (int t = (int)blockIdx.x; t < 256; t += G) sgemm64(ACTb + (size_t)RP * DFF, WDt, DFF, t, SE, lds + RING_OFF);
    }
#endif
    xcd_barrier(bar);

#ifndef SKIP_P6
    {
        pg8::Gemm g{XB, WPGt, RP, D, D}; pg8::StaticOrder S; S.init(RP, D, G, (int)blockIdx.x);
        pg8::EpiFinal E{SS2, PPb, XB, Y};
        const SEpiFinal SE{SS2 + (size_t)RP * 16, PPb + (size_t)RP * D, XB + (size_t)RP * D, Y + (size_t)RP * D};
        pg8::Gemm gp{PB, WPPt, RP, D, PLE}; pg8::EpiPP EP{PPb}; const SEpiPP SP{PPb + (size_t)RP * D};
        if (blockIdx.x & 1) for (int t = (int)blockIdx.x; t < 256; t += G) { sgemm64(PB + (size_t)RP * PLE, WPPt, PLE, t, SP, lds + RING_OFF); sgemm64(XB + (size_t)RP * D, WPGt, D, t, SE, lds + RING_OFF); }
        pg8::gemm_phase<pg8::EpiPP, pg8::StaticOrder, true, true>(lds + RING_OFF, gp, S, EP);
        pg8::gemm_phase<pg8::EpiFinal, pg8::StaticOrder, true, true>(lds + RING_OFF, g, S, E);
        if (!(blockIdx.x & 1)) for (int t = (int)blockIdx.x; t < 256; t += G) { sgemm64(PB + (size_t)RP * PLE, WPPt, PLE, t, SP, lds + RING_OFF); sgemm64(XB + (size_t)RP * D, WPGt, D, t, SE, lds + RING_OFF); }
    }
#endif
}

extern "C" void kernel_launch(void* const* d_in, const int* in_sizes, int n_in, void* d_out, int out_size, void* d_ws, size_t ws_size, hipStream_t stream) {
    static int grid = 0;
    if (grid == 0) {
        if (n_in != 23 || ws_size < WS_END) { fprintf(stderr, "kernel_launch: unexpected shapes (n_in %d, ws %zu)\n", n_in, ws_size); grid = -1; return; }
        int dev = 0, cus = 0, per_cu = 0;
        if (hipGetDevice(&dev) != hipSuccess || hipDeviceGetAttribute(&cus, hipDeviceAttributeMultiprocessorCount, dev) != hipSuccess) { grid = -1; return; }
        if (hipFuncSetAttribute((const void*)mk_fwd, hipFuncAttributeMaxDynamicSharedMemorySize, LDS_BYTES) != hipSuccess) { fprintf(stderr, "kernel_launch: hipFuncSetAttribute failed\n"); grid = -1; return; }
        if (hipOccupancyMaxActiveBlocksPerMultiprocessor(&per_cu, (const void*)mk_fwd, NWAVES * 64, LDS_BYTES) != hipSuccess || per_cu < 1) { fprintf(stderr, "kernel_launch: occupancy query says %d blocks per CU\n", per_cu); }
        (void)hipGetLastError();
        grid = cus;
    }
    if (grid < 0) return;
    if (hipMemsetAsync((char*)d_ws + WS_CTL, 0, CTL_ZERO_BYTES, stream) != hipSuccess) return;
    Args a{};
    for (int i = 0; i < 23; ++i) a.in[i] = (const float*)d_in[i];
    a.out = (float*)d_out; a.ws = (unsigned char*)d_ws;
    hipLaunchKernelGGL(mk_fwd, dim3(grid), dim3(NWAVES * 64), LDS_BYTES, stream, a);
}
```

```cpp
#include <hip/hip_runtime.h>
#include <cstdio>
#include <cstdint>
constexpr int D = 1024, SEQ = 8192, NB = 4, DB = 32, DS = 32;
constexpr int RP = NB * SEQ, RS = DB * DS, R = RP + RS;
constexpr int INC = 2560, DFF = 2816, PLE = 256, NH = 8, HD = 64, CW = 512;
constexpr int NREL = 257, CONVW = 31, CH = 30, KSROWS = 576;
constexpr int KVT_BYTES = 131072;
constexpr float EPS = 1e-6f, LOG2E = 1.4426950408889634f, QSCALE = 0.125f * LOG2E;
constexpr size_t OY = 0, OKP = (size_t)R * D, OVP = OKP + (size_t)NB * 512 * 512, OCP = OVP + (size_t)NB * 512 * 512,
                 OKS = OCP + (size_t)NB * CH * CW, OVS = OKS + (size_t)DB * 512 * 512, OCS = OVS + (size_t)DB * 512 * 512;
namespace pg8 {
#define PG8_LAS __attribute__((address_space(3)))
typedef unsigned short bf16_t;
typedef short bf16x8 __attribute__((ext_vector_type(8)));
typedef float f32x4 __attribute__((ext_vector_type(4)));
typedef unsigned u32x4 __attribute__((ext_vector_type(4)));
constexpr int BM = 256, BK = 64, HALF = 128, HTB = HALF * BK * 2  , STAGE_BYTES = 8 * HTB, NXCD = 8, WGM = 8;

__host__ __device__ __forceinline__ int lds_byte(int r, int c) { const int st = (r >> 4) * 2 + (c >> 5), rr = r & 15, cc = c & 31, ob = rr * 64 + cc * 2; return st * 1024 + (ob ^ (((ob >> 9) & 1) << 5)); }
__host__ __device__ __forceinline__ void stage_rc(int b, int& R, int& C) { const int st = b / 1024, sb = b % 1024, swz = sb ^ (((sb >> 9) & 1) << 5); R = (st >> 1) * 16 + swz / 64; C = (st & 1) * 32 + (swz % 64) / 2; }
__host__ __device__ __forceinline__ int perm32(int rho) { const int n = rho >> 4, i = rho & 15; return 8 * (i >> 2) + 4 * n + (i & 3); }

struct Unit { int pm, pn; };
struct Gemm { const bf16_t* A; const bf16_t* Bt; int M, N, K; };

struct StaticOrder {
    int nM, nN, nwg, G, c;
    __host__ __device__ void init(int M, int N, int G_, int c_) { nM = M / BM; nN = N / BM; nwg = nM * nN; G = G_; c = c_; }
    __host__ __device__ bool next(int i, Unit& u) const {
        const long L = (long)i * G + c; if (L >= nwg) return false;
        int wgid = (int)L; { const int q = nwg / NXCD, r = nwg % NXCD, xcd = wgid % NXCD, off = wgid / NXCD; wgid = (xcd < r ? xcd * (q + 1) : r * (q + 1) + (xcd - r) * q) + off; }
        const int nig = WGM * nN, gid = wgid / nig, fm = gid * WGM, gsz = (nM - fm) < WGM ? (nM - fm) : WGM;
        u.pm = fm + ((wgid % nig) % gsz); u.pn = (wgid % nig) / gsz; return true;
    }
    __device__ __forceinline__ void a_ready(const Unit&) const {}
    __device__ __forceinline__ void done(const Unit&) const {}
};

__device__ __forceinline__ unsigned cvt_pk_bf16(float lo, float hi) { unsigned r; asm volatile("v_cvt_pk_bf16_f32 %0, %1, %2" : "=v"(r) : "v"(lo), "v"(hi)); return r; }
typedef float f32x2 __attribute__((ext_vector_type(2)));typedef unsigned u32x2 __attribute__((ext_vector_type(2)));
__device__ __forceinline__ u32x4 pack8(const f32x4 a, const f32x4 b) { u32x4 w; w.x = cvt_pk_bf16(a[0], a[1]); w.y = cvt_pk_bf16(a[2], a[3]); w.z = cvt_pk_bf16(b[0], b[1]); w.w = cvt_pk_bf16(b[2], b[3]); return w; }
__device__ __forceinline__ float sigm(float x) { return __builtin_amdgcn_rcpf(1.0f + __builtin_amdgcn_exp2f(-x * LOG2E)); }
__device__ __forceinline__ float quad_sum(float s) { s += __shfl_xor(s, 16); s += __shfl_xor(s, 32); return s; }
struct Epi1 {
    static constexpr bool PERM = true, AFTER_DRAIN = false;
    const float* rx; const float* qg; const float* kg; bf16_t* Q; unsigned char* KVP; unsigned char* KVS; bf16_t* GLU; float* out;
    __device__ __forceinline__ void operator()(const f32x4 (&acc)[2][2][4][2], const Unit& u, int wr, int wc, int fr, int fq) const {
        const int pn = u.pn, rowt = u.pm * BM + wr * 64 + fr;
        float rxv[2][4];
#pragma unroll
        for (int ai = 0; ai < 2; ++ai)
#pragma unroll
            for (int m = 0; m < 4; ++m) rxv[ai][m] = rx[rowt + ai * HALF + m * 16];
        if (pn < 6) {
            const int sec = pn >> 1, col = (4 * (pn & 1) + wc) * 64 + 8 * fq;
            f32x4 g[2][2];
#pragma unroll
            for (int bj = 0; bj < 2; ++bj)
#pragma unroll
                for (int n = 0; n < 2; ++n) { g[bj][n] = (f32x4){1.f, 1.f, 1.f, 1.f};
                    if (sec == 0) g[bj][n] = *(const f32x4*)(qg + 32 * bj + 8 * fq + 4 * n) * QSCALE;
                    if (sec == 1) g[bj][n] = *(const f32x4*)(kg + 32 * bj + 8 * fq + 4 * n); }
#pragma unroll
            for (int ai = 0; ai < 2; ++ai)
#pragma unroll
                for (int m = 0; m < 4; ++m) {
                    const int row = rowt + ai * HALF + m * 16; const float r = rxv[ai][m];
                    f32x4 z[2][2];
#pragma unroll
                    for (int bj = 0; bj < 2; ++bj)
#pragma unroll
                        for (int n = 0; n < 2; ++n) z[bj][n] = acc[ai][bj][m][n] * r;
                    if (sec < 2) {
                        float ss = 0.f;
#pragma unroll
                        for (int bj = 0; bj < 2; ++bj)
#pragma unroll
                            for (int n = 0; n < 2; ++n) { const f32x4 q = z[bj][n] * z[bj][n]; ss += (q[0] + q[1]) + (q[2] + q[3]); }
                        ss = quad_sum(ss);
                        const float rn = rsqrtf(ss * (1.0f / 64.0f) + EPS);
#pragma unroll
                        for (int bj = 0; bj < 2; ++bj)
#pragma unroll
                            for (int n = 0; n < 2; ++n) z[bj][n] = z[bj][n] * rn * g[bj][n];
                    }
                    const int sb = (row - RP) >> 5, si = (row - RP) & 31;
                    float* fo = nullptr;
                    if (sec == 0) {
#pragma unroll
                        for (int bj = 0; bj < 2; ++bj) *(u32x4*)(Q + (size_t)row * 512 + col + 32 * bj) = pack8(z[bj][0], z[bj][1]);
                    } else {
                        unsigned char* tb; int kv;
                        if (row < RP) { tb = KVP + (size_t)(row >> 6) * KVT_BYTES; kv = row & 63;
                            const int t = row & (SEQ - 1); if (t >= SEQ - 512) fo = out + OKP + (size_t)(sec - 1) * (OVP - OKP) + ((size_t)((row >> 13) * 512 + (t - (SEQ - 512)))) * 512 + col; }
                        else { tb = KVS + (size_t)(sb * 9 + 8) * KVT_BYTES; kv = si; fo = out + OKS + (size_t)(sec - 1) * (OVS - OKS) + ((size_t)(sb * 512 + 480 + si)) * 512 + col; }
                        tb += (pn & 1) * 65536 + wc * 16384;
                        const int ok = fq * 1024 + kv * 16, ov = 8192 + (kv >> 4) * 1024 + (kv & 15) * 64 + fq * 16;
#pragma unroll
                        for (int bj = 0; bj < 2; ++bj) *(u32x4*)(tb + (sec == 1 ? ok + bj * 4096 : ov + bj * 4096)) = pack8(z[bj][0], z[bj][1]);
                    }
                    if (fo) {
#pragma unroll
                        for (int bj = 0; bj < 2; ++bj)
#pragma unroll
                            for (int n = 0; n < 2; ++n) *(f32x4*)(fo + 32 * bj + 4 * n) = z[bj][n]; }
                }
        } else {
            const int col = 128 * (pn - 6) + 32 * wc + 8 * fq;
#pragma unroll
            for (int ai = 0; ai < 2; ++ai)
#pragma unroll
                for (int m = 0; m < 4; ++m) {
                    const int row = rowt + ai * HALF + m * 16; const float r = rxv[ai][m];
                    f32x4 gl[2];
#pragma unroll
                    for (int n = 0; n < 2; ++n) { const f32x4 a = acc[ai][0][m][n] * r, b = acc[ai][1][m][n] * r;
#pragma unroll
                        for (int e = 0; e < 4; ++e) gl[n][e] = a[e] * sigm(b[e]); }
                    *(u32x4*)(GLU + (size_t)row * 512 + col) = pack8(gl[0], gl[1]);
                    float* fo = nullptr;
                    if (row < RP) { const int t = row & (SEQ - 1); if (t >= SEQ - CH) fo = out + OCP + ((size_t)((row >> 13) * CH + (t - (SEQ - CH)))) * CW + col; }
                    else { const int sb = (row - RP) >> 5, si = (row - RP) & 31; if (si >= DS - CH) fo = out + OCS + ((size_t)(sb * CH + (si - (DS - CH)))) * CW + col; }
                    if (fo) { *(f32x4*)(fo) = gl[0]; *(f32x4*)(fo + 4) = gl[1]; }
                }
        }
    }
};
struct EpiPP {
    static constexpr bool PERM = true, AFTER_DRAIN = false;
    bf16_t* O;
    __device__ __forceinline__ void operator()(const f32x4 (&acc)[2][2][4][2], const Unit& u, int wr, int wc, int fr, int fq) const {
        const int rowt = u.pm * BM + wr * 64 + fr, col = u.pn * BM + 32 * wc + 8 * fq;
#pragma unroll
        for (int ai = 0; ai < 2; ++ai)
#pragma unroll
            for (int m = 0; m < 4; ++m) { bf16_t* rowp = O + (size_t)(rowt + ai * HALF + m * 16) * D + col;
#pragma unroll
                for (int bj = 0; bj < 2; ++bj) *(u32x4*)(rowp + bj * HALF) = pack8(acc[ai][bj][m][0], acc[ai][bj][m][1]); }
    }
};
__device__ __forceinline__ f32x4 bf_lo4(const u32x4 w) { return (f32x4){__uint_as_float(w.x << 16), __uint_as_float(w.x & 0xffff0000u), __uint_as_float(w.y << 16), __uint_as_float(w.y & 0xffff0000u)}; }
__device__ __forceinline__ f32x4 bf_hi4(const u32x4 w) { return (f32x4){__uint_as_float(w.z << 16), __uint_as_float(w.z & 0xffff0000u), __uint_as_float(w.w << 16), __uint_as_float(w.w & 0xffff0000u)}; }
template <bool BF> struct EpiRes {
    static constexpr bool PERM = true, AFTER_DRAIN = false;
    const float* bp; const float* bs; bf16_t* HB; float* SS;
    __device__ __forceinline__ void operator()(const f32x4 (&acc)[2][2][4][2], const Unit& u, int wr, int wc, int fr, int fq) const {
        const int rowt = u.pm * BM + wr * 64 + fr, col = u.pn * BM + 32 * wc + 8 * fq;
        f32x4 bv[2][2][2];
        auto ldbase = [&](int i, f32x4 (&d)[2][2]) {
            const int row = rowt + (i >> 2) * HALF + (i & 3) * 16;
            if (BF) { const bf16_t* hrow = HB + (size_t)row * D + col;
#pragma unroll
                for (int bj = 0; bj < 2; ++bj) { const u32x4 w = *(const u32x4*)(hrow + bj * HALF); d[bj][0] = bf_lo4(w); d[bj][1] = bf_hi4(w); } }
            else { const float* brow = (row < RP ? bp + (size_t)row * D : bs + (size_t)(row - RP) * D) + col;
#pragma unroll
                for (int bj = 0; bj < 2; ++bj) { d[bj][0] = *(const f32x4*)(brow + bj * HALF); d[bj][1] = *(const f32x4*)(brow + bj * HALF + 4); } } };
        ldbase(0, bv[0]);
#pragma unroll
        for (int i = 0; i < 8; ++i) {
            const int ai = i >> 2, m = i & 3, row = rowt + ai * HALF + m * 16;
            if (i + 1 < 8) ldbase(i + 1, bv[(i + 1) & 1]);
            bf16_t* hrow = HB + (size_t)row * D + col;
            float ss = 0.f;
#pragma unroll
            for (int bj = 0; bj < 2; ++bj) {
                const f32x4 v0 = bv[i & 1][bj][0] + acc[ai][bj][m][0], v1 = bv[i & 1][bj][1] + acc[ai][bj][m][1];
                *(u32x4*)(hrow + bj * HALF) = pack8(v0, v1);
                const f32x4 q0 = v0 * v0, q1 = v1 * v1; ss += ((q0[0] + q0[1]) + (q0[2] + q0[3])) + ((q1[0] + q1[1]) + (q1[2] + q1[3]));
            }
            ss = quad_sum(ss);
            if (fq == 0) SS[(size_t)row * 16 + 4 * u.pn + wc] = ss;
        }
    }
};
__device__ __forceinline__ float row_rs(const float* SS, int row, int fq) {
    const f32x4 s4 = *(const f32x4*)(SS + (size_t)row * 16 + 4 * fq);
    return rsqrtf(quad_sum((s4[0] + s4[1]) + (s4[2] + s4[3])) * (1.0f / D) + EPS);
}
struct EpiAct {
    static constexpr bool PERM = true, AFTER_DRAIN = false;
    const float* SS; bf16_t* ACT;
    __device__ __forceinline__ void operator()(const f32x4 (&acc)[2][2][4][2], const Unit& u, int wr, int wc, int fr, int fq) const {
        const int rowt = u.pm * BM + wr * 64 + fr, col = 128 * u.pn + 32 * wc + 8 * fq;
        float rv[2][4];
#pragma unroll
        for (int ai = 0; ai < 2; ++ai)
#pragma unroll
            for (int m = 0; m < 4; ++m) rv[ai][m] = row_rs(SS, rowt + ai * HALF + m * 16, fq);
#pragma unroll
        for (int ai = 0; ai < 2; ++ai)
#pragma unroll
            for (int m = 0; m < 4; ++m) {
                const int row = rowt + ai * HALF + m * 16; const float r = rv[ai][m];
                f32x4 v[2];
#pragma unroll
                for (int n = 0; n < 2; ++n) { const f32x4 g = acc[ai][0][m][n] * r, up = acc[ai][1][m][n] * r;
#pragma unroll
                    for (int e = 0; e < 4; ++e) v[n][e] = g[e] * sigm(g[e]) * up[e]; }
                *(u32x4*)(ACT + (size_t)row * DFF + col) = pack8(v[0], v[1]);
            }
    }
};
struct EpiFinal {
    static constexpr bool PERM = true, AFTER_DRAIN = false;
    const float* SS; const bf16_t* PP; const bf16_t* HB; float* Y;
    __device__ __forceinline__ void operator()(const f32x4 (&acc)[2][2][4][2], const Unit& u, int wr, int wc, int fr, int fq) const {
        const int rowt = u.pm * BM + wr * 64 + fr, col = u.pn * BM + 32 * wc + 8 * fq;
        float rv[2][4];
#pragma unroll
        for (int ai = 0; ai < 2; ++ai)
#pragma unroll
            for (int m = 0; m < 4; ++m) rv[ai][m] = row_rs(SS, rowt + ai * HALF + m * 16, fq);
        u32x4 pwv[2][2], hwv[2][2];
        auto ld = [&](int i, u32x4 (&p)[2], u32x4 (&h)[2]) { const size_t o = (size_t)(rowt + (i >> 2) * HALF + (i & 3) * 16) * D + col;
#pragma unroll
            for (int bj = 0; bj < 2; ++bj) { p[bj] = *(const u32x4*)(PP + o + bj * HALF); h[bj] = *(const u32x4*)(HB + o + bj * HALF); } };
        ld(0, pwv[0], hwv[0]);
#pragma unroll
        for (int i = 0; i < 8; ++i) {
            const int ai = i >> 2, m = i & 3, row = rowt + ai * HALF + m * 16; const float r = rv[ai][m];
            if (i + 1 < 8) ld(i + 1, pwv[(i + 1) & 1], hwv[(i + 1) & 1]);
#pragma unroll
            for (int bj = 0; bj < 2; ++bj) {
                const size_t o = (size_t)row * D + col + bj * HALF;
                const u32x4 pw = pwv[i & 1][bj], hw = hwv[i & 1][bj];
                const f32x4 a0 = acc[ai][bj][m][0] * r, a1 = acc[ai][bj][m][1] * r, p0 = bf_lo4(pw), p1 = bf_hi4(pw);
                f32x4 h0 = bf_lo4(hw), h1 = bf_hi4(hw);
#pragma unroll
                for (int e2 = 0; e2 < 4; ++e2) { h0[e2] += sigm(a0[e2]) * p0[e2]; h1[e2] += sigm(a1[e2]) * p1[e2]; }
                *(f32x4*)(Y + o) = h0; *(f32x4*)(Y + o + 4) = h1;
            }
        }
    }
};

template <class Epi, class Sched, bool ALIGN_EPI = false, bool SP2 = false>
__device__ __forceinline__ void gemm_phase(PG8_LAS unsigned char* lds, const Gemm g, const Sched& S, const Epi& E) {
    int tid_ = threadIdx.x; asm volatile("" : "+v"(tid_));
    const int tid = tid_, wid = __builtin_amdgcn_readfirstlane(tid >> 6), lane = tid & 63, wr = wid >> 2, wc = wid & 3, fr = lane & 15, fq = lane >> 4;
    int K_ = g.K; asm volatile("" : "+s"(K_));
    const int K = K_, nt = K / BK;
    unsigned voffA[2], voffB[2];
#pragma unroll
    for (int i = 0; i < 2; ++i) { int R, C; stage_rc(tid * 16 + i * 8192, R, C); const int Rb = Epi::PERM ? ((R & ~31) + perm32(R & 31)) : R;
        voffA[i] = (unsigned)(R * K + C) * 2u; voffB[i] = (unsigned)(Rb * K + C) * 2u; }
    const size_t kstep = (size_t)(BK * 2);
    const size_t hstep = (size_t)HALF * K * 2;
    const size_t tstep = 2 * hstep;
    const unsigned ldsw = (unsigned)wid * 1024u;
    const int aoff = lds_byte(wr * 64 + fr, fq * 8), boff = lds_byte(wc * 32 + fr, fq * 8);
#define PG8_SA(b, h) (((b) * 2 + (h)) * HTB)
#define PG8_SB(b, h) ((4 + (b) * 2 + (h)) * HTB)
#define PG8_STAGE(bufoff, gbase, voff) do { _Pragma("unroll") for (int _i = 0; _i < 2; ++_i) \
        __builtin_amdgcn_global_load_lds((const unsigned*)((const char*)(gbase) + (voff)[_i]), (PG8_LAS unsigned*)(lds + (bufoff) + ldsw + _i * 8192), 16, 0, 0); } while (0)
#define PG8_LDA(dst, b, h) do { _Pragma("unroll") for (int m = 0; m < 4; ++m) _Pragma("unroll") for (int k = 0; k < 2; ++k) dst[m][k] = *(const PG8_LAS bf16x8*)(lds + PG8_SA(b, h) + aoff + m * 2048 + k * 1024); } while (0)
#define PG8_LDB(dst, b, h) do { _Pragma("unroll") for (int n = 0; n < 2; ++n) _Pragma("unroll") for (int k = 0; k < 2; ++k) dst[n][k] = *(const PG8_LAS bf16x8*)(lds + PG8_SB(b, h) + boff + n * 2048 + k * 1024); } while (0)
#define PG8_MMA(ai, bj, At, Bt) do { __builtin_amdgcn_s_setprio(1); _Pragma("unroll") for (int m = 0; m < 4; ++m) _Pragma("unroll") for (int n = 0; n < 2; ++n) _Pragma("unroll") for (int k = 0; k < 2; ++k) \
        acc[ai][bj][m][n] = __builtin_amdgcn_mfma_f32_16x16x32_bf16(Bt[n][k], At[m][k], acc[ai][bj][m][n], 0, 0, 0); __builtin_amdgcn_s_setprio(0); } while (0)
#define PG8_WAIT_V(n) asm volatile("s_waitcnt vmcnt(" #n ")" ::: "memory")
#define PG8_WAIT_L(n) asm volatile("s_waitcnt lgkmcnt(" #n ")" ::: "memory")
#define PG8_BAR __builtin_amdgcn_s_barrier()
#define PG8_SCHED __builtin_amdgcn_sched_barrier(0)
    Unit cur, nxt; int ui = 0;
    if (!S.next(0, cur)) return;
    f32x4 acc[2][2][4][2];
#pragma unroll
    for (int a = 0; a < 2; ++a)
#pragma unroll
        for (int b = 0; b < 2; ++b)
#pragma unroll
            for (int m = 0; m < 4; ++m)
#pragma unroll
                for (int n = 0; n < 2; ++n) acc[a][b][m][n] = (f32x4){0.f, 0.f, 0.f, 0.f};
    bf16x8 At[4][2], B0[2][2], B1[2][2];
    const char* cA = (const char*)g.A + (size_t)cur.pm * tstep; const char* cB = (const char*)g.Bt + (size_t)cur.pn * tstep;
    S.a_ready(cur);
    if constexpr (SP2) {
        PG8_STAGE(PG8_SB(0, 0), cB, voffB); PG8_STAGE(PG8_SB(0, 1), cB + hstep, voffB); PG8_STAGE(PG8_SA(0, 0), cA, voffA); PG8_STAGE(PG8_SA(0, 1), cA + hstep, voffA);
        if (wr == 1) PG8_BAR;
        PG8_WAIT_V(2); PG8_BAR;
        PG8_STAGE(PG8_SB(1, 0), cB + kstep, voffB); PG8_STAGE(PG8_SA(1, 0), cA + kstep, voffA); PG8_STAGE(PG8_SB(1, 1), cB + hstep + kstep, voffB);
        PG8_WAIT_V(6); PG8_BAR;
    } else {
        PG8_STAGE(PG8_SB(0, 0), cB, voffB); PG8_STAGE(PG8_SA(0, 0), cA, voffA); PG8_STAGE(PG8_SB(0, 1), cB + hstep, voffB); PG8_STAGE(PG8_SA(0, 1), cA + hstep, voffA);
        if (wr == 1) PG8_BAR;
        PG8_WAIT_V(4); PG8_BAR;
        PG8_STAGE(PG8_SB(1, 0), cB + kstep, voffB); PG8_STAGE(PG8_SA(1, 0), cA + kstep, voffA); PG8_STAGE(PG8_SB(1, 1), cB + hstep + kstep, voffB);
        PG8_WAIT_V(6); PG8_BAR;
    }
    for (;;) {
        const bool has_next = S.next(ui + 1, nxt);
        const char* nA = has_next ? (const char*)g.A + (size_t)nxt.pm * tstep : cA; const char* nB = has_next ? (const char*)g.Bt + (size_t)nxt.pn * tstep : cB;
        for (int t = 0; t < nt; t += 2) {
            const bool last = (t == nt - 2);
            const char* a1 = cA + (size_t)(t + 1) * kstep;
            const char* a2 = last ? nA : cA + (size_t)(t + 2) * kstep; const char* b2 = last ? nB : cB + (size_t)(t + 2) * kstep;
            const char* a3 = a2 + kstep; const char* b3 = b2 + kstep;
            if (last && has_next) S.a_ready(nxt);
            if constexpr (SP2) {
            PG8_LDB(B0, 0, 0); PG8_LDB(B1, 0, 1); PG8_SCHED; PG8_LDA(At, 0, 0); PG8_STAGE(PG8_SA(1, 1), a1 + hstep, voffA);
            PG8_WAIT_V(8); PG8_WAIT_L(0); PG8_BAR; PG8_MMA(0, 0, At, B0); PG8_MMA(0, 1, At, B1); PG8_BAR; PG8_SCHED;
            PG8_LDA(At, 0, 1); PG8_STAGE(PG8_SB(0, 0), b2, voffB); PG8_STAGE(PG8_SB(0, 1), b2 + hstep, voffB); PG8_STAGE(PG8_SA(0, 0), a2, voffA);
            PG8_WAIT_V(8); PG8_WAIT_L(0); PG8_BAR; PG8_MMA(1, 0, At, B0); PG8_MMA(1, 1, At, B1); PG8_BAR; PG8_SCHED;
            PG8_LDB(B0, 1, 0); PG8_LDB(B1, 1, 1); PG8_SCHED; PG8_LDA(At, 1, 0); PG8_STAGE(PG8_SA(0, 1), a2 + hstep, voffA);
            PG8_WAIT_V(8); PG8_WAIT_L(0); PG8_BAR; PG8_MMA(0, 0, At, B0); PG8_MMA(0, 1, At, B1); PG8_BAR; PG8_SCHED;
            PG8_LDA(At, 1, 1); PG8_STAGE(PG8_SB(1, 0), b3, voffB); PG8_STAGE(PG8_SB(1, 1), b3 + hstep, voffB); PG8_STAGE(PG8_SA(1, 0), a3, voffA);
            PG8_WAIT_V(8); PG8_WAIT_L(0); PG8_BAR; PG8_MMA(1, 0, At, B0); PG8_MMA(1, 1, At, B1); PG8_BAR; PG8_SCHED;
            } else {
            PG8_LDB(B0, 0, 0); PG8_SCHED; PG8_LDA(At, 0, 0); PG8_STAGE(PG8_SA(1, 1), a1 + hstep, voffA);
            PG8_WAIT_L(8); PG8_BAR; PG8_WAIT_L(0); PG8_MMA(0, 0, At, B0); PG8_BAR; PG8_SCHED;
            PG8_LDB(B1, 0, 1); PG8_STAGE(PG8_SB(0, 0), b2, voffB);
            PG8_BAR; PG8_WAIT_L(0); PG8_MMA(0, 1, At, B1); PG8_BAR;
            PG8_LDA(At, 0, 1); PG8_STAGE(PG8_SA(0, 0), a2, voffA);
            PG8_BAR; PG8_WAIT_L(0); PG8_MMA(1, 0, At, B0); PG8_BAR; PG8_SCHED;
            PG8_STAGE(PG8_SB(0, 1), b2 + hstep, voffB);
            PG8_WAIT_V(6); PG8_BAR; PG8_MMA(1, 1, At, B1); PG8_BAR;
            PG8_LDB(B0, 1, 0); PG8_SCHED; PG8_LDA(At, 1, 0); PG8_STAGE(PG8_SA(0, 1), a2 + hstep, voffA);
            PG8_WAIT_L(8); PG8_BAR; PG8_WAIT_L(0); PG8_MMA(0, 0, At, B0); PG8_BAR; PG8_SCHED;
            PG8_LDB(B1, 1, 1); PG8_STAGE(PG8_SB(1, 0), b3, voffB);
            PG8_BAR; PG8_WAIT_L(0); PG8_MMA(0, 1, At, B1); PG8_BAR;
            PG8_LDA(At, 1, 1); PG8_STAGE(PG8_SA(1, 0), a3, voffA);
            PG8_BAR; PG8_WAIT_L(0); PG8_MMA(1, 0, At, B0); PG8_BAR; PG8_SCHED;
            PG8_STAGE(PG8_SB(1, 1), b3 + hstep, voffB);
            PG8_WAIT_V(6); PG8_BAR; PG8_MMA(1, 1, At, B1); PG8_BAR;
            }
        }
        if constexpr (ALIGN_EPI) { if (wr == 0) PG8_BAR; }
        if constexpr (!Epi::AFTER_DRAIN) { E(acc, cur, wr, wc, fr, fq); S.done(cur); }
        if (!has_next) break;
#pragma unroll
        for (int a = 0; a < 2; ++a)
#pragma unroll
            for (int b = 0; b < 2; ++b)
#pragma unroll
                for (int m = 0; m < 4; ++m)
#pragma unroll
                    for (int n = 0; n < 2; ++n) acc[a][b][m][n] = (f32x4){0.f, 0.f, 0.f, 0.f};
        cur = nxt; cA = nA; cB = nB; ++ui;
        if constexpr (ALIGN_EPI) { if (wr == 1) PG8_BAR; }
    }
    PG8_WAIT_V(0);
    if constexpr (!ALIGN_EPI) { if (wr == 0) PG8_BAR; }
    PG8_BAR;
    if constexpr (Epi::AFTER_DRAIN) { E.fused(acc, cur, wr, wc, fr, fq, lds, wid, lane); S.done(cur); }
#undef PG8_SA
#undef PG8_SB
#undef PG8_STAGE
#undef PG8_LDA
#undef PG8_LDB
#undef PG8_MMA
#undef PG8_WAIT_V
#undef PG8_WAIT_L
#undef PG8_BAR
#undef PG8_SCHED
}
}
#define GAS __attribute__((address_space(1)))
#define LAS __attribute__((address_space(3)))
typedef unsigned short bf16;
typedef unsigned v4u __attribute__((ext_vector_type(4)));
typedef float f32x4 __attribute__((ext_vector_type(4)));
typedef short bf16x8 __attribute__((ext_vector_type(8)));
typedef GAS unsigned gu32;
typedef GAS unsigned long long gu64;
#define RLX_AGENT __ATOMIC_RELAXED, __HIP_MEMORY_SCOPE_AGENT
#define LDS_WAIT() asm volatile("s_waitcnt lgkmcnt(0)" ::: "memory")
#define VM_WAIT() asm volatile("s_waitcnt vmcnt(0)" ::: "memory")
__device__ __forceinline__ unsigned long long rt() { return __builtin_amdgcn_s_memrealtime(); }
__device__ __forceinline__ unsigned f2bf(float f) { unsigned u = __builtin_bit_cast(unsigned, f); return (u + 0x7fffu + ((u >> 16) & 1u)) >> 16; }
__device__ __forceinline__ unsigned pk2(float lo, float hi) { return f2bf(lo) | (f2bf(hi) << 16); }
#define XB_TMO      128
#define XB_XCNT(j)  (256  + 64 * (j))
#define XB_XSUB(j)  (1280 + 64 * (j))
#define XB_XGEN(j)  (2304 + 64 * (j))
#define XB_TOP      3328
#define XB_TOPGEN   3392
#define XCD_BAR_WORDS 3456
#define XB_SPIN_CAP (1u << 18)

__device__ __forceinline__ unsigned xb_ld(unsigned* p)              { return __hip_atomic_load(p, __ATOMIC_RELAXED, __HIP_MEMORY_SCOPE_AGENT); }
__device__ __forceinline__ unsigned xb_add(unsigned* p, unsigned v) { return __hip_atomic_fetch_add(p, v, __ATOMIC_RELAXED, __HIP_MEMORY_SCOPE_AGENT); }
__device__ __forceinline__ unsigned xb_xcc_id() { return (unsigned)__builtin_amdgcn_s_getreg((3 << 11) | 20) & 0xFu; }
#define XB_SPIN(cond, bar) do { unsigned _sp = 0; while (cond) { __builtin_amdgcn_s_sleep(1); \
    if ((++_sp & 255u) == 0u) { if (xb_ld(&(bar)[XB_TMO])) break; if (_sp > XB_SPIN_CAP) { atomicAdd(&(bar)[XB_TMO], 1u); break; } } } } while (0)

struct XcdBarrier {
    unsigned* bar; unsigned x;
    volatile LAS unsigned* st;
};

__device__ __forceinline__ XcdBarrier xcd_barrier_post(unsigned* bar, volatile LAS unsigned* st) {
    XcdBarrier b; b.bar = bar; b.x = xb_xcc_id(); b.st = st;
    if (threadIdx.x == 0) (void)xb_add(&bar[XB_XCNT(b.x)], 1u);
    return b;
}
__device__ __forceinline__ void xcd_barrier_complete(unsigned* bar, unsigned x, unsigned& nloc, unsigned& nx) {
    const unsigned G = gridDim.x * gridDim.y * gridDim.z;
    unsigned sum, cnt, mine, sp = 0u;
    for (;;) {
        sum = 0u; cnt = 0u; mine = 0u;
#pragma unroll
        for (unsigned j = 0; j < 16; ++j) { const unsigned c = xb_ld(&bar[XB_XCNT(j)]); sum += c; cnt += (c > 0u) ? 1u : 0u; mine = (j == x) ? c : mine; }
        if (sum == G) break;
        __builtin_amdgcn_s_sleep(1);
        if ((++sp & 255u) == 0u) { if (xb_ld(&bar[XB_TMO])) break; if (sp > XB_SPIN_CAP) { atomicAdd(&bar[XB_TMO], 1u); break; } }
    }
    nloc = mine > 0u ? mine : 1u; nx = cnt > 0u ? cnt : 1u;
}

__device__ __forceinline__ void xcd_barrier(const XcdBarrier& b) {
    asm volatile("s_waitcnt vmcnt(0)" ::: "memory");
    __syncthreads();
    if (threadIdx.x == 0) {
        unsigned* bar = b.bar;
        __builtin_amdgcn_s_waitcnt(0);
        unsigned nloc = b.st[0], nx = b.st[1];
        if (nloc == 0u) { xcd_barrier_complete(bar, b.x, nloc, nx); b.st[0] = nloc; b.st[1] = nx; }
        const unsigned old = xb_add(&bar[XB_XSUB(b.x)], 1u);
        const unsigned gen = old / nloc;
        if (old + 1u == (gen + 1u) * nloc) {
            __builtin_amdgcn_fence(__ATOMIC_RELEASE, "agent");
            asm volatile("s_waitcnt vmcnt(0)" ::: "memory");
            const unsigned og = xb_add(&bar[XB_TOP], 1u);
            const unsigned tg = og / nx;
            if (og + 1u == (tg + 1u) * nx) xb_add(&bar[XB_TOPGEN], 1u);
            else XB_SPIN(xb_ld(&bar[XB_TOPGEN]) == tg, bar);
            __builtin_amdgcn_fence(__ATOMIC_ACQUIRE, "agent");
            xb_add(&bar[XB_XGEN(b.x)], 1u);
            asm volatile("s_waitcnt vmcnt(0)" ::: "memory");
        } else {
            __builtin_amdgcn_fence(__ATOMIC_ACQUIRE, "agent");
            XB_SPIN(xb_ld(&bar[XB_XGEN(b.x)]) == gen, bar);
            asm volatile("s_waitcnt vmcnt(0)" ::: "memory");
        }
    }
    __syncthreads();
}
constexpr int NWAVES = 8;
constexpr size_t MiB = 1u << 20;
constexpr size_t WS_CTL = 0, CTL_ZERO_BYTES = 65536;
constexpr size_t WS_W1 = 1 * MiB, WS_WO = 6 * MiB, WS_WGU = 8 * MiB, WS_WD = 19 * MiB, WS_WPG = 25 * MiB, WS_WPP = 27 * MiB;
constexpr size_t WS_RX = 28 * MiB, WS_SS1 = 29 * MiB, WS_SS2 = 32 * MiB;
constexpr size_t WS_XB = 36 * MiB;
constexpr size_t WS_PB = 102 * MiB, WS_PP = 119 * MiB;
constexpr size_t WS_Q = 185 * MiB, WS_KP = 218 * MiB, WS_VP = 250 * MiB, WS_KS = 282 * MiB, WS_VS = 300 * MiB, WS_GLU = 318 * MiB, WS_MIX = 351 * MiB;
constexpr size_t WS_ACT = 185 * MiB;
constexpr size_t WS_END = 417 * MiB;
static_assert(WS_XB + (size_t)R * D * 2 <= WS_PB && WS_PB + (size_t)R * PLE * 2 <= WS_PP && WS_PP + (size_t)R * D * 2 <= WS_Q && WS_Q + (size_t)R * 512 * 2 <= WS_KP &&
              WS_KP + (size_t)(RP / 64) * KVT_BYTES <= WS_KS && WS_KS + (size_t)DB * 9 * KVT_BYTES <= WS_GLU && WS_GLU + (size_t)R * 512 * 2 <= WS_MIX &&
              WS_MIX + (size_t)R * D * 2 <= WS_END && WS_ACT + (size_t)R * DFF * 2 <= WS_END && WS_SS1 + (size_t)R * 64 <= WS_SS2 && WS_SS2 + (size_t)R * 64 <= WS_XB && WS_RX + (size_t)R * 4 <= WS_SS1, "d_ws map");
constexpr int CW_BAR = 4096, CW_Q = 8192, CW_QG = CW_Q + 64 * 32;
constexpr int RING_OFF = 0, RING_BYTES = 131072;
constexpr int LDSCTL_OFF = RING_BYTES, MISC_OFF = LDSCTL_OFF + 320;
constexpr int ATT_TAB = 132096, ATT_LSC = ATT_TAB + 8192;
constexpr int LDS_BYTES = 147456;
static_assert(ATT_LSC + 2048 <= LDS_BYTES && MISC_OFF + 128 <= ATT_TAB, "LDS map");

__device__ __forceinline__ float wave_sum(float v) {
#pragma unroll
    for (int o = 1; o < 64; o <<= 1) v += __shfl_xor(v, o);
    return v;
}
__device__ __forceinline__ float wave_max(float v) {
#pragma unroll
    for (int o = 1; o < 64; o <<= 1) v = fmaxf(v, __shfl_xor(v, o));
    return v;
}
__device__ __forceinline__ int map_win(int n) {
    if (n < 1536) { const int sec = n >> 9, nn = n & 511, h = nn >> 6, d = nn & 63; return sec * 512 + 256 * (h >> 2) + 128 * (d >> 5) + 32 * (h & 3) + (d & 31); }
    if (n < 2048) { const int i = n - 1536; return 1536 + 256 * (i >> 7) + (i & 127); }
    const int i = n - 2048; return 1536 + 256 * (i >> 7) + 128 + (i & 127);
}
__device__ __forceinline__ int map_gu(int n) {
    if (n < DFF) return 256 * (n >> 7) + (n & 127);
    const int i = n - DFF; return 256 * (i >> 7) + 128 + (i & 127);
}
template <int MAP> __device__ __forceinline__ void p0_transpose_item(const float* W, const float* gain, int K, int N, bf16* WT, LAS float* scr, int item, int lane) {
    const int nblk = N / 32, kb = item / nblk, nb = item % nblk, k0 = 64 * kb, n0 = 32 * nb;
    { const int nq = lane & 7, kr = lane >> 3; f32x4 v[8];
#pragma unroll
      for (int i = 0; i < 8; ++i) v[i] = *(const GAS f32x4*)(W + (size_t)(k0 + 8 * i + kr) * N + n0 + 4 * nq);
#pragma unroll
      for (int i = 0; i < 8; ++i) { const int kk = 8 * i + kr; const float gk = gain ? gain[k0 + kk] : 1.0f;
#pragma unroll
          for (int e = 0; e < 4; ++e) scr[kk * 33 + 4 * nq + e] = v[i][e] * gk; } }
    LDS_WAIT(); asm volatile("" ::: "memory");
    const int c = lane & 7;
#pragma unroll
    for (int j = 0; j < 4; ++j) { const int n = (lane >> 3) + 8 * j; const LAS float* s = scr + (8 * c) * 33 + n;
        v4u o; o.x = pk2(s[0 * 33], s[1 * 33]); o.y = pk2(s[2 * 33], s[3 * 33]); o.z = pk2(s[4 * 33], s[5 * 33]); o.w = pk2(s[6 * 33], s[7 * 33]);
        const int ns = n0 + n, dr = MAP == 0 ? ns : (MAP == 1 ? map_win(ns) : map_gu(ns));
        *(GAS v4u*)(WT + (size_t)dr * K + k0 + 8 * c) = o; }
    LDS_WAIT(); asm volatile("" ::: "memory");
}

namespace att {
typedef short bf16x8 __attribute__((ext_vector_type(8)));
typedef short s16x4 __attribute__((ext_vector_type(4)));
typedef float f32x16 __attribute__((ext_vector_type(16)));
typedef unsigned u32x4 __attribute__((ext_vector_type(4)));
typedef float f32x2_t __attribute__((ext_vector_type(2))); typedef __bf16 bf16x2_t __attribute__((ext_vector_type(2)));
typedef short v4i16_t __attribute__((ext_vector_type(4)));
typedef LAS const char* lds_cptr;
constexpr int BUFB = 65536, HSLOT = 16384;
__device__ __forceinline__ int crow(int r, int hi) { return (r & 3) + 8 * (r >> 2) + 4 * hi; }
__device__ __forceinline__ void glds16(const void* gsrc, unsigned lds_dst) { unsigned keep;
    asm volatile("s_mov_b32 %0, m0\n\ts_mov_b32 m0, %2\n\ts_nop 0\n\tglobal_load_lds_dwordx4 %1, off\n\ts_mov_b32 m0, %0" : "=&s"(keep) : "v"(gsrc), "s"(lds_dst) : "memory"); }
__device__ __forceinline__ unsigned cvtpk_s(float lo, float hi) { f32x2_t v = {lo, hi}; bf16x2_t b = __builtin_convertvector(v, bf16x2_t); return __builtin_bit_cast(unsigned, b); }
__device__ __forceinline__ s16x4 vtr(lds_cptr p) { return __builtin_bit_cast(s16x4, __builtin_amdgcn_ds_read_tr16_b64_v4i16((LAS v4i16_t*)p)); }
#define ATT_WAIT_BAR() asm volatile("s_waitcnt vmcnt(0) lgkmcnt(0)\n\ts_barrier" ::: "memory")

struct AUnit { const bf16* Qrow; const unsigned char* KV; bf16* Orow; int nt, hg, sample, c0rel; };

__device__ __forceinline__ void attn_prefetch(const AUnit& U, LAS unsigned char* lds, int wid, int lane, bf16x8 (&qr)[2][4]) {
    const int r32 = lane & 31, hi = lane >> 5, hl = wid & 3, ci = wid >> 2, head = 4 * U.hg + hl;
    const bool wact = !U.sample || ci == 0;
    const unsigned char* kvsrc = U.KV + U.hg * 65536 + wid * 1024 + lane * 16;
    const unsigned kvdst = (unsigned)(size_t)lds + wid * 1024;
#pragma unroll
    for (int j_ = 0; j_ < 8; ++j_) glds16(kvsrc + j_ * 8192, (unsigned)__builtin_amdgcn_readfirstlane(kvdst + j_ * 8192));
    const bf16* Qw = U.Qrow + (size_t)((wact ? 64 * ci : 0) + r32) * 512 + head * 64 + hi * 8; const bf16* Qw1 = Qw + (U.sample ? 0 : 32 * 512);
#pragma unroll
    for (int d0 = 0; d0 < 4; ++d0) { qr[0][d0] = *(const bf16x8*)(Qw + d0 * 16); qr[1][d0] = *(const bf16x8*)(Qw1 + d0 * 16); }
}
template <bool TWO> __device__ __forceinline__ void attn_steps(const AUnit& U, LAS unsigned char* lds, int wid, int lane, const bf16x8 (&qr)[2][4], f32x16 (&o)[2][2], float (&lsum)[2]) {
    const int r32 = lane & 31, hi = lane >> 5, hl = wid & 3, ci = wid >> 2, head = 4 * U.hg + hl, nt = U.nt, own = U.c0rel + ci;
    const bool wact = TWO || ci == 0;
    const unsigned lds0 = (unsigned)(size_t)lds;
    const LAS float* tabh = (const LAS float*)(lds + ATT_TAB) + head * 256;
    const unsigned char* kvsrc = U.KV + U.hg * 65536 + wid * 1024 + lane * 16;
    const unsigned kvdst = lds0 + wid * 1024;
#define ATT_DMA(ti, b) do { _Pragma("unroll") for (int j_ = 0; j_ < 8; ++j_) \
        glds16(kvsrc + (size_t)(ti) * KVT_BYTES + j_ * 8192, (unsigned)__builtin_amdgcn_readfirstlane(kvdst + (b) * BUFB + j_ * 8192)); } while (0)
    for (int ti = 0; ti < nt; ++ti) {
        ATT_WAIT_BAR();
        const int b = ti & 1;
        if (ti + 1 < nt) ATT_DMA(ti + 1, b ^ 1);
        const int jt = own - ti;
        if (wact && jt >= 0 && jt <= 8) {
            const float m1 = (!TWO && jt == 0) ? 0.f : 1.f;
            const lds_cptr kp = (lds_cptr)(lds + b * BUFB + hl * HSLOT + hi * 1024 + r32 * 16);
            bf16x8 kf[8];
            { const unsigned ka = (unsigned)(size_t)kp;
              asm volatile("ds_read_b128 %0, %8\n\tds_read_b128 %1, %8 offset:512\n\tds_read_b128 %2, %8 offset:2048\n\tds_read_b128 %3, %8 offset:2560\n\t"
                           "ds_read_b128 %4, %8 offset:4096\n\tds_read_b128 %5, %8 offset:4608\n\tds_read_b128 %6, %8 offset:6144\n\tds_read_b128 %7, %8 offset:6656\n\ts_waitcnt lgkmcnt(0)"
                           : "=&v"(kf[0]), "=&v"(kf[1]), "=&v"(kf[2]), "=&v"(kf[3]), "=&v"(kf[4]), "=&v"(kf[5]), "=&v"(kf[6]), "=&v"(kf[7]) : "v"(ka) : "memory");
              __builtin_amdgcn_sched_barrier(0); }
            f32x16 s[2][2]; s[0][0] = f32x16{}; s[0][1] = f32x16{}; s[1][0] = f32x16{}; s[1][1] = f32x16{};
#pragma unroll
            for (int h2 = 0; h2 < (TWO ? 2 : 1); ++h2)
#pragma unroll
                for (int d0 = 0; d0 < 4; ++d0) { s[h2][0] = __builtin_amdgcn_mfma_f32_32x32x16_bf16(kf[2 * d0], qr[h2][d0], s[h2][0], 0, 0, 0);
                                                 s[h2][1] = __builtin_amdgcn_mfma_f32_32x32x16_bf16(kf[2 * d0 + 1], qr[h2][d0], s[h2][1], 0, 0, 0); }
            u32x4 pw[2][4];
#pragma unroll
            for (int h2 = 0; h2 < (TWO ? 2 : 1); ++h2) {
                f32x16& p0 = s[h2][0]; f32x16& p1 = s[h2][1];
                if (jt < 3) { const LAS float* tp = tabh + (191 - (32 * h2 + r32) - 64 * jt + 4 * hi);
#pragma unroll
                    for (int r = 0; r < 16; ++r) { p0[r] += tp[(r & 3) + 8 * (r >> 2)]; p1[r] += tp[32 + (r & 3) + 8 * (r >> 2)]; } }
                float sacc = 0.f;
#pragma unroll
                for (int r = 0; r < 16; ++r) { p0[r] = __builtin_amdgcn_exp2f(p0[r]); p1[r] = __builtin_amdgcn_exp2f(p1[r]); if (!TWO) p1[r] *= m1; sacc += p0[r] + p1[r]; }
                lsum[h2] += sacc;
#pragma unroll
                for (int k = 0; k < 2; ++k) { pw[h2][k] = (u32x4){cvtpk_s(p0[8 * k], p0[8 * k + 1]), cvtpk_s(p0[8 * k + 2], p0[8 * k + 3]), cvtpk_s(p0[8 * k + 4], p0[8 * k + 5]), cvtpk_s(p0[8 * k + 6], p0[8 * k + 7])};
                    pw[h2][2 + k] = (u32x4){cvtpk_s(p1[8 * k], p1[8 * k + 1]), cvtpk_s(p1[8 * k + 2], p1[8 * k + 3]), cvtpk_s(p1[8 * k + 4], p1[8 * k + 5]), cvtpk_s(p1[8 * k + 6], p1[8 * k + 7])}; }
            }
            const lds_cptr vp = (lds_cptr)(lds + b * BUFB + hl * HSLOT + 8192 + ((lane >> 4) & 1) * 32 + (lane & 3) * 8 + (4 * hi + ((lane & 15) >> 2)) * 64);
            const unsigned va = (unsigned)(size_t)vp;
#pragma unroll
            for (int d0 = 0; d0 < 2; ++d0) {
                s16x4 lo[4], hh[4];
                asm volatile("ds_read_b64_tr_b16 %0, %8 offset:%c9\n\tds_read_b64_tr_b16 %1, %8 offset:%c10\n\tds_read_b64_tr_b16 %2, %8 offset:%c11\n\tds_read_b64_tr_b16 %3, %8 offset:%c12\n\t"
                             "ds_read_b64_tr_b16 %4, %8 offset:%c13\n\tds_read_b64_tr_b16 %5, %8 offset:%c14\n\tds_read_b64_tr_b16 %6, %8 offset:%c15\n\tds_read_b64_tr_b16 %7, %8 offset:%c16\n\ts_waitcnt lgkmcnt(0)"
                             : "=&v"(lo[0]), "=&v"(hh[0]), "=&v"(lo[1]), "=&v"(hh[1]), "=&v"(lo[2]), "=&v"(hh[2]), "=&v"(lo[3]), "=&v"(hh[3])
                             : "v"(va), "i"(d0 * 4096), "i"(d0 * 4096 + 512), "i"(d0 * 4096 + 1024), "i"(d0 * 4096 + 1536), "i"(d0 * 4096 + 2048), "i"(d0 * 4096 + 2560), "i"(d0 * 4096 + 3072), "i"(d0 * 4096 + 3584) : "memory");
                __builtin_amdgcn_sched_barrier(0);
#pragma unroll
                for (int ks = 0; ks < 4; ++ks) {
                    const bf16x8 vf = (bf16x8){lo[ks][0], lo[ks][1], lo[ks][2], lo[ks][3], hh[ks][0], hh[ks][1], hh[ks][2], hh[ks][3]};
                    o[0][d0] = __builtin_amdgcn_mfma_f32_32x32x16_bf16(__builtin_bit_cast(bf16x8, pw[0][ks]), vf, o[0][d0], 0, 0, 0);
                    if (TWO) o[1][d0] = __builtin_amdgcn_mfma_f32_32x32x16_bf16(__builtin_bit_cast(bf16x8, pw[1][ks]), vf, o[1][d0], 0, 0, 0); }
            }
        }
    }
#undef ATT_DMA
}
template <bool TWO> __device__ __forceinline__ void attn_store(const AUnit& U, LAS unsigned char* lds, int wid, int lane, const f32x16 (&o)[2][2], const float (&lsum)[2]) {
    const int r32 = lane & 31, hi = lane >> 5, hl = wid & 3, ci = wid >> 2, head = 4 * U.hg + hl;
    const bool wact = TWO || ci == 0;
    LAS float* lsc = (LAS float*)(lds + ATT_LSC) + wid * 64;
    if (wact) {
#pragma unroll
        for (int h2 = 0; h2 < (TWO ? 2 : 1); ++h2) {
            float ls = lsum[h2];
            { auto rr = __builtin_amdgcn_permlane32_swap(__float_as_uint(ls), __float_as_uint(ls), false, false); ls = __uint_as_float(rr[0]) + __uint_as_float(rr[1]); }
            if (hi == 0) lsc[32 * h2 + r32] = ls;
            asm volatile("s_waitcnt lgkmcnt(0)" ::: "memory");
            LAS bf16* stg = (LAS bf16*)(lds + BUFB + wid * 8192 + h2 * 4096);
#pragma unroll
            for (int r = 0; r < 16; ++r) { const int orow = crow(r, hi); const float rl = __builtin_amdgcn_rcpf(lsc[32 * h2 + orow]);
#pragma unroll
                for (int d0 = 0; d0 < 2; ++d0) stg[orow * 64 + d0 * 32 + r32] = (bf16)f2bf(o[h2][d0][r] * rl); }
            asm volatile("s_waitcnt lgkmcnt(0)" ::: "memory");
            bf16* Ow = U.Orow + (size_t)(64 * ci + 32 * h2) * D + head * 64;
#pragma unroll
            for (int i = 0; i < 4; ++i) { const int row = i * 8 + (lane >> 3), ch = lane & 7; const u32x4 v = *(const LAS u32x4*)(stg + row * 64 + ch * 8); *(u32x4*)(Ow + (size_t)row * D + ch * 8) = v; }
        }
    }
}
}

__device__ __forceinline__ void conv_item(int item, const bf16* GLU, const float* st, const float* cw, const float* cb, const float* lg, const float* lb, bf16* MIX, LAS unsigned char* lds, int tid) {
    const bool samp = item >= RP / 32; const int b = samp ? item - RP / 32 : item >> 8, t0 = samp ? 0 : (item & 255) * 32, rowbase = samp ? RP + DS * b : b * SEQ;
    const int ch = tid, wid = tid >> 6, lane = tid & 63;
    LAS bf16* xs = (LAS bf16*)lds;
    LAS float* ybuf = (LAS float*)(lds + 65536);
#pragma unroll
    for (int i = 0; i < 8; ++i) { const int k = wid + 8 * i; if (k < 62) { const int tp = t0 - CH + k; pg8::u32x4 v = (pg8::u32x4){0u, 0u, 0u, 0u};
        if (tp >= 0) v = *(const pg8::u32x4*)(GLU + (size_t)(rowbase + tp) * 512 + 8 * lane);
        else if (samp) { const float* sp = st + ((size_t)b * CH + (CH + tp)) * CW + 8 * lane; v = pg8::pack8(*(const f32x4*)sp, *(const f32x4*)(sp + 4)); }
        *(LAS pg8::u32x4*)(xs + k * 512 + 8 * lane) = v; } }
    float w[CONVW];
#pragma unroll
    for (int j = 0; j < CONVW; ++j) w[j] = cw[j * CW + ch];
    const float bias = cb[ch];
    __syncthreads();
#pragma unroll 1
    for (int hb = 0; hb < 2; ++hb) {
        float x[46];
#pragma unroll
        for (int k = 0; k < 46; ++k) x[k] = __uint_as_float((unsigned)xs[(16 * hb + k) * 512 + ch] << 16);
        float y[16];
#pragma unroll
        for (int i = 0; i < 16; ++i) y[i] = bias;
#pragma unroll
        for (int j = 0; j < CONVW; ++j)
#pragma unroll
            for (int i = 0; i < 16; ++i) y[i] += w[j] * x[i + j];
#pragma unroll
        for (int i = 0; i < 16; ++i) ybuf[(16 * hb + i) * 512 + ch] = y[i];
    }
    __syncthreads();
    f32x4 g0 = *(const f32x4*)(lg + 8 * lane), g1 = *(const f32x4*)(lg + 8 * lane + 4), b0 = *(const f32x4*)(lb + 8 * lane), b1 = *(const f32x4*)(lb + 8 * lane + 4);
#pragma unroll
    for (int q = 0; q < 4; ++q) { const int i = 4 * wid + q;
        f32x4 v0 = *(const LAS f32x4*)(ybuf + i * 512 + 8 * lane), v1 = *(const LAS f32x4*)(ybuf + i * 512 + 8 * lane + 4);
        const float mean = wave_sum((v0[0] + v0[1]) + (v0[2] + v0[3]) + (v1[0] + v1[1]) + (v1[2] + v1[3])) * (1.0f / CW);
        v0 = v0 - mean; v1 = v1 - mean;
        const f32x4 q0 = v0 * v0, q1 = v1 * v1;
        const float rstd = rsqrtf(wave_sum((q0[0] + q0[1]) + (q0[2] + q0[3]) + (q1[0] + q1[1]) + (q1[2] + q1[3])) * (1.0f / CW) + EPS);
        v0 = v0 * rstd * g0 + b0; v1 = v1 * rstd * g1 + b1;
#pragma unroll
        for (int e = 0; e < 4; ++e) { v0[e] *= pg8::sigm(v0[e]); v1[e] *= pg8::sigm(v1[e]); }
        *(pg8::u32x4*)(MIX + (size_t)(rowbase + t0 + i) * D + 512 + 8 * lane) = pg8::pack8(v0, v1); }
    __syncthreads();
}


constexpr int SG_LD = 68;
#define SG_WAIT_BAR(N) asm volatile("s_waitcnt vmcnt(" #N ") lgkmcnt(0)\n\ts_barrier" ::: "memory")
template <class Epi> __device__ __forceinline__ void sgemm64(const bf16* A, const bf16* Bt, int K_, int tile, const Epi& E, LAS unsigned char* lds) {
    int tid_ = threadIdx.x; asm volatile("" : "+v"(tid_)); int K = K_; asm volatile("" : "+s"(K));
    const int lane = tid_ & 63, wave = __builtin_amdgcn_readfirstlane(tid_ >> 6), fr = lane & 15, fq = lane >> 4, wm = wave & 3, wn = wave >> 2, tr = tile >> 4, tc = tile & 15;
    const int KS = K >> 7;
    const unsigned char* src[4]; unsigned dsto[4];
#pragma unroll
    for (int i = 0; i < 4; ++i) { const int p = wave + 8 * i, r = 4 * (p & 15) + (lane >> 4), cs = (lane & 15) ^ (r & 15);
        src[i] = (const unsigned char*)((p < 16 ? A + (size_t)(64 * tr + r) * K : Bt + (size_t)(64 * tc + r) * K)) + cs * 16;
        dsto[i] = (p < 16 ? 0u : 16384u) + (unsigned)(p & 15) * 1024u; }
    const unsigned lds0 = (unsigned)(size_t)lds;
#define SG_STAGE(t) do { _Pragma("unroll") for (int i_ = 0; i_ < 4; ++i_) att::glds16(src[i_] + (size_t)(t) * 256, (unsigned)__builtin_amdgcn_readfirstlane(lds0 + (unsigned)((t) & 3) * 32768u + dsto[i_])); } while (0)
    f32x4 acc0 = (f32x4){0.f, 0.f, 0.f, 0.f}, acc1 = acc0;
    SG_STAGE(0); if (KS > 1) SG_STAGE(1); if (KS > 2) SG_STAGE(2);
    const unsigned ra = (unsigned)(16 * wm + fr) * 256u, rb = 16384u + (unsigned)(32 * wn + fr) * 256u;
    for (int t = 0; t < KS; ++t) {
        if (t + 2 < KS) SG_WAIT_BAR(8); else if (t + 1 < KS) SG_WAIT_BAR(4); else SG_WAIT_BAR(0);
        if (t + 3 < KS) SG_STAGE(t + 3);
        const LAS unsigned char* sb = lds + (t & 3) * 32768;
#pragma unroll
        for (int ks = 0; ks < 4; ++ks) { const unsigned ch = (unsigned)((4 * ks + fq) ^ fr) * 16u;
            const bf16x8 a = *(const LAS bf16x8*)(sb + ra + ch), b0 = *(const LAS bf16x8*)(sb + rb + ch), b1 = *(const LAS bf16x8*)(sb + rb + 4096 + ch);
            acc0 = __builtin_amdgcn_mfma_f32_16x16x32_bf16(b0, a, acc0, 0, 0, 0); acc1 = __builtin_amdgcn_mfma_f32_16x16x32_bf16(b1, a, acc1, 0, 0, 0); }
    }
#undef SG_STAGE
    SG_WAIT_BAR(0);
    LAS float* part = (LAS float*)lds;
    *(LAS f32x4*)(part + (16 * wm + fr) * SG_LD + 32 * wn + 4 * fq) = acc0; *(LAS f32x4*)(part + (16 * wm + fr) * SG_LD + 32 * wn + 16 + 4 * fq) = acc1;
    __syncthreads();
    const int row = tid_ >> 3, c8 = (tid_ & 7) * 8;
    const f32x4 v0 = *(const LAS f32x4*)(part + row * SG_LD + c8), v1 = *(const LAS f32x4*)(part + row * SG_LD + c8 + 4);
    E(64 * tr + row, 64 * tc + c8, tc, tid_ & 7, v0, v1);
    __syncthreads();
}
__device__ __forceinline__ float oct_sum(float s) { s += __shfl_xor(s, 1); s += __shfl_xor(s, 2); s += __shfl_xor(s, 4); return s; }
template <bool BF> struct SEpiRes {
    const float* base; bf16* HB; float* SS;
    __device__ __forceinline__ void operator()(int row, int col, int tc, int l8, f32x4 v0, f32x4 v1) const {
        const size_t o = (size_t)row * D + col;
        if (BF) { const pg8::u32x4 w = *(const pg8::u32x4*)(HB + o); v0 = v0 + pg8::bf_lo4(w); v1 = v1 + pg8::bf_hi4(w); }
        else { v0 = v0 + *(const f32x4*)(base + o); v1 = v1 + *(const f32x4*)(base + o + 4); }
        *(pg8::u32x4*)(HB + o) = pg8::pack8(v0, v1);
        const f32x4 q0 = v0 * v0, q1 = v1 * v1;
        const float ss = oct_sum(((q0[0] + q0[1]) + (q0[2] + q0[3])) + ((q1[0] + q1[1]) + (q1[2] + q1[3])));
        if (l8 == 0) SS[(size_t)row * 16 + tc] = ss;
    }
};
struct SEpiPP {
    bf16* PP;
    __device__ __forceinline__ void operator()(int row, int col, int tc, int l8, f32x4 v0, f32x4 v1) const { *(pg8::u32x4*)(PP + (size_t)row * D + col) = pg8::pack8(v0, v1); }
};
struct SEpiFinal {
    const float* SS; const bf16* PP; const bf16* HB; float* Y;
    __device__ __forceinline__ void operator()(int row, int col, int tc, int l8, f32x4 v0, f32x4 v1) const {
        const float r = rsqrtf(oct_sum(SS[(size_t)row * 16 + 2 * l8] + SS[(size_t)row * 16 + 2 * l8 + 1]) * (1.0f / D) + EPS);
        const size_t o = (size_t)row * D + col;
        const pg8::u32x4 pw = *(const pg8::u32x4*)(PP + o), hw = *(const pg8::u32x4*)(HB + o);
        const f32x4 p0 = pg8::bf_lo4(pw), p1 = pg8::bf_hi4(pw); f32x4 h0 = pg8::bf_lo4(hw), h1 = pg8::bf_hi4(hw);
#pragma unroll
        for (int e = 0; e < 4; ++e) { h0[e] += pg8::sigm(v0[e] * r) * p0[e]; h1[e] += pg8::sigm(v1[e] * r) * p1[e]; }
        *(f32x4*)(Y + o) = h0; *(f32x4*)(Y + o + 4) = h1;
    }
};

#ifndef REP_P0
#define REP_P0 1
#endif
#ifndef REP_P1
#define REP_P1 1
#endif
#ifndef REP_P2
#define REP_P2 1
#endif
#ifndef REP_P3
#define REP_P3 1
#endif
#ifndef REP_P4
#define REP_P4 1
#endif
struct Args { const float* in[23]; float* out; unsigned char* ws; };
constexpr int N_ATT_S = 2 * DB, N_ATT_P = NB * 64 * 2, N_CONV = R / 32;
constexpr int I_WO = (D / 64) * (D / 32), I_WGU = (D / 64) * (2 * DFF / 32), N_WCV = (I_WO + I_WGU) / 8;
constexpr int N_ATT_Q = 8 + 64;
static_assert((I_WO + I_WGU) % 8 == 0, "weight conversion entries");
#define W1t ((bf16*)(ws + WS_W1))
#define WOt ((bf16*)(ws + WS_WO))
#define WGUt ((bf16*)(ws + WS_WGU))
#define WDt ((bf16*)(ws + WS_WD))
#define WPGt ((bf16*)(ws + WS_WPG))
#define WPPt ((bf16*)(ws + WS_WPP))
#define RX ((float*)(ws + WS_RX))
#define SS1 ((float*)(ws + WS_SS1))
#define SS2 ((float*)(ws + WS_SS2))
#define XB ((bf16*)(ws + WS_XB))
#define PB ((bf16*)(ws + WS_PB))
#define PPb ((bf16*)(ws + WS_PP))
#define Qb ((bf16*)(ws + WS_Q))
#define KVP (ws + WS_KP)
#define KVS (ws + WS_KS)
#define GLUb ((bf16*)(ws + WS_GLU))
#define MIXb ((bf16*)(ws + WS_MIX))
#define ACTb ((bf16*)(ws + WS_ACT))
#define Y (out + OY)
__global__ void __launch_bounds__(NWAVES * 64, 2) mk_fwd(Args args) {
    extern __shared__ __attribute__((aligned(16))) unsigned char lds_[];
    LAS unsigned char* lds = (LAS unsigned char*)lds_;
    volatile LAS unsigned* MISC = (volatile LAS unsigned*)(lds + MISC_OFF);
    const int G = gridDim.x, vcu = (G % 8 == 0) ? ((int)blockIdx.x % 8) * (G / 8) + (int)blockIdx.x / 8 : (int)blockIdx.x;
    unsigned char* ws = args.ws; float* out = args.out;
    gu32* ctl = (gu32*)(ws + WS_CTL);
    for (int u = threadIdx.x; u < (ATT_TAB - LDSCTL_OFF) / 4; u += NWAVES * 64) ((LAS unsigned*)(lds + LDSCTL_OFF))[u] = 0u;
    __syncthreads();
    XcdBarrier bar = xcd_barrier_post((unsigned*)(ctl + CW_BAR), MISC + 8);

#ifndef SKIP_P0
    for (int rep = 0; rep < REP_P0; ++rep) {
        if (rep) xcd_barrier(bar);
        int tid0 = threadIdx.x; asm volatile("" : "+v"(tid0));
        const int lane = tid0 & 63, wave = __builtin_amdgcn_readfirstlane(tid0 >> 6);
        LAS float* scr = (LAS float*)(lds + RING_OFF + wave * 16384);
        const int gw = vcu * NWAVES + wave, NGW = G * NWAVES;
        constexpr int I_1 = (D / 64) * (INC / 32), I_PP = (PLE / 64) * (D / 32);
        constexpr int NITEMS = I_1 + I_PP;
        for (int it = gw; it < NITEMS; it += NGW) {
            if (it < I_1) p0_transpose_item<1>(args.in[8], args.in[7], D, INC, W1t, scr, it, lane);
            else p0_transpose_item<0>(args.in[22], nullptr, PLE, D, WPPt, scr, it - I_1, lane);
        }
        for (int m2 = gw; m2 < R / 2; m2 += NGW) {
            f32x4 v[2][4];
#pragma unroll
            for (int rr = 0; rr < 2; ++rr) { const int m = 2 * m2 + rr; const float* xrow = m < RP ? args.in[0] + (size_t)m * D : args.in[1] + (size_t)(m - RP) * D;
                const GAS f32x4* xr = (const GAS f32x4*)xrow + lane;
#pragma unroll
                for (int j = 0; j < 4; ++j) v[rr][j] = xr[64 * j]; }
#pragma unroll
            for (int rr = 0; rr < 2; ++rr) { const int m = 2 * m2 + rr; float s = 0.f;
#pragma unroll
                for (int j = 0; j < 4; ++j) s += (v[rr][j].x * v[rr][j].x + v[rr][j].y * v[rr][j].y) + (v[rr][j].z * v[rr][j].z + v[rr][j].w * v[rr][j].w);
                s = wave_sum(s); if (lane == 0) RX[m] = rsqrtf(s * (1.0f / D) + EPS);
                GAS unsigned long long* o8 = (GAS unsigned long long*)(XB + (size_t)m * D) + lane;
#pragma unroll
                for (int j = 0; j < 4; ++j) o8[64 * j] = (unsigned long long)pk2(v[rr][j].x, v[rr][j].y) | ((unsigned long long)pk2(v[rr][j].z, v[rr][j].w) << 32); }
        }
        for (int m8 = gw; m8 < R / 8; m8 += NGW) {
            const int m = 8 * m8; const float* prow = m < RP ? args.in[2] + (size_t)m * PLE : args.in[3] + (size_t)(m - RP) * PLE;
            const GAS f32x4* pr = (const GAS f32x4*)prow + lane; f32x4 pv[8];
#pragma unroll
            for (int j = 0; j < 8; ++j) pv[j] = pr[64 * j];
            GAS unsigned long long* o8 = (GAS unsigned long long*)(PB + (size_t)m * PLE) + lane;
#pragma unroll
            for (int j = 0; j < 8; ++j) o8[64 * j] = (unsigned long long)pk2(pv[j].x, pv[j].y) | ((unsigned long long)pk2(pv[j].z, pv[j].w) << 32);
        }
    }
#endif
    xcd_barrier(bar);

#ifndef SKIP_P1
    for (int rep = 0; rep < REP_P1; ++rep) {
        if (rep) xcd_barrier(bar);
        pg8::Gemm g{XB, W1t, R, INC, D}; pg8::StaticOrder S; S.init(R, INC, G, (int)blockIdx.x);
        pg8::Epi1 E{RX, args.in[9], args.in[10], Qb, KVP, KVS, GLUb, out};
        pg8::gemm_phase<pg8::Epi1, pg8::StaticOrder, true, true>(lds + RING_OFF, g, S, E);
        { const int c0 = ((R / 256) * (INC / 256)) % G, nwgc = c0 ? G - c0 : G, cc = c0 ? (int)blockIdx.x - c0 : (int)blockIdx.x;
          if (cc >= 0) {
            int tidc = threadIdx.x; asm volatile("" : "+v"(tidc));
            const int lane = tidc & 63, wave = __builtin_amdgcn_readfirstlane(tidc >> 6), head = lane >> 3, dq = lane & 7;
            for (int m2 = cc * NWAVES + wave; m2 < DB * 512; m2 += nwgc * NWAVES) {
                const int b = m2 >> 9, j = m2 & 511, kv = j & 63;
                const GAS f32x4* sk = (const GAS f32x4*)(args.in[4] + (size_t)m2 * 512) + 2 * lane; const GAS f32x4* sv = (const GAS f32x4*)(args.in[5] + (size_t)m2 * 512) + 2 * lane;
                const f32x4 k0 = sk[0], k1 = sk[1], v0 = sv[0], v1 = sv[1];
                unsigned char* tb = KVS + (size_t)(b * 9 + (j >> 6)) * KVT_BYTES + (head >> 2) * 65536 + (head & 3) * 16384;
                *(GAS v4u*)(tb + dq * 1024 + kv * 16) = (v4u){pk2(k0.x, k0.y), pk2(k0.z, k0.w), pk2(k1.x, k1.y), pk2(k1.z, k1.w)};
                *(GAS v4u*)(tb + 8192 + (dq >> 2) * 4096 + (kv >> 4) * 1024 + (kv & 15) * 64 + (dq & 3) * 16) = (v4u){pk2(v0.x, v0.y), pk2(v0.z, v0.w), pk2(v1.x, v1.y), pk2(v1.z, v1.w)};
            }
            for (int p = cc * NWAVES + wave; p < DB * NH; p += nwgc * NWAVES) {
                unsigned char* tb = KVS + (size_t)((p >> 3) * 9 + 8) * KVT_BYTES + ((p & 7) >> 2) * 65536 + (p & 3) * 16384; const v4u z = (v4u){0u, 0u, 0u, 0u};
#pragma unroll
                for (int c2 = 0; c2 < 4; ++c2) *(GAS v4u*)(tb + (2 * c2 + (lane >> 5)) * 1024 + 512 + (lane & 31) * 16) = z;
#pragma unroll
                for (int q = 0; q < 4; ++q) *(GAS v4u*)(tb + 8192 + (q >> 1) * 4096 + (2 + (q & 1)) * 1024 + lane * 16) = z;
            }
          } }
    }
#endif
    xcd_barrier(bar);

#ifndef SKIP_P2
    for (int rep = 0; rep < REP_P2; ++rep) {
        if (rep) xcd_barrier(bar);
        { int tidt = threadIdx.x; asm volatile("" : "+v"(tidt)); const int lane = tidt & 63, wave = __builtin_amdgcn_readfirstlane(tidt >> 6);
          const float* relb = args.in[11] + wave * NREL; LAS float* T = (LAS float*)(lds + ATT_TAB) + wave * 256;
          const float bfar = relb[256];
          for (int x = lane; x < 256; x += 64) { int dd = 191 - x; dd = dd < -128 ? -128 : (dd > 128 ? 128 : dd); T[x] = (relb[dd + 128] - bfar) * LOG2E; } }
        __syncthreads();
        {
            int tid2 = threadIdx.x; asm volatile("" : "+v"(tid2));
            const int lane2 = tid2 & 63, wave2 = __builtin_amdgcn_readfirstlane(tid2 >> 6);
            int qk = 0, q = (int)blockIdx.x & 7;
#define ATT_POP(qq) ((int)__hip_atomic_fetch_add((unsigned*)(ctl + CW_Q + 64 * ((qq) + 8 * rep)), 1u, __ATOMIC_RELAXED, __HIP_MEMORY_SCOPE_AGENT))
#define ATT_DECODE(code, U) do { const int q_ = (int)((code) >> 8), i_ = (int)((code) & 255u); \
                if (i_ < 8) { const int sb = 4 * q_ + (i_ >> 1); U.hg = i_ & 1; U.sample = 1; U.nt = 9; U.c0rel = 8; \
                    U.Qrow = Qb + (size_t)(RP + DS * sb) * 512; U.KV = KVS + (size_t)(sb * 9) * KVT_BYTES; U.Orow = MIXb + (size_t)(RP + DS * sb) * D; } \
                else { const int j = i_ - 8, pi = j < 60 ? 4 + j : 63 - j, bb = q_ >> 1, c0 = 2 * pi;     \
                    U.hg = q_ & 1; U.sample = 0; U.c0rel = c0 < 8 ? c0 : 8; U.nt = U.c0rel + 2; const size_t row0 = (size_t)bb * SEQ + 64 * c0; \
                    U.Qrow = Qb + row0 * 512; U.KV = KVP + (size_t)(bb * 128 + c0 - U.c0rel) * KVT_BYTES; U.Orow = MIXb + row0 * D; } } while (0)
            if (tid2 == 0) { int i = ATT_POP(q); while (i >= N_ATT_Q) { if (++qk == 8) { i = -1; break; } q = ((int)blockIdx.x + qk) & 7; i = ATT_POP(q); }
                MISC[4] = i < 0 ? 0xffffffffu : (unsigned)((q << 8) | i); }
            __syncthreads();
            unsigned code = MISC[4];
            if (code != 0xffffffffu) {
                att::AUnit U; ATT_DECODE(code, U);
                att::bf16x8 qr[2][4];
                att::attn_prefetch(U, lds, wave2, lane2, qr);
                for (;;) {
                    int nraw = 0; if (tid2 == 0) nraw = ATT_POP(q);
#pragma unroll
                    for (int d0 = 0; d0 < 4; ++d0) asm volatile("" : "+v"(qr[0][d0]), "+v"(qr[1][d0]));
                    att::f32x16 o[2][2]; o[0][0] = att::f32x16{}; o[0][1] = att::f32x16{}; o[1][0] = att::f32x16{}; o[1][1] = att::f32x16{}; float lsum[2] = {0.f, 0.f};
                    if (U.sample) att::attn_steps<false>(U, lds, wave2, lane2, qr, o, lsum); else att::attn_steps<true>(U, lds, wave2, lane2, qr, o, lsum);
                    if (tid2 == 0) { int i = nraw; while (i >= N_ATT_Q) { if (++qk == 8) { i = -1; break; } q = ((int)blockIdx.x + qk) & 7; i = ATT_POP(q); }
                        MISC[4] = i < 0 ? 0xffffffffu : (unsigned)((q << 8) | i); }
                    ATT_WAIT_BAR();
                    const unsigned ncode = MISC[4];
                    att::AUnit Un = U;
                    if (ncode != 0xffffffffu) { ATT_DECODE(ncode, Un); att::attn_prefetch(Un, lds, wave2, lane2, qr); }
                    if (U.sample) att::attn_store<false>(U, lds, wave2, lane2, o, lsum); else att::attn_store<true>(U, lds, wave2, lane2, o, lsum);
                    if (ncode == 0xffffffffu) break;
                    U = Un;
                }
                ATT_WAIT_BAR();
            }
#undef ATT_POP
#undef ATT_DECODE
        }
        for (;;) {
            int tid2 = threadIdx.x; asm volatile("" : "+v"(tid2));
            if (tid2 == 0) MISC[4] = __hip_atomic_fetch_add((unsigned*)(ctl + CW_QG + 64 * rep), 1u, __ATOMIC_RELAXED, __HIP_MEMORY_SCOPE_AGENT);
            __syncthreads();
            const int idx = (int)MISC[4];
            __syncthreads();
            if (idx >= N_CONV + N_WCV) break;
            const int lane2 = tid2 & 63, wave2 = __builtin_amdgcn_readfirstlane(tid2 >> 6);
            if (idx < N_CONV) conv_item(idx, GLUb, args.in[6], args.in[12], args.in[13], args.in[14], args.in[15], MIXb, lds, tid2);
            else { const int it = 8 * (idx - N_CONV) + wave2; LAS float* scr = (LAS float*)(lds + RING_OFF + wave2 * 16384);
                if (it < I_WO) p0_transpose_item<0>(args.in[16], nullptr, D, D, WOt, scr, it, lane2);
                else p0_transpose_item<2>(args.in[18], args.in[17], D, 2 * DFF, WGUt, scr, it - I_WO, lane2);
                __syncthreads(); }
        }
    }
#endif
    xcd_barrier(bar);

#ifndef SKIP_P3
    for (int rep = 0; rep < REP_P3; ++rep) {
        if (rep) xcd_barrier(bar);
        pg8::Gemm g{MIXb, WOt, RP, D, D}; pg8::StaticOrder S; S.init(RP, D, G, (int)blockIdx.x);
        pg8::EpiRes<true> E{nullptr, nullptr, XB, SS1};
        const SEpiRes<true> SE{nullptr, XB + (size_t)RP * D, SS1 + (size_t)RP * 16};
        if (blockIdx.x & 1) for (int t = (int)blockIdx.x; t < 256; t += G) sgemm64(MIXb + (size_t)RP * D, WOt, D, t, SE, lds + RING_OFF);
        pg8::gemm_phase<pg8::EpiRes<true>, pg8::StaticOrder, true, true>(lds + RING_OFF, g, S, E);
        if (!(blockIdx.x & 1)) for (int t = (int)blockIdx.x; t < 256; t += G) sgemm64(MIXb + (size_t)RP * D, WOt, D, t, SE, lds + RING_OFF);
    }
#endif
    xcd_barrier(bar);

#ifndef SKIP_P4
    for (int rep = 0; rep < REP_P4; ++rep) {
        if (rep) xcd_barrier(bar);
        { const int c0 = ((R / 256) * (2 * DFF / 256)) % G, nwgc = c0 ? G - c0 : G, cc = c0 ? (int)blockIdx.x - c0 : (int)blockIdx.x;
          if (cc >= 0) {
            const bool wt = (nwgc % 4) == 0; const int k = wt ? cc & 3 : 1, j = wt ? cc >> 2 : cc, per = wt ? nwgc / 4 : nwgc, nslot = wt ? 6 * per : per;
            const int s0 = !wt ? j : (k == 1 ? j : (k == 2 ? per + 2 * j : 3 * per + 3 * j));
            int tidc = threadIdx.x; asm volatile("" : "+v"(tidc));
            const int lane = tidc & 63, wave = __builtin_amdgcn_readfirstlane(tidc >> 6);
            for (int q = 0; q < k; ++q)
            for (int m4 = s0 + q + nslot * wave; m4 < 2 * DB * 120; m4 += nslot * NWAVES) {
                const int kv = m4 >= DB * 120, mm = kv ? m4 - DB * 120 : m4, b = mm / 120, j2 = DS + 4 * (mm % 120);
                const GAS f32x4* src = (const GAS f32x4*)(args.in[4 + kv] + ((size_t)b * 512 + j2) * 512) + lane;
                GAS f32x4* dst = (GAS f32x4*)(out + (kv ? OVS : OKS) + ((size_t)b * 512 + (j2 - DS)) * 512) + lane;
                f32x4 v[8];
#pragma unroll
                for (int i = 0; i < 8; ++i) v[i] = src[64 * i];
#pragma unroll
                for (int i = 0; i < 8; ++i) dst[64 * i] = v[i];
            }
            { LAS float* scr = (LAS float*)(lds + RING_OFF + wave * 16384); constexpr int I_D = (DFF / 64) * (D / 32), I_PG = (D / 64) * (D / 32);
              for (int it = cc * NWAVES + wave; it < I_D + I_PG; it += nwgc * NWAVES) {
                  if (it < I_D) p0_transpose_item<0>(args.in[19], nullptr, DFF, D, WDt, scr, it, lane);
                  else p0_transpose_item<0>(args.in[21], args.in[20], D, D, WPGt, scr, it - I_D, lane); }
              __syncthreads(); }
          } }
        pg8::Gemm g{XB, WGUt, R, 2 * DFF, D}; pg8::StaticOrder S; S.init(R, 2 * DFF, G, (int)blockIdx.x);
        pg8::EpiAct E{SS1, ACTb};
        pg8::gemm_phase<pg8::EpiAct, pg8::StaticOrder, true, true>(lds + RING_OFF, g, S, E);
    }
#endif
    xcd_barrier(bar);

#ifndef SKIP_P5
    {
        pg8::Gemm g{ACTb, WDt, RP, D, DFF}; pg8::StaticOrder S; S.init(RP, D, G, (int)blockIdx.x);
        pg8::EpiRes<true> E{nullptr, nullptr, XB, SS2};
        const SEpiRes<true> SE{nullptr, XB + (size_t)RP * D, SS2 + (size_t)RP * 16};
        if (blockIdx.x & 1) for (int t = (int)blockIdx.x; t < 256; t += G) sgemm64(ACTb + (size_t)RP * DFF, WDt, DFF, t, SE, lds + RING_OFF);
        pg8::gemm_phase<pg8::EpiRes<true>, pg8::StaticOrder, true, true>(lds + RING_OFF, g, S, E);
        if (!(blockIdx.x & 1)) for (int t = (int)blockIdx.x; t < 256; t += G) sgemm64(ACTb + (size_t)RP * DFF, WDt, DFF, t, SE, lds + RING_OFF);
    }
#endif
    xcd_barrier(bar);

#ifndef SKIP_P6
    {
        pg8::Gemm g{XB, WPGt, RP, D, D}; pg8::StaticOrder S; S.init(RP, D, G, (int)blockIdx.x);
        pg8::EpiFinal E{SS2, PPb, XB, Y};
        const SEpiFinal SE{SS2 + (size_t)RP * 16, PPb + (size_t)RP * D, XB + (size_t)RP * D, Y + (size_t)RP * D};
        pg8::Gemm gp{PB, WPPt, RP, D, PLE}; pg8::EpiPP EP{PPb}; const SEpiPP SP{PPb + (size_t)RP * D};
        if (blockIdx.x & 1) for (int t = (int)blockIdx.x; t < 256; t += G) { sgemm64(PB + (size_t)RP * PLE, WPPt, PLE, t, SP, lds + RING_OFF); sgemm64(XB + (size_t)RP * D, WPGt, D, t, SE, lds + RING_OFF); }
        pg8::gemm_phase<pg8::EpiPP, pg8::StaticOrder, true, true>(lds + RING_OFF, gp, S, EP);
        pg8::gemm_phase<pg8::EpiFinal, pg8::StaticOrder, true, true>(lds + RING_OFF, g, S, E);
        if (!(blockIdx.x & 1)) for (int t = (int)blockIdx.x; t < 256; t += G) { sgemm64(PB + (size_t)RP * PLE, WPPt, PLE, t, SP, lds + RING_OFF); sgemm64(XB + (size_t)RP * D, WPGt, D, t, SE, lds + RING_OFF); }
    }
#endif
}

extern "C" void kernel_launch(void* const* d_in, const int* in_sizes, int n_in, void* d_out, int out_size, void* d_ws, size_t ws_size, hipStream_t stream) {
    static int grid = 0;
    if (grid == 0) {
        if (n_in != 23 || ws_size < WS_END) { fprintf(stderr, "kernel_launch: unexpected shapes (n_in %d, ws %zu)\n", n_in, ws_size); grid = -1; return; }
        int dev = 0, cus = 0, per_cu = 0;
        if (hipGetDevice(&dev) != hipSuccess || hipDeviceGetAttribute(&cus, hipDeviceAttributeMultiprocessorCount, dev) != hipSuccess) { grid = -1; return; }
        if (hipFuncSetAttribute((const void*)mk_fwd, hipFuncAttributeMaxDynamicSharedMemorySize, LDS_BYTES) != hipSuccess) { fprintf(stderr, "kernel_launch: hipFuncSetAttribute failed\n"); grid = -1; return; }
        if (hipOccupancyMaxActiveBlocksPerMultiprocessor(&per_cu, (const void*)mk_fwd, NWAVES * 64, LDS_BYTES) != hipSuccess || per_cu < 1) { fprintf(stderr, "kernel_launch: occupancy query says %d blocks per CU\n", per_cu); }
        (void)hipGetLastError();
        grid = cus;
    }
    if (grid < 0) return;
    if (hipMemsetAsync((char*)d_ws + WS_CTL, 0, CTL_ZERO_BYTES, stream) != hipSuccess) return;
    Args a{};
    for (int i = 0; i < 23; ++i) a.in[i] = (const float*)d_in[i];
    a.out = (float*)d_out; a.ws = (unsigned char*)d_ws;
    hipLaunchKernelGGL(mk_fwd, dim3(grid), dim3(NWAVES * 64), LDS_BYTES, stream, a);
}
```

```cpp
#include <hip/hip_runtime.h>
#include <cstdio>
#include <cstdint>
constexpr int D = 1024, SEQ = 8192, NB = 4, DB = 32, DS = 32;
constexpr int RP = NB * SEQ, RS = DB * DS, R = RP + RS;
constexpr int INC = 2560, DFF = 2816, PLE = 256, NH = 8, HD = 64, CW = 512;
constexpr int NREL = 257, CONVW = 31, CH = 30, KSROWS = 576;
constexpr int KVT_BYTES = 131072;
constexpr float EPS = 1e-6f, LOG2E = 1.4426950408889634f, QSCALE = 0.125f * LOG2E;
constexpr size_t OY = 0, OKP = (size_t)R * D, OVP = OKP + (size_t)NB * 512 * 512, OCP = OVP + (size_t)NB * 512 * 512,
                 OKS = OCP + (size_t)NB * CH * CW, OVS = OKS + (size_t)DB * 512 * 512, OCS = OVS + (size_t)DB * 512 * 512;
namespace pg8 {
#define PG8_LAS __attribute__((address_space(3)))
typedef unsigned short bf16_t;
typedef short bf16x8 __attribute__((ext_vector_type(8)));
typedef float f32x4 __attribute__((ext_vector_type(4)));
typedef unsigned u32x4 __attribute__((ext_vector_type(4)));
constexpr int BM = 256, BK = 64, HALF = 128, HTB = HALF * BK * 2  , STAGE_BYTES = 8 * HTB, NXCD = 8, WGM = 8;

__host__ __device__ __forceinline__ int lds_byte(int r, int c) { const int st = (r >> 4) * 2 + (c >> 5), rr = r & 15, cc = c & 31, ob = rr * 64 + cc * 2; return st * 1024 + (ob ^ (((ob >> 9) & 1) << 5)); }
__host__ __device__ __forceinline__ void stage_rc(int b, int& R, int& C) { const int st = b / 1024, sb = b % 1024, swz = sb ^ (((sb >> 9) & 1) << 5); R = (st >> 1) * 16 + swz / 64; C = (st & 1) * 32 + (swz % 64) / 2; }
__host__ __device__ __forceinline__ int perm32(int rho) { const int n = rho >> 4, i = rho & 15; return 8 * (i >> 2) + 4 * n + (i & 3); }

struct Unit { int pm, pn; };
struct Gemm { const bf16_t* A; const bf16_t* Bt; int M, N, K; };

struct StaticOrder {
    int nM, nN, nwg, G, c;
    __host__ __device__ void init(int M, int N, int G_, int c_) { nM = M / BM; nN = N / BM; nwg = nM * nN; G = G_; c = c_; }
    __host__ __device__ bool next(int i, Unit& u) const {
        const long L = (long)i * G + c; if (L >= nwg) return false;
        int wgid = (int)L; { const int q = nwg / NXCD, r = nwg % NXCD, xcd = wgid % NXCD, off = wgid / NXCD; wgid = (xcd < r ? xcd * (q + 1) : r * (q + 1) + (xcd - r) * q) + off; }
        const int nig = WGM * nN, gid = wgid / nig, fm = gid * WGM, gsz = (nM - fm) < WGM ? (nM - fm) : WGM;
        u.pm = fm + ((wgid % nig) % gsz); u.pn = (wgid % nig) / gsz; return true;
    }
    __device__ __forceinline__ void a_ready(const Unit&) const {}
    __device__ __forceinline__ void done(const Unit&) const {}
};

__device__ __forceinline__ unsigned cvt_pk_bf16(float lo, float hi) { unsigned r; asm volatile("v_cvt_pk_bf16_f32 %0, %1, %2" : "=v"(r) : "v"(lo), "v"(hi)); return r; }
typedef float f32x2 __attribute__((ext_vector_type(2)));typedef unsigned u32x2 __attribute__((ext_vector_type(2)));
__device__ __forceinline__ u32x4 pack8(const f32x4 a, const f32x4 b) { u32x4 w; w.x = cvt_pk_bf16(a[0], a[1]); w.y = cvt_pk_bf16(a[2], a[3]); w.z = cvt_pk_bf16(b[0], b[1]); w.w = cvt_pk_bf16(b[2], b[3]); return w; }
__device__ __forceinline__ float sigm(float x) { return __builtin_amdgcn_rcpf(1.0f + __builtin_amdgcn_exp2f(-x * LOG2E)); }
__device__ __forceinline__ float quad_sum(float s) { s += __shfl_xor(s, 16); s += __shfl_xor(s, 32); return s; }
struct Epi1 {
    static constexpr bool PERM = true, AFTER_DRAIN = false;
    const float* rx; const float* qg; const float* kg; bf16_t* Q; unsigned char* KVP; unsigned char* KVS; bf16_t* GLU; float* out;
    __device__ __forceinline__ void operator()(const f32x4 (&acc)[2][2][4][2], const Unit& u, int wr, int wc, int fr, int fq) const {
        const int pn = u.pn, rowt = u.pm * BM + wr * 64 + fr;
        float rxv[2][4];
#pragma unroll
        for (int ai = 0; ai < 2; ++ai)
#pragma unroll
            for (int m = 0; m < 4; ++m) rxv[ai][m] = rx[rowt + ai * HALF + m * 16];
        if (pn < 6) {
            const int sec = pn >> 1, col = (4 * (pn & 1) + wc) * 64 + 8 * fq;
            f32x4 g[2][2];
#pragma unroll
            for (int bj = 0; bj < 2; ++bj)
#pragma unroll
                for (int n = 0; n < 2; ++n) { g[bj][n] = (f32x4){1.f, 1.f, 1.f, 1.f};
                    if (sec == 0) g[bj][n] = *(const f32x4*)(qg + 32 * bj + 8 * fq + 4 * n) * QSCALE;
                    if (sec == 1) g[bj][n] = *(const f32x4*)(kg + 32 * bj + 8 * fq + 4 * n); }
#pragma unroll
            for (int ai = 0; ai < 2; ++ai)
#pragma unroll
                for (int m = 0; m < 4; ++m) {
                    const int row = rowt + ai * HALF + m * 16; const float r = rxv[ai][m];
                    f32x4 z[2][2];
#pragma unroll
                    for (int bj = 0; bj < 2; ++bj)
#pragma unroll
                        for (int n = 0; n < 2; ++n) z[bj][n] = acc[ai][bj][m][n] * r;
                    if (sec < 2) {
                        float ss = 0.f;
#pragma unroll
                        for (int bj = 0; bj < 2; ++bj)
#pragma unroll
                            for (int n = 0; n < 2; ++n) { const f32x4 q = z[bj][n] * z[bj][n]; ss += (q[0] + q[1]) + (q[2] + q[3]); }
                        ss = quad_sum(ss);
                        const float rn = rsqrtf(ss * (1.0f / 64.0f) + EPS);
#pragma unroll
                        for (int bj = 0; bj < 2; ++bj)
#pragma unroll
                            for (int n = 0; n < 2; ++n) z[bj][n] = z[bj][n] * rn * g[bj][n];
                    }
                    const int sb = (row - RP) >> 5, si = (row - RP) & 31;
                    float* fo = nullptr;
                    if (sec == 0) {
#pragma unroll
                        for (int bj = 0; bj < 2; ++bj) *(u32x4*)(Q + (size_t)row * 512 + col + 32 * bj) = pack8(z[bj][0], z[bj][1]);
                    } else {
                        unsigned char* tb; int kv;
                        if (row < RP) { tb = KVP + (size_t)(row >> 6) * KVT_BYTES; kv = row & 63;
                            const int t = row & (SEQ - 1); if (t >= SEQ - 512) fo = out + OKP + (size_t)(sec - 1) * (OVP - OKP) + ((size_t)((row >> 13) * 512 + (t - (SEQ - 512)))) * 512 + col; }
                        else { tb = KVS + (size_t)(sb * 9 + 8) * KVT_BYTES; kv = si; fo = out + OKS + (size_t)(sec - 1) * (OVS - OKS) + ((size_t)(sb * 512 + 480 + si)) * 512 + col; }
                        tb += (pn & 1) * 65536 + wc * 16384;
                        const int ok = fq * 1024 + kv * 16, ov = 8192 + (kv >> 4) * 1024 + (kv & 15) * 64 + fq * 16;
#pragma unroll
                        for (int bj = 0; bj < 2; ++bj) *(u32x4*)(tb + (sec == 1 ? ok + bj * 4096 : ov + bj * 4096)) = pack8(z[bj][0], z[bj][1]);
                    }
                    if (fo) {
#pragma unroll
                        for (int bj = 0; bj < 2; ++bj)
#pragma unroll
                            for (int n = 0; n < 2; ++n) *(f32x4*)(fo + 32 * bj + 4 * n) = z[bj][n]; }
                }
        } else {
            const int col = 128 * (pn - 6) + 32 * wc + 8 * fq;
#pragma unroll
            for (int ai = 0; ai < 2; ++ai)
#pragma unroll
                for (int m = 0; m < 4; ++m) {
                    const int row = rowt + ai * HALF + m * 16; const float r = rxv[ai][m];
                    f32x4 gl[2];
#pragma unroll
                    for (int n = 0; n < 2; ++n) { const f32x4 a = acc[ai][0][m][n] * r, b = acc[ai][1][m][n] * r;
#pragma unroll
                        for (int e = 0; e < 4; ++e) gl[n][e] = a[e] * sigm(b[e]); }
                    *(u32x4*)(GLU + (size_t)row * 512 + col) = pack8(gl[0], gl[1]);
                    float* fo = nullptr;
                    if (row < RP) { const int t = row & (SEQ - 1); if (t >= SEQ - CH) fo = out + OCP + ((size_t)((row >> 13) * CH + (t - (SEQ - CH)))) * CW + col; }
                    else { const int sb = (row - RP) >> 5, si = (row - RP) & 31; if (si >= DS - CH) fo = out + OCS + ((size_t)(sb * CH + (si - (DS - CH)))) * CW + col; }
                    if (fo) { *(f32x4*)(fo) = gl[0]; *(f32x4*)(fo + 4) = gl[1]; }
                }
        }
    }
};
struct EpiPP {
    static constexpr bool PERM = true, AFTER_DRAIN = false;
    bf16_t* O;
    __device__ __forceinline__ void operator()(const f32x4 (&acc)[2][2][4][2], const Unit& u, int wr, int wc, int fr, int fq) const {
        const int rowt = u.pm * BM + wr * 64 + fr, col = u.pn * BM + 32 * wc + 8 * fq;
#pragma unroll
        for (int ai = 0; ai < 2; ++ai)
#pragma unroll
            for (int m = 0; m < 4; ++m) { bf16_t* rowp = O + (size_t)(rowt + ai * HALF + m * 16) * D + col;
#pragma unroll
                for (int bj = 0; bj < 2; ++bj) *(u32x4*)(rowp + bj * HALF) = pack8(acc[ai][bj][m][0], acc[ai][bj][m][1]); }
    }
};
__device__ __forceinline__ f32x4 bf_lo4(const u32x4 w) { return (f32x4){__uint_as_float(w.x << 16), __uint_as_float(w.x & 0xffff0000u), __uint_as_float(w.y << 16), __uint_as_float(w.y & 0xffff0000u)}; }
__device__ __forceinline__ f32x4 bf_hi4(const u32x4 w) { return (f32x4){__uint_as_float(w.z << 16), __uint_as_float(w.z & 0xffff0000u), __uint_as_float(w.w << 16), __uint_as_float(w.w & 0xffff0000u)}; }
template <bool BF> struct EpiRes {
    static constexpr bool PERM = true, AFTER_DRAIN = false;
    const float* bp; const float* bs; bf16_t* HB; float* SS;
    __device__ __forceinline__ void operator()(const f32x4 (&acc)[2][2][4][2], const Unit& u, int wr, int wc, int fr, int fq) const {
        const int rowt = u.pm * BM + wr * 64 + fr, col = u.pn * BM + 32 * wc + 8 * fq;
        f32x4 bv[2][2][2];
        auto ldbase = [&](int i, f32x4 (&d)[2][2]) {
            const int row = rowt + (i >> 2) * HALF + (i & 3) * 16;
            if (BF) { const bf16_t* hrow = HB + (size_t)row * D + col;
#pragma unroll
                for (int bj = 0; bj < 2; ++bj) { const u32x4 w = *(const u32x4*)(hrow + bj * HALF); d[bj][0] = bf_lo4(w); d[bj][1] = bf_hi4(w); } }
            else { const float* brow = (row < RP ? bp + (size_t)row * D : bs + (size_t)(row - RP) * D) + col;
#pragma unroll
                for (int bj = 0; bj < 2; ++bj) { d[bj][0] = *(const f32x4*)(brow + bj * HALF); d[bj][1] = *(const f32x4*)(brow + bj * HALF + 4); } } };
        ldbase(0, bv[0]);
#pragma unroll
        for (int i = 0; i < 8; ++i) {
            const int ai = i >> 2, m = i & 3, row = rowt + ai * HALF + m * 16;
            if (i + 1 < 8) ldbase(i + 1, bv[(i + 1) & 1]);
            bf16_t* hrow = HB + (size_t)row * D + col;
            float ss = 0.f;
#pragma unroll
            for (int bj = 0; bj < 2; ++bj) {
                const f32x4 v0 = bv[i & 1][bj][0] + acc[ai][bj][m][0], v1 = bv[i & 1][bj][1] + acc[ai][bj][m][1];
                *(u32x4*)(hrow + bj * HALF) = pack8(v0, v1);
                const f32x4 q0 = v0 * v0, q1 = v1 * v1; ss += ((q0[0] + q0[1]) + (q0[2] + q0[3])) + ((q1[0] + q1[1]) + (q1[2] + q1[3]));
            }
            ss = quad_sum(ss);
            if (fq == 0) SS[(size_t)row * 16 + 4 * u.pn + wc] = ss;
        }
    }
};
__device__ __forceinline__ float row_rs(const float* SS, int row, int fq) {
    const f32x4 s4 = *(const f32x4*)(SS + (size_t)row * 16 + 4 * fq);
    return rsqrtf(quad_sum((s4[0] + s4[1]) + (s4[2] + s4[3])) * (1.0f / D) + EPS);
}
struct EpiAct {
    static constexpr bool PERM = true, AFTER_DRAIN = false;
    const float* SS; bf16_t* ACT;
    __device__ __forceinline__ void operator()(const f32x4 (&acc)[2][2][4][2], const Unit& u, int wr, int wc, int fr, int fq) const {
        const int rowt = u.pm * BM + wr * 64 + fr, col = 128 * u.pn + 32 * wc + 8 * fq;
        float rv[2][4];
#pragma unroll
        for (int ai = 0; ai < 2; ++ai)
#pragma unroll
            for (int m = 0; m < 4; ++m) rv[ai][m] = row_rs(SS, rowt + ai * HALF + m * 16, fq);
#pragma unroll
        for (int ai = 0; ai < 2; ++ai)
#pragma unroll
            for (int m = 0; m < 4; ++m) {
                const int row = rowt + ai * HALF + m * 16; const float r = rv[ai][m];
                f32x4 v[2];
#pragma unroll
                for (int n = 0; n < 2; ++n) { const f32x4 g = acc[ai][0][m][n] * r, up = acc[ai][1][m][n] * r;
#pragma unroll
                    for (int e = 0; e < 4; ++e) v[n][e] = g[e] * sigm(g[e]) * up[e]; }
                *(u32x4*)(ACT + (size_t)row * DFF + col) = pack8(v[0], v[1]);
            }
    }
};
struct EpiFinal {
    static constexpr bool PERM = true, AFTER_DRAIN = false;
    const float* SS; const bf16_t* PP; const bf16_t* HB; float* Y;
    __device__ __forceinline__ void operator()(const f32x4 (&acc)[2][2][4][2], const Unit& u, int wr, int wc, int fr, int fq) const {
        const int rowt = u.pm * BM + wr * 64 + fr, col = u.pn * BM + 32 * wc + 8 * fq;
        float rv[2][4];
#pragma unroll
        for (int ai = 0; ai < 2; ++ai)
#pragma unroll
            for (int m = 0; m < 4; ++m) rv[ai][m] = row_rs(SS, rowt + ai * HALF + m * 16, fq);
        u32x4 pwv[2][2], hwv[2][2];
        auto ld = [&](int i, u32x4 (&p)[2], u32x4 (&h)[2]) { const size_t o = (size_t)(rowt + (i >> 2) * HALF + (i & 3) * 16) * D + col;
#pragma unroll
            for (int bj = 0; bj < 2; ++bj) { p[bj] = *(const u32x4*)(PP + o + bj * HALF); h[bj] = *(const u32x4*)(HB + o + bj * HALF); } };
        ld(0, pwv[0], hwv[0]);
#pragma unroll
        for (int i = 0; i < 8; ++i) {
            const int ai = i >> 2, m = i & 3, row = rowt + ai * HALF + m * 16; const float r = rv[ai][m];
            if (i + 1 < 8) ld(i + 1, pwv[(i + 1) & 1], hwv[(i + 1) & 1]);
#pragma unroll
            for (int bj = 0; bj < 2; ++bj) {
                const size_t o = (size_t)row * D + col + bj * HALF;
                const u32x4 pw = pwv[i & 1][bj], hw = hwv[i & 1][bj];
                const f32x4 a0 = acc[ai][bj][m][0] * r, a1 = acc[ai][bj][m][1] * r, p0 = bf_lo4(pw), p1 = bf_hi4(pw);
                f32x4 h0 = bf_lo4(hw), h1 = bf_hi4(hw);
#pragma unroll
                for (int e2 = 0; e2 < 4; ++e2) { h0[e2] += sigm(a0[e2]) * p0[e2]; h1[e2] += sigm(a1[e2]) * p1[e2]; }
                *(f32x4*)(Y + o) = h0; *(f32x4*)(Y + o + 4) = h1;
            }
        }
    }
};

template <class Epi, class Sched, bool ALIGN_EPI = false, bool SP2 = false>
__device__ __forceinline__ void gemm_phase(PG8_LAS unsigned char* lds, const Gemm g, const Sched& S, const Epi& E) {
    int tid_ = threadIdx.x; asm volatile("" : "+v"(tid_));
    const int tid = tid_, wid = __builtin_amdgcn_readfirstlane(tid >> 6), lane = tid & 63, wr = wid >> 2, wc = wid & 3, fr = lane & 15, fq = lane >> 4;
    int K_ = g.K; asm volatile("" : "+s"(K_));
    const int K = K_, nt = K / BK;
    unsigned voffA[2], voffB[2];
#pragma unroll
    for (int i = 0; i < 2; ++i) { int R, C; stage_rc(tid * 16 + i * 8192, R, C); const int Rb = Epi::PERM ? ((R & ~31) + perm32(R & 31)) : R;
        voffA[i] = (unsigned)(R * K + C) * 2u; voffB[i] = (unsigned)(Rb * K + C) * 2u; }
    const size_t kstep = (size_t)(BK * 2);
    const size_t hstep = (size_t)HALF * K * 2;
    const size_t tstep = 2 * hstep;
    const unsigned ldsw = (unsigned)wid * 1024u;
    const int aoff = lds_byte(wr * 64 + fr, fq * 8), boff = lds_byte(wc * 32 + fr, fq * 8);
#define PG8_SA(b, h) (((b) * 2 + (h)) * HTB)
#define PG8_SB(b, h) ((4 + (b) * 2 + (h)) * HTB)
#define PG8_STAGE(bufoff, gbase, voff) do { _Pragma("unroll") for (int _i = 0; _i < 2; ++_i) \
        __builtin_amdgcn_global_load_lds((const unsigned*)((const char*)(gbase) + (voff)[_i]), (PG8_LAS unsigned*)(lds + (bufoff) + ldsw + _i * 8192), 16, 0, 0); } while (0)
#define PG8_LDA(dst, b, h) do { _Pragma("unroll") for (int m = 0; m < 4; ++m) _Pragma("unroll") for (int k = 0; k < 2; ++k) dst[m][k] = *(const PG8_LAS bf16x8*)(lds + PG8_SA(b, h) + aoff + m * 2048 + k * 1024); } while (0)
#define PG8_LDB(dst, b, h) do { _Pragma("unroll") for (int n = 0; n < 2; ++n) _Pragma("unroll") for (int k = 0; k < 2; ++k) dst[n][k] = *(const PG8_LAS bf16x8*)(lds + PG8_SB(b, h) + boff + n * 2048 + k * 1024); } while (0)
#define PG8_MMA(ai, bj, At, Bt) do { __builtin_amdgcn_s_setprio(1); _Pragma("unroll") for (int m = 0; m < 4; ++m) _Pragma("unroll") for (int n = 0; n < 2; ++n) _Pragma("unroll") for (int k = 0; k < 2; ++k) \
        acc[ai][bj][m][n] = __builtin_amdgcn_mfma_f32_16x16x32_bf16(Bt[n][k], At[m][k], acc[ai][bj][m][n], 0, 0, 0); __builtin_amdgcn_s_setprio(0); } while (0)
#define PG8_WAIT_V(n) asm volatile("s_waitcnt vmcnt(" #n ")" ::: "memory")
#define PG8_WAIT_L(n) asm volatile("s_waitcnt lgkmcnt(" #n ")" ::: "memory")
#define PG8_BAR __builtin_amdgcn_s_barrier()
#define PG8_SCHED __builtin_amdgcn_sched_barrier(0)
    Unit cur, nxt; int ui = 0;
    if (!S.next(0, cur)) return;
    f32x4 acc[2][2][4][2];
#pragma unroll
    for (int a = 0; a < 2; ++a)
#pragma unroll
        for (int b = 0; b < 2; ++b)
#pragma unroll
            for (int m = 0; m < 4; ++m)
#pragma unroll
                for (int n = 0; n < 2; ++n) acc[a][b][m][n] = (f32x4){0.f, 0.f, 0.f, 0.f};
    bf16x8 At[4][2], B0[2][2], B1[2][2];
    const char* cA = (const char*)g.A + (size_t)cur.pm * tstep; const char* cB = (const char*)g.Bt + (size_t)cur.pn * tstep;
    S.a_ready(cur);
    if constexpr (SP2) {
        PG8_STAGE(PG8_SB(0, 0), cB, voffB); PG8_STAGE(PG8_SB(0, 1), cB + hstep, voffB); PG8_STAGE(PG8_SA(0, 0), cA, voffA); PG8_STAGE(PG8_SA(0, 1), cA + hstep, voffA);
        if (wr == 1) PG8_BAR;
        PG8_WAIT_V(2); PG8_BAR;
        PG8_STAGE(PG8_SB(1, 0), cB + kstep, voffB); PG8_STAGE(PG8_SA(1, 0), cA + kstep, voffA); PG8_STAGE(PG8_SB(1, 1), cB + hstep + kstep, voffB);
        PG8_WAIT_V(6); PG8_BAR;
    } else {
        PG8_STAGE(PG8_SB(0, 0), cB, voffB); PG8_STAGE(PG8_SA(0, 0), cA, voffA); PG8_STAGE(PG8_SB(0, 1), cB + hstep, voffB); PG8_STAGE(PG8_SA(0, 1), cA + hstep, voffA);
        if (wr == 1) PG8_BAR;
        PG8_WAIT_V(4); PG8_BAR;
        PG8_STAGE(PG8_SB(1, 0), cB + kstep, voffB); PG8_STAGE(PG8_SA(1, 0), cA + kstep, voffA); PG8_STAGE(PG8_SB(1, 1), cB + hstep + kstep, voffB);
        PG8_WAIT_V(6); PG8_BAR;
    }
    for (;;) {
        const bool has_next = S.next(ui + 1, nxt);
        const char* nA = has_next ? (const char*)g.A + (size_t)nxt.pm * tstep : cA; const char* nB = has_next ? (const char*)g.Bt + (size_t)nxt.pn * tstep : cB;
        for (int t = 0; t < nt; t += 2) {
            const bool last = (t == nt - 2);
            const char* a1 = cA + (size_t)(t + 1) * kstep;
            const char* a2 = last ? nA : cA + (size_t)(t + 2) * kstep; const char* b2 = last ? nB : cB + (size_t)(t + 2) * kstep;
            const char* a3 = a2 + kstep; const char* b3 = b2 + kstep;
            if (last && has_next) S.a_ready(nxt);
            if constexpr (SP2) {
            PG8_LDB(B0, 0, 0); PG8_LDB(B1, 0, 1); PG8_SCHED; PG8_LDA(At, 0, 0); PG8_STAGE(PG8_SA(1, 1), a1 + hstep, voffA);
            PG8_WAIT_V(8); PG8_WAIT_L(0); PG8_BAR; PG8_MMA(0, 0, At, B0); PG8_MMA(0, 1, At, B1); PG8_BAR; PG8_SCHED;
            PG8_LDA(At, 0, 1); PG8_STAGE(PG8_SB(0, 0), b2, voffB); PG8_STAGE(PG8_SB(0, 1), b2 + hstep, voffB); PG8_STAGE(PG8_SA(0, 0), a2, voffA);
            PG8_WAIT_V(8); PG8_WAIT_L(0); PG8_BAR; PG8_MMA(1, 0, At, B0); PG8_MMA(1, 1, At, B1); PG8_BAR; PG8_SCHED;
            PG8_LDB(B0, 1, 0); PG8_LDB(B1, 1, 1); PG8_SCHED; PG8_LDA(At, 1, 0); PG8_STAGE(PG8_SA(0, 1), a2 + hstep, voffA);
            PG8_WAIT_V(8); PG8_WAIT_L(0); PG8_BAR; PG8_MMA(0, 0, At, B0); PG8_MMA(0, 1, At, B1); PG8_BAR; PG8_SCHED;
            PG8_LDA(At, 1, 1); PG8_STAGE(PG8_SB(1, 0), b3, voffB); PG8_STAGE(PG8_SB(1, 1), b3 + hstep, voffB); PG8_STAGE(PG8_SA(1, 0), a3, voffA);
            PG8_WAIT_V(8); PG8_WAIT_L(0); PG8_BAR; PG8_MMA(1, 0, At, B0); PG8_MMA(1, 1, At, B1); PG8_BAR; PG8_SCHED;
            } else {
            PG8_LDB(B0, 0, 0); PG8_SCHED; PG8_LDA(At, 0, 0); PG8_STAGE(PG8_SA(1, 1), a1 + hstep, voffA);
            PG8_WAIT_L(8); PG8_BAR; PG8_WAIT_L(0); PG8_MMA(0, 0, At, B0); PG8_BAR; PG8_SCHED;
            PG8_LDB(B1, 0, 1); PG8_STAGE(PG8_SB(0, 0), b2, voffB);
            PG8_BAR; PG8_WAIT_L(0); PG8_MMA(0, 1, At, B1); PG8_BAR;
            PG8_LDA(At, 0, 1); PG8_STAGE(PG8_SA(0, 0), a2, voffA);
            PG8_BAR; PG8_WAIT_L(0); PG8_MMA(1, 0, At, B0); PG8_BAR; PG8_SCHED;
            PG8_STAGE(PG8_SB(0, 1), b2 + hstep, voffB);
            PG8_WAIT_V(6); PG8_BAR; PG8_MMA(1, 1, At, B1); PG8_BAR;
            PG8_LDB(B0, 1, 0); PG8_SCHED; PG8_LDA(At, 1, 0); PG8_STAGE(PG8_SA(0, 1), a2 + hstep, voffA);
            PG8_WAIT_L(8); PG8_BAR; PG8_WAIT_L(0); PG8_MMA(0, 0, At, B0); PG8_BAR; PG8_SCHED;
            PG8_LDB(B1, 1, 1); PG8_STAGE(PG8_SB(1, 0), b3, voffB);
            PG8_BAR; PG8_WAIT_L(0); PG8_MMA(0, 1, At, B1); PG8_BAR;
            PG8_LDA(At, 1, 1); PG8_STAGE(PG8_SA(1, 0), a3, voffA);
            PG8_BAR; PG8_WAIT_L(0); PG8_MMA(1, 0, At, B0); PG8_BAR; PG8_SCHED;
            PG8_STAGE(PG8_SB(1, 1), b3 + hstep, voffB);
            PG8_WAIT_V(6); PG8_BAR; PG8_MMA(1, 1, At, B1); PG8_BAR;
            }
        }
        if constexpr (ALIGN_EPI) { if (wr == 0) PG8_BAR; }
        if constexpr (!Epi::AFTER_DRAIN) { E(acc, cur, wr, wc, fr, fq); S.done(cur); }
        if (!has_next) break;
#pragma unroll
        for (int a = 0; a < 2; ++a)
#pragma unroll
            for (int b = 0; b < 2; ++b)
#pragma unroll
                for (int m = 0; m < 4; ++m)
#pragma unroll
                    for (int n = 0; n < 2; ++n) acc[a][b][m][n] = (f32x4){0.f, 0.f, 0.f, 0.f};
        cur = nxt; cA = nA; cB = nB; ++ui;
        if constexpr (ALIGN_EPI) { if (wr == 1) PG8_BAR; }
    }
    PG8_WAIT_V(0);
    if constexpr (!ALIGN_EPI) { if (wr == 0) PG8_BAR; }
    PG8_BAR;
    if constexpr (Epi::AFTER_DRAIN) { E.fused(acc, cur, wr, wc, fr, fq, lds, wid, lane); S.done(cur); }
#undef PG8_SA
#undef PG8_SB
#undef PG8_STAGE
#undef PG8_LDA
#undef PG8_LDB
#undef PG8_MMA
#undef PG8_WAIT_V
#undef PG8_WAIT_L
#undef PG8_BAR
#undef PG8_SCHED
}
}
#define GAS __attribute__((address_space(1)))
#define LAS __attribute__((address_space(3)))
typedef unsigned short bf16;
typedef unsigned v4u __attribute__((ext_vector_type(4)));
typedef float f32x4 __attribute__((ext_vector_type(4)));
typedef short bf16x8 __attribute__((ext_vector_type(8)));
typedef GAS unsigned gu32;
typedef GAS unsigned long long gu64;
#define RLX_AGENT __ATOMIC_RELAXED, __HIP_MEMORY_SCOPE_AGENT
#define LDS_WAIT() asm volatile("s_waitcnt lgkmcnt(0)" ::: "memory")
#define VM_WAIT() asm volatile("s_waitcnt vmcnt(0)" ::: "memory")
__device__ __forceinline__ unsigned long long rt() { return __builtin_amdgcn_s_memrealtime(); }
__device__ __forceinline__ unsigned f2bf(float f) { unsigned u = __builtin_bit_cast(unsigned, f); return (u + 0x7fffu + ((u >> 16) & 1u)) >> 16; }
__device__ __forceinline__ unsigned pk2(float lo, float hi) { return f2bf(lo) | (f2bf(hi) << 16); }
#define XB_TMO      128
#define XB_XCNT(j)  (256  + 64 * (j))
#define XB_XSUB(j)  (1280 + 64 * (j))
#define XB_XGEN(j)  (2304 + 64 * (j))
#define XB_TOP      3328
#define XB_TOPGEN   3392
#define XCD_BAR_WORDS 3456
#define XB_SPIN_CAP (1u << 18)

__device__ __forceinline__ unsigned xb_ld(unsigned* p)              { return __hip_atomic_load(p, __ATOMIC_RELAXED, __HIP_MEMORY_SCOPE_AGENT); }
__device__ __forceinline__ unsigned xb_add(unsigned* p, unsigned v) { return __hip_atomic_fetch_add(p, v, __ATOMIC_RELAXED, __HIP_MEMORY_SCOPE_AGENT); }
__device__ __forceinline__ unsigned xb_xcc_id() { return (unsigned)__builtin_amdgcn_s_getreg((3 << 11) | 20) & 0xFu; }
#define XB_SPIN(cond, bar) do { unsigned _sp = 0; while (cond) { __builtin_amdgcn_s_sleep(1); \
    if ((++_sp & 255u) == 0u) { if (xb_ld(&(bar)[XB_TMO])) break; if (_sp > XB_SPIN_CAP) { atomicAdd(&(bar)[XB_TMO], 1u); break; } } } } while (0)

struct XcdBarrier {
    unsigned* bar; unsigned x;
    volatile LAS unsigned* st;
};

__device__ __forceinline__ XcdBarrier xcd_barrier_post(unsigned* bar, volatile LAS unsigned* st) {
    XcdBarrier b; b.bar = bar; b.x = xb_xcc_id(); b.st = st;
    if (threadIdx.x == 0) (void)xb_add(&bar[XB_XCNT(b.x)], 1u);
    return b;
}
__device__ __forceinline__ void xcd_barrier_complete(unsigned* bar, unsigned x, unsigned& nloc, unsigned& nx) {
    const unsigned G = gridDim.x * gridDim.y * gridDim.z;
    unsigned sum, cnt, mine, sp = 0u;
    for (;;) {
        sum = 0u; cnt = 0u; mine = 0u;
#pragma unroll
        for (unsigned j = 0; j < 16; ++j) { const unsigned c = xb_ld(&bar[XB_XCNT(j)]); sum += c; cnt += (c > 0u) ? 1u : 0u; mine = (j == x) ? c : mine; }
        if (sum == G) break;
        __builtin_amdgcn_s_sleep(1);
        if ((++sp & 255u) == 0u) { if (xb_ld(&bar[XB_TMO])) break; if (sp > XB_SPIN_CAP) { atomicAdd(&bar[XB_TMO], 1u); break; } }
    }
    nloc = mine > 0u ? mine : 1u; nx = cnt > 0u ? cnt : 1u;
}

__device__ __forceinline__ void xcd_barrier(const XcdBarrier& b) {
    asm volatile("s_waitcnt vmcnt(0)" ::: "memory");
    __syncthreads();
    if (threadIdx.x == 0) {
        unsigned* bar = b.bar;
        __builtin_amdgcn_s_waitcnt(0);
        unsigned nloc = b.st[0], nx = b.st[1];
        if (nloc == 0u) { xcd_barrier_complete(bar, b.x, nloc, nx); b.st[0] = nloc; b.st[1] = nx; }
        const unsigned old = xb_add(&bar[XB_XSUB(b.x)], 1u);
        const unsigned gen = old / nloc;
        if (old + 1u == (gen + 1u) * nloc) {
            __builtin_amdgcn_fence(__ATOMIC_RELEASE, "agent");
            asm volatile("s_waitcnt vmcnt(0)" ::: "memory");
            const unsigned og = xb_add(&bar[XB_TOP], 1u);
            const unsigned tg = og / nx;
            if (og + 1u == (tg + 1u) * nx) xb_add(&bar[XB_TOPGEN], 1u);
            else XB_SPIN(xb_ld(&bar[XB_TOPGEN]) == tg, bar);
            __builtin_amdgcn_fence(__ATOMIC_ACQUIRE, "agent");
            xb_add(&bar[XB_XGEN(b.x)], 1u);
            asm volatile("s_waitcnt vmcnt(0)" ::: "memory");
        } else {
            __builtin_amdgcn_fence(__ATOMIC_ACQUIRE, "agent");
            XB_SPIN(xb_ld(&bar[XB_XGEN(b.x)]) == gen, bar);
            asm volatile("s_waitcnt vmcnt(0)" ::: "memory");
        }
    }
    __syncthreads();
}
constexpr int NWAVES = 8;
constexpr size_t MiB = 1u << 20;
constexpr size_t WS_CTL = 0, CTL_ZERO_BYTES = 65536;
constexpr size_t WS_W1 = 1 * MiB, WS_WO = 6 * MiB, WS_WGU = 8 * MiB, WS_WD = 19 * MiB, WS_WPG = 25 * MiB, WS_WPP = 27 * MiB;
constexpr size_t WS_RX = 28 * MiB, WS_SS1 = 29 * MiB, WS_SS2 = 32 * MiB;
constexpr size_t WS_XB = 36 * MiB;
constexpr size_t WS_PB = 102 * MiB, WS_PP = 119 * MiB;
constexpr size_t WS_Q = 185 * MiB, WS_KP = 218 * MiB, WS_VP = 250 * MiB, WS_KS = 282 * MiB, WS_VS = 300 * MiB, WS_GLU = 318 * MiB, WS_MIX = 351 * MiB;
constexpr size_t WS_ACT = 185 * MiB;
constexpr size_t WS_END = 417 * MiB;
static_assert(WS_XB + (size_t)R * D * 2 <= WS_PB && WS_PB + (size_t)R * PLE * 2 <= WS_PP && WS_PP + (size_t)R * D * 2 <= WS_Q && WS_Q + (size_t)R * 512 * 2 <= WS_KP &&
              WS_KP + (size_t)(RP / 64) * KVT_BYTES <= WS_KS && WS_KS + (size_t)DB * 9 * KVT_BYTES <= WS_GLU && WS_GLU + (size_t)R * 512 * 2 <= WS_MIX &&
              WS_MIX + (size_t)R * D * 2 <= WS_END && WS_ACT + (size_t)R * DFF * 2 <= WS_END && WS_SS1 + (size_t)R * 64 <= WS_SS2 && WS_SS2 + (size_t)R * 64 <= WS_XB && WS_RX + (size_t)R * 4 <= WS_SS1, "d_ws map");
constexpr int CW_BAR = 4096, CW_Q = 8192, CW_QG = CW_Q + 64 * 32;
constexpr int RING_OFF = 0, RING_BYTES = 131072;
constexpr int LDSCTL_OFF = RING_BYTES, MISC_OFF = LDSCTL_OFF + 320;
constexpr int ATT_TAB = 132096, ATT_LSC = ATT_TAB + 8192;
constexpr int LDS_BYTES = 147456;
static_assert(ATT_LSC + 2048 <= LDS_BYTES && MISC_OFF + 128 <= ATT_TAB, "LDS map");

__device__ __forceinline__ float wave_sum(float v) {
#pragma unroll
    for (int o = 1; o < 64; o <<= 1) v += __shfl_xor(v, o);
    return v;
}
__device__ __forceinline__ float wave_max(float v) {
#pragma unroll
    for (int o = 1; o < 64; o <<= 1) v = fmaxf(v, __shfl_xor(v, o));
    return v;
}
__device__ __forceinline__ int map_win(int n) {
    if (n < 1536) { const int sec = n >> 9, nn = n & 511, h = nn >> 6, d = nn & 63; return sec * 512 + 256 * (h >> 2) + 128 * (d >> 5) + 32 * (h & 3) + (d & 31); }
    if (n < 2048) { const int i = n - 1536; return 1536 + 256 * (i >> 7) + (i & 127); }
    const int i = n - 2048; return 1536 + 256 * (i >> 7) + 128 + (i & 127);
}
__device__ __forceinline__ int map_gu(int n) {
    if (n < DFF) return 256 * (n >> 7) + (n & 127);
    const int i = n - DFF; return 256 * (i >> 7) + 128 + (i & 127);
}
template <int MAP> __device__ __forceinline__ void p0_transpose_item(const float* W, const float* gain, int K, int N, bf16* WT, LAS float* scr, int item, int lane) {
    const int nblk = N / 32, kb = item / nblk, nb = item % nblk, k0 = 64 * kb, n0 = 32 * nb;
    { const int nq = lane & 7, kr = lane >> 3; f32x4 v[8];
#pragma unroll
      for (int i = 0; i < 8; ++i) v[i] = *(const GAS f32x4*)(W + (size_t)(k0 + 8 * i + kr) * N + n0 + 4 * nq);
#pragma unroll
      for (int i = 0; i < 8; ++i) { const int kk = 8 * i + kr; const float gk = gain ? gain[k0 + kk] : 1.0f;
#pragma unroll
          for (int e = 0; e < 4; ++e) scr[kk * 33 + 4 * nq + e] = v[i][e] * gk; } }
    LDS_WAIT(); asm volatile("" ::: "memory");
    const int c = lane & 7;
#pragma unroll
    for (int j = 0; j < 4; ++j) { const int n = (lane >> 3) + 8 * j; const LAS float* s = scr + (8 * c) * 33 + n;
        v4u o; o.x = pk2(s[0 * 33], s[1 * 33]); o.y = pk2(s[2 * 33], s[3 * 33]); o.z = pk2(s[4 * 33], s[5 * 33]); o.w = pk2(s[6 * 33], s[7 * 33]);
        const int ns = n0 + n, dr = MAP == 0 ? ns : (MAP == 1 ? map_win(ns) : map_gu(ns));
        *(GAS v4u*)(WT + (size_t)dr * K + k0 + 8 * c) = o; }
    LDS_WAIT(); asm volatile("" ::: "memory");
}

namespace att {
typedef short bf16x8 __attribute__((ext_vector_type(8)));
typedef short s16x4 __attribute__((ext_vector_type(4)));
typedef float f32x16 __attribute__((ext_vector_type(16)));
typedef unsigned u32x4 __attribute__((ext_vector_type(4)));
typedef float f32x2_t __attribute__((ext_vector_type(2))); typedef __bf16 bf16x2_t __attribute__((ext_vector_type(2)));
typedef short v4i16_t __attribute__((ext_vector_type(4)));
typedef LAS const char* lds_cptr;
constexpr int BUFB = 65536, HSLOT = 16384;
__device__ __forceinline__ int crow(int r, int hi) { return (r & 3) + 8 * (r >> 2) + 4 * hi; }
__device__ __forceinline__ void glds16(const void* gsrc, unsigned lds_dst) { unsigned keep;
    asm volatile("s_mov_b32 %0, m0\n\ts_mov_b32 m0, %2\n\ts_nop 0\n\tglobal_load_lds_dwordx4 %1, off\n\ts_mov_b32 m0, %0" : "=&s"(keep) : "v"(gsrc), "s"(lds_dst) : "memory"); }
__device__ __forceinline__ unsigned cvtpk_s(float lo, float hi) { f32x2_t v = {lo, hi}; bf16x2_t b = __builtin_convertvector(v, bf16x2_t); return __builtin_bit_cast(unsigned, b); }
__device__ __forceinline__ s16x4 vtr(lds_cptr p) { return __builtin_bit_cast(s16x4, __builtin_amdgcn_ds_read_tr16_b64_v4i16((LAS v4i16_t*)p)); }
#define ATT_WAIT_BAR() asm volatile("s_waitcnt vmcnt(0) lgkmcnt(0)\n\ts_barrier" ::: "memory")

struct AUnit { const bf16* Qrow; const unsigned char* KV; bf16* Orow; int nt, hg, sample, c0rel; };

__device__ __forceinline__ void attn_prefetch(const AUnit& U, LAS unsigned char* lds, int wid, int lane, bf16x8 (&qr)[2][4]) {
    const int r32 = lane & 31, hi = lane >> 5, hl = wid & 3, ci = wid >> 2, head = 4 * U.hg + hl;
    const bool wact = !U.sample || ci == 0;
    const unsigned char* kvsrc = U.KV + U.hg * 65536 + wid * 1024 + lane * 16;
    const unsigned kvdst = (unsigned)(size_t)lds + wid * 1024;
#pragma unroll
    for (int j_ = 0; j_ < 8; ++j_) glds16(kvsrc + j_ * 8192, (unsigned)__builtin_amdgcn_readfirstlane(kvdst + j_ * 8192));
    const bf16* Qw = U.Qrow + (size_t)((wact ? 64 * ci : 0) + r32) * 512 + head * 64 + hi * 8; const bf16* Qw1 = Qw + (U.sample ? 0 : 32 * 512);
#pragma unroll
    for (int d0 = 0; d0 < 4; ++d0) { qr[0][d0] = *(const bf16x8*)(Qw + d0 * 16); qr[1][d0] = *(const bf16x8*)(Qw1 + d0 * 16); }
}
template <bool TWO> __device__ __forceinline__ void attn_steps(const AUnit& U, LAS unsigned char* lds, int wid, int lane, const bf16x8 (&qr)[2][4], f32x16 (&o)[2][2], float (&lsum)[2]) {
    const int r32 = lane & 31, hi = lane >> 5, hl = wid & 3, ci = wid >> 2, head = 4 * U.hg + hl, nt = U.nt, own = U.c0rel + ci;
    const bool wact = TWO || ci == 0;
    const unsigned lds0 = (unsigned)(size_t)lds;
    const LAS float* tabh = (const LAS float*)(lds + ATT_TAB) + head * 256;
    const unsigned char* kvsrc = U.KV + U.hg * 65536 + wid * 1024 + lane * 16;
    const unsigned kvdst = lds0 + wid * 1024;
#define ATT_DMA(ti, b) do { _Pragma("unroll") for (int j_ = 0; j_ < 8; ++j_) \
        glds16(kvsrc + (size_t)(ti) * KVT_BYTES + j_ * 8192, (unsigned)__builtin_amdgcn_readfirstlane(kvdst + (b) * BUFB + j_ * 8192)); } while (0)
    for (int ti = 0; ti < nt; ++ti) {
        ATT_WAIT_BAR();
        const int b = ti & 1;
        if (ti + 1 < nt) ATT_DMA(ti + 1, b ^ 1);
        const int jt = own - ti;
        if (wact && jt >= 0 && jt <= 8) {
            const float m1 = (!TWO && jt == 0) ? 0.f : 1.f;
            const lds_cptr kp = (lds_cptr)(lds + b * BUFB + hl * HSLOT + hi * 1024 + r32 * 16);
            bf16x8 kf[8];
            { const unsigned ka = (unsigned)(size_t)kp;
              asm volatile("ds_read_b128 %0, %8\n\tds_read_b128 %1, %8 offset:512\n\tds_read_b128 %2, %8 offset:2048\n\tds_read_b128 %3, %8 offset:2560\n\t"
                           "ds_read_b128 %4, %8 offset:4096\n\tds_read_b128 %5, %8 offset:4608\n\tds_read_b128 %6, %8 offset:6144\n\tds_read_b128 %7, %8 offset:6656\n\ts_waitcnt lgkmcnt(0)"
                           : "=&v"(kf[0]), "=&v"(kf[1]), "=&v"(kf[2]), "=&v"(kf[3]), "=&v"(kf[4]), "=&v"(kf[5]), "=&v"(kf[6]), "=&v"(kf[7]) : "v"(ka) : "memory");
              __builtin_amdgcn_sched_barrier(0); }
            f32x16 s[2][2]; s[0][0] = f32x16{}; s[0][1] = f32x16{}; s[1][0] = f32x16{}; s[1][1] = f32x16{};
#pragma unroll
            for (int h2 = 0; h2 < (TWO ? 2 : 1); ++h2)
#pragma unroll
                for (int d0 = 0; d0 < 4; ++d0) { s[h2][0] = __builtin_amdgcn_mfma_f32_32x32x16_bf16(kf[2 * d0], qr[h2][d0], s[h2][0], 0, 0, 0);
                                                 s[h2][1] = __builtin_amdgcn_mfma_f32_32x32x16_bf16(kf[2 * d0 + 1], qr[h2][d0], s[h2][1], 0, 0, 0); }
            u32x4 pw[2][4];
#pragma unroll
            for (int h2 = 0; h2 < (TWO ? 2 : 1); ++h2) {
                f32x16& p0 = s[h2][0]; f32x16& p1 = s[h2][1];
                if (jt < 3) { const LAS float* tp = tabh + (191 - (32 * h2 + r32) - 64 * jt + 4 * hi);
#pragma unroll
                    for (int r = 0; r < 16; ++r) { p0[r] += tp[(r & 3) + 8 * (r >> 2)]; p1[r] += tp[32 + (r & 3) + 8 * (r >> 2)]; } }
                float sacc = 0.f;
#pragma unroll
                for (int r = 0; r < 16; ++r) { p0[r] = __builtin_amdgcn_exp2f(p0[r]); p1[r] = __builtin_amdgcn_exp2f(p1[r]); if (!TWO) p1[r] *= m1; sacc += p0[r] + p1[r]; }
                lsum[h2] += sacc;
#pragma unroll
                for (int k = 0; k < 2; ++k) { pw[h2][k] = (u32x4){cvtpk_s(p0[8 * k], p0[8 * k + 1]), cvtpk_s(p0[8 * k + 2], p0[8 * k + 3]), cvtpk_s(p0[8 * k + 4], p0[8 * k + 5]), cvtpk_s(p0[8 * k + 6], p0[8 * k + 7])};
                    pw[h2][2 + k] = (u32x4){cvtpk_s(p1[8 * k], p1[8 * k + 1]), cvtpk_s(p1[8 * k + 2], p1[8 * k + 3]), cvtpk_s(p1[8 * k + 4], p1[8 * k + 5]), cvtpk_s(p1[8 * k + 6], p1[8 * k + 7])}; }
            }
            const lds_cptr vp = (lds_cptr)(lds + b * BUFB + hl * HSLOT + 8192 + ((lane >> 4) & 1) * 32 + (lane & 3) * 8 + (4 * hi + ((lane & 15) >> 2)) * 64);
            const unsigned va = (unsigned)(size_t)vp;
#pragma unroll
            for (int d0 = 0; d0 < 2; ++d0) {
                s16x4 lo[4], hh[4];
                asm volatile("ds_read_b64_tr_b16 %0, %8 offset:%c9\n\tds_read_b64_tr_b16 %1, %8 offset:%c10\n\tds_read_b64_tr_b16 %2, %8 offset:%c11\n\tds_read_b64_tr_b16 %3, %8 offset:%c12\n\t"
                             "ds_read_b64_tr_b16 %4, %8 offset:%c13\n\tds_read_b64_tr_b16 %5, %8 offset:%c14\n\tds_read_b64_tr_b16 %6, %8 offset:%c15\n\tds_read_b64_tr_b16 %7, %8 offset:%c16\n\ts_waitcnt lgkmcnt(0)"
                             : "=&v"(lo[0]), "=&v"(hh[0]), "=&v"(lo[1]), "=&v"(hh[1]), "=&v"(lo[2]), "=&v"(hh[2]), "=&v"(lo[3]), "=&v"(hh[3])
                             : "v"(va), "i"(d0 * 4096), "i"(d0 * 4096 + 512), "i"(d0 * 4096 + 1024), "i"(d0 * 4096 + 1536), "i"(d0 * 4096 + 2048), "i"(d0 * 4096 + 2560), "i"(d0 * 4096 + 3072), "i"(d0 * 4096 + 3584) : "memory");
                __builtin_amdgcn_sched_barrier(0);
#pragma unroll
                for (int ks = 0; ks < 4; ++ks) {
                    const bf16x8 vf = (bf16x8){lo[ks][0], lo[ks][1], lo[ks][2], lo[ks][3], hh[ks][0], hh[ks][1], hh[ks][2], hh[ks][3]};
                    o[0][d0] = __builtin_amdgcn_mfma_f32_32x32x16_bf16(__builtin_bit_cast(bf16x8, pw[0][ks]), vf, o[0][d0], 0, 0, 0);
                    if (TWO) o[1][d0] = __builtin_amdgcn_mfma_f32_32x32x16_bf16(__builtin_bit_cast(bf16x8, pw[1][ks]), vf, o[1][d0], 0, 0, 0); }
            }
        }
    }
#undef ATT_DMA
}
template <bool TWO> __device__ __forceinline__ void attn_store(const AUnit& U, LAS unsigned char* lds, int wid, int lane, const f32x16 (&o)[2][2], const float (&lsum)[2]) {
    const int r32 = lane & 31, hi = lane >> 5, hl = wid & 3, ci = wid >> 2, head = 4 * U.hg + hl;
    const bool wact = TWO || ci == 0;
    LAS float* lsc = (LAS float*)(lds + ATT_LSC) + wid * 64;
    if (wact) {
#pragma unroll
        for (int h2 = 0; h2 < (TWO ? 2 : 1); ++h2) {
            float ls = lsum[h2];
            { auto rr = __builtin_amdgcn_permlane32_swap(__float_as_uint(ls), __float_as_uint(ls), false, false); ls = __uint_as_float(rr[0]) + __uint_as_float(rr[1]); }
            if (hi == 0) lsc[32 * h2 + r32] = ls;
            asm volatile("s_waitcnt lgkmcnt(0)" ::: "memory");
            LAS bf16* stg = (LAS bf16*)(lds + BUFB + wid * 8192 + h2 * 4096);
#pragma unroll
            for (int r = 0; r < 16; ++r) { const int orow = crow(r, hi); const float rl = __builtin_amdgcn_rcpf(lsc[32 * h2 + orow]);
#pragma unroll
                for (int d0 = 0; d0 < 2; ++d0) stg[orow * 64 + d0 * 32 + r32] = (bf16)f2bf(o[h2][d0][r] * rl); }
            asm volatile("s_waitcnt lgkmcnt(0)" ::: "memory");
            bf16* Ow = U.Orow + (size_t)(64 * ci + 32 * h2) * D + head * 64;
#pragma unroll
            for (int i = 0; i < 4; ++i) { const int row = i * 8 + (lane >> 3), ch = lane & 7; const u32x4 v = *(const LAS u32x4*)(stg + row * 64 + ch * 8); *(u32x4*)(Ow + (size_t)row * D + ch * 8) = v; }
        }
    }
}
}

__device__ __forceinline__ void conv_item(int item, const bf16* GLU, const float* st, const float* cw, const float* cb, const float* lg, const float* lb, bf16* MIX, LAS unsigned char* lds, int tid) {
    const bool samp = item >= RP / 32; const int b = samp ? item - RP / 32 : item >> 8, t0 = samp ? 0 : (item & 255) * 32, rowbase = samp ? RP + DS * b : b * SEQ;
    const int ch = tid, wid = tid >> 6, lane = tid & 63;
    LAS bf16* xs = (LAS bf16*)lds;
    LAS float* ybuf = (LAS float*)(lds + 65536);
#pragma unroll
    for (int i = 0; i < 8; ++i) { const int k = wid + 8 * i; if (k < 62) { const int tp = t0 - CH + k; pg8::u32x4 v = (pg8::u32x4){0u, 0u, 0u, 0u};
        if (tp >= 0) v = *(const pg8::u32x4*)(GLU + (size_t)(rowbase + tp) * 512 + 8 * lane);
        else if (samp) { const float* sp = st + ((size_t)b * CH + (CH + tp)) * CW + 8 * lane; v = pg8::pack8(*(const f32x4*)sp, *(const f32x4*)(sp + 4)); }
        *(LAS pg8::u32x4*)(xs + k * 512 + 8 * lane) = v; } }
    float w[CONVW];
#pragma unroll
    for (int j = 0; j < CONVW; ++j) w[j] = cw[j * CW + ch];
    const float bias = cb[ch];
    __syncthreads();
#pragma unroll 1
    for (int hb = 0; hb < 2; ++hb) {
        float x[46];
#pragma unroll
        for (int k = 0; k < 46; ++k) x[k] = __uint_as_float((unsigned)xs[(16 * hb + k) * 512 + ch] << 16);
        float y[16];
#pragma unroll
        for (int i = 0; i < 16; ++i) y[i] = bias;
#pragma unroll
        for (int j = 0; j < CONVW; ++j)
#pragma unroll
            for (int i = 0; i < 16; ++i) y[i] += w[j] * x[i + j];
#pragma unroll
        for (int i = 0; i < 16; ++i) ybuf[(16 * hb + i) * 512 + ch] = y[i];
    }
    __syncthreads();
    f32x4 g0 = *(const f32x4*)(lg + 8 * lane), g1 = *(const f32x4*)(lg + 8 * lane + 4), b0 = *(const f32x4*)(lb + 8 * lane), b1 = *(const f32x4*)(lb + 8 * lane + 4);
#pragma unroll
    for (int q = 0; q < 4; ++q) { const int i = 4 * wid + q;
        f32x4 v0 = *(const LAS f32x4*)(ybuf + i * 512 + 8 * lane), v1 = *(const LAS f32x4*)(ybuf + i * 512 + 8 * lane + 4);
        const float mean = wave_sum((v0[0] + v0[1]) + (v0[2] + v0[3]) + (v1[0] + v1[1]) + (v1[2] + v1[3])) * (1.0f / CW);
        v0 = v0 - mean; v1 = v1 - mean;
        const f32x4 q0 = v0 * v0, q1 = v1 * v1;
        const float rstd = rsqrtf(wave_sum((q0[0] + q0[1]) + (q0[2] + q0[3]) + (q1[0] + q1[1]) + (q1[2] + q1[3])) * (1.0f / CW) + EPS);
        v0 = v0 * rstd * g0 + b0; v1 = v1 * rstd * g1 + b1;
#pragma unroll
        for (int e = 0; e < 4; ++e) { v0[e] *= pg8::sigm(v0[e]); v1[e] *= pg8::sigm(v1[e]); }
        *(pg8::u32x4*)(MIX + (size_t)(rowbase + t0 + i) * D + 512 + 8 * lane) = pg8::pack8(v0, v1); }
    __syncthreads();
}


constexpr int SG_LD = 68;
#define SG_WAIT_BAR(N) asm volatile("s_waitcnt vmcnt(" #N ") lgkmcnt(0)\n\ts_barrier" ::: "memory")
template <class Epi> __device__ __forceinline__ void sgemm64(const bf16* A, const bf16* Bt, int K_, int tile, const Epi& E, LAS unsigned char* lds) {
    int tid_ = threadIdx.x; asm volatile("" : "+v"(tid_)); int K = K_; asm volatile("" : "+s"(K));
    const int lane = tid_ & 63, wave = __builtin_amdgcn_readfirstlane(tid_ >> 6), fr = lane & 15, fq = lane >> 4, wm = wave & 3, wn = wave >> 2, tr = tile >> 4, tc = tile & 15;
    const int KS = K >> 7;
    const unsigned char* src[4]; unsigned dsto[4];
#pragma unroll
    for (int i = 0; i < 4; ++i) { const int p = wave + 8 * i, r = 4 * (p & 15) + (lane >> 4), cs = (lane & 15) ^ (r & 15);
        src[i] = (const unsigned char*)((p < 16 ? A + (size_t)(64 * tr + r) * K : Bt + (size_t)(64 * tc + r) * K)) + cs * 16;
        dsto[i] = (p < 16 ? 0u : 16384u) + (unsigned)(p & 15) * 1024u; }
    const unsigned lds0 = (unsigned)(size_t)lds;
#define SG_STAGE(t) do { _Pragma("unroll") for (int i_ = 0; i_ < 4; ++i_) att::glds16(src[i_] + (size_t)(t) * 256, (unsigned)__builtin_amdgcn_readfirstlane(lds0 + (unsigned)((t) & 3) * 32768u + dsto[i_])); } while (0)
    f32x4 acc0 = (f32x4){0.f, 0.f, 0.f, 0.f}, acc1 = acc0;
    SG_STAGE(0); if (KS > 1) SG_STAGE(1); if (KS > 2) SG_STAGE(2);
    const unsigned ra = (unsigned)(16 * wm + fr) * 256u, rb = 16384u + (unsigned)(32 * wn + fr) * 256u;
    for (int t = 0; t < KS; ++t) {
        if (t + 2 < KS) SG_WAIT_BAR(8); else if (t + 1 < KS) SG_WAIT_BAR(4); else SG_WAIT_BAR(0);
        if (t + 3 < KS) SG_STAGE(t + 3);
        const LAS unsigned char* sb = lds + (t & 3) * 32768;
#pragma unroll
        for (int ks = 0; ks < 4; ++ks) { const unsigned ch = (unsigned)((4 * ks + fq) ^ fr) * 16u;
            const bf16x8 a = *(const LAS bf16x8*)(sb + ra + ch), b0 = *(const LAS bf16x8*)(sb + rb + ch), b1 = *(const LAS bf16x8*)(sb + rb + 4096 + ch);
            acc0 = __builtin_amdgcn_mfma_f32_16x16x32_bf16(b0, a, acc0, 0, 0, 0); acc1 = __builtin_amdgcn_mfma_f32_16x16x32_bf16(b1, a, acc1, 0, 0, 0); }
    }
#undef SG_STAGE
    SG_WAIT_BAR(0);
    LAS float* part = (LAS float*)lds;
    *(LAS f32x4*)(part + (16 * wm + fr) * SG_LD + 32 * wn + 4 * fq) = acc0; *(LAS f32x4*)(part + (16 * wm + fr) * SG_LD + 32 * wn + 16 + 4 * fq) = acc1;
    __syncthreads();
    const int row = tid_ >> 3, c8 = (tid_ & 7) * 8;
    const f32x4 v0 = *(const LAS f32x4*)(part + row * SG_LD + c8), v1 = *(const LAS f32x4*)(part + row * SG_LD + c8 + 4);
    E(64 * tr + row, 64 * tc + c8, tc, tid_ & 7, v0, v1);
    __syncthreads();
}
__device__ __forceinline__ float oct_sum(float s) { s += __shfl_xor(s, 1); s += __shfl_xor(s, 2); s += __shfl_xor(s, 4); return s; }
template <bool BF> struct SEpiRes {
    const float* base; bf16* HB; float* SS;
    __device__ __forceinline__ void operator()(int row, int col, int tc, int l8, f32x4 v0, f32x4 v1) const {
        const size_t o = (size_t)row * D + col;
        if (BF) { const pg8::u32x4 w = *(const pg8::u32x4*)(HB + o); v0 = v0 + pg8::bf_lo4(w); v1 = v1 + pg8::bf_hi4(w); }
        else { v0 = v0 + *(const f32x4*)(base + o); v1 = v1 + *(const f32x4*)(base + o + 4); }
        *(pg8::u32x4*)(HB + o) = pg8::pack8(v0, v1);
        const f32x4 q0 = v0 * v0, q1 = v1 * v1;
        const float ss = oct_sum(((q0[0] + q0[1]) + (q0[2] + q0[3])) + ((q1[0] + q1[1]) + (q1[2] + q1[3])));
        if (l8 == 0) SS[(size_t)row * 16 + tc] = ss;
    }
};
struct SEpiPP {
    bf16* PP;
    __device__ __forceinline__ void operator()(int row, int col, int tc, int l8, f32x4 v0, f32x4 v1) const { *(pg8::u32x4*)(PP + (size_t)row * D + col) = pg8::pack8(v0, v1); }
};
struct SEpiFinal {
    const float* SS; const bf16* PP; const bf16* HB; float* Y;
    __device__ __forceinline__ void operator()(int row, int col, int tc, int l8, f32x4 v0, f32x4 v1) const {
        const float r = rsqrtf(oct_sum(SS[(size_t)row * 16 + 2 * l8] + SS[(size_t)row * 16 + 2 * l8 + 1]) * (1.0f / D) + EPS);
        const size_t o = (size_t)row * D + col;
        const pg8::u32x4 pw = *(const pg8::u32x4*)(PP + o), hw = *(const pg8::u32x4*)(HB + o);
        const f32x4 p0 = pg8::bf_lo4(pw), p1 = pg8::bf_hi4(pw); f32x4 h0 = pg8::bf_lo4(hw), h1 = pg8::bf_hi4(hw);
#pragma unroll
        for (int e = 0; e < 4; ++e) { h0[e] += pg8::sigm(v0[e] * r) * p0[e]; h1[e] += pg8::sigm(v1[e] * r) * p1[e]; }
        *(f32x4*)(Y + o) = h0; *(f32x4*)(Y + o + 4) = h1;
    }
};

#ifndef REP_P0
#define REP_P0 1
#endif
#ifndef REP_P1
#define REP_P1 1
#endif
#ifndef REP_P2
#define REP_P2 1
#endif
#ifndef REP_P3
#define REP_P3 1
#endif
#ifndef REP_P4
#define REP_P4 1
#endif
struct Args { const float* in[23]; float* out; unsigned char* ws; };
constexpr int N_ATT_S = 2 * DB, N_ATT_P = NB * 64 * 2, N_CONV = R / 32;
constexpr int I_WO = (D / 64) * (D / 32), I_WGU = (D / 64) * (2 * DFF / 32), N_WCV = (I_WO + I_WGU) / 8;
constexpr int N_ATT_Q = 8 + 64;
static_assert((I_WO + I_WGU) % 8 == 0, "weight conversion entries");
#define W1t ((bf16*)(ws + WS_W1))
#define WOt ((bf16*)(ws + WS_WO))
#define WGUt ((bf16*)(ws + WS_WGU))
#define WDt ((bf16*)(ws + WS_WD))
#define WPGt ((bf16*)(ws + WS_WPG))
#define WPPt ((bf16*)(ws + WS_WPP))
#define RX ((float*)(ws + WS_RX))
#define SS1 ((float*)(ws + WS_SS1))
#define SS2 ((float*)(ws + WS_SS2))
#define XB ((bf16*)(ws + WS_XB))
#define PB ((bf16*)(ws + WS_PB))
#define PPb ((bf16*)(ws + WS_PP))
#define Qb ((bf16*)(ws + WS_Q))
#define KVP (ws + WS_KP)
#define KVS (ws + WS_KS)
#define GLUb ((bf16*)(ws + WS_GLU))
#define MIXb ((bf16*)(ws + WS_MIX))
#define ACTb ((bf16*)(ws + WS_ACT))
#define Y (out + OY)
__global__ void __launch_bounds__(NWAVES * 64, 2) mk_fwd(Args args) {
    extern __shared__ __attribute__((aligned(16))) unsigned char lds_[];
    LAS unsigned char* lds = (LAS unsigned char*)lds_;
    volatile LAS unsigned* MISC = (volatile LAS unsigned*)(lds + MISC_OFF);
    const int G = gridDim.x, vcu = (G % 8 == 0) ? ((int)blockIdx.x % 8) * (G / 8) + (int)blockIdx.x / 8 : (int)blockIdx.x;
    unsigned char* ws = args.ws; float* out = args.out;
    gu32* ctl = (gu32*)(ws + WS_CTL);
    for (int u = threadIdx.x; u < (ATT_TAB - LDSCTL_OFF) / 4; u += NWAVES * 64) ((LAS unsigned*)(lds + LDSCTL_OFF))[u] = 0u;
    __syncthreads();
    XcdBarrier bar = xcd_barrier_post((unsigned*)(ctl + CW_BAR), MISC + 8);

#ifndef SKIP_P0
    for (int rep = 0; rep < REP_P0; ++rep) {
        if (rep) xcd_barrier(bar);
        int tid0 = threadIdx.x; asm volatile("" : "+v"(tid0));
        const int lane = tid0 & 63, wave = __builtin_amdgcn_readfirstlane(tid0 >> 6);
        LAS float* scr = (LAS float*)(lds + RING_OFF + wave * 16384);
        const int gw = vcu * NWAVES + wave, NGW = G * NWAVES;
        constexpr int I_1 = (D / 64) * (INC / 32);
        for (int it = gw; it < I_1; it += NGW) p0_transpose_item<1>(args.in[8], args.in[7], D, INC, W1t, scr, it, lane);
        for (int m2 = gw; m2 < R / 2; m2 += NGW) {
            f32x4 v[2][4];
#pragma unroll
            for (int rr = 0; rr < 2; ++rr) { const int m = 2 * m2 + rr; const float* xrow = m < RP ? args.in[0] + (size_t)m * D : args.in[1] + (size_t)(m - RP) * D;
                const GAS f32x4* xr = (const GAS f32x4*)xrow + lane;
#pragma unroll
                for (int j = 0; j < 4; ++j) v[rr][j] = xr[64 * j]; }
#pragma unroll
            for (int rr = 0; rr < 2; ++rr) { const int m = 2 * m2 + rr; float s = 0.f;
#pragma unroll
                for (int j = 0; j < 4; ++j) s += (v[rr][j].x * v[rr][j].x + v[rr][j].y * v[rr][j].y) + (v[rr][j].z * v[rr][j].z + v[rr][j].w * v[rr][j].w);
                s = wave_sum(s); if (lane == 0) RX[m] = rsqrtf(s * (1.0f / D) + EPS);
                GAS unsigned long long* o8 = (GAS unsigned long long*)(XB + (size_t)m * D) + lane;
#pragma unroll
                for (int j = 0; j < 4; ++j) o8[64 * j] = (unsigned long long)pk2(v[rr][j].x, v[rr][j].y) | ((unsigned long long)pk2(v[rr][j].z, v[rr][j].w) << 32); }
        }
    }
#endif
    xcd_barrier(bar);

#ifndef SKIP_P1
    for (int rep = 0; rep < REP_P1; ++rep) {
        if (rep) xcd_barrier(bar);
        pg8::Gemm g{XB, W1t, R, INC, D}; pg8::StaticOrder S; S.init(R, INC, G, (int)blockIdx.x);
        pg8::Epi1 E{RX, args.in[9], args.in[10], Qb, KVP, KVS, GLUb, out};
        pg8::gemm_phase<pg8::Epi1, pg8::StaticOrder, true, true>(lds + RING_OFF, g, S, E);
        { const int c0 = ((R / 256) * (INC / 256)) % G, nwgc = c0 ? G - c0 : G, cc = c0 ? (int)blockIdx.x - c0 : (int)blockIdx.x;
          if (cc >= 0) {
            int tidc = threadIdx.x; asm volatile("" : "+v"(tidc));
            const int lane = tidc & 63, wave = __builtin_amdgcn_readfirstlane(tidc >> 6), head = lane >> 3, dq = lane & 7;
            for (int m2 = cc * NWAVES + wave; m2 < DB * 512; m2 += nwgc * NWAVES) {
                const int b = m2 >> 9, j = m2 & 511, kv = j & 63;
                const GAS f32x4* sk = (const GAS f32x4*)(args.in[4] + (size_t)m2 * 512) + 2 * lane; const GAS f32x4* sv = (const GAS f32x4*)(args.in[5] + (size_t)m2 * 512) + 2 * lane;
                const f32x4 k0 = sk[0], k1 = sk[1], v0 = sv[0], v1 = sv[1];
                unsigned char* tb = KVS + (size_t)(b * 9 + (j >> 6)) * KVT_BYTES + (head >> 2) * 65536 + (head & 3) * 16384;
                *(GAS v4u*)(tb + dq * 1024 + kv * 16) = (v4u){pk2(k0.x, k0.y), pk2(k0.z, k0.w), pk2(k1.x, k1.y), pk2(k1.z, k1.w)};
                *(GAS v4u*)(tb + 8192 + (dq >> 2) * 4096 + (kv >> 4) * 1024 + (kv & 15) * 64 + (dq & 3) * 16) = (v4u){pk2(v0.x, v0.y), pk2(v0.z, v0.w), pk2(v1.x, v1.y), pk2(v1.z, v1.w)};
            }
            for (int p = cc * NWAVES + wave; p < DB * NH; p += nwgc * NWAVES) {
                unsigned char* tb = KVS + (size_t)((p >> 3) * 9 + 8) * KVT_BYTES + ((p & 7) >> 2) * 65536 + (p & 3) * 16384; const v4u z = (v4u){0u, 0u, 0u, 0u};
#pragma unroll
                for (int c2 = 0; c2 < 4; ++c2) *(GAS v4u*)(tb + (2 * c2 + (lane >> 5)) * 1024 + 512 + (lane & 31) * 16) = z;
#pragma unroll
                for (int q = 0; q < 4; ++q) *(GAS v4u*)(tb + 8192 + (q >> 1) * 4096 + (2 + (q & 1)) * 1024 + lane * 16) = z;
            }
          } }
    }
#endif
    xcd_barrier(bar);

#ifndef SKIP_P2
    for (int rep = 0; rep < REP_P2; ++rep) {
        if (rep) xcd_barrier(bar);
        { int tidt = threadIdx.x; asm volatile("" : "+v"(tidt)); const int lane = tidt & 63, wave = __builtin_amdgcn_readfirstlane(tidt >> 6);
          const float* relb = args.in[11] + wave * NREL; LAS float* T = (LAS float*)(lds + ATT_TAB) + wave * 256;
          const float bfar = relb[256];
          for (int x = lane; x < 256; x += 64) { int dd = 191 - x; dd = dd < -128 ? -128 : (dd > 128 ? 128 : dd); T[x] = (relb[dd + 128] - bfar) * LOG2E; } }
        __syncthreads();
        {
            int tid2 = threadIdx.x; asm volatile("" : "+v"(tid2));
            const int lane2 = tid2 & 63, wave2 = __builtin_amdgcn_readfirstlane(tid2 >> 6);
            int qk = 0, q = (int)blockIdx.x & 7;
#define ATT_POP(qq) ((int)__hip_atomic_fetch_add((unsigned*)(ctl + CW_Q + 64 * ((qq) + 8 * rep)), 1u, __ATOMIC_RELAXED, __HIP_MEMORY_SCOPE_AGENT))
#define ATT_DECODE(code, U) do { const int q_ = (int)((code) >> 8), i_ = (int)((code) & 255u); \
                if (i_ < 8) { const int sb = 4 * q_ + (i_ >> 1); U.hg = i_ & 1; U.sample = 1; U.nt = 9; U.c0rel = 8; \
                    U.Qrow = Qb + (size_t)(RP + DS * sb) * 512; U.KV = KVS + (size_t)(sb * 9) * KVT_BYTES; U.Orow = MIXb + (size_t)(RP + DS * sb) * D; } \
                else { const int j = i_ - 8, pi = j < 60 ? 4 + j : 63 - j, bb = q_ >> 1, c0 = 2 * pi;     \
                    U.hg = q_ & 1; U.sample = 0; U.c0rel = c0 < 8 ? c0 : 8; U.nt = U.c0rel + 2; const size_t row0 = (size_t)bb * SEQ + 64 * c0; \
                    U.Qrow = Qb + row0 * 512; U.KV = KVP + (size_t)(bb * 128 + c0 - U.c0rel) * KVT_BYTES; U.Orow = MIXb + row0 * D; } } while (0)
            if (tid2 == 0) { int i = ATT_POP(q); while (i >= N_ATT_Q) { if (++qk == 8) { i = -1; break; } q = ((int)blockIdx.x + qk) & 7; i = ATT_POP(q); }
                MISC[4] = i < 0 ? 0xffffffffu : (unsigned)((q << 8) | i); }
            __syncthreads();
            unsigned code = MISC[4];
            if (code != 0xffffffffu) {
                att::AUnit U; ATT_DECODE(code, U);
                att::bf16x8 qr[2][4];
                att::attn_prefetch(U, lds, wave2, lane2, qr);
                for (;;) {
                    int nraw = 0; if (tid2 == 0) nraw = ATT_POP(q);
#pragma unroll
                    for (int d0 = 0; d0 < 4; ++d0) asm volatile("" : "+v"(qr[0][d0]), "+v"(qr[1][d0]));
                    att::f32x16 o[2][2]; o[0][0] = att::f32x16{}; o[0][1] = att::f32x16{}; o[1][0] = att::f32x16{}; o[1][1] = att::f32x16{}; float lsum[2] = {0.f, 0.f};
                    if (U.sample) att::attn_steps<false>(U, lds, wave2, lane2, qr, o, lsum); else att::attn_steps<true>(U, lds, wave2, lane2, qr, o, lsum);
                    if (tid2 == 0) { int i = nraw; while (i >= N_ATT_Q) { if (++qk == 8) { i = -1; break; } q = ((int)blockIdx.x + qk) & 7; i = ATT_POP(q); }
                        MISC[4] = i < 0 ? 0xffffffffu : (unsigned)((q << 8) | i); }
                    ATT_WAIT_BAR();
                    const unsigned ncode = MISC[4];
                    att::AUnit Un = U;
                    if (ncode != 0xffffffffu) { ATT_DECODE(ncode, Un); att::attn_prefetch(Un, lds, wave2, lane2, qr); }
                    if (U.sample) att::attn_store<false>(U, lds, wave2, lane2, o, lsum); else att::attn_store<true>(U, lds, wave2, lane2, o, lsum);
                    if (ncode == 0xffffffffu) break;
                    U = Un;
                }
                ATT_WAIT_BAR();
            }
#undef ATT_POP
#undef ATT_DECODE
        }
        for (;;) {
            int tid2 = threadIdx.x; asm volatile("" : "+v"(tid2));
            if (tid2 == 0) MISC[4] = __hip_atomic_fetch_add((unsigned*)(ctl + CW_QG + 64 * rep), 1u, __ATOMIC_RELAXED, __HIP_MEMORY_SCOPE_AGENT);
            __syncthreads();
            const int idx = (int)MISC[4];
            __syncthreads();
            if (idx >= N_CONV + N_WCV) break;
            const int lane2 = tid2 & 63, wave2 = __builtin_amdgcn_readfirstlane(tid2 >> 6);
            if (idx < N_CONV) conv_item(idx, GLUb, args.in[6], args.in[12], args.in[13], args.in[14], args.in[15], MIXb, lds, tid2);
            else { const int it = 8 * (idx - N_CONV) + wave2; LAS float* scr = (LAS float*)(lds + RING_OFF + wave2 * 16384);
                if (it < I_WO) p0_transpose_item<0>(args.in[16], nullptr, D, D, WOt, scr, it, lane2);
                else p0_transpose_item<2>(args.in[18], args.in[17], D, 2 * DFF, WGUt, scr, it - I_WO, lane2);
                __syncthreads(); }
        }
    }
#endif
    xcd_barrier(bar);

#ifndef SKIP_P3
    for (int rep = 0; rep < REP_P3; ++rep) {
        if (rep) xcd_barrier(bar);
        pg8::Gemm g{MIXb, WOt, RP, D, D}; pg8::StaticOrder S; S.init(RP, D, G, (int)blockIdx.x);
        pg8::EpiRes<true> E{nullptr, nullptr, XB, SS1};
        const SEpiRes<true> SE{nullptr, XB + (size_t)RP * D, SS1 + (size_t)RP * 16};
        if (blockIdx.x & 1) for (int t = (int)blockIdx.x; t < 256; t += G) sgemm64(MIXb + (size_t)RP * D, WOt, D, t, SE, lds + RING_OFF);
        pg8::gemm_phase<pg8::EpiRes<true>, pg8::StaticOrder, true, true>(lds + RING_OFF, g, S, E);
        if (!(blockIdx.x & 1)) for (int t = (int)blockIdx.x; t < 256; t += G) sgemm64(MIXb + (size_t)RP * D, WOt, D, t, SE, lds + RING_OFF);
    }
#endif
    xcd_barrier(bar);

#ifndef SKIP_P4
    for (int rep = 0; rep < REP_P4; ++rep) {
        if (rep) xcd_barrier(bar);
        { const int c0 = ((R / 256) * (2 * DFF / 256)) % G, nwgc = c0 ? G - c0 : G, cc = c0 ? (int)blockIdx.x - c0 : (int)blockIdx.x;
          if (cc >= 0) {
            const bool wt = (nwgc % 4) == 0; const int k = wt ? cc & 3 : 1, j = wt ? cc >> 2 : cc, per = wt ? nwgc / 4 : nwgc, nslot = wt ? 6 * per : per;
            const int s0 = !wt ? j : (k == 1 ? j : (k == 2 ? per + 2 * j : 3 * per + 3 * j));
            int tidc = threadIdx.x; asm volatile("" : "+v"(tidc));
            const int lane = tidc & 63, wave = __builtin_amdgcn_readfirstlane(tidc >> 6);
            for (int q = 0; q < k; ++q)
            for (int m4 = s0 + q + nslot * wave; m4 < 2 * DB * 120; m4 += nslot * NWAVES) {
                const int kv = m4 >= DB * 120, mm = kv ? m4 - DB * 120 : m4, b = mm / 120, j2 = DS + 4 * (mm % 120);
                const GAS f32x4* src = (const GAS f32x4*)(args.in[4 + kv] + ((size_t)b * 512 + j2) * 512) + lane;
                GAS f32x4* dst = (GAS f32x4*)(out + (kv ? OVS : OKS) + ((size_t)b * 512 + (j2 - DS)) * 512) + lane;
                f32x4 v[8];
#pragma unroll
                for (int i = 0; i < 8; ++i) v[i] = src[64 * i];
#pragma unroll
                for (int i = 0; i < 8; ++i) dst[64 * i] = v[i];
            }
            { LAS float* scr = (LAS float*)(lds + RING_OFF + wave * 16384); constexpr int I_D = (DFF / 64) * (D / 32), I_PG = (D / 64) * (D / 32);
              constexpr int I_PP = (PLE / 64) * (D / 32);
              for (int it = cc * NWAVES + wave; it < I_D + I_PG + I_PP; it += nwgc * NWAVES) {
                  if (it < I_D) p0_transpose_item<0>(args.in[19], nullptr, DFF, D, WDt, scr, it, lane);
                  else if (it < I_D + I_PG) p0_transpose_item<0>(args.in[21], args.in[20], D, D, WPGt, scr, it - I_D, lane);
                  else p0_transpose_item<0>(args.in[22], nullptr, PLE, D, WPPt, scr, it - I_D - I_PG, lane); }
              __syncthreads(); }
            for (int m8 = cc * NWAVES + wave; m8 < R / 8; m8 += nwgc * NWAVES) {
                const int m = 8 * m8; const float* prow = m < RP ? args.in[2] + (size_t)m * PLE : args.in[3] + (size_t)(m - RP) * PLE;
                const GAS f32x4* pr = (const GAS f32x4*)prow + lane; f32x4 pv[8];
#pragma unroll
                for (int j = 0; j < 8; ++j) pv[j] = pr[64 * j];
                GAS unsigned long long* o8 = (GAS unsigned long long*)(PB + (size_t)m * PLE) + lane;
#pragma unroll
                for (int j = 0; j < 8; ++j) o8[64 * j] = (unsigned long long)pk2(pv[j].x, pv[j].y) | ((unsigned long long)pk2(pv[j].z, pv[j].w) << 32);
            }
          } }
        pg8::Gemm g{XB, WGUt, R, 2 * DFF, D}; pg8::StaticOrder S; S.init(R, 2 * DFF, G, (int)blockIdx.x);
        pg8::EpiAct E{SS1, ACTb};
        pg8::gemm_phase<pg8::EpiAct, pg8::StaticOrder, true, true>(lds + RING_OFF, g, S, E);
    }
#endif
    xcd_barrier(bar);

#ifndef SKIP_P5
    {
        pg8::Gemm g{ACTb, WDt, RP, D, DFF}; pg8::StaticOrder S; S.init(RP, D, G, (int)blockIdx.x);
        pg8::EpiRes<true> E{nullptr, nullptr, XB, SS2};
        const SEpiRes<true> SE{nullptr, XB + (size_t)RP * D, SS2 + (size_t)RP * 16};
        if (blockIdx.x & 1) for (int t = (int)blockIdx.x; t < 256; t += G) sgemm64(ACTb + (size_t)RP * DFF, WDt, DFF, t, SE, lds + RING_OFF);
        pg8::gemm_phase<pg8::EpiRes<true>, pg8::StaticOrder, true, true>(lds + RING_OFF, g, S, E);
        if (!(blockIdx.x & 1)) for (int t = (int)blockIdx.x; t < 256; t += G) sgemm64(ACTb + (size_t)RP * DFF, WDt, DFF, t, SE, lds + RING_OFF);
    }
#endif
    xcd_barrier(bar);

#ifndef SKIP_P6
    {
        pg8::Gemm g{XB, WPGt, RP, D, D}; pg8::StaticOrder S; S.init(RP, D, G, (int)blockIdx.x);
        pg8::EpiFinal E{SS2, PPb, XB, Y};
        const SEpiFinal SE{SS2 + (size_t)RP * 16, PPb + (size_t)RP * D, XB + (size_t)RP * D, Y + (size_t)RP * D};
        pg8::Gemm gp{PB, WPPt, RP, D, PLE}; pg8::EpiPP EP{PPb}; const SEpiPP SP{PPb + (size_t)RP * D};
        if (blockIdx.x & 1) for (int t = (int)blockIdx.x; t < 256; t += G) { sgemm64(PB + (size_t)RP * PLE, WPPt, PLE, t, SP, lds + RING_OFF); sgemm64(XB + (size_t)RP * D, WPGt, D, t, SE, lds + RING_OFF); }
        pg8::gemm_phase<pg8::EpiPP, pg8::StaticOrder, true, true>(lds + RING_OFF, gp, S, EP);
        pg8::gemm_phase<pg8::EpiFinal, pg8::StaticOrder, true, true>(lds + RING_OFF, g, S, E);
        if (!(blockIdx.x & 1)) for (int t = (int)blockIdx.x; t < 256; t += G) { sgemm64(PB + (size_t)RP * PLE, WPPt, PLE, t, SP, lds + RING_OFF); sgemm64(XB + (size_t)RP * D, WPGt, D, t, SE, lds + RING_OFF); }
    }
#endif
}

extern "C" void kernel_launch(void* const* d_in, const int* in_sizes, int n_in, void* d_out, int out_size, void* d_ws, size_t ws_size, hipStream_t stream) {
    static int grid = 0;
    if (grid == 0) {
        if (n_in != 23 || ws_size < WS_END) { fprintf(stderr, "kernel_launch: unexpected shapes (n_in %d, ws %zu)\n", n_in, ws_size); grid = -1; return; }
        int dev = 0, cus = 0, per_cu = 0;
        if (hipGetDevice(&dev) != hipSuccess || hipDeviceGetAttribute(&cus, hipDeviceAttributeMultiprocessorCount, dev) != hipSuccess) { grid = -1; return; }
        if (hipFuncSetAttribute((const void*)mk_fwd, hipFuncAttributeMaxDynamicSharedMemorySize, LDS_BYTES) != hipSuccess) { fprintf(stderr, "kernel_launch: hipFuncSetAttribute failed\n"); grid = -1; return; }
        if (hipOccupancyMaxActiveBlocksPerMultiprocessor(&per_cu, (const void*)mk_fwd, NWAVES * 64, LDS_BYTES) != hipSuccess || per_cu < 1) { fprintf(stderr, "kernel_launch: occupancy query says %d blocks per CU\n", per_cu); }
        (void)hipGetLastError();
        grid = cus;
    }
    if (grid < 0) return;
    if (hipMemsetAsync((char*)d_ws + WS_CTL, 0, CTL_ZERO_BYTES, stream) != hipSuccess) return;
    Args a{};
    for (int i = 0; i < 23; ++i) a.in[i] = (const float*)d_in[i];
    a.out = (float*)d_out; a.ws = (unsigned char*)d_ws;
    hipLaunchKernelGGL(mk_fwd, dim3(grid), dim3(NWAVES * 64), LDS_BYTES, stream, a);
}
```

```cpp
#include <hip/hip_runtime.h>
#include <cstdio>
#include <cstdint>
constexpr int D = 1024, SEQ = 8192, NB = 4, DB = 32, DS = 32;
constexpr int RP = NB * SEQ, RS = DB * DS, R = RP + RS;
constexpr int INC = 2560, DFF = 2816, PLE = 256, NH = 8, HD = 64, CW = 512;
constexpr int NREL = 257, CONVW = 31, CH = 30, KSROWS = 576;
constexpr int KVT_BYTES = 131072;
constexpr float EPS = 1e-6f, LOG2E = 1.4426950408889634f, QSCALE = 0.125f * LOG2E;
constexpr size_t OY = 0, OKP = (size_t)R * D, OVP = OKP + (size_t)NB * 512 * 512, OCP = OVP + (size_t)NB * 512 * 512,
                 OKS = OCP + (size_t)NB * CH * CW, OVS = OKS + (size_t)DB * 512 * 512, OCS = OVS + (size_t)DB * 512 * 512;
namespace pg8 {
#define PG8_LAS __attribute__((address_space(3)))
typedef unsigned short bf16_t;
typedef short bf16x8 __attribute__((ext_vector_type(8)));
typedef float f32x4 __attribute__((ext_vector_type(4)));
typedef unsigned u32x4 __attribute__((ext_vector_type(4)));
constexpr int BM = 256, BK = 64, HALF = 128, HTB = HALF * BK * 2  , STAGE_BYTES = 8 * HTB, NXCD = 8, WGM = 8;

__host__ __device__ __forceinline__ int lds_byte(int r, int c) { const int st = (r >> 4) * 2 + (c >> 5), rr = r & 15, cc = c & 31, ob = rr * 64 + cc * 2; return st * 1024 + (ob ^ (((ob >> 9) & 1) << 5)); }
__host__ __device__ __forceinline__ void stage_rc(int b, int& R, int& C) { const int st = b / 1024, sb = b % 1024, swz = sb ^ (((sb >> 9) & 1) << 5); R = (st >> 1) * 16 + swz / 64; C = (st & 1) * 32 + (swz % 64) / 2; }
__host__ __device__ __forceinline__ int perm32(int rho) { const int n = rho >> 4, i = rho & 15; return 8 * (i >> 2) + 4 * n + (i & 3); }

struct Unit { int pm, pn; };
struct Gemm { const bf16_t* A; const bf16_t* Bt; int M, N, K; };

struct StaticOrder {
    int nM, nN, nwg, G, c;
    __host__ __device__ void init(int M, int N, int G_, int c_) { nM = M / BM; nN = N / BM; nwg = nM * nN; G = G_; c = c_; }
    __host__ __device__ bool next(int i, Unit& u) const {
        const long L = (long)i * G + c; if (L >= nwg) return false;
        int wgid = (int)L; { const int q = nwg / NXCD, r = nwg % NXCD, xcd = wgid % NXCD, off = wgid / NXCD; wgid = (xcd < r ? xcd * (q + 1) : r * (q + 1) + (xcd - r) * q) + off; }
        const int nig = WGM * nN, gid = wgid / nig, fm = gid * WGM, gsz = (nM - fm) < WGM ? (nM - fm) : WGM;
        u.pm = fm + ((wgid % nig) % gsz); u.pn = (wgid % nig) / gsz; return true;
    }
    __device__ __forceinline__ void a_ready(const Unit&) const {}
    __device__ __forceinline__ void done(const Unit&) const {}
};

__device__ __forceinline__ unsigned cvt_pk_bf16(float lo, float hi) { unsigned r; asm volatile("v_cvt_pk_bf16_f32 %0, %1, %2" : "=v"(r) : "v"(lo), "v"(hi)); return r; }
typedef float f32x2 __attribute__((ext_vector_type(2)));typedef unsigned u32x2 __attribute__((ext_vector_type(2)));
__device__ __forceinline__ u32x4 pack8(const f32x4 a, const f32x4 b) { u32x4 w; w.x = cvt_pk_bf16(a[0], a[1]); w.y = cvt_pk_bf16(a[2], a[3]); w.z = cvt_pk_bf16(b[0], b[1]); w.w = cvt_pk_bf16(b[2], b[3]); return w; }
__device__ __forceinline__ float sigm(float x) { return __builtin_amdgcn_rcpf(1.0f + __builtin_amdgcn_exp2f(-x * LOG2E)); }
__device__ __forceinline__ float quad_sum(float s) { s += __shfl_xor(s, 16); s += __shfl_xor(s, 32); return s; }
struct Epi1 {
    static constexpr bool PERM = true, AFTER_DRAIN = false;
    const float* rx; const float* qg; const float* kg; bf16_t* Q; unsigned char* KVP; unsigned char* KVS; bf16_t* GLU; float* out;
    __device__ __forceinline__ void operator()(const f32x4 (&acc)[2][2][4][2], const Unit& u, int wr, int wc, int fr, int fq) const {
        const int pn = u.pn, rowt = u.pm * BM + wr * 64 + fr;
        float rxv[2][4];
#pragma unroll
        for (int ai = 0; ai < 2; ++ai)
#pragma unroll
            for (int m = 0; m < 4; ++m) rxv[ai][m] = rx[rowt + ai * HALF + m * 16];
        if (pn < 6) {
            const int sec = pn >> 1, col = (4 * (pn & 1) + wc) * 64 + 8 * fq;
            f32x4 g[2][2];
#pragma unroll
            for (int bj = 0; bj < 2; ++bj)
#pragma unroll
                for (int n = 0; n < 2; ++n) { g[bj][n] = (f32x4){1.f, 1.f, 1.f, 1.f};
                    if (sec == 0) g[bj][n] = *(const f32x4*)(qg + 32 * bj + 8 * fq + 4 * n) * QSCALE;
                    if (sec == 1) g[bj][n] = *(const f32x4*)(kg + 32 * bj + 8 * fq + 4 * n); }
#pragma unroll
            for (int ai = 0; ai < 2; ++ai)
#pragma unroll
                for (int m = 0; m < 4; ++m) {
                    const int row = rowt + ai * HALF + m * 16; const float r = rxv[ai][m];
                    f32x4 z[2][2];
#pragma unroll
                    for (int bj = 0; bj < 2; ++bj)
#pragma unroll
                        for (int n = 0; n < 2; ++n) z[bj][n] = acc[ai][bj][m][n] * r;
                    if (sec < 2) {
                        float ss = 0.f;
#pragma unroll
                        for (int bj = 0; bj < 2; ++bj)
#pragma unroll
                            for (int n = 0; n < 2; ++n) { const f32x4 q = z[bj][n] * z[bj][n]; ss += (q[0] + q[1]) + (q[2] + q[3]); }
                        ss = quad_sum(ss);
                        const float rn = rsqrtf(ss * (1.0f / 64.0f) + EPS);
#pragma unroll
                        for (int bj = 0; bj < 2; ++bj)
#pragma unroll
                            for (int n = 0; n < 2; ++n) z[bj][n] = z[bj][n] * rn * g[bj][n];
                    }
                    const int sb = (row - RP) >> 5, si = (row - RP) & 31;
                    float* fo = nullptr;
                    if (sec == 0) {
#pragma unroll
                        for (int bj = 0; bj < 2; ++bj) *(u32x4*)(Q + (size_t)row * 512 + col + 32 * bj) = pack8(z[bj][0], z[bj][1]);
                    } else {
                        unsigned char* tb; int kv;
                        if (row < RP) { tb = KVP + (size_t)(row >> 6) * KVT_BYTES; kv = row & 63;
                            const int t = row & (SEQ - 1); if (t >= SEQ - 512) fo = out + OKP + (size_t)(sec - 1) * (OVP - OKP) + ((size_t)((row >> 13) * 512 + (t - (SEQ - 512)))) * 512 + col; }
                        else { tb = KVS + (size_t)(sb * 9 + 8) * KVT_BYTES; kv = si; fo = out + OKS + (size_t)(sec - 1) * (OVS - OKS) + ((size_t)(sb * 512 + 480 + si)) * 512 + col; }
                        tb += (pn & 1) * 65536 + wc * 16384;
                        const int ok = fq * 1024 + kv * 16, ov = 8192 + (kv >> 4) * 1024 + (kv & 15) * 64 + fq * 16;
#pragma unroll
                        for (int bj = 0; bj < 2; ++bj) *(u32x4*)(tb + (sec == 1 ? ok + bj * 4096 : ov + bj * 4096)) = pack8(z[bj][0], z[bj][1]);
                    }
                    if (fo) {
#pragma unroll
                        for (int bj = 0; bj < 2; ++bj)
#pragma unroll
                            for (int n = 0; n < 2; ++n) *(f32x4*)(fo + 32 * bj + 4 * n) = z[bj][n]; }
                }
        } else {
            const int col = 128 * (pn - 6) + 32 * wc + 8 * fq;
#pragma unroll
            for (int ai = 0; ai < 2; ++ai)
#pragma unroll
                for (int m = 0; m < 4; ++m) {
                    const int row = rowt + ai * HALF + m * 16; const float r = rxv[ai][m];
                    f32x4 gl[2];
#pragma unroll
                    for (int n = 0; n < 2; ++n) { const f32x4 a = acc[ai][0][m][n] * r, b = acc[ai][1][m][n] * r;
#pragma unroll
                        for (int e = 0; e < 4; ++e) gl[n][e] = a[e] * sigm(b[e]); }
                    *(u32x4*)(GLU + (size_t)row * 512 + col) = pack8(gl[0], gl[1]);
                    float* fo = nullptr;
                    if (row < RP) { const int t = row & (SEQ - 1); if (t >= SEQ - CH) fo = out + OCP + ((size_t)((row >> 13) * CH + (t - (SEQ - CH)))) * CW + col; }
                    else { const int sb = (row - RP) >> 5, si = (row - RP) & 31; if (si >= DS - CH) fo = out + OCS + ((size_t)(sb * CH + (si - (DS - CH)))) * CW + col; }
                    if (fo) { *(f32x4*)(fo) = gl[0]; *(f32x4*)(fo + 4) = gl[1]; }
                }
        }
    }
};
struct EpiPP {
    static constexpr bool PERM = true, AFTER_DRAIN = false;
    bf16_t* O;
    __device__ __forceinline__ void operator()(const f32x4 (&acc)[2][2][4][2], const Unit& u, int wr, int wc, int fr, int fq) const {
        const int rowt = u.pm * BM + wr * 64 + fr, col = u.pn * BM + 32 * wc + 8 * fq;
#pragma unroll
        for (int ai = 0; ai < 2; ++ai)
#pragma unroll
            for (int m = 0; m < 4; ++m) { bf16_t* rowp = O + (size_t)(rowt + ai * HALF + m * 16) * D + col;
#pragma unroll
                for (int bj = 0; bj < 2; ++bj) *(u32x4*)(rowp + bj * HALF) = pack8(acc[ai][bj][m][0], acc[ai][bj][m][1]); }
    }
};
__device__ __forceinline__ f32x4 bf_lo4(const u32x4 w) { return (f32x4){__uint_as_float(w.x << 16), __uint_as_float(w.x & 0xffff0000u), __uint_as_float(w.y << 16), __uint_as_float(w.y & 0xffff0000u)}; }
__device__ __forceinline__ f32x4 bf_hi4(const u32x4 w) { return (f32x4){__uint_as_float(w.z << 16), __uint_as_float(w.z & 0xffff0000u), __uint_as_float(w.w << 16), __uint_as_float(w.w & 0xffff0000u)}; }
template <bool BF> struct EpiRes {
    static constexpr bool PERM = true, AFTER_DRAIN = false;
    const float* bp; const float* bs; bf16_t* HB; float* SS;
    __device__ __forceinline__ void operator()(const f32x4 (&acc)[2][2][4][2], const Unit& u, int wr, int wc, int fr, int fq) const {
        const int rowt = u.pm * BM + wr * 64 + fr, col = u.pn * BM + 32 * wc + 8 * fq;
        f32x4 bv[2][2][2];
        auto ldbase = [&](int i, f32x4 (&d)[2][2]) {
            const int row = rowt + (i >> 2) * HALF + (i & 3) * 16;
            if (BF) { const bf16_t* hrow = HB + (size_t)row * D + col;
#pragma unroll
                for (int bj = 0; bj < 2; ++bj) { const u32x4 w = *(const u32x4*)(hrow + bj * HALF); d[bj][0] = bf_lo4(w); d[bj][1] = bf_hi4(w); } }
            else { const float* brow = (row < RP ? bp + (size_t)row * D : bs + (size_t)(row - RP) * D) + col;
#pragma unroll
                for (int bj = 0; bj < 2; ++bj) { d[bj][0] = *(const f32x4*)(brow + bj * HALF); d[bj][1] = *(const f32x4*)(brow + bj * HALF + 4); } } };
        ldbase(0, bv[0]);
#pragma unroll
        for (int i = 0; i < 8; ++i) {
            const int ai = i >> 2, m = i & 3, row = rowt + ai * HALF + m * 16;
            if (i + 1 < 8) ldbase(i + 1, bv[(i + 1) & 1]);
            bf16_t* hrow = HB + (size_t)row * D + col;
            float ss = 0.f;
#pragma unroll
            for (int bj = 0; bj < 2; ++bj) {
                const f32x4 v0 = bv[i & 1][bj][0] + acc[ai][bj][m][0], v1 = bv[i & 1][bj][1] + acc[ai][bj][m][1];
                *(u32x4*)(hrow + bj * HALF) = pack8(v0, v1);
                const f32x4 q0 = v0 * v0, q1 = v1 * v1; ss += ((q0[0] + q0[1]) + (q0[2] + q0[3])) + ((q1[0] + q1[1]) + (q1[2] + q1[3]));
            }
            ss = quad_sum(ss);
            if (fq == 0) SS[(size_t)row * 16 + 4 * u.pn + wc] = ss;
        }
    }
};
__device__ __forceinline__ float row_rs(const float* SS, int row, int fq) {
    const f32x4 s4 = *(const f32x4*)(SS + (size_t)row * 16 + 4 * fq);
    return rsqrtf(quad_sum((s4[0] + s4[1]) + (s4[2] + s4[3])) * (1.0f / D) + EPS);
}
struct EpiAct {
    static constexpr bool PERM = true, AFTER_DRAIN = false;
    const float* SS; bf16_t* ACT;
    __device__ __forceinline__ void operator()(const f32x4 (&acc)[2][2][4][2], const Unit& u, int wr, int wc, int fr, int fq) const {
        const int rowt = u.pm * BM + wr * 64 + fr, col = 128 * u.pn + 32 * wc + 8 * fq;
        float rv[2][4];
#pragma unroll
        for (int ai = 0; ai < 2; ++ai)
#pragma unroll
            for (int m = 0; m < 4; ++m) rv[ai][m] = row_rs(SS, rowt + ai * HALF + m * 16, fq);
#pragma unroll
        for (int ai = 0; ai < 2; ++ai)
#pragma unroll
            for (int m = 0; m < 4; ++m) {
                const int row = rowt + ai * HALF + m * 16; const float r = rv[ai][m];
                f32x4 v[2];
#pragma unroll
                for (int n = 0; n < 2; ++n) { const f32x4 g = acc[ai][0][m][n] * r, up = acc[ai][1][m][n] * r;
#pragma unroll
                    for (int e = 0; e < 4; ++e) v[n][e] = g[e] * sigm(g[e]) * up[e]; }
                *(u32x4*)(ACT + (size_t)row * DFF + col) = pack8(v[0], v[1]);
            }
    }
};
struct EpiFinal {
    static constexpr bool PERM = true, AFTER_DRAIN = false;
    const float* SS; const bf16_t* PP; const bf16_t* HB; float* Y;
    __device__ __forceinline__ void operator()(const f32x4 (&acc)[2][2][4][2], const Unit& u, int wr, int wc, int fr, int fq) const {
        const int rowt = u.pm * BM + wr * 64 + fr, col = u.pn * BM + 32 * wc + 8 * fq;
        float rv[2][4];
#pragma unroll
        for (int ai = 0; ai < 2; ++ai)
#pragma unroll
            for (int m = 0; m < 4; ++m) rv[ai][m] = row_rs(SS, rowt + ai * HALF + m * 16, fq);
        u32x4 pwv[2][2], hwv[2][2];
        auto ld = [&](int i, u32x4 (&p)[2], u32x4 (&h)[2]) { const size_t o = (size_t)(rowt + (i >> 2) * HALF + (i & 3) * 16) * D + col;
#pragma unroll
            for (int bj = 0; bj < 2; ++bj) { p[bj] = *(const u32x4*)(PP + o + bj * HALF); h[bj] = *(const u32x4*)(HB + o + bj * HALF); } };
        ld(0, pwv[0], hwv[0]);
#pragma unroll
        for (int i = 0; i < 8; ++i) {
            const int ai = i >> 2, m = i & 3, row = rowt + ai * HALF + m * 16; const float r = rv[ai][m];
            if (i + 1 < 8) ld(i + 1, pwv[(i + 1) & 1], hwv[(i + 1) & 1]);
#pragma unroll
            for (int bj = 0; bj < 2; ++bj) {
                const size_t o = (size_t)row * D + col + bj * HALF;
                const u32x4 pw = pwv[i & 1][bj], hw = hwv[i & 1][bj];
                const f32x4 a0 = acc[ai][bj][m][0] * r, a1 = acc[ai][bj][m][1] * r, p0 = bf_lo4(pw), p1 = bf_hi4(pw);
                f32x4 h0 = bf_lo4(hw), h1 = bf_hi4(hw);
#pragma unroll
                for (int e2 = 0; e2 < 4; ++e2) { h0[e2] += sigm(a0[e2]) * p0[e2]; h1[e2] += sigm(a1[e2]) * p1[e2]; }
                *(f32x4*)(Y + o) = h0; *(f32x4*)(Y + o + 4) = h1;
            }
        }
    }
};

template <class Epi, class Sched, bool ALIGN_EPI = false, bool SP2 = false>
__device__ __forceinline__ void gemm_phase(PG8_LAS unsigned char* lds, const Gemm g, const Sched& S, const Epi& E) {
    int tid_ = threadIdx.x; asm volatile("" : "+v"(tid_));
    const int tid = tid_, wid = __builtin_amdgcn_readfirstlane(tid >> 6), lane = tid & 63, wr = wid >> 2, wc = wid & 3, fr = lane & 15, fq = lane >> 4;
    int K_ = g.K; asm volatile("" : "+s"(K_));
    const int K = K_, nt = K / BK;
    unsigned voffA[2], voffB[2];
#pragma unroll
    for (int i = 0; i < 2; ++i) { int R, C; stage_rc(tid * 16 + i * 8192, R, C); const int Rb = Epi::PERM ? ((R & ~31) + perm32(R & 31)) : R;
        voffA[i] = (unsigned)(R * K + C) * 2u; voffB[i] = (unsigned)(Rb * K + C) * 2u; }
    const size_t kstep = (size_t)(BK * 2);
    const size_t hstep = (size_t)HALF * K * 2;
    const size_t tstep = 2 * hstep;
    const unsigned ldsw = (unsigned)wid * 1024u;
    const int aoff = lds_byte(wr * 64 + fr, fq * 8), boff = lds_byte(wc * 32 + fr, fq * 8);
#define PG8_SA(b, h) (((b) * 2 + (h)) * HTB)
#define PG8_SB(b, h) ((4 + (b) * 2 + (h)) * HTB)
#define PG8_STAGE(bufoff, gbase, voff) do { _Pragma("unroll") for (int _i = 0; _i < 2; ++_i) \
        __builtin_amdgcn_global_load_lds((const unsigned*)((const char*)(gbase) + (voff)[_i]), (PG8_LAS unsigned*)(lds + (bufoff) + ldsw + _i * 8192), 16, 0, 0); } while (0)
#define PG8_LDA(dst, b, h) do { _Pragma("unroll") for (int m = 0; m < 4; ++m) _Pragma("unroll") for (int k = 0; k < 2; ++k) dst[m][k] = *(const PG8_LAS bf16x8*)(lds + PG8_SA(b, h) + aoff + m * 2048 + k * 1024); } while (0)
#define PG8_LDB(dst, b, h) do { _Pragma("unroll") for (int n = 0; n < 2; ++n) _Pragma("unroll") for (int k = 0; k < 2; ++k) dst[n][k] = *(const PG8_LAS bf16x8*)(lds + PG8_SB(b, h) + boff + n * 2048 + k * 1024); } while (0)
#define PG8_MMA(ai, bj, At, Bt) do { __builtin_amdgcn_s_setprio(1); _Pragma("unroll") for (int m = 0; m < 4; ++m) _Pragma("unroll") for (int n = 0; n < 2; ++n) _Pragma("unroll") for (int k = 0; k < 2; ++k) \
        acc[ai][bj][m][n] = __builtin_amdgcn_mfma_f32_16x16x32_bf16(Bt[n][k], At[m][k], acc[ai][bj][m][n], 0, 0, 0); __builtin_amdgcn_s_setprio(0); } while (0)
#define PG8_WAIT_V(n) asm volatile("s_waitcnt vmcnt(" #n ")" ::: "memory")
#define PG8_WAIT_L(n) asm volatile("s_waitcnt lgkmcnt(" #n ")" ::: "memory")
#define PG8_BAR __builtin_amdgcn_s_barrier()
#define PG8_SCHED __builtin_amdgcn_sched_barrier(0)
    Unit cur, nxt; int ui = 0;
    if (!S.next(0, cur)) return;
    f32x4 acc[2][2][4][2];
#pragma unroll
    for (int a = 0; a < 2; ++a)
#pragma unroll
        for (int b = 0; b < 2; ++b)
#pragma unroll
            for (int m = 0; m < 4; ++m)
#pragma unroll
                for (int n = 0; n < 2; ++n) acc[a][b][m][n] = (f32x4){0.f, 0.f, 0.f, 0.f};
    bf16x8 At[4][2], B0[2][2], B1[2][2];
    const char* cA = (const char*)g.A + (size_t)cur.pm * tstep; const char* cB = (const char*)g.Bt + (size_t)cur.pn * tstep;
    S.a_ready(cur);
    if constexpr (SP2) {
        PG8_STAGE(PG8_SB(0, 0), cB, voffB); PG8_STAGE(PG8_SB(0, 1), cB + hstep, voffB); PG8_STAGE(PG8_SA(0, 0), cA, voffA); PG8_STAGE(PG8_SA(0, 1), cA + hstep, voffA);
        if (wr == 1) PG8_BAR;
        PG8_WAIT_V(2); PG8_BAR;
        PG8_STAGE(PG8_SB(1, 0), cB + kstep, voffB); PG8_STAGE(PG8_SA(1, 0), cA + kstep, voffA); PG8_STAGE(PG8_SB(1, 1), cB + hstep + kstep, voffB);
        PG8_WAIT_V(6); PG8_BAR;
    } else {
        PG8_STAGE(PG8_SB(0, 0), cB, voffB); PG8_STAGE(PG8_SA(0, 0), cA, voffA); PG8_STAGE(PG8_SB(0, 1), cB + hstep, voffB); PG8_STAGE(PG8_SA(0, 1), cA + hstep, voffA);
        if (wr == 1) PG8_BAR;
        PG8_WAIT_V(4); PG8_BAR;
        PG8_STAGE(PG8_SB(1, 0), cB + kstep, voffB); PG8_STAGE(PG8_SA(1, 0), cA + kstep, voffA); PG8_STAGE(PG8_SB(1, 1), cB + hstep + kstep, voffB);
        PG8_WAIT_V(6); PG8_BAR;
    }
    for (;;) {
        const bool has_next = S.next(ui + 1, nxt);
        const char* nA = has_next ? (const char*)g.A + (size_t)nxt.pm * tstep : cA; const char* nB = has_next ? (const char*)g.Bt + (size_t)nxt.pn * tstep : cB;
        for (int t = 0; t < nt; t += 2) {
            const bool last = (t == nt - 2);
            const char* a1 = cA + (size_t)(t + 1) * kstep;
            const char* a2 = last ? nA : cA + (size_t)(t + 2) * kstep; const char* b2 = last ? nB : cB + (size_t)(t + 2) * kstep;
            const char* a3 = a2 + kstep; const char* b3 = b2 + kstep;
            if (last && has_next) S.a_ready(nxt);
            if constexpr (SP2) {
            PG8_LDB(B0, 0, 0); PG8_LDB(B1, 0, 1); PG8_SCHED; PG8_LDA(At, 0, 0); PG8_STAGE(PG8_SA(1, 1), a1 + hstep, voffA);
            PG8_WAIT_V(8); PG8_WAIT_L(0); PG8_BAR; PG8_MMA(0, 0, At, B0); PG8_MMA(0, 1, At, B1); PG8_BAR; PG8_SCHED;
            PG8_LDA(At, 0, 1); PG8_STAGE(PG8_SB(0, 0), b2, voffB); PG8_STAGE(PG8_SB(0, 1), b2 + hstep, voffB); PG8_STAGE(PG8_SA(0, 0), a2, voffA);
            PG8_WAIT_V(8); PG8_WAIT_L(0); PG8_BAR; PG8_MMA(1, 0, At, B0); PG8_MMA(1, 1, At, B1); PG8_BAR; PG8_SCHED;
            PG8_LDB(B0, 1, 0); PG8_LDB(B1, 1, 1); PG8_SCHED; PG8_LDA(At, 1, 0); PG8_STAGE(PG8_SA(0, 1), a2 + hstep, voffA);
            PG8_WAIT_V(8); PG8_WAIT_L(0); PG8_BAR; PG8_MMA(0, 0, At, B0); PG8_MMA(0, 1, At, B1); PG8_BAR; PG8_SCHED;
            PG8_LDA(At, 1, 1); PG8_STAGE(PG8_SB(1, 0), b3, voffB); PG8_STAGE(PG8_SB(1, 1), b3 + hstep, voffB); PG8_STAGE(PG8_SA(1, 0), a3, voffA);
            PG8_WAIT_V(8); PG8_WAIT_L(0); PG8_BAR; PG8_MMA(1, 0, At, B0); PG8_MMA(1, 1, At, B1); PG8_BAR; PG8_SCHED;
            } else {
            PG8_LDB(B0, 0, 0); PG8_SCHED; PG8_LDA(At, 0, 0); PG8_STAGE(PG8_SA(1, 1), a1 + hstep, voffA);
            PG8_WAIT_L(8); PG8_BAR; PG8_WAIT_L(0); PG8_MMA(0, 0, At, B0); PG8_BAR; PG8_SCHED;
            PG8_LDB(B1, 0, 1); PG8_STAGE(PG8_SB(0, 0), b2, voffB);
            PG8_BAR; PG8_WAIT_L(0); PG8_MMA(0, 1, At, B1); PG8_BAR;
            PG8_LDA(At, 0, 1); PG8_STAGE(PG8_SA(0, 0), a2, voffA);
            PG8_BAR; PG8_WAIT_L(0); PG8_MMA(1, 0, At, B0); PG8_BAR; PG8_SCHED;
            PG8_STAGE(PG8_SB(0, 1), b2 + hstep, voffB);
            PG8_WAIT_V(6); PG8_BAR; PG8_MMA(1, 1, At, B1); PG8_BAR;
            PG8_LDB(B0, 1, 0); PG8_SCHED; PG8_LDA(At, 1, 0); PG8_STAGE(PG8_SA(0, 1), a2 + hstep, voffA);
            PG8_WAIT_L(8); PG8_BAR; PG8_WAIT_L(0); PG8_MMA(0, 0, At, B0); PG8_BAR; PG8_SCHED;
            PG8_LDB(B1, 1, 1); PG8_STAGE(PG8_SB(1, 0), b3, voffB);
            PG8_BAR; PG8_WAIT_L(0); PG8_MMA(0, 1, At, B1); PG8_BAR;
            PG8_LDA(At, 1, 1); PG8_STAGE(PG8_SA(1, 0), a3, voffA);
            PG8_BAR; PG8_WAIT_L(0); PG8_MMA(1, 0, At, B0); PG8_BAR; PG8_SCHED;
            PG8_STAGE(PG8_SB(1, 1), b3 + hstep, voffB);
            PG8_WAIT_V(6); PG8_BAR; PG8_MMA(1, 1, At, B1); PG8_BAR;
            }
        }
        if constexpr (ALIGN_EPI) { if (wr == 0) PG8_BAR; }
        if constexpr (!Epi::AFTER_DRAIN) { E(acc, cur, wr, wc, fr, fq); S.done(cur); }
        if (!has_next) break;
#pragma unroll
        for (int a = 0; a < 2; ++a)
#pragma unroll
            for (int b = 0; b < 2; ++b)
#pragma unroll
                for (int m = 0; m < 4; ++m)
#pragma unroll
                    for (int n = 0; n < 2; ++n) acc[a][b][m][n] = (f32x4){0.f, 0.f, 0.f, 0.f};
        cur = nxt; cA = nA; cB = nB; ++ui;
        if constexpr (ALIGN_EPI) { if (wr == 1) PG8_BAR; }
    }
    PG8_WAIT_V(0);
    if constexpr (!ALIGN_EPI) { if (wr == 0) PG8_BAR; }
    PG8_BAR;
    if constexpr (Epi::AFTER_DRAIN) { E.fused(acc, cur, wr, wc, fr, fq, lds, wid, lane); S.done(cur); }
#undef PG8_SA
#undef PG8_SB
#undef PG8_STAGE
#undef PG8_LDA
#undef PG8_LDB
#undef PG8_MMA
#undef PG8_WAIT_V
#undef PG8_WAIT_L
#undef PG8_BAR
#undef PG8_SCHED
}
}
#define GAS __attribute__((address_space(1)))
#define LAS __attribute__((address_space(3)))
typedef unsigned short bf16;
typedef unsigned v4u __attribute__((ext_vector_type(4)));
typedef float f32x4 __attribute__((ext_vector_type(4)));
typedef short bf16x8 __attribute__((ext_vector_type(8)));
typedef GAS unsigned gu32;
typedef GAS unsigned long long gu64;
#define RLX_AGENT __ATOMIC_RELAXED, __HIP_MEMORY_SCOPE_AGENT
#define LDS_WAIT() asm volatile("s_waitcnt lgkmcnt(0)" ::: "memory")
#define VM_WAIT() asm volatile("s_waitcnt vmcnt(0)" ::: "memory")
__device__ __forceinline__ unsigned long long rt() { return __builtin_amdgcn_s_memrealtime(); }
__device__ __forceinline__ unsigned f2bf(float f) { unsigned u = __builtin_bit_cast(unsigned, f); return (u + 0x7fffu + ((u >> 16) & 1u)) >> 16; }
__device__ __forceinline__ unsigned pk2(float lo, float hi) { return f2bf(lo) | (f2bf(hi) << 16); }
#define XB_TMO      128
#define XB_XCNT(j)  (256  + 64 * (j))
#define XB_XSUB(j)  (1280 + 64 * (j))
#define XB_XGEN(j)  (2304 + 64 * (j))
#define XB_TOP      3328
#define XB_TOPGEN   3392
#define XCD_BAR_WORDS 3456
#define XB_SPIN_CAP (1u << 18)

__device__ __forceinline__ unsigned xb_ld(unsigned* p)              { return __hip_atomic_load(p, __ATOMIC_RELAXED, __HIP_MEMORY_SCOPE_AGENT); }
__device__ __forceinline__ unsigned xb_add(unsigned* p, unsigned v) { return __hip_atomic_fetch_add(p, v, __ATOMIC_RELAXED, __HIP_MEMORY_SCOPE_AGENT); }
__device__ __forceinline__ unsigned xb_xcc_id() { return (unsigned)__builtin_amdgcn_s_getreg((3 << 11) | 20) & 0xFu; }
#define XB_SPIN(cond, bar) do { unsigned _sp = 0; while (cond) { __builtin_amdgcn_s_sleep(1); \
    if ((++_sp & 255u) == 0u) { if (xb_ld(&(bar)[XB_TMO])) break; if (_sp > XB_SPIN_CAP) { atomicAdd(&(bar)[XB_TMO], 1u); break; } } } } while (0)

struct XcdBarrier {
    unsigned* bar; unsigned x;
    volatile LAS unsigned* st;
};

__device__ __forceinline__ XcdBarrier xcd_barrier_post(unsigned* bar, volatile LAS unsigned* st) {
    XcdBarrier b; b.bar = bar; b.x = xb_xcc_id(); b.st = st;
    if (threadIdx.x == 0) (void)xb_add(&bar[XB_XCNT(b.x)], 1u);
    return b;
}
__device__ __forceinline__ void xcd_barrier_complete(unsigned* bar, unsigned x, unsigned& nloc, unsigned& nx) {
    const unsigned G = gridDim.x * gridDim.y * gridDim.z;
    unsigned sum, cnt, mine, sp = 0u;
    for (;;) {
        sum = 0u; cnt = 0u; mine = 0u;
#pragma unroll
        for (unsigned j = 0; j < 16; ++j) { const unsigned c = xb_ld(&bar[XB_XCNT(j)]); sum += c; cnt += (c > 0u) ? 1u : 0u; mine = (j == x) ? c : mine; }
        if (sum == G) break;
        __builtin_amdgcn_s_sleep(1);
        if ((++sp & 255u) == 0u) { if (xb_ld(&bar[XB_TMO])) break; if (sp > XB_SPIN_CAP) { atomicAdd(&bar[XB_TMO], 1u); break; } }
    }
    nloc = mine > 0u ? mine : 1u; nx = cnt > 0u ? cnt : 1u;
}

__device__ __forceinline__ void xcd_barrier(const XcdBarrier& b) {
    asm volatile("s_waitcnt vmcnt(0)" ::: "memory");
    __syncthreads();
    if (threadIdx.x == 0) {
        unsigned* bar = b.bar;
        __builtin_amdgcn_s_waitcnt(0);
        unsigned nloc = b.st[0], nx = b.st[1];
        if (nloc == 0u) { xcd_barrier_complete(bar, b.x, nloc, nx); b.st[0] = nloc; b.st[1] = nx; }
        const unsigned old = xb_add(&bar[XB_XSUB(b.x)], 1u);
        const unsigned gen = old / nloc;
        if (old + 1u == (gen + 1u) * nloc) {
            __builtin_amdgcn_fence(__ATOMIC_RELEASE, "agent");
            asm volatile("s_waitcnt vmcnt(0)" ::: "memory");
            const unsigned og = xb_add(&bar[XB_TOP], 1u);
            const unsigned tg = og / nx;
            if (og + 1u == (tg + 1u) * nx) xb_add(&bar[XB_TOPGEN], 1u);
            else XB_SPIN(xb_ld(&bar[XB_TOPGEN]) == tg, bar);
            __builtin_amdgcn_fence(__ATOMIC_ACQUIRE, "agent");
            xb_add(&bar[XB_XGEN(b.x)], 1u);
            asm volatile("s_waitcnt vmcnt(0)" ::: "memory");
        } else {
            __builtin_amdgcn_fence(__ATOMIC_ACQUIRE, "agent");
            XB_SPIN(xb_ld(&bar[XB_XGEN(b.x)]) == gen, bar);
            asm volatile("s_waitcnt vmcnt(0)" ::: "memory");
        }
    }
    __syncthreads();
}
constexpr int NWAVES = 8;
constexpr size_t MiB = 1u << 20;
constexpr size_t WS_CTL = 0, CTL_ZERO_BYTES = 65536;
constexpr size_t WS_W1 = 1 * MiB, WS_WO = 6 * MiB, WS_WGU = 8 * MiB, WS_WD = 19 * MiB, WS_WPG = 25 * MiB, WS_WPP = 27 * MiB;
constexpr size_t WS_RX = 28 * MiB, WS_SS1 = 29 * MiB, WS_SS2 = 32 * MiB;
constexpr size_t WS_XB = 36 * MiB;
constexpr size_t WS_PB = 102 * MiB, WS_PP = 119 * MiB;
constexpr size_t WS_Q = 185 * MiB, WS_KP = 218 * MiB, WS_VP = 250 * MiB, WS_KS = 282 * MiB, WS_VS = 300 * MiB, WS_GLU = 318 * MiB, WS_MIX = 351 * MiB;
constexpr size_t WS_ACT = 185 * MiB;
constexpr size_t WS_END = 417 * MiB;
static_assert(WS_XB + (size_t)R * D * 2 <= WS_PB && WS_PB + (size_t)R * PLE * 2 <= WS_PP && WS_PP + (size_t)R * D * 2 <= WS_Q && WS_Q + (size_t)R * 512 * 2 <= WS_KP &&
              WS_KP + (size_t)(RP / 64) * KVT_BYTES <= WS_KS && WS_KS + (size_t)DB * 9 * KVT_BYTES <= WS_GLU && WS_GLU + (size_t)R * 512 * 2 <= WS_MIX &&
              WS_MIX + (size_t)R * D * 2 <= WS_END && WS_ACT + (size_t)R * DFF * 2 <= WS_END && WS_SS1 + (size_t)R * 64 <= WS_SS2 && WS_SS2 + (size_t)R * 64 <= WS_XB && WS_RX + (size_t)R * 4 <= WS_SS1, "d_ws map");
constexpr int CW_BAR = 4096, CW_Q = 8192, CW_QG = CW_Q + 64 * 32;
constexpr int RING_OFF = 0, RING_BYTES = 131072;
constexpr int LDSCTL_OFF = RING_BYTES, MISC_OFF = LDSCTL_OFF + 320;
constexpr int ATT_TAB = 132096, ATT_LSC = ATT_TAB + 8192;
constexpr int LDS_BYTES = 147456;
static_assert(ATT_LSC + 2048 <= LDS_BYTES && MISC_OFF + 128 <= ATT_TAB, "LDS map");

__device__ __forceinline__ float wave_sum(float v) {
#pragma unroll
    for (int o = 1; o < 64; o <<= 1) v += __shfl_xor(v, o);
    return v;
}
__device__ __forceinline__ float wave_max(float v) {
#pragma unroll
    for (int o = 1; o < 64; o <<= 1) v = fmaxf(v, __shfl_xor(v, o));
    return v;
}
__device__ __forceinline__ int map_win(int n) {
    if (n < 1536) { const int sec = n >> 9, nn = n & 511, h = nn >> 6, d = nn & 63; return sec * 512 + 256 * (h >> 2) + 128 * (d >> 5) + 32 * (h & 3) + (d & 31); }
    if (n < 2048) { const int i = n - 1536; return 1536 + 256 * (i >> 7) + (i & 127); }
    const int i = n - 2048; return 1536 + 256 * (i >> 7) + 128 + (i & 127);
}
__device__ __forceinline__ int map_gu(int n) {
    if (n < DFF) return 256 * (n >> 7) + (n & 127);
    const int i = n - DFF; return 256 * (i >> 7) + 128 + (i & 127);
}
template <int MAP> __device__ __forceinline__ void p0_transpose_item(const float* W, const float* gain, int K, int N, bf16* WT, LAS float* scr, int item, int lane) {
    const int nblk = N / 32, kb = item / nblk, nb = item % nblk, k0 = 64 * kb, n0 = 32 * nb;
    { const int nq = lane & 7, kr = lane >> 3; f32x4 v[8];
#pragma unroll
      for (int i = 0; i < 8; ++i) v[i] = *(const GAS f32x4*)(W + (size_t)(k0 + 8 * i + kr) * N + n0 + 4 * nq);
#pragma unroll
      for (int i = 0; i < 8; ++i) { const int kk = 8 * i + kr; const float gk = gain ? gain[k0 + kk] : 1.0f;
#pragma unroll
          for (int e = 0; e < 4; ++e) scr[kk * 33 + 4 * nq + e] = v[i][e] * gk; } }
    LDS_WAIT(); asm volatile("" ::: "memory");
    const int c = lane & 7;
#pragma unroll
    for (int j = 0; j < 4; ++j) { const int n = (lane >> 3) + 8 * j; const LAS float* s = scr + (8 * c) * 33 + n;
        v4u o; o.x = pk2(s[0 * 33], s[1 * 33]); o.y = pk2(s[2 * 33], s[3 * 33]); o.z = pk2(s[4 * 33], s[5 * 33]); o.w = pk2(s[6 * 33], s[7 * 33]);
        const int ns = n0 + n, dr = MAP == 0 ? ns : (MAP == 1 ? map_win(ns) : map_gu(ns));
        *(GAS v4u*)(WT + (size_t)dr * K + k0 + 8 * c) = o; }
    LDS_WAIT(); asm volatile("" ::: "memory");
}

namespace att {
typedef short bf16x8 __attribute__((ext_vector_type(8)));
typedef short s16x4 __attribute__((ext_vector_type(4)));
typedef float f32x16 __attribute__((ext_vector_type(16)));
typedef unsigned u32x4 __attribute__((ext_vector_type(4)));
typedef float f32x2_t __attribute__((ext_vector_type(2))); typedef __bf16 bf16x2_t __attribute__((ext_vector_type(2)));
typedef short v4i16_t __attribute__((ext_vector_type(4)));
typedef LAS const char* lds_cptr;
constexpr int BUFB = 65536, HSLOT = 16384;
__device__ __forceinline__ int crow(int r, int hi) { return (r & 3) + 8 * (r >> 2) + 4 * hi; }
__device__ __forceinline__ void glds16(const void* gsrc, unsigned lds_dst) { unsigned keep;
    asm volatile("s_mov_b32 %0, m0\n\ts_mov_b32 m0, %2\n\ts_nop 0\n\tglobal_load_lds_dwordx4 %1, off\n\ts_mov_b32 m0, %0" : "=&s"(keep) : "v"(gsrc), "s"(lds_dst) : "memory"); }
__device__ __forceinline__ unsigned cvtpk_s(float lo, float hi) { f32x2_t v = {lo, hi}; bf16x2_t b = __builtin_convertvector(v, bf16x2_t); return __builtin_bit_cast(unsigned, b); }
__device__ __forceinline__ s16x4 vtr(lds_cptr p) { return __builtin_bit_cast(s16x4, __builtin_amdgcn_ds_read_tr16_b64_v4i16((LAS v4i16_t*)p)); }
#define ATT_WAIT_BAR() asm volatile("s_waitcnt vmcnt(0) lgkmcnt(0)\n\ts_barrier" ::: "memory")

struct AUnit { const bf16* Qrow; const unsigned char* KV; bf16* Orow; int nt, hg, sample, c0rel; };

__device__ __forceinline__ void attn_prefetch(const AUnit& U, LAS unsigned char* lds, int wid, int lane, bf16x8 (&qr)[2][4]) {
    const int r32 = lane & 31, hi = lane >> 5, hl = wid & 3, ci = wid >> 2, head = 4 * U.hg + hl;
    const bool wact = !U.sample || ci == 0;
    const unsigned char* kvsrc = U.KV + U.hg * 65536 + wid * 1024 + lane * 16;
    const unsigned kvdst = (unsigned)(size_t)lds + wid * 1024;
#pragma unroll
    for (int j_ = 0; j_ < 8; ++j_) glds16(kvsrc + j_ * 8192, (unsigned)__builtin_amdgcn_readfirstlane(kvdst + j_ * 8192));
    const bf16* Qw = U.Qrow + (size_t)((wact ? 64 * ci : 0) + r32) * 512 + head * 64 + hi * 8; const bf16* Qw1 = Qw + (U.sample ? 0 : 32 * 512);
#pragma unroll
    for (int d0 = 0; d0 < 4; ++d0) { qr[0][d0] = *(const bf16x8*)(Qw + d0 * 16); qr[1][d0] = *(const bf16x8*)(Qw1 + d0 * 16); }
}
template <bool TWO> __device__ __forceinline__ void attn_steps(const AUnit& U, LAS unsigned char* lds, int wid, int lane, const bf16x8 (&qr)[2][4], f32x16 (&o)[2][2], float (&lsum)[2]) {
    const int r32 = lane & 31, hi = lane >> 5, hl = wid & 3, ci = wid >> 2, head = 4 * U.hg + hl, nt = U.nt, own = U.c0rel + ci;
    const bool wact = TWO || ci == 0;
    const unsigned lds0 = (unsigned)(size_t)lds;
    const LAS float* tabh = (const LAS float*)(lds + ATT_TAB) + head * 256;
    const unsigned char* kvsrc = U.KV + U.hg * 65536 + wid * 1024 + lane * 16;
    const unsigned kvdst = lds0 + wid * 1024;
#define ATT_DMA(ti, b) do { _Pragma("unroll") for (int j_ = 0; j_ < 8; ++j_) \
        glds16(kvsrc + (size_t)(ti) * KVT_BYTES + j_ * 8192, (unsigned)__builtin_amdgcn_readfirstlane(kvdst + (b) * BUFB + j_ * 8192)); } while (0)
    for (int ti = 0; ti < nt; ++ti) {
        ATT_WAIT_BAR();
        const int b = ti & 1;
        if (ti + 1 < nt) ATT_DMA(ti + 1, b ^ 1);
        const int jt = own - ti;
        if (wact && jt >= 0 && jt <= 8) {
            const float m1 = (!TWO && jt == 0) ? 0.f : 1.f;
            const lds_cptr kp = (lds_cptr)(lds + b * BUFB + hl * HSLOT + hi * 1024 + r32 * 16);
            bf16x8 kf[8];
            { const unsigned ka = (unsigned)(size_t)kp;
              asm volatile("ds_read_b128 %0, %8\n\tds_read_b128 %1, %8 offset:512\n\tds_read_b128 %2, %8 offset:2048\n\tds_read_b128 %3, %8 offset:2560\n\t"
                           "ds_read_b128 %4, %8 offset:4096\n\tds_read_b128 %5, %8 offset:4608\n\tds_read_b128 %6, %8 offset:6144\n\tds_read_b128 %7, %8 offset:6656\n\ts_waitcnt lgkmcnt(0)"
                           : "=&v"(kf[0]), "=&v"(kf[1]), "=&v"(kf[2]), "=&v"(kf[3]), "=&v"(kf[4]), "=&v"(kf[5]), "=&v"(kf[6]), "=&v"(kf[7]) : "v"(ka) : "memory");
              __builtin_amdgcn_sched_barrier(0); }
            f32x16 s[2][2]; s[0][0] = f32x16{}; s[0][1] = f32x16{}; s[1][0] = f32x16{}; s[1][1] = f32x16{};
#pragma unroll
            for (int h2 = 0; h2 < (TWO ? 2 : 1); ++h2)
#pragma unroll
                for (int d0 = 0; d0 < 4; ++d0) { s[h2][0] = __builtin_amdgcn_mfma_f32_32x32x16_bf16(kf[2 * d0], qr[h2][d0], s[h2][0], 0, 0, 0);
                                                 s[h2][1] = __builtin_amdgcn_mfma_f32_32x32x16_bf16(kf[2 * d0 + 1], qr[h2][d0], s[h2][1], 0, 0, 0); }
            u32x4 pw[2][4];
#pragma unroll
            for (int h2 = 0; h2 < (TWO ? 2 : 1); ++h2) {
                f32x16& p0 = s[h2][0]; f32x16& p1 = s[h2][1];
                if (jt < 3) { const LAS float* tp = tabh + (191 - (32 * h2 + r32) - 64 * jt + 4 * hi);
#pragma unroll
                    for (int r = 0; r < 16; ++r) { p0[r] += tp[(r & 3) + 8 * (r >> 2)]; p1[r] += tp[32 + (r & 3) + 8 * (r >> 2)]; } }
                float sacc = 0.f;
#pragma unroll
                for (int r = 0; r < 16; ++r) { p0[r] = __builtin_amdgcn_exp2f(p0[r]); p1[r] = __builtin_amdgcn_exp2f(p1[r]); if (!TWO) p1[r] *= m1; sacc += p0[r] + p1[r]; }
                lsum[h2] += sacc;
#pragma unroll
                for (int k = 0; k < 2; ++k) { pw[h2][k] = (u32x4){cvtpk_s(p0[8 * k], p0[8 * k + 1]), cvtpk_s(p0[8 * k + 2], p0[8 * k + 3]), cvtpk_s(p0[8 * k + 4], p0[8 * k + 5]), cvtpk_s(p0[8 * k + 6], p0[8 * k + 7])};
                    pw[h2][2 + k] = (u32x4){cvtpk_s(p1[8 * k], p1[8 * k + 1]), cvtpk_s(p1[8 * k + 2], p1[8 * k + 3]), cvtpk_s(p1[8 * k + 4], p1[8 * k + 5]), cvtpk_s(p1[8 * k + 6], p1[8 * k + 7])}; }
            }
            const lds_cptr vp = (lds_cptr)(lds + b * BUFB + hl * HSLOT + 8192 + ((lane >> 4) & 1) * 32 + (lane & 3) * 8 + (4 * hi + ((lane & 15) >> 2)) * 64);
            const unsigned va = (unsigned)(size_t)vp;
#pragma unroll
            for (int d0 = 0; d0 < 2; ++d0) {
                s16x4 lo[4], hh[4];
                asm volatile("ds_read_b64_tr_b16 %0, %8 offset:%c9\n\tds_read_b64_tr_b16 %1, %8 offset:%c10\n\tds_read_b64_tr_b16 %2, %8 offset:%c11\n\tds_read_b64_tr_b16 %3, %8 offset:%c12\n\t"
                             "ds_read_b64_tr_b16 %4, %8 offset:%c13\n\tds_read_b64_tr_b16 %5, %8 offset:%c14\n\tds_read_b64_tr_b16 %6, %8 offset:%c15\n\tds_read_b64_tr_b16 %7, %8 offset:%c16\n\ts_waitcnt lgkmcnt(0)"
                             : "=&v"(lo[0]), "=&v"(hh[0]), "=&v"(lo[1]), "=&v"(hh[1]), "=&v"(lo[2]), "=&v"(hh[2]), "=&v"(lo[3]), "=&v"(hh[3])
                             : "v"(va), "i"(d0 * 4096), "i"(d0 * 4096 + 512), "i"(d0 * 4096 + 1024), "i"(d0 * 4096 + 1536), "i"(d0 * 4096 + 2048), "i"(d0 * 4096 + 2560), "i"(d0 * 4096 + 3072), "i"(d0 * 4096 + 3584) : "memory");
                __builtin_amdgcn_sched_barrier(0);
#pragma unroll
                for (int ks = 0; ks < 4; ++ks) {
                    const bf16x8 vf = (bf16x8){lo[ks][0], lo[ks][1], lo[ks][2], lo[ks][3], hh[ks][0], hh[ks][1], hh[ks][2], hh[ks][3]};
                    o[0][d0] = __builtin_amdgcn_mfma_f32_32x32x16_bf16(__builtin_bit_cast(bf16x8, pw[0][ks]), vf, o[0][d0], 0, 0, 0);
                    if (TWO) o[1][d0] = __builtin_amdgcn_mfma_f32_32x32x16_bf16(__builtin_bit_cast(bf16x8, pw[1][ks]), vf, o[1][d0], 0, 0, 0); }
            }
        }
    }
#undef ATT_DMA
}
template <bool TWO> __device__ __forceinline__ void attn_store(const AUnit& U, LAS unsigned char* lds, int wid, int lane, const f32x16 (&o)[2][2], const float (&lsum)[2]) {
    const int r32 = lane & 31, hi = lane >> 5, hl = wid & 3, ci = wid >> 2, head = 4 * U.hg + hl;
    const bool wact = TWO || ci == 0;
    LAS float* lsc = (LAS float*)(lds + ATT_LSC) + wid * 64;
    if (wact) {
#pragma unroll
        for (int h2 = 0; h2 < (TWO ? 2 : 1); ++h2) {
            float ls = lsum[h2];
            { auto rr = __builtin_amdgcn_permlane32_swap(__float_as_uint(ls), __float_as_uint(ls), false, false); ls = __uint_as_float(rr[0]) + __uint_as_float(rr[1]); }
            if (hi == 0) lsc[32 * h2 + r32] = ls;
            asm volatile("s_waitcnt lgkmcnt(0)" ::: "memory");
            LAS bf16* stg = (LAS bf16*)(lds + BUFB + wid * 8192 + h2 * 4096);
#pragma unroll
            for (int r = 0; r < 16; ++r) { const int orow = crow(r, hi); const float rl = __builtin_amdgcn_rcpf(lsc[32 * h2 + orow]);
#pragma unroll
                for (int d0 = 0; d0 < 2; ++d0) stg[orow * 64 + d0 * 32 + r32] = (bf16)f2bf(o[h2][d0][r] * rl); }
            asm volatile("s_waitcnt lgkmcnt(0)" ::: "memory");
            bf16* Ow = U.Orow + (size_t)(64 * ci + 32 * h2) * D + head * 64;
#pragma unroll
            for (int i = 0; i < 4; ++i) { const int row = i * 8 + (lane >> 3), ch = lane & 7; const u32x4 v = *(const LAS u32x4*)(stg + row * 64 + ch * 8); *(u32x4*)(Ow + (size_t)row * D + ch * 8) = v; }
        }
    }
}
}

__device__ __forceinline__ float wave_sum_dpp(float v) {
#define DPP_ADD(ctrl, rmask) v += __builtin_bit_cast(float, __builtin_amdgcn_update_dpp(0, __builtin_bit_cast(int, v), ctrl, rmask, 0xf, true))
    DPP_ADD(0x111, 0xf); DPP_ADD(0x112, 0xf); DPP_ADD(0x114, 0xf); DPP_ADD(0x118, 0xf); DPP_ADD(0x142, 0xa); DPP_ADD(0x143, 0xc);
#undef DPP_ADD
    return __builtin_bit_cast(float, __builtin_amdgcn_readlane(__builtin_bit_cast(int, v), 63));
}
#define CV_WAIT_BAR(N) asm volatile("s_waitcnt vmcnt(" #N ") lgkmcnt(0)\n\ts_barrier" ::: "memory")
typedef float f32x2v __attribute__((ext_vector_type(2)));
struct ConvConst { f32x2v w[CONVW]; f32x2v bias; };
__device__ __forceinline__ void conv_consts(ConvConst& C, const float* cw, const float* cb, int tid) {
    const int cp = tid & 255;
#pragma unroll
    for (int j = 0; j < CONVW; ++j) C.w[j] = *(const f32x2v*)(cw + j * CW + 2 * cp);
    C.bias = *(const f32x2v*)(cb + 2 * cp);
}
__device__ __forceinline__ void conv_entry(int e, const ConvConst& C, const bf16* GLU, const float* st, const float* lg, const float* lb, bf16* MIX, LAS unsigned char* lds, int tid) {
    const bool samp = e >= RP / 64; const int b = samp ? e - RP / 64 : e >> 7, t0 = samp ? 0 : (e & 127) * 64, nb = samp ? 2 : 4, rowbase = samp ? RP + DS * b : b * SEQ;
    const int wid = __builtin_amdgcn_readfirstlane(tid >> 6), lane = tid & 63, cp = tid & 255, th = tid >> 8;
    const bool first = t0 == 0;
    LAS bf16* xs = (LAS bf16*)lds;
    LAS float* ybuf = (LAS float*)(lds + 98304);
    const unsigned lds0 = (unsigned)(size_t)lds;
    const int tlast = t0 + 16 * nb - 1;
    f32x4 g0 = *(const f32x4*)(lg + 8 * lane), g1 = *(const f32x4*)(lg + 8 * lane + 4), b0 = *(const f32x4*)(lb + 8 * lane), b1 = *(const f32x4*)(lb + 8 * lane + 4);
    asm volatile("" : "+v"(g0), "+v"(g1), "+v"(b0), "+v"(b1));
#pragma unroll
    for (int i = 0; i < 12; ++i) { const int k = wid + 8 * i; int tp = t0 - CH + k; tp = tp > tlast ? tlast : tp;
        if (tp >= 0) att::glds16(GLU + (size_t)(rowbase + tp) * 512 + 8 * lane, (unsigned)__builtin_amdgcn_readfirstlane(lds0 + (unsigned)k * 1024u));
        else { pg8::u32x4 v = (pg8::u32x4){0u, 0u, 0u, 0u};
            if (samp) { const float* sp = st + ((size_t)b * CH + (CH + tp)) * CW + 8 * lane; v = pg8::pack8(*(const f32x4*)sp, *(const f32x4*)(sp + 4)); }
            *(LAS pg8::u32x4*)(xs + k * 512 + 8 * lane) = v; } }
    for (int s = 0; s < nb; ++s) {
        if (first || s == 3) CV_WAIT_BAR(0); else if (s == 0) CV_WAIT_BAR(6); else if (s == 1) CV_WAIT_BAR(4); else CV_WAIT_BAR(2);
        {
            f32x2v x[38];
            const LAS unsigned* xp = (const LAS unsigned*)(xs + (16 * s + 8 * th) * 512 + 2 * cp);
#pragma unroll
            for (int k = 0; k < 38; ++k) { const unsigned u = xp[k * 256]; x[k] = (f32x2v){__uint_as_float(u << 16), __uint_as_float(u & 0xffff0000u)}; }
            f32x2v y[8];
#pragma unroll
            for (int i = 0; i < 8; ++i) y[i] = C.bias;
#pragma unroll
            for (int j = 0; j < CONVW; ++j)
#pragma unroll
                for (int i = 0; i < 8; ++i) y[i] = __builtin_elementwise_fma(C.w[j], x[i + j], y[i]);
#pragma unroll
            for (int i = 0; i < 8; ++i) *(LAS f32x2v*)(ybuf + (8 * th + i) * 512 + 2 * cp) = y[i];
        }
        __syncthreads();
#pragma unroll
        for (int q = 0; q < 2; ++q) { const int i = 2 * wid + q;
            f32x4 v0 = *(const LAS f32x4*)(ybuf + i * 512 + 8 * lane), v1 = *(const LAS f32x4*)(ybuf + i * 512 + 8 * lane + 4);
            const float mean = wave_sum_dpp((v0[0] + v0[1]) + (v0[2] + v0[3]) + (v1[0] + v1[1]) + (v1[2] + v1[3])) * (1.0f / CW);
            v0 = v0 - mean; v1 = v1 - mean;
            const f32x4 q0 = v0 * v0, q1 = v1 * v1;
            const float rstd = rsqrtf(wave_sum_dpp((q0[0] + q0[1]) + (q0[2] + q0[3]) + (q1[0] + q1[1]) + (q1[2] + q1[3])) * (1.0f / CW) + EPS);
            v0 = v0 * rstd * g0 + b0; v1 = v1 * rstd * g1 + b1;
#pragma unroll
            for (int e2 = 0; e2 < 4; ++e2) { v0[e2] *= pg8::sigm(v0[e2]); v1[e2] *= pg8::sigm(v1[e2]); }
            *(pg8::u32x4*)(MIX + (size_t)(rowbase + t0 + 16 * s + i) * D + 512 + 8 * lane) = pg8::pack8(v0, v1); }
        __syncthreads();
    }
}

constexpr int SG_LD = 68;
#define SG_WAIT_BAR(N) asm volatile("s_waitcnt vmcnt(" #N ") lgkmcnt(0)\n\ts_barrier" ::: "memory")
template <class Epi> __device__ __forceinline__ void sgemm64(const bf16* A, const bf16* Bt, int K_, int tile, const Epi& E, LAS unsigned char* lds) {
    int tid_ = threadIdx.x; asm volatile("" : "+v"(tid_)); int K = K_; asm volatile("" : "+s"(K));
    const int lane = tid_ & 63, wave = __builtin_amdgcn_readfirstlane(tid_ >> 6), fr = lane & 15, fq = lane >> 4, wm = wave & 3, wn = wave >> 2, tr = tile >> 4, tc = tile & 15;
    const int KS = K >> 7;
    const unsigned char* src[4]; unsigned dsto[4];
#pragma unroll
    for (int i = 0; i < 4; ++i) { const int p = wave + 8 * i, r = 4 * (p & 15) + (lane >> 4), cs = (lane & 15) ^ (r & 15);
        src[i] = (const unsigned char*)((p < 16 ? A + (size_t)(64 * tr + r) * K : Bt + (size_t)(64 * tc + r) * K)) + cs * 16;
        dsto[i] = (p < 16 ? 0u : 16384u) + (unsigned)(p & 15) * 1024u; }
    const unsigned lds0 = (unsigned)(size_t)lds;
#define SG_STAGE(t) do { _Pragma("unroll") for (int i_ = 0; i_ < 4; ++i_) att::glds16(src[i_] + (size_t)(t) * 256, (unsigned)__builtin_amdgcn_readfirstlane(lds0 + (unsigned)((t) & 3) * 32768u + dsto[i_])); } while (0)
    f32x4 acc0 = (f32x4){0.f, 0.f, 0.f, 0.f}, acc1 = acc0;
    SG_STAGE(0); if (KS > 1) SG_STAGE(1); if (KS > 2) SG_STAGE(2);
    const unsigned ra = (unsigned)(16 * wm + fr) * 256u, rb = 16384u + (unsigned)(32 * wn + fr) * 256u;
    for (int t = 0; t < KS; ++t) {
        if (t + 2 < KS) SG_WAIT_BAR(8); else if (t + 1 < KS) SG_WAIT_BAR(4); else SG_WAIT_BAR(0);
        if (t + 3 < KS) SG_STAGE(t + 3);
        const LAS unsigned char* sb = lds + (t & 3) * 32768;
#pragma unroll
        for (int ks = 0; ks < 4; ++ks) { const unsigned ch = (unsigned)((4 * ks + fq) ^ fr) * 16u;
            const bf16x8 a = *(const LAS bf16x8*)(sb + ra + ch), b0 = *(const LAS bf16x8*)(sb + rb + ch), b1 = *(const LAS bf16x8*)(sb + rb + 4096 + ch);
            acc0 = __builtin_amdgcn_mfma_f32_16x16x32_bf16(b0, a, acc0, 0, 0, 0); acc1 = __builtin_amdgcn_mfma_f32_16x16x32_bf16(b1, a, acc1, 0, 0, 0); }
    }
#undef SG_STAGE
    SG_WAIT_BAR(0);
    LAS float* part = (LAS float*)lds;
    *(LAS f32x4*)(part + (16 * wm + fr) * SG_LD + 32 * wn + 4 * fq) = acc0; *(LAS f32x4*)(part + (16 * wm + fr) * SG_LD + 32 * wn + 16 + 4 * fq) = acc1;
    __syncthreads();
    const int row = tid_ >> 3, c8 = (tid_ & 7) * 8;
    const f32x4 v0 = *(const LAS f32x4*)(part + row * SG_LD + c8), v1 = *(const LAS f32x4*)(part + row * SG_LD + c8 + 4);
    E(64 * tr + row, 64 * tc + c8, tc, tid_ & 7, v0, v1);
    __syncthreads();
}
__device__ __forceinline__ float oct_sum(float s) { s += __shfl_xor(s, 1); s += __shfl_xor(s, 2); s += __shfl_xor(s, 4); return s; }
template <bool BF> struct SEpiRes {
    const float* base; bf16* HB; float* SS;
    __device__ __forceinline__ void operator()(int row, int col, int tc, int l8, f32x4 v0, f32x4 v1) const {
        const size_t o = (size_t)row * D + col;
        if (BF) { const pg8::u32x4 w = *(const pg8::u32x4*)(HB + o); v0 = v0 + pg8::bf_lo4(w); v1 = v1 + pg8::bf_hi4(w); }
        else { v0 = v0 + *(const f32x4*)(base + o); v1 = v1 + *(const f32x4*)(base + o + 4); }
        *(pg8::u32x4*)(HB + o) = pg8::pack8(v0, v1);
        const f32x4 q0 = v0 * v0, q1 = v1 * v1;
        const float ss = oct_sum(((q0[0] + q0[1]) + (q0[2] + q0[3])) + ((q1[0] + q1[1]) + (q1[2] + q1[3])));
        if (l8 == 0) SS[(size_t)row * 16 + tc] = ss;
    }
};
struct SEpiPP {
    bf16* PP;
    __device__ __forceinline__ void operator()(int row, int col, int tc, int l8, f32x4 v0, f32x4 v1) const { *(pg8::u32x4*)(PP + (size_t)row * D + col) = pg8::pack8(v0, v1); }
};
struct SEpiFinal {
    const float* SS; const bf16* PP; const bf16* HB; float* Y;
    __device__ __forceinline__ void operator()(int row, int col, int tc, int l8, f32x4 v0, f32x4 v1) const {
        const float r = rsqrtf(oct_sum(SS[(size_t)row * 16 + 2 * l8] + SS[(size_t)row * 16 + 2 * l8 + 1]) * (1.0f / D) + EPS);
        const size_t o = (size_t)row * D + col;
        const pg8::u32x4 pw = *(const pg8::u32x4*)(PP + o), hw = *(const pg8::u32x4*)(HB + o);
        const f32x4 p0 = pg8::bf_lo4(pw), p1 = pg8::bf_hi4(pw); f32x4 h0 = pg8::bf_lo4(hw), h1 = pg8::bf_hi4(hw);
#pragma unroll
        for (int e = 0; e < 4; ++e) { h0[e] += pg8::sigm(v0[e] * r) * p0[e]; h1[e] += pg8::sigm(v1[e] * r) * p1[e]; }
        *(f32x4*)(Y + o) = h0; *(f32x4*)(Y + o + 4) = h1;
    }
};

#ifndef REP_P0
#define REP_P0 1
#endif
#ifndef REP_P1
#define REP_P1 1
#endif
#ifndef REP_P2
#define REP_P2 1
#endif
#ifndef REP_P3
#define REP_P3 1
#endif
#ifndef REP_P4
#define REP_P4 1
#endif
struct Args { const float* in[23]; float* out; unsigned char* ws; };
constexpr int N_ATT_S = 2 * DB, N_ATT_P = NB * 64 * 2, N_CONV = RP / 64 + DB;
constexpr int I_WO = (D / 64) * (D / 32), I_WGU = (D / 64) * (2 * DFF / 32), N_WCV = (I_WO + I_WGU) / 8;
constexpr int N_ATT_Q = 8 + 64;
static_assert((I_WO + I_WGU) % 8 == 0, "weight conversion entries");
#define W1t ((bf16*)(ws + WS_W1))
#define WOt ((bf16*)(ws + WS_WO))
#define WGUt ((bf16*)(ws + WS_WGU))
#define WDt ((bf16*)(ws + WS_WD))
#define WPGt ((bf16*)(ws + WS_WPG))
#define WPPt ((bf16*)(ws + WS_WPP))
#define RX ((float*)(ws + WS_RX))
#define SS1 ((float*)(ws + WS_SS1))
#define SS2 ((float*)(ws + WS_SS2))
#define XB ((bf16*)(ws + WS_XB))
#define PB ((bf16*)(ws + WS_PB))
#define PPb ((bf16*)(ws + WS_PP))
#define Qb ((bf16*)(ws + WS_Q))
#define KVP (ws + WS_KP)
#define KVS (ws + WS_KS)
#define GLUb ((bf16*)(ws + WS_GLU))
#define MIXb ((bf16*)(ws + WS_MIX))
#define ACTb ((bf16*)(ws + WS_ACT))
#define Y (out + OY)
__global__ void __launch_bounds__(NWAVES * 64, 2) mk_fwd(Args args) {
    extern __shared__ __attribute__((aligned(16))) unsigned char lds_[];
    LAS unsigned char* lds = (LAS unsigned char*)lds_;
    volatile LAS unsigned* MISC = (volatile LAS unsigned*)(lds + MISC_OFF);
    const int G = gridDim.x, vcu = (G % 8 == 0) ? ((int)blockIdx.x % 8) * (G / 8) + (int)blockIdx.x / 8 : (int)blockIdx.x;
    unsigned char* ws = args.ws; float* out = args.out;
    gu32* ctl = (gu32*)(ws + WS_CTL);
    for (int u = threadIdx.x; u < (ATT_TAB - LDSCTL_OFF) / 4; u += NWAVES * 64) ((LAS unsigned*)(lds + LDSCTL_OFF))[u] = 0u;
    __syncthreads();
    XcdBarrier bar = xcd_barrier_post((unsigned*)(ctl + CW_BAR), MISC + 8);

#ifndef SKIP_P0
    for (int rep = 0; rep < REP_P0; ++rep) {
        if (rep) xcd_barrier(bar);
        int tid0 = threadIdx.x; asm volatile("" : "+v"(tid0));
        const int lane = tid0 & 63, wave = __builtin_amdgcn_readfirstlane(tid0 >> 6);
        LAS float* scr = (LAS float*)(lds + RING_OFF + wave * 16384);
        const int gw = vcu * NWAVES + wave, NGW = G * NWAVES;
        constexpr int I_1 = (D / 64) * (INC / 32);
        for (int it = gw; it < I_1; it += NGW) p0_transpose_item<1>(args.in[8], args.in[7], D, INC, W1t, scr, it, lane);
        for (int m2 = gw; m2 < R / 2; m2 += NGW) {
            f32x4 v[2][4];
#pragma unroll
            for (int rr = 0; rr < 2; ++rr) { const int m = 2 * m2 + rr; const float* xrow = m < RP ? args.in[0] + (size_t)m * D : args.in[1] + (size_t)(m - RP) * D;
                const GAS f32x4* xr = (const GAS f32x4*)xrow + lane;
#pragma unroll
                for (int j = 0; j < 4; ++j) v[rr][j] = xr[64 * j]; }
#pragma unroll
            for (int rr = 0; rr < 2; ++rr) { const int m = 2 * m2 + rr; float s = 0.f;
#pragma unroll
                for (int j = 0; j < 4; ++j) s += (v[rr][j].x * v[rr][j].x + v[rr][j].y * v[rr][j].y) + (v[rr][j].z * v[rr][j].z + v[rr][j].w * v[rr][j].w);
                s = wave_sum(s); if (lane == 0) RX[m] = rsqrtf(s * (1.0f / D) + EPS);
                GAS unsigned long long* o8 = (GAS unsigned long long*)(XB + (size_t)m * D) + lane;
#pragma unroll
                for (int j = 0; j < 4; ++j) o8[64 * j] = (unsigned long long)pk2(v[rr][j].x, v[rr][j].y) | ((unsigned long long)pk2(v[rr][j].z, v[rr][j].w) << 32); }
        }
    }
#endif
    xcd_barrier(bar);

#ifndef SKIP_P1
    for (int rep = 0; rep < REP_P1; ++rep) {
        if (rep) xcd_barrier(bar);
        pg8::Gemm g{XB, W1t, R, INC, D}; pg8::StaticOrder S; S.init(R, INC, G, (int)blockIdx.x);
        pg8::Epi1 E{RX, args.in[9], args.in[10], Qb, KVP, KVS, GLUb, out};
        pg8::gemm_phase<pg8::Epi1, pg8::StaticOrder, true, true>(lds + RING_OFF, g, S, E);
        { const int c0 = ((R / 256) * (INC / 256)) % G, nwgc = c0 ? G - c0 : G, cc = c0 ? (int)blockIdx.x - c0 : (int)blockIdx.x;
          if (cc >= 0) {
            int tidc = threadIdx.x; asm volatile("" : "+v"(tidc));
            const int lane = tidc & 63, wave = __builtin_amdgcn_readfirstlane(tidc >> 6), head = lane >> 3, dq = lane & 7;
            for (int m2 = cc * NWAVES + wave; m2 < DB * 512; m2 += nwgc * NWAVES) {
                const int b = m2 >> 9, j = m2 & 511, kv = j & 63;
                const GAS f32x4* sk = (const GAS f32x4*)(args.in[4] + (size_t)m2 * 512) + 2 * lane; const GAS f32x4* sv = (const GAS f32x4*)(args.in[5] + (size_t)m2 * 512) + 2 * lane;
                const f32x4 k0 = sk[0], k1 = sk[1], v0 = sv[0], v1 = sv[1];
                unsigned char* tb = KVS + (size_t)(b * 9 + (j >> 6)) * KVT_BYTES + (head >> 2) * 65536 + (head & 3) * 16384;
                *(GAS v4u*)(tb + dq * 1024 + kv * 16) = (v4u){pk2(k0.x, k0.y), pk2(k0.z, k0.w), pk2(k1.x, k1.y), pk2(k1.z, k1.w)};
                *(GAS v4u*)(tb + 8192 + (dq >> 2) * 4096 + (kv >> 4) * 1024 + (kv & 15) * 64 + (dq & 3) * 16) = (v4u){pk2(v0.x, v0.y), pk2(v0.z, v0.w), pk2(v1.x, v1.y), pk2(v1.z, v1.w)};
            }
            for (int p = cc * NWAVES + wave; p < DB * NH; p += nwgc * NWAVES) {
                unsigned char* tb = KVS + (size_t)((p >> 3) * 9 + 8) * KVT_BYTES + ((p & 7) >> 2) * 65536 + (p & 3) * 16384; const v4u z = (v4u){0u, 0u, 0u, 0u};
#pragma unroll
                for (int c2 = 0; c2 < 4; ++c2) *(GAS v4u*)(tb + (2 * c2 + (lane >> 5)) * 1024 + 512 + (lane & 31) * 16) = z;
#pragma unroll
                for (int q = 0; q < 4; ++q) *(GAS v4u*)(tb + 8192 + (q >> 1) * 4096 + (2 + (q & 1)) * 1024 + lane * 16) = z;
            }
          } }
    }
#endif
    xcd_barrier(bar);

#ifndef SKIP_P2
    for (int rep = 0; rep < REP_P2; ++rep) {
        if (rep) xcd_barrier(bar);
        { int tidt = threadIdx.x; asm volatile("" : "+v"(tidt)); const int lane = tidt & 63, wave = __builtin_amdgcn_readfirstlane(tidt >> 6);
          const float* relb = args.in[11] + wave * NREL; LAS float* T = (LAS float*)(lds + ATT_TAB) + wave * 256;
          const float bfar = relb[256];
          for (int x = lane; x < 256; x += 64) { int dd = 191 - x; dd = dd < -128 ? -128 : (dd > 128 ? 128 : dd); T[x] = (relb[dd + 128] - bfar) * LOG2E; } }
        __syncthreads();
        {
            int tid2 = threadIdx.x; asm volatile("" : "+v"(tid2));
            const int lane2 = tid2 & 63, wave2 = __builtin_amdgcn_readfirstlane(tid2 >> 6);
            int qk = 0, q = (int)blockIdx.x & 7;
#define ATT_POP(qq) ((int)__hip_atomic_fetch_add((unsigned*)(ctl + CW_Q + 64 * ((qq) + 8 * rep)), 1u, __ATOMIC_RELAXED, __HIP_MEMORY_SCOPE_AGENT))
#define ATT_DECODE(code, U) do { const int q_ = (int)((code) >> 8), i_ = (int)((code) & 255u); \
                if (i_ < 8) { const int sb = 4 * q_ + (i_ >> 1); U.hg = i_ & 1; U.sample = 1; U.nt = 9; U.c0rel = 8; \
                    U.Qrow = Qb + (size_t)(RP + DS * sb) * 512; U.KV = KVS + (size_t)(sb * 9) * KVT_BYTES; U.Orow = MIXb + (size_t)(RP + DS * sb) * D; } \
                else { const int j = i_ - 8, pi = j < 60 ? 4 + j : 63 - j, bb = q_ >> 1, c0 = 2 * pi;     \
                    U.hg = q_ & 1; U.sample = 0; U.c0rel = c0 < 8 ? c0 : 8; U.nt = U.c0rel + 2; const size_t row0 = (size_t)bb * SEQ + 64 * c0; \
                    U.Qrow = Qb + row0 * 512; U.KV = KVP + (size_t)(bb * 128 + c0 - U.c0rel) * KVT_BYTES; U.Orow = MIXb + row0 * D; } } while (0)
            if (tid2 == 0) { int i = ATT_POP(q); while (i >= N_ATT_Q) { if (++qk == 8) { i = -1; break; } q = ((int)blockIdx.x + qk) & 7; i = ATT_POP(q); }
                MISC[4] = i < 0 ? 0xffffffffu : (unsigned)((q << 8) | i); }
            __syncthreads();
            unsigned code = MISC[4];
            if (code != 0xffffffffu) {
                att::AUnit U; ATT_DECODE(code, U);
                att::bf16x8 qr[2][4];
                att::attn_prefetch(U, lds, wave2, lane2, qr);
                for (;;) {
                    int nraw = 0; if (tid2 == 0) nraw = ATT_POP(q);
#pragma unroll
                    for (int d0 = 0; d0 < 4; ++d0) asm volatile("" : "+v"(qr[0][d0]), "+v"(qr[1][d0]));
                    att::f32x16 o[2][2]; o[0][0] = att::f32x16{}; o[0][1] = att::f32x16{}; o[1][0] = att::f32x16{}; o[1][1] = att::f32x16{}; float lsum[2] = {0.f, 0.f};
                    if (U.sample) att::attn_steps<false>(U, lds, wave2, lane2, qr, o, lsum); else att::attn_steps<true>(U, lds, wave2, lane2, qr, o, lsum);
                    if (tid2 == 0) { int i = nraw; while (i >= N_ATT_Q) { if (++qk == 8) { i = -1; break; } q = ((int)blockIdx.x + qk) & 7; i = ATT_POP(q); }
                        MISC[4] = i < 0 ? 0xffffffffu : (unsigned)((q << 8) | i); }
                    ATT_WAIT_BAR();
                    const unsigned ncode = MISC[4];
                    att::AUnit Un = U;
                    if (ncode != 0xffffffffu) { ATT_DECODE(ncode, Un); att::attn_prefetch(Un, lds, wave2, lane2, qr); }
                    if (U.sample) att::attn_store<false>(U, lds, wave2, lane2, o, lsum); else att::attn_store<true>(U, lds, wave2, lane2, o, lsum);
                    if (ncode == 0xffffffffu) break;
                    U = Un;
                }
                ATT_WAIT_BAR();
            }
#undef ATT_POP
#undef ATT_DECODE
        }
        ConvConst CC; { int tidc = threadIdx.x; asm volatile("" : "+v"(tidc)); conv_consts(CC, args.in[12], args.in[13], tidc); }
        for (;;) {
            int tid2 = threadIdx.x; asm volatile("" : "+v"(tid2));
            if (tid2 == 0) MISC[4] = __hip_atomic_fetch_add((unsigned*)(ctl + CW_QG + 64 * rep), 1u, __ATOMIC_RELAXED, __HIP_MEMORY_SCOPE_AGENT);
            __syncthreads();
            const int idx = (int)MISC[4];
            __syncthreads();
            if (idx >= N_CONV + N_WCV) break;
            const int lane2 = tid2 & 63, wave2 = __builtin_amdgcn_readfirstlane(tid2 >> 6);
            if (idx < N_CONV) conv_entry(idx, CC, GLUb, args.in[6], args.in[14], args.in[15], MIXb, lds, tid2);
            else { const int it = 8 * (idx - N_CONV) + wave2; LAS float* scr = (LAS float*)(lds + RING_OFF + wave2 * 16384);
                if (it < I_WO) p0_transpose_item<0>(args.in[16], nullptr, D, D, WOt, scr, it, lane2);
                else p0_transpose_item<2>(args.in[18], args.in[17], D, 2 * DFF, WGUt, scr, it - I_WO, lane2);
                __syncthreads(); }
        }
    }
#endif
    xcd_barrier(bar);

#ifndef SKIP_P3
    for (int rep = 0; rep < REP_P3; ++rep) {
        if (rep) xcd_barrier(bar);
        pg8::Gemm g{MIXb, WOt, RP, D, D}; pg8::StaticOrder S; S.init(RP, D, G, (int)blockIdx.x);
        pg8::EpiRes<true> E{nullptr, nullptr, XB, SS1};
        const SEpiRes<true> SE{nullptr, XB + (size_t)RP * D, SS1 + (size_t)RP * 16};
        if (blockIdx.x & 1) for (int t = (int)blockIdx.x; t < 256; t += G) sgemm64(MIXb + (size_t)RP * D, WOt, D, t, SE, lds + RING_OFF);
        pg8::gemm_phase<pg8::EpiRes<true>, pg8::StaticOrder, true, true>(lds + RING_OFF, g, S, E);
        if (!(blockIdx.x & 1)) for (int t = (int)blockIdx.x; t < 256; t += G) sgemm64(MIXb + (size_t)RP * D, WOt, D, t, SE, lds + RING_OFF);
    }
#endif
    xcd_barrier(bar);

#ifndef SKIP_P4
    for (int rep = 0; rep < REP_P4; ++rep) {
        if (rep) xcd_barrier(bar);
        { const int c0 = ((R / 256) * (2 * DFF / 256)) % G, nwgc = c0 ? G - c0 : G, cc = c0 ? (int)blockIdx.x - c0 : (int)blockIdx.x;
          if (cc >= 0) {
            const bool wt = (nwgc % 4) == 0; const int k = wt ? cc & 3 : 1, j = wt ? cc >> 2 : cc, per = wt ? nwgc / 4 : nwgc, nslot = wt ? 6 * per : per;
            const int s0 = !wt ? j : (k == 1 ? j : (k == 2 ? per + 2 * j : 3 * per + 3 * j));
            int tidc = threadIdx.x; asm volatile("" : "+v"(tidc));
            const int lane = tidc & 63, wave = __builtin_amdgcn_readfirstlane(tidc >> 6);
            for (int q = 0; q < k; ++q)
            for (int m4 = s0 + q + nslot * wave; m4 < 2 * DB * 120; m4 += nslot * NWAVES) {
                const int kv = m4 >= DB * 120, mm = kv ? m4 - DB * 120 : m4, b = mm / 120, j2 = DS + 4 * (mm % 120);
                const GAS f32x4* src = (const GAS f32x4*)(args.in[4 + kv] + ((size_t)b * 512 + j2) * 512) + lane;
                GAS f32x4* dst = (GAS f32x4*)(out + (kv ? OVS : OKS) + ((size_t)b * 512 + (j2 - DS)) * 512) + lane;
                f32x4 v[8];
#pragma unroll
                for (int i = 0; i < 8; ++i) v[i] = src[64 * i];
#pragma unroll
                for (int i = 0; i < 8; ++i) dst[64 * i] = v[i];
            }
            { LAS float* scr = (LAS float*)(lds + RING_OFF + wave * 16384); constexpr int I_D = (DFF / 64) * (D / 32), I_PG = (D / 64) * (D / 32);
              constexpr int I_PP = (PLE / 64) * (D / 32);
              for (int it = cc * NWAVES + wave; it < I_D + I_PG + I_PP; it += nwgc * NWAVES) {
                  if (it < I_D) p0_transpose_item<0>(args.in[19], nullptr, DFF, D, WDt, scr, it, lane);
                  else if (it < I_D + I_PG) p0_transpose_item<0>(args.in[21], args.in[20], D, D, WPGt, scr, it - I_D, lane);
                  else p0_transpose_item<0>(args.in[22], nullptr, PLE, D, WPPt, scr, it - I_D - I_PG, lane); }
              __syncthreads(); }
            for (int m8 = cc * NWAVES + wave; m8 < R / 8; m8 += nwgc * NWAVES) {
                const int m = 8 * m8; const float* prow = m < RP ? args.in[2] + (size_t)m * PLE : args.in[3] + (size_t)(m - RP) * PLE;
                const GAS f32x4* pr = (const GAS f32x4*)prow + lane; f32x4 pv[8];
#pragma unroll
                for (int j = 0; j < 8; ++j) pv[j] = pr[64 * j];
                GAS unsigned long long* o8 = (GAS unsigned long long*)(PB + (size_t)m * PLE) + lane;
#pragma unroll
                for (int j = 0; j < 8; ++j) o8[64 * j] = (unsigned long long)pk2(pv[j].x, pv[j].y) | ((unsigned long long)pk2(pv[j].z, pv[j].w) << 32);
            }
          } }
        pg8::Gemm g{XB, WGUt, R, 2 * DFF, D}; pg8::StaticOrder S; S.init(R, 2 * DFF, G, (int)blockIdx.x);
        pg8::EpiAct E{SS1, ACTb};
        pg8::gemm_phase<pg8::EpiAct, pg8::StaticOrder, true, true>(lds + RING_OFF, g, S, E);
    }
#endif
    xcd_barrier(bar);

#ifndef SKIP_P5
    {
        pg8::Gemm g{ACTb, WDt, RP, D, DFF}; pg8::StaticOrder S; S.init(RP, D, G, (int)blockIdx.x);
        pg8::EpiRes<true> E{nullptr, nullptr, XB, SS2};
        const SEpiRes<true> SE{nullptr, XB + (size_t)RP * D, SS2 + (size_t)RP * 16};
        if (blockIdx.x & 1) for (int t = (int)blockIdx.x; t < 256; t += G) sgemm64(ACTb + (size_t)RP * DFF, WDt, DFF, t, SE, lds + RING_OFF);
        pg8::gemm_phase<pg8::EpiRes<true>, pg8::StaticOrder, true, true>(lds + RING_OFF, g, S, E);
        if (!(blockIdx.x & 1)) for (int t = (int)blockIdx.x; t < 256; t += G) sgemm64(ACTb + (size_t)RP * DFF, WDt, DFF, t, SE, lds + RING_OFF);
    }
#endif
    xcd_barrier(bar);

#ifndef SKIP_P6
    {
        pg8::Gemm g{XB, WPGt, RP, D, D}; pg8::StaticOrder S; S.init(RP, D, G, (int)blockIdx.x);
        pg8::EpiFinal E{SS2, PPb, XB, Y};
        const SEpiFinal SE{SS2 + (size_t)RP * 16, PPb + (size_t)RP * D, XB + (size_t)RP * D, Y + (size_t)RP * D};
        pg8::Gemm gp{PB, WPPt, RP, D, PLE}; pg8::EpiPP EP{PPb}; const SEpiPP SP{PPb + (size_t)RP * D};
        if (blockIdx.x & 1) for (int t = (int)blockIdx.x; t < 256; t += G) { sgemm64(PB + (size_t)RP * PLE, WPPt, PLE, t, SP, lds + RING_OFF); sgemm64(XB + (size_t)RP * D, WPGt, D, t, SE, lds + RING_OFF); }
        pg8::gemm_phase<pg8::EpiPP, pg8::StaticOrder, true, true>(lds + RING_OFF, gp, S, EP);
        pg8::gemm_phase<pg8::EpiFinal, pg8::StaticOrder, true, true>(lds + RING_OFF, g, S, E);
        if (!(blockIdx.x & 1)) for (int t = (int)blockIdx.x; t < 256; t += G) { sgemm64(PB + (size_t)RP * PLE, WPPt, PLE, t, SP, lds + RING_OFF); sgemm64(XB + (size_t)RP * D, WPGt, D, t, SE, lds + RING_OFF); }
    }
#endif
}

extern "C" void kernel_launch(void* const* d_in, const int* in_sizes, int n_in, void* d_out, int out_size, void* d_ws, size_t ws_size, hipStream_t stream) {
    static int grid = 0;
    if (grid == 0) {
        if (n_in != 23 || ws_size < WS_END) { fprintf(stderr, "kernel_launch: unexpected shapes (n_in %d, ws %zu)\n", n_in, ws_size); grid = -1; return; }
        int dev = 0, cus = 0, per_cu = 0;
        if (hipGetDevice(&dev) != hipSuccess || hipDeviceGetAttribute(&cus, hipDeviceAttributeMultiprocessorCount, dev) != hipSuccess) { grid = -1; return; }
        if (hipFuncSetAttribute((const void*)mk_fwd, hipFuncAttributeMaxDynamicSharedMemorySize, LDS_BYTES) != hipSuccess) { fprintf(stderr, "kernel_launch: hipFuncSetAttribute failed\n"); grid = -1; return; }
        if (hipOccupancyMaxActiveBlocksPerMultiprocessor(&per_cu, (const void*)mk_fwd, NWAVES * 64, LDS_BYTES) != hipSuccess || per_cu < 1) { fprintf(stderr, "kernel_launch: occupancy query says %d blocks per CU\n", per_cu); }
        (void)hipGetLastError();
        grid = cus;
    }
    if (grid < 0) return;
    if (hipMemsetAsync((char*)d_ws + WS_CTL, 0, CTL_ZERO_BYTES, stream) != hipSuccess) return;
    Args a{};
    for (int i = 0; i < 23; ++i) a.in[i] = (const float*)d_in[i];
    a.out = (float*)d_out; a.ws = (unsigned char*)d_ws;
    hipLaunchKernelGGL(mk_fwd, dim3(grid), dim3(NWAVES * 64), LDS_BYTES, stream, a);
}
```

```cpp
#include <hip/hip_runtime.h>
#include <cstdio>
#include <cstdint>
constexpr int D = 1024, SEQ = 8192, NB = 4, DB = 32, DS = 32;
constexpr int RP = NB * SEQ, RS = DB * DS, R = RP + RS;
constexpr int INC = 2560, DFF = 2816, PLE = 256, NH = 8, HD = 64, CW = 512;
constexpr int NREL = 257, CONVW = 31, CH = 30, KSROWS = 576;
constexpr int KVT_BYTES = 131072;
constexpr float EPS = 1e-6f, LOG2E = 1.4426950408889634f, QSCALE = 0.125f * LOG2E;
constexpr size_t OY = 0, OKP = (size_t)R * D, OVP = OKP + (size_t)NB * 512 * 512, OCP = OVP + (size_t)NB * 512 * 512,
                 OKS = OCP + (size_t)NB * CH * CW, OVS = OKS + (size_t)DB * 512 * 512, OCS = OVS + (size_t)DB * 512 * 512;
namespace pg8 {
#define PG8_LAS __attribute__((address_space(3)))
typedef unsigned short bf16_t;
typedef short bf16x8 __attribute__((ext_vector_type(8)));
typedef float f32x4 __attribute__((ext_vector_type(4)));
typedef unsigned u32x4 __attribute__((ext_vector_type(4)));
constexpr int BM = 256, BK = 64, HALF = 128, HTB = HALF * BK * 2  , STAGE_BYTES = 8 * HTB, NXCD = 8, WGM = 8;

__host__ __device__ __forceinline__ int lds_byte(int r, int c) { const int st = (r >> 4) * 2 + (c >> 5), rr = r & 15, cc = c & 31, ob = rr * 64 + cc * 2; return st * 1024 + (ob ^ (((ob >> 9) & 1) << 5)); }
__host__ __device__ __forceinline__ void stage_rc(int b, int& R, int& C) { const int st = b / 1024, sb = b % 1024, swz = sb ^ (((sb >> 9) & 1) << 5); R = (st >> 1) * 16 + swz / 64; C = (st & 1) * 32 + (swz % 64) / 2; }
__host__ __device__ __forceinline__ int perm32(int rho) { const int n = rho >> 4, i = rho & 15; return 8 * (i >> 2) + 4 * n + (i & 3); }

struct Unit { int pm, pn; };
struct Gemm { const bf16_t* A; const bf16_t* Bt; int M, N, K; };

struct StaticOrder {
    int nM, nN, nwg, G, c;
    __host__ __device__ void init(int M, int N, int G_, int c_) { nM = M / BM; nN = N / BM; nwg = nM * nN; G = G_; c = c_; }
    __host__ __device__ bool next(int i, Unit& u) const {
        const long L = (long)i * G + c; if (L >= nwg) return false;
        int wgid = (int)L; { const int q = nwg / NXCD, r = nwg % NXCD, xcd = wgid % NXCD, off = wgid / NXCD; wgid = (xcd < r ? xcd * (q + 1) : r * (q + 1) + (xcd - r) * q) + off; }
        const int nig = WGM * nN, gid = wgid / nig, fm = gid * WGM, gsz = (nM - fm) < WGM ? (nM - fm) : WGM;
        u.pm = fm + ((wgid % nig) % gsz); u.pn = (wgid % nig) / gsz; return true;
    }
    __device__ __forceinline__ void a_ready(const Unit&) const {}
    __device__ __forceinline__ void done(const Unit&) const {}
};

__device__ __forceinline__ unsigned cvt_pk_bf16(float lo, float hi) { unsigned r; asm volatile("v_cvt_pk_bf16_f32 %0, %1, %2" : "=v"(r) : "v"(lo), "v"(hi)); return r; }
typedef float f32x2 __attribute__((ext_vector_type(2)));typedef unsigned u32x2 __attribute__((ext_vector_type(2)));
__device__ __forceinline__ u32x4 pack8(const f32x4 a, const f32x4 b) { u32x4 w; w.x = cvt_pk_bf16(a[0], a[1]); w.y = cvt_pk_bf16(a[2], a[3]); w.z = cvt_pk_bf16(b[0], b[1]); w.w = cvt_pk_bf16(b[2], b[3]); return w; }
__device__ __forceinline__ float sigm(float x) { return __builtin_amdgcn_rcpf(1.0f + __builtin_amdgcn_exp2f(-x * LOG2E)); }
__device__ __forceinline__ float quad_sum(float s) { s += __shfl_xor(s, 16); s += __shfl_xor(s, 32); return s; }
struct Epi1 {
    static constexpr bool PERM = true, AFTER_DRAIN = false;
    const float* rx; const float* qg; const float* kg; bf16_t* Q; unsigned char* KVP; unsigned char* KVS; bf16_t* GLU; float* out;
    __device__ __forceinline__ void operator()(const f32x4 (&acc)[2][2][4][2], const Unit& u, int wr, int wc, int fr, int fq) const {
        const int pn = u.pn, rowt = u.pm * BM + wr * 64 + fr;
        float rxv[2][4];
#pragma unroll
        for (int ai = 0; ai < 2; ++ai)
#pragma unroll
            for (int m = 0; m < 4; ++m) rxv[ai][m] = rx[rowt + ai * HALF + m * 16];
        if (pn < 6) {
            const int sec = pn >> 1, col = (4 * (pn & 1) + wc) * 64 + 8 * fq;
            f32x4 g[2][2];
#pragma unroll
            for (int bj = 0; bj < 2; ++bj)
#pragma unroll
                for (int n = 0; n < 2; ++n) { g[bj][n] = (f32x4){1.f, 1.f, 1.f, 1.f};
                    if (sec == 0) g[bj][n] = *(const f32x4*)(qg + 32 * bj + 8 * fq + 4 * n) * QSCALE;
                    if (sec == 1) g[bj][n] = *(const f32x4*)(kg + 32 * bj + 8 * fq + 4 * n); }
#pragma unroll
            for (int ai = 0; ai < 2; ++ai)
#pragma unroll
                for (int m = 0; m < 4; ++m) {
                    const int row = rowt + ai * HALF + m * 16; const float r = rxv[ai][m];
                    f32x4 z[2][2];
#pragma unroll
                    for (int bj = 0; bj < 2; ++bj)
#pragma unroll
                        for (int n = 0; n < 2; ++n) z[bj][n] = acc[ai][bj][m][n] * r;
                    if (sec < 2) {
                        float ss = 0.f;
#pragma unroll
                        for (int bj = 0; bj < 2; ++bj)
#pragma unroll
                            for (int n = 0; n < 2; ++n) { const f32x4 q = z[bj][n] * z[bj][n]; ss += (q[0] + q[1]) + (q[2] + q[3]); }
                        ss = quad_sum(ss);
                        const float rn = rsqrtf(ss * (1.0f / 64.0f) + EPS);
#pragma unroll
                        for (int bj = 0; bj < 2; ++bj)
#pragma unroll
                            for (int n = 0; n < 2; ++n) z[bj][n] = z[bj][n] * rn * g[bj][n];
                    }
                    const int sb = (row - RP) >> 5, si = (row - RP) & 31;
                    float* fo = nullptr;
                    if (sec == 0) {
#pragma unroll
                        for (int bj = 0; bj < 2; ++bj) *(u32x4*)(Q + (size_t)row * 512 + col + 32 * bj) = pack8(z[bj][0], z[bj][1]);
                    } else {
                        unsigned char* tb; int kv;
                        if (row < RP) { tb = KVP + (size_t)(row >> 6) * KVT_BYTES; kv = row & 63;
                            const int t = row & (SEQ - 1); if (t >= SEQ - 512) fo = out + OKP + (size_t)(sec - 1) * (OVP - OKP) + ((size_t)((row >> 13) * 512 + (t - (SEQ - 512)))) * 512 + col; }
                        else { tb = KVS + (size_t)(sb * 9 + 8) * KVT_BYTES; kv = si; fo = out + OKS + (size_t)(sec - 1) * (OVS - OKS) + ((size_t)(sb * 512 + 480 + si)) * 512 + col; }
                        tb += (pn & 1) * 65536 + wc * 16384;
                        const int ok = fq * 1024 + kv * 16, ov = 8192 + (kv >> 4) * 1024 + (kv & 15) * 64 + fq * 16;
#pragma unroll
                        for (int bj = 0; bj < 2; ++bj) *(u32x4*)(tb + (sec == 1 ? ok + bj * 4096 : ov + bj * 4096)) = pack8(z[bj][0], z[bj][1]);
                    }
                    if (fo) {
#pragma unroll
                        for (int bj = 0; bj < 2; ++bj)
#pragma unroll
                            for (int n = 0; n < 2; ++n) *(f32x4*)(fo + 32 * bj + 4 * n) = z[bj][n]; }
                }
        } else {
            const int col = 128 * (pn - 6) + 32 * wc + 8 * fq;
#pragma unroll
            for (int ai = 0; ai < 2; ++ai)
#pragma unroll
                for (int m = 0; m < 4; ++m) {
                    const int row = rowt + ai * HALF + m * 16; const float r = rxv[ai][m];
                    f32x4 gl[2];
#pragma unroll
                    for (int n = 0; n < 2; ++n) { const f32x4 a = acc[ai][0][m][n] * r, b = acc[ai][1][m][n] * r;
#pragma unroll
                        for (int e = 0; e < 4; ++e) gl[n][e] = a[e] * sigm(b[e]); }
                    *(u32x4*)(GLU + (size_t)row * 512 + col) = pack8(gl[0], gl[1]);
                    float* fo = nullptr;
                    if (row < RP) { const int t = row & (SEQ - 1); if (t >= SEQ - CH) fo = out + OCP + ((size_t)((row >> 13) * CH + (t - (SEQ - CH)))) * CW + col; }
                    else { const int sb = (row - RP) >> 5, si = (row - RP) & 31; if (si >= DS - CH) fo = out + OCS + ((size_t)(sb * CH + (si - (DS - CH)))) * CW + col; }
                    if (fo) { *(f32x4*)(fo) = gl[0]; *(f32x4*)(fo + 4) = gl[1]; }
                }
        }
    }
};
struct EpiPP {
    static constexpr bool PERM = true, AFTER_DRAIN = false;
    bf16_t* O;
    __device__ __forceinline__ void operator()(const f32x4 (&acc)[2][2][4][2], const Unit& u, int wr, int wc, int fr, int fq) const {
        const int rowt = u.pm * BM + wr * 64 + fr, col = u.pn * BM + 32 * wc + 8 * fq;
#pragma unroll
        for (int ai = 0; ai < 2; ++ai)
#pragma unroll
            for (int m = 0; m < 4; ++m) { bf16_t* rowp = O + (size_t)(rowt + ai * HALF + m * 16) * D + col;
#pragma unroll
                for (int bj = 0; bj < 2; ++bj) *(u32x4*)(rowp + bj * HALF) = pack8(acc[ai][bj][m][0], acc[ai][bj][m][1]); }
    }
};
__device__ __forceinline__ f32x4 bf_lo4(const u32x4 w) { return (f32x4){__uint_as_float(w.x << 16), __uint_as_float(w.x & 0xffff0000u), __uint_as_float(w.y << 16), __uint_as_float(w.y & 0xffff0000u)}; }
__device__ __forceinline__ f32x4 bf_hi4(const u32x4 w) { return (f32x4){__uint_as_float(w.z << 16), __uint_as_float(w.z & 0xffff0000u), __uint_as_float(w.w << 16), __uint_as_float(w.w & 0xffff0000u)}; }
template <bool BF> struct EpiRes {
    static constexpr bool PERM = true, AFTER_DRAIN = false;
    const float* bp; const float* bs; bf16_t* HB; float* SS;
    __device__ __forceinline__ void operator()(const f32x4 (&acc)[2][2][4][2], const Unit& u, int wr, int wc, int fr, int fq) const {
        const int rowt = u.pm * BM + wr * 64 + fr, col = u.pn * BM + 32 * wc + 8 * fq;
        f32x4 bv[2][2][2];
        auto ldbase = [&](int i, f32x4 (&d)[2][2]) {
            const int row = rowt + (i >> 2) * HALF + (i & 3) * 16;
            if (BF) { const bf16_t* hrow = HB + (size_t)row * D + col;
#pragma unroll
                for (int bj = 0; bj < 2; ++bj) { const u32x4 w = *(const u32x4*)(hrow + bj * HALF); d[bj][0] = bf_lo4(w); d[bj][1] = bf_hi4(w); } }
            else { const float* brow = (row < RP ? bp + (size_t)row * D : bs + (size_t)(row - RP) * D) + col;
#pragma unroll
                for (int bj = 0; bj < 2; ++bj) { d[bj][0] = *(const f32x4*)(brow + bj * HALF); d[bj][1] = *(const f32x4*)(brow + bj * HALF + 4); } } };
        ldbase(0, bv[0]);
#pragma unroll
        for (int i = 0; i < 8; ++i) {
            const int ai = i >> 2, m = i & 3, row = rowt + ai * HALF + m * 16;
            if (i + 1 < 8) ldbase(i + 1, bv[(i + 1) & 1]);
            bf16_t* hrow = HB + (size_t)row * D + col;
            float ss = 0.f;
#pragma unroll
            for (int bj = 0; bj < 2; ++bj) {
                const f32x4 v0 = bv[i & 1][bj][0] + acc[ai][bj][m][0], v1 = bv[i & 1][bj][1] + acc[ai][bj][m][1];
                *(u32x4*)(hrow + bj * HALF) = pack8(v0, v1);
                const f32x4 q0 = v0 * v0, q1 = v1 * v1; ss += ((q0[0] + q0[1]) + (q0[2] + q0[3])) + ((q1[0] + q1[1]) + (q1[2] + q1[3]));
            }
            ss = quad_sum(ss);
            if (fq == 0) SS[(size_t)row * 16 + 4 * u.pn + wc] = ss;
        }
    }
};
__device__ __forceinline__ float row_rs(const float* SS, int row, int fq) {
    const f32x4 s4 = *(const f32x4*)(SS + (size_t)row * 16 + 4 * fq);
    return rsqrtf(quad_sum((s4[0] + s4[1]) + (s4[2] + s4[3])) * (1.0f / D) + EPS);
}
struct EpiAct {
    static constexpr bool PERM = true, AFTER_DRAIN = false;
    const float* SS; bf16_t* ACT;
    __device__ __forceinline__ void operator()(const f32x4 (&acc)[2][2][4][2], const Unit& u, int wr, int wc, int fr, int fq) const {
        const int rowt = u.pm * BM + wr * 64 + fr, col = 128 * u.pn + 32 * wc + 8 * fq;
        float rv[2][4];
#pragma unroll
        for (int ai = 0; ai < 2; ++ai)
#pragma unroll
            for (int m = 0; m < 4; ++m) rv[ai][m] = row_rs(SS, rowt + ai * HALF + m * 16, fq);
#pragma unroll
        for (int ai = 0; ai < 2; ++ai)
#pragma unroll
            for (int m = 0; m < 4; ++m) {
                const int row = rowt + ai * HALF + m * 16; const float r = rv[ai][m];
                f32x4 v[2];
#pragma unroll
                for (int n = 0; n < 2; ++n) { const f32x4 g = acc[ai][0][m][n] * r, up = acc[ai][1][m][n] * r;
#pragma unroll
                    for (int e = 0; e < 4; ++e) v[n][e] = g[e] * sigm(g[e]) * up[e]; }
                *(u32x4*)(ACT + (size_t)row * DFF + col) = pack8(v[0], v[1]);
            }
    }
};
struct EpiFinal {
    static constexpr bool PERM = true, AFTER_DRAIN = false;
    const float* SS; const bf16_t* PP; const bf16_t* HB; float* Y;
    __device__ __forceinline__ void operator()(const f32x4 (&acc)[2][2][4][2], const Unit& u, int wr, int wc, int fr, int fq) const {
        const int rowt = u.pm * BM + wr * 64 + fr, col = u.pn * BM + 32 * wc + 8 * fq;
        float rv[2][4];
#pragma unroll
        for (int ai = 0; ai < 2; ++ai)
#pragma unroll
            for (int m = 0; m < 4; ++m) rv[ai][m] = row_rs(SS, rowt + ai * HALF + m * 16, fq);
        u32x4 pwv[2][2], hwv[2][2];
        auto ld = [&](int i, u32x4 (&p)[2], u32x4 (&h)[2]) { const size_t o = (size_t)(rowt + (i >> 2) * HALF + (i & 3) * 16) * D + col;
#pragma unroll
            for (int bj = 0; bj < 2; ++bj) { p[bj] = *(const u32x4*)(PP + o + bj * HALF); h[bj] = *(const u32x4*)(HB + o + bj * HALF); } };
        ld(0, pwv[0], hwv[0]);
#pragma unroll
        for (int i = 0; i < 8; ++i) {
            const int ai = i >> 2, m = i & 3, row = rowt + ai * HALF + m * 16; const float r = rv[ai][m];
            if (i + 1 < 8) ld(i + 1, pwv[(i + 1) & 1], hwv[(i + 1) & 1]);
#pragma unroll
            for (int bj = 0; bj < 2; ++bj) {
                const size_t o = (size_t)row * D + col + bj * HALF;
                const u32x4 pw = pwv[i & 1][bj], hw = hwv[i & 1][bj];
                const f32x4 a0 = acc[ai][bj][m][0] * r, a1 = acc[ai][bj][m][1] * r, p0 = bf_lo4(pw), p1 = bf_hi4(pw);
                f32x4 h0 = bf_lo4(hw), h1 = bf_hi4(hw);
#pragma unroll
                for (int e2 = 0; e2 < 4; ++e2) { h0[e2] += sigm(a0[e2]) * p0[e2]; h1[e2] += sigm(a1[e2]) * p1[e2]; }
                *(f32x4*)(Y + o) = h0; *(f32x4*)(Y + o + 4) = h1;
            }
        }
    }
};

template <class Epi, class Sched, bool ALIGN_EPI = false, bool SP2 = false>
__device__ __forceinline__ void gemm_phase(PG8_LAS unsigned char* lds, const Gemm g, const Sched& S, const Epi& E) {
    int tid_ = threadIdx.x; asm volatile("" : "+v"(tid_));
    const int tid = tid_, wid = __builtin_amdgcn_readfirstlane(tid >> 6), lane = tid & 63, wr = wid >> 2, wc = wid & 3, fr = lane & 15, fq = lane >> 4;
    int K_ = g.K; asm volatile("" : "+s"(K_));
    const int K = K_, nt = K / BK;
    unsigned voffA[2], voffB[2];
#pragma unroll
    for (int i = 0; i < 2; ++i) { int R, C; stage_rc(tid * 16 + i * 8192, R, C); const int Rb = Epi::PERM ? ((R & ~31) + perm32(R & 31)) : R;
        voffA[i] = (unsigned)(R * K + C) * 2u; voffB[i] = (unsigned)(Rb * K + C) * 2u; }
    const size_t kstep = (size_t)(BK * 2);
    const size_t hstep = (size_t)HALF * K * 2;
    const size_t tstep = 2 * hstep;
    const unsigned ldsw = (unsigned)wid * 1024u;
    const int aoff = lds_byte(wr * 64 + fr, fq * 8), boff = lds_byte(wc * 32 + fr, fq * 8);
#define PG8_SA(b, h) (((b) * 2 + (h)) * HTB)
#define PG8_SB(b, h) ((4 + (b) * 2 + (h)) * HTB)
#define PG8_STAGE(bufoff, gbase, voff) do { _Pragma("unroll") for (int _i = 0; _i < 2; ++_i) \
        __builtin_amdgcn_global_load_lds((const unsigned*)((const char*)(gbase) + (voff)[_i]), (PG8_LAS unsigned*)(lds + (bufoff) + ldsw + _i * 8192), 16, 0, 0); } while (0)
#define PG8_LDA(dst, b, h) do { _Pragma("unroll") for (int m = 0; m < 4; ++m) _Pragma("unroll") for (int k = 0; k < 2; ++k) dst[m][k] = *(const PG8_LAS bf16x8*)(lds + PG8_SA(b, h) + aoff + m * 2048 + k * 1024); } while (0)
#define PG8_LDB(dst, b, h) do { _Pragma("unroll") for (int n = 0; n < 2; ++n) _Pragma("unroll") for (int k = 0; k < 2; ++k) dst[n][k] = *(const PG8_LAS bf16x8*)(lds + PG8_SB(b, h) + boff + n * 2048 + k * 1024); } while (0)
#define PG8_MMA(ai, bj, At, Bt) do { __builtin_amdgcn_s_setprio(1); _Pragma("unroll") for (int m = 0; m < 4; ++m) _Pragma("unroll") for (int n = 0; n < 2; ++n) _Pragma("unroll") for (int k = 0; k < 2; ++k) \
        acc[ai][bj][m][n] = __builtin_amdgcn_mfma_f32_16x16x32_bf16(Bt[n][k], At[m][k], acc[ai][bj][m][n], 0, 0, 0); __builtin_amdgcn_s_setprio(0); } while (0)
#define PG8_WAIT_V(n) asm volatile("s_waitcnt vmcnt(" #n ")" ::: "memory")
#define PG8_WAIT_L(n) asm volatile("s_waitcnt lgkmcnt(" #n ")" ::: "memory")
#define PG8_BAR __builtin_amdgcn_s_barrier()
#define PG8_SCHED __builtin_amdgcn_sched_barrier(0)
    Unit cur, nxt; int ui = 0;
    if (!S.next(0, cur)) return;
    f32x4 acc[2][2][4][2];
#pragma unroll
    for (int a = 0; a < 2; ++a)
#pragma unroll
        for (int b = 0; b < 2; ++b)
#pragma unroll
            for (int m = 0; m < 4; ++m)
#pragma unroll
                for (int n = 0; n < 2; ++n) acc[a][b][m][n] = (f32x4){0.f, 0.f, 0.f, 0.f};
    bf16x8 At[4][2], B0[2][2], B1[2][2];
    const char* cA = (const char*)g.A + (size_t)cur.pm * tstep; const char* cB = (const char*)g.Bt + (size_t)cur.pn * tstep;
    S.a_ready(cur);
    if constexpr (SP2) {
        PG8_STAGE(PG8_SB(0, 0), cB, voffB); PG8_STAGE(PG8_SB(0, 1), cB + hstep, voffB); PG8_STAGE(PG8_SA(0, 0), cA, voffA); PG8_STAGE(PG8_SA(0, 1), cA + hstep, voffA);
        if (wr == 1) PG8_BAR;
        PG8_WAIT_V(2); PG8_BAR;
        PG8_STAGE(PG8_SB(1, 0), cB + kstep, voffB); PG8_STAGE(PG8_SA(1, 0), cA + kstep, voffA); PG8_STAGE(PG8_SB(1, 1), cB + hstep + kstep, voffB);
        PG8_WAIT_V(6); PG8_BAR;
    } else {
        PG8_STAGE(PG8_SB(0, 0), cB, voffB); PG8_STAGE(PG8_SA(0, 0), cA, voffA); PG8_STAGE(PG8_SB(0, 1), cB + hstep, voffB); PG8_STAGE(PG8_SA(0, 1), cA + hstep, voffA);
        if (wr == 1) PG8_BAR;
        PG8_WAIT_V(4); PG8_BAR;
        PG8_STAGE(PG8_SB(1, 0), cB + kstep, voffB); PG8_STAGE(PG8_SA(1, 0), cA + kstep, voffA); PG8_STAGE(PG8_SB(1, 1), cB + hstep + kstep, voffB);
        PG8_WAIT_V(6); PG8_BAR;
    }
    for (;;) {
        const bool has_next = S.next(ui + 1, nxt);
        const char* nA = has_next ? (const char*)g.A + (size_t)nxt.pm * tstep : cA; const char* nB = has_next ? (const char*)g.Bt + (size_t)nxt.pn * tstep : cB;
        for (int t = 0; t < nt; t += 2) {
            const bool last = (t == nt - 2);
            const char* a1 = cA + (size_t)(t + 1) * kstep;
            const char* a2 = last ? nA : cA + (size_t)(t + 2) * kstep; const char* b2 = last ? nB : cB + (size_t)(t + 2) * kstep;
            const char* a3 = a2 + kstep; const char* b3 = b2 + kstep;
            if (last && has_next) S.a_ready(nxt);
            if constexpr (SP2) {
            PG8_LDB(B0, 0, 0); PG8_LDB(B1, 0, 1); PG8_SCHED; PG8_LDA(At, 0, 0); PG8_STAGE(PG8_SA(1, 1), a1 + hstep, voffA);
            PG8_WAIT_V(8); PG8_WAIT_L(0); PG8_BAR; PG8_MMA(0, 0, At, B0); PG8_MMA(0, 1, At, B1); PG8_BAR; PG8_SCHED;
            PG8_LDA(At, 0, 1); PG8_STAGE(PG8_SB(0, 0), b2, voffB); PG8_STAGE(PG8_SB(0, 1), b2 + hstep, voffB); PG8_STAGE(PG8_SA(0, 0), a2, voffA);
            PG8_WAIT_V(8); PG8_WAIT_L(0); PG8_BAR; PG8_MMA(1, 0, At, B0); PG8_MMA(1, 1, At, B1); PG8_BAR; PG8_SCHED;
            PG8_LDB(B0, 1, 0); PG8_LDB(B1, 1, 1); PG8_SCHED; PG8_LDA(At, 1, 0); PG8_STAGE(PG8_SA(0, 1), a2 + hstep, voffA);
            PG8_WAIT_V(8); PG8_WAIT_L(0); PG8_BAR; PG8_MMA(0, 0, At, B0); PG8_MMA(0, 1, At, B1); PG8_BAR; PG8_SCHED;
            PG8_LDA(At, 1, 1); PG8_STAGE(PG8_SB(1, 0), b3, voffB); PG8_STAGE(PG8_SB(1, 1), b3 + hstep, voffB); PG8_STAGE(PG8_SA(1, 0), a3, voffA);
            PG8_WAIT_V(8); PG8_WAIT_L(0); PG8_BAR; PG8_MMA(1, 0, At, B0); PG8_MMA(1, 1, At, B1); PG8_BAR; PG8_SCHED;
            } else {
            PG8_LDB(B0, 0, 0); PG8_SCHED; PG8_LDA(At, 0, 0); PG8_STAGE(PG8_SA(1, 1), a1 + hstep, voffA);
            PG8_WAIT_L(8); PG8_BAR; PG8_WAIT_L(0); PG8_MMA(0, 0, At, B0); PG8_BAR; PG8_SCHED;
            PG8_LDB(B1, 0, 1); PG8_STAGE(PG8_SB(0, 0), b2, voffB);
            PG8_BAR; PG8_WAIT_L(0); PG8_MMA(0, 1, At, B1); PG8_BAR;
            PG8_LDA(At, 0, 1); PG8_STAGE(PG8_SA(0, 0), a2, voffA);
            PG8_BAR; PG8_WAIT_L(0); PG8_MMA(1, 0, At, B0); PG8_BAR; PG8_SCHED;
            PG8_STAGE(PG8_SB(0, 1), b2 + hstep, voffB);
            PG8_WAIT_V(6); PG8_BAR; PG8_MMA(1, 1, At, B1); PG8_BAR;
            PG8_LDB(B0, 1, 0); PG8_SCHED; PG8_LDA(At, 1, 0); PG8_STAGE(PG8_SA(0, 1), a2 + hstep, voffA);
            PG8_WAIT_L(8); PG8_BAR; PG8_WAIT_L(0); PG8_MMA(0, 0, At, B0); PG8_BAR; PG8_SCHED;
            PG8_LDB(B1, 1, 1); PG8_STAGE(PG8_SB(1, 0), b3, voffB);
            PG8_BAR; PG8_WAIT_L(0); PG8_MMA(0, 1, At, B1); PG8_BAR;
            PG8_LDA(At, 1, 1); PG8_STAGE(PG8_SA(1, 0), a3, voffA);
            PG8_BAR; PG8_WAIT_L(0); PG8_MMA(1, 0, At, B0); PG8_BAR; PG8_SCHED;
            PG8_STAGE(PG8_SB(1, 1), b3 + hstep, voffB);
            PG8_WAIT_V(6); PG8_BAR; PG8_MMA(1, 1, At, B1); PG8_BAR;
            }
        }
        if constexpr (ALIGN_EPI) { if (wr == 0) PG8_BAR; }
        if constexpr (!Epi::AFTER_DRAIN) { E(acc, cur, wr, wc, fr, fq); S.done(cur); }
        if (!has_next) break;
#pragma unroll
        for (int a = 0; a < 2; ++a)
#pragma unroll
            for (int b = 0; b < 2; ++b)
#pragma unroll
                for (int m = 0; m < 4; ++m)
#pragma unroll
                    for (int n = 0; n < 2; ++n) acc[a][b][m][n] = (f32x4){0.f, 0.f, 0.f, 0.f};
        cur = nxt; cA = nA; cB = nB; ++ui;
        if constexpr (ALIGN_EPI) { if (wr == 1) PG8_BAR; }
    }
    PG8_WAIT_V(0);
    if constexpr (!ALIGN_EPI) { if (wr == 0) PG8_BAR; }
    PG8_BAR;
    if constexpr (Epi::AFTER_DRAIN) { E.fused(acc, cur, wr, wc, fr, fq, lds, wid, lane); S.done(cur); }
#undef PG8_SA
#undef PG8_SB
#undef PG8_STAGE
#undef PG8_LDA
#undef PG8_LDB
#undef PG8_MMA
#undef PG8_WAIT_V
#undef PG8_WAIT_L
#undef PG8_BAR
#undef PG8_SCHED
}
}
#define GAS __attribute__((address_space(1)))
#define LAS __attribute__((address_space(3)))
typedef unsigned short bf16;
typedef unsigned v4u __attribute__((ext_vector_type(4)));
typedef float f32x4 __attribute__((ext_vector_type(4)));
typedef short bf16x8 __attribute__((ext_vector_type(8)));
typedef GAS unsigned gu32;
typedef GAS unsigned long long gu64;
#define RLX_AGENT __ATOMIC_RELAXED, __HIP_MEMORY_SCOPE_AGENT
#define LDS_WAIT() asm volatile("s_waitcnt lgkmcnt(0)" ::: "memory")
#define VM_WAIT() asm volatile("s_waitcnt vmcnt(0)" ::: "memory")
__device__ __forceinline__ unsigned long long rt() { return __builtin_amdgcn_s_memrealtime(); }
__device__ __forceinline__ unsigned f2bf(float f) { unsigned u = __builtin_bit_cast(unsigned, f); return (u + 0x7fffu + ((u >> 16) & 1u)) >> 16; }
__device__ __forceinline__ unsigned pk2(float lo, float hi) { return f2bf(lo) | (f2bf(hi) << 16); }
#define XB_TMO      128
#define XB_XCNT(j)  (256  + 64 * (j))
#define XB_XSUB(j)  (1280 + 64 * (j))
#define XB_XGEN(j)  (2304 + 64 * (j))
#define XB_TOP      3328
#define XB_TOPGEN   3392
#define XCD_BAR_WORDS 3456
#define XB_SPIN_CAP (1u << 18)

__device__ __forceinline__ unsigned xb_ld(unsigned* p)              { return __hip_atomic_load(p, __ATOMIC_RELAXED, __HIP_MEMORY_SCOPE_AGENT); }
__device__ __forceinline__ unsigned xb_add(unsigned* p, unsigned v) { return __hip_atomic_fetch_add(p, v, __ATOMIC_RELAXED, __HIP_MEMORY_SCOPE_AGENT); }
__device__ __forceinline__ unsigned xb_xcc_id() { return (unsigned)__builtin_amdgcn_s_getreg((3 << 11) | 20) & 0xFu; }
#define XB_SPIN(cond, bar) do { unsigned _sp = 0; while (cond) { __builtin_amdgcn_s_sleep(1); \
    if ((++_sp & 255u) == 0u) { if (xb_ld(&(bar)[XB_TMO])) break; if (_sp > XB_SPIN_CAP) { atomicAdd(&(bar)[XB_TMO], 1u); break; } } } } while (0)

struct XcdBarrier {
    unsigned* bar; unsigned x;
    volatile LAS unsigned* st;
};

__device__ __forceinline__ XcdBarrier xcd_barrier_post(unsigned* bar, volatile LAS unsigned* st) {
    XcdBarrier b; b.bar = bar; b.x = xb_xcc_id(); b.st = st;
    if (threadIdx.x == 0) (void)xb_add(&bar[XB_XCNT(b.x)], 1u);
    return b;
}
__device__ __forceinline__ void xcd_barrier_complete(unsigned* bar, unsigned x, unsigned& nloc, unsigned& nx) {
    const unsigned G = gridDim.x * gridDim.y * gridDim.z;
    unsigned sum, cnt, mine, sp = 0u;
    for (;;) {
        sum = 0u; cnt = 0u; mine = 0u;
#pragma unroll
        for (unsigned j = 0; j < 16; ++j) { const unsigned c = xb_ld(&bar[XB_XCNT(j)]); sum += c; cnt += (c > 0u) ? 1u : 0u; mine = (j == x) ? c : mine; }
        if (sum == G) break;
        __builtin_amdgcn_s_sleep(1);
        if ((++sp & 255u) == 0u) { if (xb_ld(&bar[XB_TMO])) break; if (sp > XB_SPIN_CAP) { atomicAdd(&bar[XB_TMO], 1u); break; } }
    }
    nloc = mine > 0u ? mine : 1u; nx = cnt > 0u ? cnt : 1u;
}

__device__ __forceinline__ void xcd_barrier(const XcdBarrier& b) {
    asm volatile("s_waitcnt vmcnt(0)" ::: "memory");
    __syncthreads();
    if (threadIdx.x == 0) {
        unsigned* bar = b.bar;
        __builtin_amdgcn_s_waitcnt(0);
        unsigned nloc = b.st[0], nx = b.st[1];
        if (nloc == 0u) { xcd_barrier_complete(bar, b.x, nloc, nx); b.st[0] = nloc; b.st[1] = nx; }
        const unsigned old = xb_add(&bar[XB_XSUB(b.x)], 1u);
        const unsigned gen = old / nloc;
        if (old + 1u == (gen + 1u) * nloc) {
            __builtin_amdgcn_fence(__ATOMIC_RELEASE, "agent");
            asm volatile("s_waitcnt vmcnt(0)" ::: "memory");
            const unsigned og = xb_add(&bar[XB_TOP], 1u);
            const unsigned tg = og / nx;
            if (og + 1u == (tg + 1u) * nx) xb_add(&bar[XB_TOPGEN], 1u);
            else XB_SPIN(xb_ld(&bar[XB_TOPGEN]) == tg, bar);
            __builtin_amdgcn_fence(__ATOMIC_ACQUIRE, "agent");
            xb_add(&bar[XB_XGEN(b.x)], 1u);
            asm volatile("s_waitcnt vmcnt(0)" ::: "memory");
        } else {
            __builtin_amdgcn_fence(__ATOMIC_ACQUIRE, "agent");
            XB_SPIN(xb_ld(&bar[XB_XGEN(b.x)]) == gen, bar);
            asm volatile("s_waitcnt vmcnt(0)" ::: "memory");
        }
    }
    __syncthreads();
}
constexpr int NWAVES = 8;
constexpr size_t MiB = 1u << 20;
constexpr size_t WS_CTL = 0, CTL_ZERO_BYTES = 65536;
constexpr size_t WS_W1 = 1 * MiB, WS_WO = 6 * MiB, WS_WGU = 8 * MiB, WS_WD = 19 * MiB, WS_WPG = 25 * MiB, WS_WPP = 27 * MiB;
constexpr size_t WS_RX = 28 * MiB, WS_SS1 = 29 * MiB, WS_SS2 = 32 * MiB;
constexpr size_t WS_XB = 36 * MiB;
constexpr size_t WS_PB = 102 * MiB, WS_PP = 119 * MiB;
constexpr size_t WS_Q = 185 * MiB, WS_KP = 218 * MiB, WS_VP = 250 * MiB, WS_KS = 282 * MiB, WS_VS = 300 * MiB, WS_GLU = 318 * MiB, WS_MIX = 351 * MiB;
constexpr size_t WS_ACT = 185 * MiB;
constexpr size_t WS_END = 417 * MiB;
static_assert(WS_XB + (size_t)R * D * 2 <= WS_PB && WS_PB + (size_t)R * PLE * 2 <= WS_PP && WS_PP + (size_t)R * D * 2 <= WS_Q && WS_Q + (size_t)R * 512 * 2 <= WS_KP &&
              WS_KP + (size_t)(RP / 64) * KVT_BYTES <= WS_KS && WS_KS + (size_t)DB * 9 * KVT_BYTES <= WS_GLU && WS_GLU + (size_t)R * 512 * 2 <= WS_MIX &&
              WS_MIX + (size_t)R * D * 2 <= WS_END && WS_ACT + (size_t)R * DFF * 2 <= WS_END && WS_SS1 + (size_t)R * 64 <= WS_SS2 && WS_SS2 + (size_t)R * 64 <= WS_XB && WS_RX + (size_t)R * 4 <= WS_SS1, "d_ws map");
constexpr int CW_BAR = 4096, CW_Q = 8192, CW_QG = CW_Q + 64 * 32;
constexpr int RING_OFF = 0, RING_BYTES = 131072;
constexpr int LDSCTL_OFF = RING_BYTES, MISC_OFF = LDSCTL_OFF + 320;
constexpr int ATT_TAB = 132096, ATT_LSC = ATT_TAB + 8192;
constexpr int LDS_BYTES = 147456;
static_assert(ATT_LSC + 2048 <= LDS_BYTES && MISC_OFF + 128 <= ATT_TAB, "LDS map");

__device__ __forceinline__ float wave_sum(float v) {
#pragma unroll
    for (int o = 1; o < 64; o <<= 1) v += __shfl_xor(v, o);
    return v;
}
__device__ __forceinline__ float wave_max(float v) {
#pragma unroll
    for (int o = 1; o < 64; o <<= 1) v = fmaxf(v, __shfl_xor(v, o));
    return v;
}
__device__ __forceinline__ int map_win(int n) {
    if (n < 1536) { const int sec = n >> 9, nn = n & 511, h = nn >> 6, d = nn & 63; return sec * 512 + 256 * (h >> 2) + 128 * (d >> 5) + 32 * (h & 3) + (d & 31); }
    if (n < 2048) { const int i = n - 1536; return 1536 + 256 * (i >> 7) + (i & 127); }
    const int i = n - 2048; return 1536 + 256 * (i >> 7) + 128 + (i & 127);
}
__device__ __forceinline__ int map_gu(int n) {
    if (n < DFF) return 256 * (n >> 7) + (n & 127);
    const int i = n - DFF; return 256 * (i >> 7) + 128 + (i & 127);
}
template <int MAP> __device__ __forceinline__ void p0_transpose_item(const float* W, const float* gain, int K, int N, bf16* WT, LAS float* scr, int item, int lane) {
    const int nblk = N / 32, kb = item / nblk, nb = item % nblk, k0 = 64 * kb, n0 = 32 * nb;
    { const int nq = lane & 7, kr = lane >> 3; f32x4 v[8];
#pragma unroll
      for (int i = 0; i < 8; ++i) v[i] = *(const GAS f32x4*)(W + (size_t)(k0 + 8 * i + kr) * N + n0 + 4 * nq);
#pragma unroll
      for (int i = 0; i < 8; ++i) { const int kk = 8 * i + kr; const float gk = gain ? gain[k0 + kk] : 1.0f;
#pragma unroll
          for (int e = 0; e < 4; ++e) scr[kk * 33 + 4 * nq + e] = v[i][e] * gk; } }
    LDS_WAIT(); asm volatile("" ::: "memory");
    const int c = lane & 7;
#pragma unroll
    for (int j = 0; j < 4; ++j) { const int n = (lane >> 3) + 8 * j; const LAS float* s = scr + (8 * c) * 33 + n;
        v4u o; o.x = pk2(s[0 * 33], s[1 * 33]); o.y = pk2(s[2 * 33], s[3 * 33]); o.z = pk2(s[4 * 33], s[5 * 33]); o.w = pk2(s[6 * 33], s[7 * 33]);
        const int ns = n0 + n, dr = MAP == 0 ? ns : (MAP == 1 ? map_win(ns) : map_gu(ns));
        *(GAS v4u*)(WT + (size_t)dr * K + k0 + 8 * c) = o; }
    LDS_WAIT(); asm volatile("" ::: "memory");
}

namespace att {
typedef short bf16x8 __attribute__((ext_vector_type(8)));
typedef short s16x4 __attribute__((ext_vector_type(4)));
typedef float f32x16 __attribute__((ext_vector_type(16)));
typedef unsigned u32x4 __attribute__((ext_vector_type(4)));
typedef float f32x2_t __attribute__((ext_vector_type(2))); typedef __bf16 bf16x2_t __attribute__((ext_vector_type(2)));
typedef short v4i16_t __attribute__((ext_vector_type(4)));
typedef LAS const char* lds_cptr;
constexpr int BUFB = 65536, HSLOT = 16384;
__device__ __forceinline__ int crow(int r, int hi) { return (r & 3) + 8 * (r >> 2) + 4 * hi; }
__device__ __forceinline__ void glds16(const void* gsrc, unsigned lds_dst) { unsigned keep;
    asm volatile("s_mov_b32 %0, m0\n\ts_mov_b32 m0, %2\n\ts_nop 0\n\tglobal_load_lds_dwordx4 %1, off\n\ts_mov_b32 m0, %0" : "=&s"(keep) : "v"(gsrc), "s"(lds_dst) : "memory"); }
__device__ __forceinline__ unsigned cvtpk_s(float lo, float hi) { f32x2_t v = {lo, hi}; bf16x2_t b = __builtin_convertvector(v, bf16x2_t); return __builtin_bit_cast(unsigned, b); }
__device__ __forceinline__ s16x4 vtr(lds_cptr p) { return __builtin_bit_cast(s16x4, __builtin_amdgcn_ds_read_tr16_b64_v4i16((LAS v4i16_t*)p)); }
#define ATT_WAIT_BAR() asm volatile("s_waitcnt vmcnt(0) lgkmcnt(0)\n\ts_barrier" ::: "memory")

struct AUnit { const bf16* Qrow; const unsigned char* KV; bf16* Orow; int nt, hg, sample, c0rel; };

__device__ __forceinline__ void attn_prefetch(const AUnit& U, LAS unsigned char* lds, int wid, int lane, bf16x8 (&qr)[2][4]) {
    const int r32 = lane & 31, hi = lane >> 5, hl = wid & 3, ci = wid >> 2, head = 4 * U.hg + hl;
    const bool wact = !U.sample || ci == 0;
    const unsigned char* kvsrc = U.KV + U.hg * 65536 + wid * 1024 + lane * 16;
    const unsigned kvdst = (unsigned)(size_t)lds + wid * 1024;
#pragma unroll
    for (int j_ = 0; j_ < 8; ++j_) glds16(kvsrc + j_ * 8192, (unsigned)__builtin_amdgcn_readfirstlane(kvdst + j_ * 8192));
    const bf16* Qw = U.Qrow + (size_t)((wact ? 64 * ci : 0) + r32) * 512 + head * 64 + hi * 8; const bf16* Qw1 = Qw + (U.sample ? 0 : 32 * 512);
#pragma unroll
    for (int d0 = 0; d0 < 4; ++d0) { qr[0][d0] = *(const bf16x8*)(Qw + d0 * 16); qr[1][d0] = *(const bf16x8*)(Qw1 + d0 * 16); }
}
template <bool TWO> __device__ __forceinline__ void attn_steps(const AUnit& U, LAS unsigned char* lds, int wid, int lane, const bf16x8 (&qr)[2][4], f32x16 (&o)[2][2], float (&lsum)[2]) {
    const int r32 = lane & 31, hi = lane >> 5, hl = wid & 3, ci = wid >> 2, head = 4 * U.hg + hl, nt = U.nt, own = U.c0rel + ci;
    const bool wact = TWO || ci == 0;
    const unsigned lds0 = (unsigned)(size_t)lds;
    const LAS float* tabh = (const LAS float*)(lds + ATT_TAB) + head * 256;
    const unsigned char* kvsrc = U.KV + U.hg * 65536 + wid * 1024 + lane * 16;
    const unsigned kvdst = lds0 + wid * 1024;
#define ATT_DMA(ti, b) do { _Pragma("unroll") for (int j_ = 0; j_ < 8; ++j_) \
        glds16(kvsrc + (size_t)(ti) * KVT_BYTES + j_ * 8192, (unsigned)__builtin_amdgcn_readfirstlane(kvdst + (b) * BUFB + j_ * 8192)); } while (0)
    for (int ti = 0; ti < nt; ++ti) {
        ATT_WAIT_BAR();
        const int b = ti & 1;
        if (ti + 1 < nt) ATT_DMA(ti + 1, b ^ 1);
        const int jt = own - ti;
        if (wact && jt >= 0 && jt <= 8) {
            const float m1 = (!TWO && jt == 0) ? 0.f : 1.f;
            const lds_cptr kp = (lds_cptr)(lds + b * BUFB + hl * HSLOT + hi * 1024 + r32 * 16);
            bf16x8 kf[8];
            { const unsigned ka = (unsigned)(size_t)kp;
              asm volatile("ds_read_b128 %0, %8\n\tds_read_b128 %1, %8 offset:512\n\tds_read_b128 %2, %8 offset:2048\n\tds_read_b128 %3, %8 offset:2560\n\t"
                           "ds_read_b128 %4, %8 offset:4096\n\tds_read_b128 %5, %8 offset:4608\n\tds_read_b128 %6, %8 offset:6144\n\tds_read_b128 %7, %8 offset:6656\n\ts_waitcnt lgkmcnt(0)"
                           : "=&v"(kf[0]), "=&v"(kf[1]), "=&v"(kf[2]), "=&v"(kf[3]), "=&v"(kf[4]), "=&v"(kf[5]), "=&v"(kf[6]), "=&v"(kf[7]) : "v"(ka) : "memory");
              __builtin_amdgcn_sched_barrier(0); }
            f32x16 s[2][2]; s[0][0] = f32x16{}; s[0][1] = f32x16{}; s[1][0] = f32x16{}; s[1][1] = f32x16{};
#pragma unroll
            for (int h2 = 0; h2 < (TWO ? 2 : 1); ++h2)
#pragma unroll
                for (int d0 = 0; d0 < 4; ++d0) { s[h2][0] = __builtin_amdgcn_mfma_f32_32x32x16_bf16(kf[2 * d0], qr[h2][d0], s[h2][0], 0, 0, 0);
                                                 s[h2][1] = __builtin_amdgcn_mfma_f32_32x32x16_bf16(kf[2 * d0 + 1], qr[h2][d0], s[h2][1], 0, 0, 0); }
            u32x4 pw[2][4];
#pragma unroll
            for (int h2 = 0; h2 < (TWO ? 2 : 1); ++h2) {
                f32x16& p0 = s[h2][0]; f32x16& p1 = s[h2][1];
                if (jt < 3) { const LAS float* tp = tabh + (191 - (32 * h2 + r32) - 64 * jt + 4 * hi);
#pragma unroll
                    for (int r = 0; r < 16; ++r) { p0[r] += tp[(r & 3) + 8 * (r >> 2)]; p1[r] += tp[32 + (r & 3) + 8 * (r >> 2)]; } }
                float sacc = 0.f;
#pragma unroll
                for (int r = 0; r < 16; ++r) { p0[r] = __builtin_amdgcn_exp2f(p0[r]); p1[r] = __builtin_amdgcn_exp2f(p1[r]); if (!TWO) p1[r] *= m1; sacc += p0[r] + p1[r]; }
                lsum[h2] += sacc;
#pragma unroll
                for (int k = 0; k < 2; ++k) { pw[h2][k] = (u32x4){cvtpk_s(p0[8 * k], p0[8 * k + 1]), cvtpk_s(p0[8 * k + 2], p0[8 * k + 3]), cvtpk_s(p0[8 * k + 4], p0[8 * k + 5]), cvtpk_s(p0[8 * k + 6], p0[8 * k + 7])};
                    pw[h2][2 + k] = (u32x4){cvtpk_s(p1[8 * k], p1[8 * k + 1]), cvtpk_s(p1[8 * k + 2], p1[8 * k + 3]), cvtpk_s(p1[8 * k + 4], p1[8 * k + 5]), cvtpk_s(p1[8 * k + 6], p1[8 * k + 7])}; }
            }
            const lds_cptr vp = (lds_cptr)(lds + b * BUFB + hl * HSLOT + 8192 + ((lane >> 4) & 1) * 32 + (lane & 3) * 8 + (4 * hi + ((lane & 15) >> 2)) * 64);
            const unsigned va = (unsigned)(size_t)vp;
#pragma unroll
            for (int d0 = 0; d0 < 2; ++d0) {
                s16x4 lo[4], hh[4];
                asm volatile("ds_read_b64_tr_b16 %0, %8 offset:%c9\n\tds_read_b64_tr_b16 %1, %8 offset:%c10\n\tds_read_b64_tr_b16 %2, %8 offset:%c11\n\tds_read_b64_tr_b16 %3, %8 offset:%c12\n\t"
                             "ds_read_b64_tr_b16 %4, %8 offset:%c13\n\tds_read_b64_tr_b16 %5, %8 offset:%c14\n\tds_read_b64_tr_b16 %6, %8 offset:%c15\n\tds_read_b64_tr_b16 %7, %8 offset:%c16\n\ts_waitcnt lgkmcnt(0)"
                             : "=&v"(lo[0]), "=&v"(hh[0]), "=&v"(lo[1]), "=&v"(hh[1]), "=&v"(lo[2]), "=&v"(hh[2]), "=&v"(lo[3]), "=&v"(hh[3])
                             : "v"(va), "i"(d0 * 4096), "i"(d0 * 4096 + 512), "i"(d0 * 4096 + 1024), "i"(d0 * 4096 + 1536), "i"(d0 * 4096 + 2048), "i"(d0 * 4096 + 2560), "i"(d0 * 4096 + 3072), "i"(d0 * 4096 + 3584) : "memory");
                __builtin_amdgcn_sched_barrier(0);
#pragma unroll
                for (int ks = 0; ks < 4; ++ks) {
                    const bf16x8 vf = (bf16x8){lo[ks][0], lo[ks][1], lo[ks][2], lo[ks][3], hh[ks][0], hh[ks][1], hh[ks][2], hh[ks][3]};
                    o[0][d0] = __builtin_amdgcn_mfma_f32_32x32x16_bf16(__builtin_bit_cast(bf16x8, pw[0][ks]), vf, o[0][d0], 0, 0, 0);
                    if (TWO) o[1][d0] = __builtin_amdgcn_mfma_f32_32x32x16_bf16(__builtin_bit_cast(bf16x8, pw[1][ks]), vf, o[1][d0], 0, 0, 0); }
            }
        }
    }
#undef ATT_DMA
}
template <bool TWO> __device__ __forceinline__ void attn_store(const AUnit& U, LAS unsigned char* lds, int wid, int lane, const f32x16 (&o)[2][2], const float (&lsum)[2]) {
    const int r32 = lane & 31, hi = lane >> 5, hl = wid & 3, ci = wid >> 2, head = 4 * U.hg + hl;
    const bool wact = TWO || ci == 0;
    LAS float* lsc = (LAS float*)(lds + ATT_LSC) + wid * 64;
    if (wact) {
#pragma unroll
        for (int h2 = 0; h2 < (TWO ? 2 : 1); ++h2) {
            float ls = lsum[h2];
            { auto rr = __builtin_amdgcn_permlane32_swap(__float_as_uint(ls), __float_as_uint(ls), false, false); ls = __uint_as_float(rr[0]) + __uint_as_float(rr[1]); }
            if (hi == 0) lsc[32 * h2 + r32] = ls;
            asm volatile("s_waitcnt lgkmcnt(0)" ::: "memory");
            LAS bf16* stg = (LAS bf16*)(lds + BUFB + wid * 8192 + h2 * 4096);
#pragma unroll
            for (int r = 0; r < 16; ++r) { const int orow = crow(r, hi); const float rl = __builtin_amdgcn_rcpf(lsc[32 * h2 + orow]);
#pragma unroll
                for (int d0 = 0; d0 < 2; ++d0) stg[orow * 64 + d0 * 32 + r32] = (bf16)f2bf(o[h2][d0][r] * rl); }
            asm volatile("s_waitcnt lgkmcnt(0)" ::: "memory");
            bf16* Ow = U.Orow + (size_t)(64 * ci + 32 * h2) * D + head * 64;
#pragma unroll
            for (int i = 0; i < 4; ++i) { const int row = i * 8 + (lane >> 3), ch = lane & 7; const u32x4 v = *(const LAS u32x4*)(stg + row * 64 + ch * 8); *(u32x4*)(Ow + (size_t)row * D + ch * 8) = v; }
        }
    }
}
}

__device__ __forceinline__ float wave_sum_dpp(float v) {
#define DPP_ADD(ctrl, rmask) v += __builtin_bit_cast(float, __builtin_amdgcn_update_dpp(0, __builtin_bit_cast(int, v), ctrl, rmask, 0xf, true))
    DPP_ADD(0x111, 0xf); DPP_ADD(0x112, 0xf); DPP_ADD(0x114, 0xf); DPP_ADD(0x118, 0xf); DPP_ADD(0x142, 0xa); DPP_ADD(0x143, 0xc);
#undef DPP_ADD
    return __builtin_bit_cast(float, __builtin_amdgcn_readlane(__builtin_bit_cast(int, v), 63));
}
#define CV_WAIT_BAR(N) asm volatile("s_waitcnt vmcnt(" #N ") lgkmcnt(0)\n\ts_barrier" ::: "memory")
typedef float f32x2v __attribute__((ext_vector_type(2)));
struct ConvConst { f32x2v w[CONVW]; f32x2v bias; };
__device__ __forceinline__ void conv_consts(ConvConst& C, const float* cw, const float* cb, int tid) {
    const int cp = tid & 255;
#pragma unroll
    for (int j = 0; j < CONVW; ++j) C.w[j] = *(const f32x2v*)(cw + j * CW + 2 * cp);
    C.bias = *(const f32x2v*)(cb + 2 * cp);
}
__device__ __forceinline__ void conv_entry(int e, const ConvConst& C, const bf16* GLU, const float* st, const float* lg, const float* lb, bf16* MIX, LAS unsigned char* lds, int tid) {
    const bool samp = e >= RP / 64; const int b = samp ? e - RP / 64 : e >> 7, t0 = samp ? 0 : (e & 127) * 64, nb = samp ? 2 : 4, rowbase = samp ? RP + DS * b : b * SEQ;
    const int wid = __builtin_amdgcn_readfirstlane(tid >> 6), lane = tid & 63, cp = tid & 255, th = tid >> 8;
    const bool first = t0 == 0;
    LAS bf16* xs = (LAS bf16*)lds;
    LAS float* ybuf = (LAS float*)(lds + 98304);
    const unsigned lds0 = (unsigned)(size_t)lds;
    const int tlast = t0 + 16 * nb - 1;
    f32x4 g0 = *(const f32x4*)(lg + 8 * lane), g1 = *(const f32x4*)(lg + 8 * lane + 4), b0 = *(const f32x4*)(lb + 8 * lane), b1 = *(const f32x4*)(lb + 8 * lane + 4);
    asm volatile("" : "+v"(g0), "+v"(g1), "+v"(b0), "+v"(b1));
#pragma unroll
    for (int i = 0; i < 12; ++i) { const int k = wid + 8 * i; int tp = t0 - CH + k; tp = tp > tlast ? tlast : tp;
        if (tp >= 0) att::glds16(GLU + (size_t)(rowbase + tp) * 512 + 8 * lane, (unsigned)__builtin_amdgcn_readfirstlane(lds0 + (unsigned)k * 1024u));
        else { pg8::u32x4 v = (pg8::u32x4){0u, 0u, 0u, 0u};
            if (samp) { const float* sp = st + ((size_t)b * CH + (CH + tp)) * CW + 8 * lane; v = pg8::pack8(*(const f32x4*)sp, *(const f32x4*)(sp + 4)); }
            *(LAS pg8::u32x4*)(xs + k * 512 + 8 * lane) = v; } }
    for (int s = 0; s < nb; ++s) {
        if (first || s == 3) CV_WAIT_BAR(0); else if (s == 0) CV_WAIT_BAR(6); else if (s == 1) CV_WAIT_BAR(4); else CV_WAIT_BAR(2);
        {
            f32x2v x[38];
            const LAS unsigned* xp = (const LAS unsigned*)(xs + (16 * s + 8 * th) * 512 + 2 * cp);
#pragma unroll
            for (int k = 0; k < 38; ++k) { const unsigned u = xp[k * 256]; x[k] = (f32x2v){__uint_as_float(u << 16), __uint_as_float(u & 0xffff0000u)}; }
            f32x2v y[8];
#pragma unroll
            for (int i = 0; i < 8; ++i) y[i] = C.bias;
#pragma unroll
            for (int j = 0; j < CONVW; ++j)
#pragma unroll
                for (int i = 0; i < 8; ++i) y[i] = __builtin_elementwise_fma(C.w[j], x[i + j], y[i]);
#pragma unroll
            for (int i = 0; i < 8; ++i) *(LAS f32x2v*)(ybuf + (8 * th + i) * 512 + 2 * cp) = y[i];
        }
        __syncthreads();
#pragma unroll
        for (int q = 0; q < 2; ++q) { const int i = 2 * wid + q;
            f32x4 v0 = *(const LAS f32x4*)(ybuf + i * 512 + 8 * lane), v1 = *(const LAS f32x4*)(ybuf + i * 512 + 8 * lane + 4);
            const float mean = wave_sum_dpp((v0[0] + v0[1]) + (v0[2] + v0[3]) + (v1[0] + v1[1]) + (v1[2] + v1[3])) * (1.0f / CW);
            v0 = v0 - mean; v1 = v1 - mean;
            const f32x4 q0 = v0 * v0, q1 = v1 * v1;
            const float rstd = rsqrtf(wave_sum_dpp((q0[0] + q0[1]) + (q0[2] + q0[3]) + (q1[0] + q1[1]) + (q1[2] + q1[3])) * (1.0f / CW) + EPS);
            v0 = v0 * rstd * g0 + b0; v1 = v1 * rstd * g1 + b1;
#pragma unroll
            for (int e2 = 0; e2 < 4; ++e2) { v0[e2] *= pg8::sigm(v0[e2]); v1[e2] *= pg8::sigm(v1[e2]); }
            *(pg8::u32x4*)(MIX + (size_t)(rowbase + t0 + 16 * s + i) * D + 512 + 8 * lane) = pg8::pack8(v0, v1); }
        __syncthreads();
    }
}

constexpr int SG_LD = 68;
#define SG_WAIT_BAR(N) asm volatile("s_waitcnt vmcnt(" #N ") lgkmcnt(0)\n\ts_barrier" ::: "memory")
template <class Epi> __device__ __forceinline__ void sgemm64(const bf16* A, const bf16* Bt, int K_, int tile, const Epi& E, LAS unsigned char* lds) {
    int tid_ = threadIdx.x; asm volatile("" : "+v"(tid_)); int K = K_; asm volatile("" : "+s"(K));
    const int lane = tid_ & 63, wave = __builtin_amdgcn_readfirstlane(tid_ >> 6), fr = lane & 15, fq = lane >> 4, wm = wave & 3, wn = wave >> 2, tr = tile >> 4, tc = tile & 15;
    const int KS = K >> 7;
    const unsigned char* src[4]; unsigned dsto[4];
#pragma unroll
    for (int i = 0; i < 4; ++i) { const int p = wave + 8 * i, r = 4 * (p & 15) + (lane >> 4), cs = (lane & 15) ^ (r & 15);
        src[i] = (const unsigned char*)((p < 16 ? A + (size_t)(64 * tr + r) * K : Bt + (size_t)(64 * tc + r) * K)) + cs * 16;
        dsto[i] = (p < 16 ? 0u : 16384u) + (unsigned)(p & 15) * 1024u; }
    const unsigned lds0 = (unsigned)(size_t)lds;
#define SG_STAGE(t) do { _Pragma("unroll") for (int i_ = 0; i_ < 4; ++i_) att::glds16(src[i_] + (size_t)(t) * 256, (unsigned)__builtin_amdgcn_readfirstlane(lds0 + (unsigned)((t) & 3) * 32768u + dsto[i_])); } while (0)
    f32x4 acc0 = (f32x4){0.f, 0.f, 0.f, 0.f}, acc1 = acc0;
    SG_STAGE(0); if (KS > 1) SG_STAGE(1); if (KS > 2) SG_STAGE(2);
    const unsigned ra = (unsigned)(16 * wm + fr) * 256u, rb = 16384u + (unsigned)(32 * wn + fr) * 256u;
    for (int t = 0; t < KS; ++t) {
        if (t + 2 < KS) SG_WAIT_BAR(8); else if (t + 1 < KS) SG_WAIT_BAR(4); else SG_WAIT_BAR(0);
        if (t + 3 < KS) SG_STAGE(t + 3);
        const LAS unsigned char* sb = lds + (t & 3) * 32768;
#pragma unroll
        for (int ks = 0; ks < 4; ++ks) { const unsigned ch = (unsigned)((4 * ks + fq) ^ fr) * 16u;
            const bf16x8 a = *(const LAS bf16x8*)(sb + ra + ch), b0 = *(const LAS bf16x8*)(sb + rb + ch), b1 = *(const LAS bf16x8*)(sb + rb + 4096 + ch);
            acc0 = __builtin_amdgcn_mfma_f32_16x16x32_bf16(b0, a, acc0, 0, 0, 0); acc1 = __builtin_amdgcn_mfma_f32_16x16x32_bf16(b1, a, acc1, 0, 0, 0); }
    }
#undef SG_STAGE
    SG_WAIT_BAR(0);
    LAS float* part = (LAS float*)lds;
    *(LAS f32x4*)(part + (16 * wm + fr) * SG_LD + 32 * wn + 4 * fq) = acc0; *(LAS f32x4*)(part + (16 * wm + fr) * SG_LD + 32 * wn + 16 + 4 * fq) = acc1;
    __syncthreads();
    const int row = tid_ >> 3, c8 = (tid_ & 7) * 8;
    const f32x4 v0 = *(const LAS f32x4*)(part + row * SG_LD + c8), v1 = *(const LAS f32x4*)(part + row * SG_LD + c8 + 4);
    E(64 * tr + row, 64 * tc + c8, tc, tid_ & 7, v0, v1);
    __syncthreads();
}
__device__ __forceinline__ float oct_sum(float s) { s += __shfl_xor(s, 1); s += __shfl_xor(s, 2); s += __shfl_xor(s, 4); return s; }
template <bool BF> struct SEpiRes {
    const float* base; bf16* HB; float* SS;
    __device__ __forceinline__ void operator()(int row, int col, int tc, int l8, f32x4 v0, f32x4 v1) const {
        const size_t o = (size_t)row * D + col;
        if (BF) { const pg8::u32x4 w = *(const pg8::u32x4*)(HB + o); v0 = v0 + pg8::bf_lo4(w); v1 = v1 + pg8::bf_hi4(w); }
        else { v0 = v0 + *(const f32x4*)(base + o); v1 = v1 + *(const f32x4*)(base + o + 4); }
        *(pg8::u32x4*)(HB + o) = pg8::pack8(v0, v1);
        const f32x4 q0 = v0 * v0, q1 = v1 * v1;
        const float ss = oct_sum(((q0[0] + q0[1]) + (q0[2] + q0[3])) + ((q1[0] + q1[1]) + (q1[2] + q1[3])));
        if (l8 == 0) SS[(size_t)row * 16 + tc] = ss;
    }
};
struct SEpiPP {
    bf16* PP;
    __device__ __forceinline__ void operator()(int row, int col, int tc, int l8, f32x4 v0, f32x4 v1) const { *(pg8::u32x4*)(PP + (size_t)row * D + col) = pg8::pack8(v0, v1); }
};
struct SEpiFinal {
    const float* SS; const bf16* PP; const bf16* HB; float* Y;
    __device__ __forceinline__ void operator()(int row, int col, int tc, int l8, f32x4 v0, f32x4 v1) const {
        const float r = rsqrtf(oct_sum(SS[(size_t)row * 16 + 2 * l8] + SS[(size_t)row * 16 + 2 * l8 + 1]) * (1.0f / D) + EPS);
        const size_t o = (size_t)row * D + col;
        const pg8::u32x4 pw = *(const pg8::u32x4*)(PP + o), hw = *(const pg8::u32x4*)(HB + o);
        const f32x4 p0 = pg8::bf_lo4(pw), p1 = pg8::bf_hi4(pw); f32x4 h0 = pg8::bf_lo4(hw), h1 = pg8::bf_hi4(hw);
#pragma unroll
        for (int e = 0; e < 4; ++e) { h0[e] += pg8::sigm(v0[e] * r) * p0[e]; h1[e] += pg8::sigm(v1[e] * r) * p1[e]; }
        *(f32x4*)(Y + o) = h0; *(f32x4*)(Y + o + 4) = h1;
    }
};

#ifndef REP_P0
#define REP_P0 1
#endif
#ifndef REP_P1
#define REP_P1 1
#endif
#ifndef REP_P2
#define REP_P2 1
#endif
#ifndef REP_P3
#define REP_P3 1
#endif
#ifndef REP_P4
#define REP_P4 1
#endif
struct Args { const float* in[23]; float* out; unsigned char* ws; };
constexpr int N_ATT_S = 2 * DB, N_ATT_P = NB * 64 * 2, N_CONV = RP / 64 + DB;
constexpr int I_WO = (D / 64) * (D / 32), I_WGU = (D / 64) * (2 * DFF / 32), N_WCV = (I_WO + I_WGU) / 8;
constexpr int N_ATT_Q = 8 + 64;
static_assert((I_WO + I_WGU) % 8 == 0, "weight conversion entries");
#define W1t ((bf16*)(ws + WS_W1))
#define WOt ((bf16*)(ws + WS_WO))
#define WGUt ((bf16*)(ws + WS_WGU))
#define WDt ((bf16*)(ws + WS_WD))
#define WPGt ((bf16*)(ws + WS_WPG))
#define WPPt ((bf16*)(ws + WS_WPP))
#define RX ((float*)(ws + WS_RX))
#define SS1 ((float*)(ws + WS_SS1))
#define SS2 ((float*)(ws + WS_SS2))
#define XB ((bf16*)(ws + WS_XB))
#define PB ((bf16*)(ws + WS_PB))
#define PPb ((bf16*)(ws + WS_PP))
#define Qb ((bf16*)(ws + WS_Q))
#define KVP (ws + WS_KP)
#define KVS (ws + WS_KS)
#define GLUb ((bf16*)(ws + WS_GLU))
#define MIXb ((bf16*)(ws + WS_MIX))
#define ACTb ((bf16*)(ws + WS_ACT))
#define Y (out + OY)
__global__ void __launch_bounds__(NWAVES * 64, 2) mk_fwd(Args args) {
    extern __shared__ __attribute__((aligned(16))) unsigned char lds_[];
    LAS unsigned char* lds = (LAS unsigned char*)lds_;
    volatile LAS unsigned* MISC = (volatile LAS unsigned*)(lds + MISC_OFF);
    const int G = gridDim.x, vcu = (G % 8 == 0) ? ((int)blockIdx.x % 8) * (G / 8) + (int)blockIdx.x / 8 : (int)blockIdx.x;
    unsigned char* ws = args.ws; float* out = args.out;
    gu32* ctl = (gu32*)(ws + WS_CTL);
    for (int u = threadIdx.x; u < (ATT_TAB - LDSCTL_OFF) / 4; u += NWAVES * 64) ((LAS unsigned*)(lds + LDSCTL_OFF))[u] = 0u;
    __syncthreads();
    XcdBarrier bar = xcd_barrier_post((unsigned*)(ctl + CW_BAR), MISC + 8);

#ifndef SKIP_P0
    for (int rep = 0; rep < REP_P0; ++rep) {
        if (rep) xcd_barrier(bar);
        int tid0 = threadIdx.x; asm volatile("" : "+v"(tid0));
        const int lane = tid0 & 63, wave = __builtin_amdgcn_readfirstlane(tid0 >> 6);
        LAS float* scr = (LAS float*)(lds + RING_OFF + wave * 16384);
        const int gw = vcu * NWAVES + wave, NGW = G * NWAVES;
        constexpr int I_1 = (D / 64) * (INC / 32);
        for (int it = gw; it < I_1; it += NGW) p0_transpose_item<1>(args.in[8], args.in[7], D, INC, W1t, scr, it, lane);
        for (int m2 = gw; m2 < R / 2; m2 += NGW) {
            f32x4 v[2][4];
#pragma unroll
            for (int rr = 0; rr < 2; ++rr) { const int m = 2 * m2 + rr; const float* xrow = m < RP ? args.in[0] + (size_t)m * D : args.in[1] + (size_t)(m - RP) * D;
                const GAS f32x4* xr = (const GAS f32x4*)xrow + lane;
#pragma unroll
                for (int j = 0; j < 4; ++j) v[rr][j] = xr[64 * j]; }
#pragma unroll
            for (int rr = 0; rr < 2; ++rr) { const int m = 2 * m2 + rr; float s = 0.f;
#pragma unroll
                for (int j = 0; j < 4; ++j) s += (v[rr][j].x * v[rr][j].x + v[rr][j].y * v[rr][j].y) + (v[rr][j].z * v[rr][j].z + v[rr][j].w * v[rr][j].w);
                s = wave_sum(s); if (lane == 0) RX[m] = rsqrtf(s * (1.0f / D) + EPS);
                GAS unsigned long long* o8 = (GAS unsigned long long*)(XB + (size_t)m * D) + lane;
#pragma unroll
                for (int j = 0; j < 4; ++j) o8[64 * j] = (unsigned long long)pk2(v[rr][j].x, v[rr][j].y) | ((unsigned long long)pk2(v[rr][j].z, v[rr][j].w) << 32); }
        }
    }
#endif
    xcd_barrier(bar);

#ifndef SKIP_P1
    for (int rep = 0; rep < REP_P1; ++rep) {
        if (rep) xcd_barrier(bar);
        pg8::Gemm g{XB, W1t, R, INC, D}; pg8::StaticOrder S; S.init(R, INC, G, (int)blockIdx.x);
        pg8::Epi1 E{RX, args.in[9], args.in[10], Qb, KVP, KVS, GLUb, out};
        pg8::gemm_phase<pg8::Epi1, pg8::StaticOrder, true, true>(lds + RING_OFF, g, S, E);
        { const int c0 = ((R / 256) * (INC / 256)) % G, nwgc = c0 ? G - c0 : G, cc = c0 ? (int)blockIdx.x - c0 : (int)blockIdx.x;
          if (cc >= 0) {
            int tidc = threadIdx.x; asm volatile("" : "+v"(tidc));
            const int lane = tidc & 63, wave = __builtin_amdgcn_readfirstlane(tidc >> 6), head = lane >> 3, dq = lane & 7;
            for (int m2 = cc * NWAVES + wave; m2 < DB * 512; m2 += nwgc * NWAVES) {
                const int b = m2 >> 9, j = m2 & 511, kv = j & 63;
                const GAS f32x4* sk = (const GAS f32x4*)(args.in[4] + (size_t)m2 * 512) + 2 * lane; const GAS f32x4* sv = (const GAS f32x4*)(args.in[5] + (size_t)m2 * 512) + 2 * lane;
                const f32x4 k0 = sk[0], k1 = sk[1], v0 = sv[0], v1 = sv[1];
                unsigned char* tb = KVS + (size_t)(b * 9 + (j >> 6)) * KVT_BYTES + (head >> 2) * 65536 + (head & 3) * 16384;
                *(GAS v4u*)(tb + dq * 1024 + kv * 16) = (v4u){pk2(k0.x, k0.y), pk2(k0.z, k0.w), pk2(k1.x, k1.y), pk2(k1.z, k1.w)};
                *(GAS v4u*)(tb + 8192 + (dq >> 2) * 4096 + (kv >> 4) * 1024 + (kv & 15) * 64 + (dq & 3) * 16) = (v4u){pk2(v0.x, v0.y), pk2(v0.z, v0.w), pk2(v1.x, v1.y), pk2(v1.z, v1.w)};
            }
            for (int p = cc * NWAVES + wave; p < DB * NH; p += nwgc * NWAVES) {
                unsigned char* tb = KVS + (size_t)((p >> 3) * 9 + 8) * KVT_BYTES + ((p & 7) >> 2) * 65536 + (p & 3) * 16384; const v4u z = (v4u){0u, 0u, 0u, 0u};
#pragma unroll
                for (int c2 = 0; c2 < 4; ++c2) *(GAS v4u*)(tb + (2 * c2 + (lane >> 5)) * 1024 + 512 + (lane & 31) * 16) = z;
#pragma unroll
                for (int q = 0; q < 4; ++q) *(GAS v4u*)(tb + 8192 + (q >> 1) * 4096 + (2 + (q & 1)) * 1024 + lane * 16) = z;
            }
          } }
    }
#endif
    xcd_barrier(bar);

#ifndef SKIP_P2
    for (int rep = 0; rep < REP_P2; ++rep) {
        if (rep) xcd_barrier(bar);
        { int tidt = threadIdx.x; asm volatile("" : "+v"(tidt)); const int lane = tidt & 63, wave = __builtin_amdgcn_readfirstlane(tidt >> 6);
          const float* relb = args.in[11] + wave * NREL; LAS float* T = (LAS float*)(lds + ATT_TAB) + wave * 256;
          const float bfar = relb[256];
          for (int x = lane; x < 256; x += 64) { int dd = 191 - x; dd = dd < -128 ? -128 : (dd > 128 ? 128 : dd); T[x] = (relb[dd + 128] - bfar) * LOG2E; } }
        __syncthreads();
        {
            int tid2 = threadIdx.x; asm volatile("" : "+v"(tid2));
            const int lane2 = tid2 & 63, wave2 = __builtin_amdgcn_readfirstlane(tid2 >> 6);
            int qk = 0, q = (int)blockIdx.x & 7;
#define ATT_POP(qq) ((int)__hip_atomic_fetch_add((unsigned*)(ctl + CW_Q + 64 * ((qq) + 8 * rep)), 1u, __ATOMIC_RELAXED, __HIP_MEMORY_SCOPE_AGENT))
#define ATT_DECODE(code, U) do { const int q_ = (int)((code) >> 8), i_ = (int)((code) & 255u); \
                if (i_ < 8) { const int sb = 4 * q_ + (i_ >> 1); U.hg = i_ & 1; U.sample = 1; U.nt = 9; U.c0rel = 8; \
                    U.Qrow = Qb + (size_t)(RP + DS * sb) * 512; U.KV = KVS + (size_t)(sb * 9) * KVT_BYTES; U.Orow = MIXb + (size_t)(RP + DS * sb) * D; } \
                else { const int j = i_ - 8, pi = j < 60 ? 4 + j : 63 - j, bb = q_ >> 1, c0 = 2 * pi;     \
                    U.hg = q_ & 1; U.sample = 0; U.c0rel = c0 < 8 ? c0 : 8; U.nt = U.c0rel + 2; const size_t row0 = (size_t)bb * SEQ + 64 * c0; \
                    U.Qrow = Qb + row0 * 512; U.KV = KVP + (size_t)(bb * 128 + c0 - U.c0rel) * KVT_BYTES; U.Orow = MIXb + row0 * D; } } while (0)
            if (tid2 == 0) { int i = ATT_POP(q); while (i >= N_ATT_Q) { if (++qk == 8) { i = -1; break; } q = ((int)blockIdx.x + qk) & 7; i = ATT_POP(q); }
                MISC[4] = i < 0 ? 0xffffffffu : (unsigned)((q << 8) | i); }
            __syncthreads();
            unsigned code = MISC[4];
            if (code != 0xffffffffu) {
                att::AUnit U; ATT_DECODE(code, U);
                att::bf16x8 qr[2][4];
                att::attn_prefetch(U, lds, wave2, lane2, qr);
                for (;;) {
                    int nraw = 0; if (tid2 == 0) nraw = ATT_POP(q);
#pragma unroll
                    for (int d0 = 0; d0 < 4; ++d0) asm volatile("" : "+v"(qr[0][d0]), "+v"(qr[1][d0]));
                    att::f32x16 o[2][2]; o[0][0] = att::f32x16{}; o[0][1] = att::f32x16{}; o[1][0] = att::f32x16{}; o[1][1] = att::f32x16{}; float lsum[2] = {0.f, 0.f};
                    if (U.sample) att::attn_steps<false>(U, lds, wave2, lane2, qr, o, lsum); else att::attn_steps<true>(U, lds, wave2, lane2, qr, o, lsum);
                    if (tid2 == 0) { int i = nraw; while (i >= N_ATT_Q) { if (++qk == 8) { i = -1; break; } q = ((int)blockIdx.x + qk) & 7; i = ATT_POP(q); }
                        MISC[4] = i < 0 ? 0xffffffffu : (unsigned)((q << 8) | i); }
                    ATT_WAIT_BAR();
                    const unsigned ncode = MISC[4];
                    att::AUnit Un = U;
                    if (ncode != 0xffffffffu) { ATT_DECODE(ncode, Un); att::attn_prefetch(Un, lds, wave2, lane2, qr); }
                    if (U.sample) att::attn_store<false>(U, lds, wave2, lane2, o, lsum); else att::attn_store<true>(U, lds, wave2, lane2, o, lsum);
                    if (ncode == 0xffffffffu) break;
                    U = Un;
                }
                ATT_WAIT_BAR();
            }
#undef ATT_POP
#undef ATT_DECODE
        }
        ConvConst CC; { int tidc = threadIdx.x; asm volatile("" : "+v"(tidc)); conv_consts(CC, args.in[12], args.in[13], tidc); }
        for (;;) {
            int tid2 = threadIdx.x; asm volatile("" : "+v"(tid2));
            if (tid2 == 0) MISC[4] = __hip_atomic_fetch_add((unsigned*)(ctl + CW_QG + 64 * rep), 1u, __ATOMIC_RELAXED, __HIP_MEMORY_SCOPE_AGENT);
            __syncthreads();
            const int idx = (int)MISC[4];
            __syncthreads();
            if (idx >= N_CONV + N_WCV) break;
            const int lane2 = tid2 & 63, wave2 = __builtin_amdgcn_readfirstlane(tid2 >> 6);
            if (idx < N_CONV) conv_entry(idx, CC, GLUb, args.in[6], args.in[14], args.in[15], MIXb, lds, tid2);
            else { const int it = 8 * (idx - N_CONV) + wave2; LAS float* scr = (LAS float*)(lds + RING_OFF + wave2 * 16384);
                if (it < I_WO) p0_transpose_item<0>(args.in[16], nullptr, D, D, WOt, scr, it, lane2);
                else p0_transpose_item<2>(args.in[18], args.in[17], D, 2 * DFF, WGUt, scr, it - I_WO, lane2);
                __syncthreads(); }
        }
    }
#endif
    xcd_barrier(bar);

#ifndef SKIP_P3
    for (int rep = 0; rep < REP_P3; ++rep) {
        if (rep) xcd_barrier(bar);
        pg8::Gemm g{MIXb, WOt, RP, D, D}; pg8::StaticOrder S; S.init(RP, D, G, (int)blockIdx.x);
        pg8::EpiRes<true> E{nullptr, nullptr, XB, SS1};
        const SEpiRes<true> SE{nullptr, XB + (size_t)RP * D, SS1 + (size_t)RP * 16};
        if (blockIdx.x & 1) for (int t = (int)blockIdx.x; t < 256; t += G) sgemm64(MIXb + (size_t)RP * D, WOt, D, t, SE, lds + RING_OFF);
        pg8::gemm_phase<pg8::EpiRes<true>, pg8::StaticOrder, true, true>(lds + RING_OFF, g, S, E);
        if (!(blockIdx.x & 1)) for (int t = (int)blockIdx.x; t < 256; t += G) sgemm64(MIXb + (size_t)RP * D, WOt, D, t, SE, lds + RING_OFF);
    }
#endif
    xcd_barrier(bar);

#ifndef SKIP_P4
    for (int rep = 0; rep < REP_P4; ++rep) {
        if (rep) xcd_barrier(bar);
        { const int c0 = ((R / 256) * (2 * DFF / 256)) % G, nwgc = c0 ? G - c0 : G, cc = c0 ? (int)blockIdx.x - c0 : (int)blockIdx.x;
          if (cc >= 0) {
            const bool wt = false; const int k = wt ? cc & 3 : 1, j = wt ? cc >> 2 : cc, per = wt ? nwgc / 4 : nwgc, nslot = wt ? 6 * per : per;
            const int s0 = !wt ? j : (k == 1 ? j : (k == 2 ? per + 2 * j : 3 * per + 3 * j));
            int tidc = threadIdx.x; asm volatile("" : "+v"(tidc));
            const int lane = tidc & 63, wave = __builtin_amdgcn_readfirstlane(tidc >> 6);
            for (int q = 0; q < k; ++q)
            for (int m4 = s0 + q + nslot * wave; m4 < 2 * DB * 120; m4 += nslot * NWAVES) {
                const int kv = m4 >= DB * 120, mm = kv ? m4 - DB * 120 : m4, b = mm / 120, j2 = DS + 4 * (mm % 120);
                const GAS f32x4* src = (const GAS f32x4*)(args.in[4 + kv] + ((size_t)b * 512 + j2) * 512) + lane;
                GAS f32x4* dst = (GAS f32x4*)(out + (kv ? OVS : OKS) + ((size_t)b * 512 + (j2 - DS)) * 512) + lane;
                f32x4 v[8];
#pragma unroll
                for (int i = 0; i < 8; ++i) v[i] = src[64 * i];
#pragma unroll
                for (int i = 0; i < 8; ++i) dst[64 * i] = v[i];
            }
            { LAS float* scr = (LAS float*)(lds + RING_OFF + wave * 16384); constexpr int I_D = (DFF / 64) * (D / 32), I_PG = (D / 64) * (D / 32);
              constexpr int I_PP = (PLE / 64) * (D / 32);
              for (int it = cc * NWAVES + wave; it < I_D + I_PG + I_PP; it += nwgc * NWAVES) {
                  if (it < I_D) p0_transpose_item<0>(args.in[19], nullptr, DFF, D, WDt, scr, it, lane);
                  else if (it < I_D + I_PG) p0_transpose_item<0>(args.in[21], args.in[20], D, D, WPGt, scr, it - I_D, lane);
                  else p0_transpose_item<0>(args.in[22], nullptr, PLE, D, WPPt, scr, it - I_D - I_PG, lane); }
              __syncthreads(); }
            for (int m8 = cc * NWAVES + wave; m8 < R / 8; m8 += nwgc * NWAVES) {
                const int m = 8 * m8; const float* prow = m < RP ? args.in[2] + (size_t)m * PLE : args.in[3] + (size_t)(m - RP) * PLE;
                const GAS f32x4* pr = (const GAS f32x4*)prow + lane; f32x4 pv[8];
#pragma unroll
                for (int j = 0; j < 8; ++j) pv[j] = pr[64 * j];
                GAS unsigned long long* o8 = (GAS unsigned long long*)(PB + (size_t)m * PLE) + lane;
#pragma unroll
                for (int j = 0; j < 8; ++j) o8[64 * j] = (unsigned long long)pk2(pv[j].x, pv[j].y) | ((unsigned long long)pk2(pv[j].z, pv[j].w) << 32);
            }
          } }
        pg8::Gemm g{XB, WGUt, R, 2 * DFF, D}; pg8::StaticOrder S; S.init(R, 2 * DFF, G, (int)blockIdx.x);
        pg8::EpiAct E{SS1, ACTb};
        pg8::gemm_phase<pg8::EpiAct, pg8::StaticOrder, true, true>(lds + RING_OFF, g, S, E);
    }
#endif
    xcd_barrier(bar);

#ifndef SKIP_P5
    {
        pg8::Gemm g{ACTb, WDt, RP, D, DFF}; pg8::StaticOrder S; S.init(RP, D, G, (int)blockIdx.x);
        pg8::EpiRes<true> E{nullptr, nullptr, XB, SS2};
        const SEpiRes<true> SE{nullptr, XB + (size_t)RP * D, SS2 + (size_t)RP * 16};
        if (blockIdx.x & 1) for (int t = (int)blockIdx.x; t < 256; t += G) sgemm64(ACTb + (size_t)RP * DFF, WDt, DFF, t, SE, lds + RING_OFF);
        pg8::gemm_phase<pg8::EpiRes<true>, pg8::StaticOrder, true, true>(lds + RING_OFF, g, S, E);
        if (!(blockIdx.x & 1)) for (int t = (int)blockIdx.x; t < 256; t += G) sgemm64(ACTb + (size_t)RP * DFF, WDt, DFF, t, SE, lds + RING_OFF);
    }
#endif
    xcd_barrier(bar);

#ifndef SKIP_P6
    {
        pg8::Gemm g{XB, WPGt, RP, D, D}; pg8::StaticOrder S; S.init(RP, D, G, (int)blockIdx.x);
        pg8::EpiFinal E{SS2, PPb, XB, Y};
        const SEpiFinal SE{SS2 + (size_t)RP * 16, PPb + (size_t)RP * D, XB + (size_t)RP * D, Y + (size_t)RP * D};
        pg8::Gemm gp{PB, WPPt, RP, D, PLE}; pg8::EpiPP EP{PPb}; const SEpiPP SP{PPb + (size_t)RP * D};
        if (blockIdx.x & 1) for (int t = (int)blockIdx.x; t < 256; t += G) { sgemm64(PB + (size_t)RP * PLE, WPPt, PLE, t, SP, lds + RING_OFF); sgemm64(XB + (size_t)RP * D, WPGt, D, t, SE, lds + RING_OFF); }
        pg8::gemm_phase<pg8::EpiPP, pg8::StaticOrder, true, true>(lds + RING_OFF, gp, S, EP);
        pg8::gemm_phase<pg8::EpiFinal, pg8::StaticOrder, true, true>(lds + RING_OFF, g, S, E);
        if (!(blockIdx.x & 1)) for (int t = (int)blockIdx.x; t < 256; t += G) { sgemm64(PB + (size_t)RP * PLE, WPPt, PLE, t, SP, lds + RING_OFF); sgemm64(XB + (size_t)RP * D, WPGt, D, t, SE, lds + RING_OFF); }
    }
#endif
}

extern "C" void kernel_launch(void* const* d_in, const int* in_sizes, int n_in, void* d_out, int out_size, void* d_ws, size_t ws_size, hipStream_t stream) {
    static int grid = 0;
    if (grid == 0) {
        if (n_in != 23 || ws_size < WS_END) { fprintf(stderr, "kernel_launch: unexpected shapes (n_in %d, ws %zu)\n", n_in, ws_size); grid = -1; return; }
        int dev = 0, cus = 0, per_cu = 0;
        if (hipGetDevice(&dev) != hipSuccess || hipDeviceGetAttribute(&cus, hipDeviceAttributeMultiprocessorCount, dev) != hipSuccess) { grid = -1; return; }
        if (hipFuncSetAttribute((const void*)mk_fwd, hipFuncAttributeMaxDynamicSharedMemorySize, LDS_BYTES) != hipSuccess) { fprintf(stderr, "kernel_launch: hipFuncSetAttribute failed\n"); grid = -1; return; }
        if (hipOccupancyMaxActiveBlocksPerMultiprocessor(&per_cu, (const void*)mk_fwd, NWAVES * 64, LDS_BYTES) != hipSuccess || per_cu < 1) { fprintf(stderr, "kernel_launch: occupancy query says %d blocks per CU\n", per_cu); }
        (void)hipGetLastError();
        grid = cus;
    }
    if (grid < 0) return;
    if (hipMemsetAsync((char*)d_ws + WS_CTL, 0, CTL_ZERO_BYTES, stream) != hipSuccess) return;
    Args a{};
    for (int i = 0; i < 23; ++i) a.in[i] = (const float*)d_in[i];
    a.out = (float*)d_out; a.ws = (unsigned char*)d_ws;
    hipLaunchKernelGGL(mk_fwd, dim3(grid), dim3(NWAVES * 64), LDS_BYTES, stream, a);
}
```

```cpp
#include <hip/hip_runtime.h>
#include <cstdio>
#include <cstdint>
constexpr int D = 1024, SEQ = 8192, NB = 4, DB = 32, DS = 32;
constexpr int RP = NB * SEQ, RS = DB * DS, R = RP + RS;
constexpr int INC = 2560, DFF = 2816, PLE = 256, NH = 8, HD = 64, CW = 512;
constexpr int NREL = 257, CONVW = 31, CH = 30, KSROWS = 576;
constexpr int KVT_BYTES = 131072;
constexpr float EPS = 1e-6f, LOG2E = 1.4426950408889634f, QSCALE = 0.125f * LOG2E;
constexpr size_t OY = 0, OKP = (size_t)R * D, OVP = OKP + (size_t)NB * 512 * 512, OCP = OVP + (size_t)NB * 512 * 512,
                 OKS = OCP + (size_t)NB * CH * CW, OVS = OKS + (size_t)DB * 512 * 512, OCS = OVS + (size_t)DB * 512 * 512;
namespace pg8 {
#define PG8_LAS __attribute__((address_space(3)))
typedef unsigned short bf16_t;
typedef short bf16x8 __attribute__((ext_vector_type(8)));
typedef float f32x4 __attribute__((ext_vector_type(4)));
typedef unsigned u32x4 __attribute__((ext_vector_type(4)));
constexpr int BM = 256, BK = 64, HALF = 128, HTB = HALF * BK * 2  , STAGE_BYTES = 8 * HTB, NXCD = 8, WGM = 8;

__host__ __device__ __forceinline__ int lds_byte(int r, int c) { const int st = (r >> 4) * 2 + (c >> 5), rr = r & 15, cc = c & 31, ob = rr * 64 + cc * 2; return st * 1024 + (ob ^ (((ob >> 9) & 1) << 5)); }
__host__ __device__ __forceinline__ void stage_rc(int b, int& R, int& C) { const int st = b / 1024, sb = b % 1024, swz = sb ^ (((sb >> 9) & 1) << 5); R = (st >> 1) * 16 + swz / 64; C = (st & 1) * 32 + (swz % 64) / 2; }
__host__ __device__ __forceinline__ int perm32(int rho) { const int n = rho >> 4, i = rho & 15; return 8 * (i >> 2) + 4 * n + (i & 3); }

struct Unit { int pm, pn; };
struct Gemm { const bf16_t* A; const bf16_t* Bt; int M, N, K; };

struct StaticOrder {
    int nM, nN, nwg, G, c;
    __host__ __device__ void init(int M, int N, int G_, int c_) { nM = M / BM; nN = N / BM; nwg = nM * nN; G = G_; c = c_; }
    __host__ __device__ bool next(int i, Unit& u) const {
        const long L = (long)i * G + c; if (L >= nwg) return false;
        int wgid = (int)L; { const int q = nwg / NXCD, r = nwg % NXCD, xcd = wgid % NXCD, off = wgid / NXCD; wgid = (xcd < r ? xcd * (q + 1) : r * (q + 1) + (xcd - r) * q) + off; }
        const int nig = WGM * nN, gid = wgid / nig, fm = gid * WGM, gsz = (nM - fm) < WGM ? (nM - fm) : WGM;
        u.pm = fm + ((wgid % nig) % gsz); u.pn = (wgid % nig) / gsz; return true;
    }
    __device__ __forceinline__ void a_ready(const Unit&) const {}
    __device__ __forceinline__ void done(const Unit&) const {}
};

__device__ __forceinline__ unsigned cvt_pk_bf16(float lo, float hi) { unsigned r; asm volatile("v_cvt_pk_bf16_f32 %0, %1, %2" : "=v"(r) : "v"(lo), "v"(hi)); return r; }
typedef float f32x2 __attribute__((ext_vector_type(2)));typedef unsigned u32x2 __attribute__((ext_vector_type(2)));
__device__ __forceinline__ u32x4 pack8(const f32x4 a, const f32x4 b) { u32x4 w; w.x = cvt_pk_bf16(a[0], a[1]); w.y = cvt_pk_bf16(a[2], a[3]); w.z = cvt_pk_bf16(b[0], b[1]); w.w = cvt_pk_bf16(b[2], b[3]); return w; }
__device__ __forceinline__ float sigm(float x) { return __builtin_amdgcn_rcpf(1.0f + __builtin_amdgcn_exp2f(-x * LOG2E)); }
__device__ __forceinline__ float quad_sum(float s) { s += __shfl_xor(s, 16); s += __shfl_xor(s, 32); return s; }
struct Epi1 {
    static constexpr bool PERM = true, AFTER_DRAIN = false;
    const float* rx; const float* qg; const float* kg; bf16_t* Q; unsigned char* KVP; unsigned char* KVS; bf16_t* GLU; float* out;
    __device__ __forceinline__ void operator()(const f32x4 (&acc)[2][2][4][2], const Unit& u, int wr, int wc, int fr, int fq) const {
        const int pn = u.pn, rowt = u.pm * BM + wr * 64 + fr;
        float rxv[2][4];
#pragma unroll
        for (int ai = 0; ai < 2; ++ai)
#pragma unroll
            for (int m = 0; m < 4; ++m) rxv[ai][m] = rx[rowt + ai * HALF + m * 16];
        if (pn < 6) {
            const int sec = pn >> 1, col = (4 * (pn & 1) + wc) * 64 + 8 * fq;
            f32x4 g[2][2];
#pragma unroll
            for (int bj = 0; bj < 2; ++bj)
#pragma unroll
                for (int n = 0; n < 2; ++n) { g[bj][n] = (f32x4){1.f, 1.f, 1.f, 1.f};
                    if (sec == 0) g[bj][n] = *(const f32x4*)(qg + 32 * bj + 8 * fq + 4 * n) * QSCALE;
                    if (sec == 1) g[bj][n] = *(const f32x4*)(kg + 32 * bj + 8 * fq + 4 * n); }
#pragma unroll
            for (int ai = 0; ai < 2; ++ai)
#pragma unroll
                for (int m = 0; m < 4; ++m) {
                    const int row = rowt + ai * HALF + m * 16; const float r = rxv[ai][m];
                    f32x4 z[2][2];
#pragma unroll
                    for (int bj = 0; bj < 2; ++bj)
#pragma unroll
                        for (int n = 0; n < 2; ++n) z[bj][n] = acc[ai][bj][m][n] * r;
                    if (sec < 2) {
                        float ss = 0.f;
#pragma unroll
                        for (int bj = 0; bj < 2; ++bj)
#pragma unroll
                            for (int n = 0; n < 2; ++n) { const f32x4 q = z[bj][n] * z[bj][n]; ss += (q[0] + q[1]) + (q[2] + q[3]); }
                        ss = quad_sum(ss);
                        const float rn = rsqrtf(ss * (1.0f / 64.0f) + EPS);
#pragma unroll
                        for (int bj = 0; bj < 2; ++bj)
#pragma unroll
                            for (int n = 0; n < 2; ++n) z[bj][n] = z[bj][n] * rn * g[bj][n];
                    }
                    const int sb = (row - RP) >> 5, si = (row - RP) & 31;
                    float* fo = nullptr;
                    if (sec == 0) {
#pragma unroll
                        for (int bj = 0; bj < 2; ++bj) *(u32x4*)(Q + (size_t)row * 512 + col + 32 * bj) = pack8(z[bj][0], z[bj][1]);
                    } else {
                        unsigned char* tb; int kv;
                        if (row < RP) { tb = KVP + (size_t)(row >> 6) * KVT_BYTES; kv = row & 63;
                            const int t = row & (SEQ - 1); if (t >= SEQ - 512) fo = out + OKP + (size_t)(sec - 1) * (OVP - OKP) + ((size_t)((row >> 13) * 512 + (t - (SEQ - 512)))) * 512 + col; }
                        else { tb = KVS + (size_t)(sb * 9 + 8) * KVT_BYTES; kv = si; fo = out + OKS + (size_t)(sec - 1) * (OVS - OKS) + ((size_t)(sb * 512 + 480 + si)) * 512 + col; }
                        tb += (pn & 1) * 65536 + wc * 16384;
                        const int ok = fq * 1024 + kv * 16, ov = 8192 + (kv >> 4) * 1024 + (kv & 15) * 64 + fq * 16;
#pragma unroll
                        for (int bj = 0; bj < 2; ++bj) *(u32x4*)(tb + (sec == 1 ? ok + bj * 4096 : ov + bj * 4096)) = pack8(z[bj][0], z[bj][1]);
                    }
                    if (fo) {
#pragma unroll
                        for (int bj = 0; bj < 2; ++bj)
#pragma unroll
                            for (int n = 0; n < 2; ++n) __builtin_nontemporal_store(z[bj][n], (f32x4*)(fo + 32 * bj + 4 * n)); }
                }
        } else {
            const int col = 128 * (pn - 6) + 32 * wc + 8 * fq;
#pragma unroll
            for (int ai = 0; ai < 2; ++ai)
#pragma unroll
                for (int m = 0; m < 4; ++m) {
                    const int row = rowt + ai * HALF + m * 16; const float r = rxv[ai][m];
                    f32x4 gl[2];
#pragma unroll
                    for (int n = 0; n < 2; ++n) { const f32x4 a = acc[ai][0][m][n] * r, b = acc[ai][1][m][n] * r;
#pragma unroll
                        for (int e = 0; e < 4; ++e) gl[n][e] = a[e] * sigm(b[e]); }
                    *(u32x4*)(GLU + (size_t)row * 512 + col) = pack8(gl[0], gl[1]);
                    float* fo = nullptr;
                    if (row < RP) { const int t = row & (SEQ - 1); if (t >= SEQ - CH) fo = out + OCP + ((size_t)((row >> 13) * CH + (t - (SEQ - CH)))) * CW + col; }
                    else { const int sb = (row - RP) >> 5, si = (row - RP) & 31; if (si >= DS - CH) fo = out + OCS + ((size_t)(sb * CH + (si - (DS - CH)))) * CW + col; }
                    if (fo) { __builtin_nontemporal_store(gl[0], (f32x4*)(fo)); __builtin_nontemporal_store(gl[1], (f32x4*)(fo + 4)); }
                }
        }
    }
};
struct EpiPP {
    static constexpr bool PERM = true, AFTER_DRAIN = false;
    bf16_t* O;
    __device__ __forceinline__ void operator()(const f32x4 (&acc)[2][2][4][2], const Unit& u, int wr, int wc, int fr, int fq) const {
        const int rowt = u.pm * BM + wr * 64 + fr, col = u.pn * BM + 32 * wc + 8 * fq;
#pragma unroll
        for (int ai = 0; ai < 2; ++ai)
#pragma unroll
            for (int m = 0; m < 4; ++m) { bf16_t* rowp = O + (size_t)(rowt + ai * HALF + m * 16) * D + col;
#pragma unroll
                for (int bj = 0; bj < 2; ++bj) *(u32x4*)(rowp + bj * HALF) = pack8(acc[ai][bj][m][0], acc[ai][bj][m][1]); }
    }
};
__device__ __forceinline__ f32x4 bf_lo4(const u32x4 w) { return (f32x4){__uint_as_float(w.x << 16), __uint_as_float(w.x & 0xffff0000u), __uint_as_float(w.y << 16), __uint_as_float(w.y & 0xffff0000u)}; }
__device__ __forceinline__ f32x4 bf_hi4(const u32x4 w) { return (f32x4){__uint_as_float(w.z << 16), __uint_as_float(w.z & 0xffff0000u), __uint_as_float(w.w << 16), __uint_as_float(w.w & 0xffff0000u)}; }
template <bool BF> struct EpiRes {
    static constexpr bool PERM = true, AFTER_DRAIN = false;
    const float* bp; const float* bs; bf16_t* HB; float* SS;
    __device__ __forceinline__ void operator()(const f32x4 (&acc)[2][2][4][2], const Unit& u, int wr, int wc, int fr, int fq) const {
        const int rowt = u.pm * BM + wr * 64 + fr, col = u.pn * BM + 32 * wc + 8 * fq;
        f32x4 bv[2][2][2];
        auto ldbase = [&](int i, f32x4 (&d)[2][2]) {
            const int row = rowt + (i >> 2) * HALF + (i & 3) * 16;
            if (BF) { const bf16_t* hrow = HB + (size_t)row * D + col;
#pragma unroll
                for (int bj = 0; bj < 2; ++bj) { const u32x4 w = *(const u32x4*)(hrow + bj * HALF); d[bj][0] = bf_lo4(w); d[bj][1] = bf_hi4(w); } }
            else { const float* brow = (row < RP ? bp + (size_t)row * D : bs + (size_t)(row - RP) * D) + col;
#pragma unroll
                for (int bj = 0; bj < 2; ++bj) { d[bj][0] = *(const f32x4*)(brow + bj * HALF); d[bj][1] = *(const f32x4*)(brow + bj * HALF + 4); } } };
        ldbase(0, bv[0]);
#pragma unroll
        for (int i = 0; i < 8; ++i) {
            const int ai = i >> 2, m = i & 3, row = rowt + ai * HALF + m * 16;
            if (i + 1 < 8) ldbase(i + 1, bv[(i + 1) & 1]);
            bf16_t* hrow = HB + (size_t)row * D + col;
            float ss = 0.f;
#pragma unroll
            for (int bj = 0; bj < 2; ++bj) {
                const f32x4 v0 = bv[i & 1][bj][0] + acc[ai][bj][m][0], v1 = bv[i & 1][bj][1] + acc[ai][bj][m][1];
                *(u32x4*)(hrow + bj * HALF) = pack8(v0, v1);
                const f32x4 q0 = v0 * v0, q1 = v1 * v1; ss += ((q0[0] + q0[1]) + (q0[2] + q0[3])) + ((q1[0] + q1[1]) + (q1[2] + q1[3]));
            }
            ss = quad_sum(ss);
            if (fq == 0) SS[(size_t)row * 16 + 4 * u.pn + wc] = ss;
        }
    }
};
__device__ __forceinline__ float row_rs(const float* SS, int row, int fq) {
    const f32x4 s4 = *(const f32x4*)(SS + (size_t)row * 16 + 4 * fq);
    return rsqrtf(quad_sum((s4[0] + s4[1]) + (s4[2] + s4[3])) * (1.0f / D) + EPS);
}
struct EpiAct {
    static constexpr bool PERM = true, AFTER_DRAIN = false;
    const float* SS; bf16_t* ACT;
    __device__ __forceinline__ void operator()(const f32x4 (&acc)[2][2][4][2], const Unit& u, int wr, int wc, int fr, int fq) const {
        const int rowt = u.pm * BM + wr * 64 + fr, col = 128 * u.pn + 32 * wc + 8 * fq;
        float rv[2][4];
#pragma unroll
        for (int ai = 0; ai < 2; ++ai)
#pragma unroll
            for (int m = 0; m < 4; ++m) rv[ai][m] = row_rs(SS, rowt + ai * HALF + m * 16, fq);
#pragma unroll
        for (int ai = 0; ai < 2; ++ai)
#pragma unroll
            for (int m = 0; m < 4; ++m) {
                const int row = rowt + ai * HALF + m * 16; const float r = rv[ai][m];
                f32x4 v[2];
#pragma unroll
                for (int n = 0; n < 2; ++n) { const f32x4 g = acc[ai][0][m][n] * r, up = acc[ai][1][m][n] * r;
#pragma unroll
                    for (int e = 0; e < 4; ++e) v[n][e] = g[e] * sigm(g[e]) * up[e]; }
                *(u32x4*)(ACT + (size_t)row * DFF + col) = pack8(v[0], v[1]);
            }
    }
};
struct EpiFinal {
    static constexpr bool PERM = true, AFTER_DRAIN = false;
    const float* SS; const bf16_t* PP; const bf16_t* HB; float* Y;
    __device__ __forceinline__ void operator()(const f32x4 (&acc)[2][2][4][2], const Unit& u, int wr, int wc, int fr, int fq) const {
        const int rowt = u.pm * BM + wr * 64 + fr, col = u.pn * BM + 32 * wc + 8 * fq;
        float rv[2][4];
#pragma unroll
        for (int ai = 0; ai < 2; ++ai)
#pragma unroll
            for (int m = 0; m < 4; ++m) rv[ai][m] = row_rs(SS, rowt + ai * HALF + m * 16, fq);
        u32x4 pwv[2][2], hwv[2][2];
        auto ld = [&](int i, u32x4 (&p)[2], u32x4 (&h)[2]) { const size_t o = (size_t)(rowt + (i >> 2) * HALF + (i & 3) * 16) * D + col;
#pragma unroll
            for (int bj = 0; bj < 2; ++bj) { p[bj] = *(const u32x4*)(PP + o + bj * HALF); h[bj] = *(const u32x4*)(HB + o + bj * HALF); } };
        ld(0, pwv[0], hwv[0]);
#pragma unroll
        for (int i = 0; i < 8; ++i) {
            const int ai = i >> 2, m = i & 3, row = rowt + ai * HALF + m * 16; const float r = rv[ai][m];
            if (i + 1 < 8) ld(i + 1, pwv[(i + 1) & 1], hwv[(i + 1) & 1]);
#pragma unroll
            for (int bj = 0; bj < 2; ++bj) {
                const size_t o = (size_t)row * D + col + bj * HALF;
                const u32x4 pw = pwv[i & 1][bj], hw = hwv[i & 1][bj];
                const f32x4 a0 = acc[ai][bj][m][0] * r, a1 = acc[ai][bj][m][1] * r, p0 = bf_lo4(pw), p1 = bf_hi4(pw);
                f32x4 h0 = bf_lo4(hw), h1 = bf_hi4(hw);
#pragma unroll
                for (int e2 = 0; e2 < 4; ++e2) { h0[e2] += sigm(a0[e2]) * p0[e2]; h1[e2] += sigm(a1[e2]) * p1[e2]; }
                __builtin_nontemporal_store(h0, (f32x4*)(Y + o)); __builtin_nontemporal_store(h1, (f32x4*)(Y + o + 4));
            }
        }
    }
};

template <class Epi, class Sched, bool ALIGN_EPI = false, bool SP2 = false>
__device__ __forceinline__ void gemm_phase(PG8_LAS unsigned char* lds, const Gemm g, const Sched& S, const Epi& E) {
    int tid_ = threadIdx.x; asm volatile("" : "+v"(tid_));
    const int tid = tid_, wid = __builtin_amdgcn_readfirstlane(tid >> 6), lane = tid & 63, wr = wid >> 2, wc = wid & 3, fr = lane & 15, fq = lane >> 4;
    int K_ = g.K; asm volatile("" : "+s"(K_));
    const int K = K_, nt = K / BK;
    unsigned voffA[2], voffB[2];
#pragma unroll
    for (int i = 0; i < 2; ++i) { int R, C; stage_rc(tid * 16 + i * 8192, R, C); const int Rb = Epi::PERM ? ((R & ~31) + perm32(R & 31)) : R;
        voffA[i] = (unsigned)(R * K + C) * 2u; voffB[i] = (unsigned)(Rb * K + C) * 2u; }
    const size_t kstep = (size_t)(BK * 2);
    const size_t hstep = (size_t)HALF * K * 2;
    const size_t tstep = 2 * hstep;
    const unsigned ldsw = (unsigned)wid * 1024u;
    const int aoff = lds_byte(wr * 64 + fr, fq * 8), boff = lds_byte(wc * 32 + fr, fq * 8);
#define PG8_SA(b, h) (((b) * 2 + (h)) * HTB)
#define PG8_SB(b, h) ((4 + (b) * 2 + (h)) * HTB)
#define PG8_STAGE(bufoff, gbase, voff) do { _Pragma("unroll") for (int _i = 0; _i < 2; ++_i) \
        __builtin_amdgcn_global_load_lds((const unsigned*)((const char*)(gbase) + (voff)[_i]), (PG8_LAS unsigned*)(lds + (bufoff) + ldsw + _i * 8192), 16, 0, 0); } while (0)
#define PG8_LDA(dst, b, h) do { _Pragma("unroll") for (int m = 0; m < 4; ++m) _Pragma("unroll") for (int k = 0; k < 2; ++k) dst[m][k] = *(const PG8_LAS bf16x8*)(lds + PG8_SA(b, h) + aoff + m * 2048 + k * 1024); } while (0)
#define PG8_LDB(dst, b, h) do { _Pragma("unroll") for (int n = 0; n < 2; ++n) _Pragma("unroll") for (int k = 0; k < 2; ++k) dst[n][k] = *(const PG8_LAS bf16x8*)(lds + PG8_SB(b, h) + boff + n * 2048 + k * 1024); } while (0)
#define PG8_MMA(ai, bj, At, Bt) do { __builtin_amdgcn_s_setprio(1); _Pragma("unroll") for (int m = 0; m < 4; ++m) _Pragma("unroll") for (int n = 0; n < 2; ++n) _Pragma("unroll") for (int k = 0; k < 2; ++k) \
        acc[ai][bj][m][n] = __builtin_amdgcn_mfma_f32_16x16x32_bf16(Bt[n][k], At[m][k], acc[ai][bj][m][n], 0, 0, 0); __builtin_amdgcn_s_setprio(0); } while (0)
#define PG8_WAIT_V(n) asm volatile("s_waitcnt vmcnt(" #n ")" ::: "memory")
#define PG8_WAIT_L(n) asm volatile("s_waitcnt lgkmcnt(" #n ")" ::: "memory")
#define PG8_BAR __builtin_amdgcn_s_barrier()
#define PG8_SCHED __builtin_amdgcn_sched_barrier(0)
    Unit cur, nxt; int ui = 0;
    if (!S.next(0, cur)) return;
    f32x4 acc[2][2][4][2];
#pragma unroll
    for (int a = 0; a < 2; ++a)
#pragma unroll
        for (int b = 0; b < 2; ++b)
#pragma unroll
            for (int m = 0; m < 4; ++m)
#pragma unroll
                for (int n = 0; n < 2; ++n) acc[a][b][m][n] = (f32x4){0.f, 0.f, 0.f, 0.f};
    bf16x8 At[4][2], B0[2][2], B1[2][2];
    const char* cA = (const char*)g.A + (size_t)cur.pm * tstep; const char* cB = (const char*)g.Bt + (size_t)cur.pn * tstep;
    S.a_ready(cur);
    if constexpr (SP2) {
        PG8_STAGE(PG8_SB(0, 0), cB, voffB); PG8_STAGE(PG8_SB(0, 1), cB + hstep, voffB); PG8_STAGE(PG8_SA(0, 0), cA, voffA); PG8_STAGE(PG8_SA(0, 1), cA + hstep, voffA);
        if (wr == 1) PG8_BAR;
        PG8_WAIT_V(2); PG8_BAR;
        PG8_STAGE(PG8_SB(1, 0), cB + kstep, voffB); PG8_STAGE(PG8_SA(1, 0), cA + kstep, voffA); PG8_STAGE(PG8_SB(1, 1), cB + hstep + kstep, voffB);
        PG8_WAIT_V(6); PG8_BAR;
    } else {
        PG8_STAGE(PG8_SB(0, 0), cB, voffB); PG8_STAGE(PG8_SA(0, 0), cA, voffA); PG8_STAGE(PG8_SB(0, 1), cB + hstep, voffB); PG8_STAGE(PG8_SA(0, 1), cA + hstep, voffA);
        if (wr == 1) PG8_BAR;
        PG8_WAIT_V(4); PG8_BAR;
        PG8_STAGE(PG8_SB(1, 0), cB + kstep, voffB); PG8_STAGE(PG8_SA(1, 0), cA + kstep, voffA); PG8_STAGE(PG8_SB(1, 1), cB + hstep + kstep, voffB);
        PG8_WAIT_V(6); PG8_BAR;
    }
    for (;;) {
        const bool has_next = S.next(ui + 1, nxt);
        const char* nA = has_next ? (const char*)g.A + (size_t)nxt.pm * tstep : cA; const char* nB = has_next ? (const char*)g.Bt + (size_t)nxt.pn * tstep : cB;
        for (int t = 0; t < nt; t += 2) {
            const bool last = (t == nt - 2);
            const char* a1 = cA + (size_t)(t + 1) * kstep;
            const char* a2 = last ? nA : cA + (size_t)(t + 2) * kstep; const char* b2 = last ? nB : cB + (size_t)(t + 2) * kstep;
            const char* a3 = a2 + kstep; const char* b3 = b2 + kstep;
            if (last && has_next) S.a_ready(nxt);
            if constexpr (SP2) {
            PG8_LDB(B0, 0, 0); PG8_LDB(B1, 0, 1); PG8_SCHED; PG8_LDA(At, 0, 0); PG8_STAGE(PG8_SA(1, 1), a1 + hstep, voffA);
            PG8_WAIT_V(8); PG8_WAIT_L(0); PG8_BAR; PG8_MMA(0, 0, At, B0); PG8_MMA(0, 1, At, B1); PG8_BAR; PG8_SCHED;
            PG8_LDA(At, 0, 1); PG8_STAGE(PG8_SB(0, 0), b2, voffB); PG8_STAGE(PG8_SB(0, 1), b2 + hstep, voffB); PG8_STAGE(PG8_SA(0, 0), a2, voffA);
            PG8_WAIT_V(8); PG8_WAIT_L(0); PG8_BAR; PG8_MMA(1, 0, At, B0); PG8_MMA(1, 1, At, B1); PG8_BAR; PG8_SCHED;
            PG8_LDB(B0, 1, 0); PG8_LDB(B1, 1, 1); PG8_SCHED; PG8_LDA(At, 1, 0); PG8_STAGE(PG8_SA(0, 1), a2 + hstep, voffA);
            PG8_WAIT_V(8); PG8_WAIT_L(0); PG8_BAR; PG8_MMA(0, 0, At, B0); PG8_MMA(0, 1, At, B1); PG8_BAR; PG8_SCHED;
            PG8_LDA(At, 1, 1); PG8_STAGE(PG8_SB(1, 0), b3, voffB); PG8_STAGE(PG8_SB(1, 1), b3 + hstep, voffB); PG8_STAGE(PG8_SA(1, 0), a3, voffA);
            PG8_WAIT_V(8); PG8_WAIT_L(0); PG8_BAR; PG8_MMA(1, 0, At, B0); PG8_MMA(1, 1, At, B1); PG8_BAR; PG8_SCHED;
            } else {
            PG8_LDB(B0, 0, 0); PG8_SCHED; PG8_LDA(At, 0, 0); PG8_STAGE(PG8_SA(1, 1), a1 + hstep, voffA);
            PG8_WAIT_L(8); PG8_BAR; PG8_WAIT_L(0); PG8_MMA(0, 0, At, B0); PG8_BAR; PG8_SCHED;
            PG8_LDB(B1, 0, 1); PG8_STAGE(PG8_SB(0, 0), b2, voffB);
            PG8_BAR; PG8_WAIT_L(0); PG8_MMA(0, 1, At, B1); PG8_BAR;
            PG8_LDA(At, 0, 1); PG8_STAGE(PG8_SA(0, 0), a2, voffA);
            PG8_BAR; PG8_WAIT_L(0); PG8_MMA(1, 0, At, B0); PG8_BAR; PG8_SCHED;
            PG8_STAGE(PG8_SB(0, 1), b2 + hstep, voffB);
            PG8_WAIT_V(6); PG8_BAR; PG8_MMA(1, 1, At, B1); PG8_BAR;
            PG8_LDB(B0, 1, 0); PG8_SCHED; PG8_LDA(At, 1, 0); PG8_STAGE(PG8_SA(0, 1), a2 + hstep, voffA);
            PG8_WAIT_L(8); PG8_BAR; PG8_WAIT_L(0); PG8_MMA(0, 0, At, B0); PG8_BAR; PG8_SCHED;
            PG8_LDB(B1, 1, 1); PG8_STAGE(PG8_SB(1, 0), b3, voffB);
            PG8_BAR; PG8_WAIT_L(0); PG8_MMA(0, 1, At, B1); PG8_BAR;
            PG8_LDA(At, 1, 1); PG8_STAGE(PG8_SA(1, 0), a3, voffA);
            PG8_BAR; PG8_WAIT_L(0); PG8_MMA(1, 0, At, B0); PG8_BAR; PG8_SCHED;
            PG8_STAGE(PG8_SB(1, 1), b3 + hstep, voffB);
            PG8_WAIT_V(6); PG8_BAR; PG8_MMA(1, 1, At, B1); PG8_BAR;
            }
        }
        if constexpr (ALIGN_EPI) { if (wr == 0) PG8_BAR; }
        if constexpr (!Epi::AFTER_DRAIN) { E(acc, cur, wr, wc, fr, fq); S.done(cur); }
        if (!has_next) break;
#pragma unroll
        for (int a = 0; a < 2; ++a)
#pragma unroll
            for (int b = 0; b < 2; ++b)
#pragma unroll
                for (int m = 0; m < 4; ++m)
#pragma unroll
                    for (int n = 0; n < 2; ++n) acc[a][b][m][n] = (f32x4){0.f, 0.f, 0.f, 0.f};
        cur = nxt; cA = nA; cB = nB; ++ui;
        if constexpr (ALIGN_EPI) { if (wr == 1) PG8_BAR; }
    }
    PG8_WAIT_V(0);
    if constexpr (!ALIGN_EPI) { if (wr == 0) PG8_BAR; }
    PG8_BAR;
    if constexpr (Epi::AFTER_DRAIN) { E.fused(acc, cur, wr, wc, fr, fq, lds, wid, lane); S.done(cur); }
#undef PG8_SA
#undef PG8_SB
#undef PG8_STAGE
#undef PG8_LDA
#undef PG8_LDB
#undef PG8_MMA
#undef PG8_WAIT_V
#undef PG8_WAIT_L
#undef PG8_BAR
#undef PG8_SCHED
}
}
#define GAS __attribute__((address_space(1)))
#define LAS __attribute__((address_space(3)))
typedef unsigned short bf16;
typedef unsigned v4u __attribute__((ext_vector_type(4)));
typedef float f32x4 __attribute__((ext_vector_type(4)));
typedef short bf16x8 __attribute__((ext_vector_type(8)));
typedef GAS unsigned gu32;
typedef GAS unsigned long long gu64;
#define RLX_AGENT __ATOMIC_RELAXED, __HIP_MEMORY_SCOPE_AGENT
#define LDS_WAIT() asm volatile("s_waitcnt lgkmcnt(0)" ::: "memory")
#define VM_WAIT() asm volatile("s_waitcnt vmcnt(0)" ::: "memory")
__device__ __forceinline__ unsigned long long rt() { return __builtin_amdgcn_s_memrealtime(); }
__device__ __forceinline__ unsigned f2bf(float f) { unsigned u = __builtin_bit_cast(unsigned, f); return (u + 0x7fffu + ((u >> 16) & 1u)) >> 16; }
__device__ __forceinline__ unsigned pk2(float lo, float hi) { return f2bf(lo) | (f2bf(hi) << 16); }
#define XB_TMO      128
#define XB_XCNT(j)  (256  + 64 * (j))
#define XB_XSUB(j)  (1280 + 64 * (j))
#define XB_XGEN(j)  (2304 + 64 * (j))
#define XB_TOP      3328
#define XB_TOPGEN   3392
#define XCD_BAR_WORDS 3456
#define XB_SPIN_CAP (1u << 18)

__device__ __forceinline__ unsigned xb_ld(unsigned* p)              { return __hip_atomic_load(p, __ATOMIC_RELAXED, __HIP_MEMORY_SCOPE_AGENT); }
__device__ __forceinline__ unsigned xb_add(unsigned* p, unsigned v) { return __hip_atomic_fetch_add(p, v, __ATOMIC_RELAXED, __HIP_MEMORY_SCOPE_AGENT); }
__device__ __forceinline__ unsigned xb_xcc_id() { return (unsigned)__builtin_amdgcn_s_getreg((3 << 11) | 20) & 0xFu; }
#define XB_SPIN(cond, bar) do { unsigned _sp = 0; while (cond) { __builtin_amdgcn_s_sleep(1); \
    if ((++_sp & 255u) == 0u) { if (xb_ld(&(bar)[XB_TMO])) break; if (_sp > XB_SPIN_CAP) { atomicAdd(&(bar)[XB_TMO], 1u); break; } } } } while (0)

struct XcdBarrier {
    unsigned* bar; unsigned x;
    volatile LAS unsigned* st;
};

__device__ __forceinline__ XcdBarrier xcd_barrier_post(unsigned* bar, volatile LAS unsigned* st) {
    XcdBarrier b; b.bar = bar; b.x = xb_xcc_id(); b.st = st;
    if (threadIdx.x == 0) (void)xb_add(&bar[XB_XCNT(b.x)], 1u);
    return b;
}
__device__ __forceinline__ void xcd_barrier_complete(unsigned* bar, unsigned x, unsigned& nloc, unsigned& nx) {
    const unsigned G = gridDim.x * gridDim.y * gridDim.z;
    unsigned sum, cnt, mine, sp = 0u;
    for (;;) {
        sum = 0u; cnt = 0u; mine = 0u;
#pragma unroll
        for (unsigned j = 0; j < 16; ++j) { const unsigned c = xb_ld(&bar[XB_XCNT(j)]); sum += c; cnt += (c > 0u) ? 1u : 0u; mine = (j == x) ? c : mine; }
        if (sum == G) break;
        __builtin_amdgcn_s_sleep(1);
        if ((++sp & 255u) == 0u) { if (xb_ld(&bar[XB_TMO])) break; if (sp > XB_SPIN_CAP) { atomicAdd(&bar[XB_TMO], 1u); break; } }
    }
    nloc = mine > 0u ? mine : 1u; nx = cnt > 0u ? cnt : 1u;
}

__device__ __forceinline__ void xcd_barrier(const XcdBarrier& b) {
    asm volatile("s_waitcnt vmcnt(0)" ::: "memory");
    __syncthreads();
    if (threadIdx.x == 0) {
        unsigned* bar = b.bar;
        __builtin_amdgcn_s_waitcnt(0);
        unsigned nloc = b.st[0], nx = b.st[1];
        if (nloc == 0u) { xcd_barrier_complete(bar, b.x, nloc, nx); b.st[0] = nloc; b.st[1] = nx; }
        const unsigned old = xb_add(&bar[XB_XSUB(b.x)], 1u);
        const unsigned gen = old / nloc;
        if (old + 1u == (gen + 1u) * nloc) {
            __builtin_amdgcn_fence(__ATOMIC_RELEASE, "agent");
            asm volatile("s_waitcnt vmcnt(0)" ::: "memory");
            const unsigned og = xb_add(&bar[XB_TOP], 1u);
            const unsigned tg = og / nx;
            if (og + 1u == (tg + 1u) * nx) xb_add(&bar[XB_TOPGEN], 1u);
            else XB_SPIN(xb_ld(&bar[XB_TOPGEN]) == tg, bar);
            __builtin_amdgcn_fence(__ATOMIC_ACQUIRE, "agent");
            xb_add(&bar[XB_XGEN(b.x)], 1u);
            asm volatile("s_waitcnt vmcnt(0)" ::: "memory");
        } else {
            __builtin_amdgcn_fence(__ATOMIC_ACQUIRE, "agent");
            XB_SPIN(xb_ld(&bar[XB_XGEN(b.x)]) == gen, bar);
            asm volatile("s_waitcnt vmcnt(0)" ::: "memory");
        }
    }
    __syncthreads();
}
constexpr int NWAVES = 8;
constexpr size_t MiB = 1u << 20;
constexpr size_t WS_CTL = 0, CTL_ZERO_BYTES = 65536;
constexpr size_t WS_W1 = 1 * MiB, WS_WO = 6 * MiB, WS_WGU = 8 * MiB, WS_WD = 19 * MiB, WS_WPG = 25 * MiB, WS_WPP = 27 * MiB;
constexpr size_t WS_RX = 28 * MiB, WS_SS1 = 29 * MiB, WS_SS2 = 32 * MiB;
constexpr size_t WS_XB = 36 * MiB;
constexpr size_t WS_PB = 102 * MiB, WS_PP = 119 * MiB;
constexpr size_t WS_Q = 185 * MiB, WS_KP = 218 * MiB, WS_VP = 250 * MiB, WS_KS = 282 * MiB, WS_VS = 300 * MiB, WS_GLU = 318 * MiB, WS_MIX = 351 * MiB;
constexpr size_t WS_ACT = 185 * MiB;
constexpr size_t WS_END = 417 * MiB;
static_assert(WS_XB + (size_t)R * D * 2 <= WS_PB && WS_PB + (size_t)R * PLE * 2 <= WS_PP && WS_PP + (size_t)R * D * 2 <= WS_Q && WS_Q + (size_t)R * 512 * 2 <= WS_KP &&
              WS_KP + (size_t)(RP / 64) * KVT_BYTES <= WS_KS && WS_KS + (size_t)DB * 9 * KVT_BYTES <= WS_GLU && WS_GLU + (size_t)R * 512 * 2 <= WS_MIX &&
              WS_MIX + (size_t)R * D * 2 <= WS_END && WS_ACT + (size_t)R * DFF * 2 <= WS_END && WS_SS1 + (size_t)R * 64 <= WS_SS2 && WS_SS2 + (size_t)R * 64 <= WS_XB && WS_RX + (size_t)R * 4 <= WS_SS1, "d_ws map");
constexpr int CW_BAR = 4096, CW_Q = 8192, CW_QG = CW_Q + 64 * 32;
constexpr int RING_OFF = 0, RING_BYTES = 131072;
constexpr int LDSCTL_OFF = RING_BYTES, MISC_OFF = LDSCTL_OFF + 320;
constexpr int ATT_TAB = 132096, ATT_LSC = ATT_TAB + 8192;
constexpr int LDS_BYTES = 147456;
static_assert(ATT_LSC + 2048 <= LDS_BYTES && MISC_OFF + 128 <= ATT_TAB, "LDS map");

__device__ __forceinline__ float wave_sum(float v) {
#pragma unroll
    for (int o = 1; o < 64; o <<= 1) v += __shfl_xor(v, o);
    return v;
}
__device__ __forceinline__ float wave_max(float v) {
#pragma unroll
    for (int o = 1; o < 64; o <<= 1) v = fmaxf(v, __shfl_xor(v, o));
    return v;
}
__device__ __forceinline__ int map_win(int n) {
    if (n < 1536) { const int sec = n >> 9, nn = n & 511, h = nn >> 6, d = nn & 63; return sec * 512 + 256 * (h >> 2) + 128 * (d >> 5) + 32 * (h & 3) + (d & 31); }
    if (n < 2048) { const int i = n - 1536; return 1536 + 256 * (i >> 7) + (i & 127); }
    const int i = n - 2048; return 1536 + 256 * (i >> 7) + 128 + (i & 127);
}
__device__ __forceinline__ int map_gu(int n) {
    if (n < DFF) return 256 * (n >> 7) + (n & 127);
    const int i = n - DFF; return 256 * (i >> 7) + 128 + (i & 127);
}
template <int MAP> __device__ __forceinline__ void p0_transpose_item(const float* W, const float* gain, int K, int N, bf16* WT, LAS float* scr, int item, int lane) {
    const int nblk = N / 32, kb = item / nblk, nb = item % nblk, k0 = 64 * kb, n0 = 32 * nb;
    { const int nq = lane & 7, kr = lane >> 3; f32x4 v[8];
#pragma unroll
      for (int i = 0; i < 8; ++i) v[i] = __builtin_nontemporal_load((const GAS f32x4*)(W + (size_t)(k0 + 8 * i + kr) * N + n0 + 4 * nq));
#pragma unroll
      for (int i = 0; i < 8; ++i) { const int kk = 8 * i + kr; const float gk = gain ? gain[k0 + kk] : 1.0f;
#pragma unroll
          for (int e = 0; e < 4; ++e) scr[kk * 33 + 4 * nq + e] = v[i][e] * gk; } }
    LDS_WAIT(); asm volatile("" ::: "memory");
    const int c = lane & 7;
#pragma unroll
    for (int j = 0; j < 4; ++j) { const int n = (lane >> 3) + 8 * j; const LAS float* s = scr + (8 * c) * 33 + n;
        v4u o; o.x = pk2(s[0 * 33], s[1 * 33]); o.y = pk2(s[2 * 33], s[3 * 33]); o.z = pk2(s[4 * 33], s[5 * 33]); o.w = pk2(s[6 * 33], s[7 * 33]);
        const int ns = n0 + n, dr = MAP == 0 ? ns : (MAP == 1 ? map_win(ns) : map_gu(ns));
        *(GAS v4u*)(WT + (size_t)dr * K + k0 + 8 * c) = o; }
    LDS_WAIT(); asm volatile("" ::: "memory");
}

namespace att {
typedef short bf16x8 __attribute__((ext_vector_type(8)));
typedef short s16x4 __attribute__((ext_vector_type(4)));
typedef float f32x16 __attribute__((ext_vector_type(16)));
typedef unsigned u32x4 __attribute__((ext_vector_type(4)));
typedef float f32x2_t __attribute__((ext_vector_type(2))); typedef __bf16 bf16x2_t __attribute__((ext_vector_type(2)));
typedef short v4i16_t __attribute__((ext_vector_type(4)));
typedef LAS const char* lds_cptr;
constexpr int BUFB = 65536, HSLOT = 16384;
__device__ __forceinline__ int crow(int r, int hi) { return (r & 3) + 8 * (r >> 2) + 4 * hi; }
__device__ __forceinline__ void glds16(const void* gsrc, unsigned lds_dst) { unsigned keep;
    asm volatile("s_mov_b32 %0, m0\n\ts_mov_b32 m0, %2\n\ts_nop 0\n\tglobal_load_lds_dwordx4 %1, off\n\ts_mov_b32 m0, %0" : "=&s"(keep) : "v"(gsrc), "s"(lds_dst) : "memory"); }
__device__ __forceinline__ unsigned cvtpk_s(float lo, float hi) { f32x2_t v = {lo, hi}; bf16x2_t b = __builtin_convertvector(v, bf16x2_t); return __builtin_bit_cast(unsigned, b); }
__device__ __forceinline__ s16x4 vtr(lds_cptr p) { return __builtin_bit_cast(s16x4, __builtin_amdgcn_ds_read_tr16_b64_v4i16((LAS v4i16_t*)p)); }
#define ATT_WAIT_BAR() asm volatile("s_waitcnt vmcnt(0) lgkmcnt(0)\n\ts_barrier" ::: "memory")

struct AUnit { const bf16* Qrow; const unsigned char* KV; bf16* Orow; int nt, hg, sample, c0rel; };

__device__ __forceinline__ void attn_prefetch(const AUnit& U, LAS unsigned char* lds, int wid, int lane, bf16x8 (&qr)[2][4]) {
    const int r32 = lane & 31, hi = lane >> 5, hl = wid & 3, ci = wid >> 2, head = 4 * U.hg + hl;
    const bool wact = !U.sample || ci == 0;
    const unsigned char* kvsrc = U.KV + U.hg * 65536 + wid * 1024 + lane * 16;
    const unsigned kvdst = (unsigned)(size_t)lds + wid * 1024;
#pragma unroll
    for (int j_ = 0; j_ < 8; ++j_) glds16(kvsrc + j_ * 8192, (unsigned)__builtin_amdgcn_readfirstlane(kvdst + j_ * 8192));
    const bf16* Qw = U.Qrow + (size_t)((wact ? 64 * ci : 0) + r32) * 512 + head * 64 + hi * 8; const bf16* Qw1 = Qw + (U.sample ? 0 : 32 * 512);
#pragma unroll
    for (int d0 = 0; d0 < 4; ++d0) { qr[0][d0] = *(const bf16x8*)(Qw + d0 * 16); qr[1][d0] = *(const bf16x8*)(Qw1 + d0 * 16); }
}
template <bool TWO> __device__ __forceinline__ void attn_steps(const AUnit& U, LAS unsigned char* lds, int wid, int lane, const bf16x8 (&qr)[2][4], f32x16 (&o)[2][2], float (&lsum)[2]) {
    const int r32 = lane & 31, hi = lane >> 5, hl = wid & 3, ci = wid >> 2, head = 4 * U.hg + hl, nt = U.nt, own = U.c0rel + ci;
    const bool wact = TWO || ci == 0;
    const unsigned lds0 = (unsigned)(size_t)lds;
    const LAS float* tabh = (const LAS float*)(lds + ATT_TAB) + head * 256;
    const unsigned char* kvsrc = U.KV + U.hg * 65536 + wid * 1024 + lane * 16;
    const unsigned kvdst = lds0 + wid * 1024;
#define ATT_DMA(ti, b) do { _Pragma("unroll") for (int j_ = 0; j_ < 8; ++j_) \
        glds16(kvsrc + (size_t)(ti) * KVT_BYTES + j_ * 8192, (unsigned)__builtin_amdgcn_readfirstlane(kvdst + (b) * BUFB + j_ * 8192)); } while (0)
    for (int ti = 0; ti < nt; ++ti) {
        ATT_WAIT_BAR();
        const int b = ti & 1;
        if (ti + 1 < nt) ATT_DMA(ti + 1, b ^ 1);
        const int jt = own - ti;
        if (wact && jt >= 0 && jt <= 8) {
            const float m1 = (!TWO && jt == 0) ? 0.f : 1.f;
            const lds_cptr kp = (lds_cptr)(lds + b * BUFB + hl * HSLOT + hi * 1024 + r32 * 16);
            bf16x8 kf[8];
            { const unsigned ka = (unsigned)(size_t)kp;
              asm volatile("ds_read_b128 %0, %8\n\tds_read_b128 %1, %8 offset:512\n\tds_read_b128 %2, %8 offset:2048\n\tds_read_b128 %3, %8 offset:2560\n\t"
                           "ds_read_b128 %4, %8 offset:4096\n\tds_read_b128 %5, %8 offset:4608\n\tds_read_b128 %6, %8 offset:6144\n\tds_read_b128 %7, %8 offset:6656\n\ts_waitcnt lgkmcnt(0)"
                           : "=&v"(kf[0]), "=&v"(kf[1]), "=&v"(kf[2]), "=&v"(kf[3]), "=&v"(kf[4]), "=&v"(kf[5]), "=&v"(kf[6]), "=&v"(kf[7]) : "v"(ka) : "memory");
              __builtin_amdgcn_sched_barrier(0); }
            f32x16 s[2][2]; s[0][0] = f32x16{}; s[0][1] = f32x16{}; s[1][0] = f32x16{}; s[1][1] = f32x16{};
#pragma unroll
            for (int h2 = 0; h2 < (TWO ? 2 : 1); ++h2)
#pragma unroll
                for (int d0 = 0; d0 < 4; ++d0) { s[h2][0] = __builtin_amdgcn_mfma_f32_32x32x16_bf16(kf[2 * d0], qr[h2][d0], s[h2][0], 0, 0, 0);
                                                 s[h2][1] = __builtin_amdgcn_mfma_f32_32x32x16_bf16(kf[2 * d0 + 1], qr[h2][d0], s[h2][1], 0, 0, 0); }
            u32x4 pw[2][4];
#pragma unroll
            for (int h2 = 0; h2 < (TWO ? 2 : 1); ++h2) {
                f32x16& p0 = s[h2][0]; f32x16& p1 = s[h2][1];
                if (jt < 3) { const LAS float* tp = tabh + (191 - (32 * h2 + r32) - 64 * jt + 4 * hi);
#pragma unroll
                    for (int r = 0; r < 16; ++r) { p0[r] += tp[(r & 3) + 8 * (r >> 2)]; p1[r] += tp[32 + (r & 3) + 8 * (r >> 2)]; } }
                float sacc = 0.f;
#pragma unroll
                for (int r = 0; r < 16; ++r) { p0[r] = __builtin_amdgcn_exp2f(p0[r]); p1[r] = __builtin_amdgcn_exp2f(p1[r]); if (!TWO) p1[r] *= m1; sacc += p0[r] + p1[r]; }
                lsum[h2] += sacc;
#pragma unroll
                for (int k = 0; k < 2; ++k) { pw[h2][k] = (u32x4){cvtpk_s(p0[8 * k], p0[8 * k + 1]), cvtpk_s(p0[8 * k + 2], p0[8 * k + 3]), cvtpk_s(p0[8 * k + 4], p0[8 * k + 5]), cvtpk_s(p0[8 * k + 6], p0[8 * k + 7])};
                    pw[h2][2 + k] = (u32x4){cvtpk_s(p1[8 * k], p1[8 * k + 1]), cvtpk_s(p1[8 * k + 2], p1[8 * k + 3]), cvtpk_s(p1[8 * k + 4], p1[8 * k + 5]), cvtpk_s(p1[8 * k + 6], p1[8 * k + 7])}; }
            }
            const lds_cptr vp = (lds_cptr)(lds + b * BUFB + hl * HSLOT + 8192 + ((lane >> 4) & 1) * 32 + (lane & 3) * 8 + (4 * hi + ((lane & 15) >> 2)) * 64);
            const unsigned va = (unsigned)(size_t)vp;
#pragma unroll
            for (int d0 = 0; d0 < 2; ++d0) {
                s16x4 lo[4], hh[4];
                asm volatile("ds_read_b64_tr_b16 %0, %8 offset:%c9\n\tds_read_b64_tr_b16 %1, %8 offset:%c10\n\tds_read_b64_tr_b16 %2, %8 offset:%c11\n\tds_read_b64_tr_b16 %3, %8 offset:%c12\n\t"
                             "ds_read_b64_tr_b16 %4, %8 offset:%c13\n\tds_read_b64_tr_b16 %5, %8 offset:%c14\n\tds_read_b64_tr_b16 %6, %8 offset:%c15\n\tds_read_b64_tr_b16 %7, %8 offset:%c16\n\ts_waitcnt lgkmcnt(0)"
                             : "=&v"(lo[0]), "=&v"(hh[0]), "=&v"(lo[1]), "=&v"(hh[1]), "=&v"(lo[2]), "=&v"(hh[2]), "=&v"(lo[3]), "=&v"(hh[3])
                             : "v"(va), "i"(d0 * 4096), "i"(d0 * 4096 + 512), "i"(d0 * 4096 + 1024), "i"(d0 * 4096 + 1536), "i"(d0 * 4096 + 2048), "i"(d0 * 4096 + 2560), "i"(d0 * 4096 + 3072), "i"(d0 * 4096 + 3584) : "memory");
                __builtin_amdgcn_sched_barrier(0);
#pragma unroll
                for (int ks = 0; ks < 4; ++ks) {
                    const bf16x8 vf = (bf16x8){lo[ks][0], lo[ks][1], lo[ks][2], lo[ks][3], hh[ks][0], hh[ks][1], hh[ks][2], hh[ks][3]};
                    o[0][d0] = __builtin_amdgcn_mfma_f32_32x32x16_bf16(__builtin_bit_cast(bf16x8, pw[0][ks]), vf, o[0][d0], 0, 0, 0);
                    if (TWO) o[1][d0] = __builtin_amdgcn_mfma_f32_32x32x16_bf16(__builtin_bit_cast(bf16x8, pw[1][ks]), vf, o[1][d0], 0, 0, 0); }
            }
        }
    }
#undef ATT_DMA
}
template <bool TWO> __device__ __forceinline__ void attn_store(const AUnit& U, LAS unsigned char* lds, int wid, int lane, const f32x16 (&o)[2][2], const float (&lsum)[2]) {
    const int r32 = lane & 31, hi = lane >> 5, hl = wid & 3, ci = wid >> 2, head = 4 * U.hg + hl;
    const bool wact = TWO || ci == 0;
    LAS float* lsc = (LAS float*)(lds + ATT_LSC) + wid * 64;
    if (wact) {
#pragma unroll
        for (int h2 = 0; h2 < (TWO ? 2 : 1); ++h2) {
            float ls = lsum[h2];
            { auto rr = __builtin_amdgcn_permlane32_swap(__float_as_uint(ls), __float_as_uint(ls), false, false); ls = __uint_as_float(rr[0]) + __uint_as_float(rr[1]); }
            if (hi == 0) lsc[32 * h2 + r32] = ls;
            asm volatile("s_waitcnt lgkmcnt(0)" ::: "memory");
            LAS bf16* stg = (LAS bf16*)(lds + BUFB + wid * 8192 + h2 * 4096);
#pragma unroll
            for (int r = 0; r < 16; ++r) { const int orow = crow(r, hi); const float rl = __builtin_amdgcn_rcpf(lsc[32 * h2 + orow]);
#pragma unroll
                for (int d0 = 0; d0 < 2; ++d0) stg[orow * 64 + d0 * 32 + r32] = (bf16)f2bf(o[h2][d0][r] * rl); }
            asm volatile("s_waitcnt lgkmcnt(0)" ::: "memory");
            bf16* Ow = U.Orow + (size_t)(64 * ci + 32 * h2) * D + head * 64;
#pragma unroll
            for (int i = 0; i < 4; ++i) { const int row = i * 8 + (lane >> 3), ch = lane & 7; const u32x4 v = *(const LAS u32x4*)(stg + row * 64 + ch * 8); *(u32x4*)(Ow + (size_t)row * D + ch * 8) = v; }
        }
    }
}
}

__device__ __forceinline__ float wave_sum_dpp(float v) {
#define DPP_ADD(ctrl, rmask) v += __builtin_bit_cast(float, __builtin_amdgcn_update_dpp(0, __builtin_bit_cast(int, v), ctrl, rmask, 0xf, true))
    DPP_ADD(0x111, 0xf); DPP_ADD(0x112, 0xf); DPP_ADD(0x114, 0xf); DPP_ADD(0x118, 0xf); DPP_ADD(0x142, 0xa); DPP_ADD(0x143, 0xc);
#undef DPP_ADD
    return __builtin_bit_cast(float, __builtin_amdgcn_readlane(__builtin_bit_cast(int, v), 63));
}
#define CV_WAIT_BAR(N) asm volatile("s_waitcnt vmcnt(" #N ") lgkmcnt(0)\n\ts_barrier" ::: "memory")
typedef float f32x2v __attribute__((ext_vector_type(2)));
struct ConvConst { f32x2v w[CONVW]; f32x2v bias; };
__device__ __forceinline__ void conv_consts(ConvConst& C, const float* cw, const float* cb, int tid) {
    const int cp = tid & 255;
#pragma unroll
    for (int j = 0; j < CONVW; ++j) C.w[j] = *(const f32x2v*)(cw + j * CW + 2 * cp);
    C.bias = *(const f32x2v*)(cb + 2 * cp);
}
__device__ __forceinline__ void conv_entry(int e, const ConvConst& C, const bf16* GLU, const float* st, const float* lg, const float* lb, bf16* MIX, LAS unsigned char* lds, int tid) {
    const bool samp = e >= RP / 64; const int b = samp ? e - RP / 64 : e >> 7, t0 = samp ? 0 : (e & 127) * 64, nb = samp ? 2 : 4, rowbase = samp ? RP + DS * b : b * SEQ;
    const int wid = __builtin_amdgcn_readfirstlane(tid >> 6), lane = tid & 63, cp = tid & 255, th = tid >> 8;
    const bool first = t0 == 0;
    LAS bf16* xs = (LAS bf16*)lds;
    LAS float* ybuf = (LAS float*)(lds + 98304);
    const unsigned lds0 = (unsigned)(size_t)lds;
    const int tlast = t0 + 16 * nb - 1;
    f32x4 g0 = *(const f32x4*)(lg + 8 * lane), g1 = *(const f32x4*)(lg + 8 * lane + 4), b0 = *(const f32x4*)(lb + 8 * lane), b1 = *(const f32x4*)(lb + 8 * lane + 4);
    asm volatile("" : "+v"(g0), "+v"(g1), "+v"(b0), "+v"(b1));
#pragma unroll
    for (int i = 0; i < 12; ++i) { const int k = wid + 8 * i; int tp = t0 - CH + k; tp = tp > tlast ? tlast : tp;
        if (tp >= 0) att::glds16(GLU + (size_t)(rowbase + tp) * 512 + 8 * lane, (unsigned)__builtin_amdgcn_readfirstlane(lds0 + (unsigned)k * 1024u));
        else { pg8::u32x4 v = (pg8::u32x4){0u, 0u, 0u, 0u};
            if (samp) { const float* sp = st + ((size_t)b * CH + (CH + tp)) * CW + 8 * lane; v = pg8::pack8(*(const f32x4*)sp, *(const f32x4*)(sp + 4)); }
            *(LAS pg8::u32x4*)(xs + k * 512 + 8 * lane) = v; } }
    for (int s = 0; s < nb; ++s) {
        if (first || s == 3) CV_WAIT_BAR(0); else if (s == 0) CV_WAIT_BAR(6); else if (s == 1) CV_WAIT_BAR(4); else CV_WAIT_BAR(2);
        {
            f32x2v x[38];
            const LAS unsigned* xp = (const LAS unsigned*)(xs + (16 * s + 8 * th) * 512 + 2 * cp);
#pragma unroll
            for (int k = 0; k < 38; ++k) { const unsigned u = xp[k * 256]; x[k] = (f32x2v){__uint_as_float(u << 16), __uint_as_float(u & 0xffff0000u)}; }
            f32x2v y[8];
#pragma unroll
            for (int i = 0; i < 8; ++i) y[i] = C.bias;
#pragma unroll
            for (int j = 0; j < CONVW; ++j)
#pragma unroll
                for (int i = 0; i < 8; ++i) y[i] = __builtin_elementwise_fma(C.w[j], x[i + j], y[i]);
#pragma unroll
            for (int i = 0; i < 8; ++i) *(LAS f32x2v*)(ybuf + (8 * th + i) * 512 + 2 * cp) = y[i];
        }
        __syncthreads();
#pragma unroll
        for (int q = 0; q < 2; ++q) { const int i = 2 * wid + q;
            f32x4 v0 = *(const LAS f32x4*)(ybuf + i * 512 + 8 * lane), v1 = *(const LAS f32x4*)(ybuf + i * 512 + 8 * lane + 4);
            const float mean = wave_sum_dpp((v0[0] + v0[1]) + (v0[2] + v0[3]) + (v1[0] + v1[1]) + (v1[2] + v1[3])) * (1.0f / CW);
            v0 = v0 - mean; v1 = v1 - mean;
            const f32x4 q0 = v0 * v0, q1 = v1 * v1;
            const float rstd = rsqrtf(wave_sum_dpp((q0[0] + q0[1]) + (q0[2] + q0[3]) + (q1[0] + q1[1]) + (q1[2] + q1[3])) * (1.0f / CW) + EPS);
            v0 = v0 * rstd * g0 + b0; v1 = v1 * rstd * g1 + b1;
#pragma unroll
            for (int e2 = 0; e2 < 4; ++e2) { v0[e2] *= pg8::sigm(v0[e2]); v1[e2] *= pg8::sigm(v1[e2]); }
            *(pg8::u32x4*)(MIX + (size_t)(rowbase + t0 + 16 * s + i) * D + 512 + 8 * lane) = pg8::pack8(v0, v1); }
        __syncthreads();
    }
}

constexpr int SG_LD = 68;
#define SG_WAIT_BAR(N) asm volatile("s_waitcnt vmcnt(" #N ") lgkmcnt(0)\n\ts_barrier" ::: "memory")
template <class Epi> __device__ __forceinline__ void sgemm64(const bf16* A, const bf16* Bt, int K_, int tile, const Epi& E, LAS unsigned char* lds) {
    int tid_ = threadIdx.x; asm volatile("" : "+v"(tid_)); int K = K_; asm volatile("" : "+s"(K));
    const int lane = tid_ & 63, wave = __builtin_amdgcn_readfirstlane(tid_ >> 6), fr = lane & 15, fq = lane >> 4, wm = wave & 3, wn = wave >> 2, tr = tile >> 4, tc = tile & 15;
    const int KS = K >> 7;
    const unsigned char* src[4]; unsigned dsto[4];
#pragma unroll
    for (int i = 0; i < 4; ++i) { const int p = wave + 8 * i, r = 4 * (p & 15) + (lane >> 4), cs = (lane & 15) ^ (r & 15);
        src[i] = (const unsigned char*)((p < 16 ? A + (size_t)(64 * tr + r) * K : Bt + (size_t)(64 * tc + r) * K)) + cs * 16;
        dsto[i] = (p < 16 ? 0u : 16384u) + (unsigned)(p & 15) * 1024u; }
    const unsigned lds0 = (unsigned)(size_t)lds;
#define SG_STAGE(t) do { _Pragma("unroll") for (int i_ = 0; i_ < 4; ++i_) att::glds16(src[i_] + (size_t)(t) * 256, (unsigned)__builtin_amdgcn_readfirstlane(lds0 + (unsigned)((t) & 3) * 32768u + dsto[i_])); } while (0)
    f32x4 acc0 = (f32x4){0.f, 0.f, 0.f, 0.f}, acc1 = acc0;
    SG_STAGE(0); if (KS > 1) SG_STAGE(1); if (KS > 2) SG_STAGE(2);
    const unsigned ra = (unsigned)(16 * wm + fr) * 256u, rb = 16384u + (unsigned)(32 * wn + fr) * 256u;
    for (int t = 0; t < KS; ++t) {
        if (t + 2 < KS) SG_WAIT_BAR(8); else if (t + 1 < KS) SG_WAIT_BAR(4); else SG_WAIT_BAR(0);
        if (t + 3 < KS) SG_STAGE(t + 3);
        const LAS unsigned char* sb = lds + (t & 3) * 32768;
#pragma unroll
        for (int ks = 0; ks < 4; ++ks) { const unsigned ch = (unsigned)((4 * ks + fq) ^ fr) * 16u;
            const bf16x8 a = *(const LAS bf16x8*)(sb + ra + ch), b0 = *(const LAS bf16x8*)(sb + rb + ch), b1 = *(const LAS bf16x8*)(sb + rb + 4096 + ch);
            acc0 = __builtin_amdgcn_mfma_f32_16x16x32_bf16(b0, a, acc0, 0, 0, 0); acc1 = __builtin_amdgcn_mfma_f32_16x16x32_bf16(b1, a, acc1, 0, 0, 0); }
    }
#undef SG_STAGE
    SG_WAIT_BAR(0);
    LAS float* part = (LAS float*)lds;
    *(LAS f32x4*)(part + (16 * wm + fr) * SG_LD + 32 * wn + 4 * fq) = acc0; *(LAS f32x4*)(part + (16 * wm + fr) * SG_LD + 32 * wn + 16 + 4 * fq) = acc1;
    __syncthreads();
    const int row = tid_ >> 3, c8 = (tid_ & 7) * 8;
    const f32x4 v0 = *(const LAS f32x4*)(part + row * SG_LD + c8), v1 = *(const LAS f32x4*)(part + row * SG_LD + c8 + 4);
    E(64 * tr + row, 64 * tc + c8, tc, tid_ & 7, v0, v1);
    __syncthreads();
}
__device__ __forceinline__ float oct_sum(float s) { s += __shfl_xor(s, 1); s += __shfl_xor(s, 2); s += __shfl_xor(s, 4); return s; }
template <bool BF> struct SEpiRes {
    const float* base; bf16* HB; float* SS;
    __device__ __forceinline__ void operator()(int row, int col, int tc, int l8, f32x4 v0, f32x4 v1) const {
        const size_t o = (size_t)row * D + col;
        if (BF) { const pg8::u32x4 w = *(const pg8::u32x4*)(HB + o); v0 = v0 + pg8::bf_lo4(w); v1 = v1 + pg8::bf_hi4(w); }
        else { v0 = v0 + *(const f32x4*)(base + o); v1 = v1 + *(const f32x4*)(base + o + 4); }
        *(pg8::u32x4*)(HB + o) = pg8::pack8(v0, v1);
        const f32x4 q0 = v0 * v0, q1 = v1 * v1;
        const float ss = oct_sum(((q0[0] + q0[1]) + (q0[2] + q0[3])) + ((q1[0] + q1[1]) + (q1[2] + q1[3])));
        if (l8 == 0) SS[(size_t)row * 16 + tc] = ss;
    }
};
struct SEpiPP {
    bf16* PP;
    __device__ __forceinline__ void operator()(int row, int col, int tc, int l8, f32x4 v0, f32x4 v1) const { *(pg8::u32x4*)(PP + (size_t)row * D + col) = pg8::pack8(v0, v1); }
};
struct SEpiFinal {
    const float* SS; const bf16* PP; const bf16* HB; float* Y;
    __device__ __forceinline__ void operator()(int row, int col, int tc, int l8, f32x4 v0, f32x4 v1) const {
        const float r = rsqrtf(oct_sum(SS[(size_t)row * 16 + 2 * l8] + SS[(size_t)row * 16 + 2 * l8 + 1]) * (1.0f / D) + EPS);
        const size_t o = (size_t)row * D + col;
        const pg8::u32x4 pw = *(const pg8::u32x4*)(PP + o), hw = *(const pg8::u32x4*)(HB + o);
        const f32x4 p0 = pg8::bf_lo4(pw), p1 = pg8::bf_hi4(pw); f32x4 h0 = pg8::bf_lo4(hw), h1 = pg8::bf_hi4(hw);
#pragma unroll
        for (int e = 0; e < 4; ++e) { h0[e] += pg8::sigm(v0[e] * r) * p0[e]; h1[e] += pg8::sigm(v1[e] * r) * p1[e]; }
        __builtin_nontemporal_store(h0, (f32x4*)(Y + o)); __builtin_nontemporal_store(h1, (f32x4*)(Y + o + 4));
    }
};

#ifndef REP_P0
#define REP_P0 1
#endif
#ifndef REP_P1
#define REP_P1 1
#endif
#ifndef REP_P2
#define REP_P2 1
#endif
#ifndef REP_P3
#define REP_P3 1
#endif
#ifndef REP_P4
#define REP_P4 1
#endif
struct Args { const float* in[23]; float* out; unsigned char* ws; };
constexpr int N_ATT_S = 2 * DB, N_ATT_P = NB * 64 * 2, N_CONV = RP / 64 + DB;
constexpr int I_WO = (D / 64) * (D / 32), I_WGU = (D / 64) * (2 * DFF / 32), N_WCV = (I_WO + I_WGU) / 8;
constexpr int N_ATT_Q = 8 + 64;
static_assert((I_WO + I_WGU) % 8 == 0, "weight conversion entries");
#define W1t ((bf16*)(ws + WS_W1))
#define WOt ((bf16*)(ws + WS_WO))
#define WGUt ((bf16*)(ws + WS_WGU))
#define WDt ((bf16*)(ws + WS_WD))
#define WPGt ((bf16*)(ws + WS_WPG))
#define WPPt ((bf16*)(ws + WS_WPP))
#define RX ((float*)(ws + WS_RX))
#define SS1 ((float*)(ws + WS_SS1))
#define SS2 ((float*)(ws + WS_SS2))
#define XB ((bf16*)(ws + WS_XB))
#define PB ((bf16*)(ws + WS_PB))
#define PPb ((bf16*)(ws + WS_PP))
#define Qb ((bf16*)(ws + WS_Q))
#define KVP (ws + WS_KP)
#define KVS (ws + WS_KS)
#define GLUb ((bf16*)(ws + WS_GLU))
#define MIXb ((bf16*)(ws + WS_MIX))
#define ACTb ((bf16*)(ws + WS_ACT))
#define Y (out + OY)
__global__ void __launch_bounds__(NWAVES * 64, 2) mk_fwd(Args args) {
    extern __shared__ __attribute__((aligned(16))) unsigned char lds_[];
    LAS unsigned char* lds = (LAS unsigned char*)lds_;
    volatile LAS unsigned* MISC = (volatile LAS unsigned*)(lds + MISC_OFF);
    const int G = gridDim.x, vcu = (G % 8 == 0) ? ((int)blockIdx.x % 8) * (G / 8) + (int)blockIdx.x / 8 : (int)blockIdx.x;
    unsigned char* ws = args.ws; float* out = args.out;
    gu32* ctl = (gu32*)(ws + WS_CTL);
    for (int u = threadIdx.x; u < (ATT_TAB - LDSCTL_OFF) / 4; u += NWAVES * 64) ((LAS unsigned*)(lds + LDSCTL_OFF))[u] = 0u;
    __syncthreads();
    XcdBarrier bar = xcd_barrier_post((unsigned*)(ctl + CW_BAR), MISC + 8);

#ifndef SKIP_P0
    for (int rep = 0; rep < REP_P0; ++rep) {
        if (rep) xcd_barrier(bar);
        int tid0 = threadIdx.x; asm volatile("" : "+v"(tid0));
        const int lane = tid0 & 63, wave = __builtin_amdgcn_readfirstlane(tid0 >> 6);
        LAS float* scr = (LAS float*)(lds + RING_OFF + wave * 16384);
        const int gw = vcu * NWAVES + wave, NGW = G * NWAVES;
        constexpr int I_1 = (D / 64) * (INC / 32);
        for (int it = gw; it < I_1; it += NGW) p0_transpose_item<1>(args.in[8], args.in[7], D, INC, W1t, scr, it, lane);
        for (int m2 = gw; m2 < R / 2; m2 += NGW) {
            f32x4 v[2][4];
#pragma unroll
            for (int rr = 0; rr < 2; ++rr) { const int m = 2 * m2 + rr; const float* xrow = m < RP ? args.in[0] + (size_t)m * D : args.in[1] + (size_t)(m - RP) * D;
                const GAS f32x4* xr = (const GAS f32x4*)xrow + lane;
#pragma unroll
                for (int j = 0; j < 4; ++j) v[rr][j] = __builtin_nontemporal_load(xr + 64 * j); }
#pragma unroll
            for (int rr = 0; rr < 2; ++rr) { const int m = 2 * m2 + rr; float s = 0.f;
#pragma unroll
                for (int j = 0; j < 4; ++j) s += (v[rr][j].x * v[rr][j].x + v[rr][j].y * v[rr][j].y) + (v[rr][j].z * v[rr][j].z + v[rr][j].w * v[rr][j].w);
                s = wave_sum(s); if (lane == 0) RX[m] = rsqrtf(s * (1.0f / D) + EPS);
                GAS unsigned long long* o8 = (GAS unsigned long long*)(XB + (size_t)m * D) + lane;
#pragma unroll
                for (int j = 0; j < 4; ++j) o8[64 * j] = (unsigned long long)pk2(v[rr][j].x, v[rr][j].y) | ((unsigned long long)pk2(v[rr][j].z, v[rr][j].w) << 32); }
        }
    }
#endif
    xcd_barrier(bar);

#ifndef SKIP_P1
    for (int rep = 0; rep < REP_P1; ++rep) {
        if (rep) xcd_barrier(bar);
        pg8::Gemm g{XB, W1t, R, INC, D}; pg8::StaticOrder S; S.init(R, INC, G, (int)blockIdx.x);
        pg8::Epi1 E{RX, args.in[9], args.in[10], Qb, KVP, KVS, GLUb, out};
        pg8::gemm_phase<pg8::Epi1, pg8::StaticOrder, true, true>(lds + RING_OFF, g, S, E);
        { const int c0 = ((R / 256) * (INC / 256)) % G, nwgc = c0 ? G - c0 : G, cc = c0 ? (int)blockIdx.x - c0 : (int)blockIdx.x;
          if (cc >= 0) {
            int tidc = threadIdx.x; asm volatile("" : "+v"(tidc));
            const int lane = tidc & 63, wave = __builtin_amdgcn_readfirstlane(tidc >> 6), head = lane >> 3, dq = lane & 7;
            for (int m2 = cc * NWAVES + wave; m2 < DB * 512; m2 += nwgc * NWAVES) {
                const int b = m2 >> 9, j = m2 & 511, kv = j & 63;
                const GAS f32x4* sk = (const GAS f32x4*)(args.in[4] + (size_t)m2 * 512) + 2 * lane; const GAS f32x4* sv = (const GAS f32x4*)(args.in[5] + (size_t)m2 * 512) + 2 * lane;
                const f32x4 k0 = __builtin_nontemporal_load(sk), k1 = __builtin_nontemporal_load(sk + 1), v0 = __builtin_nontemporal_load(sv), v1 = __builtin_nontemporal_load(sv + 1);
                unsigned char* tb = KVS + (size_t)(b * 9 + (j >> 6)) * KVT_BYTES + (head >> 2) * 65536 + (head & 3) * 16384;
                *(GAS v4u*)(tb + dq * 1024 + kv * 16) = (v4u){pk2(k0.x, k0.y), pk2(k0.z, k0.w), pk2(k1.x, k1.y), pk2(k1.z, k1.w)};
                *(GAS v4u*)(tb + 8192 + (dq >> 2) * 4096 + (kv >> 4) * 1024 + (kv & 15) * 64 + (dq & 3) * 16) = (v4u){pk2(v0.x, v0.y), pk2(v0.z, v0.w), pk2(v1.x, v1.y), pk2(v1.z, v1.w)};
            }
            for (int p = cc * NWAVES + wave; p < DB * NH; p += nwgc * NWAVES) {
                unsigned char* tb = KVS + (size_t)((p >> 3) * 9 + 8) * KVT_BYTES + ((p & 7) >> 2) * 65536 + (p & 3) * 16384; const v4u z = (v4u){0u, 0u, 0u, 0u};
#pragma unroll
                for (int c2 = 0; c2 < 4; ++c2) *(GAS v4u*)(tb + (2 * c2 + (lane >> 5)) * 1024 + 512 + (lane & 31) * 16) = z;
#pragma unroll
                for (int q = 0; q < 4; ++q) *(GAS v4u*)(tb + 8192 + (q >> 1) * 4096 + (2 + (q & 1)) * 1024 + lane * 16) = z;
            }
          } }
    }
#endif
    xcd_barrier(bar);

#ifndef SKIP_P2
    for (int rep = 0; rep < REP_P2; ++rep) {
        if (rep) xcd_barrier(bar);
        { int tidt = threadIdx.x; asm volatile("" : "+v"(tidt)); const int lane = tidt & 63, wave = __builtin_amdgcn_readfirstlane(tidt >> 6);
          const float* relb = args.in[11] + wave * NREL; LAS float* T = (LAS float*)(lds + ATT_TAB) + wave * 256;
          const float bfar = relb[256];
          for (int x = lane; x < 256; x += 64) { int dd = 191 - x; dd = dd < -128 ? -128 : (dd > 128 ? 128 : dd); T[x] = (relb[dd + 128] - bfar) * LOG2E; } }
        __syncthreads();
        {
            int tid2 = threadIdx.x; asm volatile("" : "+v"(tid2));
            const int lane2 = tid2 & 63, wave2 = __builtin_amdgcn_readfirstlane(tid2 >> 6);
            int qk = 0, q = (int)blockIdx.x & 7;
#define ATT_POP(qq) ((int)__hip_atomic_fetch_add((unsigned*)(ctl + CW_Q + 64 * ((qq) + 8 * rep)), 1u, __ATOMIC_RELAXED, __HIP_MEMORY_SCOPE_AGENT))
#define ATT_DECODE(code, U) do { const int q_ = (int)((code) >> 8), i_ = (int)((code) & 255u); \
                if (i_ < 8) { const int sb = 4 * q_ + (i_ >> 1); U.hg = i_ & 1; U.sample = 1; U.nt = 9; U.c0rel = 8; \
                    U.Qrow = Qb + (size_t)(RP + DS * sb) * 512; U.KV = KVS + (size_t)(sb * 9) * KVT_BYTES; U.Orow = MIXb + (size_t)(RP + DS * sb) * D; } \
                else { const int j = i_ - 8, pi = j < 60 ? 4 + j : 63 - j, bb = q_ >> 1, c0 = 2 * pi;     \
                    U.hg = q_ & 1; U.sample = 0; U.c0rel = c0 < 8 ? c0 : 8; U.nt = U.c0rel + 2; const size_t row0 = (size_t)bb * SEQ + 64 * c0; \
                    U.Qrow = Qb + row0 * 512; U.KV = KVP + (size_t)(bb * 128 + c0 - U.c0rel) * KVT_BYTES; U.Orow = MIXb + row0 * D; } } while (0)
            if (tid2 == 0) { int i = ATT_POP(q); while (i >= N_ATT_Q) { if (++qk == 8) { i = -1; break; } q = ((int)blockIdx.x + qk) & 7; i = ATT_POP(q); }
                MISC[4] = i < 0 ? 0xffffffffu : (unsigned)((q << 8) | i); }
            __syncthreads();
            unsigned code = MISC[4];
            if (code != 0xffffffffu) {
                att::AUnit U; ATT_DECODE(code, U);
                att::bf16x8 qr[2][4];
                att::attn_prefetch(U, lds, wave2, lane2, qr);
                for (;;) {
                    int nraw = 0; if (tid2 == 0) nraw = ATT_POP(q);
#pragma unroll
                    for (int d0 = 0; d0 < 4; ++d0) asm volatile("" : "+v"(qr[0][d0]), "+v"(qr[1][d0]));
                    att::f32x16 o[2][2]; o[0][0] = att::f32x16{}; o[0][1] = att::f32x16{}; o[1][0] = att::f32x16{}; o[1][1] = att::f32x16{}; float lsum[2] = {0.f, 0.f};
                    if (U.sample) att::attn_steps<false>(U, lds, wave2, lane2, qr, o, lsum); else att::attn_steps<true>(U, lds, wave2, lane2, qr, o, lsum);
                    if (tid2 == 0) { int i = nraw; while (i >= N_ATT_Q) { if (++qk == 8) { i = -1; break; } q = ((int)blockIdx.x + qk) & 7; i = ATT_POP(q); }
                        MISC[4] = i < 0 ? 0xffffffffu : (unsigned)((q << 8) | i); }
                    ATT_WAIT_BAR();
                    const unsigned ncode = MISC[4];
                    att::AUnit Un = U;
                    if (ncode != 0xffffffffu) { ATT_DECODE(ncode, Un); att::attn_prefetch(Un, lds, wave2, lane2, qr); }
                    if (U.sample) att::attn_store<false>(U, lds, wave2, lane2, o, lsum); else att::attn_store<true>(U, lds, wave2, lane2, o, lsum);
                    if (ncode == 0xffffffffu) break;
                    U = Un;
                }
                ATT_WAIT_BAR();
            }
#undef ATT_POP
#undef ATT_DECODE
        }
        ConvConst CC; { int tidc = threadIdx.x; asm volatile("" : "+v"(tidc)); conv_consts(CC, args.in[12], args.in[13], tidc); }
        for (;;) {
            int tid2 = threadIdx.x; asm volatile("" : "+v"(tid2));
            if (tid2 == 0) MISC[4] = __hip_atomic_fetch_add((unsigned*)(ctl + CW_QG + 64 * rep), 1u, __ATOMIC_RELAXED, __HIP_MEMORY_SCOPE_AGENT);
            __syncthreads();
            const int idx = (int)MISC[4];
            __syncthreads();
            if (idx >= N_CONV + N_WCV) break;
            const int lane2 = tid2 & 63, wave2 = __builtin_amdgcn_readfirstlane(tid2 >> 6);
            if (idx < N_CONV) conv_entry(idx, CC, GLUb, args.in[6], args.in[14], args.in[15], MIXb, lds, tid2);
            else { const int it = 8 * (idx - N_CONV) + wave2; LAS float* scr = (LAS float*)(lds + RING_OFF + wave2 * 16384);
                if (it < I_WO) p0_transpose_item<0>(args.in[16], nullptr, D, D, WOt, scr, it, lane2);
                else p0_transpose_item<2>(args.in[18], args.in[17], D, 2 * DFF, WGUt, scr, it - I_WO, lane2);
                __syncthreads(); }
        }
    }
#endif
    xcd_barrier(bar);

#ifndef SKIP_P3
    for (int rep = 0; rep < REP_P3; ++rep) {
        if (rep) xcd_barrier(bar);
        pg8::Gemm g{MIXb, WOt, RP, D, D}; pg8::StaticOrder S; S.init(RP, D, G, (int)blockIdx.x);
        pg8::EpiRes<true> E{nullptr, nullptr, XB, SS1};
        const SEpiRes<true> SE{nullptr, XB + (size_t)RP * D, SS1 + (size_t)RP * 16};
        if (blockIdx.x & 1) for (int t = (int)blockIdx.x; t < 256; t += G) sgemm64(MIXb + (size_t)RP * D, WOt, D, t, SE, lds + RING_OFF);
        pg8::gemm_phase<pg8::EpiRes<true>, pg8::StaticOrder, true, true>(lds + RING_OFF, g, S, E);
        if (!(blockIdx.x & 1)) for (int t = (int)blockIdx.x; t < 256; t += G) sgemm64(MIXb + (size_t)RP * D, WOt, D, t, SE, lds + RING_OFF);
    }
#endif
    xcd_barrier(bar);

#ifndef SKIP_P4
    for (int rep = 0; rep < REP_P4; ++rep) {
        if (rep) xcd_barrier(bar);
        { const int c0 = ((R / 256) * (2 * DFF / 256)) % G, nwgc = c0 ? G - c0 : G, cc = c0 ? (int)blockIdx.x - c0 : (int)blockIdx.x;
          if (cc >= 0) {
            const bool wt = false; const int k = wt ? cc & 3 : 1, j = wt ? cc >> 2 : cc, per = wt ? nwgc / 4 : nwgc, nslot = wt ? 6 * per : per;
            const int s0 = !wt ? j : (k == 1 ? j : (k == 2 ? per + 2 * j : 3 * per + 3 * j));
            int tidc = threadIdx.x; asm volatile("" : "+v"(tidc));
            const int lane = tidc & 63, wave = __builtin_amdgcn_readfirstlane(tidc >> 6);
            for (int q = 0; q < k; ++q)
            for (int m4 = s0 + q + nslot * wave; m4 < 2 * DB * 120; m4 += nslot * NWAVES) {
                const int kv = m4 >= DB * 120, mm = kv ? m4 - DB * 120 : m4, b = mm / 120, j2 = DS + 4 * (mm % 120);
                const GAS f32x4* src = (const GAS f32x4*)(args.in[4 + kv] + ((size_t)b * 512 + j2) * 512) + lane;
                GAS f32x4* dst = (GAS f32x4*)(out + (kv ? OVS : OKS) + ((size_t)b * 512 + (j2 - DS)) * 512) + lane;
                f32x4 v[8];
#pragma unroll
                for (int i = 0; i < 8; ++i) v[i] = __builtin_nontemporal_load(src + 64 * i);
#pragma unroll
                for (int i = 0; i < 8; ++i) __builtin_nontemporal_store(v[i], dst + 64 * i);
            }
            { LAS float* scr = (LAS float*)(lds + RING_OFF + wave * 16384); constexpr int I_D = (DFF / 64) * (D / 32), I_PG = (D / 64) * (D / 32);
              constexpr int I_PP = (PLE / 64) * (D / 32);
              for (int it = cc * NWAVES + wave; it < I_D + I_PG + I_PP; it += nwgc * NWAVES) {
                  if (it < I_D) p0_transpose_item<0>(args.in[19], nullptr, DFF, D, WDt, scr, it, lane);
                  else if (it < I_D + I_PG) p0_transpose_item<0>(args.in[21], args.in[20], D, D, WPGt, scr, it - I_D, lane);
                  else p0_transpose_item<0>(args.in[22], nullptr, PLE, D, WPPt, scr, it - I_D - I_PG, lane); }
              __syncthreads(); }
            for (int m8 = cc * NWAVES + wave; m8 < R / 8; m8 += nwgc * NWAVES) {
                const int m = 8 * m8; const float* prow = m < RP ? args.in[2] + (size_t)m * PLE : args.in[3] + (size_t)(m - RP) * PLE;
                const GAS f32x4* pr = (const GAS f32x4*)prow + lane; f32x4 pv[8];
#pragma unroll
                for (int j = 0; j < 8; ++j) pv[j] = __builtin_nontemporal_load(pr + 64 * j);
                GAS unsigned long long* o8 = (GAS unsigned long long*)(PB + (size_t)m * PLE) + lane;
#pragma unroll
                for (int j = 0; j < 8; ++j) o8[64 * j] = (unsigned long long)pk2(pv[j].x, pv[j].y) | ((unsigned long long)pk2(pv[j].z, pv[j].w) << 32);
            }
          } }
        pg8::Gemm g{XB, WGUt, R, 2 * DFF, D}; pg8::StaticOrder S; S.init(R, 2 * DFF, G, (int)blockIdx.x);
        pg8::EpiAct E{SS1, ACTb};
        pg8::gemm_phase<pg8::EpiAct, pg8::StaticOrder, true, true>(lds + RING_OFF, g, S, E);
    }
#endif
    xcd_barrier(bar);

#ifndef SKIP_P5
    {
        pg8::Gemm g{ACTb, WDt, RP, D, DFF}; pg8::StaticOrder S; S.init(RP, D, G, (int)blockIdx.x);
        pg8::EpiRes<true> E{nullptr, nullptr, XB, SS2};
        const SEpiRes<true> SE{nullptr, XB + (size_t)RP * D, SS2 + (size_t)RP * 16};
        if (blockIdx.x & 1) for (int t = (int)blockIdx.x; t < 256; t += G) sgemm64(ACTb + (size_t)RP * DFF, WDt, DFF, t, SE, lds + RING_OFF);
        pg8::gemm_phase<pg8::EpiRes<true>, pg8::StaticOrder, true, true>(lds + RING_OFF, g, S, E);
        if (!(blockIdx.x & 1)) for (int t = (int)blockIdx.x; t < 256; t += G) sgemm64(ACTb + (size_t)RP * DFF, WDt, DFF, t, SE, lds + RING_OFF);
    }
#endif
    xcd_barrier(bar);

#ifndef SKIP_P6
    {
        pg8::Gemm g{XB, WPGt, RP, D, D}; pg8::StaticOrder S; S.init(RP, D, G, (int)blockIdx.x);
        pg8::EpiFinal E{SS2, PPb, XB, Y};
        const SEpiFinal SE{SS2 + (size_t)RP * 16, PPb + (size_t)RP * D, XB + (size_t)RP * D, Y + (size_t)RP * D};
        pg8::Gemm gp{PB, WPPt, RP, D, PLE}; pg8::EpiPP EP{PPb}; const SEpiPP SP{PPb + (size_t)RP * D};
        if (blockIdx.x & 1) for (int t = (int)blockIdx.x; t < 256; t += G) { sgemm64(PB + (size_t)RP * PLE, WPPt, PLE, t, SP, lds + RING_OFF); sgemm64(XB + (size_t)RP * D, WPGt, D, t, SE, lds + RING_OFF); }
        pg8::gemm_phase<pg8::EpiPP, pg8::StaticOrder, true, true>(lds + RING_OFF, gp, S, EP);
        pg8::gemm_phase<pg8::EpiFinal, pg8::StaticOrder, true, true>(lds + RING_OFF, g, S, E);
        if (!(blockIdx.x & 1)) for (int t = (int)blockIdx.x; t < 256; t += G) { sgemm64(PB + (size_t)RP * PLE, WPPt, PLE, t, SP, lds + RING_OFF); sgemm64(XB + (size_t)RP * D, WPGt, D, t, SE, lds + RING_OFF); }
    }
#endif
}

extern "C" void kernel_launch(void* const* d_in, const int* in_sizes, int n_in, void* d_out, int out_size, void* d_ws, size_t ws_size, hipStream_t stream) {
    static int grid = 0;
    if (grid == 0) {
        if (n_in != 23 || ws_size < WS_END) { fprintf(stderr, "kernel_launch: unexpected shapes (n_in %d, ws %zu)\n", n_in, ws_size); grid = -1; return; }
        int dev = 0, cus = 0, per_cu = 0;
        if (hipGetDevice(&dev) != hipSuccess || hipDeviceGetAttribute(&cus, hipDeviceAttributeMultiprocessorCount, dev) != hipSuccess) { grid = -1; return; }
        if (hipFuncSetAttribute((const void*)mk_fwd, hipFuncAttributeMaxDynamicSharedMemorySize, LDS_BYTES) != hipSuccess) { fprintf(stderr, "kernel_launch: hipFuncSetAttribute failed\n"); grid = -1; return; }
        if (hipOccupancyMaxActiveBlocksPerMultiprocessor(&per_cu, (const void*)mk_fwd, NWAVES * 64, LDS_BYTES) != hipSuccess || per_cu < 1) { fprintf(stderr, "kernel_launch: occupancy query says %d blocks per CU\n", per_cu); }
        (void)hipGetLastError();
        grid = cus;
    }
    if (grid < 0) return;
    if (hipMemsetAsync((char*)d_ws + WS_CTL, 0, CTL_ZERO_BYTES, stream) != hipSuccess) return;
    Args a{};
    for (int i = 0; i < 23; ++i) a.in[i] = (const float*)d_in[i];
    a.out = (float*)d_out; a.ws = (unsigned char*)d_ws;
    hipLaunchKernelGGL(mk_fwd, dim3(grid), dim3(NWAVES * 64), LDS_BYTES, stream, a);
}
```

```cpp
#include <hip/hip_runtime.h>
#include <cstdio>
#include <cstdint>
constexpr int D = 1024, SEQ = 8192, NB = 4, DB = 32, DS = 32;
constexpr int RP = NB * SEQ, RS = DB * DS, R = RP + RS;
constexpr int INC = 2560, DFF = 2816, PLE = 256, NH = 8, HD = 64, CW = 512;
constexpr int NREL = 257, CONVW = 31, CH = 30, KSROWS = 576;
constexpr int KVT_BYTES = 131072;
constexpr float EPS = 1e-6f, LOG2E = 1.4426950408889634f, QSCALE = 0.125f * LOG2E;
constexpr size_t OY = 0, OKP = (size_t)R * D, OVP = OKP + (size_t)NB * 512 * 512, OCP = OVP + (size_t)NB * 512 * 512,
                 OKS = OCP + (size_t)NB * CH * CW, OVS = OKS + (size_t)DB * 512 * 512, OCS = OVS + (size_t)DB * 512 * 512;
namespace pg8 {
#define PG8_LAS __attribute__((address_space(3)))
typedef unsigned short bf16_t;
typedef short bf16x8 __attribute__((ext_vector_type(8)));
typedef float f32x4 __attribute__((ext_vector_type(4)));
typedef unsigned u32x4 __attribute__((ext_vector_type(4)));
constexpr int BM = 256, BK = 64, HALF = 128, HTB = HALF * BK * 2  , STAGE_BYTES = 8 * HTB, NXCD = 8, WGM = 8;

__host__ __device__ __forceinline__ int lds_byte(int r, int c) { const int st = (r >> 4) * 2 + (c >> 5), rr = r & 15, cc = c & 31, ob = rr * 64 + cc * 2; return st * 1024 + (ob ^ (((ob >> 9) & 1) << 5)); }
__host__ __device__ __forceinline__ void stage_rc(int b, int& R, int& C) { const int st = b / 1024, sb = b % 1024, swz = sb ^ (((sb >> 9) & 1) << 5); R = (st >> 1) * 16 + swz / 64; C = (st & 1) * 32 + (swz % 64) / 2; }
__host__ __device__ __forceinline__ int perm32(int rho) { const int n = rho >> 4, i = rho & 15; return 8 * (i >> 2) + 4 * n + (i & 3); }

struct Unit { int pm, pn; };
struct Gemm { const bf16_t* A; const bf16_t* Bt; int M, N, K; };

struct StaticOrder {
    int nM, nN, nwg, G, c;
    __host__ __device__ void init(int M, int N, int G_, int c_) { nM = M / BM; nN = N / BM; nwg = nM * nN; G = G_; c = c_; }
    __host__ __device__ bool next(int i, Unit& u) const {
        const long L = (long)i * G + c; if (L >= nwg) return false;
        int wgid = (int)L; { const int q = nwg / NXCD, r = nwg % NXCD, xcd = wgid % NXCD, off = wgid / NXCD; wgid = (xcd < r ? xcd * (q + 1) : r * (q + 1) + (xcd - r) * q) + off; }
        const int nig = WGM * nN, gid = wgid / nig, fm = gid * WGM, gsz = (nM - fm) < WGM ? (nM - fm) : WGM;
        u.pm = fm + ((wgid % nig) % gsz); u.pn = (wgid % nig) / gsz; return true;
    }
    __device__ __forceinline__ void a_ready(const Unit&) const {}
    __device__ __forceinline__ void done(const Unit&) const {}
};

__device__ __forceinline__ unsigned cvt_pk_bf16(float lo, float hi) { unsigned r; asm volatile("v_cvt_pk_bf16_f32 %0, %1, %2" : "=v"(r) : "v"(lo), "v"(hi)); return r; }
typedef float f32x2 __attribute__((ext_vector_type(2)));typedef unsigned u32x2 __attribute__((ext_vector_type(2)));
__device__ __forceinline__ u32x4 pack8(const f32x4 a, const f32x4 b) { u32x4 w; w.x = cvt_pk_bf16(a[0], a[1]); w.y = cvt_pk_bf16(a[2], a[3]); w.z = cvt_pk_bf16(b[0], b[1]); w.w = cvt_pk_bf16(b[2], b[3]); return w; }
__device__ __forceinline__ float sigm(float x) { return __builtin_amdgcn_rcpf(1.0f + __builtin_amdgcn_exp2f(-x * LOG2E)); }
__device__ __forceinline__ float quad_sum(float s) { s += __shfl_xor(s, 16); s += __shfl_xor(s, 32); return s; }
struct Epi1 {
    static constexpr bool PERM = true, AFTER_DRAIN = false;
    const float* rx; const float* qg; const float* kg; bf16_t* Q; unsigned char* KVP; unsigned char* KVS; bf16_t* GLU; float* out;
    __device__ __forceinline__ void operator()(const f32x4 (&acc)[2][2][4][2], const Unit& u, int wr, int wc, int fr, int fq) const {
        const int pn = u.pn, rowt = u.pm * BM + wr * 64 + fr;
        float rxv[2][4];
#pragma unroll
        for (int ai = 0; ai < 2; ++ai)
#pragma unroll
            for (int m = 0; m < 4; ++m) rxv[ai][m] = rx[rowt + ai * HALF + m * 16];
        if (pn < 6) {
            const int sec = pn >> 1, col = (4 * (pn & 1) + wc) * 64 + 8 * fq;
            f32x4 g[2][2];
#pragma unroll
            for (int bj = 0; bj < 2; ++bj)
#pragma unroll
                for (int n = 0; n < 2; ++n) { g[bj][n] = (f32x4){1.f, 1.f, 1.f, 1.f};
                    if (sec == 0) g[bj][n] = *(const f32x4*)(qg + 32 * bj + 8 * fq + 4 * n) * QSCALE;
                    if (sec == 1) g[bj][n] = *(const f32x4*)(kg + 32 * bj + 8 * fq + 4 * n); }
#pragma unroll
            for (int ai = 0; ai < 2; ++ai)
#pragma unroll
                for (int m = 0; m < 4; ++m) {
                    const int row = rowt + ai * HALF + m * 16; const float r = rxv[ai][m];
                    f32x4 z[2][2];
#pragma unroll
                    for (int bj = 0; bj < 2; ++bj)
#pragma unroll
                        for (int n = 0; n < 2; ++n) z[bj][n] = acc[ai][bj][m][n] * r;
                    if (sec < 2) {
                        float ss = 0.f;
#pragma unroll
                        for (int bj = 0; bj < 2; ++bj)
#pragma unroll
                            for (int n = 0; n < 2; ++n) { const f32x4 q = z[bj][n] * z[bj][n]; ss += (q[0] + q[1]) + (q[2] + q[3]); }
                        ss = quad_sum(ss);
                        const float rn = rsqrtf(ss * (1.0f / 64.0f) + EPS);
#pragma unroll
                        for (int bj = 0; bj < 2; ++bj)
#pragma unroll
                            for (int n = 0; n < 2; ++n) z[bj][n] = z[bj][n] * rn * g[bj][n];
                    }
                    const int sb = (row - RP) >> 5, si = (row - RP) & 31;
                    float* fo = nullptr;
                    if (sec == 0) {
#pragma unroll
                        for (int bj = 0; bj < 2; ++bj) *(u32x4*)(Q + (size_t)row * 512 + col + 32 * bj) = pack8(z[bj][0], z[bj][1]);
                    } else {
                        unsigned char* tb; int kv;
                        if (row < RP) { tb = KVP + (size_t)(row >> 6) * KVT_BYTES; kv = row & 63;
                            const int t = row & (SEQ - 1); if (t >= SEQ - 512) fo = out + OKP + (size_t)(sec - 1) * (OVP - OKP) + ((size_t)((row >> 13) * 512 + (t - (SEQ - 512)))) * 512 + col; }
                        else { tb = KVS + (size_t)(sb * 9 + 8) * KVT_BYTES; kv = si; fo = out + OKS + (size_t)(sec - 1) * (OVS - OKS) + ((size_t)(sb * 512 + 480 + si)) * 512 + col; }
                        tb += (pn & 1) * 65536 + wc * 16384;
                        const int ok = fq * 1024 + kv * 16, ov = 8192 + (kv >> 4) * 1024 + (kv & 15) * 64 + fq * 16;
#pragma unroll
                        for (int bj = 0; bj < 2; ++bj) *(u32x4*)(tb + (sec == 1 ? ok + bj * 4096 : ov + bj * 4096)) = pack8(z[bj][0], z[bj][1]);
                    }
                    if (fo) {
#pragma unroll
                        for (int bj = 0; bj < 2; ++bj)
#pragma unroll
                            for (int n = 0; n < 2; ++n) __builtin_nontemporal_store(z[bj][n], (f32x4*)(fo + 32 * bj + 4 * n)); }
                }
        } else {
            const int col = 128 * (pn - 6) + 32 * wc + 8 * fq;
#pragma unroll
            for (int ai = 0; ai < 2; ++ai)
#pragma unroll
                for (int m = 0; m < 4; ++m) {
                    const int row = rowt + ai * HALF + m * 16; const float r = rxv[ai][m];
                    f32x4 gl[2];
#pragma unroll
                    for (int n = 0; n < 2; ++n) { const f32x4 a = acc[ai][0][m][n] * r, b = acc[ai][1][m][n] * r;
#pragma unroll
                        for (int e = 0; e < 4; ++e) gl[n][e] = a[e] * sigm(b[e]); }
                    *(u32x4*)(GLU + (size_t)row * 512 + col) = pack8(gl[0], gl[1]);
                    float* fo = nullptr;
                    if (row < RP) { const int t = row & (SEQ - 1); if (t >= SEQ - CH) fo = out + OCP + ((size_t)((row >> 13) * CH + (t - (SEQ - CH)))) * CW + col; }
                    else { const int sb = (row - RP) >> 5, si = (row - RP) & 31; if (si >= DS - CH) fo = out + OCS + ((size_t)(sb * CH + (si - (DS - CH)))) * CW + col; }
                    if (fo) { __builtin_nontemporal_store(gl[0], (f32x4*)(fo)); __builtin_nontemporal_store(gl[1], (f32x4*)(fo + 4)); }
                }
        }
    }
};
struct EpiPP {
    static constexpr bool PERM = true, AFTER_DRAIN = false;
    bf16_t* O;
    __device__ __forceinline__ void operator()(const f32x4 (&acc)[2][2][4][2], const Unit& u, int wr, int wc, int fr, int fq) const {
        const int rowt = u.pm * BM + wr * 64 + fr, col = u.pn * BM + 32 * wc + 8 * fq;
#pragma unroll
        for (int ai = 0; ai < 2; ++ai)
#pragma unroll
            for (int m = 0; m < 4; ++m) { bf16_t* rowp = O + (size_t)(rowt + ai * HALF + m * 16) * D + col;
#pragma unroll
                for (int bj = 0; bj < 2; ++bj) *(u32x4*)(rowp + bj * HALF) = pack8(acc[ai][bj][m][0], acc[ai][bj][m][1]); }
    }
};
__device__ __forceinline__ f32x4 bf_lo4(const u32x4 w) { return (f32x4){__uint_as_float(w.x << 16), __uint_as_float(w.x & 0xffff0000u), __uint_as_float(w.y << 16), __uint_as_float(w.y & 0xffff0000u)}; }
__device__ __forceinline__ f32x4 bf_hi4(const u32x4 w) { return (f32x4){__uint_as_float(w.z << 16), __uint_as_float(w.z & 0xffff0000u), __uint_as_float(w.w << 16), __uint_as_float(w.w & 0xffff0000u)}; }
template <bool BF> struct EpiRes {
    static constexpr bool PERM = true, AFTER_DRAIN = false;
    const float* bp; const float* bs; bf16_t* HB; float* SS;
    __device__ __forceinline__ void operator()(const f32x4 (&acc)[2][2][4][2], const Unit& u, int wr, int wc, int fr, int fq) const {
        const int rowt = u.pm * BM + wr * 64 + fr, col = u.pn * BM + 32 * wc + 8 * fq;
        f32x4 bv[2][2][2];
        auto ldbase = [&](int i, f32x4 (&d)[2][2]) {
            const int row = rowt + (i >> 2) * HALF + (i & 3) * 16;
            if (BF) { const bf16_t* hrow = HB + (size_t)row * D + col;
#pragma unroll
                for (int bj = 0; bj < 2; ++bj) { const u32x4 w = *(const u32x4*)(hrow + bj * HALF); d[bj][0] = bf_lo4(w); d[bj][1] = bf_hi4(w); } }
            else { const float* brow = (row < RP ? bp + (size_t)row * D : bs + (size_t)(row - RP) * D) + col;
#pragma unroll
                for (int bj = 0; bj < 2; ++bj) { d[bj][0] = *(const f32x4*)(brow + bj * HALF); d[bj][1] = *(const f32x4*)(brow + bj * HALF + 4); } } };
        ldbase(0, bv[0]);
#pragma unroll
        for (int i = 0; i < 8; ++i) {
            const int ai = i >> 2, m = i & 3, row = rowt + ai * HALF + m * 16;
            if (i + 1 < 8) ldbase(i + 1, bv[(i + 1) & 1]);
            bf16_t* hrow = HB + (size_t)row * D + col;
            float ss = 0.f;
#pragma unroll
            for (int bj = 0; bj < 2; ++bj) {
                const f32x4 v0 = bv[i & 1][bj][0] + acc[ai][bj][m][0], v1 = bv[i & 1][bj][1] + acc[ai][bj][m][1];
                *(u32x4*)(hrow + bj * HALF) = pack8(v0, v1);
                const f32x4 q0 = v0 * v0, q1 = v1 * v1; ss += ((q0[0] + q0[1]) + (q0[2] + q0[3])) + ((q1[0] + q1[1]) + (q1[2] + q1[3]));
            }
            ss = quad_sum(ss);
            if (fq == 0) SS[(size_t)row * 16 + 4 * u.pn + wc] = ss;
        }
    }
};
__device__ __forceinline__ float row_rs(const float* SS, int row, int fq) {
    const f32x4 s4 = *(const f32x4*)(SS + (size_t)row * 16 + 4 * fq);
    return rsqrtf(quad_sum((s4[0] + s4[1]) + (s4[2] + s4[3])) * (1.0f / D) + EPS);
}
struct EpiAct {
    static constexpr bool PERM = true, AFTER_DRAIN = false;
    const float* SS; bf16_t* ACT;
    __device__ __forceinline__ void operator()(const f32x4 (&acc)[2][2][4][2], const Unit& u, int wr, int wc, int fr, int fq) const {
        const int rowt = u.pm * BM + wr * 64 + fr, col = 128 * u.pn + 32 * wc + 8 * fq;
        float rv[2][4];
#pragma unroll
        for (int ai = 0; ai < 2; ++ai)
#pragma unroll
            for (int m = 0; m < 4; ++m) rv[ai][m] = row_rs(SS, rowt + ai * HALF + m * 16, fq);
#pragma unroll
        for (int ai = 0; ai < 2; ++ai)
#pragma unroll
            for (int m = 0; m < 4; ++m) {
                const int row = rowt + ai * HALF + m * 16; const float r = rv[ai][m];
                f32x4 v[2];
#pragma unroll
                for (int n = 0; n < 2; ++n) {
                    const f32x4 ga = acc[ai][0][m][n], ua = acc[ai][1][m][n]; const float nr = -r * LOG2E, r2 = r * r;
#pragma unroll
                    for (int h2 = 0; h2 < 2; ++h2) { const f32x2 g2 = (f32x2){ga[2 * h2], ga[2 * h2 + 1]}, u2 = (f32x2){ua[2 * h2], ua[2 * h2 + 1]};
                        const f32x2 t = g2 * nr; f32x2 ex; ex.x = __builtin_amdgcn_exp2f(t.x); ex.y = __builtin_amdgcn_exp2f(t.y);
                        const f32x2 d2 = ex + 1.0f; f32x2 q; q.x = __builtin_amdgcn_rcpf(d2.x); q.y = __builtin_amdgcn_rcpf(d2.y);
                        const f32x2 o2 = (g2 * u2) * (q * r2); v[n][2 * h2] = o2.x; v[n][2 * h2 + 1] = o2.y; } }
                *(u32x4*)(ACT + (size_t)row * DFF + col) = pack8(v[0], v[1]);
            }
    }
};
struct EpiFinal {
    static constexpr bool PERM = true, AFTER_DRAIN = false;
    const float* SS; const bf16_t* PP; const bf16_t* HB; float* Y;
    __device__ __forceinline__ void operator()(const f32x4 (&acc)[2][2][4][2], const Unit& u, int wr, int wc, int fr, int fq) const {
        const int rowt = u.pm * BM + wr * 64 + fr, col = u.pn * BM + 32 * wc + 8 * fq;
        float rv[2][4];
#pragma unroll
        for (int ai = 0; ai < 2; ++ai)
#pragma unroll
            for (int m = 0; m < 4; ++m) rv[ai][m] = row_rs(SS, rowt + ai * HALF + m * 16, fq);
        u32x4 pwv[2][2], hwv[2][2];
        auto ld = [&](int i, u32x4 (&p)[2], u32x4 (&h)[2]) { const size_t o = (size_t)(rowt + (i >> 2) * HALF + (i & 3) * 16) * D + col;
#pragma unroll
            for (int bj = 0; bj < 2; ++bj) { p[bj] = *(const u32x4*)(PP + o + bj * HALF); h[bj] = *(const u32x4*)(HB + o + bj * HALF); } };
        ld(0, pwv[0], hwv[0]);
#pragma unroll
        for (int i = 0; i < 8; ++i) {
            const int ai = i >> 2, m = i & 3, row = rowt + ai * HALF + m * 16; const float r = rv[ai][m];
            if (i + 1 < 8) ld(i + 1, pwv[(i + 1) & 1], hwv[(i + 1) & 1]);
#pragma unroll
            for (int bj = 0; bj < 2; ++bj) {
                const size_t o = (size_t)row * D + col + bj * HALF;
                const u32x4 pw = pwv[i & 1][bj], hw = hwv[i & 1][bj];
                const f32x4 a0 = acc[ai][bj][m][0] * r, a1 = acc[ai][bj][m][1] * r, p0 = bf_lo4(pw), p1 = bf_hi4(pw);
                f32x4 h0 = bf_lo4(hw), h1 = bf_hi4(hw);
#pragma unroll
                for (int e2 = 0; e2 < 4; ++e2) { h0[e2] += sigm(a0[e2]) * p0[e2]; h1[e2] += sigm(a1[e2]) * p1[e2]; }
                __builtin_nontemporal_store(h0, (f32x4*)(Y + o)); __builtin_nontemporal_store(h1, (f32x4*)(Y + o + 4));
            }
        }
    }
};

template <class Epi, class Sched, bool ALIGN_EPI = false, bool SP2 = false>
__device__ __forceinline__ void gemm_phase(PG8_LAS unsigned char* lds, const Gemm g, const Sched& S, const Epi& E) {
    int tid_ = threadIdx.x; asm volatile("" : "+v"(tid_));
    const int tid = tid_, wid = __builtin_amdgcn_readfirstlane(tid >> 6), lane = tid & 63, wr = wid >> 2, wc = wid & 3, fr = lane & 15, fq = lane >> 4;
    int K_ = g.K; asm volatile("" : "+s"(K_));
    const int K = K_, nt = K / BK;
    unsigned voffA[2], voffB[2];
#pragma unroll
    for (int i = 0; i < 2; ++i) { int R, C; stage_rc(tid * 16 + i * 8192, R, C); const int Rb = Epi::PERM ? ((R & ~31) + perm32(R & 31)) : R;
        voffA[i] = (unsigned)(R * K + C) * 2u; voffB[i] = (unsigned)(Rb * K + C) * 2u; }
    const size_t kstep = (size_t)(BK * 2);
    const size_t hstep = (size_t)HALF * K * 2;
    const size_t tstep = 2 * hstep;
    const unsigned ldsw = (unsigned)wid * 1024u;
    const int aoff = lds_byte(wr * 64 + fr, fq * 8), boff = lds_byte(wc * 32 + fr, fq * 8);
#define PG8_SA(b, h) (((b) * 2 + (h)) * HTB)
#define PG8_SB(b, h) ((4 + (b) * 2 + (h)) * HTB)
#define PG8_STAGE(bufoff, gbase, voff) do { _Pragma("unroll") for (int _i = 0; _i < 2; ++_i) \
        __builtin_amdgcn_global_load_lds((const unsigned*)((const char*)(gbase) + (voff)[_i]), (PG8_LAS unsigned*)(lds + (bufoff) + ldsw + _i * 8192), 16, 0, 0); } while (0)
#define PG8_LDA(dst, b, h) do { _Pragma("unroll") for (int m = 0; m < 4; ++m) _Pragma("unroll") for (int k = 0; k < 2; ++k) dst[m][k] = *(const PG8_LAS bf16x8*)(lds + PG8_SA(b, h) + aoff + m * 2048 + k * 1024); } while (0)
#define PG8_LDB(dst, b, h) do { _Pragma("unroll") for (int n = 0; n < 2; ++n) _Pragma("unroll") for (int k = 0; k < 2; ++k) dst[n][k] = *(const PG8_LAS bf16x8*)(lds + PG8_SB(b, h) + boff + n * 2048 + k * 1024); } while (0)
#define PG8_MMA(ai, bj, At, Bt) do { __builtin_amdgcn_s_setprio(1); _Pragma("unroll") for (int m = 0; m < 4; ++m) _Pragma("unroll") for (int n = 0; n < 2; ++n) _Pragma("unroll") for (int k = 0; k < 2; ++k) \
        acc[ai][bj][m][n] = __builtin_amdgcn_mfma_f32_16x16x32_bf16(Bt[n][k], At[m][k], acc[ai][bj][m][n], 0, 0, 0); __builtin_amdgcn_s_setprio(0); } while (0)
#define PG8_WAIT_V(n) asm volatile("s_waitcnt vmcnt(" #n ")" ::: "memory")
#define PG8_WAIT_L(n) asm volatile("s_waitcnt lgkmcnt(" #n ")" ::: "memory")
#define PG8_BAR __builtin_amdgcn_s_barrier()
#define PG8_SCHED __builtin_amdgcn_sched_barrier(0)
    Unit cur, nxt; int ui = 0;
    if (!S.next(0, cur)) return;
    f32x4 acc[2][2][4][2];
#pragma unroll
    for (int a = 0; a < 2; ++a)
#pragma unroll
        for (int b = 0; b < 2; ++b)
#pragma unroll
            for (int m = 0; m < 4; ++m)
#pragma unroll
                for (int n = 0; n < 2; ++n) acc[a][b][m][n] = (f32x4){0.f, 0.f, 0.f, 0.f};
    bf16x8 At[4][2], B0[2][2], B1[2][2];
    const char* cA = (const char*)g.A + (size_t)cur.pm * tstep; const char* cB = (const char*)g.Bt + (size_t)cur.pn * tstep;
    S.a_ready(cur);
    if constexpr (SP2) {
        PG8_STAGE(PG8_SB(0, 0), cB, voffB); PG8_STAGE(PG8_SB(0, 1), cB + hstep, voffB); PG8_STAGE(PG8_SA(0, 0), cA, voffA); PG8_STAGE(PG8_SA(0, 1), cA + hstep, voffA);
        if (wr == 1) PG8_BAR;
        PG8_WAIT_V(2); PG8_BAR;
        PG8_STAGE(PG8_SB(1, 0), cB + kstep, voffB); PG8_STAGE(PG8_SA(1, 0), cA + kstep, voffA); PG8_STAGE(PG8_SB(1, 1), cB + hstep + kstep, voffB);
        PG8_WAIT_V(6); PG8_BAR;
    } else {
        PG8_STAGE(PG8_SB(0, 0), cB, voffB); PG8_STAGE(PG8_SA(0, 0), cA, voffA); PG8_STAGE(PG8_SB(0, 1), cB + hstep, voffB); PG8_STAGE(PG8_SA(0, 1), cA + hstep, voffA);
        if (wr == 1) PG8_BAR;
        PG8_WAIT_V(4); PG8_BAR;
        PG8_STAGE(PG8_SB(1, 0), cB + kstep, voffB); PG8_STAGE(PG8_SA(1, 0), cA + kstep, voffA); PG8_STAGE(PG8_SB(1, 1), cB + hstep + kstep, voffB);
        PG8_WAIT_V(6); PG8_BAR;
    }
    for (;;) {
        const bool has_next = S.next(ui + 1, nxt);
        const char* nA = has_next ? (const char*)g.A + (size_t)nxt.pm * tstep : cA; const char* nB = has_next ? (const char*)g.Bt + (size_t)nxt.pn * tstep : cB;
        for (int t = 0; t < nt; t += 2) {
            const bool last = (t == nt - 2);
            const char* a1 = cA + (size_t)(t + 1) * kstep;
            const char* a2 = last ? nA : cA + (size_t)(t + 2) * kstep; const char* b2 = last ? nB : cB + (size_t)(t + 2) * kstep;
            const char* a3 = a2 + kstep; const char* b3 = b2 + kstep;
            if (last && has_next) S.a_ready(nxt);
            if constexpr (SP2) {
            PG8_LDB(B0, 0, 0); PG8_LDB(B1, 0, 1); PG8_SCHED; PG8_LDA(At, 0, 0); PG8_STAGE(PG8_SA(1, 1), a1 + hstep, voffA);
            PG8_WAIT_V(8); PG8_WAIT_L(0); PG8_BAR; PG8_MMA(0, 0, At, B0); PG8_MMA(0, 1, At, B1); PG8_BAR; PG8_SCHED;
            PG8_LDA(At, 0, 1); PG8_STAGE(PG8_SB(0, 0), b2, voffB); PG8_STAGE(PG8_SB(0, 1), b2 + hstep, voffB); PG8_STAGE(PG8_SA(0, 0), a2, voffA);
            PG8_WAIT_V(8); PG8_WAIT_L(0); PG8_BAR; PG8_MMA(1, 0, At, B0); PG8_MMA(1, 1, At, B1); PG8_BAR; PG8_SCHED;
            PG8_LDB(B0, 1, 0); PG8_LDB(B1, 1, 1); PG8_SCHED; PG8_LDA(At, 1, 0); PG8_STAGE(PG8_SA(0, 1), a2 + hstep, voffA);
            PG8_WAIT_V(8); PG8_WAIT_L(0); PG8_BAR; PG8_MMA(0, 0, At, B0); PG8_MMA(0, 1, At, B1); PG8_BAR; PG8_SCHED;
            PG8_LDA(At, 1, 1); PG8_STAGE(PG8_SB(1, 0), b3, voffB); PG8_STAGE(PG8_SB(1, 1), b3 + hstep, voffB); PG8_STAGE(PG8_SA(1, 0), a3, voffA);
            PG8_WAIT_V(8); PG8_WAIT_L(0); PG8_BAR; PG8_MMA(1, 0, At, B0); PG8_MMA(1, 1, At, B1); PG8_BAR; PG8_SCHED;
            } else {
            PG8_LDB(B0, 0, 0); PG8_SCHED; PG8_LDA(At, 0, 0); PG8_STAGE(PG8_SA(1, 1), a1 + hstep, voffA);
            PG8_WAIT_L(8); PG8_BAR; PG8_WAIT_L(0); PG8_MMA(0, 0, At, B0); PG8_BAR; PG8_SCHED;
            PG8_LDB(B1, 0, 1); PG8_STAGE(PG8_SB(0, 0), b2, voffB);
            PG8_BAR; PG8_WAIT_L(0); PG8_MMA(0, 1, At, B1); PG8_BAR;
            PG8_LDA(At, 0, 1); PG8_STAGE(PG8_SA(0, 0), a2, voffA);
            PG8_BAR; PG8_WAIT_L(0); PG8_MMA(1, 0, At, B0); PG8_BAR; PG8_SCHED;
            PG8_STAGE(PG8_SB(0, 1), b2 + hstep, voffB);
            PG8_WAIT_V(6); PG8_BAR; PG8_MMA(1, 1, At, B1); PG8_BAR;
            PG8_LDB(B0, 1, 0); PG8_SCHED; PG8_LDA(At, 1, 0); PG8_STAGE(PG8_SA(0, 1), a2 + hstep, voffA);
            PG8_WAIT_L(8); PG8_BAR; PG8_WAIT_L(0); PG8_MMA(0, 0, At, B0); PG8_BAR; PG8_SCHED;
            PG8_LDB(B1, 1, 1); PG8_STAGE(PG8_SB(1, 0), b3, voffB);
            PG8_BAR; PG8_WAIT_L(0); PG8_MMA(0, 1, At, B1); PG8_BAR;
            PG8_LDA(At, 1, 1); PG8_STAGE(PG8_SA(1, 0), a3, voffA);
            PG8_BAR; PG8_WAIT_L(0); PG8_MMA(1, 0, At, B0); PG8_BAR; PG8_SCHED;
            PG8_STAGE(PG8_SB(1, 1), b3 + hstep, voffB);
            PG8_WAIT_V(6); PG8_BAR; PG8_MMA(1, 1, At, B1); PG8_BAR;
            }
        }
        if constexpr (ALIGN_EPI) { if (wr == 0) PG8_BAR; }
        if constexpr (!Epi::AFTER_DRAIN) { E(acc, cur, wr, wc, fr, fq); S.done(cur); }
        if (!has_next) break;
#pragma unroll
        for (int a = 0; a < 2; ++a)
#pragma unroll
            for (int b = 0; b < 2; ++b)
#pragma unroll
                for (int m = 0; m < 4; ++m)
#pragma unroll
                    for (int n = 0; n < 2; ++n) acc[a][b][m][n] = (f32x4){0.f, 0.f, 0.f, 0.f};
        cur = nxt; cA = nA; cB = nB; ++ui;
        if constexpr (ALIGN_EPI) { if (wr == 1) PG8_BAR; }
    }
    PG8_WAIT_V(0);
    if constexpr (!ALIGN_EPI) { if (wr == 0) PG8_BAR; }
    PG8_BAR;
    if constexpr (Epi::AFTER_DRAIN) { E.fused(acc, cur, wr, wc, fr, fq, lds, wid, lane); S.done(cur); }
#undef PG8_SA
#undef PG8_SB
#undef PG8_STAGE
#undef PG8_LDA
#undef PG8_LDB
#undef PG8_MMA
#undef PG8_WAIT_V
#undef PG8_WAIT_L
#undef PG8_BAR
#undef PG8_SCHED
}
}
#define GAS __attribute__((address_space(1)))
#define LAS __attribute__((address_space(3)))
typedef unsigned short bf16;
typedef unsigned v4u __attribute__((ext_vector_type(4)));
typedef float f32x4 __attribute__((ext_vector_type(4)));
typedef short bf16x8 __attribute__((ext_vector_type(8)));
typedef GAS unsigned gu32;
typedef GAS unsigned long long gu64;
#define RLX_AGENT __ATOMIC_RELAXED, __HIP_MEMORY_SCOPE_AGENT
#define LDS_WAIT() asm volatile("s_waitcnt lgkmcnt(0)" ::: "memory")
#define VM_WAIT() asm volatile("s_waitcnt vmcnt(0)" ::: "memory")
__device__ __forceinline__ unsigned long long rt() { return __builtin_amdgcn_s_memrealtime(); }
__device__ __forceinline__ unsigned f2bf(float f) { unsigned u = __builtin_bit_cast(unsigned, f); return (u + 0x7fffu + ((u >> 16) & 1u)) >> 16; }
__device__ __forceinline__ unsigned pk2(float lo, float hi) { return f2bf(lo) | (f2bf(hi) << 16); }
#define XB_TMO      128
#define XB_XCNT(j)  (256  + 64 * (j))
#define XB_XSUB(j)  (1280 + 64 * (j))
#define XB_XGEN(j)  (2304 + 64 * (j))
#define XB_TOP      3328
#define XB_TOPGEN   3392
#define XCD_BAR_WORDS 3456
#define XB_SPIN_CAP (1u << 18)

__device__ __forceinline__ unsigned xb_ld(unsigned* p)              { return __hip_atomic_load(p, __ATOMIC_RELAXED, __HIP_MEMORY_SCOPE_AGENT); }
__device__ __forceinline__ unsigned xb_add(unsigned* p, unsigned v) { return __hip_atomic_fetch_add(p, v, __ATOMIC_RELAXED, __HIP_MEMORY_SCOPE_AGENT); }
__device__ __forceinline__ unsigned xb_xcc_id() { return (unsigned)__builtin_amdgcn_s_getreg((3 << 11) | 20) & 0xFu; }
#define XB_SPIN(cond, bar) do { unsigned _sp = 0; while (cond) { __builtin_amdgcn_s_sleep(1); \
    if ((++_sp & 255u) == 0u) { if (xb_ld(&(bar)[XB_TMO])) break; if (_sp > XB_SPIN_CAP) { atomicAdd(&(bar)[XB_TMO], 1u); break; } } } } while (0)

struct XcdBarrier {
    unsigned* bar; unsigned x;
    volatile LAS unsigned* st;
};

__device__ __forceinline__ XcdBarrier xcd_barrier_post(unsigned* bar, volatile LAS unsigned* st) {
    XcdBarrier b; b.bar = bar; b.x = xb_xcc_id(); b.st = st;
    if (threadIdx.x == 0) (void)xb_add(&bar[XB_XCNT(b.x)], 1u);
    return b;
}
__device__ __forceinline__ void xcd_barrier_complete(unsigned* bar, unsigned x, unsigned& nloc, unsigned& nx) {
    const unsigned G = gridDim.x * gridDim.y * gridDim.z;
    unsigned sum, cnt, mine, sp = 0u;
    for (;;) {
        sum = 0u; cnt = 0u; mine = 0u;
#pragma unroll
        for (unsigned j = 0; j < 16; ++j) { const unsigned c = xb_ld(&bar[XB_XCNT(j)]); sum += c; cnt += (c > 0u) ? 1u : 0u; mine = (j == x) ? c : mine; }
        if (sum == G) break;
        __builtin_amdgcn_s_sleep(1);
        if ((++sp & 255u) == 0u) { if (xb_ld(&bar[XB_TMO])) break; if (sp > XB_SPIN_CAP) { atomicAdd(&bar[XB_TMO], 1u); break; } }
    }
    nloc = mine > 0u ? mine : 1u; nx = cnt > 0u ? cnt : 1u;
}

__device__ __forceinline__ void xcd_barrier(const XcdBarrier& b) {
    asm volatile("s_waitcnt vmcnt(0)" ::: "memory");
    __syncthreads();
    if (threadIdx.x == 0) {
        unsigned* bar = b.bar;
        __builtin_amdgcn_s_waitcnt(0);
        unsigned nloc = b.st[0], nx = b.st[1];
        if (nloc == 0u) { xcd_barrier_complete(bar, b.x, nloc, nx); b.st[0] = nloc; b.st[1] = nx; }
        const unsigned old = xb_add(&bar[XB_XSUB(b.x)], 1u);
        const unsigned gen = old / nloc;
        if (old + 1u == (gen + 1u) * nloc) {
            __builtin_amdgcn_fence(__ATOMIC_RELEASE, "agent");
            asm volatile("s_waitcnt vmcnt(0)" ::: "memory");
            const unsigned og = xb_add(&bar[XB_TOP], 1u);
            const unsigned tg = og / nx;
            if (og + 1u == (tg + 1u) * nx) xb_add(&bar[XB_TOPGEN], 1u);
            else XB_SPIN(xb_ld(&bar[XB_TOPGEN]) == tg, bar);
            __builtin_amdgcn_fence(__ATOMIC_ACQUIRE, "agent");
            xb_add(&bar[XB_XGEN(b.x)], 1u);
            asm volatile("s_waitcnt vmcnt(0)" ::: "memory");
        } else {
            __builtin_amdgcn_fence(__ATOMIC_ACQUIRE, "agent");
            XB_SPIN(xb_ld(&bar[XB_XGEN(b.x)]) == gen, bar);
            asm volatile("s_waitcnt vmcnt(0)" ::: "memory");
        }
    }
    __syncthreads();
}
constexpr int NWAVES = 8;
constexpr size_t MiB = 1u << 20;
constexpr size_t WS_CTL = 0, CTL_ZERO_BYTES = 65536;
constexpr size_t WS_W1 = 1 * MiB, WS_WO = 6 * MiB, WS_WGU = 8 * MiB, WS_WD = 19 * MiB, WS_WPG = 25 * MiB, WS_WPP = 27 * MiB;
constexpr size_t WS_RX = 28 * MiB, WS_SS1 = 29 * MiB, WS_SS2 = 32 * MiB;
constexpr size_t WS_XB = 36 * MiB;
constexpr size_t WS_PB = 102 * MiB, WS_PP = 119 * MiB;
constexpr size_t WS_Q = 185 * MiB, WS_KP = 218 * MiB, WS_VP = 250 * MiB, WS_KS = 282 * MiB, WS_VS = 300 * MiB, WS_GLU = 318 * MiB, WS_MIX = 351 * MiB;
constexpr size_t WS_ACT = 185 * MiB;
constexpr size_t WS_END = 417 * MiB;
static_assert(WS_XB + (size_t)R * D * 2 <= WS_PB && WS_PB + (size_t)R * PLE * 2 <= WS_PP && WS_PP + (size_t)R * D * 2 <= WS_Q && WS_Q + (size_t)R * 512 * 2 <= WS_KP &&
              WS_KP + (size_t)(RP / 64) * KVT_BYTES <= WS_KS && WS_KS + (size_t)DB * 9 * KVT_BYTES <= WS_GLU && WS_GLU + (size_t)R * 512 * 2 <= WS_MIX &&
              WS_MIX + (size_t)R * D * 2 <= WS_END && WS_ACT + (size_t)R * DFF * 2 <= WS_END && WS_SS1 + (size_t)R * 64 <= WS_SS2 && WS_SS2 + (size_t)R * 64 <= WS_XB && WS_RX + (size_t)R * 4 <= WS_SS1, "d_ws map");
constexpr int CW_BAR = 4096, CW_Q = 8192, CW_QG = CW_Q + 64 * 32;
constexpr int RING_OFF = 0, RING_BYTES = 131072;
constexpr int LDSCTL_OFF = RING_BYTES, MISC_OFF = LDSCTL_OFF + 320;
constexpr int ATT_TAB = 132096, ATT_LSC = ATT_TAB + 8192;
constexpr int LDS_BYTES = 147456;
static_assert(ATT_LSC + 2048 <= LDS_BYTES && MISC_OFF + 128 <= ATT_TAB, "LDS map");

__device__ __forceinline__ float wave_sum(float v) {
#pragma unroll
    for (int o = 1; o < 64; o <<= 1) v += __shfl_xor(v, o);
    return v;
}
__device__ __forceinline__ float wave_max(float v) {
#pragma unroll
    for (int o = 1; o < 64; o <<= 1) v = fmaxf(v, __shfl_xor(v, o));
    return v;
}
__device__ __forceinline__ int map_win(int n) {
    if (n < 1536) { const int sec = n >> 9, nn = n & 511, h = nn >> 6, d = nn & 63; return sec * 512 + 256 * (h >> 2) + 128 * (d >> 5) + 32 * (h & 3) + (d & 31); }
    if (n < 2048) { const int i = n - 1536; return 1536 + 256 * (i >> 7) + (i & 127); }
    const int i = n - 2048; return 1536 + 256 * (i >> 7) + 128 + (i & 127);
}
__device__ __forceinline__ int map_gu(int n) {
    if (n < DFF) return 256 * (n >> 7) + (n & 127);
    const int i = n - DFF; return 256 * (i >> 7) + 128 + (i & 127);
}
template <int MAP> __device__ __forceinline__ void p0_transpose_item(const float* W, const float* gain, int K, int N, bf16* WT, LAS float* scr, int item, int lane) {
    const int nblk = N / 32, kb = item / nblk, nb = item % nblk, k0 = 64 * kb, n0 = 32 * nb;
    { const int nq = lane & 7, kr = lane >> 3; f32x4 v[8];
#pragma unroll
      for (int i = 0; i < 8; ++i) v[i] = __builtin_nontemporal_load((const GAS f32x4*)(W + (size_t)(k0 + 8 * i + kr) * N + n0 + 4 * nq));
#pragma unroll
      for (int i = 0; i < 8; ++i) { const int kk = 8 * i + kr; const float gk = gain ? gain[k0 + kk] : 1.0f;
#pragma unroll
          for (int e = 0; e < 4; ++e) scr[kk * 33 + 4 * nq + e] = v[i][e] * gk; } }
    LDS_WAIT(); asm volatile("" ::: "memory");
    const int c = lane & 7;
#pragma unroll
    for (int j = 0; j < 4; ++j) { const int n = (lane >> 3) + 8 * j; const LAS float* s = scr + (8 * c) * 33 + n;
        v4u o; o.x = pk2(s[0 * 33], s[1 * 33]); o.y = pk2(s[2 * 33], s[3 * 33]); o.z = pk2(s[4 * 33], s[5 * 33]); o.w = pk2(s[6 * 33], s[7 * 33]);
        const int ns = n0 + n, dr = MAP == 0 ? ns : (MAP == 1 ? map_win(ns) : map_gu(ns));
        *(GAS v4u*)(WT + (size_t)dr * K + k0 + 8 * c) = o; }
    LDS_WAIT(); asm volatile("" ::: "memory");
}

namespace att {
typedef short bf16x8 __attribute__((ext_vector_type(8)));
typedef short s16x4 __attribute__((ext_vector_type(4)));
typedef float f32x16 __attribute__((ext_vector_type(16)));
typedef unsigned u32x4 __attribute__((ext_vector_type(4)));
typedef float f32x2_t __attribute__((ext_vector_type(2))); typedef __bf16 bf16x2_t __attribute__((ext_vector_type(2)));
typedef short v4i16_t __attribute__((ext_vector_type(4)));
typedef LAS const char* lds_cptr;
constexpr int BUFB = 65536, HSLOT = 16384;
__device__ __forceinline__ int crow(int r, int hi) { return (r & 3) + 8 * (r >> 2) + 4 * hi; }
__device__ __forceinline__ void glds16(const void* gsrc, unsigned lds_dst) { unsigned keep;
    asm volatile("s_mov_b32 %0, m0\n\ts_mov_b32 m0, %2\n\ts_nop 0\n\tglobal_load_lds_dwordx4 %1, off\n\ts_mov_b32 m0, %0" : "=&s"(keep) : "v"(gsrc), "s"(lds_dst) : "memory"); }
__device__ __forceinline__ unsigned cvtpk_s(float lo, float hi) { f32x2_t v = {lo, hi}; bf16x2_t b = __builtin_convertvector(v, bf16x2_t); return __builtin_bit_cast(unsigned, b); }
__device__ __forceinline__ s16x4 vtr(lds_cptr p) { return __builtin_bit_cast(s16x4, __builtin_amdgcn_ds_read_tr16_b64_v4i16((LAS v4i16_t*)p)); }
#define ATT_WAIT_BAR() asm volatile("s_waitcnt vmcnt(0) lgkmcnt(0)\n\ts_barrier" ::: "memory")

struct AUnit { const bf16* Qrow; const unsigned char* KV; bf16* Orow; int nt, hg, sample, c0rel; };

__device__ __forceinline__ void attn_prefetch(const AUnit& U, LAS unsigned char* lds, int wid, int lane, bf16x8 (&qr)[2][4]) {
    const int r32 = lane & 31, hi = lane >> 5, hl = wid & 3, ci = wid >> 2, head = 4 * U.hg + hl;
    const bool wact = !U.sample || ci == 0;
    const unsigned char* kvsrc = U.KV + U.hg * 65536 + wid * 1024 + lane * 16;
    const unsigned kvdst = (unsigned)(size_t)lds + wid * 1024;
#pragma unroll
    for (int j_ = 0; j_ < 8; ++j_) glds16(kvsrc + j_ * 8192, (unsigned)__builtin_amdgcn_readfirstlane(kvdst + j_ * 8192));
    const bf16* Qw = U.Qrow + (size_t)((wact ? 64 * ci : 0) + r32) * 512 + head * 64 + hi * 8; const bf16* Qw1 = Qw + (U.sample ? 0 : 32 * 512);
#pragma unroll
    for (int d0 = 0; d0 < 4; ++d0) { qr[0][d0] = __builtin_nontemporal_load((const bf16x8*)(Qw + d0 * 16)); qr[1][d0] = __builtin_nontemporal_load((const bf16x8*)(Qw1 + d0 * 16)); }
}
template <bool TWO> __device__ __forceinline__ void attn_steps(const AUnit& U, LAS unsigned char* lds, int wid, int lane, const bf16x8 (&qr)[2][4], f32x16 (&o)[2][2], float (&lsum)[2]) {
    const int r32 = lane & 31, hi = lane >> 5, hl = wid & 3, ci = wid >> 2, head = 4 * U.hg + hl, nt = U.nt, own = U.c0rel + ci;
    const bool wact = TWO || ci == 0;
    const unsigned lds0 = (unsigned)(size_t)lds;
    const LAS float* tabh = (const LAS float*)(lds + ATT_TAB) + head * 256;
    const unsigned char* kvsrc = U.KV + U.hg * 65536 + wid * 1024 + lane * 16;
    const unsigned kvdst = lds0 + wid * 1024;
#define ATT_DMA(ti, b) do { _Pragma("unroll") for (int j_ = 0; j_ < 8; ++j_) \
        glds16(kvsrc + (size_t)(ti) * KVT_BYTES + j_ * 8192, (unsigned)__builtin_amdgcn_readfirstlane(kvdst + (b) * BUFB + j_ * 8192)); } while (0)
    for (int ti = 0; ti < nt; ++ti) {
        ATT_WAIT_BAR();
        const int b = ti & 1;
        if (ti + 1 < nt) ATT_DMA(ti + 1, b ^ 1);
        const int jt = own - ti;
        if (wact && jt >= 0 && jt <= 8) {
            const float m1 = (!TWO && jt == 0) ? 0.f : 1.f;
            const lds_cptr kp = (lds_cptr)(lds + b * BUFB + hl * HSLOT + hi * 1024 + r32 * 16);
            bf16x8 kf[8];
            { const unsigned ka = (unsigned)(size_t)kp;
              asm volatile("ds_read_b128 %0, %8\n\tds_read_b128 %1, %8 offset:512\n\tds_read_b128 %2, %8 offset:2048\n\tds_read_b128 %3, %8 offset:2560\n\t"
                           "ds_read_b128 %4, %8 offset:4096\n\tds_read_b128 %5, %8 offset:4608\n\tds_read_b128 %6, %8 offset:6144\n\tds_read_b128 %7, %8 offset:6656\n\ts_waitcnt lgkmcnt(0)"
                           : "=&v"(kf[0]), "=&v"(kf[1]), "=&v"(kf[2]), "=&v"(kf[3]), "=&v"(kf[4]), "=&v"(kf[5]), "=&v"(kf[6]), "=&v"(kf[7]) : "v"(ka) : "memory");
              __builtin_amdgcn_sched_barrier(0); }
            f32x16 s[2][2]; s[0][0] = f32x16{}; s[0][1] = f32x16{}; s[1][0] = f32x16{}; s[1][1] = f32x16{};
#pragma unroll
            for (int h2 = 0; h2 < (TWO ? 2 : 1); ++h2)
#pragma unroll
                for (int d0 = 0; d0 < 4; ++d0) { s[h2][0] = __builtin_amdgcn_mfma_f32_32x32x16_bf16(kf[2 * d0], qr[h2][d0], s[h2][0], 0, 0, 0);
                                                 s[h2][1] = __builtin_amdgcn_mfma_f32_32x32x16_bf16(kf[2 * d0 + 1], qr[h2][d0], s[h2][1], 0, 0, 0); }
            u32x4 pw[2][4];
#pragma unroll
            for (int h2 = 0; h2 < (TWO ? 2 : 1); ++h2) {
                f32x16& p0 = s[h2][0]; f32x16& p1 = s[h2][1];
                if (jt < 3) { const LAS float* tp = tabh + (191 - (32 * h2 + r32) - 64 * jt + 4 * hi);
#pragma unroll
                    for (int r = 0; r < 16; ++r) { p0[r] += tp[(r & 3) + 8 * (r >> 2)]; p1[r] += tp[32 + (r & 3) + 8 * (r >> 2)]; } }
                float sacc = 0.f;
#pragma unroll
                for (int r = 0; r < 16; ++r) { p0[r] = __builtin_amdgcn_exp2f(p0[r]); p1[r] = __builtin_amdgcn_exp2f(p1[r]); if (!TWO) p1[r] *= m1; sacc += p0[r] + p1[r]; }
                lsum[h2] += sacc;
#pragma unroll
                for (int k = 0; k < 2; ++k) { pw[h2][k] = (u32x4){cvtpk_s(p0[8 * k], p0[8 * k + 1]), cvtpk_s(p0[8 * k + 2], p0[8 * k + 3]), cvtpk_s(p0[8 * k + 4], p0[8 * k + 5]), cvtpk_s(p0[8 * k + 6], p0[8 * k + 7])};
                    pw[h2][2 + k] = (u32x4){cvtpk_s(p1[8 * k], p1[8 * k + 1]), cvtpk_s(p1[8 * k + 2], p1[8 * k + 3]), cvtpk_s(p1[8 * k + 4], p1[8 * k + 5]), cvtpk_s(p1[8 * k + 6], p1[8 * k + 7])}; }
            }
            const lds_cptr vp = (lds_cptr)(lds + b * BUFB + hl * HSLOT + 8192 + ((lane >> 4) & 1) * 32 + (lane & 3) * 8 + (4 * hi + ((lane & 15) >> 2)) * 64);
            const unsigned va = (unsigned)(size_t)vp;
#pragma unroll
            for (int d0 = 0; d0 < 2; ++d0) {
                s16x4 lo[4], hh[4];
                asm volatile("ds_read_b64_tr_b16 %0, %8 offset:%c9\n\tds_read_b64_tr_b16 %1, %8 offset:%c10\n\tds_read_b64_tr_b16 %2, %8 offset:%c11\n\tds_read_b64_tr_b16 %3, %8 offset:%c12\n\t"
                             "ds_read_b64_tr_b16 %4, %8 offset:%c13\n\tds_read_b64_tr_b16 %5, %8 offset:%c14\n\tds_read_b64_tr_b16 %6, %8 offset:%c15\n\tds_read_b64_tr_b16 %7, %8 offset:%c16\n\ts_waitcnt lgkmcnt(0)"
                             : "=&v"(lo[0]), "=&v"(hh[0]), "=&v"(lo[1]), "=&v"(hh[1]), "=&v"(lo[2]), "=&v"(hh[2]), "=&v"(lo[3]), "=&v"(hh[3])
                             : "v"(va), "i"(d0 * 4096), "i"(d0 * 4096 + 512), "i"(d0 * 4096 + 1024), "i"(d0 * 4096 + 1536), "i"(d0 * 4096 + 2048), "i"(d0 * 4096 + 2560), "i"(d0 * 4096 + 3072), "i"(d0 * 4096 + 3584) : "memory");
                __builtin_amdgcn_sched_barrier(0);
#pragma unroll
                for (int ks = 0; ks < 4; ++ks) {
                    const bf16x8 vf = (bf16x8){lo[ks][0], lo[ks][1], lo[ks][2], lo[ks][3], hh[ks][0], hh[ks][1], hh[ks][2], hh[ks][3]};
                    o[0][d0] = __builtin_amdgcn_mfma_f32_32x32x16_bf16(__builtin_bit_cast(bf16x8, pw[0][ks]), vf, o[0][d0], 0, 0, 0);
                    if (TWO) o[1][d0] = __builtin_amdgcn_mfma_f32_32x32x16_bf16(__builtin_bit_cast(bf16x8, pw[1][ks]), vf, o[1][d0], 0, 0, 0); }
            }
        }
    }
#undef ATT_DMA
}
template <bool TWO> __device__ __forceinline__ void attn_store(const AUnit& U, LAS unsigned char* lds, int wid, int lane, const f32x16 (&o)[2][2], const float (&lsum)[2]) {
    const int r32 = lane & 31, hi = lane >> 5, hl = wid & 3, ci = wid >> 2, head = 4 * U.hg + hl;
    const bool wact = TWO || ci == 0;
    LAS float* lsc = (LAS float*)(lds + ATT_LSC) + wid * 64;
    if (wact) {
#pragma unroll
        for (int h2 = 0; h2 < (TWO ? 2 : 1); ++h2) {
            float ls = lsum[h2];
            { auto rr = __builtin_amdgcn_permlane32_swap(__float_as_uint(ls), __float_as_uint(ls), false, false); ls = __uint_as_float(rr[0]) + __uint_as_float(rr[1]); }
            if (hi == 0) lsc[32 * h2 + r32] = ls;
            asm volatile("s_waitcnt lgkmcnt(0)" ::: "memory");
            LAS bf16* stg = (LAS bf16*)(lds + BUFB + wid * 8192 + h2 * 4096);
#pragma unroll
            for (int r = 0; r < 16; ++r) { const int orow = crow(r, hi); const float rl = __builtin_amdgcn_rcpf(lsc[32 * h2 + orow]);
#pragma unroll
                for (int d0 = 0; d0 < 2; ++d0) stg[orow * 64 + d0 * 32 + r32] = (bf16)f2bf(o[h2][d0][r] * rl); }
            asm volatile("s_waitcnt lgkmcnt(0)" ::: "memory");
            bf16* Ow = U.Orow + (size_t)(64 * ci + 32 * h2) * D + head * 64;
#pragma unroll
            for (int i = 0; i < 4; ++i) { const int row = i * 8 + (lane >> 3), ch = lane & 7; const u32x4 v = *(const LAS u32x4*)(stg + row * 64 + ch * 8); *(u32x4*)(Ow + (size_t)row * D + ch * 8) = v; }
        }
    }
}
}

__device__ __forceinline__ float wave_sum_dpp(float v) {
#define DPP_ADD(ctrl, rmask) v += __builtin_bit_cast(float, __builtin_amdgcn_update_dpp(0, __builtin_bit_cast(int, v), ctrl, rmask, 0xf, true))
    DPP_ADD(0x111, 0xf); DPP_ADD(0x112, 0xf); DPP_ADD(0x114, 0xf); DPP_ADD(0x118, 0xf); DPP_ADD(0x142, 0xa); DPP_ADD(0x143, 0xc);
#undef DPP_ADD
    return __builtin_bit_cast(float, __builtin_amdgcn_readlane(__builtin_bit_cast(int, v), 63));
}
#define CV_WAIT_BAR(N) asm volatile("s_waitcnt vmcnt(" #N ") lgkmcnt(0)\n\ts_barrier" ::: "memory")
typedef float f32x2v __attribute__((ext_vector_type(2)));
struct ConvConst { f32x2v w[CONVW]; f32x2v bias; };
__device__ __forceinline__ void conv_consts(ConvConst& C, const float* cw, const float* cb, int tid) {
    const int cp = tid & 255;
#pragma unroll
    for (int j = 0; j < CONVW; ++j) C.w[j] = *(const f32x2v*)(cw + j * CW + 2 * cp);
    C.bias = *(const f32x2v*)(cb + 2 * cp);
}
__device__ __forceinline__ void conv_entry(int e, const ConvConst& C, const bf16* GLU, const float* st, const float* lg, const float* lb, bf16* MIX, LAS unsigned char* lds, int tid) {
    const bool samp = e >= RP / 64; const int b = samp ? e - RP / 64 : e >> 7, t0 = samp ? 0 : (e & 127) * 64, nb = samp ? 2 : 4, rowbase = samp ? RP + DS * b : b * SEQ;
    const int wid = __builtin_amdgcn_readfirstlane(tid >> 6), lane = tid & 63, cp = tid & 255, th = tid >> 8;
    const bool first = t0 == 0;
    LAS bf16* xs = (LAS bf16*)lds;
    LAS float* ybuf = (LAS float*)(lds + 98304);
    const unsigned lds0 = (unsigned)(size_t)lds;
    const int tlast = t0 + 16 * nb - 1;
    f32x4 g0 = *(const f32x4*)(lg + 8 * lane), g1 = *(const f32x4*)(lg + 8 * lane + 4), b0 = *(const f32x4*)(lb + 8 * lane), b1 = *(const f32x4*)(lb + 8 * lane + 4);
    asm volatile("" : "+v"(g0), "+v"(g1), "+v"(b0), "+v"(b1));
#pragma unroll
    for (int i = 0; i < 12; ++i) { const int k = wid + 8 * i; int tp = t0 - CH + k; tp = tp > tlast ? tlast : tp;
        if (tp >= 0) att::glds16(GLU + (size_t)(rowbase + tp) * 512 + 8 * lane, (unsigned)__builtin_amdgcn_readfirstlane(lds0 + (unsigned)k * 1024u));
        else { pg8::u32x4 v = (pg8::u32x4){0u, 0u, 0u, 0u};
            if (samp) { const float* sp = st + ((size_t)b * CH + (CH + tp)) * CW + 8 * lane; v = pg8::pack8(*(const f32x4*)sp, *(const f32x4*)(sp + 4)); }
            *(LAS pg8::u32x4*)(xs + k * 512 + 8 * lane) = v; } }
    for (int s = 0; s < nb; ++s) {
        if (first || s == 3) CV_WAIT_BAR(0); else if (s == 0) CV_WAIT_BAR(6); else if (s == 1) CV_WAIT_BAR(4); else CV_WAIT_BAR(2);
        {
            f32x2v x[38];
            const LAS unsigned* xp = (const LAS unsigned*)(xs + (16 * s + 8 * th) * 512 + 2 * cp);
#pragma unroll
            for (int k = 0; k < 38; ++k) { const unsigned u = xp[k * 256]; x[k] = (f32x2v){__uint_as_float(u << 16), __uint_as_float(u & 0xffff0000u)}; }
            f32x2v y[8];
#pragma unroll
            for (int i = 0; i < 8; ++i) y[i] = C.bias;
#pragma unroll
            for (int j = 0; j < CONVW; ++j)
#pragma unroll
                for (int i = 0; i < 8; ++i) y[i] = __builtin_elementwise_fma(C.w[j], x[i + j], y[i]);
#pragma unroll
            for (int i = 0; i < 8; ++i) *(LAS f32x2v*)(ybuf + (8 * th + i) * 512 + 2 * cp) = y[i];
        }
        __syncthreads();
#pragma unroll
        for (int q = 0; q < 2; ++q) { const int i = 2 * wid + q;
            f32x4 v0 = *(const LAS f32x4*)(ybuf + i * 512 + 8 * lane), v1 = *(const LAS f32x4*)(ybuf + i * 512 + 8 * lane + 4);
            const float mean = wave_sum_dpp((v0[0] + v0[1]) + (v0[2] + v0[3]) + (v1[0] + v1[1]) + (v1[2] + v1[3])) * (1.0f / CW);
            v0 = v0 - mean; v1 = v1 - mean;
            const f32x4 q0 = v0 * v0, q1 = v1 * v1;
            const float rstd = rsqrtf(wave_sum_dpp((q0[0] + q0[1]) + (q0[2] + q0[3]) + (q1[0] + q1[1]) + (q1[2] + q1[3])) * (1.0f / CW) + EPS);
            v0 = v0 * rstd * g0 + b0; v1 = v1 * rstd * g1 + b1;
#pragma unroll
            for (int e2 = 0; e2 < 4; ++e2) { v0[e2] *= pg8::sigm(v0[e2]); v1[e2] *= pg8::sigm(v1[e2]); }
            *(pg8::u32x4*)(MIX + (size_t)(rowbase + t0 + 16 * s + i) * D + 512 + 8 * lane) = pg8::pack8(v0, v1); }
        __syncthreads();
    }
}

constexpr int SG_LD = 68;
#define SG_WAIT_BAR(N) asm volatile("s_waitcnt vmcnt(" #N ") lgkmcnt(0)\n\ts_barrier" ::: "memory")
template <class Epi> __device__ __forceinline__ void sgemm64(const bf16* A, const bf16* Bt, int K_, int tile, const Epi& E, LAS unsigned char* lds) {
    int tid_ = threadIdx.x; asm volatile("" : "+v"(tid_)); int K = K_; asm volatile("" : "+s"(K));
    const int lane = tid_ & 63, wave = __builtin_amdgcn_readfirstlane(tid_ >> 6), fr = lane & 15, fq = lane >> 4, wm = wave & 3, wn = wave >> 2, tr = tile >> 4, tc = tile & 15;
    const int KS = K >> 7;
    const unsigned char* src[4]; unsigned dsto[4];
#pragma unroll
    for (int i = 0; i < 4; ++i) { const int p = wave + 8 * i, r = 4 * (p & 15) + (lane >> 4), cs = (lane & 15) ^ (r & 15);
        src[i] = (const unsigned char*)((p < 16 ? A + (size_t)(64 * tr + r) * K : Bt + (size_t)(64 * tc + r) * K)) + cs * 16;
        dsto[i] = (p < 16 ? 0u : 16384u) + (unsigned)(p & 15) * 1024u; }
    const unsigned lds0 = (unsigned)(size_t)lds;
#define SG_STAGE(t) do { _Pragma("unroll") for (int i_ = 0; i_ < 4; ++i_) att::glds16(src[i_] + (size_t)(t) * 256, (unsigned)__builtin_amdgcn_readfirstlane(lds0 + (unsigned)((t) & 3) * 32768u + dsto[i_])); } while (0)
    f32x4 acc0 = (f32x4){0.f, 0.f, 0.f, 0.f}, acc1 = acc0;
    SG_STAGE(0); if (KS > 1) SG_STAGE(1); if (KS > 2) SG_STAGE(2);
    const unsigned ra = (unsigned)(16 * wm + fr) * 256u, rb = 16384u + (unsigned)(32 * wn + fr) * 256u;
    for (int t = 0; t < KS; ++t) {
        if (t + 2 < KS) SG_WAIT_BAR(8); else if (t + 1 < KS) SG_WAIT_BAR(4); else SG_WAIT_BAR(0);
        if (t + 3 < KS) SG_STAGE(t + 3);
        const LAS unsigned char* sb = lds + (t & 3) * 32768;
#pragma unroll
        for (int ks = 0; ks < 4; ++ks) { const unsigned ch = (unsigned)((4 * ks + fq) ^ fr) * 16u;
            const bf16x8 a = *(const LAS bf16x8*)(sb + ra + ch), b0 = *(const LAS bf16x8*)(sb + rb + ch), b1 = *(const LAS bf16x8*)(sb + rb + 4096 + ch);
            acc0 = __builtin_amdgcn_mfma_f32_16x16x32_bf16(b0, a, acc0, 0, 0, 0); acc1 = __builtin_amdgcn_mfma_f32_16x16x32_bf16(b1, a, acc1, 0, 0, 0); }
    }
#undef SG_STAGE
    SG_WAIT_BAR(0);
    LAS float* part = (LAS float*)lds;
    *(LAS f32x4*)(part + (16 * wm + fr) * SG_LD + 32 * wn + 4 * fq) = acc0; *(LAS f32x4*)(part + (16 * wm + fr) * SG_LD + 32 * wn + 16 + 4 * fq) = acc1;
    __syncthreads();
    const int row = tid_ >> 3, c8 = (tid_ & 7) * 8;
    const f32x4 v0 = *(const LAS f32x4*)(part + row * SG_LD + c8), v1 = *(const LAS f32x4*)(part + row * SG_LD + c8 + 4);
    E(64 * tr + row, 64 * tc + c8, tc, tid_ & 7, v0, v1);
    __syncthreads();
}
__device__ __forceinline__ float oct_sum(float s) { s += __shfl_xor(s, 1); s += __shfl_xor(s, 2); s += __shfl_xor(s, 4); return s; }
template <bool BF> struct SEpiRes {
    const float* base; bf16* HB; float* SS;
    __device__ __forceinline__ void operator()(int row, int col, int tc, int l8, f32x4 v0, f32x4 v1) const {
        const size_t o = (size_t)row * D + col;
        if (BF) { const pg8::u32x4 w = *(const pg8::u32x4*)(HB + o); v0 = v0 + pg8::bf_lo4(w); v1 = v1 + pg8::bf_hi4(w); }
        else { v0 = v0 + *(const f32x4*)(base + o); v1 = v1 + *(const f32x4*)(base + o + 4); }
        *(pg8::u32x4*)(HB + o) = pg8::pack8(v0, v1);
        const f32x4 q0 = v0 * v0, q1 = v1 * v1;
        const float ss = oct_sum(((q0[0] + q0[1]) + (q0[2] + q0[3])) + ((q1[0] + q1[1]) + (q1[2] + q1[3])));
        if (l8 == 0) SS[(size_t)row * 16 + tc] = ss;
    }
};
struct SEpiPP {
    bf16* PP;
    __device__ __forceinline__ void operator()(int row, int col, int tc, int l8, f32x4 v0, f32x4 v1) const { *(pg8::u32x4*)(PP + (size_t)row * D + col) = pg8::pack8(v0, v1); }
};
struct SEpiFinal {
    const float* SS; const bf16* PP; const bf16* HB; float* Y;
    __device__ __forceinline__ void operator()(int row, int col, int tc, int l8, f32x4 v0, f32x4 v1) const {
        const float r = rsqrtf(oct_sum(SS[(size_t)row * 16 + 2 * l8] + SS[(size_t)row * 16 + 2 * l8 + 1]) * (1.0f / D) + EPS);
        const size_t o = (size_t)row * D + col;
        const pg8::u32x4 pw = *(const pg8::u32x4*)(PP + o), hw = *(const pg8::u32x4*)(HB + o);
        const f32x4 p0 = pg8::bf_lo4(pw), p1 = pg8::bf_hi4(pw); f32x4 h0 = pg8::bf_lo4(hw), h1 = pg8::bf_hi4(hw);
#pragma unroll
        for (int e = 0; e < 4; ++e) { h0[e] += pg8::sigm(v0[e] * r) * p0[e]; h1[e] += pg8::sigm(v1[e] * r) * p1[e]; }
        __builtin_nontemporal_store(h0, (f32x4*)(Y + o)); __builtin_nontemporal_store(h1, (f32x4*)(Y + o + 4));
    }
};

#ifndef REP_P0
#define REP_P0 1
#endif
#ifndef REP_P1
#define REP_P1 1
#endif
#ifndef REP_P2
#define REP_P2 1
#endif
#ifndef REP_P3
#define REP_P3 1
#endif
#ifndef REP_P4
#define REP_P4 1
#endif
struct Args { const float* in[23]; float* out; unsigned char* ws; };
constexpr int N_ATT_S = 2 * DB, N_ATT_P = NB * 64 * 2, N_CONV = RP / 64 + DB;
constexpr int I_WO = (D / 64) * (D / 32), I_WGU = (D / 64) * (2 * DFF / 32), N_WCV = (I_WO + I_WGU) / 8;
constexpr int N_ATT_Q = 8 + 64;
static_assert((I_WO + I_WGU) % 8 == 0, "weight conversion entries");
#define W1t ((bf16*)(ws + WS_W1))
#define WOt ((bf16*)(ws + WS_WO))
#define WGUt ((bf16*)(ws + WS_WGU))
#define WDt ((bf16*)(ws + WS_WD))
#define WPGt ((bf16*)(ws + WS_WPG))
#define WPPt ((bf16*)(ws + WS_WPP))
#define RX ((float*)(ws + WS_RX))
#define SS1 ((float*)(ws + WS_SS1))
#define SS2 ((float*)(ws + WS_SS2))
#define XB ((bf16*)(ws + WS_XB))
#define PB ((bf16*)(ws + WS_PB))
#define PPb ((bf16*)(ws + WS_PP))
#define Qb ((bf16*)(ws + WS_Q))
#define KVP (ws + WS_KP)
#define KVS (ws + WS_KS)
#define GLUb ((bf16*)(ws + WS_GLU))
#define MIXb ((bf16*)(ws + WS_MIX))
#define ACTb ((bf16*)(ws + WS_ACT))
#define Y (out + OY)
__global__ void __launch_bounds__(NWAVES * 64, 2) mk_fwd(Args args) {
    extern __shared__ __attribute__((aligned(16))) unsigned char lds_[];
    LAS unsigned char* lds = (LAS unsigned char*)lds_;
    volatile LAS unsigned* MISC = (volatile LAS unsigned*)(lds + MISC_OFF);
    const int G = gridDim.x, vcu = (G % 8 == 0) ? ((int)blockIdx.x % 8) * (G / 8) + (int)blockIdx.x / 8 : (int)blockIdx.x;
    unsigned char* ws = args.ws; float* out = args.out;
    gu32* ctl = (gu32*)(ws + WS_CTL);
    for (int u = threadIdx.x; u < (ATT_TAB - LDSCTL_OFF) / 4; u += NWAVES * 64) ((LAS unsigned*)(lds + LDSCTL_OFF))[u] = 0u;
    __syncthreads();
    XcdBarrier bar = xcd_barrier_post((unsigned*)(ctl + CW_BAR), MISC + 8);

#ifndef SKIP_P0
    for (int rep = 0; rep < REP_P0; ++rep) {
        if (rep) xcd_barrier(bar);
        int tid0 = threadIdx.x; asm volatile("" : "+v"(tid0));
        const int lane = tid0 & 63, wave = __builtin_amdgcn_readfirstlane(tid0 >> 6);
        LAS float* scr = (LAS float*)(lds + RING_OFF + wave * 16384);
        const int gw = vcu * NWAVES + wave, NGW = G * NWAVES;
        constexpr int I_1 = (D / 64) * (INC / 32);
        for (int it = gw; it < I_1; it += NGW) p0_transpose_item<1>(args.in[8], args.in[7], D, INC, W1t, scr, it, lane);
        for (int m2 = gw; m2 < R / 2; m2 += NGW) {
            f32x4 v[2][4];
#pragma unroll
            for (int rr = 0; rr < 2; ++rr) { const int m = 2 * m2 + rr; const float* xrow = m < RP ? args.in[0] + (size_t)m * D : args.in[1] + (size_t)(m - RP) * D;
                const GAS f32x4* xr = (const GAS f32x4*)xrow + lane;
#pragma unroll
                for (int j = 0; j < 4; ++j) v[rr][j] = __builtin_nontemporal_load(xr + 64 * j); }
#pragma unroll
            for (int rr = 0; rr < 2; ++rr) { const int m = 2 * m2 + rr; float s = 0.f;
#pragma unroll
                for (int j = 0; j < 4; ++j) s += (v[rr][j].x * v[rr][j].x + v[rr][j].y * v[rr][j].y) + (v[rr][j].z * v[rr][j].z + v[rr][j].w * v[rr][j].w);
                s = wave_sum(s); if (lane == 0) RX[m] = rsqrtf(s * (1.0f / D) + EPS);
                GAS unsigned long long* o8 = (GAS unsigned long long*)(XB + (size_t)m * D) + lane;
#pragma unroll
                for (int j = 0; j < 4; ++j) o8[64 * j] = (unsigned long long)pk2(v[rr][j].x, v[rr][j].y) | ((unsigned long long)pk2(v[rr][j].z, v[rr][j].w) << 32); }
        }
    }
#endif
    xcd_barrier(bar);

#ifndef SKIP_P1
    for (int rep = 0; rep < REP_P1; ++rep) {
        if (rep) xcd_barrier(bar);
        pg8::Gemm g{XB, W1t, R, INC, D}; pg8::StaticOrder S; S.init(R, INC, G, (int)blockIdx.x);
        pg8::Epi1 E{RX, args.in[9], args.in[10], Qb, KVP, KVS, GLUb, out};
        pg8::gemm_phase<pg8::Epi1, pg8::StaticOrder, true, true>(lds + RING_OFF, g, S, E);
        { const int c0 = ((R / 256) * (INC / 256)) % G, nwgc = c0 ? G - c0 : G, cc = c0 ? (int)blockIdx.x - c0 : (int)blockIdx.x;
          if (cc >= 0) {
            int tidc = threadIdx.x; asm volatile("" : "+v"(tidc));
            const int lane = tidc & 63, wave = __builtin_amdgcn_readfirstlane(tidc >> 6), head = lane >> 3, dq = lane & 7;
            for (int m2 = cc * NWAVES + wave; m2 < DB * 512; m2 += nwgc * NWAVES) {
                const int b = m2 >> 9, j = m2 & 511, kv = j & 63;
                const GAS f32x4* sk = (const GAS f32x4*)(args.in[4] + (size_t)m2 * 512) + 2 * lane; const GAS f32x4* sv = (const GAS f32x4*)(args.in[5] + (size_t)m2 * 512) + 2 * lane;
                const f32x4 k0 = __builtin_nontemporal_load(sk), k1 = __builtin_nontemporal_load(sk + 1), v0 = __builtin_nontemporal_load(sv), v1 = __builtin_nontemporal_load(sv + 1);
                unsigned char* tb = KVS + (size_t)(b * 9 + (j >> 6)) * KVT_BYTES + (head >> 2) * 65536 + (head & 3) * 16384;
                *(GAS v4u*)(tb + dq * 1024 + kv * 16) = (v4u){pk2(k0.x, k0.y), pk2(k0.z, k0.w), pk2(k1.x, k1.y), pk2(k1.z, k1.w)};
                *(GAS v4u*)(tb + 8192 + (dq >> 2) * 4096 + (kv >> 4) * 1024 + (kv & 15) * 64 + (dq & 3) * 16) = (v4u){pk2(v0.x, v0.y), pk2(v0.z, v0.w), pk2(v1.x, v1.y), pk2(v1.z, v1.w)};
            }
            for (int p = cc * NWAVES + wave; p < DB * NH; p += nwgc * NWAVES) {
                unsigned char* tb = KVS + (size_t)((p >> 3) * 9 + 8) * KVT_BYTES + ((p & 7) >> 2) * 65536 + (p & 3) * 16384; const v4u z = (v4u){0u, 0u, 0u, 0u};
#pragma unroll
                for (int c2 = 0; c2 < 4; ++c2) *(GAS v4u*)(tb + (2 * c2 + (lane >> 5)) * 1024 + 512 + (lane & 31) * 16) = z;
#pragma unroll
                for (int q = 0; q < 4; ++q) *(GAS v4u*)(tb + 8192 + (q >> 1) * 4096 + (2 + (q & 1)) * 1024 + lane * 16) = z;
            }
          } }
    }
#endif
    xcd_barrier(bar);

#ifndef SKIP_P2
    for (int rep = 0; rep < REP_P2; ++rep) {
        if (rep) xcd_barrier(bar);
        { int tidt = threadIdx.x; asm volatile("" : "+v"(tidt)); const int lane = tidt & 63, wave = __builtin_amdgcn_readfirstlane(tidt >> 6);
          const float* relb = args.in[11] + wave * NREL; LAS float* T = (LAS float*)(lds + ATT_TAB) + wave * 256;
          const float bfar = relb[256];
          for (int x = lane; x < 256; x += 64) { int dd = 191 - x; dd = dd < -128 ? -128 : (dd > 128 ? 128 : dd); T[x] = (relb[dd + 128] - bfar) * LOG2E; } }
        __syncthreads();
        {
            int tid2 = threadIdx.x; asm volatile("" : "+v"(tid2));
            const int lane2 = tid2 & 63, wave2 = __builtin_amdgcn_readfirstlane(tid2 >> 6);
            int qk = 0, q = (int)blockIdx.x & 7;
#define ATT_POP(qq) ((int)__hip_atomic_fetch_add((unsigned*)(ctl + CW_Q + 64 * ((qq) + 8 * rep)), 1u, __ATOMIC_RELAXED, __HIP_MEMORY_SCOPE_AGENT))
#define ATT_DECODE(code, U) do { const int q_ = (int)((code) >> 8), i_ = (int)((code) & 255u); \
                if (i_ < 8) { const int sb = 4 * q_ + (i_ >> 1); U.hg = i_ & 1; U.sample = 1; U.nt = 9; U.c0rel = 8; \
                    U.Qrow = Qb + (size_t)(RP + DS * sb) * 512; U.KV = KVS + (size_t)(sb * 9) * KVT_BYTES; U.Orow = MIXb + (size_t)(RP + DS * sb) * D; } \
                else { const int j = i_ - 8, pi = j < 60 ? 4 + j : 63 - j, bb = q_ >> 1, c0 = 2 * pi;     \
                    U.hg = q_ & 1; U.sample = 0; U.c0rel = c0 < 8 ? c0 : 8; U.nt = U.c0rel + 2; const size_t row0 = (size_t)bb * SEQ + 64 * c0; \
                    U.Qrow = Qb + row0 * 512; U.KV = KVP + (size_t)(bb * 128 + c0 - U.c0rel) * KVT_BYTES; U.Orow = MIXb + row0 * D; } } while (0)
            if (tid2 == 0) { int i = ATT_POP(q); while (i >= N_ATT_Q) { if (++qk == 8) { i = -1; break; } q = ((int)blockIdx.x + qk) & 7; i = ATT_POP(q); }
                MISC[4] = i < 0 ? 0xffffffffu : (unsigned)((q << 8) | i); }
            __syncthreads();
            unsigned code = MISC[4];
            if (code != 0xffffffffu) {
                att::AUnit U; ATT_DECODE(code, U);
                att::bf16x8 qr[2][4];
                att::attn_prefetch(U, lds, wave2, lane2, qr);
                for (;;) {
                    int nraw = 0; if (tid2 == 0) nraw = ATT_POP(q);
#pragma unroll
                    for (int d0 = 0; d0 < 4; ++d0) asm volatile("" : "+v"(qr[0][d0]), "+v"(qr[1][d0]));
                    att::f32x16 o[2][2]; o[0][0] = att::f32x16{}; o[0][1] = att::f32x16{}; o[1][0] = att::f32x16{}; o[1][1] = att::f32x16{}; float lsum[2] = {0.f, 0.f};
                    if (U.sample) att::attn_steps<false>(U, lds, wave2, lane2, qr, o, lsum); else att::attn_steps<true>(U, lds, wave2, lane2, qr, o, lsum);
                    if (tid2 == 0) { int i = nraw; while (i >= N_ATT_Q) { if (++qk == 8) { i = -1; break; } q = ((int)blockIdx.x + qk) & 7; i = ATT_POP(q); }
                        MISC[4] = i < 0 ? 0xffffffffu : (unsigned)((q << 8) | i); }
                    ATT_WAIT_BAR();
                    const unsigned ncode = MISC[4];
                    att::AUnit Un = U;
                    if (ncode != 0xffffffffu) { ATT_DECODE(ncode, Un); att::attn_prefetch(Un, lds, wave2, lane2, qr); }
                    if (U.sample) att::attn_store<false>(U, lds, wave2, lane2, o, lsum); else att::attn_store<true>(U, lds, wave2, lane2, o, lsum);
                    if (ncode == 0xffffffffu) break;
                    U = Un;
                }
                ATT_WAIT_BAR();
            }
#undef ATT_POP
#undef ATT_DECODE
        }
        ConvConst CC; { int tidc = threadIdx.x; asm volatile("" : "+v"(tidc)); conv_consts(CC, args.in[12], args.in[13], tidc); }
        for (;;) {
            int tid2 = threadIdx.x; asm volatile("" : "+v"(tid2));
            if (tid2 == 0) MISC[4] = __hip_atomic_fetch_add((unsigned*)(ctl + CW_QG + 64 * rep), 1u, __ATOMIC_RELAXED, __HIP_MEMORY_SCOPE_AGENT);
            __syncthreads();
            const int idx = (int)MISC[4];
            __syncthreads();
            if (idx >= N_CONV + N_WCV) break;
            const int lane2 = tid2 & 63, wave2 = __builtin_amdgcn_readfirstlane(tid2 >> 6);
            if (idx < N_CONV) conv_entry(idx, CC, GLUb, args.in[6], args.in[14], args.in[15], MIXb, lds, tid2);
            else { const int it = 8 * (idx - N_CONV) + wave2; LAS float* scr = (LAS float*)(lds + RING_OFF + wave2 * 16384);
                if (it < I_WO) p0_transpose_item<0>(args.in[16], nullptr, D, D, WOt, scr, it, lane2);
                else p0_transpose_item<2>(args.in[18], args.in[17], D, 2 * DFF, WGUt, scr, it - I_WO, lane2);
                __syncthreads(); }
        }
    }
#endif
    xcd_barrier(bar);

#ifndef SKIP_P3
    for (int rep = 0; rep < REP_P3; ++rep) {
        if (rep) xcd_barrier(bar);
        pg8::Gemm g{MIXb, WOt, RP, D, D}; pg8::StaticOrder S; S.init(RP, D, G, (int)blockIdx.x);
        pg8::EpiRes<true> E{nullptr, nullptr, XB, SS1};
        const SEpiRes<true> SE{nullptr, XB + (size_t)RP * D, SS1 + (size_t)RP * 16};
        if (blockIdx.x & 1) for (int t = (int)blockIdx.x; t < 256; t += G) sgemm64(MIXb + (size_t)RP * D, WOt, D, t, SE, lds + RING_OFF);
        pg8::gemm_phase<pg8::EpiRes<true>, pg8::StaticOrder, true, true>(lds + RING_OFF, g, S, E);
        if (!(blockIdx.x & 1)) for (int t = (int)blockIdx.x; t < 256; t += G) sgemm64(MIXb + (size_t)RP * D, WOt, D, t, SE, lds + RING_OFF);
    }
#endif
    xcd_barrier(bar);

#ifndef SKIP_P4
    for (int rep = 0; rep < REP_P4; ++rep) {
        if (rep) xcd_barrier(bar);
        { const int c0 = ((R / 256) * (2 * DFF / 256)) % G, nwgc = c0 ? G - c0 : G, cc = c0 ? (int)blockIdx.x - c0 : (int)blockIdx.x;
          if (cc >= 0) {
            const bool wt = false; const int k = wt ? cc & 3 : 1, j = wt ? cc >> 2 : cc, per = wt ? nwgc / 4 : nwgc, nslot = wt ? 6 * per : per;
            const int s0 = !wt ? j : (k == 1 ? j : (k == 2 ? per + 2 * j : 3 * per + 3 * j));
            int tidc = threadIdx.x; asm volatile("" : "+v"(tidc));
            const int lane = tidc & 63, wave = __builtin_amdgcn_readfirstlane(tidc >> 6);
            for (int q = 0; q < k; ++q)
            for (int m4 = s0 + q + nslot * wave; m4 < 2 * DB * 120; m4 += nslot * NWAVES) {
                const int kv = m4 >= DB * 120, mm = kv ? m4 - DB * 120 : m4, b = mm / 120, j2 = DS + 4 * (mm % 120);
                const GAS f32x4* src = (const GAS f32x4*)(args.in[4 + kv] + ((size_t)b * 512 + j2) * 512) + lane;
                GAS f32x4* dst = (GAS f32x4*)(out + (kv ? OVS : OKS) + ((size_t)b * 512 + (j2 - DS)) * 512) + lane;
                f32x4 v[8];
#pragma unroll
                for (int i = 0; i < 8; ++i) v[i] = __builtin_nontemporal_load(src + 64 * i);
#pragma unroll
                for (int i = 0; i < 8; ++i) __builtin_nontemporal_store(v[i], dst + 64 * i);
            }
            { LAS float* scr = (LAS float*)(lds + RING_OFF + wave * 16384); constexpr int I_D = (DFF / 64) * (D / 32), I_PG = (D / 64) * (D / 32);
              constexpr int I_PP = (PLE / 64) * (D / 32);
              for (int it = cc * NWAVES + wave; it < I_D + I_PG + I_PP; it += nwgc * NWAVES) {
                  if (it < I_D) p0_transpose_item<0>(args.in[19], nullptr, DFF, D, WDt, scr, it, lane);
                  else if (it < I_D + I_PG) p0_transpose_item<0>(args.in[21], args.in[20], D, D, WPGt, scr, it - I_D, lane);
                  else p0_transpose_item<0>(args.in[22], nullptr, PLE, D, WPPt, scr, it - I_D - I_PG, lane); }
              __syncthreads(); }
            for (int m8 = cc * NWAVES + wave; m8 < R / 8; m8 += nwgc * NWAVES) {
                const int m = 8 * m8; const float* prow = m < RP ? args.in[2] + (size_t)m * PLE : args.in[3] + (size_t)(m - RP) * PLE;
                const GAS f32x4* pr = (const GAS f32x4*)prow + lane; f32x4 pv[8];
#pragma unroll
                for (int j = 0; j < 8; ++j) pv[j] = __builtin_nontemporal_load(pr + 64 * j);
                GAS unsigned long long* o8 = (GAS unsigned long long*)(PB + (size_t)m * PLE) + lane;
#pragma unroll
                for (int j = 0; j < 8; ++j) o8[64 * j] = (unsigned long long)pk2(pv[j].x, pv[j].y) | ((unsigned long long)pk2(pv[j].z, pv[j].w) << 32);
            }
          } }
        pg8::Gemm g{XB, WGUt, R, 2 * DFF, D}; pg8::StaticOrder S; S.init(R, 2 * DFF, G, (int)blockIdx.x);
        pg8::EpiAct E{SS1, ACTb};
        pg8::gemm_phase<pg8::EpiAct, pg8::StaticOrder, true, true>(lds + RING_OFF, g, S, E);
    }
#endif
    xcd_barrier(bar);

#ifndef SKIP_P5
    {
        pg8::Gemm g{ACTb, WDt, RP, D, DFF}; pg8::StaticOrder S; S.init(RP, D, G, (int)blockIdx.x);
        pg8::EpiRes<true> E{nullptr, nullptr, XB, SS2};
        const SEpiRes<true> SE{nullptr, XB + (size_t)RP * D, SS2 + (size_t)RP * 16};
        if (blockIdx.x & 1) for (int t = (int)blockIdx.x; t < 256; t += G) sgemm64(ACTb + (size_t)RP * DFF, WDt, DFF, t, SE, lds + RING_OFF);
        pg8::gemm_phase<pg8::EpiRes<true>, pg8::StaticOrder, true, true>(lds + RING_OFF, g, S, E);
        if (!(blockIdx.x & 1)) for (int t = (int)blockIdx.x; t < 256; t += G) sgemm64(ACTb + (size_t)RP * DFF, WDt, DFF, t, SE, lds + RING_OFF);
    }
#endif
    xcd_barrier(bar);

#ifndef SKIP_P6
    {
        pg8::Gemm g{XB, WPGt, RP, D, D}; pg8::StaticOrder S; S.init(RP, D, G, (int)blockIdx.x);
        pg8::EpiFinal E{SS2, PPb, XB, Y};
        const SEpiFinal SE{SS2 + (size_t)RP * 16, PPb + (size_t)RP * D, XB + (size_t)RP * D, Y + (size_t)RP * D};
        pg8::Gemm gp{PB, WPPt, RP, D, PLE}; pg8::EpiPP EP{PPb}; const SEpiPP SP{PPb + (size_t)RP * D};
        if (blockIdx.x & 1) for (int t = (int)blockIdx.x; t < 256; t += G) { sgemm64(PB + (size_t)RP * PLE, WPPt, PLE, t, SP, lds + RING_OFF); sgemm64(XB + (size_t)RP * D, WPGt, D, t, SE, lds + RING_OFF); }
        pg8::gemm_phase<pg8::EpiPP, pg8::StaticOrder, true, true>(lds + RING_OFF, gp, S, EP);
        pg8::gemm_phase<pg8::EpiFinal, pg8::StaticOrder, true, true>(lds + RING_OFF, g, S, E);
        if (!(blockIdx.x & 1)) for (int t = (int)blockIdx.x; t < 256; t += G) { sgemm64(PB + (size_t)RP * PLE, WPPt, PLE, t, SP, lds + RING_OFF); sgemm64(XB + (size_t)RP * D, WPGt, D, t, SE, lds + RING_OFF); }
    }
#endif
}

extern "C" void kernel_launch(void* const* d_in, const int* in_sizes, int n_in, void* d_out, int out_size, void* d_ws, size_t ws_size, hipStream_t stream) {
    static int grid = 0;
    if (grid == 0) {
        if (n_in != 23 || ws_size < WS_END) { fprintf(stderr, "kernel_launch: unexpected shapes (n_in %d, ws %zu)\n", n_in, ws_size); grid = -1; return; }
        int dev = 0, cus = 0, per_cu = 0;
        if (hipGetDevice(&dev) != hipSuccess || hipDeviceGetAttribute(&cus, hipDeviceAttributeMultiprocessorCount, dev) != hipSuccess) { grid = -1; return; }
        if (hipFuncSetAttribute((const void*)mk_fwd, hipFuncAttributeMaxDynamicSharedMemorySize, LDS_BYTES) != hipSuccess) { fprintf(stderr, "kernel_launch: hipFuncSetAttribute failed\n"); grid = -1; return; }
        if (hipOccupancyMaxActiveBlocksPerMultiprocessor(&per_cu, (const void*)mk_fwd, NWAVES * 64, LDS_BYTES) != hipSuccess || per_cu < 1) { fprintf(stderr, "kernel_launch: occupancy query says %d blocks per CU\n", per_cu); }
        (void)hipGetLastError();
        grid = cus;
    }
    if (grid < 0) return;
    if (hipMemsetAsync((char*)d_ws + WS_CTL, 0, CTL_ZERO_BYTES, stream) != hipSuccess) return;
    Args a{};
    for (int i = 0; i < 23; ++i) a.in[i] = (const float*)d_in[i];
    a.out = (float*)d_out; a.ws = (unsigned char*)d_ws;
    hipLaunchKernelGGL(mk_fwd, dim3(grid), dim3(NWAVES * 64), LDS_BYTES, stream, a);
}
```
